# Optimizing an MI355X kernel written in HIP

```python
import math
import jax, jax.numpy as jnp
from jax import lax
import numpy as np


D_MODEL = 1024
BATCH = 8
SEQ = 8192
DEPTH = 1

MIX_WIDTH = D_MODEL
NSA_WIDTH = MIX_WIDTH // 2
SSD_WIDTH = MIX_WIDTH - NSA_WIDTH

NSA_HEAD_DIM = 64
NSA_HEADS = NSA_WIDTH // NSA_HEAD_DIM
NSA_KV_GROUPS = 2
NSA_HPG = NSA_HEADS // NSA_KV_GROUPS
NSA_KV_WIDTH = NSA_KV_GROUPS * NSA_HEAD_DIM
N_BRANCH = 3
CMP_BLOCK = 32
CMP_STRIDE = 16
CMP_HIDDEN = 256
SEL_BLOCK = 64
SEL_TOPN = 16
WINDOW = 512
Q_BLOCK = 128
ROPE_THETA = 500000.0
ROPE_DIM = NSA_HEAD_DIM // 4

SSD_HEAD_DIM = 64
SSD_HEADS = SSD_WIDTH // SSD_HEAD_DIM
SSD_GROUPS = 2
SSD_RPG = SSD_HEADS // SSD_GROUPS
SSD_STATE = 128
SSD_CONV = 4
SSD_CHUNK = 128
SSD_CONV_CH = SSD_WIDTH + 2 * SSD_GROUPS * SSD_STATE

PEER_HEADS = 8
PEER_NKEYS = 128
PEER_EXPERTS = PEER_NKEYS * PEER_NKEYS
PEER_QDIM = 256
PEER_TOPK = 16
PEER_TOKEN_BLOCK = 256

IN_SPLIT_SIZES = (NSA_WIDTH,) + (NSA_KV_WIDTH,) * 6 + (NSA_HEADS * N_BRANCH, SSD_WIDTH, SSD_CONV_CH, SSD_HEADS)
IN_COLS = sum(IN_SPLIT_SIZES)

NORM_EPS = 1e-6
NEG_INF = -1e30
FORCE_BONUS = 1e4

kernel_name = 'hymba_nsa_ssd_peer_adaln_block'


def rmsnorm(x, w):
    xf = x.astype(jnp.float32)
    y = xf * lax.rsqrt(jnp.mean(xf * xf, axis=-1, keepdims=True) + NORM_EPS)
    return (y * w.astype(jnp.float32)).astype(x.dtype)


def modulate(x, w, shift, scale):
    return rmsnorm(x, w) * (1 + scale[:, None, :]) + shift[:, None, :]


def masked_softmax(s, mask):
    s = jnp.where(mask, s.astype(jnp.float32), NEG_INF)
    p = jax.nn.softmax(s, axis=-1)
    return jnp.where(mask, p, 0.0)


def partial_rope(x, pos):
    half = ROPE_DIM // 2
    inv_freq = ROPE_THETA ** (-jnp.arange(half, dtype=jnp.float32) / half)
    ang = pos.astype(jnp.float32)[:, None] * inv_freq[None, :]
    cos, sin = jnp.cos(ang), jnp.sin(ang)
    xr = x[..., :ROPE_DIM].astype(jnp.float32)
    x1, x2 = xr[..., :half], xr[..., half:]
    rot = jnp.concatenate([x1 * cos - x2 * sin, x2 * cos + x1 * sin], axis=-1).astype(x.dtype)
    return jnp.concatenate([rot, x[..., ROPE_DIM:]], axis=-1)


def nsa_mixer(q, k_cmp, v_cmp, k_sel, v_sel, k_win, v_win, gate_logits,
              pe_k, pe_v, w1_k, w2_k, w1_v, w2_v):
    bsz, s, _ = q.shape
    dh = NSA_HEAD_DIM
    G, R = NSA_KV_GROUPS, NSA_HPG
    pos = jnp.arange(s)
    scale = NSA_HEAD_DIM ** -0.5

    qh = q.reshape(bsz, s, G, R, dh).transpose(0, 2, 3, 1, 4)
    qr = partial_rope(qh, pos)

    def heads_kv(t):
        return t.reshape(bsz, s, G, dh).transpose(0, 2, 1, 3)

    k_cmp, v_cmp, k_sel, v_sel, k_win, v_win = (heads_kv(t) for t in (k_cmp, v_cmp, k_sel, v_sel, k_win, v_win))
    k_sel = partial_rope(k_sel, pos)
    k_win = partial_rope(k_win, pos)
    gates = jax.nn.sigmoid(gate_logits.astype(jnp.float32)).astype(q.dtype)
    gates = gates.reshape(bsz, s, G, R, N_BRANCH).transpose(0, 2, 3, 1, 4)

    n_cmp = (s - CMP_BLOCK) // CMP_STRIDE + 1
    cmp_start = jnp.arange(n_cmp) * CMP_STRIDE
    cmp_idx = cmp_start[:, None] + jnp.arange(CMP_BLOCK)[None, :]

    def compress(kv, pe, w1, w2):
        blk = (kv[:, :, cmp_idx] + pe).reshape(bsz, G, n_cmp, CMP_BLOCK * dh)
        return jax.nn.gelu(blk @ w1) @ w2

    kc = compress(k_cmp, pe_k, w1_k, w2_k)
    vc = compress(v_cmp, pe_v, w1_v, w2_v)
    cmp_end = cmp_start + CMP_BLOCK - 1

    n_sel = s // SEL_BLOCK
    n_top = min(SEL_TOPN, n_sel)
    sel_start = jnp.arange(n_sel) * SEL_BLOCK
    overlap = jnp.maximum(
        jnp.minimum(cmp_start[:, None] + CMP_BLOCK, sel_start[None, :] + SEL_BLOCK)
        - jnp.maximum(cmp_start[:, None], sel_start[None, :]), 0).astype(jnp.float32) / CMP_BLOCK
    ks_blk = k_sel.reshape(bsz, G, n_sel, SEL_BLOCK, dh)
    vs_blk = v_sel.reshape(bsz, G, n_sel, SEL_BLOCK, dh)
    gather_blocks = jax.vmap(jax.vmap(lambda blocks, idx: blocks[idx]))

    kw_pad = jnp.pad(k_win, ((0, 0), (0, 0), (WINDOW, 0), (0, 0)))
    vw_pad = jnp.pad(v_win, ((0, 0), (0, 0), (WINDOW, 0), (0, 0)))
    sel_off = jnp.arange(SEL_BLOCK)
    jj = jnp.arange(n_sel)

    def query_block(qb):
        q0 = qb * Q_BLOCK
        t = q0 + jnp.arange(Q_BLOCK)
        qc = lax.dynamic_slice_in_dim(qh, q0, Q_BLOCK, axis=3)
        qrc = lax.dynamic_slice_in_dim(qr, q0, Q_BLOCK, axis=3)
        g = lax.dynamic_slice_in_dim(gates, q0, Q_BLOCK, axis=3)

        s_c = jnp.einsum('bgrtd,bgnd->bgrtn', qc, kc) * scale
        p_c = masked_softmax(s_c, cmp_end[None, :] <= t[:, None])
        o_c = jnp.einsum('bgrtn,bgnd->bgrtd', p_c.astype(vc.dtype), vc)

        imp = jnp.einsum('bgrtn,nj->bgtj', p_c, overlap)
        blk_t = t // SEL_BLOCK
        forced = (jj[None, :] == 0) | (jj[None, :] == blk_t[:, None]) | (jj[None, :] == blk_t[:, None] - 1)
        imp = jnp.where(sel_start[None, :] <= t[:, None], imp + jnp.where(forced, FORCE_BONUS, 0.0), NEG_INF)
        _, sel = lax.top_k(imp, n_top)

        kg = gather_blocks(ks_blk, sel).reshape(bsz, G, Q_BLOCK, n_top * SEL_BLOCK, dh)
        vg = gather_blocks(vs_blk, sel).reshape(bsz, G, Q_BLOCK, n_top * SEL_BLOCK, dh)
        kpos = (sel[..., None] * SEL_BLOCK + sel_off).reshape(bsz, G, Q_BLOCK, n_top * SEL_BLOCK)
        s_s = jnp.einsum('bgrtd,bgtmd->bgrtm', qrc, kg) * scale
        p_s = masked_softmax(s_s, (kpos <= t[None, None, :, None])[:, :, None])
        o_s = jnp.einsum('bgrtm,bgtmd->bgrtd', p_s.astype(vg.dtype), vg)

        kw = lax.dynamic_slice_in_dim(kw_pad, q0, Q_BLOCK + WINDOW, axis=2)
        vw = lax.dynamic_slice_in_dim(vw_pad, q0, Q_BLOCK + WINDOW, axis=2)
        kpos_w = q0 - WINDOW + jnp.arange(Q_BLOCK + WINDOW)
        m_w = (kpos_w[None, :] >= 0) & (kpos_w[None, :] <= t[:, None]) & (t[:, None] - kpos_w[None, :] < WINDOW)
        s_w = jnp.einsum('bgrtd,bgkd->bgrtk', qrc, kw) * scale
        p_w = masked_softmax(s_w, m_w)
        o_w = jnp.einsum('bgrtk,bgkd->bgrtd', p_w.astype(vw.dtype), vw)

        return g[..., 0:1] * o_c + g[..., 1:2] * o_s + g[..., 2:3] * o_w

    out = lax.map(query_block, jnp.arange(s // Q_BLOCK))
    out = out.transpose(1, 2, 3, 0, 4, 5).reshape(bsz, G, R, s, dh)
    return out.transpose(0, 3, 1, 2, 4).reshape(bsz, s, NSA_WIDTH)


def causal_dwconv(x, w, b):
    k = w.shape[0]
    y = lax.conv_general_dilated(x, w[:, None, :].astype(x.dtype), window_strides=(1,), padding=[(k - 1, 0)],
                                 dimension_numbers=('NWC', 'WIO', 'NWC'), feature_group_count=x.shape[-1])
    return y + b


def ssd_scan(xs, dt, a, bm, cm):
    bsz, s = xs.shape[:2]
    L = SSD_CHUNK
    nc = s // L
    G, R, P, N = SSD_GROUPS, SSD_RPG, SSD_HEAD_DIM, SSD_STATE
    X = (xs * dt[..., None]).reshape(bsz, nc, L, G, R, P)
    A = (dt * a).reshape(bsz, nc, L, G, R).transpose(0, 3, 4, 1, 2)
    Bc = bm.reshape(bsz, nc, L, G, N)
    Cc = cm.reshape(bsz, nc, L, G, N)
    A_cs = jnp.cumsum(A, axis=-1)
    causal = jnp.tril(jnp.ones((L, L), dtype=bool))
    Lm = jnp.exp(jnp.where(causal, A_cs[..., :, None] - A_cs[..., None, :], -jnp.inf))
    CB = jnp.einsum('bclgn,bcsgn->bgcls', Cc, Bc)
    Y_diag = jnp.einsum('bgrcls,bcsgrp->bclgrp', CB[:, :, None] * Lm, X)
    decay_states = jnp.exp(A_cs[..., -1:] - A_cs)
    states = jnp.einsum('bclgn,bgrcl,bclgrp->bcgrpn', Bc, decay_states, X)
    chunk_decay = jnp.exp(A_cs[..., -1])

    def step(h, inp):
        st, d = inp
        return h * d[..., None, None] + st, h

    h0 = jnp.zeros((bsz, G, R, P, N), jnp.float32)
    _, prev = lax.scan(step, h0, (states.transpose(1, 0, 2, 3, 4, 5), chunk_decay.transpose(3, 0, 1, 2)))
    prev = prev.transpose(1, 0, 2, 3, 4, 5)
    Y_off = jnp.einsum('bclgn,bcgrpn,bgrcl->bclgrp', Cc, prev, jnp.exp(A_cs))
    return (Y_diag + Y_off).reshape(bsz, s, G, R, P)


def ssd_mixer(z, xbc, dt_raw, conv_w, conv_b, dt_bias, a_log, d_skip, norm_w):
    bsz, s, _ = z.shape
    f32 = jnp.float32
    xbc = jax.nn.silu(causal_dwconv(xbc, conv_w, conv_b)).astype(f32)
    xs, bm, cm = jnp.split(xbc, [SSD_WIDTH, SSD_WIDTH + SSD_GROUPS * SSD_STATE], axis=-1)
    xs = xs.reshape(bsz, s, SSD_GROUPS, SSD_RPG, SSD_HEAD_DIM)
    bm = bm.reshape(bsz, s, SSD_GROUPS, SSD_STATE)
    cm = cm.reshape(bsz, s, SSD_GROUPS, SSD_STATE)
    dt = jax.nn.softplus(dt_raw.astype(f32) + dt_bias.astype(f32)).reshape(bsz, s, SSD_GROUPS, SSD_RPG)
    a = -jnp.exp(a_log.astype(f32)).reshape(SSD_GROUPS, SSD_RPG)
    y = ssd_scan(xs, dt, a, bm, cm) + xs * d_skip.astype(f32).reshape(SSD_GROUPS, SSD_RPG)[:, :, None]
    y = y.reshape(bsz, s, SSD_WIDTH) * jax.nn.silu(z.astype(f32))
    return rmsnorm(y, norm_w).astype(z.dtype)


def peer_ffn(h, w_q, q_norm_w, sub_keys, expert_down, expert_up):
    bsz, s, d = h.shape
    n_tok = bsz * s
    tb = math.gcd(n_tok, PEER_TOKEN_BLOCK)
    half = PEER_QDIM // 2

    def token_block(xb):
        q = rmsnorm((xb @ w_q).reshape(tb, PEER_HEADS, PEER_QDIM), q_norm_w)
        q = q.reshape(tb, PEER_HEADS, 2, half)
        sc = jnp.einsum('thkd,hknd->thkn', q, sub_keys)
        s1, i1 = lax.top_k(sc[:, :, 0], PEER_TOPK)
        s2, i2 = lax.top_k(sc[:, :, 1], PEER_TOPK)
        cand_s = (s1[..., :, None] + s2[..., None, :]).reshape(tb, PEER_HEADS, PEER_TOPK * PEER_TOPK)
        cand_i = (i1[..., :, None] * PEER_NKEYS + i2[..., None, :]).reshape(tb, PEER_HEADS, PEER_TOPK * PEER_TOPK)
        top_s, top_pos = lax.top_k(cand_s, PEER_TOPK)
        eidx = jnp.take_along_axis(cand_i, top_pos, axis=-1)
        gate = jax.nn.softmax(top_s.astype(jnp.float32), axis=-1)
        u = expert_down[eidx]
        v = expert_up[eidx]
        act = jax.nn.gelu(jnp.einsum('td,thkd->thk', xb, u))
        return jnp.einsum('thk,thkd->td', (gate * act).astype(v.dtype), v)

    y = lax.map(token_block, h.reshape(n_tok // tb, tb, d))
    return y.reshape(bsz, s, d)


def setup_inputs(seed: int = 0) -> dict:
    key = jax.random.key(seed)
    ks = jax.random.split(key, 32)
    f32 = jnp.float32
    L = DEPTH

    def nrm(k, shape, scale):
        return jax.random.normal(k, shape, f32) * scale

    dt0 = jnp.exp(jax.random.uniform(ks[17], (L, SSD_HEADS), f32, math.log(1e-3), math.log(1e-1)))
    return {
        'x': nrm(ks[0], (BATCH, SEQ, D_MODEL), 1.0),
        'c': nrm(ks[1], (BATCH, D_MODEL), 1.0),
        'w_ada': nrm(ks[2], (L, D_MODEL, 6 * D_MODEL), 0.5 * D_MODEL ** -0.5),
        'b_ada': nrm(ks[3], (L, 6 * D_MODEL), 0.02),
        'norm1_w': 1.0 + nrm(ks[4], (L, D_MODEL), 0.02),
        'w_in': nrm(ks[5], (L, D_MODEL, IN_COLS), D_MODEL ** -0.5),
        'cmp_pe_k': nrm(ks[6], (L, CMP_BLOCK, NSA_HEAD_DIM), 0.1),
        'cmp_pe_v': nrm(ks[7], (L, CMP_BLOCK, NSA_HEAD_DIM), 0.1),
        'cmp_w1_k': nrm(ks[8], (L, CMP_BLOCK * NSA_HEAD_DIM, CMP_HIDDEN), (CMP_BLOCK * NSA_HEAD_DIM) ** -0.5),
        'cmp_w2_k': nrm(ks[9], (L, CMP_HIDDEN, NSA_HEAD_DIM), CMP_HIDDEN ** -0.5),
        'cmp_w1_v': nrm(ks[10], (L, CMP_BLOCK * NSA_HEAD_DIM, CMP_HIDDEN), (CMP_BLOCK * NSA_HEAD_DIM) ** -0.5),
        'cmp_w2_v': nrm(ks[11], (L, CMP_HIDDEN, NSA_HEAD_DIM), CMP_HIDDEN ** -0.5),
        'nsa_norm_w': 1.0 + nrm(ks[12], (L, NSA_WIDTH), 0.02),
        'conv_w': nrm(ks[13], (L, SSD_CONV, SSD_CONV_CH), SSD_CONV ** -0.5),
        'conv_b': nrm(ks[14], (L, SSD_CONV_CH), 0.02),
        'dt_bias': dt0 + jnp.log(-jnp.expm1(-dt0)),
        'a_log': jnp.log(jax.random.uniform(ks[15], (L, SSD_HEADS), f32, 1.0, 16.0)),
        'd_skip': 1.0 + nrm(ks[16], (L, SSD_HEADS), 0.02),
        'ssd_norm_w': 1.0 + nrm(ks[18], (L, SSD_WIDTH), 0.02),
        'w_out': nrm(ks[19], (L, MIX_WIDTH, D_MODEL), MIX_WIDTH ** -0.5),
        'norm2_w': 1.0 + nrm(ks[20], (L, D_MODEL), 0.02),
        'peer_wq': nrm(ks[21], (L, D_MODEL, PEER_HEADS * PEER_QDIM), D_MODEL ** -0.5),
        'peer_qnorm_w': 1.0 + nrm(ks[22], (L, PEER_QDIM), 0.02),
        'peer_sub_keys': nrm(ks[23], (L, PEER_HEADS, 2, PEER_NKEYS, PEER_QDIM // 2), (PEER_QDIM // 2) ** -0.5),
        'peer_down': nrm(ks[24], (L, PEER_EXPERTS, D_MODEL), D_MODEL ** -0.5),
        'peer_up': nrm(ks[25], (L, PEER_EXPERTS, D_MODEL), PEER_HEADS ** -0.5),
        'final_norm_w': 1.0 + nrm(ks[26], (D_MODEL,), 0.02),
    }


def reference(x, c, w_ada, b_ada, norm1_w, w_in, cmp_pe_k, cmp_pe_v, cmp_w1_k, cmp_w2_k, cmp_w1_v, cmp_w2_v,
              nsa_norm_w, conv_w, conv_b, dt_bias, a_log, d_skip, ssd_norm_w, w_out, norm2_w,
              peer_wq, peer_qnorm_w, peer_sub_keys, peer_down, peer_up, final_norm_w):
    split_at = np.cumsum(IN_SPLIT_SIZES)[:-1].tolist()
    for layer in range(DEPTH):
        mod = c @ w_ada[layer] + b_ada[layer]
        sh1, sc1, g1, sh2, sc2, g2 = jnp.split(mod, 6, axis=-1)

        h = modulate(x, norm1_w[layer], sh1, sc1)
        proj = h @ w_in[layer]
        q, kc, vc, ksel, vsel, kwin, vwin, gl, z, xbc, dtr = jnp.split(proj, split_at, axis=-1)
        o_nsa = rmsnorm(nsa_mixer(q, kc, vc, ksel, vsel, kwin, vwin, gl,
                                  cmp_pe_k[layer], cmp_pe_v[layer], cmp_w1_k[layer], cmp_w2_k[layer],
                                  cmp_w1_v[layer], cmp_w2_v[layer]), nsa_norm_w[layer])
        o_ssd = ssd_mixer(z, xbc, dtr, conv_w[layer], conv_b[layer], dt_bias[layer], a_log[layer],
                          d_skip[layer], ssd_norm_w[layer])
        mix = jnp.concatenate([o_nsa, o_ssd], axis=-1) @ w_out[layer]
        x = x + g1[:, None, :] * mix

        h2 = modulate(x, norm2_w[layer], sh2, sc2)
        x = x + g2[:, None, :] * peer_ffn(h2, peer_wq[layer], peer_qnorm_w[layer], peer_sub_keys[layer],
                                          peer_down[layer], peer_up[layer])
    return rmsnorm(x, final_norm_w)
```

```cpp
#include <hip/hip_runtime.h>
#include <stdint.h>

typedef unsigned short bf16_t;
typedef short bf16x8 __attribute__((ext_vector_type(8)));
typedef float f32x4 __attribute__((ext_vector_type(4)));
typedef unsigned u32x4 __attribute__((ext_vector_type(4)));
typedef unsigned u32x2 __attribute__((ext_vector_type(2)));

#define NB 8
#define SEQ 8192
#define NTOK 65536
#define DM 1024
#define PROJ_LD 2816
#define NIN_PAD 2944
#define C_Q 0
#define C_KCMP 512
#define C_VCMP 640
#define C_KSEL 768
#define C_VSEL 896
#define C_KWIN 1024
#define C_VWIN 1152
#define C_Z 1280
#define C_XBC 1792
#define NCMP 511
#define EPS 1e-6f

#define OFF_MOD    ((size_t)0)
#define OFF_ROPE   ((size_t)1 << 20)
#define OFF_BIAS1  ((size_t)2 << 20)
#define OFF_WIN_T  ((size_t)3 << 20)
#define OFF_WOUT_T ((size_t)9 << 20)
#define OFF_WQ_T   ((size_t)11 << 20)
#define OFF_SUBK   ((size_t)15 << 20)
#define OFF_W1K_T  ((size_t)16 << 20)
#define OFF_W1V_T  ((size_t)17 << 20)
#define OFF_KC     ((size_t)18 << 20)
#define OFF_VC     ((size_t)19 << 20)
#define OFF_HIDK   ((size_t)20 << 20)
#define OFF_HIDV   ((size_t)24 << 20)
#define OFF_DOWN   ((size_t)28 << 20)
#define OFF_UP     ((size_t)60 << 20)
#define OFF_SMALL  ((size_t)92 << 20)
#define OFF_H      ((size_t)100 << 20)
#define OFF_PROJ   ((size_t)228 << 20)
#define OFF_QROPE  ((size_t)580 << 20)
#define OFF_ONSA   ((size_t)644 << 20)
#define OFF_YSSD   ((size_t)772 << 20)
#define OFF_EIDX   ((size_t)900 << 20)
#define OFF_GATE   ((size_t)932 << 20)
#define WS_NEED    ((size_t)964 << 20)

__device__ __forceinline__ bf16_t f2bf(float f) { unsigned u = __float_as_uint(f); u += 0x7fffu + ((u >> 16) & 1u); return (bf16_t)(u >> 16); }
__device__ __forceinline__ float bf2f(bf16_t h) { return __uint_as_float(((unsigned)h) << 16); }
__device__ __forceinline__ float bflo(unsigned u) { return __uint_as_float(u << 16); }
__device__ __forceinline__ float bfhi(unsigned u) { return __uint_as_float(u & 0xffff0000u); }
__device__ __forceinline__ unsigned pack2(float a, float b) { return (unsigned)f2bf(a) | ((unsigned)f2bf(b) << 16); }
__device__ __forceinline__ float wave_sum(float v) {
#pragma unroll
    for (int o = 32; o; o >>= 1) v += __shfl_xor(v, o);
    return v;
}
__device__ __forceinline__ float wave_max(float v) {
#pragma unroll
    for (int o = 32; o; o >>= 1) v = fmaxf(v, __shfl_xor(v, o));
    return v;
}
__device__ __forceinline__ float gelu_tanh(float x) { return 0.5f * x * (1.0f + tanhf(0.7978845608028654f * (x + 0.044715f * x * x * x))); }
__device__ __forceinline__ float silu(float x) { return x / (1.0f + __expf(-x)); }
__device__ __forceinline__ float sigmoidf(float x) { return 1.0f / (1.0f + __expf(-x)); }
__device__ __forceinline__ float softplusf(float x) { return x > 20.f ? x : log1pf(__expf(x)); }

__device__ __forceinline__ int inproj_src(int n) {
    if (n < 1280) return n;
    if (n < 1792) return 1304 + (n - 1280);
    if (n < 2816) return 1816 + (n - 1792);
    if (n < 2840) return 1280 + (n - 2816);
    if (n < 2848) return 2840 + (n - 2840);
    return -1;
}
__global__ void k_transpose_w(const float* __restrict__ W, bf16_t* __restrict__ Wt, int K, int N, int mode, int pad) {
    __shared__ float t[32][33];
    const int n0 = blockIdx.x * 32, k0 = blockIdx.y * 32, tx = threadIdx.x & 31, ty = threadIdx.x >> 5;
#pragma unroll
    for (int i = 0; i < 4; ++i) {
        const int k = k0 + ty + 8 * i, n = n0 + tx;
        const int src = mode == 1 ? inproj_src(n) : n;
        t[ty + 8 * i][tx] = (src >= 0 && src < N) ? W[(size_t)k * N + src] : 0.f;
    }
    __syncthreads();
#pragma unroll
    for (int i = 0; i < 4; ++i) Wt[(size_t)(n0 + ty + 8 * i) * K + k0 + tx] = f2bf(t[tx][ty + 8 * i]);
}
__global__ void k_convert_bf16(const float* __restrict__ in, bf16_t* __restrict__ out, size_t n8) {
    size_t i = (size_t)blockIdx.x * blockDim.x + threadIdx.x;
    const size_t stride = (size_t)gridDim.x * blockDim.x;
    for (; i < n8; i += stride) {
        const f32x4 a = ((const f32x4*)in)[2 * i], b = ((const f32x4*)in)[2 * i + 1];
        u32x4 o; o.x = pack2(a.x, a.y); o.y = pack2(a.z, a.w); o.z = pack2(b.x, b.y); o.w = pack2(b.z, b.w);
        ((u32x4*)out)[i] = o;
    }
}
__global__ __launch_bounds__(256) void k_mod(const float* __restrict__ c, const float* __restrict__ w_ada, const float* __restrict__ b_ada, float* __restrict__ mod) {
    __shared__ float part[4][8][64];
    const int tid = threadIdx.x, jl = tid & 63, kq = tid >> 6, j = blockIdx.x * 64 + jl;
    float acc[8];
#pragma unroll
    for (int b = 0; b < 8; ++b) acc[b] = 0.f;
    for (int k = kq * 256; k < kq * 256 + 256; ++k) {
        const float w = w_ada[(size_t)k * 6144 + j];
#pragma unroll
        for (int b = 0; b < 8; ++b) acc[b] += c[b * 1024 + k] * w;
    }
#pragma unroll
    for (int b = 0; b < 8; ++b) part[kq][b][jl] = acc[b];
    __syncthreads();
    for (int i = tid; i < 512; i += 256) {
        const int b = i >> 6, jj = i & 63;
        mod[b * 6144 + blockIdx.x * 64 + jj] = part[0][b][jj] + part[1][b][jj] + part[2][b][jj] + part[3][b][jj] + b_ada[blockIdx.x * 64 + jj];
    }
}
__global__ void k_rope_table(float2* __restrict__ rope) {
    const int i = blockIdx.x * blockDim.x + threadIdx.x;
    if (i >= SEQ * 8) return;
    const int pos = i >> 3, f = i & 7;
    const double inv = pow(500000.0, -(double)f / 8.0);
    const double ang = (double)pos * inv;
    rope[i] = make_float2((float)cos(ang), (float)sin(ang));
}
__global__ void k_bias1(const float* __restrict__ pe_k, const float* __restrict__ w1_k, const float* __restrict__ pe_v, const float* __restrict__ w1_v, float* __restrict__ bias1) {
    const int which = blockIdx.x, j = threadIdx.x;
    const float* pe = which ? pe_v : pe_k; const float* w1 = which ? w1_v : w1_k;
    float a = 0.f;
    for (int k = 0; k < 2048; ++k) a += pe[k] * w1[(size_t)k * 256 + j];
    bias1[which * 256 + j] = a;
}

__global__ __launch_bounds__(256) void k_norm_mod(const float* __restrict__ x, const float* __restrict__ w, const float* __restrict__ mod, int sh_off, int sc_off, bf16_t* __restrict__ out) {
    __shared__ float red[4];
    const int row = blockIdx.x, tid = threadIdx.x, b = row >> 13;
    const f32x4 v = ((const f32x4*)(x + (size_t)row * DM))[tid];
    float ss = v.x * v.x + v.y * v.y + v.z * v.z + v.w * v.w;
    ss = wave_sum(ss);
    if ((tid & 63) == 0) red[tid >> 6] = ss;
    __syncthreads();
    const float r = rsqrtf((red[0] + red[1] + red[2] + red[3]) * (1.0f / DM) + EPS);
    const f32x4 wv = ((const f32x4*)w)[tid];
    const f32x4 sc = ((const f32x4*)(mod + b * 6144 + sc_off))[tid];
    const f32x4 sh = ((const f32x4*)(mod + b * 6144 + sh_off))[tid];
    u32x2 o;
    o.x = pack2(v.x * r * wv.x * (1.f + sc.x) + sh.x, v.y * r * wv.y * (1.f + sc.y) + sh.y);
    o.y = pack2(v.z * r * wv.z * (1.f + sc.z) + sh.z, v.w * r * wv.w * (1.f + sc.w) + sh.w);
    ((u32x2*)(out + (size_t)row * DM))[tid] = o;
}

#define GLD 72
struct ALoadPlain { const bf16_t* A; int lda; int pad;
    __device__ __forceinline__ const bf16_t* operator()(int row, int k) const { return A + (size_t)row * lda + k; } };
struct ALoadCmp { const bf16_t* proj; int coloff; int pad;
    __device__ __forceinline__ const bf16_t* operator()(int row, int k) const {
        if (row > NB * 2 * NCMP - 1) row = NB * 2 * NCMP - 1;
        const int bg = row / NCMP, n = row - bg * NCMP, b = bg >> 1, g = bg & 1, tok = k >> 6, d = k & 63;
        return proj + (size_t)(b * SEQ + 16 * n + tok) * PROJ_LD + coloff + g * 64 + d; } };

struct EpInProj { bf16_t* proj; bf16_t* qrope; float* small; const float2* rope; const float* dt_bias;
    __device__ __forceinline__ void operator()(int m, int n0, f32x4 v) const {
        if (n0 < 2816) {
            const bool is_q = n0 < 512;
            const bool roped_seg = is_q || (n0 >= C_KSEL && n0 < C_VSEL) || (n0 >= C_KWIN && n0 < C_VWIN);
            const bool rope_dims = roped_seg && ((n0 & 63) < 16);
            u32x2 raw; raw.x = pack2(v.x, v.y); raw.y = pack2(v.z, v.w);
            if (is_q) *(u32x2*)(proj + (size_t)m * PROJ_LD + n0) = raw;
            if (rope_dims) {
                f32x4 p; p.x = __shfl_xor(v.x, 32); p.y = __shfl_xor(v.y, 32); p.z = __shfl_xor(v.z, 32); p.w = __shfl_xor(v.w, 32);
                const int i0 = n0 & 15, pos = m & (SEQ - 1);
                const float sgn = i0 < 8 ? -1.f : 1.f;
                const float2* rp = rope + pos * 8 + (i0 & 7);
                const float2 c0 = rp[0], c1 = rp[1], c2 = rp[2], c3 = rp[3];
                v.x = v.x * c0.x + sgn * p.x * c0.y; v.y = v.y * c1.x + sgn * p.y * c1.y;
                v.z = v.z * c2.x + sgn * p.z * c2.y; v.w = v.w * c3.x + sgn * p.w * c3.y;
            }
            u32x2 o; o.x = pack2(v.x, v.y); o.y = pack2(v.z, v.w);
            if (is_q) *(u32x2*)(qrope + (size_t)m * 512 + n0) = o;
            else *(u32x2*)(proj + (size_t)m * PROJ_LD + n0) = o;
        } else if (n0 < 2848) {
            const int c = n0 - 2816; f32x4 o;
            if (c < 24) { o.x = sigmoidf(v.x); o.y = sigmoidf(v.y); o.z = sigmoidf(v.z); o.w = sigmoidf(v.w); }
            else { const float* db = dt_bias + (c - 24); o.x = softplusf(v.x + db[0]); o.y = softplusf(v.y + db[1]); o.z = softplusf(v.z + db[2]); o.w = softplusf(v.w + db[3]); }
            *(f32x4*)(small + (size_t)m * 32 + c) = o;
        }
    } };
struct EpCmpHid { bf16_t* hid; const float* bias;
    __device__ __forceinline__ void operator()(int m, int n0, f32x4 v) const {
        if (m >= NB * 2 * NCMP) return;
        const f32x4 b = *(const f32x4*)(bias + n0);
        u32x2 o; o.x = pack2(gelu_tanh(v.x + b.x), gelu_tanh(v.y + b.y)); o.y = pack2(gelu_tanh(v.z + b.z), gelu_tanh(v.w + b.w));
        *(u32x2*)(hid + (size_t)m * 256 + n0) = o;
    } };
struct EpOutProj { const float* x; const float* mod; float* x1;
    __device__ __forceinline__ void operator()(int m, int n0, f32x4 v) const {
        const int b = m >> 13;
        const f32x4 xv = *(const f32x4*)(x + (size_t)m * DM + n0);
        const f32x4 g = *(const f32x4*)(mod + b * 6144 + 2048 + n0);
        f32x4 o; o.x = xv.x + g.x * v.x; o.y = xv.y + g.y * v.y; o.z = xv.z + g.z * v.z; o.w = xv.w + g.w * v.w;
        *(f32x4*)(x1 + (size_t)m * DM + n0) = o;
    } };
struct EpStoreBf16 { bf16_t* out; int ld; int pad;
    __device__ __forceinline__ void operator()(int m, int n0, f32x4 v) const {
        u32x2 o; o.x = pack2(v.x, v.y); o.y = pack2(v.z, v.w);
        *(u32x2*)(out + (size_t)m * ld + n0) = o;
    } };

template <class AL, class EP>
__global__ __launch_bounds__(256) void k_gemm(AL al, const bf16_t* __restrict__ Bt, int K, int ntn, EP ep) {
    __shared__ __attribute__((aligned(16))) bf16_t sA[128 * GLD];
    __shared__ __attribute__((aligned(16))) bf16_t sB[128 * GLD];
    const int tid = threadIdx.x, lane = tid & 63, wid = tid >> 6, wr = wid >> 1, wc = wid & 1, fr = lane & 15, fq = lane >> 4;
    const int tile_m = blockIdx.x / ntn, tile_n = blockIdx.x - tile_m * ntn;
    const int m0 = tile_m * 128, n0 = tile_n * 128;
    const int lr = tid >> 3, lk = (tid & 7) * 8;
    f32x4 acc[4][4];
#pragma unroll
    for (int i = 0; i < 4; ++i)
#pragma unroll
        for (int j = 0; j < 4; ++j) acc[i][j] = (f32x4){0.f, 0.f, 0.f, 0.f};
    u32x4 ra[4], rb[4];
#pragma unroll
    for (int i = 0; i < 4; ++i) {
        ra[i] = *(const u32x4*)al(m0 + lr + 32 * i, lk);
        rb[i] = *(const u32x4*)(Bt + (size_t)(n0 + lr + 32 * i) * K + lk);
    }
    const int nk = K / 64;
    for (int kt = 0; kt < nk; ++kt) {
#pragma unroll
        for (int i = 0; i < 4; ++i) {
            *(u32x4*)(sA + (lr + 32 * i) * GLD + lk) = ra[i];
            *(u32x4*)(sB + (lr + 32 * i) * GLD + lk) = rb[i];
        }
        __syncthreads();
        if (kt + 1 < nk) {
            const int k0 = (kt + 1) * 64;
#pragma unroll
            for (int i = 0; i < 4; ++i) {
                ra[i] = *(const u32x4*)al(m0 + lr + 32 * i, k0 + lk);
                rb[i] = *(const u32x4*)(Bt + (size_t)(n0 + lr + 32 * i) * K + k0 + lk);
            }
        }
#pragma unroll
        for (int ks = 0; ks < 2; ++ks) {
            bf16x8 fa[4], fb[4];
#pragma unroll
            for (int i = 0; i < 4; ++i) {
                fa[i] = *(const bf16x8*)(sA + (wr * 64 + i * 16 + fr) * GLD + ks * 32 + fq * 8);
                fb[i] = *(const bf16x8*)(sB + (wc * 64 + i * 16 + fr) * GLD + ks * 32 + fq * 8);
            }
#pragma unroll
            for (int mi = 0; mi < 4; ++mi)
#pragma unroll
                for (int ni = 0; ni < 4; ++ni)
                    acc[mi][ni] = __builtin_amdgcn_mfma_f32_16x16x32_bf16(fb[ni], fa[mi], acc[mi][ni], 0, 0, 0);
        }
        __syncthreads();
    }
#pragma unroll
    for (int mi = 0; mi < 4; ++mi)
#pragma unroll
        for (int ni = 0; ni < 4; ++ni)
            ep(m0 + wr * 64 + mi * 16 + fr, n0 + wc * 64 + ni * 16 + fq * 4, acc[mi][ni]);
}

__global__ __launch_bounds__(256) void k_cmp_out(const bf16_t* __restrict__ hid, const float* __restrict__ w2, bf16_t* __restrict__ out) {
    const int m = blockIdx.x * 4 + (threadIdx.x >> 6), d = threadIdx.x & 63;
    if (m >= NB * 2 * NCMP) return;
    float a = 0.f;
    for (int j = 0; j < 256; ++j) a += bf2f(hid[(size_t)m * 256 + j]) * w2[j * 64 + d];
    const int bg = m / NCMP, n = m - bg * NCMP;
    out[((size_t)bg * 512 + n) * 64 + d] = f2bf(a);
}

struct AttnSt { float m, l; float o[8]; };
__device__ __forceinline__ float dot64(const float (&q)[64], const bf16_t* krow) {
    float s = 0.f;
#pragma unroll
    for (int c = 0; c < 8; ++c) {
        const u32x4 kv = *(const u32x4*)(krow + c * 8);
        s += q[c * 8 + 0] * bflo(kv.x) + q[c * 8 + 1] * bfhi(kv.x) + q[c * 8 + 2] * bflo(kv.y) + q[c * 8 + 3] * bfhi(kv.y)
           + q[c * 8 + 4] * bflo(kv.z) + q[c * 8 + 5] * bfhi(kv.z) + q[c * 8 + 6] * bflo(kv.w) + q[c * 8 + 7] * bfhi(kv.w);
    }
    return s;
}
__device__ __forceinline__ void pv_tile(float p, const bf16_t* vbase, size_t vstride, int lane, float (&o)[8]) {
    const int ks = lane >> 3, dc = lane & 7;
#pragma unroll
    for (int j = 0; j < 8; ++j) {
        const int kk = j * 8 + ks;
        const float pj = __shfl(p, kk);
        const u32x4 vv = *(const u32x4*)(vbase + (size_t)kk * vstride + dc * 8);
        o[0] += pj * bflo(vv.x); o[1] += pj * bfhi(vv.x); o[2] += pj * bflo(vv.y); o[3] += pj * bfhi(vv.y);
        o[4] += pj * bflo(vv.z); o[5] += pj * bfhi(vv.z); o[6] += pj * bflo(vv.w); o[7] += pj * bfhi(vv.w);
    }
}
__device__ __forceinline__ void attn_tile(const float (&q)[64], const bf16_t* krow, bool valid, const bf16_t* vbase, size_t vstride, int lane, AttnSt& st) {
    float s = valid ? dot64(q, krow) * 0.125f : -1e30f;
    const float mn = fmaxf(st.m, wave_max(s));
    const float alpha = __expf(st.m - mn);
    const float p = valid ? __expf(s - mn) : 0.f;
    st.l = st.l * alpha + wave_sum(p);
    st.m = mn;
#pragma unroll
    for (int e = 0; e < 8; ++e) st.o[e] *= alpha;
    pv_tile(p, vbase, vstride, lane, st.o);
}
__device__ __forceinline__ void load_q64(const bf16_t* qp, float (&q)[64]) {
#pragma unroll
    for (int c = 0; c < 8; ++c) {
        const u32x4 v = *(const u32x4*)(qp + c * 8);
        q[c * 8 + 0] = bflo(v.x); q[c * 8 + 1] = bfhi(v.x); q[c * 8 + 2] = bflo(v.y); q[c * 8 + 3] = bfhi(v.y);
        q[c * 8 + 4] = bflo(v.z); q[c * 8 + 5] = bfhi(v.z); q[c * 8 + 6] = bflo(v.w); q[c * 8 + 7] = bfhi(v.w);
    }
}
__device__ __forceinline__ void finish_branch(AttnSt& st, float gate, float (&tot)[8]) {
#pragma unroll
    for (int e = 0; e < 8; ++e) {
        float v = st.o[e];
        v += __shfl_xor(v, 8); v += __shfl_xor(v, 16); v += __shfl_xor(v, 32);
        tot[e] += (st.l > 0.f) ? gate * v / st.l : 0.f;
    }
}

__global__ __launch_bounds__(256) void k_nsa(const bf16_t* __restrict__ proj, const bf16_t* __restrict__ qrope, const bf16_t* __restrict__ kc, const bf16_t* __restrict__ vc,
                                             const float* __restrict__ small, float* __restrict__ onsa) {
    __shared__ float pc[4][512];
    __shared__ float linv[4];
    __shared__ float impv[128];
    __shared__ int sel[16];
    __shared__ int nsel_s;
    const int tid = threadIdx.x, lane = tid & 63, w = tid >> 6;
    const int blk = blockIdx.x, t = blk & (SEQ - 1), g = (blk >> 13) & 1, b = blk >> 14;
    const size_t tok = (size_t)b * SEQ + t;
    for (int i = tid; i < 2048; i += 256) (&pc[0][0])[i] = 0.f;
    __syncthreads();
    float q[64];
    float tot[8];
#pragma unroll
    for (int e = 0; e < 8; ++e) tot[e] = 0.f;
    const float* gt = small + tok * 32 + g * 12 + w * 3;
    const float g_c = gt[0], g_s = gt[1], g_w = gt[2];

    load_q64(proj + tok * PROJ_LD + C_Q + g * 256 + w * 64, q);
    const int nvalid = t >= 31 ? (t - 31) / 16 + 1 : 0;
    const int ntile_c = (nvalid + 63) >> 6;
    const bf16_t* kcb = kc + (size_t)(b * 2 + g) * 512 * 64;
    const bf16_t* vcb = vc + (size_t)(b * 2 + g) * 512 * 64;
    {
        float mx = -1e30f;
        for (int tl = 0; tl < ntile_c; ++tl) {
            const int n = tl * 64 + lane; const bool valid = n < nvalid;
            const float s = valid ? dot64(q, kcb + (size_t)n * 64) * 0.125f : -1e30f;
            mx = fmaxf(mx, s);
        }
        mx = wave_max(mx);
        AttnSt st; st.m = mx; st.l = 0.f;
#pragma unroll
        for (int e = 0; e < 8; ++e) st.o[e] = 0.f;
        for (int tl = 0; tl < ntile_c; ++tl) {
            const int n = tl * 64 + lane; const bool valid = n < nvalid;
            const float s = valid ? dot64(q, kcb + (size_t)n * 64) * 0.125f : -1e30f;
            const float p = valid ? __expf(s - mx) : 0.f;
            st.l += wave_sum(p);
            pc[w][n] = p;
            pv_tile(p, vcb + (size_t)tl * 64 * 64, 64, lane, st.o);
        }
        if (lane == 0) linv[w] = st.l > 0.f ? 1.0f / st.l : 0.f;
        finish_branch(st, g_c, tot);
    }
    __syncthreads();
    const int blk_t = t >> 6;
    if (tid < 128) {
        const int j = tid; float v = 0.f;
#pragma unroll
        for (int r = 0; r < 4; ++r) {
            const float a = pc[r][4 * j] + pc[r][4 * j + 1] + pc[r][4 * j + 2] + 0.5f * (pc[r][4 * j + 3] + (j > 0 ? pc[r][4 * j - 1] : 0.f));
            v += a * linv[r];
        }
        const bool forced = (j == 0) || (j == blk_t) || (j == blk_t - 1);
        impv[j] = (j <= blk_t) ? v + (forced ? 1e4f : 0.f) : -1e30f;
    }
    __syncthreads();
    if (w == 0) {
        float v0 = impv[lane], v1 = impv[lane + 64];
        int ns = 0;
        for (int it = 0; it < 16; ++it) {
            float bv; int bi;
            if (v0 >= v1) { bv = v0; bi = lane; } else { bv = v1; bi = lane + 64; }
#pragma unroll
            for (int o = 32; o; o >>= 1) {
                const float ov = __shfl_xor(bv, o); const int oi = __shfl_xor(bi, o);
                if (ov > bv || (ov == bv && oi < bi)) { bv = ov; bi = oi; }
            }
            if (bv < -1e29f) break;
            if (lane == 0) sel[it] = bi;
            ++ns;
            if (bi == lane) v0 = -3e38f;
            if (bi == lane + 64) v1 = -3e38f;
        }
        if (lane == 0) nsel_s = ns;
    }
    __syncthreads();
    load_q64(qrope + tok * 512 + g * 256 + w * 64, q);
    {
        AttnSt st; st.m = -1e30f; st.l = 0.f;
#pragma unroll
        for (int e = 0; e < 8; ++e) st.o[e] = 0.f;
        const int ns = nsel_s;
        for (int i = 0; i < ns; ++i) {
            const int j = sel[i]; const int key = j * 64 + lane; const bool valid = key <= t;
            const bf16_t* krow = proj + ((size_t)b * SEQ + key) * PROJ_LD + C_KSEL + g * 64;
            const bf16_t* vb = proj + ((size_t)b * SEQ + j * 64) * PROJ_LD + C_VSEL + g * 64;
            attn_tile(q, krow, valid, vb, PROJ_LD, lane, st);
        }
        finish_branch(st, g_s, tot);
    }
    {
        AttnSt st; st.m = -1e30f; st.l = 0.f;
#pragma unroll
        for (int e = 0; e < 8; ++e) st.o[e] = 0.f;
        const int lo = t - 511 > 0 ? t - 511 : 0;
        for (int tl = lo >> 6; tl <= blk_t; ++tl) {
            const int key = tl * 64 + lane; const bool valid = key >= lo && key <= t;
            const bf16_t* krow = proj + ((size_t)b * SEQ + key) * PROJ_LD + C_KWIN + g * 64;
            const bf16_t* vb = proj + ((size_t)b * SEQ + tl * 64) * PROJ_LD + C_VWIN + g * 64;
            attn_tile(q, krow, valid, vb, PROJ_LD, lane, st);
        }
        finish_branch(st, g_w, tot);
    }
    if (lane < 8) {
        float* op = onsa + tok * 512 + g * 256 + w * 64 + lane * 8;
        *(f32x4*)op = (f32x4){tot[0], tot[1], tot[2], tot[3]};
        *(f32x4*)(op + 4) = (f32x4){tot[4], tot[5], tot[6], tot[7]};
    }
}

__global__ __launch_bounds__(256) void k_ssd(const bf16_t* __restrict__ proj, const float* __restrict__ small, const float* __restrict__ conv_w, const float* __restrict__ conv_b,
                                             const float* __restrict__ a_log, const float* __restrict__ d_skip, float* __restrict__ yssd) {
    __shared__ float sB[16][128], sC[16][128], sdt[16], sdA[16], ypart[16][4][64];
    const int tid = threadIdx.x, p = tid & 63, nq = tid >> 6;
    const int b = blockIdx.x >> 3, hh = blockIdx.x & 7, g = hh >> 2;
    const int ch_bc = tid < 128 ? 512 + g * 128 + tid : 768 + g * 128 + (tid - 128);
    const int ch_x = hh * 64 + p;
    float wbc[4], wx[4];
#pragma unroll
    for (int k = 0; k < 4; ++k) { wbc[k] = conv_w[k * 1024 + ch_bc]; wx[k] = conv_w[k * 1024 + ch_x]; }
    const float bbc = conv_b[ch_bc], bx = conv_b[ch_x];
    const float a = -__expf(a_log[hh]), dsk = d_skip[hh];
    float hb0 = 0.f, hb1 = 0.f, hb2 = 0.f, hx0 = 0.f, hx1 = 0.f, hx2 = 0.f;
    float h[32];
#pragma unroll
    for (int k = 0; k < 32; ++k) h[k] = 0.f;
    const bf16_t* pb = proj + (size_t)b * SEQ * PROJ_LD + C_XBC;
    for (int t0 = 0; t0 < SEQ; t0 += 16) {
        float rbc[16], rx[16];
#pragma unroll
        for (int i = 0; i < 16; ++i) {
            rbc[i] = bf2f(pb[(size_t)(t0 + i) * PROJ_LD + ch_bc]);
            rx[i] = bf2f(pb[(size_t)(t0 + i) * PROJ_LD + ch_x]);
        }
        if (tid < 16) { const float dtv = small[((size_t)b * SEQ + t0 + tid) * 32 + 24 + hh]; sdt[tid] = dtv; sdA[tid] = __expf(dtv * a); }
        float xv[16];
#pragma unroll
        for (int i = 0; i < 16; ++i) {
            const float vb = bbc + wbc[0] * hb0 + wbc[1] * hb1 + wbc[2] * hb2 + wbc[3] * rbc[i];
            hb0 = hb1; hb1 = hb2; hb2 = rbc[i];
            const float sv = silu(vb);
            if (tid < 128) sB[i][tid] = sv; else sC[i][tid - 128] = sv;
            const float vx = bx + wx[0] * hx0 + wx[1] * hx1 + wx[2] * hx2 + wx[3] * rx[i];
            hx0 = hx1; hx1 = hx2; hx2 = rx[i];
            xv[i] = silu(vx);
        }
        __syncthreads();
#pragma unroll
        for (int i = 0; i < 16; ++i) {
            const float dtv = sdt[i], dA = sdA[i], xdt = xv[i] * dtv;
            float yp = 0.f;
#pragma unroll
            for (int k4 = 0; k4 < 8; ++k4) {
                const f32x4 bv = *(const f32x4*)&sB[i][nq * 32 + k4 * 4];
                const f32x4 cv = *(const f32x4*)&sC[i][nq * 32 + k4 * 4];
                h[k4 * 4 + 0] = h[k4 * 4 + 0] * dA + xdt * bv.x; yp += cv.x * h[k4 * 4 + 0];
                h[k4 * 4 + 1] = h[k4 * 4 + 1] * dA + xdt * bv.y; yp += cv.y * h[k4 * 4 + 1];
                h[k4 * 4 + 2] = h[k4 * 4 + 2] * dA + xdt * bv.z; yp += cv.z * h[k4 * 4 + 2];
                h[k4 * 4 + 3] = h[k4 * 4 + 3] * dA + xdt * bv.w; yp += cv.w * h[k4 * 4 + 3];
            }
            if (nq == 0) yp += xv[i] * dsk;
            ypart[i][nq][p] = yp;
        }
        __syncthreads();
#pragma unroll
        for (int k2 = 0; k2 < 4; ++k2) {
            const int i = nq + 4 * k2;
            yssd[((size_t)b * SEQ + t0 + i) * 512 + hh * 64 + p] = ypart[i][0][p] + ypart[i][1][p] + ypart[i][2][p] + ypart[i][3][p];
        }
        __syncthreads();
    }
}

__global__ __launch_bounds__(256) void k_mix_prep(const float* __restrict__ onsa, const float* __restrict__ yssd, const bf16_t* __restrict__ proj,
                                                  const float* __restrict__ nsa_w, const float* __restrict__ ssd_w, bf16_t* __restrict__ A2) {
    __shared__ float red[2][4];
    const int tid = threadIdx.x; const size_t tok = blockIdx.x;
    const float o0 = onsa[tok * 512 + tid * 2], o1 = onsa[tok * 512 + tid * 2 + 1];
    const unsigned zz = *(const unsigned*)(proj + tok * PROJ_LD + C_Z + tid * 2);
    const float y0 = yssd[tok * 512 + tid * 2] * silu(bflo(zz)), y1 = yssd[tok * 512 + tid * 2 + 1] * silu(bfhi(zz));
    float s0 = wave_sum(o0 * o0 + o1 * o1), s1 = wave_sum(y0 * y0 + y1 * y1);
    if ((tid & 63) == 0) { red[0][tid >> 6] = s0; red[1][tid >> 6] = s1; }
    __syncthreads();
    const float r0 = rsqrtf((red[0][0] + red[0][1] + red[0][2] + red[0][3]) * (1.0f / 512) + EPS);
    const float r1 = rsqrtf((red[1][0] + red[1][1] + red[1][2] + red[1][3]) * (1.0f / 512) + EPS);
    *(unsigned*)(A2 + tok * DM + tid * 2) = pack2(o0 * r0 * nsa_w[tid * 2], o1 * r0 * nsa_w[tid * 2 + 1]);
    *(unsigned*)(A2 + tok * DM + 512 + tid * 2) = pack2(y0 * r1 * ssd_w[tid * 2], y1 * r1 * ssd_w[tid * 2 + 1]);
}

__device__ __forceinline__ void argmax_bfly(float& bv, int& bi) {
#pragma unroll
    for (int o = 32; o; o >>= 1) {
        const float ov = __shfl_xor(bv, o); const int oi = __shfl_xor(bi, o);
        if (ov > bv || (ov == bv && oi < bi)) { bv = ov; bi = oi; }
    }
}
__global__ __launch_bounds__(256) void k_peer_topk(const bf16_t* __restrict__ qp, const float* __restrict__ qnw, const bf16_t* __restrict__ subk, int* __restrict__ eidx, float* __restrict__ gate) {
    __shared__ __attribute__((aligned(16))) float sq[4][256];
    const int tid = threadIdx.x, lane = tid & 63, wid = tid >> 6;
    const int gw = blockIdx.x * 4 + wid; const size_t tok = gw >> 3; const int h = gw & 7;
    {
        const u32x2 v = *(const u32x2*)(qp + tok * 2048 + h * 256 + lane * 4);
        const float a0 = bflo(v.x), a1 = bfhi(v.x), a2 = bflo(v.y), a3 = bfhi(v.y);
        const float ss = wave_sum(a0 * a0 + a1 * a1 + a2 * a2 + a3 * a3);
        const float r = rsqrtf(ss * (1.0f / 256) + EPS);
        const f32x4 wv = *(const f32x4*)(qnw + lane * 4);
        *(f32x4*)&sq[wid][lane * 4] = (f32x4){a0 * r * wv.x, a1 * r * wv.y, a2 * r * wv.z, a3 * r * wv.w};
    }
    __syncthreads();
    float sc[2][2];
#pragma unroll
    for (int k = 0; k < 2; ++k)
#pragma unroll
        for (int hf = 0; hf < 2; ++hf) {
            const int n = lane + 64 * hf;
            const bf16_t* kr = subk + ((size_t)(h * 2 + k) * 128 + n) * 128;
            float s = 0.f;
#pragma unroll
            for (int c = 0; c < 16; ++c) {
                const u32x4 kv = *(const u32x4*)(kr + c * 8);
                const f32x4 q0 = *(const f32x4*)&sq[wid][k * 128 + c * 8], q1 = *(const f32x4*)&sq[wid][k * 128 + c * 8 + 4];
                s += q0.x * bflo(kv.x) + q0.y * bfhi(kv.x) + q0.z * bflo(kv.y) + q0.w * bfhi(kv.y)
                   + q1.x * bflo(kv.z) + q1.y * bfhi(kv.z) + q1.z * bflo(kv.w) + q1.w * bfhi(kv.w);
            }
            sc[k][hf] = s;
        }
    float s1v = 0.f, s2v = 0.f; int i1v = 0, i2v = 0;
#pragma unroll
    for (int k = 0; k < 2; ++k) {
        float v0 = sc[k][0], v1 = sc[k][1];
        for (int it = 0; it < 16; ++it) {
            float bv; int bi;
            if (v0 >= v1) { bv = v0; bi = lane; } else { bv = v1; bi = lane + 64; }
            argmax_bfly(bv, bi);
            if (lane == it) { if (k == 0) { s1v = bv; i1v = bi; } else { s2v = bv; i2v = bi; } }
            if (bi == lane) v0 = -3e38f;
            if (bi == lane + 64) v1 = -3e38f;
        }
    }
    float cs[4]; int ci[4];
#pragma unroll
    for (int e = 0; e < 4; ++e) {
        const int a = lane >> 2, bb = (lane & 3) * 4 + e;
        cs[e] = __shfl(s1v, a) + __shfl(s2v, bb);
        ci[e] = __shfl(i1v, a) * 128 + __shfl(i2v, bb);
    }
    float tsv = -3e38f; int tev = 0;
    for (int it = 0; it < 16; ++it) {
        float bv = cs[0]; int bc = lane * 4;
#pragma unroll
        for (int e = 1; e < 4; ++e) if (cs[e] > bv) { bv = cs[e]; bc = lane * 4 + e; }
        argmax_bfly(bv, bc);
        const int owner = bc >> 2, oe = bc & 3;
        int ev = 0;
#pragma unroll
        for (int e = 0; e < 4; ++e) if (oe == e) ev = ci[e];
        ev = __shfl(ev, owner);
        if (lane == it) { tsv = bv; tev = ev; }
        if (lane == owner) {
#pragma unroll
            for (int e = 0; e < 4; ++e) if (oe == e) cs[e] = -3e38f;
        }
    }
    const float mx = wave_max(tsv);
    const float pe = lane < 16 ? __expf(tsv - mx) : 0.f;
    const float sum = wave_sum(pe);
    if (lane < 16) {
        eidx[(tok * 8 + h) * 16 + lane] = tev;
        gate[(tok * 8 + h) * 16 + lane] = pe / sum;
    }
}

__global__ __launch_bounds__(256) void k_peer_expert(const bf16_t* __restrict__ h2, const bf16_t* __restrict__ down, const bf16_t* __restrict__ up, const int* __restrict__ eidx,
                                                     const float* __restrict__ gate, const float* __restrict__ mod, const float* __restrict__ fw, float* __restrict__ out) {
    const int tid = threadIdx.x, lane = tid & 63, wid = tid >> 6;
    const size_t tok = (size_t)blockIdx.x * 4 + wid; const int b = (int)(tok >> 13);
    float hx[16], acc[16];
    {
        const u32x4 v0 = *(const u32x4*)(h2 + tok * DM + lane * 8), v1 = *(const u32x4*)(h2 + tok * DM + 512 + lane * 8);
        hx[0] = bflo(v0.x); hx[1] = bfhi(v0.x); hx[2] = bflo(v0.y); hx[3] = bfhi(v0.y); hx[4] = bflo(v0.z); hx[5] = bfhi(v0.z); hx[6] = bflo(v0.w); hx[7] = bfhi(v0.w);
        hx[8] = bflo(v1.x); hx[9] = bfhi(v1.x); hx[10] = bflo(v1.y); hx[11] = bfhi(v1.y); hx[12] = bflo(v1.z); hx[13] = bfhi(v1.z); hx[14] = bflo(v1.w); hx[15] = bfhi(v1.w);
    }
#pragma unroll
    for (int e = 0; e < 16; ++e) acc[e] = 0.f;
    const int* ep = eidx + tok * 128; const float* gp = gate + tok * 128;
    for (int j0 = 0; j0 < 128; j0 += 4) {
        u32x4 d0[4], d1[4], u0[4], u1[4]; float gt[4];
#pragma unroll
        for (int jj = 0; jj < 4; ++jj) {
            const int e = __builtin_amdgcn_readfirstlane(ep[j0 + jj]);
            gt[jj] = gp[j0 + jj];
            const bf16_t* dr = down + (size_t)e * DM; const bf16_t* ur = up + (size_t)e * DM;
            d0[jj] = *(const u32x4*)(dr + lane * 8); d1[jj] = *(const u32x4*)(dr + 512 + lane * 8);
            u0[jj] = *(const u32x4*)(ur + lane * 8); u1[jj] = *(const u32x4*)(ur + 512 + lane * 8);
        }
#pragma unroll
        for (int jj = 0; jj < 4; ++jj) {
            float s = hx[0] * bflo(d0[jj].x) + hx[1] * bfhi(d0[jj].x) + hx[2] * bflo(d0[jj].y) + hx[3] * bfhi(d0[jj].y)
                    + hx[4] * bflo(d0[jj].z) + hx[5] * bfhi(d0[jj].z) + hx[6] * bflo(d0[jj].w) + hx[7] * bfhi(d0[jj].w)
                    + hx[8] * bflo(d1[jj].x) + hx[9] * bfhi(d1[jj].x) + hx[10] * bflo(d1[jj].y) + hx[11] * bfhi(d1[jj].y)
                    + hx[12] * bflo(d1[jj].z) + hx[13] * bfhi(d1[jj].z) + hx[14] * bflo(d1[jj].w) + hx[15] * bfhi(d1[jj].w);
            s = wave_sum(s);
            const float a = gelu_tanh(s) * gt[jj];
            acc[0] += a * bflo(u0[jj].x); acc[1] += a * bfhi(u0[jj].x); acc[2] += a * bflo(u0[jj].y); acc[3] += a * bfhi(u0[jj].y);
            acc[4] += a * bflo(u0[jj].z); acc[5] += a * bfhi(u0[jj].z); acc[6] += a * bflo(u0[jj].w); acc[7] += a * bfhi(u0[jj].w);
            acc[8] += a * bflo(u1[jj].x); acc[9] += a * bfhi(u1[jj].x); acc[10] += a * bflo(u1[jj].y); acc[11] += a * bfhi(u1[jj].y);
            acc[12] += a * bflo(u1[jj].z); acc[13] += a * bfhi(u1[jj].z); acc[14] += a * bflo(u1[jj].w); acc[15] += a * bfhi(u1[jj].w);
        }
    }
    float x2[16]; float ss = 0.f;
#pragma unroll
    for (int hf = 0; hf < 2; ++hf)
#pragma unroll
        for (int q4 = 0; q4 < 2; ++q4) {
            const int col = hf * 512 + lane * 8 + q4 * 4;
            const f32x4 xv = *(const f32x4*)(out + tok * DM + col);
            const f32x4 g2 = *(const f32x4*)(mod + b * 6144 + 5120 + col);
            const int e0 = hf * 8 + q4 * 4;
            x2[e0 + 0] = xv.x + g2.x * acc[e0 + 0]; x2[e0 + 1] = xv.y + g2.y * acc[e0 + 1]; x2[e0 + 2] = xv.z + g2.z * acc[e0 + 2]; x2[e0 + 3] = xv.w + g2.w * acc[e0 + 3];
            ss += x2[e0] * x2[e0] + x2[e0 + 1] * x2[e0 + 1] + x2[e0 + 2] * x2[e0 + 2] + x2[e0 + 3] * x2[e0 + 3];
        }
    ss = wave_sum(ss);
    const float r = rsqrtf(ss * (1.0f / DM) + EPS);
#pragma unroll
    for (int hf = 0; hf < 2; ++hf)
#pragma unroll
        for (int q4 = 0; q4 < 2; ++q4) {
            const int col = hf * 512 + lane * 8 + q4 * 4;
            const f32x4 w = *(const f32x4*)(fw + col);
            const int e0 = hf * 8 + q4 * 4;
            *(f32x4*)(out + tok * DM + col) = (f32x4){x2[e0] * r * w.x, x2[e0 + 1] * r * w.y, x2[e0 + 2] * r * w.z, x2[e0 + 3] * r * w.w};
        }
}

extern "C" void kernel_launch(void* const* d_in, const int* in_sizes, int n_in, void* d_out, int out_size, void* d_ws, size_t ws_size, hipStream_t stream) {
    if (ws_size < WS_NEED) return;
    const float* x = (const float*)d_in[0];
    const float* c = (const float*)d_in[1];
    const float* w_ada = (const float*)d_in[2];
    const float* b_ada = (const float*)d_in[3];
    const float* norm1_w = (const float*)d_in[4];
    const float* w_in = (const float*)d_in[5];
    const float* cmp_pe_k = (const float*)d_in[6];
    const float* cmp_pe_v = (const float*)d_in[7];
    const float* cmp_w1_k = (const float*)d_in[8];
    const float* cmp_w2_k = (const float*)d_in[9];
    const float* cmp_w1_v = (const float*)d_in[10];
    const float* cmp_w2_v = (const float*)d_in[11];
    const float* nsa_norm_w = (const float*)d_in[12];
    const float* conv_w = (const float*)d_in[13];
    const float* conv_b = (const float*)d_in[14];
    const float* dt_bias = (const float*)d_in[15];
    const float* a_log = (const float*)d_in[16];
    const float* d_skip = (const float*)d_in[17];
    const float* ssd_norm_w = (const float*)d_in[18];
    const float* w_out = (const float*)d_in[19];
    const float* norm2_w = (const float*)d_in[20];
    const float* peer_wq = (const float*)d_in[21];
    const float* peer_qnorm_w = (const float*)d_in[22];
    const float* peer_sub_keys = (const float*)d_in[23];
    const float* peer_down = (const float*)d_in[24];
    const float* peer_up = (const float*)d_in[25];
    const float* final_norm_w = (const float*)d_in[26];
    float* out = (float*)d_out;
    char* ws = (char*)d_ws;
    float* mod = (float*)(ws + OFF_MOD);
    float2* rope = (float2*)(ws + OFF_ROPE);
    float* bias1 = (float*)(ws + OFF_BIAS1);
    bf16_t* win_t = (bf16_t*)(ws + OFF_WIN_T);
    bf16_t* wout_t = (bf16_t*)(ws + OFF_WOUT_T);
    bf16_t* wq_t = (bf16_t*)(ws + OFF_WQ_T);
    bf16_t* subk = (bf16_t*)(ws + OFF_SUBK);
    bf16_t* w1k_t = (bf16_t*)(ws + OFF_W1K_T);
    bf16_t* w1v_t = (bf16_t*)(ws + OFF_W1V_T);
    bf16_t* kc = (bf16_t*)(ws + OFF_KC);
    bf16_t* vc = (bf16_t*)(ws + OFF_VC);
    bf16_t* hidk = (bf16_t*)(ws + OFF_HIDK);
    bf16_t* hidv = (bf16_t*)(ws + OFF_HIDV);
    bf16_t* down = (bf16_t*)(ws + OFF_DOWN);
    bf16_t* up = (bf16_t*)(ws + OFF_UP);
    float* small = (float*)(ws + OFF_SMALL);
    bf16_t* hbuf = (bf16_t*)(ws + OFF_H);
    bf16_t* proj = (bf16_t*)(ws + OFF_PROJ);
    bf16_t* qrope = (bf16_t*)(ws + OFF_QROPE);
    float* onsa = (float*)(ws + OFF_ONSA);
    float* yssd = (float*)(ws + OFF_YSSD);
    int* eidx = (int*)(ws + OFF_EIDX);
    float* gate = (float*)(ws + OFF_GATE);

    k_transpose_w<<<dim3(NIN_PAD / 32, 1024 / 32), 256, 0, stream>>>(w_in, win_t, 1024, 2848, 1, 0);
    k_transpose_w<<<dim3(1024 / 32, 1024 / 32), 256, 0, stream>>>(w_out, wout_t, 1024, 1024, 0, 0);
    k_transpose_w<<<dim3(2048 / 32, 1024 / 32), 256, 0, stream>>>(peer_wq, wq_t, 1024, 2048, 0, 0);
    k_transpose_w<<<dim3(256 / 32, 2048 / 32), 256, 0, stream>>>(cmp_w1_k, w1k_t, 2048, 256, 0, 0);
    k_transpose_w<<<dim3(256 / 32, 2048 / 32), 256, 0, stream>>>(cmp_w1_v, w1v_t, 2048, 256, 0, 0);
    k_convert_bf16<<<2048, 256, 0, stream>>>(peer_down, down, (size_t)16384 * 1024 / 8);
    k_convert_bf16<<<2048, 256, 0, stream>>>(peer_up, up, (size_t)16384 * 1024 / 8);
    k_convert_bf16<<<128, 256, 0, stream>>>(peer_sub_keys, subk, (size_t)8 * 2 * 128 * 128 / 8);
    k_mod<<<96, 256, 0, stream>>>(c, w_ada, b_ada, mod);
    k_rope_table<<<SEQ * 8 / 256, 256, 0, stream>>>(rope);
    k_bias1<<<2, 256, 0, stream>>>(cmp_pe_k, cmp_w1_k, cmp_pe_v, cmp_w1_v, bias1);
    k_norm_mod<<<NTOK, 256, 0, stream>>>(x, norm1_w, mod, 0, 1024, hbuf);
    {
        ALoadPlain al{hbuf, DM, 0}; EpInProj ep{proj, qrope, small, rope, dt_bias};
        k_gemm<<<(NTOK / 128) * (NIN_PAD / 128), 256, 0, stream>>>(al, win_t, 1024, NIN_PAD / 128, ep);
    }
    {
        ALoadCmp alk{proj, C_KCMP, 0}; EpCmpHid epk{hidk, bias1};
        k_gemm<<<64 * 2, 256, 0, stream>>>(alk, w1k_t, 2048, 2, epk);
        ALoadCmp alv{proj, C_VCMP, 0}; EpCmpHid epv{hidv, bias1 + 256};
        k_gemm<<<64 * 2, 256, 0, stream>>>(alv, w1v_t, 2048, 2, epv);
        k_cmp_out<<<(NB * 2 * NCMP + 3) / 4, 256, 0, stream>>>(hidk, cmp_w2_k, kc);
        k_cmp_out<<<(NB * 2 * NCMP + 3) / 4, 256, 0, stream>>>(hidv, cmp_w2_v, vc);
    }
    k_nsa<<<NB * 2 * SEQ, 256, 0, stream>>>(proj, qrope, kc, vc, small, onsa);
    k_ssd<<<NB * 8, 256, 0, stream>>>(proj, small, conv_w, conv_b, a_log, d_skip, yssd);
    k_mix_prep<<<NTOK, 256, 0, stream>>>(onsa, yssd, proj, nsa_norm_w, ssd_norm_w, hbuf);
    {
        ALoadPlain al{hbuf, DM, 0}; EpOutProj ep{x, mod, out};
        k_gemm<<<(NTOK / 128) * 8, 256, 0, stream>>>(al, wout_t, 1024, 8, ep);
    }
    k_norm_mod<<<NTOK, 256, 0, stream>>>(out, norm2_w, mod, 3072, 4096, hbuf);
    {
        ALoadPlain al{hbuf, DM, 0}; EpStoreBf16 ep{proj, 2048, 0};
        k_gemm<<<(NTOK / 128) * 16, 256, 0, stream>>>(al, wq_t, 1024, 16, ep);
    }
    k_peer_topk<<<NTOK * 8 / 4, 256, 0, stream>>>(proj, peer_qnorm_w, subk, eidx, gate);
    k_peer_expert<<<NTOK / 4, 256, 0, stream>>>(hbuf, down, up, eidx, gate, mod, final_norm_w, out);
}
```

```cpp
#include <hip/hip_runtime.h>
#include <hip/hip_cooperative_groups.h>
#include <stdint.h>
#include <cstdio>
namespace cg = cooperative_groups;

typedef unsigned short bf16_t;
typedef short bf16x8 __attribute__((ext_vector_type(8)));
typedef float f32x4 __attribute__((ext_vector_type(4)));
typedef unsigned u32x4 __attribute__((ext_vector_type(4)));
typedef unsigned u32x2 __attribute__((ext_vector_type(2)));

#define NB 8
#define SEQ 8192
#define NTOK 65536
#define DM 1024
#define PROJ_LD 2816
#define NIN_PAD 2944
#define C_Q 0
#define C_KCMP 512
#define C_VCMP 640
#define C_KSEL 768
#define C_VSEL 896
#define C_KWIN 1024
#define C_VWIN 1152
#define C_Z 1280
#define C_XBC 1792
#define NCMP 511
#define EPS 1e-6f

#define OFF_MOD    ((size_t)0)
#define OFF_ROPE   ((size_t)1 << 20)
#define OFF_BIAS1  ((size_t)2 << 20)
#define OFF_WIN_T  ((size_t)3 << 20)
#define OFF_WOUT_T ((size_t)9 << 20)
#define OFF_WQ_T   ((size_t)11 << 20)
#define OFF_SUBK   ((size_t)15 << 20)
#define OFF_W1K_T  ((size_t)16 << 20)
#define OFF_W1V_T  ((size_t)17 << 20)
#define OFF_KC     ((size_t)18 << 20)
#define OFF_VC     ((size_t)19 << 20)
#define OFF_HIDK   ((size_t)20 << 20)
#define OFF_HIDV   ((size_t)24 << 20)
#define OFF_DOWN   ((size_t)28 << 20)
#define OFF_UP     ((size_t)60 << 20)
#define OFF_SMALL  ((size_t)92 << 20)
#define OFF_H      ((size_t)100 << 20)
#define OFF_PROJ   ((size_t)228 << 20)
#define OFF_QROPE  ((size_t)580 << 20)
#define OFF_ONSA   ((size_t)644 << 20)
#define OFF_YSSD   ((size_t)772 << 20)
#define OFF_EIDX   ((size_t)900 << 20)
#define OFF_GATE   ((size_t)932 << 20)
#define OFF_CTR    ((size_t)964 << 20)
#define WS_NEED    ((size_t)965 << 20)

__device__ __forceinline__ bf16_t f2bf(float f) { unsigned u = __float_as_uint(f); u += 0x7fffu + ((u >> 16) & 1u); return (bf16_t)(u >> 16); }
__device__ __forceinline__ float bf2f(bf16_t h) { return __uint_as_float(((unsigned)h) << 16); }
__device__ __forceinline__ float bflo(unsigned u) { return __uint_as_float(u << 16); }
__device__ __forceinline__ float bfhi(unsigned u) { return __uint_as_float(u & 0xffff0000u); }
__device__ __forceinline__ unsigned pack2(float a, float b) { return (unsigned)f2bf(a) | ((unsigned)f2bf(b) << 16); }
__device__ __forceinline__ float wave_sum(float v) {
#pragma unroll
    for (int o = 32; o; o >>= 1) v += __shfl_xor(v, o);
    return v;
}
__device__ __forceinline__ float wave_max(float v) {
#pragma unroll
    for (int o = 32; o; o >>= 1) v = fmaxf(v, __shfl_xor(v, o));
    return v;
}
__device__ __forceinline__ float gelu_tanh(float x) { return 0.5f * x * (1.0f + tanhf(0.7978845608028654f * (x + 0.044715f * x * x * x))); }
__device__ __forceinline__ float silu(float x) { return x / (1.0f + __expf(-x)); }
__device__ __forceinline__ float sigmoidf(float x) { return 1.0f / (1.0f + __expf(-x)); }
__device__ __forceinline__ float softplusf(float x) { return x > 20.f ? x : log1pf(__expf(x)); }

__device__ __forceinline__ int inproj_src(int n) {
    if (n < 1280) return n;
    if (n < 1792) return 1304 + (n - 1280);
    if (n < 2816) return 1816 + (n - 1792);
    if (n < 2840) return 1280 + (n - 2816);
    if (n < 2848) return 2840 + (n - 2840);
    return -1;
}
__device__ __forceinline__ void d_transpose_w(const float* __restrict__ W, bf16_t* __restrict__ Wt, int K, int N, int mode, int bx, int by, char* lds) {
    float (*t)[33] = (float (*)[33])lds;
    const int n0 = bx * 32, k0 = by * 32, tx = threadIdx.x & 31, ty = threadIdx.x >> 5;
#pragma unroll
    for (int i = 0; i < 4; ++i) {
        const int k = k0 + ty + 8 * i, n = n0 + tx;
        const int src = mode == 1 ? inproj_src(n) : n;
        t[ty + 8 * i][tx] = (src >= 0 && src < N) ? W[(size_t)k * N + src] : 0.f;
    }
    __syncthreads();
#pragma unroll
    for (int i = 0; i < 4; ++i) Wt[(size_t)(n0 + ty + 8 * i) * K + k0 + tx] = f2bf(t[tx][ty + 8 * i]);
}
__device__ __forceinline__ void d_convert_bf16(const float* __restrict__ in, bf16_t* __restrict__ out, size_t n8, int vb, int nvb) {
    size_t i = (size_t)vb * 256 + threadIdx.x;
    const size_t stride = (size_t)nvb * 256;
    for (; i < n8; i += stride) {
        const f32x4 a = ((const f32x4*)in)[2 * i], b = ((const f32x4*)in)[2 * i + 1];
        u32x4 o; o.x = pack2(a.x, a.y); o.y = pack2(a.z, a.w); o.z = pack2(b.x, b.y); o.w = pack2(b.z, b.w);
        ((u32x4*)out)[i] = o;
    }
}
__device__ __forceinline__ void d_mod(const float* __restrict__ c, const float* __restrict__ w_ada, const float* __restrict__ b_ada, float* __restrict__ mod, int vb, char* lds) {
    float (*part)[8][64] = (float (*)[8][64])lds;
    const int tid = threadIdx.x, jl = tid & 63, kq = tid >> 6, j = vb * 64 + jl;
    float acc[8];
#pragma unroll
    for (int b = 0; b < 8; ++b) acc[b] = 0.f;
    for (int k = kq * 256; k < kq * 256 + 256; ++k) {
        const float w = w_ada[(size_t)k * 6144 + j];
#pragma unroll
        for (int b = 0; b < 8; ++b) acc[b] += c[b * 1024 + k] * w;
    }
#pragma unroll
    for (int b = 0; b < 8; ++b) part[kq][b][jl] = acc[b];
    __syncthreads();
    for (int i = tid; i < 512; i += 256) {
        const int b = i >> 6, jj = i & 63;
        mod[b * 6144 + vb * 64 + jj] = part[0][b][jj] + part[1][b][jj] + part[2][b][jj] + part[3][b][jj] + b_ada[vb * 64 + jj];
    }
}
__device__ __forceinline__ void d_rope_table(float2* __restrict__ rope, int vb) {
    const int i = vb * 256 + threadIdx.x;
    if (i >= SEQ * 8) return;
    const int pos = i >> 3, f = i & 7;
    const double inv = pow(500000.0, -(double)f / 8.0);
    const double ang = (double)pos * inv;
    rope[i] = make_float2((float)cos(ang), (float)sin(ang));
}
__device__ __forceinline__ void d_bias1(const float* __restrict__ pe_k, const float* __restrict__ w1_k, const float* __restrict__ pe_v, const float* __restrict__ w1_v, float* __restrict__ bias1, int vb) {
    const int which = vb, j = threadIdx.x;
    const float* pe = which ? pe_v : pe_k; const float* w1 = which ? w1_v : w1_k;
    float a = 0.f;
    for (int k = 0; k < 2048; ++k) a += pe[k] * w1[(size_t)k * 256 + j];
    bias1[which * 256 + j] = a;
}

__device__ __forceinline__ void d_norm_mod(const float* __restrict__ x, const float* __restrict__ w, const float* __restrict__ mod, int sh_off, int sc_off, bf16_t* __restrict__ out, int vb, char* lds) {
    float* red = (float*)lds;
    const int row = vb, tid = threadIdx.x, b = row >> 13;
    const f32x4 v = ((const f32x4*)(x + (size_t)row * DM))[tid];
    float ss = v.x * v.x + v.y * v.y + v.z * v.z + v.w * v.w;
    ss = wave_sum(ss);
    if ((tid & 63) == 0) red[tid >> 6] = ss;
    __syncthreads();
    const float r = rsqrtf((red[0] + red[1] + red[2] + red[3]) * (1.0f / DM) + EPS);
    const f32x4 wv = ((const f32x4*)w)[tid];
    const f32x4 sc = ((const f32x4*)(mod + b * 6144 + sc_off))[tid];
    const f32x4 sh = ((const f32x4*)(mod + b * 6144 + sh_off))[tid];
    u32x2 o;
    o.x = pack2(v.x * r * wv.x * (1.f + sc.x) + sh.x, v.y * r * wv.y * (1.f + sc.y) + sh.y);
    o.y = pack2(v.z * r * wv.z * (1.f + sc.z) + sh.z, v.w * r * wv.w * (1.f + sc.w) + sh.w);
    ((u32x2*)(out + (size_t)row * DM))[tid] = o;
}

#define GLD 72
struct ALoadPlain { const bf16_t* A; int lda; int pad;
    __device__ __forceinline__ const bf16_t* operator()(int row, int k) const { return A + (size_t)row * lda + k; } };
struct ALoadCmp { const bf16_t* proj; int coloff; int pad;
    __device__ __forceinline__ const bf16_t* operator()(int row, int k) const {
        if (row > NB * 2 * NCMP - 1) row = NB * 2 * NCMP - 1;
        const int bg = row / NCMP, n = row - bg * NCMP, b = bg >> 1, g = bg & 1, tok = k >> 6, d = k & 63;
        return proj + (size_t)(b * SEQ + 16 * n + tok) * PROJ_LD + coloff + g * 64 + d; } };

struct EpInProj { bf16_t* proj; bf16_t* qrope; float* small; const float2* rope; const float* dt_bias;
    __device__ __forceinline__ void operator()(int m, int n0, f32x4 v) const {
        if (n0 < 2816) {
            const bool is_q = n0 < 512;
            const bool roped_seg = is_q || (n0 >= C_KSEL && n0 < C_VSEL) || (n0 >= C_KWIN && n0 < C_VWIN);
            const bool rope_dims = roped_seg && ((n0 & 63) < 16);
            u32x2 raw; raw.x = pack2(v.x, v.y); raw.y = pack2(v.z, v.w);
            if (is_q) *(u32x2*)(proj + (size_t)m * PROJ_LD + n0) = raw;
            if (rope_dims) {
                f32x4 p; p.x = __shfl_xor(v.x, 32); p.y = __shfl_xor(v.y, 32); p.z = __shfl_xor(v.z, 32); p.w = __shfl_xor(v.w, 32);
                const int i0 = n0 & 15, pos = m & (SEQ - 1);
                const float sgn = i0 < 8 ? -1.f : 1.f;
                const float2* rp = rope + pos * 8 + (i0 & 7);
                const float2 c0 = rp[0], c1 = rp[1], c2 = rp[2], c3 = rp[3];
                v.x = v.x * c0.x + sgn * p.x * c0.y; v.y = v.y * c1.x + sgn * p.y * c1.y;
                v.z = v.z * c2.x + sgn * p.z * c2.y; v.w = v.w * c3.x + sgn * p.w * c3.y;
            }
            u32x2 o; o.x = pack2(v.x, v.y); o.y = pack2(v.z, v.w);
            if (is_q) *(u32x2*)(qrope + (size_t)m * 512 + n0) = o;
            else *(u32x2*)(proj + (size_t)m * PROJ_LD + n0) = o;
        } else if (n0 < 2848) {
            const int c = n0 - 2816; f32x4 o;
            if (c < 24) { o.x = sigmoidf(v.x); o.y = sigmoidf(v.y); o.z = sigmoidf(v.z); o.w = sigmoidf(v.w); }
            else { const float* db = dt_bias + (c - 24); o.x = softplusf(v.x + db[0]); o.y = softplusf(v.y + db[1]); o.z = softplusf(v.z + db[2]); o.w = softplusf(v.w + db[3]); }
            *(f32x4*)(small + (size_t)m * 32 + c) = o;
        }
    } };
struct EpCmpHid { bf16_t* hid; const float* bias;
    __device__ __forceinline__ void operator()(int m, int n0, f32x4 v) const {
        if (m >= NB * 2 * NCMP) return;
        const f32x4 b = *(const f32x4*)(bias + n0);
        u32x2 o; o.x = pack2(gelu_tanh(v.x + b.x), gelu_tanh(v.y + b.y)); o.y = pack2(gelu_tanh(v.z + b.z), gelu_tanh(v.w + b.w));
        *(u32x2*)(hid + (size_t)m * 256 + n0) = o;
    } };
struct EpOutProj { const float* x; const float* mod; float* x1;
    __device__ __forceinline__ void operator()(int m, int n0, f32x4 v) const {
        const int b = m >> 13;
        const f32x4 xv = *(const f32x4*)(x + (size_t)m * DM + n0);
        const f32x4 g = *(const f32x4*)(mod + b * 6144 + 2048 + n0);
        f32x4 o; o.x = xv.x + g.x * v.x; o.y = xv.y + g.y * v.y; o.z = xv.z + g.z * v.z; o.w = xv.w + g.w * v.w;
        *(f32x4*)(x1 + (size_t)m * DM + n0) = o;
    } };
struct EpStoreBf16 { bf16_t* out; int ld; int pad;
    __device__ __forceinline__ void operator()(int m, int n0, f32x4 v) const {
        u32x2 o; o.x = pack2(v.x, v.y); o.y = pack2(v.z, v.w);
        *(u32x2*)(out + (size_t)m * ld + n0) = o;
    } };

template <class AL, class EP>
__device__ __forceinline__ void d_gemm(const AL& al, const bf16_t* __restrict__ Bt, int K, int ntn, const EP& ep, int vb, char* lds) {
    bf16_t* sA = (bf16_t*)lds;
    bf16_t* sB = (bf16_t*)lds + 128 * GLD;
    const int tid = threadIdx.x, lane = tid & 63, wid = tid >> 6, wr = wid >> 1, wc = wid & 1, fr = lane & 15, fq = lane >> 4;
    const int tile_m = vb / ntn, tile_n = vb - tile_m * ntn;
    const int m0 = tile_m * 128, n0 = tile_n * 128;
    const int lr = tid >> 3, lk = (tid & 7) * 8;
    f32x4 acc[4][4];
#pragma unroll
    for (int i = 0; i < 4; ++i)
#pragma unroll
        for (int j = 0; j < 4; ++j) acc[i][j] = (f32x4){0.f, 0.f, 0.f, 0.f};
    u32x4 ra[4], rb[4];
#pragma unroll
    for (int i = 0; i < 4; ++i) {
        ra[i] = *(const u32x4*)al(m0 + lr + 32 * i, lk);
        rb[i] = *(const u32x4*)(Bt + (size_t)(n0 + lr + 32 * i) * K + lk);
    }
    const int nk = K / 64;
    for (int kt = 0; kt < nk; ++kt) {
#pragma unroll
        for (int i = 0; i < 4; ++i) {
            *(u32x4*)(sA + (lr + 32 * i) * GLD + lk) = ra[i];
            *(u32x4*)(sB + (lr + 32 * i) * GLD + lk) = rb[i];
        }
        __syncthreads();
        if (kt + 1 < nk) {
            const int k0 = (kt + 1) * 64;
#pragma unroll
            for (int i = 0; i < 4; ++i) {
                ra[i] = *(const u32x4*)al(m0 + lr + 32 * i, k0 + lk);
                rb[i] = *(const u32x4*)(Bt + (size_t)(n0 + lr + 32 * i) * K + k0 + lk);
            }
        }
#pragma unroll
        for (int ks = 0; ks < 2; ++ks) {
            bf16x8 fa[4], fb[4];
#pragma unroll
            for (int i = 0; i < 4; ++i) {
                fa[i] = *(const bf16x8*)(sA + (wr * 64 + i * 16 + fr) * GLD + ks * 32 + fq * 8);
                fb[i] = *(const bf16x8*)(sB + (wc * 64 + i * 16 + fr) * GLD + ks * 32 + fq * 8);
            }
#pragma unroll
            for (int mi = 0; mi < 4; ++mi)
#pragma unroll
                for (int ni = 0; ni < 4; ++ni)
                    acc[mi][ni] = __builtin_amdgcn_mfma_f32_16x16x32_bf16(fb[ni], fa[mi], acc[mi][ni], 0, 0, 0);
        }
        __syncthreads();
    }
#pragma unroll
    for (int mi = 0; mi < 4; ++mi)
#pragma unroll
        for (int ni = 0; ni < 4; ++ni)
            ep(m0 + wr * 64 + mi * 16 + fr, n0 + wc * 64 + ni * 16 + fq * 4, acc[mi][ni]);
}

__device__ __forceinline__ void d_cmp_out(const bf16_t* __restrict__ hid, const float* __restrict__ w2, bf16_t* __restrict__ out, int vb) {
    const int m = vb * 4 + (threadIdx.x >> 6), d = threadIdx.x & 63;
    if (m >= NB * 2 * NCMP) return;
    float a = 0.f;
    for (int j = 0; j < 256; ++j) a += bf2f(hid[(size_t)m * 256 + j]) * w2[j * 64 + d];
    const int bg = m / NCMP, n = m - bg * NCMP;
    out[((size_t)bg * 512 + n) * 64 + d] = f2bf(a);
}

struct AttnSt { float m, l; float o[8]; };
__device__ __forceinline__ float dot64(const float (&q)[64], const bf16_t* krow) {
    float s = 0.f;
#pragma unroll
    for (int c = 0; c < 8; ++c) {
        const u32x4 kv = *(const u32x4*)(krow + c * 8);
        s += q[c * 8 + 0] * bflo(kv.x) + q[c * 8 + 1] * bfhi(kv.x) + q[c * 8 + 2] * bflo(kv.y) + q[c * 8 + 3] * bfhi(kv.y)
           + q[c * 8 + 4] * bflo(kv.z) + q[c * 8 + 5] * bfhi(kv.z) + q[c * 8 + 6] * bflo(kv.w) + q[c * 8 + 7] * bfhi(kv.w);
    }
    return s;
}
__device__ __forceinline__ void pv_tile(float p, const bf16_t* vbase, size_t vstride, int lane, float (&o)[8]) {
    const int ks = lane >> 3, dc = lane & 7;
#pragma unroll
    for (int j = 0; j < 8; ++j) {
        const int kk = j * 8 + ks;
        const float pj = __shfl(p, kk);
        const u32x4 vv = *(const u32x4*)(vbase + (size_t)kk * vstride + dc * 8);
        o[0] += pj * bflo(vv.x); o[1] += pj * bfhi(vv.x); o[2] += pj * bflo(vv.y); o[3] += pj * bfhi(vv.y);
        o[4] += pj * bflo(vv.z); o[5] += pj * bfhi(vv.z); o[6] += pj * bflo(vv.w); o[7] += pj * bfhi(vv.w);
    }
}
__device__ __forceinline__ void attn_tile(const float (&q)[64], const bf16_t* krow, bool valid, const bf16_t* vbase, size_t vstride, int lane, AttnSt& st) {
    float s = valid ? dot64(q, krow) * 0.125f : -1e30f;
    const float mn = fmaxf(st.m, wave_max(s));
    const float alpha = __expf(st.m - mn);
    const float p = valid ? __expf(s - mn) : 0.f;
    st.l = st.l * alpha + wave_sum(p);
    st.m = mn;
#pragma unroll
    for (int e = 0; e < 8; ++e) st.o[e] *= alpha;
    pv_tile(p, vbase, vstride, lane, st.o);
}
__device__ __forceinline__ void load_q64(const bf16_t* qp, float (&q)[64]) {
#pragma unroll
    for (int c = 0; c < 8; ++c) {
        const u32x4 v = *(const u32x4*)(qp + c * 8);
        q[c * 8 + 0] = bflo(v.x); q[c * 8 + 1] = bfhi(v.x); q[c * 8 + 2] = bflo(v.y); q[c * 8 + 3] = bfhi(v.y);
        q[c * 8 + 4] = bflo(v.z); q[c * 8 + 5] = bfhi(v.z); q[c * 8 + 6] = bflo(v.w); q[c * 8 + 7] = bfhi(v.w);
    }
}
__device__ __forceinline__ void finish_branch(AttnSt& st, float gate, float (&tot)[8]) {
#pragma unroll
    for (int e = 0; e < 8; ++e) {
        float v = st.o[e];
        v += __shfl_xor(v, 8); v += __shfl_xor(v, 16); v += __shfl_xor(v, 32);
        tot[e] += (st.l > 0.f) ? gate * v / st.l : 0.f;
    }
}

__device__ __forceinline__ void d_nsa(const bf16_t* __restrict__ proj, const bf16_t* __restrict__ qrope, const bf16_t* __restrict__ kc, const bf16_t* __restrict__ vc,
                                             const float* __restrict__ small, float* __restrict__ onsa, int vb, char* lds) {
    float (*pc)[512] = (float (*)[512])lds;
    float* linv = (float*)(lds + 8192);
    float* impv = (float*)(lds + 8192 + 16);
    int* sel = (int*)(lds + 8192 + 16 + 512);
    int& nsel_s = *(int*)(lds + 8192 + 16 + 512 + 64);
    const int tid = threadIdx.x, lane = tid & 63, w = tid >> 6;
    const int blk = vb, t = blk & (SEQ - 1), g = (blk >> 13) & 1, b = blk >> 14;
    const size_t tok = (size_t)b * SEQ + t;
    for (int i = tid; i < 2048; i += 256) (&pc[0][0])[i] = 0.f;
    __syncthreads();
    float q[64];
    float tot[8];
#pragma unroll
    for (int e = 0; e < 8; ++e) tot[e] = 0.f;
    const float* gt = small + tok * 32 + g * 12 + w * 3;
    const float g_c = gt[0], g_s = gt[1], g_w = gt[2];

    load_q64(proj + tok * PROJ_LD + C_Q + g * 256 + w * 64, q);
    const int nvalid = t >= 31 ? (t - 31) / 16 + 1 : 0;
    const int ntile_c = (nvalid + 63) >> 6;
    const bf16_t* kcb = kc + (size_t)(b * 2 + g) * 512 * 64;
    const bf16_t* vcb = vc + (size_t)(b * 2 + g) * 512 * 64;
    {
        float mx = -1e30f;
        for (int tl = 0; tl < ntile_c; ++tl) {
            const int n = tl * 64 + lane; const bool valid = n < nvalid;
            const float s = valid ? dot64(q, kcb + (size_t)n * 64) * 0.125f : -1e30f;
            mx = fmaxf(mx, s);
        }
        mx = wave_max(mx);
        AttnSt st; st.m = mx; st.l = 0.f;
#pragma unroll
        for (int e = 0; e < 8; ++e) st.o[e] = 0.f;
        for (int tl = 0; tl < ntile_c; ++tl) {
            const int n = tl * 64 + lane; const bool valid = n < nvalid;
            const float s = valid ? dot64(q, kcb + (size_t)n * 64) * 0.125f : -1e30f;
            const float p = valid ? __expf(s - mx) : 0.f;
            st.l += wave_sum(p);
            pc[w][n] = p;
            pv_tile(p, vcb + (size_t)tl * 64 * 64, 64, lane, st.o);
        }
        if (lane == 0) linv[w] = st.l > 0.f ? 1.0f / st.l : 0.f;
        finish_branch(st, g_c, tot);
    }
    __syncthreads();
    const int blk_t = t >> 6;
    if (tid < 128) {
        const int j = tid; float v = 0.f;
#pragma unroll
        for (int r = 0; r < 4; ++r) {
            const float a = pc[r][4 * j] + pc[r][4 * j + 1] + pc[r][4 * j + 2] + 0.5f * (pc[r][4 * j + 3] + (j > 0 ? pc[r][4 * j - 1] : 0.f));
            v += a * linv[r];
        }
        const bool forced = (j == 0) || (j == blk_t) || (j == blk_t - 1);
        impv[j] = (j <= blk_t) ? v + (forced ? 1e4f : 0.f) : -1e30f;
    }
    __syncthreads();
    if (w == 0) {
        float v0 = impv[lane], v1 = impv[lane + 64];
        int ns = 0;
        for (int it = 0; it < 16; ++it) {
            float bv; int bi;
            if (v0 >= v1) { bv = v0; bi = lane; } else { bv = v1; bi = lane + 64; }
#pragma unroll
            for (int o = 32; o; o >>= 1) {
                const float ov = __shfl_xor(bv, o); const int oi = __shfl_xor(bi, o);
                if (ov > bv || (ov == bv && oi < bi)) { bv = ov; bi = oi; }
            }
            if (bv < -1e29f) break;
            if (lane == 0) sel[it] = bi;
            ++ns;
            if (bi == lane) v0 = -3e38f;
            if (bi == lane + 64) v1 = -3e38f;
        }
        if (lane == 0) nsel_s = ns;
    }
    __syncthreads();
    load_q64(qrope + tok * 512 + g * 256 + w * 64, q);
    {
        AttnSt st; st.m = -1e30f; st.l = 0.f;
#pragma unroll
        for (int e = 0; e < 8; ++e) st.o[e] = 0.f;
        const int ns = nsel_s;
        for (int i = 0; i < ns; ++i) {
            const int j = sel[i]; const int key = j * 64 + lane; const bool valid = key <= t;
            const bf16_t* krow = proj + ((size_t)b * SEQ + key) * PROJ_LD + C_KSEL + g * 64;
            const bf16_t* vb = proj + ((size_t)b * SEQ + j * 64) * PROJ_LD + C_VSEL + g * 64;
            attn_tile(q, krow, valid, vb, PROJ_LD, lane, st);
        }
        finish_branch(st, g_s, tot);
    }
    {
        AttnSt st; st.m = -1e30f; st.l = 0.f;
#pragma unroll
        for (int e = 0; e < 8; ++e) st.o[e] = 0.f;
        const int lo = t - 511 > 0 ? t - 511 : 0;
        for (int tl = lo >> 6; tl <= blk_t; ++tl) {
            const int key = tl * 64 + lane; const bool valid = key >= lo && key <= t;
            const bf16_t* krow = proj + ((size_t)b * SEQ + key) * PROJ_LD + C_KWIN + g * 64;
            const bf16_t* vb = proj + ((size_t)b * SEQ + tl * 64) * PROJ_LD + C_VWIN + g * 64;
            attn_tile(q, krow, valid, vb, PROJ_LD, lane, st);
        }
        finish_branch(st, g_w, tot);
    }
    if (lane < 8) {
        float* op = onsa + tok * 512 + g * 256 + w * 64 + lane * 8;
        *(f32x4*)op = (f32x4){tot[0], tot[1], tot[2], tot[3]};
        *(f32x4*)(op + 4) = (f32x4){tot[4], tot[5], tot[6], tot[7]};
    }
}

__device__ __forceinline__ void d_ssd(const bf16_t* __restrict__ proj, const float* __restrict__ small, const float* __restrict__ conv_w, const float* __restrict__ conv_b,
                                             const float* __restrict__ a_log, const float* __restrict__ d_skip, float* __restrict__ yssd, int vb, char* lds) {
    float (*sB)[128] = (float (*)[128])lds; float (*sC)[128] = (float (*)[128])(lds + 8192); float* sdt = (float*)(lds + 16384); float* sdA = (float*)(lds + 16384 + 64);
    float (*ypart)[4][64] = (float (*)[4][64])(lds + 16384 + 128);
    const int tid = threadIdx.x, p = tid & 63, nq = tid >> 6;
    const int b = vb >> 3, hh = vb & 7, g = hh >> 2;
    const int ch_bc = tid < 128 ? 512 + g * 128 + tid : 768 + g * 128 + (tid - 128);
    const int ch_x = hh * 64 + p;
    float wbc[4], wx[4];
#pragma unroll
    for (int k = 0; k < 4; ++k) { wbc[k] = conv_w[k * 1024 + ch_bc]; wx[k] = conv_w[k * 1024 + ch_x]; }
    const float bbc = conv_b[ch_bc], bx = conv_b[ch_x];
    const float a = -__expf(a_log[hh]), dsk = d_skip[hh];
    float hb0 = 0.f, hb1 = 0.f, hb2 = 0.f, hx0 = 0.f, hx1 = 0.f, hx2 = 0.f;
    float h[32];
#pragma unroll
    for (int k = 0; k < 32; ++k) h[k] = 0.f;
    const bf16_t* pb = proj + (size_t)b * SEQ * PROJ_LD + C_XBC;
    for (int t0 = 0; t0 < SEQ; t0 += 16) {
        float rbc[16], rx[16];
#pragma unroll
        for (int i = 0; i < 16; ++i) {
            rbc[i] = bf2f(pb[(size_t)(t0 + i) * PROJ_LD + ch_bc]);
            rx[i] = bf2f(pb[(size_t)(t0 + i) * PROJ_LD + ch_x]);
        }
        if (tid < 16) { const float dtv = small[((size_t)b * SEQ + t0 + tid) * 32 + 24 + hh]; sdt[tid] = dtv; sdA[tid] = __expf(dtv * a); }
        float xv[16];
#pragma unroll
        for (int i = 0; i < 16; ++i) {
            const float vb = bbc + wbc[0] * hb0 + wbc[1] * hb1 + wbc[2] * hb2 + wbc[3] * rbc[i];
            hb0 = hb1; hb1 = hb2; hb2 = rbc[i];
            const float sv = silu(vb);
            if (tid < 128) sB[i][tid] = sv; else sC[i][tid - 128] = sv;
            const float vx = bx + wx[0] * hx0 + wx[1] * hx1 + wx[2] * hx2 + wx[3] * rx[i];
            hx0 = hx1; hx1 = hx2; hx2 = rx[i];
            xv[i] = silu(vx);
        }
        __syncthreads();
#pragma unroll
        for (int i = 0; i < 16; ++i) {
            const float dtv = sdt[i], dA = sdA[i], xdt = xv[i] * dtv;
            float yp = 0.f;
#pragma unroll
            for (int k4 = 0; k4 < 8; ++k4) {
                const f32x4 bv = *(const f32x4*)&sB[i][nq * 32 + k4 * 4];
                const f32x4 cv = *(const f32x4*)&sC[i][nq * 32 + k4 * 4];
                h[k4 * 4 + 0] = h[k4 * 4 + 0] * dA + xdt * bv.x; yp += cv.x * h[k4 * 4 + 0];
                h[k4 * 4 + 1] = h[k4 * 4 + 1] * dA + xdt * bv.y; yp += cv.y * h[k4 * 4 + 1];
                h[k4 * 4 + 2] = h[k4 * 4 + 2] * dA + xdt * bv.z; yp += cv.z * h[k4 * 4 + 2];
                h[k4 * 4 + 3] = h[k4 * 4 + 3] * dA + xdt * bv.w; yp += cv.w * h[k4 * 4 + 3];
            }
            if (nq == 0) yp += xv[i] * dsk;
            ypart[i][nq][p] = yp;
        }
        __syncthreads();
#pragma unroll
        for (int k2 = 0; k2 < 4; ++k2) {
            const int i = nq + 4 * k2;
            yssd[((size_t)b * SEQ + t0 + i) * 512 + hh * 64 + p] = ypart[i][0][p] + ypart[i][1][p] + ypart[i][2][p] + ypart[i][3][p];
        }
        __syncthreads();
    }
}

__device__ __forceinline__ void d_mix_prep(const float* __restrict__ onsa, const float* __restrict__ yssd, const bf16_t* __restrict__ proj,
                                                  const float* __restrict__ nsa_w, const float* __restrict__ ssd_w, bf16_t* __restrict__ A2, int vb, char* lds) {
    float (*red)[4] = (float (*)[4])lds;
    const int tid = threadIdx.x; const size_t tok = vb;
    const float o0 = onsa[tok * 512 + tid * 2], o1 = onsa[tok * 512 + tid * 2 + 1];
    const unsigned zz = *(const unsigned*)(proj + tok * PROJ_LD + C_Z + tid * 2);
    const float y0 = yssd[tok * 512 + tid * 2] * silu(bflo(zz)), y1 = yssd[tok * 512 + tid * 2 + 1] * silu(bfhi(zz));
    float s0 = wave_sum(o0 * o0 + o1 * o1), s1 = wave_sum(y0 * y0 + y1 * y1);
    if ((tid & 63) == 0) { red[0][tid >> 6] = s0; red[1][tid >> 6] = s1; }
    __syncthreads();
    const float r0 = rsqrtf((red[0][0] + red[0][1] + red[0][2] + red[0][3]) * (1.0f / 512) + EPS);
    const float r1 = rsqrtf((red[1][0] + red[1][1] + red[1][2] + red[1][3]) * (1.0f / 512) + EPS);
    *(unsigned*)(A2 + tok * DM + tid * 2) = pack2(o0 * r0 * nsa_w[tid * 2], o1 * r0 * nsa_w[tid * 2 + 1]);
    *(unsigned*)(A2 + tok * DM + 512 + tid * 2) = pack2(y0 * r1 * ssd_w[tid * 2], y1 * r1 * ssd_w[tid * 2 + 1]);
}

__device__ __forceinline__ void argmax_bfly(float& bv, int& bi) {
#pragma unroll
    for (int o = 32; o; o >>= 1) {
        const float ov = __shfl_xor(bv, o); const int oi = __shfl_xor(bi, o);
        if (ov > bv || (ov == bv && oi < bi)) { bv = ov; bi = oi; }
    }
}
__device__ __forceinline__ void d_peer_topk(const bf16_t* __restrict__ qp, const float* __restrict__ qnw, const bf16_t* __restrict__ subk, int* __restrict__ eidx, float* __restrict__ gate, int vb, char* lds) {
    float (*sq)[256] = (float (*)[256])lds;
    const int tid = threadIdx.x, lane = tid & 63, wid = tid >> 6;
    const int gw = vb * 4 + wid; const size_t tok = gw >> 3; const int h = gw & 7;
    {
        const u32x2 v = *(const u32x2*)(qp + tok * 2048 + h * 256 + lane * 4);
        const float a0 = bflo(v.x), a1 = bfhi(v.x), a2 = bflo(v.y), a3 = bfhi(v.y);
        const float ss = wave_sum(a0 * a0 + a1 * a1 + a2 * a2 + a3 * a3);
        const float r = rsqrtf(ss * (1.0f / 256) + EPS);
        const f32x4 wv = *(const f32x4*)(qnw + lane * 4);
        *(f32x4*)&sq[wid][lane * 4] = (f32x4){a0 * r * wv.x, a1 * r * wv.y, a2 * r * wv.z, a3 * r * wv.w};
    }
    __syncthreads();
    float sc[2][2];
#pragma unroll
    for (int k = 0; k < 2; ++k)
#pragma unroll
        for (int hf = 0; hf < 2; ++hf) {
            const int n = lane + 64 * hf;
            const bf16_t* kr = subk + ((size_t)(h * 2 + k) * 128 + n) * 128;
            float s = 0.f;
#pragma unroll 4
            for (int c = 0; c < 16; ++c) {
                const u32x4 kv = *(const u32x4*)(kr + c * 8);
                const f32x4 q0 = *(const f32x4*)&sq[wid][k * 128 + c * 8], q1 = *(const f32x4*)&sq[wid][k * 128 + c * 8 + 4];
                s += q0.x * bflo(kv.x) + q0.y * bfhi(kv.x) + q0.z * bflo(kv.y) + q0.w * bfhi(kv.y)
                   + q1.x * bflo(kv.z) + q1.y * bfhi(kv.z) + q1.z * bflo(kv.w) + q1.w * bfhi(kv.w);
            }
            sc[k][hf] = s;
            __builtin_amdgcn_sched_barrier(0);
        }
    float s1v = 0.f, s2v = 0.f; int i1v = 0, i2v = 0;
#pragma unroll
    for (int k = 0; k < 2; ++k) {
        float v0 = sc[k][0], v1 = sc[k][1];
        for (int it = 0; it < 16; ++it) {
            float bv; int bi;
            if (v0 >= v1) { bv = v0; bi = lane; } else { bv = v1; bi = lane + 64; }
            argmax_bfly(bv, bi);
            if (lane == it) { if (k == 0) { s1v = bv; i1v = bi; } else { s2v = bv; i2v = bi; } }
            if (bi == lane) v0 = -3e38f;
            if (bi == lane + 64) v1 = -3e38f;
        }
    }
    float cs[4]; int ci[4];
#pragma unroll
    for (int e = 0; e < 4; ++e) {
        const int a = lane >> 2, bb = (lane & 3) * 4 + e;
        cs[e] = __shfl(s1v, a) + __shfl(s2v, bb);
        ci[e] = __shfl(i1v, a) * 128 + __shfl(i2v, bb);
    }
    float tsv = -3e38f; int tev = 0;
    for (int it = 0; it < 16; ++it) {
        float bv = cs[0]; int bc = lane * 4;
#pragma unroll
        for (int e = 1; e < 4; ++e) if (cs[e] > bv) { bv = cs[e]; bc = lane * 4 + e; }
        argmax_bfly(bv, bc);
        const int owner = bc >> 2, oe = bc & 3;
        int ev = 0;
#pragma unroll
        for (int e = 0; e < 4; ++e) if (oe == e) ev = ci[e];
        ev = __shfl(ev, owner);
        if (lane == it) { tsv = bv; tev = ev; }
        if (lane == owner) {
#pragma unroll
            for (int e = 0; e < 4; ++e) if (oe == e) cs[e] = -3e38f;
        }
    }
    const float mx = wave_max(tsv);
    const float pe = lane < 16 ? __expf(tsv - mx) : 0.f;
    const float sum = wave_sum(pe);
    if (lane < 16) {
        eidx[(tok * 8 + h) * 16 + lane] = tev;
        gate[(tok * 8 + h) * 16 + lane] = pe / sum;
    }
}

__device__ __forceinline__ void d_peer_expert(const bf16_t* __restrict__ h2, const bf16_t* __restrict__ down, const bf16_t* __restrict__ up, const int* __restrict__ eidx,
                                                     const float* __restrict__ gate, const float* __restrict__ mod, const float* __restrict__ fw, float* __restrict__ out, int vb) {
    const int tid = threadIdx.x, lane = tid & 63, wid = tid >> 6;
    const size_t tok = (size_t)vb * 4 + wid; const int b = (int)(tok >> 13);
    float hx[16], acc[16];
    {
        const u32x4 v0 = *(const u32x4*)(h2 + tok * DM + lane * 8), v1 = *(const u32x4*)(h2 + tok * DM + 512 + lane * 8);
        hx[0] = bflo(v0.x); hx[1] = bfhi(v0.x); hx[2] = bflo(v0.y); hx[3] = bfhi(v0.y); hx[4] = bflo(v0.z); hx[5] = bfhi(v0.z); hx[6] = bflo(v0.w); hx[7] = bfhi(v0.w);
        hx[8] = bflo(v1.x); hx[9] = bfhi(v1.x); hx[10] = bflo(v1.y); hx[11] = bfhi(v1.y); hx[12] = bflo(v1.z); hx[13] = bfhi(v1.z); hx[14] = bflo(v1.w); hx[15] = bfhi(v1.w);
    }
#pragma unroll
    for (int e = 0; e < 16; ++e) acc[e] = 0.f;
    const int* ep = eidx + tok * 128; const float* gp = gate + tok * 128;
    for (int j0 = 0; j0 < 128; j0 += 4) {
        u32x4 d0[4], d1[4], u0[4], u1[4]; float gt[4];
#pragma unroll
        for (int jj = 0; jj < 4; ++jj) {
            const int e = __builtin_amdgcn_readfirstlane(ep[j0 + jj]);
            gt[jj] = gp[j0 + jj];
            const bf16_t* dr = down + (size_t)e * DM; const bf16_t* ur = up + (size_t)e * DM;
            d0[jj] = *(const u32x4*)(dr + lane * 8); d1[jj] = *(const u32x4*)(dr + 512 + lane * 8);
            u0[jj] = *(const u32x4*)(ur + lane * 8); u1[jj] = *(const u32x4*)(ur + 512 + lane * 8);
        }
#pragma unroll
        for (int jj = 0; jj < 4; ++jj) {
            float s = hx[0] * bflo(d0[jj].x) + hx[1] * bfhi(d0[jj].x) + hx[2] * bflo(d0[jj].y) + hx[3] * bfhi(d0[jj].y)
                    + hx[4] * bflo(d0[jj].z) + hx[5] * bfhi(d0[jj].z) + hx[6] * bflo(d0[jj].w) + hx[7] * bfhi(d0[jj].w)
                    + hx[8] * bflo(d1[jj].x) + hx[9] * bfhi(d1[jj].x) + hx[10] * bflo(d1[jj].y) + hx[11] * bfhi(d1[jj].y)
                    + hx[12] * bflo(d1[jj].z) + hx[13] * bfhi(d1[jj].z) + hx[14] * bflo(d1[jj].w) + hx[15] * bfhi(d1[jj].w);
            s = wave_sum(s);
            const float a = gelu_tanh(s) * gt[jj];
            acc[0] += a * bflo(u0[jj].x); acc[1] += a * bfhi(u0[jj].x); acc[2] += a * bflo(u0[jj].y); acc[3] += a * bfhi(u0[jj].y);
            acc[4] += a * bflo(u0[jj].z); acc[5] += a * bfhi(u0[jj].z); acc[6] += a * bflo(u0[jj].w); acc[7] += a * bfhi(u0[jj].w);
            acc[8] += a * bflo(u1[jj].x); acc[9] += a * bfhi(u1[jj].x); acc[10] += a * bflo(u1[jj].y); acc[11] += a * bfhi(u1[jj].y);
            acc[12] += a * bflo(u1[jj].z); acc[13] += a * bfhi(u1[jj].z); acc[14] += a * bflo(u1[jj].w); acc[15] += a * bfhi(u1[jj].w);
        }
    }
    float x2[16]; float ss = 0.f;
#pragma unroll
    for (int hf = 0; hf < 2; ++hf)
#pragma unroll
        for (int q4 = 0; q4 < 2; ++q4) {
            const int col = hf * 512 + lane * 8 + q4 * 4;
            const f32x4 xv = *(const f32x4*)(out + tok * DM + col);
            const f32x4 g2 = *(const f32x4*)(mod + b * 6144 + 5120 + col);
            const int e0 = hf * 8 + q4 * 4;
            x2[e0 + 0] = xv.x + g2.x * acc[e0 + 0]; x2[e0 + 1] = xv.y + g2.y * acc[e0 + 1]; x2[e0 + 2] = xv.z + g2.z * acc[e0 + 2]; x2[e0 + 3] = xv.w + g2.w * acc[e0 + 3];
            ss += x2[e0] * x2[e0] + x2[e0 + 1] * x2[e0 + 1] + x2[e0 + 2] * x2[e0 + 2] + x2[e0 + 3] * x2[e0 + 3];
        }
    ss = wave_sum(ss);
    const float r = rsqrtf(ss * (1.0f / DM) + EPS);
#pragma unroll
    for (int hf = 0; hf < 2; ++hf)
#pragma unroll
        for (int q4 = 0; q4 < 2; ++q4) {
            const int col = hf * 512 + lane * 8 + q4 * 4;
            const f32x4 w = *(const f32x4*)(fw + col);
            const int e0 = hf * 8 + q4 * 4;
            *(f32x4*)(out + tok * DM + col) = (f32x4){x2[e0] * r * w.x, x2[e0 + 1] * r * w.y, x2[e0 + 2] * r * w.z, x2[e0 + 3] * r * w.w};
        }
}

struct Params {
    const float *x, *c, *w_ada, *b_ada, *norm1_w, *w_in, *cmp_pe_k, *cmp_pe_v, *cmp_w1_k, *cmp_w2_k, *cmp_w1_v, *cmp_w2_v, *nsa_norm_w, *conv_w, *conv_b, *dt_bias, *a_log, *d_skip,
        *ssd_norm_w, *w_out, *norm2_w, *peer_wq, *peer_qnorm_w, *peer_sub_keys, *peer_down, *peer_up, *final_norm_w;
    float* out; char* ws;
};
#define LDS_BYTES 36864

__global__ __launch_bounds__(256, 1) void mega(Params p) {
    __shared__ __attribute__((aligned(16))) char lds[LDS_BYTES];
    __shared__ int s_vb;
    cg::grid_group grid = cg::this_grid();
    const int G = gridDim.x, bid = blockIdx.x;
    char* ws = p.ws;
    float* mod = (float*)(ws + OFF_MOD);
    float2* rope = (float2*)(ws + OFF_ROPE);
    float* bias1 = (float*)(ws + OFF_BIAS1);
    bf16_t* win_t = (bf16_t*)(ws + OFF_WIN_T);
    bf16_t* wout_t = (bf16_t*)(ws + OFF_WOUT_T);
    bf16_t* wq_t = (bf16_t*)(ws + OFF_WQ_T);
    bf16_t* subk = (bf16_t*)(ws + OFF_SUBK);
    bf16_t* w1k_t = (bf16_t*)(ws + OFF_W1K_T);
    bf16_t* w1v_t = (bf16_t*)(ws + OFF_W1V_T);
    bf16_t* kc = (bf16_t*)(ws + OFF_KC);
    bf16_t* vc = (bf16_t*)(ws + OFF_VC);
    bf16_t* hidk = (bf16_t*)(ws + OFF_HIDK);
    bf16_t* hidv = (bf16_t*)(ws + OFF_HIDV);
    bf16_t* down = (bf16_t*)(ws + OFF_DOWN);
    bf16_t* up = (bf16_t*)(ws + OFF_UP);
    float* small = (float*)(ws + OFF_SMALL);
    bf16_t* hbuf = (bf16_t*)(ws + OFF_H);
    bf16_t* proj = (bf16_t*)(ws + OFF_PROJ);
    bf16_t* qrope = (bf16_t*)(ws + OFF_QROPE);
    float* onsa = (float*)(ws + OFF_ONSA);
    float* yssd = (float*)(ws + OFF_YSSD);
    int* eidx = (int*)(ws + OFF_EIDX);
    float* gate = (float*)(ws + OFF_GATE);
    unsigned* ctr = (unsigned*)(ws + OFF_CTR);

    if (bid == 0 && threadIdx.x == 0) ctr[0] = 0u;
    for (int vb = bid; vb < 11618; vb += G) {
        int v = vb;
        if (v < 2944) { d_transpose_w(p.w_in, win_t, 1024, 2848, 1, v % 92, v / 92, lds); }
        else if ((v -= 2944) < 1024) { d_transpose_w(p.w_out, wout_t, 1024, 1024, 0, v & 31, v >> 5, lds); }
        else if ((v -= 1024) < 2048) { d_transpose_w(p.peer_wq, wq_t, 1024, 2048, 0, v & 63, v >> 6, lds); }
        else if ((v -= 2048) < 512) { d_transpose_w(p.cmp_w1_k, w1k_t, 2048, 256, 0, v & 7, v >> 3, lds); }
        else if ((v -= 512) < 512) { d_transpose_w(p.cmp_w1_v, w1v_t, 2048, 256, 0, v & 7, v >> 3, lds); }
        else if ((v -= 512) < 2048) { d_convert_bf16(p.peer_down, down, (size_t)16384 * 1024 / 8, v, 2048); }
        else if ((v -= 2048) < 2048) { d_convert_bf16(p.peer_up, up, (size_t)16384 * 1024 / 8, v, 2048); }
        else if ((v -= 2048) < 128) { d_convert_bf16(p.peer_sub_keys, subk, (size_t)8 * 2 * 128 * 128 / 8, v, 128); }
        else if ((v -= 128) < 96) { d_mod(p.c, p.w_ada, p.b_ada, mod, v, lds); }
        else if ((v -= 96) < 256) { d_rope_table(rope, v); }
        else { v -= 256; d_bias1(p.cmp_pe_k, p.cmp_w1_k, p.cmp_pe_v, p.cmp_w1_v, bias1, v); }
        __syncthreads();
    }
    grid.sync();
    for (int vb = bid; vb < NTOK; vb += G) { d_norm_mod(p.x, p.norm1_w, mod, 0, 1024, hbuf, vb, lds); __syncthreads(); }
    grid.sync();
    {
        const ALoadPlain al{hbuf, DM, 0}; const EpInProj ep{proj, qrope, small, rope, p.dt_bias};
        for (int vb = bid; vb < (NTOK / 128) * (NIN_PAD / 128); vb += G) d_gemm(al, win_t, 1024, NIN_PAD / 128, ep, vb, lds);
    }
    grid.sync();
    for (int vb = bid; vb < 256; vb += G) {
        if (vb < 128) { const ALoadCmp al{proj, C_KCMP, 0}; const EpCmpHid ep{hidk, bias1}; d_gemm(al, w1k_t, 2048, 2, ep, vb, lds); }
        else { const ALoadCmp al{proj, C_VCMP, 0}; const EpCmpHid ep{hidv, bias1 + 256}; d_gemm(al, w1v_t, 2048, 2, ep, vb - 128, lds); }
    }
    grid.sync();
    for (int vb = bid; vb < 2 * 2044; vb += G) {
        if (vb < 2044) d_cmp_out(hidk, p.cmp_w2_k, kc, vb); else d_cmp_out(hidv, p.cmp_w2_v, vc, vb - 2044);
    }
    grid.sync();
    for (int vb = bid; vb < 64; vb += G) { d_ssd(proj, small, p.conv_w, p.conv_b, p.a_log, p.d_skip, yssd, vb, lds); __syncthreads(); }
    for (;;) {
        if (threadIdx.x == 0) s_vb = (int)atomicAdd(&ctr[0], 1u);
        __syncthreads();
        const int i = s_vb;
        __syncthreads();
        if (i >= NB * 2 * SEQ) break;
        const int t = SEQ - 1 - (i >> 4), bg = i & 15;
        d_nsa(proj, qrope, kc, vc, small, onsa, (bg << 13) | t, lds);
        __syncthreads();
    }
    grid.sync();
    for (int vb = bid; vb < NTOK; vb += G) { d_mix_prep(onsa, yssd, proj, p.nsa_norm_w, p.ssd_norm_w, hbuf, vb, lds); __syncthreads(); }
    grid.sync();
    {
        const ALoadPlain al{hbuf, DM, 0}; const EpOutProj ep{p.x, mod, p.out};
        for (int vb = bid; vb < (NTOK / 128) * 8; vb += G) d_gemm(al, wout_t, 1024, 8, ep, vb, lds);
    }
    grid.sync();
    for (int vb = bid; vb < NTOK; vb += G) { d_norm_mod(p.out, p.norm2_w, mod, 3072, 4096, hbuf, vb, lds); __syncthreads(); }
    grid.sync();
    {
        const ALoadPlain al{hbuf, DM, 0}; const EpStoreBf16 ep{proj, 2048, 0};
        for (int vb = bid; vb < (NTOK / 128) * 16; vb += G) d_gemm(al, wq_t, 1024, 16, ep, vb, lds);
    }
    grid.sync();
    for (int vb = bid; vb < NTOK * 2; vb += G) { d_peer_topk(proj, p.peer_qnorm_w, subk, eidx, gate, vb, lds); __syncthreads(); }
    grid.sync();
    for (int vb = bid; vb < NTOK / 4; vb += G) d_peer_expert(hbuf, down, up, eidx, gate, mod, p.final_norm_w, p.out, vb);
}

extern "C" void kernel_launch(void* const* d_in, const int* in_sizes, int n_in, void* d_out, int out_size, void* d_ws, size_t ws_size, hipStream_t stream) {
    if (ws_size < WS_NEED) { fprintf(stderr, "workspace too small\n"); return; }
    static int grid_blocks = 0;
    if (!grid_blocks) {
        int dev = 0, cus = 0, per_cu = 0;
        hipGetDevice(&dev);
        hipDeviceGetAttribute(&cus, hipDeviceAttributeMultiprocessorCount, dev);
        hipOccupancyMaxActiveBlocksPerMultiprocessor(&per_cu, mega, 256, 0);
        if (per_cu > 1) per_cu = 1;
        if (per_cu < 1) per_cu = 1;
        grid_blocks = cus * per_cu;
    }
    Params p{};
    const float** pp = (const float**)&p;
    for (int i = 0; i < 27; ++i) pp[i] = (const float*)d_in[i];
    p.out = (float*)d_out; p.ws = (char*)d_ws;
    void* args[] = {&p};
    hipError_t e = hipLaunchCooperativeKernel((void*)mega, dim3(grid_blocks), dim3(256), args, 0, stream);
    if (e != hipSuccess) fprintf(stderr, "cooperative launch failed: %s (grid %d)\n", hipGetErrorString(e), grid_blocks);
}
```

```cpp
#include <hip/hip_runtime.h>
#include <hip/hip_cooperative_groups.h>
#include <stdint.h>
#include <cstdio>
namespace cg = cooperative_groups;

typedef unsigned short bf16_t;
typedef short bf16x8 __attribute__((ext_vector_type(8)));
typedef float f32x4 __attribute__((ext_vector_type(4)));
typedef unsigned u32x4 __attribute__((ext_vector_type(4)));
typedef unsigned u32x2 __attribute__((ext_vector_type(2)));

#define NB 8
#define SEQ 8192
#define NTOK 65536
#define DM 1024
#define PROJ_LD 2816
#define NIN_PAD 2944
#define C_Q 0
#define C_KCMP 512
#define C_VCMP 640
#define C_KSEL 768
#define C_VSEL 896
#define C_KWIN 1024
#define C_VWIN 1152
#define C_Z 1280
#define C_XBC 1792
#define NCMP 511
#define EPS 1e-6f

#define OFF_MOD    ((size_t)0)
#define OFF_ROPE   ((size_t)1 << 20)
#define OFF_BIAS1  ((size_t)2 << 20)
#define OFF_WIN_T  ((size_t)3 << 20)
#define OFF_WOUT_T ((size_t)9 << 20)
#define OFF_WQ_T   ((size_t)11 << 20)
#define OFF_SUBK   ((size_t)15 << 20)
#define OFF_W1K_T  ((size_t)16 << 20)
#define OFF_W1V_T  ((size_t)17 << 20)
#define OFF_KC     ((size_t)18 << 20)
#define OFF_VC     ((size_t)19 << 20)
#define OFF_HIDK   ((size_t)20 << 20)
#define OFF_HIDV   ((size_t)24 << 20)
#define OFF_DOWN   ((size_t)28 << 20)
#define OFF_UP     ((size_t)60 << 20)
#define OFF_SMALL  ((size_t)92 << 20)
#define OFF_H      ((size_t)100 << 20)
#define OFF_PROJ   ((size_t)228 << 20)
#define OFF_QROPE  ((size_t)580 << 20)
#define OFF_ONSA   ((size_t)644 << 20)
#define OFF_YSSD   ((size_t)772 << 20)
#define OFF_EIDX   ((size_t)900 << 20)
#define OFF_GATE   ((size_t)932 << 20)
#define OFF_CTR    ((size_t)964 << 20)
#define WS_NEED    ((size_t)965 << 20)

__device__ __forceinline__ bf16_t f2bf(float f) { unsigned u = __float_as_uint(f); u += 0x7fffu + ((u >> 16) & 1u); return (bf16_t)(u >> 16); }
__device__ __forceinline__ float bf2f(bf16_t h) { return __uint_as_float(((unsigned)h) << 16); }
__device__ __forceinline__ float bflo(unsigned u) { return __uint_as_float(u << 16); }
__device__ __forceinline__ float bfhi(unsigned u) { return __uint_as_float(u & 0xffff0000u); }
__device__ __forceinline__ unsigned pack2(float a, float b) { return (unsigned)f2bf(a) | ((unsigned)f2bf(b) << 16); }
__device__ __forceinline__ float wave_sum(float v) {
#pragma unroll
    for (int o = 32; o; o >>= 1) v += __shfl_xor(v, o);
    return v;
}
__device__ __forceinline__ float wave_max(float v) {
#pragma unroll
    for (int o = 32; o; o >>= 1) v = fmaxf(v, __shfl_xor(v, o));
    return v;
}
__device__ __forceinline__ float gelu_tanh(float x) { return 0.5f * x * (1.0f + tanhf(0.7978845608028654f * (x + 0.044715f * x * x * x))); }
__device__ __forceinline__ float silu(float x) { return x / (1.0f + __expf(-x)); }
__device__ __forceinline__ float sigmoidf(float x) { return 1.0f / (1.0f + __expf(-x)); }
__device__ __forceinline__ float softplusf(float x) { return x > 20.f ? x : log1pf(__expf(x)); }

__device__ __forceinline__ int inproj_src(int n) {
    if (n < 1280) return n;
    if (n < 1792) return 1304 + (n - 1280);
    if (n < 2816) return 1816 + (n - 1792);
    if (n < 2840) return 1280 + (n - 2816);
    if (n < 2848) return 2840 + (n - 2840);
    return -1;
}
__device__ __forceinline__ void d_transpose_w(const float* __restrict__ W, bf16_t* __restrict__ Wt, int K, int N, int mode, int bx, int by, char* lds) {
    float (*t)[33] = (float (*)[33])lds;
    const int n0 = bx * 32, k0 = by * 32, tx = threadIdx.x & 31, ty = threadIdx.x >> 5;
#pragma unroll
    for (int i = 0; i < 4; ++i) {
        const int k = k0 + ty + 8 * i, n = n0 + tx;
        const int src = mode == 1 ? inproj_src(n) : n;
        t[ty + 8 * i][tx] = (src >= 0 && src < N) ? W[(size_t)k * N + src] : 0.f;
    }
    __syncthreads();
#pragma unroll
    for (int i = 0; i < 4; ++i) Wt[(size_t)(n0 + ty + 8 * i) * K + k0 + tx] = f2bf(t[tx][ty + 8 * i]);
}
__device__ __forceinline__ void d_convert_bf16(const float* __restrict__ in, bf16_t* __restrict__ out, size_t n8, int vb, int nvb) {
    size_t i = (size_t)vb * 256 + threadIdx.x;
    const size_t stride = (size_t)nvb * 256;
    for (; i < n8; i += stride) {
        const f32x4 a = ((const f32x4*)in)[2 * i], b = ((const f32x4*)in)[2 * i + 1];
        u32x4 o; o.x = pack2(a.x, a.y); o.y = pack2(a.z, a.w); o.z = pack2(b.x, b.y); o.w = pack2(b.z, b.w);
        ((u32x4*)out)[i] = o;
    }
}
__device__ __forceinline__ void d_mod(const float* __restrict__ c, const float* __restrict__ w_ada, const float* __restrict__ b_ada, float* __restrict__ mod, int vb, char* lds) {
    float (*part)[8][64] = (float (*)[8][64])lds;
    const int tid = threadIdx.x, jl = tid & 63, kq = tid >> 6, j = vb * 64 + jl;
    float acc[8];
#pragma unroll
    for (int b = 0; b < 8; ++b) acc[b] = 0.f;
    for (int k = kq * 256; k < kq * 256 + 256; ++k) {
        const float w = w_ada[(size_t)k * 6144 + j];
#pragma unroll
        for (int b = 0; b < 8; ++b) acc[b] += c[b * 1024 + k] * w;
    }
#pragma unroll
    for (int b = 0; b < 8; ++b) part[kq][b][jl] = acc[b];
    __syncthreads();
    for (int i = tid; i < 512; i += 256) {
        const int b = i >> 6, jj = i & 63;
        mod[b * 6144 + vb * 64 + jj] = part[0][b][jj] + part[1][b][jj] + part[2][b][jj] + part[3][b][jj] + b_ada[vb * 64 + jj];
    }
}
__device__ __forceinline__ void d_rope_table(float2* __restrict__ rope, int vb) {
    const int i = vb * 256 + threadIdx.x;
    if (i >= SEQ * 8) return;
    const int pos = i >> 3, f = i & 7;
    const double inv = pow(500000.0, -(double)f / 8.0);
    const double ang = (double)pos * inv;
    rope[i] = make_float2((float)cos(ang), (float)sin(ang));
}
__device__ __forceinline__ void d_bias1(const float* __restrict__ pe_k, const float* __restrict__ w1_k, const float* __restrict__ pe_v, const float* __restrict__ w1_v, float* __restrict__ bias1, int vb) {
    const int which = vb, j = threadIdx.x;
    const float* pe = which ? pe_v : pe_k; const float* w1 = which ? w1_v : w1_k;
    float a = 0.f;
    for (int k = 0; k < 2048; ++k) a += pe[k] * w1[(size_t)k * 256 + j];
    bias1[which * 256 + j] = a;
}

__device__ __forceinline__ void d_norm_mod(const float* __restrict__ x, const float* __restrict__ w, const float* __restrict__ mod, int sh_off, int sc_off, bf16_t* __restrict__ out, int vb, char* lds) {
    float* red = (float*)lds;
    const int row = vb, tid = threadIdx.x, b = row >> 13;
    const f32x4 v = ((const f32x4*)(x + (size_t)row * DM))[tid];
    float ss = v.x * v.x + v.y * v.y + v.z * v.z + v.w * v.w;
    ss = wave_sum(ss);
    if ((tid & 63) == 0) red[tid >> 6] = ss;
    __syncthreads();
    const float r = rsqrtf((red[0] + red[1] + red[2] + red[3]) * (1.0f / DM) + EPS);
    const f32x4 wv = ((const f32x4*)w)[tid];
    const f32x4 sc = ((const f32x4*)(mod + b * 6144 + sc_off))[tid];
    const f32x4 sh = ((const f32x4*)(mod + b * 6144 + sh_off))[tid];
    u32x2 o;
    o.x = pack2(v.x * r * wv.x * (1.f + sc.x) + sh.x, v.y * r * wv.y * (1.f + sc.y) + sh.y);
    o.y = pack2(v.z * r * wv.z * (1.f + sc.z) + sh.z, v.w * r * wv.w * (1.f + sc.w) + sh.w);
    ((u32x2*)(out + (size_t)row * DM))[tid] = o;
}

#define GLD 72
struct ALoadPlain { const bf16_t* A; int lda; int pad;
    __device__ __forceinline__ const bf16_t* operator()(int row, int k) const { return A + (size_t)row * lda + k; } };
struct ALoadCmp { const bf16_t* proj; int coloff; int pad;
    __device__ __forceinline__ const bf16_t* operator()(int row, int k) const {
        if (row > NB * 2 * NCMP - 1) row = NB * 2 * NCMP - 1;
        const int bg = row / NCMP, n = row - bg * NCMP, b = bg >> 1, g = bg & 1, tok = k >> 6, d = k & 63;
        return proj + (size_t)(b * SEQ + 16 * n + tok) * PROJ_LD + coloff + g * 64 + d; } };

struct EpInProj { bf16_t* proj; bf16_t* qrope; float* small; const float2* rope; const float* dt_bias;
    __device__ __forceinline__ void operator()(int m, int n0, f32x4 v) const {
        if (n0 < 2816) {
            const bool is_q = n0 < 512;
            const bool roped_seg = is_q || (n0 >= C_KSEL && n0 < C_VSEL) || (n0 >= C_KWIN && n0 < C_VWIN);
            const bool rope_dims = roped_seg && ((n0 & 63) < 16);
            u32x2 raw; raw.x = pack2(v.x, v.y); raw.y = pack2(v.z, v.w);
            if (is_q) *(u32x2*)(proj + (size_t)m * PROJ_LD + n0) = raw;
            if (rope_dims) {
                f32x4 p; p.x = __shfl_xor(v.x, 32); p.y = __shfl_xor(v.y, 32); p.z = __shfl_xor(v.z, 32); p.w = __shfl_xor(v.w, 32);
                const int i0 = n0 & 15, pos = m & (SEQ - 1);
                const float sgn = i0 < 8 ? -1.f : 1.f;
                const float2* rp = rope + pos * 8 + (i0 & 7);
                const float2 c0 = rp[0], c1 = rp[1], c2 = rp[2], c3 = rp[3];
                v.x = v.x * c0.x + sgn * p.x * c0.y; v.y = v.y * c1.x + sgn * p.y * c1.y;
                v.z = v.z * c2.x + sgn * p.z * c2.y; v.w = v.w * c3.x + sgn * p.w * c3.y;
            }
            u32x2 o; o.x = pack2(v.x, v.y); o.y = pack2(v.z, v.w);
            if (is_q) *(u32x2*)(qrope + (size_t)m * 512 + n0) = o;
            else *(u32x2*)(proj + (size_t)m * PROJ_LD + n0) = o;
        } else if (n0 < 2848) {
            const int c = n0 - 2816; f32x4 o;
            if (c < 24) { o.x = sigmoidf(v.x); o.y = sigmoidf(v.y); o.z = sigmoidf(v.z); o.w = sigmoidf(v.w); }
            else { const float* db = dt_bias + (c - 24); o.x = softplusf(v.x + db[0]); o.y = softplusf(v.y + db[1]); o.z = softplusf(v.z + db[2]); o.w = softplusf(v.w + db[3]); }
            *(f32x4*)(small + (size_t)m * 32 + c) = o;
        }
    } };
struct EpCmpHid { bf16_t* hid; const float* bias;
    __device__ __forceinline__ void operator()(int m, int n0, f32x4 v) const {
        if (m >= NB * 2 * NCMP) return;
        const f32x4 b = *(const f32x4*)(bias + n0);
        u32x2 o; o.x = pack2(gelu_tanh(v.x + b.x), gelu_tanh(v.y + b.y)); o.y = pack2(gelu_tanh(v.z + b.z), gelu_tanh(v.w + b.w));
        *(u32x2*)(hid + (size_t)m * 256 + n0) = o;
    } };
struct EpOutProj { const float* x; const float* mod; float* x1;
    __device__ __forceinline__ void operator()(int m, int n0, f32x4 v) const {
        const int b = m >> 13;
        const f32x4 xv = *(const f32x4*)(x + (size_t)m * DM + n0);
        const f32x4 g = *(const f32x4*)(mod + b * 6144 + 2048 + n0);
        f32x4 o; o.x = xv.x + g.x * v.x; o.y = xv.y + g.y * v.y; o.z = xv.z + g.z * v.z; o.w = xv.w + g.w * v.w;
        *(f32x4*)(x1 + (size_t)m * DM + n0) = o;
    } };
struct EpStoreBf16 { bf16_t* out; int ld; int pad;
    __device__ __forceinline__ void operator()(int m, int n0, f32x4 v) const {
        u32x2 o; o.x = pack2(v.x, v.y); o.y = pack2(v.z, v.w);
        *(u32x2*)(out + (size_t)m * ld + n0) = o;
    } };

template <class AL, class EP>
__device__ __forceinline__ void d_gemm(const AL& al, const bf16_t* __restrict__ Bt, int K, int ntn, const EP& ep, int vb, char* lds) {
    bf16_t* sA = (bf16_t*)lds;
    bf16_t* sB = (bf16_t*)lds + 128 * GLD;
    const int tid = threadIdx.x, lane = tid & 63, wid = tid >> 6, wr = wid >> 1, wc = wid & 1, fr = lane & 15, fq = lane >> 4;
    const int tile_m = vb / ntn, tile_n = vb - tile_m * ntn;
    const int m0 = tile_m * 128, n0 = tile_n * 128;
    const int lr = tid >> 3, lk = (tid & 7) * 8;
    f32x4 acc[4][4];
#pragma unroll
    for (int i = 0; i < 4; ++i)
#pragma unroll
        for (int j = 0; j < 4; ++j) acc[i][j] = (f32x4){0.f, 0.f, 0.f, 0.f};
    u32x4 ra[4], rb[4];
#pragma unroll
    for (int i = 0; i < 4; ++i) {
        ra[i] = *(const u32x4*)al(m0 + lr + 32 * i, lk);
        rb[i] = *(const u32x4*)(Bt + (size_t)(n0 + lr + 32 * i) * K + lk);
    }
    const int nk = K / 64;
    for (int kt = 0; kt < nk; ++kt) {
#pragma unroll
        for (int i = 0; i < 4; ++i) {
            *(u32x4*)(sA + (lr + 32 * i) * GLD + lk) = ra[i];
            *(u32x4*)(sB + (lr + 32 * i) * GLD + lk) = rb[i];
        }
        __syncthreads();
        if (kt + 1 < nk) {
            const int k0 = (kt + 1) * 64;
#pragma unroll
            for (int i = 0; i < 4; ++i) {
                ra[i] = *(const u32x4*)al(m0 + lr + 32 * i, k0 + lk);
                rb[i] = *(const u32x4*)(Bt + (size_t)(n0 + lr + 32 * i) * K + k0 + lk);
            }
        }
#pragma unroll
        for (int ks = 0; ks < 2; ++ks) {
            bf16x8 fa[4], fb[4];
#pragma unroll
            for (int i = 0; i < 4; ++i) {
                fa[i] = *(const bf16x8*)(sA + (wr * 64 + i * 16 + fr) * GLD + ks * 32 + fq * 8);
                fb[i] = *(const bf16x8*)(sB + (wc * 64 + i * 16 + fr) * GLD + ks * 32 + fq * 8);
            }
#pragma unroll
            for (int mi = 0; mi < 4; ++mi)
#pragma unroll
                for (int ni = 0; ni < 4; ++ni)
                    acc[mi][ni] = __builtin_amdgcn_mfma_f32_16x16x32_bf16(fb[ni], fa[mi], acc[mi][ni], 0, 0, 0);
        }
        __syncthreads();
    }
#pragma unroll
    for (int mi = 0; mi < 4; ++mi)
#pragma unroll
        for (int ni = 0; ni < 4; ++ni)
            ep(m0 + wr * 64 + mi * 16 + fr, n0 + wc * 64 + ni * 16 + fq * 4, acc[mi][ni]);
}

__device__ __forceinline__ void d_cmp_out(const bf16_t* __restrict__ hid, const float* __restrict__ w2, bf16_t* __restrict__ out, int vb) {
    const int m = vb * 4 + (threadIdx.x >> 6), d = threadIdx.x & 63;
    if (m >= NB * 2 * NCMP) return;
    float a = 0.f;
    for (int j = 0; j < 256; ++j) a += bf2f(hid[(size_t)m * 256 + j]) * w2[j * 64 + d];
    const int bg = m / NCMP, n = m - bg * NCMP;
    out[((size_t)bg * 512 + n) * 64 + d] = f2bf(a);
}

#define KLD 72
#define NSA_OFF_KS   0
#define NSA_OFF_VT   9216
#define NSA_OFF_IMP  18432
#define NSA_OFF_SELW (18432 + 64 * 132 * 4)
#define NSA_OFF_ANYW (NSA_OFF_SELW + 1024)
#define NSA_LDS      (NSA_OFF_ANYW + 16)
#define SM_C 0.18033688011112042f

__device__ __forceinline__ void nsa_stage_load(const bf16_t* kb, size_t ks, const bf16_t* vb, size_t vs, int tid, u32x4 (&rk)[2], u32x4 (&rv)[2]) {
#pragma unroll
    for (int i = 0; i < 2; ++i) {
        const int p = tid + 256 * i, r = p >> 3, c = p & 7;
        rk[i] = *(const u32x4*)(kb + (size_t)r * ks + c * 8);
        rv[i] = *(const u32x4*)(vb + (size_t)r * vs + c * 8);
    }
}
__device__ __forceinline__ void nsa_stage_store(bf16_t* Ks, bf16_t* Vt, int tid, const u32x4 (&rk)[2], const u32x4 (&rv)[2]) {
#pragma unroll
    for (int i = 0; i < 2; ++i) {
        const int p = tid + 256 * i, r = p >> 3, c = p & 7;
        *(u32x4*)(Ks + r * KLD + c * 8) = rk[i];
        bf16_t* vt = Vt + (c * 8) * KLD + r;
        vt[0 * KLD] = (bf16_t)(rv[i].x & 0xffffu); vt[1 * KLD] = (bf16_t)(rv[i].x >> 16);
        vt[2 * KLD] = (bf16_t)(rv[i].y & 0xffffu); vt[3 * KLD] = (bf16_t)(rv[i].y >> 16);
        vt[4 * KLD] = (bf16_t)(rv[i].z & 0xffffu); vt[5 * KLD] = (bf16_t)(rv[i].z >> 16);
        vt[6 * KLD] = (bf16_t)(rv[i].w & 0xffffu); vt[7 * KLD] = (bf16_t)(rv[i].w >> 16);
    }
}
__device__ __forceinline__ void nsa_load_q(const bf16_t* qsrc, size_t ld, int fr, int fq, bf16x8 (&qf)[4][2]) {
#pragma unroll
    for (int tt = 0; tt < 4; ++tt)
#pragma unroll
        for (int ks = 0; ks < 2; ++ks) qf[tt][ks] = *(const bf16x8*)(qsrc + (size_t)(tt * 16 + fr) * ld + ks * 32 + fq * 8);
}
__device__ __forceinline__ void nsa_qk(const bf16_t* Ks, const bf16x8 (&qf)[4][2], f32x4 (&s)[4][4], int fr, int fq) {
#pragma unroll
    for (int kt = 0; kt < 4; ++kt) {
#pragma unroll
        for (int tt = 0; tt < 4; ++tt) s[kt][tt] = (f32x4){0.f, 0.f, 0.f, 0.f};
#pragma unroll
        for (int ks = 0; ks < 2; ++ks) {
            const bf16x8 kf = *(const bf16x8*)(Ks + (kt * 16 + fr) * KLD + ks * 32 + fq * 8);
#pragma unroll
            for (int tt = 0; tt < 4; ++tt) s[kt][tt] = __builtin_amdgcn_mfma_f32_16x16x32_bf16(kf, qf[tt][ks], s[kt][tt], 0, 0, 0);
        }
    }
}
__device__ __forceinline__ void nsa_pv(const bf16_t* Vt, const f32x4 (&p)[4][4], f32x4 (&o)[4][4], int fr, int fq) {
#pragma unroll
    for (int ks2 = 0; ks2 < 2; ++ks2) {
        bf16x8 pf[4];
#pragma unroll
        for (int tt = 0; tt < 4; ++tt) {
            const f32x4 a = p[2 * ks2][tt], b = p[2 * ks2 + 1][tt];
            u32x4 w; w.x = pack2(a.x, a.y); w.y = pack2(a.z, a.w); w.z = pack2(b.x, b.y); w.w = pack2(b.z, b.w);
            pf[tt] = __builtin_bit_cast(bf16x8, w);
        }
#pragma unroll
        for (int dt = 0; dt < 4; ++dt) {
            const bf16_t* vp = Vt + (dt * 16 + fr) * KLD + ks2 * 32 + 4 * fq;
            const u32x2 a0 = *(const u32x2*)vp, a1 = *(const u32x2*)(vp + 16);
            u32x4 w; w.x = a0.x; w.y = a0.y; w.z = a1.x; w.w = a1.y;
            const bf16x8 vf = __builtin_bit_cast(bf16x8, w);
#pragma unroll
            for (int tt = 0; tt < 4; ++tt) o[dt][tt] = __builtin_amdgcn_mfma_f32_16x16x32_bf16(vf, pf[tt], o[dt][tt], 0, 0, 0);
        }
    }
}
template <int MK>
__device__ __forceinline__ bool nsa_valid(int kk, int ti, int n0, int t0) {
    if (MK == 0) return true;
    if (MK == 1) return kk <= ti;
    if (MK == 2) return kk > ti;
    return 16 * (n0 + kk) + 31 <= t0 + ti;
}
template <int MK, bool WITH_O>
__device__ __forceinline__ void nsa_softmax(f32x4 (&s)[4][4], float (&m)[4], float (&l)[4], f32x4 (&o)[4][4], const bool (&selb)[4], int fr, int fq, int n0, int t0) {
#pragma unroll
    for (int tt = 0; tt < 4; ++tt) {
        const int ti = tt * 16 + fr;
        float mx = -1e30f;
#pragma unroll
        for (int kt = 0; kt < 4; ++kt)
#pragma unroll
            for (int jj = 0; jj < 4; ++jj) {
                const int kk = kt * 16 + 4 * fq + jj;
                const bool v = selb[tt] && nsa_valid<MK>(kk, ti, n0, t0);
                const float sv = v ? s[kt][tt][jj] * SM_C : -1e30f;
                s[kt][tt][jj] = sv; mx = fmaxf(mx, sv);
            }
        mx = fmaxf(mx, __shfl_xor(mx, 16)); mx = fmaxf(mx, __shfl_xor(mx, 32));
        const float mn = fmaxf(m[tt], mx);
        const float alpha = __builtin_amdgcn_exp2f(m[tt] - mn);
        m[tt] = mn;
        float ls = 0.f;
#pragma unroll
        for (int kt = 0; kt < 4; ++kt)
#pragma unroll
            for (int jj = 0; jj < 4; ++jj) {
                const float sv = s[kt][tt][jj];
                const float pv = sv > -1e29f ? __builtin_amdgcn_exp2f(sv - mn) : 0.f;
                s[kt][tt][jj] = pv; ls += pv;
            }
        l[tt] = l[tt] * alpha + ls;
        if (WITH_O) {
#pragma unroll
            for (int dt = 0; dt < 4; ++dt) o[dt][tt] *= alpha;
        }
    }
}
__device__ __forceinline__ void nsa_insert(unsigned (&L)[16], unsigned x) {
#pragma unroll
    for (int i = 0; i < 16; ++i) { const unsigned hi = L[i] > x ? L[i] : x; x = L[i] > x ? x : L[i]; L[i] = hi; }
}
template <bool ACCUM>
__device__ __forceinline__ void nsa_emit(const f32x4 (&o)[4][4], const float (&l)[4], bool l_is_partial, const float* gsrc, float* obase, int fr, int fq) {
#pragma unroll
    for (int tt = 0; tt < 4; ++tt) {
        float lt = l[tt];
        if (l_is_partial) { lt += __shfl_xor(lt, 16); lt += __shfl_xor(lt, 32); }
        const float gv = gsrc[(size_t)(tt * 16 + fr) * 32];
        const float sc = l_is_partial ? (lt > 0.f ? gv / lt : 0.f) : gv;
#pragma unroll
        for (int dt = 0; dt < 4; ++dt) {
            float* op = obase + (size_t)(tt * 16 + fr) * 512 + dt * 16 + 4 * fq;
            f32x4 v = o[dt][tt] * sc;
            if (ACCUM) v += *(const f32x4*)op;
            *(f32x4*)op = v;
        }
    }
}

__device__ __forceinline__ void d_nsa_tile(const bf16_t* __restrict__ proj, const bf16_t* __restrict__ qrope, const bf16_t* __restrict__ kc, const bf16_t* __restrict__ vc,
                                           const float* __restrict__ small, float* __restrict__ onsa, int b, int g, int qt, char* lds) {
    bf16_t* Ks = (bf16_t*)(lds + NSA_OFF_KS);
    bf16_t* Vt = (bf16_t*)(lds + NSA_OFF_VT);
    float* imp = (float*)(lds + NSA_OFF_IMP);
    unsigned* selw = (unsigned*)(lds + NSA_OFF_SELW);
    unsigned* anyw = (unsigned*)(lds + NSA_OFF_ANYW);
    const int tid = threadIdx.x, lane = tid & 63, w = tid >> 6, fr = lane & 15, fq = lane >> 4;
    const size_t tok0 = (size_t)b * SEQ + (size_t)qt * 64;
    const int t0 = qt * 64;
    const float* gbase = small + tok0 * 32 + g * 12 + w * 3;
    float* obase = onsa + tok0 * 512 + g * 256 + w * 64;
    const bool sel_all[4] = {true, true, true, true};

    for (int i = tid; i < 64 * 132; i += 256) imp[i] = 0.f;
    if (tid < 4) anyw[tid] = 0u;

    bf16x8 qf[4][2];
    f32x4 s[4][4], o[4][4];
    float m[4], l[4];
    u32x4 rk[2], rv[2];

    nsa_load_q(proj + tok0 * PROJ_LD + C_Q + g * 256 + w * 64, PROJ_LD, fr, fq, qf);
    const int ncb = (4 * qt + 3 + 63) >> 6;
    const bf16_t* kcb = kc + (size_t)(b * 2 + g) * 512 * 64;
    const bf16_t* vcb = vc + (size_t)(b * 2 + g) * 512 * 64;
#pragma unroll
    for (int tt = 0; tt < 4; ++tt) { m[tt] = -1e30f; l[tt] = 0.f; }
    nsa_stage_load(kcb, 64, vcb, 64, tid, rk, rv);
    for (int jc = 0; jc < ncb; ++jc) {
        __syncthreads();
        nsa_stage_store(Ks, Vt, tid, rk, rv);
        __syncthreads();
        if (jc + 1 < ncb) nsa_stage_load(kcb + (size_t)(jc + 1) * 4096, 64, vcb + (size_t)(jc + 1) * 4096, 64, tid, rk, rv);
        nsa_qk(Ks, qf, s, fr, fq);
        nsa_softmax<3, false>(s, m, l, o, sel_all, fr, fq, jc * 64, t0);
    }
    float linv[4];
#pragma unroll
    for (int tt = 0; tt < 4; ++tt) { float lt = l[tt]; lt += __shfl_xor(lt, 16); lt += __shfl_xor(lt, 32); linv[tt] = lt > 0.f ? 1.0f / lt : 0.f; }
#pragma unroll
    for (int dt = 0; dt < 4; ++dt)
#pragma unroll
        for (int tt = 0; tt < 4; ++tt) o[dt][tt] = (f32x4){0.f, 0.f, 0.f, 0.f};
    nsa_stage_load(kcb, 64, vcb, 64, tid, rk, rv);
    for (int jc = 0; jc < ncb; ++jc) {
        __syncthreads();
        nsa_stage_store(Ks, Vt, tid, rk, rv);
        __syncthreads();
        if (jc + 1 < ncb) nsa_stage_load(kcb + (size_t)(jc + 1) * 4096, 64, vcb + (size_t)(jc + 1) * 4096, 64, tid, rk, rv);
        nsa_qk(Ks, qf, s, fr, fq);
#pragma unroll
        for (int tt = 0; tt < 4; ++tt) {
            const int ti = tt * 16 + fr;
#pragma unroll
            for (int kt = 0; kt < 4; ++kt) {
                f32x4 pv;
#pragma unroll
                for (int jj = 0; jj < 4; ++jj) {
                    const int kk = kt * 16 + 4 * fq + jj;
                    const bool v = nsa_valid<3>(kk, ti, jc * 64, t0);
                    pv[jj] = v ? __builtin_amdgcn_exp2f(s[kt][tt][jj] * SM_C - m[tt]) * linv[tt] : 0.f;
                }
                s[kt][tt] = pv;
                const int j = jc * 16 + kt * 4 + fq;
                float* ip = imp + ti * 132 + (j >> 5) * 33 + (j & 31);
                atomicAdd(ip, pv[0] + pv[1] + pv[2] + 0.5f * pv[3]);
                if (j + 1 < 128) { const int j1 = j + 1; atomicAdd(imp + ti * 132 + (j1 >> 5) * 33 + (j1 & 31), 0.5f * pv[3]); }
            }
        }
        nsa_pv(Vt, s, o, fr, fq);
    }
    nsa_emit<false>(o, l, false, gbase + 0, obase, fr, fq);
    __syncthreads();
    {
        const int ti = tid >> 2, q = tid & 3;
        unsigned L[16];
#pragma unroll
        for (int i = 0; i < 16; ++i) L[i] = 0u;
#pragma unroll 4
        for (int i = 0; i < 32; ++i) {
            const int j = q * 32 + i;
            const bool forced = (j == 0) || (j == qt) || (j == qt - 1);
            const float v = imp[ti * 132 + q * 33 + i] + (forced ? 1e4f : 0.f) + 1e-30f;
            const unsigned x = (j <= qt) ? ((__float_as_uint(v) & ~0x7Fu) | (unsigned)(127 - j)) : 0u;
            nsa_insert(L, x);
        }
#pragma unroll
        for (int r = 1; r <= 2; r <<= 1) {
            unsigned P[16];
#pragma unroll
            for (int i = 0; i < 16; ++i) P[i] = (unsigned)__shfl_xor((int)L[i], r);
#pragma unroll
            for (int i = 0; i < 16; ++i) nsa_insert(L, P[i]);
        }
        unsigned word = 0u;
#pragma unroll
        for (int i = 0; i < 16; ++i) {
            const unsigned e = L[i];
            const int j = 127 - (int)(e & 0x7Fu);
            if (e != 0u && (j >> 5) == q) word |= 1u << (j & 31);
        }
        selw[ti * 4 + q] = word;
        atomicOr(&anyw[q], word);
    }
    __syncthreads();
    nsa_load_q(qrope + tok0 * 512 + g * 256 + w * 64, 512, fr, fq, qf);
    const bf16_t* pb = proj + (size_t)b * SEQ * PROJ_LD + g * 64;
    {
#pragma unroll
        for (int tt = 0; tt < 4; ++tt) { m[tt] = -1e30f; l[tt] = 0.f; }
#pragma unroll
        for (int dt = 0; dt < 4; ++dt)
#pragma unroll
            for (int tt = 0; tt < 4; ++tt) o[dt][tt] = (f32x4){0.f, 0.f, 0.f, 0.f};
        const unsigned a0 = __builtin_amdgcn_readfirstlane(anyw[0]), a1 = __builtin_amdgcn_readfirstlane(anyw[1]), a2 = __builtin_amdgcn_readfirstlane(anyw[2]), a3 = __builtin_amdgcn_readfirstlane(anyw[3]);
        int j = 0;
        nsa_stage_load(pb + (size_t)(j * 64) * PROJ_LD + C_KSEL, PROJ_LD, pb + (size_t)(j * 64) * PROJ_LD + C_VSEL, PROJ_LD, tid, rk, rv);
        while (j <= qt) {
            int jn = j + 1;
            while (jn <= qt) { const unsigned wd = jn < 32 ? a0 : jn < 64 ? a1 : jn < 96 ? a2 : a3; if ((wd >> (jn & 31)) & 1u) break; ++jn; }
            __syncthreads();
            nsa_stage_store(Ks, Vt, tid, rk, rv);
            __syncthreads();
            if (jn <= qt) nsa_stage_load(pb + (size_t)(jn * 64) * PROJ_LD + C_KSEL, PROJ_LD, pb + (size_t)(jn * 64) * PROJ_LD + C_VSEL, PROJ_LD, tid, rk, rv);
            nsa_qk(Ks, qf, s, fr, fq);
            bool selb[4];
#pragma unroll
            for (int tt = 0; tt < 4; ++tt) selb[tt] = (selw[(tt * 16 + fr) * 4 + (j >> 5)] >> (j & 31)) & 1u;
            if (j == qt) nsa_softmax<1, true>(s, m, l, o, selb, fr, fq, 0, 0);
            else nsa_softmax<0, true>(s, m, l, o, selb, fr, fq, 0, 0);
            nsa_pv(Vt, s, o, fr, fq);
            j = jn;
        }
        nsa_emit<true>(o, l, true, gbase + 1, obase, fr, fq);
    }
    {
#pragma unroll
        for (int tt = 0; tt < 4; ++tt) { m[tt] = -1e30f; l[tt] = 0.f; }
#pragma unroll
        for (int dt = 0; dt < 4; ++dt)
#pragma unroll
            for (int tt = 0; tt < 4; ++tt) o[dt][tt] = (f32x4){0.f, 0.f, 0.f, 0.f};
        const int j0 = qt >= 8 ? qt - 8 : 0;
        nsa_stage_load(pb + (size_t)(j0 * 64) * PROJ_LD + C_KWIN, PROJ_LD, pb + (size_t)(j0 * 64) * PROJ_LD + C_VWIN, PROJ_LD, tid, rk, rv);
        for (int j = j0; j <= qt; ++j) {
            __syncthreads();
            nsa_stage_store(Ks, Vt, tid, rk, rv);
            __syncthreads();
            if (j + 1 <= qt) nsa_stage_load(pb + (size_t)((j + 1) * 64) * PROJ_LD + C_KWIN, PROJ_LD, pb + (size_t)((j + 1) * 64) * PROJ_LD + C_VWIN, PROJ_LD, tid, rk, rv);
            nsa_qk(Ks, qf, s, fr, fq);
            if (j == qt) nsa_softmax<1, true>(s, m, l, o, sel_all, fr, fq, 0, 0);
            else if (j == qt - 8) nsa_softmax<2, true>(s, m, l, o, sel_all, fr, fq, 0, 0);
            else nsa_softmax<0, true>(s, m, l, o, sel_all, fr, fq, 0, 0);
            nsa_pv(Vt, s, o, fr, fq);
        }
        nsa_emit<true>(o, l, true, gbase + 2, obase, fr, fq);
    }
}

__device__ __forceinline__ void d_ssd(const bf16_t* __restrict__ proj, const float* __restrict__ small, const float* __restrict__ conv_w, const float* __restrict__ conv_b,
                                             const float* __restrict__ a_log, const float* __restrict__ d_skip, float* __restrict__ yssd, int vb, char* lds) {
    float (*sB)[128] = (float (*)[128])lds; float (*sC)[128] = (float (*)[128])(lds + 8192); float* sdt = (float*)(lds + 16384); float* sdA = (float*)(lds + 16384 + 64);
    float (*ypart)[4][64] = (float (*)[4][64])(lds + 16384 + 128);
    const int tid = threadIdx.x, p = tid & 63, nq = tid >> 6;
    const int b = vb >> 3, hh = vb & 7, g = hh >> 2;
    const int ch_bc = tid < 128 ? 512 + g * 128 + tid : 768 + g * 128 + (tid - 128);
    const int ch_x = hh * 64 + p;
    float wbc[4], wx[4];
#pragma unroll
    for (int k = 0; k < 4; ++k) { wbc[k] = conv_w[k * 1024 + ch_bc]; wx[k] = conv_w[k * 1024 + ch_x]; }
    const float bbc = conv_b[ch_bc], bx = conv_b[ch_x];
    const float a = -__expf(a_log[hh]), dsk = d_skip[hh];
    float hb0 = 0.f, hb1 = 0.f, hb2 = 0.f, hx0 = 0.f, hx1 = 0.f, hx2 = 0.f;
    float h[32];
#pragma unroll
    for (int k = 0; k < 32; ++k) h[k] = 0.f;
    const bf16_t* pb = proj + (size_t)b * SEQ * PROJ_LD + C_XBC;
    for (int t0 = 0; t0 < SEQ; t0 += 16) {
        float rbc[16], rx[16];
#pragma unroll
        for (int i = 0; i < 16; ++i) {
            rbc[i] = bf2f(pb[(size_t)(t0 + i) * PROJ_LD + ch_bc]);
            rx[i] = bf2f(pb[(size_t)(t0 + i) * PROJ_LD + ch_x]);
        }
        if (tid < 16) { const float dtv = small[((size_t)b * SEQ + t0 + tid) * 32 + 24 + hh]; sdt[tid] = dtv; sdA[tid] = __expf(dtv * a); }
        float xv[16];
#pragma unroll
        for (int i = 0; i < 16; ++i) {
            const float vb = bbc + wbc[0] * hb0 + wbc[1] * hb1 + wbc[2] * hb2 + wbc[3] * rbc[i];
            hb0 = hb1; hb1 = hb2; hb2 = rbc[i];
            const float sv = silu(vb);
            if (tid < 128) sB[i][tid] = sv; else sC[i][tid - 128] = sv;
            const float vx = bx + wx[0] * hx0 + wx[1] * hx1 + wx[2] * hx2 + wx[3] * rx[i];
            hx0 = hx1; hx1 = hx2; hx2 = rx[i];
            xv[i] = silu(vx);
        }
        __syncthreads();
#pragma unroll
        for (int i = 0; i < 16; ++i) {
            const float dtv = sdt[i], dA = sdA[i], xdt = xv[i] * dtv;
            float yp = 0.f;
#pragma unroll
            for (int k4 = 0; k4 < 8; ++k4) {
                const f32x4 bv = *(const f32x4*)&sB[i][nq * 32 + k4 * 4];
                const f32x4 cv = *(const f32x4*)&sC[i][nq * 32 + k4 * 4];
                h[k4 * 4 + 0] = h[k4 * 4 + 0] * dA + xdt * bv.x; yp += cv.x * h[k4 * 4 + 0];
                h[k4 * 4 + 1] = h[k4 * 4 + 1] * dA + xdt * bv.y; yp += cv.y * h[k4 * 4 + 1];
                h[k4 * 4 + 2] = h[k4 * 4 + 2] * dA + xdt * bv.z; yp += cv.z * h[k4 * 4 + 2];
                h[k4 * 4 + 3] = h[k4 * 4 + 3] * dA + xdt * bv.w; yp += cv.w * h[k4 * 4 + 3];
            }
            if (nq == 0) yp += xv[i] * dsk;
            ypart[i][nq][p] = yp;
        }
        __syncthreads();
#pragma unroll
        for (int k2 = 0; k2 < 4; ++k2) {
            const int i = nq + 4 * k2;
            yssd[((size_t)b * SEQ + t0 + i) * 512 + hh * 64 + p] = ypart[i][0][p] + ypart[i][1][p] + ypart[i][2][p] + ypart[i][3][p];
        }
        __syncthreads();
    }
}

__device__ __forceinline__ void d_mix_prep(const float* __restrict__ onsa, const float* __restrict__ yssd, const bf16_t* __restrict__ proj,
                                                  const float* __restrict__ nsa_w, const float* __restrict__ ssd_w, bf16_t* __restrict__ A2, int vb, char* lds) {
    float (*red)[4] = (float (*)[4])lds;
    const int tid = threadIdx.x; const size_t tok = vb;
    const float o0 = onsa[tok * 512 + tid * 2], o1 = onsa[tok * 512 + tid * 2 + 1];
    const unsigned zz = *(const unsigned*)(proj + tok * PROJ_LD + C_Z + tid * 2);
    const float y0 = yssd[tok * 512 + tid * 2] * silu(bflo(zz)), y1 = yssd[tok * 512 + tid * 2 + 1] * silu(bfhi(zz));
    float s0 = wave_sum(o0 * o0 + o1 * o1), s1 = wave_sum(y0 * y0 + y1 * y1);
    if ((tid & 63) == 0) { red[0][tid >> 6] = s0; red[1][tid >> 6] = s1; }
    __syncthreads();
    const float r0 = rsqrtf((red[0][0] + red[0][1] + red[0][2] + red[0][3]) * (1.0f / 512) + EPS);
    const float r1 = rsqrtf((red[1][0] + red[1][1] + red[1][2] + red[1][3]) * (1.0f / 512) + EPS);
    *(unsigned*)(A2 + tok * DM + tid * 2) = pack2(o0 * r0 * nsa_w[tid * 2], o1 * r0 * nsa_w[tid * 2 + 1]);
    *(unsigned*)(A2 + tok * DM + 512 + tid * 2) = pack2(y0 * r1 * ssd_w[tid * 2], y1 * r1 * ssd_w[tid * 2 + 1]);
}

__device__ __forceinline__ void argmax_bfly(float& bv, int& bi) {
#pragma unroll
    for (int o = 32; o; o >>= 1) {
        const float ov = __shfl_xor(bv, o); const int oi = __shfl_xor(bi, o);
        if (ov > bv || (ov == bv && oi < bi)) { bv = ov; bi = oi; }
    }
}
__device__ __forceinline__ void d_peer_topk(const bf16_t* __restrict__ qp, const float* __restrict__ qnw, const bf16_t* __restrict__ subk, int* __restrict__ eidx, float* __restrict__ gate, int vb, char* lds) {
    float (*sq)[256] = (float (*)[256])lds;
    const int tid = threadIdx.x, lane = tid & 63, wid = tid >> 6;
    const int gw = vb * 4 + wid; const size_t tok = gw >> 3; const int h = gw & 7;
    {
        const u32x2 v = *(const u32x2*)(qp + tok * 2048 + h * 256 + lane * 4);
        const float a0 = bflo(v.x), a1 = bfhi(v.x), a2 = bflo(v.y), a3 = bfhi(v.y);
        const float ss = wave_sum(a0 * a0 + a1 * a1 + a2 * a2 + a3 * a3);
        const float r = rsqrtf(ss * (1.0f / 256) + EPS);
        const f32x4 wv = *(const f32x4*)(qnw + lane * 4);
        *(f32x4*)&sq[wid][lane * 4] = (f32x4){a0 * r * wv.x, a1 * r * wv.y, a2 * r * wv.z, a3 * r * wv.w};
    }
    __syncthreads();
    float sc[2][2];
#pragma unroll
    for (int k = 0; k < 2; ++k)
#pragma unroll
        for (int hf = 0; hf < 2; ++hf) {
            const int n = lane + 64 * hf;
            const bf16_t* kr = subk + ((size_t)(h * 2 + k) * 128 + n) * 128;
            float s = 0.f;
#pragma unroll 4
            for (int c = 0; c < 16; ++c) {
                const u32x4 kv = *(const u32x4*)(kr + c * 8);
                const f32x4 q0 = *(const f32x4*)&sq[wid][k * 128 + c * 8], q1 = *(const f32x4*)&sq[wid][k * 128 + c * 8 + 4];
                s += q0.x * bflo(kv.x) + q0.y * bfhi(kv.x) + q0.z * bflo(kv.y) + q0.w * bfhi(kv.y)
                   + q1.x * bflo(kv.z) + q1.y * bfhi(kv.z) + q1.z * bflo(kv.w) + q1.w * bfhi(kv.w);
            }
            sc[k][hf] = s;
            __builtin_amdgcn_sched_barrier(0);
        }
    float s1v = 0.f, s2v = 0.f; int i1v = 0, i2v = 0;
#pragma unroll
    for (int k = 0; k < 2; ++k) {
        float v0 = sc[k][0], v1 = sc[k][1];
        for (int it = 0; it < 16; ++it) {
            float bv; int bi;
            if (v0 >= v1) { bv = v0; bi = lane; } else { bv = v1; bi = lane + 64; }
            argmax_bfly(bv, bi);
            if (lane == it) { if (k == 0) { s1v = bv; i1v = bi; } else { s2v = bv; i2v = bi; } }
            if (bi == lane) v0 = -3e38f;
            if (bi == lane + 64) v1 = -3e38f;
        }
    }
    float cs[4]; int ci[4];
#pragma unroll
    for (int e = 0; e < 4; ++e) {
        const int a = lane >> 2, bb = (lane & 3) * 4 + e;
        cs[e] = __shfl(s1v, a) + __shfl(s2v, bb);
        ci[e] = __shfl(i1v, a) * 128 + __shfl(i2v, bb);
    }
    float tsv = -3e38f; int tev = 0;
    for (int it = 0; it < 16; ++it) {
        float bv = cs[0]; int bc = lane * 4;
#pragma unroll
        for (int e = 1; e < 4; ++e) if (cs[e] > bv) { bv = cs[e]; bc = lane * 4 + e; }
        argmax_bfly(bv, bc);
        const int owner = bc >> 2, oe = bc & 3;
        int ev = 0;
#pragma unroll
        for (int e = 0; e < 4; ++e) if (oe == e) ev = ci[e];
        ev = __shfl(ev, owner);
        if (lane == it) { tsv = bv; tev = ev; }
        if (lane == owner) {
#pragma unroll
            for (int e = 0; e < 4; ++e) if (oe == e) cs[e] = -3e38f;
        }
    }
    const float mx = wave_max(tsv);
    const float pe = lane < 16 ? __expf(tsv - mx) : 0.f;
    const float sum = wave_sum(pe);
    if (lane < 16) {
        eidx[(tok * 8 + h) * 16 + lane] = tev;
        gate[(tok * 8 + h) * 16 + lane] = pe / sum;
    }
}

__device__ __forceinline__ void d_peer_expert(const bf16_t* __restrict__ h2, const bf16_t* __restrict__ down, const bf16_t* __restrict__ up, const int* __restrict__ eidx,
                                                     const float* __restrict__ gate, const float* __restrict__ mod, const float* __restrict__ fw, float* __restrict__ out, int vb) {
    const int tid = threadIdx.x, lane = tid & 63, wid = tid >> 6;
    const size_t tok = (size_t)vb * 4 + wid; const int b = (int)(tok >> 13);
    float hx[16], acc[16];
    {
        const u32x4 v0 = *(const u32x4*)(h2 + tok * DM + lane * 8), v1 = *(const u32x4*)(h2 + tok * DM + 512 + lane * 8);
        hx[0] = bflo(v0.x); hx[1] = bfhi(v0.x); hx[2] = bflo(v0.y); hx[3] = bfhi(v0.y); hx[4] = bflo(v0.z); hx[5] = bfhi(v0.z); hx[6] = bflo(v0.w); hx[7] = bfhi(v0.w);
        hx[8] = bflo(v1.x); hx[9] = bfhi(v1.x); hx[10] = bflo(v1.y); hx[11] = bfhi(v1.y); hx[12] = bflo(v1.z); hx[13] = bfhi(v1.z); hx[14] = bflo(v1.w); hx[15] = bfhi(v1.w);
    }
#pragma unroll
    for (int e = 0; e < 16; ++e) acc[e] = 0.f;
    const int* ep = eidx + tok * 128; const float* gp = gate + tok * 128;
    for (int j0 = 0; j0 < 128; j0 += 4) {
        u32x4 d0[4], d1[4], u0[4], u1[4]; float gt[4];
#pragma unroll
        for (int jj = 0; jj < 4; ++jj) {
            const int e = __builtin_amdgcn_readfirstlane(ep[j0 + jj]);
            gt[jj] = gp[j0 + jj];
            const bf16_t* dr = down + (size_t)e * DM; const bf16_t* ur = up + (size_t)e * DM;
            d0[jj] = *(const u32x4*)(dr + lane * 8); d1[jj] = *(const u32x4*)(dr + 512 + lane * 8);
            u0[jj] = *(const u32x4*)(ur + lane * 8); u1[jj] = *(const u32x4*)(ur + 512 + lane * 8);
        }
#pragma unroll
        for (int jj = 0; jj < 4; ++jj) {
            float s = hx[0] * bflo(d0[jj].x) + hx[1] * bfhi(d0[jj].x) + hx[2] * bflo(d0[jj].y) + hx[3] * bfhi(d0[jj].y)
                    + hx[4] * bflo(d0[jj].z) + hx[5] * bfhi(d0[jj].z) + hx[6] * bflo(d0[jj].w) + hx[7] * bfhi(d0[jj].w)
                    + hx[8] * bflo(d1[jj].x) + hx[9] * bfhi(d1[jj].x) + hx[10] * bflo(d1[jj].y) + hx[11] * bfhi(d1[jj].y)
                    + hx[12] * bflo(d1[jj].z) + hx[13] * bfhi(d1[jj].z) + hx[14] * bflo(d1[jj].w) + hx[15] * bfhi(d1[jj].w);
            s = wave_sum(s);
            const float a = gelu_tanh(s) * gt[jj];
            acc[0] += a * bflo(u0[jj].x); acc[1] += a * bfhi(u0[jj].x); acc[2] += a * bflo(u0[jj].y); acc[3] += a * bfhi(u0[jj].y);
            acc[4] += a * bflo(u0[jj].z); acc[5] += a * bfhi(u0[jj].z); acc[6] += a * bflo(u0[jj].w); acc[7] += a * bfhi(u0[jj].w);
            acc[8] += a * bflo(u1[jj].x); acc[9] += a * bfhi(u1[jj].x); acc[10] += a * bflo(u1[jj].y); acc[11] += a * bfhi(u1[jj].y);
            acc[12] += a * bflo(u1[jj].z); acc[13] += a * bfhi(u1[jj].z); acc[14] += a * bflo(u1[jj].w); acc[15] += a * bfhi(u1[jj].w);
        }
    }
    float x2[16]; float ss = 0.f;
#pragma unroll
    for (int hf = 0; hf < 2; ++hf)
#pragma unroll
        for (int q4 = 0; q4 < 2; ++q4) {
            const int col = hf * 512 + lane * 8 + q4 * 4;
            const f32x4 xv = *(const f32x4*)(out + tok * DM + col);
            const f32x4 g2 = *(const f32x4*)(mod + b * 6144 + 5120 + col);
            const int e0 = hf * 8 + q4 * 4;
            x2[e0 + 0] = xv.x + g2.x * acc[e0 + 0]; x2[e0 + 1] = xv.y + g2.y * acc[e0 + 1]; x2[e0 + 2] = xv.z + g2.z * acc[e0 + 2]; x2[e0 + 3] = xv.w + g2.w * acc[e0 + 3];
            ss += x2[e0] * x2[e0] + x2[e0 + 1] * x2[e0 + 1] + x2[e0 + 2] * x2[e0 + 2] + x2[e0 + 3] * x2[e0 + 3];
        }
    ss = wave_sum(ss);
    const float r = rsqrtf(ss * (1.0f / DM) + EPS);
#pragma unroll
    for (int hf = 0; hf < 2; ++hf)
#pragma unroll
        for (int q4 = 0; q4 < 2; ++q4) {
            const int col = hf * 512 + lane * 8 + q4 * 4;
            const f32x4 w = *(const f32x4*)(fw + col);
            const int e0 = hf * 8 + q4 * 4;
            *(f32x4*)(out + tok * DM + col) = (f32x4){x2[e0] * r * w.x, x2[e0 + 1] * r * w.y, x2[e0 + 2] * r * w.z, x2[e0 + 3] * r * w.w};
        }
}

struct Params {
    const float *x, *c, *w_ada, *b_ada, *norm1_w, *w_in, *cmp_pe_k, *cmp_pe_v, *cmp_w1_k, *cmp_w2_k, *cmp_w1_v, *cmp_w2_v, *nsa_norm_w, *conv_w, *conv_b, *dt_bias, *a_log, *d_skip,
        *ssd_norm_w, *w_out, *norm2_w, *peer_wq, *peer_qnorm_w, *peer_sub_keys, *peer_down, *peer_up, *final_norm_w;
    float* out; char* ws;
};
#define LDS_BYTES 53504

__global__ __launch_bounds__(256, 1) void mega(Params p) {
    __shared__ __attribute__((aligned(16))) char lds[LDS_BYTES];
    __shared__ int s_vb;
    cg::grid_group grid = cg::this_grid();
    const int G = gridDim.x, bid = blockIdx.x;
    char* ws = p.ws;
    float* mod = (float*)(ws + OFF_MOD);
    float2* rope = (float2*)(ws + OFF_ROPE);
    float* bias1 = (float*)(ws + OFF_BIAS1);
    bf16_t* win_t = (bf16_t*)(ws + OFF_WIN_T);
    bf16_t* wout_t = (bf16_t*)(ws + OFF_WOUT_T);
    bf16_t* wq_t = (bf16_t*)(ws + OFF_WQ_T);
    bf16_t* subk = (bf16_t*)(ws + OFF_SUBK);
    bf16_t* w1k_t = (bf16_t*)(ws + OFF_W1K_T);
    bf16_t* w1v_t = (bf16_t*)(ws + OFF_W1V_T);
    bf16_t* kc = (bf16_t*)(ws + OFF_KC);
    bf16_t* vc = (bf16_t*)(ws + OFF_VC);
    bf16_t* hidk = (bf16_t*)(ws + OFF_HIDK);
    bf16_t* hidv = (bf16_t*)(ws + OFF_HIDV);
    bf16_t* down = (bf16_t*)(ws + OFF_DOWN);
    bf16_t* up = (bf16_t*)(ws + OFF_UP);
    float* small = (float*)(ws + OFF_SMALL);
    bf16_t* hbuf = (bf16_t*)(ws + OFF_H);
    bf16_t* proj = (bf16_t*)(ws + OFF_PROJ);
    bf16_t* qrope = (bf16_t*)(ws + OFF_QROPE);
    float* onsa = (float*)(ws + OFF_ONSA);
    float* yssd = (float*)(ws + OFF_YSSD);
    int* eidx = (int*)(ws + OFF_EIDX);
    float* gate = (float*)(ws + OFF_GATE);
    unsigned* ctr = (unsigned*)(ws + OFF_CTR);

    if (bid == 0 && threadIdx.x == 0) ctr[0] = 0u;
    for (int vb = bid; vb < 11618; vb += G) {
        int v = vb;
        if (v < 2944) { d_transpose_w(p.w_in, win_t, 1024, 2848, 1, v % 92, v / 92, lds); }
        else if ((v -= 2944) < 1024) { d_transpose_w(p.w_out, wout_t, 1024, 1024, 0, v & 31, v >> 5, lds); }
        else if ((v -= 1024) < 2048) { d_transpose_w(p.peer_wq, wq_t, 1024, 2048, 0, v & 63, v >> 6, lds); }
        else if ((v -= 2048) < 512) { d_transpose_w(p.cmp_w1_k, w1k_t, 2048, 256, 0, v & 7, v >> 3, lds); }
        else if ((v -= 512) < 512) { d_transpose_w(p.cmp_w1_v, w1v_t, 2048, 256, 0, v & 7, v >> 3, lds); }
        else if ((v -= 512) < 2048) { d_convert_bf16(p.peer_down, down, (size_t)16384 * 1024 / 8, v, 2048); }
        else if ((v -= 2048) < 2048) { d_convert_bf16(p.peer_up, up, (size_t)16384 * 1024 / 8, v, 2048); }
        else if ((v -= 2048) < 128) { d_convert_bf16(p.peer_sub_keys, subk, (size_t)8 * 2 * 128 * 128 / 8, v, 128); }
        else if ((v -= 128) < 96) { d_mod(p.c, p.w_ada, p.b_ada, mod, v, lds); }
        else if ((v -= 96) < 256) { d_rope_table(rope, v); }
        else { v -= 256; d_bias1(p.cmp_pe_k, p.cmp_w1_k, p.cmp_pe_v, p.cmp_w1_v, bias1, v); }
        __syncthreads();
    }
    grid.sync();
    for (int vb = bid; vb < NTOK; vb += G) { d_norm_mod(p.x, p.norm1_w, mod, 0, 1024, hbuf, vb, lds); __syncthreads(); }
    grid.sync();
    {
        const ALoadPlain al{hbuf, DM, 0}; const EpInProj ep{proj, qrope, small, rope, p.dt_bias};
        for (int vb = bid; vb < (NTOK / 128) * (NIN_PAD / 128); vb += G) d_gemm(al, win_t, 1024, NIN_PAD / 128, ep, vb, lds);
    }
    grid.sync();
    for (int vb = bid; vb < 256; vb += G) {
        if (vb < 128) { const ALoadCmp al{proj, C_KCMP, 0}; const EpCmpHid ep{hidk, bias1}; d_gemm(al, w1k_t, 2048, 2, ep, vb, lds); }
        else { const ALoadCmp al{proj, C_VCMP, 0}; const EpCmpHid ep{hidv, bias1 + 256}; d_gemm(al, w1v_t, 2048, 2, ep, vb - 128, lds); }
    }
    grid.sync();
    for (int vb = bid; vb < 2 * 2044; vb += G) {
        if (vb < 2044) d_cmp_out(hidk, p.cmp_w2_k, kc, vb); else d_cmp_out(hidv, p.cmp_w2_v, vc, vb - 2044);
    }
    grid.sync();
    for (int vb = bid; vb < 64; vb += G) { d_ssd(proj, small, p.conv_w, p.conv_b, p.a_log, p.d_skip, yssd, vb, lds); __syncthreads(); }
    for (;;) {
        if (threadIdx.x == 0) s_vb = (int)atomicAdd(&ctr[0], 1u);
        __syncthreads();
        const int i = s_vb;
        __syncthreads();
        if (i >= NB * 2 * 128) break;
        const int qt = 127 - (i >> 4), bg = i & 15;
        d_nsa_tile(proj, qrope, kc, vc, small, onsa, bg >> 1, bg & 1, qt, lds);
        __syncthreads();
    }
    grid.sync();
    for (int vb = bid; vb < NTOK; vb += G) { d_mix_prep(onsa, yssd, proj, p.nsa_norm_w, p.ssd_norm_w, hbuf, vb, lds); __syncthreads(); }
    grid.sync();
    {
        const ALoadPlain al{hbuf, DM, 0}; const EpOutProj ep{p.x, mod, p.out};
        for (int vb = bid; vb < (NTOK / 128) * 8; vb += G) d_gemm(al, wout_t, 1024, 8, ep, vb, lds);
    }
    grid.sync();
    for (int vb = bid; vb < NTOK; vb += G) { d_norm_mod(p.out, p.norm2_w, mod, 3072, 4096, hbuf, vb, lds); __syncthreads(); }
    grid.sync();
    {
        const ALoadPlain al{hbuf, DM, 0}; const EpStoreBf16 ep{proj, 2048, 0};
        for (int vb = bid; vb < (NTOK / 128) * 16; vb += G) d_gemm(al, wq_t, 1024, 16, ep, vb, lds);
    }
    grid.sync();
    for (int vb = bid; vb < NTOK * 2; vb += G) { d_peer_topk(proj, p.peer_qnorm_w, subk, eidx, gate, vb, lds); __syncthreads(); }
    grid.sync();
    for (int vb = bid; vb < NTOK / 4; vb += G) d_peer_expert(hbuf, down, up, eidx, gate, mod, p.final_norm_w, p.out, vb);
}

extern "C" void kernel_launch(void* const* d_in, const int* in_sizes, int n_in, void* d_out, int out_size, void* d_ws, size_t ws_size, hipStream_t stream) {
    if (ws_size < WS_NEED) { fprintf(stderr, "workspace too small\n"); return; }
    static int grid_blocks = 0;
    if (!grid_blocks) {
        int dev = 0, cus = 0, per_cu = 0;
        hipGetDevice(&dev);
        hipDeviceGetAttribute(&cus, hipDeviceAttributeMultiprocessorCount, dev);
        hipOccupancyMaxActiveBlocksPerMultiprocessor(&per_cu, mega, 256, 0);
        if (per_cu > 1) per_cu = 1;
        if (per_cu < 1) per_cu = 1;
        grid_blocks = cus * per_cu;
    }
    Params p{};
    const float** pp = (const float**)&p;
    for (int i = 0; i < 27; ++i) pp[i] = (const float*)d_in[i];
    p.out = (float*)d_out; p.ws = (char*)d_ws;
    void* args[] = {&p};
    hipError_t e = hipLaunchCooperativeKernel((void*)mega, dim3(grid_blocks), dim3(256), args, 0, stream);
    if (e != hipSuccess) fprintf(stderr, "cooperative launch failed: %s (grid %d)\n", hipGetErrorString(e), grid_blocks);
}
```

```cpp
#include <hip/hip_runtime.h>
#include <hip/hip_cooperative_groups.h>
#include <stdint.h>
#include <cstdio>
namespace cg = cooperative_groups;

typedef unsigned short bf16_t;
typedef short bf16x8 __attribute__((ext_vector_type(8)));
typedef float f32x4 __attribute__((ext_vector_type(4)));
typedef unsigned u32x4 __attribute__((ext_vector_type(4)));
typedef unsigned u32x2 __attribute__((ext_vector_type(2)));
typedef float f32x2 __attribute__((ext_vector_type(2)));

#define NB 8
#define SEQ 8192
#define NTOK 65536
#define DM 1024
#define PROJ_LD 2816
#define NIN_PAD 2944
#define C_Q 0
#define C_KCMP 512
#define C_VCMP 640
#define C_KSEL 768
#define C_VSEL 896
#define C_KWIN 1024
#define C_VWIN 1152
#define C_Z 1280
#define C_XBC 1792
#define NCMP 511
#define EPS 1e-6f

#define OFF_MOD    ((size_t)0)
#define OFF_ROPE   ((size_t)1 << 20)
#define OFF_BIAS1  ((size_t)2 << 20)
#define OFF_WIN_T  ((size_t)3 << 20)
#define OFF_WOUT_T ((size_t)9 << 20)
#define OFF_WQ_T   ((size_t)11 << 20)
#define OFF_SUBK   ((size_t)15 << 20)
#define OFF_W1K_T  ((size_t)16 << 20)
#define OFF_W1V_T  ((size_t)17 << 20)
#define OFF_KC     ((size_t)18 << 20)
#define OFF_VC     ((size_t)19 << 20)
#define OFF_HIDK   ((size_t)20 << 20)
#define OFF_HIDV   ((size_t)24 << 20)
#define OFF_DOWN   ((size_t)28 << 20)
#define OFF_UP     ((size_t)60 << 20)
#define OFF_SMALL  ((size_t)92 << 20)
#define OFF_H      ((size_t)100 << 20)
#define OFF_PROJ   ((size_t)228 << 20)
#define OFF_QROPE  ((size_t)580 << 20)
#define OFF_ONSA   ((size_t)644 << 20)
#define OFF_YSSD   ((size_t)772 << 20)
#define OFF_EIDX   ((size_t)900 << 20)
#define OFF_GATE   ((size_t)932 << 20)
#define OFF_CTR    ((size_t)964 << 20)
#define WS_NEED    ((size_t)965 << 20)

__device__ __forceinline__ bf16_t f2bf(float f) { unsigned u = __float_as_uint(f); u += 0x7fffu + ((u >> 16) & 1u); return (bf16_t)(u >> 16); }
__device__ __forceinline__ float bf2f(bf16_t h) { return __uint_as_float(((unsigned)h) << 16); }
__device__ __forceinline__ float bflo(unsigned u) { return __uint_as_float(u << 16); }
__device__ __forceinline__ float bfhi(unsigned u) { return __uint_as_float(u & 0xffff0000u); }
__device__ __forceinline__ unsigned pack2(float a, float b) { return (unsigned)f2bf(a) | ((unsigned)f2bf(b) << 16); }
__device__ __forceinline__ float wave_sum(float v) {
#pragma unroll
    for (int o = 32; o; o >>= 1) v += __shfl_xor(v, o);
    return v;
}
__device__ __forceinline__ float wave_max(float v) {
#pragma unroll
    for (int o = 32; o; o >>= 1) v = fmaxf(v, __shfl_xor(v, o));
    return v;
}
__device__ __forceinline__ float gelu_tanh(float x) { return 0.5f * x * (1.0f + tanhf(0.7978845608028654f * (x + 0.044715f * x * x * x))); }
__device__ __forceinline__ float silu(float x) { return x / (1.0f + __expf(-x)); }
__device__ __forceinline__ float sigmoidf(float x) { return 1.0f / (1.0f + __expf(-x)); }
__device__ __forceinline__ float softplusf(float x) { return x > 20.f ? x : log1pf(__expf(x)); }

__device__ __forceinline__ int inproj_src(int n) {
    if (n < 1280) return n;
    if (n < 1792) return 1304 + (n - 1280);
    if (n < 2816) return 1816 + (n - 1792);
    if (n < 2840) return 1280 + (n - 2816);
    if (n < 2848) return 2840 + (n - 2840);
    return -1;
}
__device__ __forceinline__ void d_transpose_w(const float* __restrict__ W, bf16_t* __restrict__ Wt, int K, int N, int mode, int bx, int by, char* lds) {
    float (*t)[33] = (float (*)[33])lds;
    const int n0 = bx * 32, k0 = by * 32, tx = threadIdx.x & 31, ty = threadIdx.x >> 5;
#pragma unroll
    for (int i = 0; i < 4; ++i) {
        const int k = k0 + ty + 8 * i, n = n0 + tx;
        const int src = mode == 1 ? inproj_src(n) : n;
        t[ty + 8 * i][tx] = (src >= 0 && src < N) ? W[(size_t)k * N + src] : 0.f;
    }
    __syncthreads();
#pragma unroll
    for (int i = 0; i < 4; ++i) Wt[(size_t)(n0 + ty + 8 * i) * K + k0 + tx] = f2bf(t[tx][ty + 8 * i]);
}
__device__ __forceinline__ void d_convert_bf16(const float* __restrict__ in, bf16_t* __restrict__ out, size_t n8, int vb, int nvb) {
    size_t i = (size_t)vb * 256 + threadIdx.x;
    const size_t stride = (size_t)nvb * 256;
    for (; i < n8; i += stride) {
        const f32x4 a = ((const f32x4*)in)[2 * i], b = ((const f32x4*)in)[2 * i + 1];
        u32x4 o; o.x = pack2(a.x, a.y); o.y = pack2(a.z, a.w); o.z = pack2(b.x, b.y); o.w = pack2(b.z, b.w);
        ((u32x4*)out)[i] = o;
    }
}
__device__ __forceinline__ void d_mod(const float* __restrict__ c, const float* __restrict__ w_ada, const float* __restrict__ b_ada, float* __restrict__ mod, int vb, char* lds) {
    float (*part)[8][64] = (float (*)[8][64])lds;
    const int tid = threadIdx.x, jl = tid & 63, kq = tid >> 6, j = vb * 64 + jl;
    float acc[8];
#pragma unroll
    for (int b = 0; b < 8; ++b) acc[b] = 0.f;
    for (int k = kq * 256; k < kq * 256 + 256; ++k) {
        const float w = w_ada[(size_t)k * 6144 + j];
#pragma unroll
        for (int b = 0; b < 8; ++b) acc[b] += c[b * 1024 + k] * w;
    }
#pragma unroll
    for (int b = 0; b < 8; ++b) part[kq][b][jl] = acc[b];
    __syncthreads();
    for (int i = tid; i < 512; i += 256) {
        const int b = i >> 6, jj = i & 63;
        mod[b * 6144 + vb * 64 + jj] = part[0][b][jj] + part[1][b][jj] + part[2][b][jj] + part[3][b][jj] + b_ada[vb * 64 + jj];
    }
}
__device__ __forceinline__ void d_rope_table(float2* __restrict__ rope, int vb) {
    const int i = vb * 256 + threadIdx.x;
    if (i >= SEQ * 8) return;
    const int pos = i >> 3, f = i & 7;
    const double inv = pow(500000.0, -(double)f / 8.0);
    const double ang = (double)pos * inv;
    rope[i] = make_float2((float)cos(ang), (float)sin(ang));
}
__device__ __forceinline__ void d_bias1(const float* __restrict__ pe_k, const float* __restrict__ w1_k, const float* __restrict__ pe_v, const float* __restrict__ w1_v, float* __restrict__ bias1, int vb) {
    const int which = vb, j = threadIdx.x;
    const float* pe = which ? pe_v : pe_k; const float* w1 = which ? w1_v : w1_k;
    float a = 0.f;
    for (int k = 0; k < 2048; ++k) a += pe[k] * w1[(size_t)k * 256 + j];
    bias1[which * 256 + j] = a;
}

__device__ __forceinline__ void d_norm_mod(const float* __restrict__ x, const float* __restrict__ w, const float* __restrict__ mod, int sh_off, int sc_off, bf16_t* __restrict__ out, int vb, char* lds) {
    float* red = (float*)lds;
    const int row = vb, tid = threadIdx.x, b = row >> 13;
    const f32x4 v = ((const f32x4*)(x + (size_t)row * DM))[tid];
    float ss = v.x * v.x + v.y * v.y + v.z * v.z + v.w * v.w;
    ss = wave_sum(ss);
    if ((tid & 63) == 0) red[tid >> 6] = ss;
    __syncthreads();
    const float r = rsqrtf((red[0] + red[1] + red[2] + red[3]) * (1.0f / DM) + EPS);
    const f32x4 wv = ((const f32x4*)w)[tid];
    const f32x4 sc = ((const f32x4*)(mod + b * 6144 + sc_off))[tid];
    const f32x4 sh = ((const f32x4*)(mod + b * 6144 + sh_off))[tid];
    u32x2 o;
    o.x = pack2(v.x * r * wv.x * (1.f + sc.x) + sh.x, v.y * r * wv.y * (1.f + sc.y) + sh.y);
    o.y = pack2(v.z * r * wv.z * (1.f + sc.z) + sh.z, v.w * r * wv.w * (1.f + sc.w) + sh.w);
    ((u32x2*)(out + (size_t)row * DM))[tid] = o;
}

#define GLD 72
struct ALoadPlain { const bf16_t* A; int lda; int pad;
    __device__ __forceinline__ const bf16_t* operator()(int row, int k) const { return A + (size_t)row * lda + k; } };
struct ALoadCmp { const bf16_t* proj; int coloff; int pad;
    __device__ __forceinline__ const bf16_t* operator()(int row, int k) const {
        if (row > NB * 2 * NCMP - 1) row = NB * 2 * NCMP - 1;
        const int bg = row / NCMP, n = row - bg * NCMP, b = bg >> 1, g = bg & 1, tok = k >> 6, d = k & 63;
        return proj + (size_t)(b * SEQ + 16 * n + tok) * PROJ_LD + coloff + g * 64 + d; } };

struct EpInProj { bf16_t* proj; bf16_t* qrope; float* small; const float2* rope; const float* dt_bias;
    __device__ __forceinline__ void operator()(int m, int n0, f32x4 v) const {
        if (n0 < 2816) {
            const bool is_q = n0 < 512;
            const bool roped_seg = is_q || (n0 >= C_KSEL && n0 < C_VSEL) || (n0 >= C_KWIN && n0 < C_VWIN);
            const bool rope_dims = roped_seg && ((n0 & 63) < 16);
            u32x2 raw; raw.x = pack2(v.x, v.y); raw.y = pack2(v.z, v.w);
            if (is_q) *(u32x2*)(proj + (size_t)m * PROJ_LD + n0) = raw;
            if (rope_dims) {
                f32x4 p; p.x = __shfl_xor(v.x, 32); p.y = __shfl_xor(v.y, 32); p.z = __shfl_xor(v.z, 32); p.w = __shfl_xor(v.w, 32);
                const int i0 = n0 & 15, pos = m & (SEQ - 1);
                const float sgn = i0 < 8 ? -1.f : 1.f;
                const float2* rp = rope + pos * 8 + (i0 & 7);
                const float2 c0 = rp[0], c1 = rp[1], c2 = rp[2], c3 = rp[3];
                v.x = v.x * c0.x + sgn * p.x * c0.y; v.y = v.y * c1.x + sgn * p.y * c1.y;
                v.z = v.z * c2.x + sgn * p.z * c2.y; v.w = v.w * c3.x + sgn * p.w * c3.y;
            }
            u32x2 o; o.x = pack2(v.x, v.y); o.y = pack2(v.z, v.w);
            if (is_q) *(u32x2*)(qrope + (size_t)m * 512 + n0) = o;
            else *(u32x2*)(proj + (size_t)m * PROJ_LD + n0) = o;
        } else if (n0 < 2848) {
            const int c = n0 - 2816; f32x4 o;
            if (c < 24) { o.x = sigmoidf(v.x); o.y = sigmoidf(v.y); o.z = sigmoidf(v.z); o.w = sigmoidf(v.w); }
            else { const float* db = dt_bias + (c - 24); o.x = softplusf(v.x + db[0]); o.y = softplusf(v.y + db[1]); o.z = softplusf(v.z + db[2]); o.w = softplusf(v.w + db[3]); }
            *(f32x4*)(small + (size_t)m * 32 + c) = o;
        }
    } };
struct EpCmpHid { bf16_t* hid; const float* bias;
    __device__ __forceinline__ void operator()(int m, int n0, f32x4 v) const {
        if (m >= NB * 2 * NCMP) return;
        const f32x4 b = *(const f32x4*)(bias + n0);
        u32x2 o; o.x = pack2(gelu_tanh(v.x + b.x), gelu_tanh(v.y + b.y)); o.y = pack2(gelu_tanh(v.z + b.z), gelu_tanh(v.w + b.w));
        *(u32x2*)(hid + (size_t)m * 256 + n0) = o;
    } };
struct EpOutProj { const float* x; const float* mod; float* x1;
    __device__ __forceinline__ void operator()(int m, int n0, f32x4 v) const {
        const int b = m >> 13;
        const f32x4 xv = *(const f32x4*)(x + (size_t)m * DM + n0);
        const f32x4 g = *(const f32x4*)(mod + b * 6144 + 2048 + n0);
        f32x4 o; o.x = xv.x + g.x * v.x; o.y = xv.y + g.y * v.y; o.z = xv.z + g.z * v.z; o.w = xv.w + g.w * v.w;
        *(f32x4*)(x1 + (size_t)m * DM + n0) = o;
    } };
struct EpStoreBf16 { bf16_t* out; int ld; int pad;
    __device__ __forceinline__ void operator()(int m, int n0, f32x4 v) const {
        u32x2 o; o.x = pack2(v.x, v.y); o.y = pack2(v.z, v.w);
        *(u32x2*)(out + (size_t)m * ld + n0) = o;
    } };

template <class AL, class EP>
__device__ __forceinline__ void d_gemm(const AL& al, const bf16_t* __restrict__ Bt, int K, int ntn, const EP& ep, int vb, char* lds) {
    bf16_t* sA = (bf16_t*)lds;
    bf16_t* sB = (bf16_t*)lds + 128 * GLD;
    const int tid = threadIdx.x, lane = tid & 63, wid = tid >> 6, wr = wid >> 1, wc = wid & 1, fr = lane & 15, fq = lane >> 4;
    const int tile_m = vb / ntn, tile_n = vb - tile_m * ntn;
    const int m0 = tile_m * 128, n0 = tile_n * 128;
    const int lr = tid >> 3, lk = (tid & 7) * 8;
    f32x4 acc[4][4];
#pragma unroll
    for (int i = 0; i < 4; ++i)
#pragma unroll
        for (int j = 0; j < 4; ++j) acc[i][j] = (f32x4){0.f, 0.f, 0.f, 0.f};
    u32x4 ra[4], rb[4];
#pragma unroll
    for (int i = 0; i < 4; ++i) {
        ra[i] = *(const u32x4*)al(m0 + lr + 32 * i, lk);
        rb[i] = *(const u32x4*)(Bt + (size_t)(n0 + lr + 32 * i) * K + lk);
    }
    const int nk = K / 64;
    for (int kt = 0; kt < nk; ++kt) {
#pragma unroll
        for (int i = 0; i < 4; ++i) {
            *(u32x4*)(sA + (lr + 32 * i) * GLD + lk) = ra[i];
            *(u32x4*)(sB + (lr + 32 * i) * GLD + lk) = rb[i];
        }
        __syncthreads();
        if (kt + 1 < nk) {
            const int k0 = (kt + 1) * 64;
#pragma unroll
            for (int i = 0; i < 4; ++i) {
                ra[i] = *(const u32x4*)al(m0 + lr + 32 * i, k0 + lk);
                rb[i] = *(const u32x4*)(Bt + (size_t)(n0 + lr + 32 * i) * K + k0 + lk);
            }
        }
#pragma unroll
        for (int ks = 0; ks < 2; ++ks) {
            bf16x8 fa[4], fb[4];
#pragma unroll
            for (int i = 0; i < 4; ++i) {
                fa[i] = *(const bf16x8*)(sA + (wr * 64 + i * 16 + fr) * GLD + ks * 32 + fq * 8);
                fb[i] = *(const bf16x8*)(sB + (wc * 64 + i * 16 + fr) * GLD + ks * 32 + fq * 8);
            }
#pragma unroll
            for (int mi = 0; mi < 4; ++mi)
#pragma unroll
                for (int ni = 0; ni < 4; ++ni)
                    acc[mi][ni] = __builtin_amdgcn_mfma_f32_16x16x32_bf16(fb[ni], fa[mi], acc[mi][ni], 0, 0, 0);
        }
        __syncthreads();
    }
#pragma unroll
    for (int mi = 0; mi < 4; ++mi)
#pragma unroll
        for (int ni = 0; ni < 4; ++ni)
            ep(m0 + wr * 64 + mi * 16 + fr, n0 + wc * 64 + ni * 16 + fq * 4, acc[mi][ni]);
}

__device__ __forceinline__ void d_cmp_out(const bf16_t* __restrict__ hid, const float* __restrict__ w2, bf16_t* __restrict__ out, int vb) {
    const int m = vb * 4 + (threadIdx.x >> 6), d = threadIdx.x & 63;
    if (m >= NB * 2 * NCMP) return;
    float a = 0.f;
    for (int j = 0; j < 256; ++j) a += bf2f(hid[(size_t)m * 256 + j]) * w2[j * 64 + d];
    const int bg = m / NCMP, n = m - bg * NCMP;
    out[((size_t)bg * 512 + n) * 64 + d] = f2bf(a);
}

#define KLD 72
#define NSA_OFF_KS   0
#define NSA_OFF_VT   9216
#define NSA_OFF_IMP  18432
#define NSA_OFF_SELW (18432 + 64 * 132 * 4)
#define NSA_OFF_ANYW (NSA_OFF_SELW + 1024)
#define NSA_LDS      (NSA_OFF_ANYW + 16)
#define SM_C 0.18033688011112042f

__device__ __forceinline__ void nsa_stage_load(const bf16_t* kb, size_t ks, const bf16_t* vb, size_t vs, int tid, u32x4 (&rk)[2], u32x4 (&rv)[2]) {
#pragma unroll
    for (int i = 0; i < 2; ++i) {
        const int p = tid + 256 * i, r = p >> 3, c = p & 7;
        rk[i] = *(const u32x4*)(kb + (size_t)r * ks + c * 8);
        rv[i] = *(const u32x4*)(vb + (size_t)r * vs + c * 8);
    }
}
__device__ __forceinline__ void nsa_stage_store(bf16_t* Ks, bf16_t* Vt, int tid, const u32x4 (&rk)[2], const u32x4 (&rv)[2]) {
#pragma unroll
    for (int i = 0; i < 2; ++i) {
        const int p = tid + 256 * i, r = p >> 3, c = p & 7;
        *(u32x4*)(Ks + r * KLD + c * 8) = rk[i];
        bf16_t* vt = Vt + (c * 8) * KLD + r;
        vt[0 * KLD] = (bf16_t)(rv[i].x & 0xffffu); vt[1 * KLD] = (bf16_t)(rv[i].x >> 16);
        vt[2 * KLD] = (bf16_t)(rv[i].y & 0xffffu); vt[3 * KLD] = (bf16_t)(rv[i].y >> 16);
        vt[4 * KLD] = (bf16_t)(rv[i].z & 0xffffu); vt[5 * KLD] = (bf16_t)(rv[i].z >> 16);
        vt[6 * KLD] = (bf16_t)(rv[i].w & 0xffffu); vt[7 * KLD] = (bf16_t)(rv[i].w >> 16);
    }
}
__device__ __forceinline__ void nsa_load_q(const bf16_t* qsrc, size_t ld, int fr, int fq, bf16x8 (&qf)[4][2]) {
#pragma unroll
    for (int tt = 0; tt < 4; ++tt)
#pragma unroll
        for (int ks = 0; ks < 2; ++ks) qf[tt][ks] = *(const bf16x8*)(qsrc + (size_t)(tt * 16 + fr) * ld + ks * 32 + fq * 8);
}
__device__ __forceinline__ void nsa_qk(const bf16_t* Ks, const bf16x8 (&qf)[4][2], f32x4 (&s)[4][4], int fr, int fq) {
#pragma unroll
    for (int kt = 0; kt < 4; ++kt) {
#pragma unroll
        for (int tt = 0; tt < 4; ++tt) s[kt][tt] = (f32x4){0.f, 0.f, 0.f, 0.f};
#pragma unroll
        for (int ks = 0; ks < 2; ++ks) {
            const bf16x8 kf = *(const bf16x8*)(Ks + (kt * 16 + fr) * KLD + ks * 32 + fq * 8);
#pragma unroll
            for (int tt = 0; tt < 4; ++tt) s[kt][tt] = __builtin_amdgcn_mfma_f32_16x16x32_bf16(kf, qf[tt][ks], s[kt][tt], 0, 0, 0);
        }
    }
}
__device__ __forceinline__ void nsa_pv(const bf16_t* Vt, const f32x4 (&p)[4][4], f32x4 (&o)[4][4], int fr, int fq) {
#pragma unroll
    for (int ks2 = 0; ks2 < 2; ++ks2) {
        bf16x8 pf[4];
#pragma unroll
        for (int tt = 0; tt < 4; ++tt) {
            const f32x4 a = p[2 * ks2][tt], b = p[2 * ks2 + 1][tt];
            u32x4 w; w.x = pack2(a.x, a.y); w.y = pack2(a.z, a.w); w.z = pack2(b.x, b.y); w.w = pack2(b.z, b.w);
            pf[tt] = __builtin_bit_cast(bf16x8, w);
        }
#pragma unroll
        for (int dt = 0; dt < 4; ++dt) {
            const bf16_t* vp = Vt + (dt * 16 + fr) * KLD + ks2 * 32 + 4 * fq;
            const u32x2 a0 = *(const u32x2*)vp, a1 = *(const u32x2*)(vp + 16);
            u32x4 w; w.x = a0.x; w.y = a0.y; w.z = a1.x; w.w = a1.y;
            const bf16x8 vf = __builtin_bit_cast(bf16x8, w);
#pragma unroll
            for (int tt = 0; tt < 4; ++tt) o[dt][tt] = __builtin_amdgcn_mfma_f32_16x16x32_bf16(vf, pf[tt], o[dt][tt], 0, 0, 0);
        }
    }
}
template <int MK>
__device__ __forceinline__ bool nsa_valid(int kk, int ti, int n0, int t0) {
    if (MK == 0) return true;
    if (MK == 1) return kk <= ti;
    if (MK == 2) return kk > ti;
    return 16 * (n0 + kk) + 31 <= t0 + ti;
}
template <int MK, bool WITH_O>
__device__ __forceinline__ void nsa_softmax(f32x4 (&s)[4][4], float (&m)[4], float (&l)[4], f32x4 (&o)[4][4], const bool (&selb)[4], int fr, int fq, int n0, int t0) {
#pragma unroll
    for (int tt = 0; tt < 4; ++tt) {
        const int ti = tt * 16 + fr;
        float mx = -1e30f;
#pragma unroll
        for (int kt = 0; kt < 4; ++kt)
#pragma unroll
            for (int jj = 0; jj < 4; ++jj) {
                const int kk = kt * 16 + 4 * fq + jj;
                const bool v = selb[tt] && nsa_valid<MK>(kk, ti, n0, t0);
                const float sv = v ? s[kt][tt][jj] * SM_C : -1e30f;
                s[kt][tt][jj] = sv; mx = fmaxf(mx, sv);
            }
        mx = fmaxf(mx, __shfl_xor(mx, 16)); mx = fmaxf(mx, __shfl_xor(mx, 32));
        const float mn = fmaxf(m[tt], mx);
        const float alpha = __builtin_amdgcn_exp2f(m[tt] - mn);
        m[tt] = mn;
        float ls = 0.f;
#pragma unroll
        for (int kt = 0; kt < 4; ++kt)
#pragma unroll
            for (int jj = 0; jj < 4; ++jj) {
                const float sv = s[kt][tt][jj];
                const float pv = sv > -1e29f ? __builtin_amdgcn_exp2f(sv - mn) : 0.f;
                s[kt][tt][jj] = pv; ls += pv;
            }
        l[tt] = l[tt] * alpha + ls;
        if (WITH_O) {
#pragma unroll
            for (int dt = 0; dt < 4; ++dt) o[dt][tt] *= alpha;
        }
    }
}
__device__ __forceinline__ void nsa_insert(unsigned (&L)[16], unsigned x) {
#pragma unroll
    for (int i = 0; i < 16; ++i) { const unsigned hi = L[i] > x ? L[i] : x; x = L[i] > x ? x : L[i]; L[i] = hi; }
}
template <bool ACCUM>
__device__ __forceinline__ void nsa_emit(const f32x4 (&o)[4][4], const float (&l)[4], bool l_is_partial, const float* gsrc, float* obase, int fr, int fq) {
#pragma unroll
    for (int tt = 0; tt < 4; ++tt) {
        float lt = l[tt];
        if (l_is_partial) { lt += __shfl_xor(lt, 16); lt += __shfl_xor(lt, 32); }
        const float gv = gsrc[(size_t)(tt * 16 + fr) * 32];
        const float sc = l_is_partial ? (lt > 0.f ? gv / lt : 0.f) : gv;
#pragma unroll
        for (int dt = 0; dt < 4; ++dt) {
            float* op = obase + (size_t)(tt * 16 + fr) * 512 + dt * 16 + 4 * fq;
            f32x4 v = o[dt][tt] * sc;
            if (ACCUM) v += *(const f32x4*)op;
            *(f32x4*)op = v;
        }
    }
}

__device__ __forceinline__ void d_nsa_tile(const bf16_t* __restrict__ proj, const bf16_t* __restrict__ qrope, const bf16_t* __restrict__ kc, const bf16_t* __restrict__ vc,
                                           const float* __restrict__ small, float* __restrict__ onsa, int b, int g, int qt, char* lds) {
    bf16_t* Ks = (bf16_t*)(lds + NSA_OFF_KS);
    bf16_t* Vt = (bf16_t*)(lds + NSA_OFF_VT);
    float* imp = (float*)(lds + NSA_OFF_IMP);
    unsigned* selw = (unsigned*)(lds + NSA_OFF_SELW);
    unsigned* anyw = (unsigned*)(lds + NSA_OFF_ANYW);
    const int tid = threadIdx.x, lane = tid & 63, w = tid >> 6, fr = lane & 15, fq = lane >> 4;
    const size_t tok0 = (size_t)b * SEQ + (size_t)qt * 64;
    const int t0 = qt * 64;
    const float* gbase = small + tok0 * 32 + g * 12 + w * 3;
    float* obase = onsa + tok0 * 512 + g * 256 + w * 64;
    const bool sel_all[4] = {true, true, true, true};

    for (int i = tid; i < 64 * 132; i += 256) imp[i] = 0.f;
    if (tid < 4) anyw[tid] = 0u;

    bf16x8 qf[4][2];
    f32x4 s[4][4], o[4][4];
    float m[4], l[4];
    u32x4 rk[2], rv[2];

    nsa_load_q(proj + tok0 * PROJ_LD + C_Q + g * 256 + w * 64, PROJ_LD, fr, fq, qf);
    const int ncb = (4 * qt + 3 + 63) >> 6;
    const bf16_t* kcb = kc + (size_t)(b * 2 + g) * 512 * 64;
    const bf16_t* vcb = vc + (size_t)(b * 2 + g) * 512 * 64;
#pragma unroll
    for (int tt = 0; tt < 4; ++tt) { m[tt] = -1e30f; l[tt] = 0.f; }
    nsa_stage_load(kcb, 64, vcb, 64, tid, rk, rv);
    for (int jc = 0; jc < ncb; ++jc) {
        __syncthreads();
        nsa_stage_store(Ks, Vt, tid, rk, rv);
        __syncthreads();
        if (jc + 1 < ncb) nsa_stage_load(kcb + (size_t)(jc + 1) * 4096, 64, vcb + (size_t)(jc + 1) * 4096, 64, tid, rk, rv);
        nsa_qk(Ks, qf, s, fr, fq);
        nsa_softmax<3, false>(s, m, l, o, sel_all, fr, fq, jc * 64, t0);
    }
    float linv[4];
#pragma unroll
    for (int tt = 0; tt < 4; ++tt) { float lt = l[tt]; lt += __shfl_xor(lt, 16); lt += __shfl_xor(lt, 32); linv[tt] = lt > 0.f ? 1.0f / lt : 0.f; }
#pragma unroll
    for (int dt = 0; dt < 4; ++dt)
#pragma unroll
        for (int tt = 0; tt < 4; ++tt) o[dt][tt] = (f32x4){0.f, 0.f, 0.f, 0.f};
    nsa_stage_load(kcb, 64, vcb, 64, tid, rk, rv);
    for (int jc = 0; jc < ncb; ++jc) {
        __syncthreads();
        nsa_stage_store(Ks, Vt, tid, rk, rv);
        __syncthreads();
        if (jc + 1 < ncb) nsa_stage_load(kcb + (size_t)(jc + 1) * 4096, 64, vcb + (size_t)(jc + 1) * 4096, 64, tid, rk, rv);
        nsa_qk(Ks, qf, s, fr, fq);
#pragma unroll
        for (int tt = 0; tt < 4; ++tt) {
            const int ti = tt * 16 + fr;
#pragma unroll
            for (int kt = 0; kt < 4; ++kt) {
                f32x4 pv;
#pragma unroll
                for (int jj = 0; jj < 4; ++jj) {
                    const int kk = kt * 16 + 4 * fq + jj;
                    const bool v = nsa_valid<3>(kk, ti, jc * 64, t0);
                    pv[jj] = v ? __builtin_amdgcn_exp2f(s[kt][tt][jj] * SM_C - m[tt]) * linv[tt] : 0.f;
                }
                s[kt][tt] = pv;
                const int j = jc * 16 + kt * 4 + fq;
                float* ip = imp + ti * 132 + (j >> 5) * 33 + (j & 31);
                atomicAdd(ip, pv[0] + pv[1] + pv[2] + 0.5f * pv[3]);
                if (j + 1 < 128) { const int j1 = j + 1; atomicAdd(imp + ti * 132 + (j1 >> 5) * 33 + (j1 & 31), 0.5f * pv[3]); }
            }
        }
        nsa_pv(Vt, s, o, fr, fq);
    }
    nsa_emit<false>(o, l, false, gbase + 0, obase, fr, fq);
    __syncthreads();
    {
        const int ti = tid >> 2, q = tid & 3;
        unsigned L[16];
#pragma unroll
        for (int i = 0; i < 16; ++i) L[i] = 0u;
#pragma unroll 4
        for (int i = 0; i < 32; ++i) {
            const int j = q * 32 + i;
            const bool forced = (j == 0) || (j == qt) || (j == qt - 1);
            const float v = imp[ti * 132 + q * 33 + i] + (forced ? 1e4f : 0.f) + 1e-30f;
            const unsigned x = (j <= qt) ? ((__float_as_uint(v) & ~0x7Fu) | (unsigned)(127 - j)) : 0u;
            nsa_insert(L, x);
        }
#pragma unroll
        for (int r = 1; r <= 2; r <<= 1) {
            unsigned P[16];
#pragma unroll
            for (int i = 0; i < 16; ++i) P[i] = (unsigned)__shfl_xor((int)L[i], r);
#pragma unroll
            for (int i = 0; i < 16; ++i) nsa_insert(L, P[i]);
        }
        unsigned word = 0u;
#pragma unroll
        for (int i = 0; i < 16; ++i) {
            const unsigned e = L[i];
            const int j = 127 - (int)(e & 0x7Fu);
            if (e != 0u && (j >> 5) == q) word |= 1u << (j & 31);
        }
        selw[ti * 4 + q] = word;
        atomicOr(&anyw[q], word);
    }
    __syncthreads();
    nsa_load_q(qrope + tok0 * 512 + g * 256 + w * 64, 512, fr, fq, qf);
    const bf16_t* pb = proj + (size_t)b * SEQ * PROJ_LD + g * 64;
    {
#pragma unroll
        for (int tt = 0; tt < 4; ++tt) { m[tt] = -1e30f; l[tt] = 0.f; }
#pragma unroll
        for (int dt = 0; dt < 4; ++dt)
#pragma unroll
            for (int tt = 0; tt < 4; ++tt) o[dt][tt] = (f32x4){0.f, 0.f, 0.f, 0.f};
        const unsigned a0 = __builtin_amdgcn_readfirstlane(anyw[0]), a1 = __builtin_amdgcn_readfirstlane(anyw[1]), a2 = __builtin_amdgcn_readfirstlane(anyw[2]), a3 = __builtin_amdgcn_readfirstlane(anyw[3]);
        int j = 0;
        nsa_stage_load(pb + (size_t)(j * 64) * PROJ_LD + C_KSEL, PROJ_LD, pb + (size_t)(j * 64) * PROJ_LD + C_VSEL, PROJ_LD, tid, rk, rv);
        while (j <= qt) {
            int jn = j + 1;
            while (jn <= qt) { const unsigned wd = jn < 32 ? a0 : jn < 64 ? a1 : jn < 96 ? a2 : a3; if ((wd >> (jn & 31)) & 1u) break; ++jn; }
            __syncthreads();
            nsa_stage_store(Ks, Vt, tid, rk, rv);
            __syncthreads();
            if (jn <= qt) nsa_stage_load(pb + (size_t)(jn * 64) * PROJ_LD + C_KSEL, PROJ_LD, pb + (size_t)(jn * 64) * PROJ_LD + C_VSEL, PROJ_LD, tid, rk, rv);
            nsa_qk(Ks, qf, s, fr, fq);
            bool selb[4];
#pragma unroll
            for (int tt = 0; tt < 4; ++tt) selb[tt] = (selw[(tt * 16 + fr) * 4 + (j >> 5)] >> (j & 31)) & 1u;
            if (j == qt) nsa_softmax<1, true>(s, m, l, o, selb, fr, fq, 0, 0);
            else nsa_softmax<0, true>(s, m, l, o, selb, fr, fq, 0, 0);
            nsa_pv(Vt, s, o, fr, fq);
            j = jn;
        }
        nsa_emit<true>(o, l, true, gbase + 1, obase, fr, fq);
    }
    {
#pragma unroll
        for (int tt = 0; tt < 4; ++tt) { m[tt] = -1e30f; l[tt] = 0.f; }
#pragma unroll
        for (int dt = 0; dt < 4; ++dt)
#pragma unroll
            for (int tt = 0; tt < 4; ++tt) o[dt][tt] = (f32x4){0.f, 0.f, 0.f, 0.f};
        const int j0 = qt >= 8 ? qt - 8 : 0;
        nsa_stage_load(pb + (size_t)(j0 * 64) * PROJ_LD + C_KWIN, PROJ_LD, pb + (size_t)(j0 * 64) * PROJ_LD + C_VWIN, PROJ_LD, tid, rk, rv);
        for (int j = j0; j <= qt; ++j) {
            __syncthreads();
            nsa_stage_store(Ks, Vt, tid, rk, rv);
            __syncthreads();
            if (j + 1 <= qt) nsa_stage_load(pb + (size_t)((j + 1) * 64) * PROJ_LD + C_KWIN, PROJ_LD, pb + (size_t)((j + 1) * 64) * PROJ_LD + C_VWIN, PROJ_LD, tid, rk, rv);
            nsa_qk(Ks, qf, s, fr, fq);
            if (j == qt) nsa_softmax<1, true>(s, m, l, o, sel_all, fr, fq, 0, 0);
            else if (j == qt - 8) nsa_softmax<2, true>(s, m, l, o, sel_all, fr, fq, 0, 0);
            else nsa_softmax<0, true>(s, m, l, o, sel_all, fr, fq, 0, 0);
            nsa_pv(Vt, s, o, fr, fq);
        }
        nsa_emit<true>(o, l, true, gbase + 2, obase, fr, fq);
    }
}

__device__ __forceinline__ void d_ssd(const bf16_t* __restrict__ proj, const float* __restrict__ small, const float* __restrict__ conv_w, const float* __restrict__ conv_b,
                                             const float* __restrict__ a_log, const float* __restrict__ d_skip, float* __restrict__ yssd, int vb, char* lds) {
    float (*sB)[128] = (float (*)[128])lds; float (*sC)[128] = (float (*)[128])(lds + 8192); float* sdt = (float*)(lds + 16384); float* sdA = (float*)(lds + 16384 + 64);
    float (*ypart)[4][64] = (float (*)[4][64])(lds + 16384 + 128);
    const int tid = threadIdx.x, p = tid & 63, nq = tid >> 6;
    const int b = vb >> 3, hh = vb & 7, g = hh >> 2;
    const int ch_bc = tid < 128 ? 512 + g * 128 + tid : 768 + g * 128 + (tid - 128);
    const int ch_x = hh * 64 + p;
    float wbc[4], wx[4];
#pragma unroll
    for (int k = 0; k < 4; ++k) { wbc[k] = conv_w[k * 1024 + ch_bc]; wx[k] = conv_w[k * 1024 + ch_x]; }
    const float bbc = conv_b[ch_bc], bx = conv_b[ch_x];
    const float a = -__expf(a_log[hh]), dsk = d_skip[hh];
    float hb0 = 0.f, hb1 = 0.f, hb2 = 0.f, hx0 = 0.f, hx1 = 0.f, hx2 = 0.f;
    float h[32];
#pragma unroll
    for (int k = 0; k < 32; ++k) h[k] = 0.f;
    const bf16_t* pb = proj + (size_t)b * SEQ * PROJ_LD + C_XBC;
    for (int t0 = 0; t0 < SEQ; t0 += 16) {
        float rbc[16], rx[16];
#pragma unroll
        for (int i = 0; i < 16; ++i) {
            rbc[i] = bf2f(pb[(size_t)(t0 + i) * PROJ_LD + ch_bc]);
            rx[i] = bf2f(pb[(size_t)(t0 + i) * PROJ_LD + ch_x]);
        }
        if (tid < 16) { const float dtv = small[((size_t)b * SEQ + t0 + tid) * 32 + 24 + hh]; sdt[tid] = dtv; sdA[tid] = __expf(dtv * a); }
        float xv[16];
#pragma unroll
        for (int i = 0; i < 16; ++i) {
            const float vb = bbc + wbc[0] * hb0 + wbc[1] * hb1 + wbc[2] * hb2 + wbc[3] * rbc[i];
            hb0 = hb1; hb1 = hb2; hb2 = rbc[i];
            const float sv = silu(vb);
            if (tid < 128) sB[i][tid] = sv; else sC[i][tid - 128] = sv;
            const float vx = bx + wx[0] * hx0 + wx[1] * hx1 + wx[2] * hx2 + wx[3] * rx[i];
            hx0 = hx1; hx1 = hx2; hx2 = rx[i];
            xv[i] = silu(vx);
        }
        __syncthreads();
#pragma unroll
        for (int i = 0; i < 16; ++i) {
            const float dtv = sdt[i], dA = sdA[i], xdt = xv[i] * dtv;
            float yp = 0.f;
#pragma unroll
            for (int k4 = 0; k4 < 8; ++k4) {
                const f32x4 bv = *(const f32x4*)&sB[i][nq * 32 + k4 * 4];
                const f32x4 cv = *(const f32x4*)&sC[i][nq * 32 + k4 * 4];
                h[k4 * 4 + 0] = h[k4 * 4 + 0] * dA + xdt * bv.x; yp += cv.x * h[k4 * 4 + 0];
                h[k4 * 4 + 1] = h[k4 * 4 + 1] * dA + xdt * bv.y; yp += cv.y * h[k4 * 4 + 1];
                h[k4 * 4 + 2] = h[k4 * 4 + 2] * dA + xdt * bv.z; yp += cv.z * h[k4 * 4 + 2];
                h[k4 * 4 + 3] = h[k4 * 4 + 3] * dA + xdt * bv.w; yp += cv.w * h[k4 * 4 + 3];
            }
            if (nq == 0) yp += xv[i] * dsk;
            ypart[i][nq][p] = yp;
        }
        __syncthreads();
#pragma unroll
        for (int k2 = 0; k2 < 4; ++k2) {
            const int i = nq + 4 * k2;
            yssd[((size_t)b * SEQ + t0 + i) * 512 + hh * 64 + p] = ypart[i][0][p] + ypart[i][1][p] + ypart[i][2][p] + ypart[i][3][p];
        }
        __syncthreads();
    }
}

__device__ __forceinline__ void d_mix_prep(const float* __restrict__ onsa, const float* __restrict__ yssd, const bf16_t* __restrict__ proj,
                                                  const float* __restrict__ nsa_w, const float* __restrict__ ssd_w, bf16_t* __restrict__ A2, int vb, char* lds) {
    float (*red)[4] = (float (*)[4])lds;
    const int tid = threadIdx.x; const size_t tok = vb;
    const float o0 = onsa[tok * 512 + tid * 2], o1 = onsa[tok * 512 + tid * 2 + 1];
    const unsigned zz = *(const unsigned*)(proj + tok * PROJ_LD + C_Z + tid * 2);
    const float y0 = yssd[tok * 512 + tid * 2] * silu(bflo(zz)), y1 = yssd[tok * 512 + tid * 2 + 1] * silu(bfhi(zz));
    float s0 = wave_sum(o0 * o0 + o1 * o1), s1 = wave_sum(y0 * y0 + y1 * y1);
    if ((tid & 63) == 0) { red[0][tid >> 6] = s0; red[1][tid >> 6] = s1; }
    __syncthreads();
    const float r0 = rsqrtf((red[0][0] + red[0][1] + red[0][2] + red[0][3]) * (1.0f / 512) + EPS);
    const float r1 = rsqrtf((red[1][0] + red[1][1] + red[1][2] + red[1][3]) * (1.0f / 512) + EPS);
    *(unsigned*)(A2 + tok * DM + tid * 2) = pack2(o0 * r0 * nsa_w[tid * 2], o1 * r0 * nsa_w[tid * 2 + 1]);
    *(unsigned*)(A2 + tok * DM + 512 + tid * 2) = pack2(y0 * r1 * ssd_w[tid * 2], y1 * r1 * ssd_w[tid * 2 + 1]);
}

__device__ __forceinline__ void argmax_bfly(float& bv, int& bi) {
#pragma unroll
    for (int o = 32; o; o >>= 1) {
        const float ov = __shfl_xor(bv, o); const int oi = __shfl_xor(bi, o);
        if (ov > bv || (ov == bv && oi < bi)) { bv = ov; bi = oi; }
    }
}
__device__ __forceinline__ void d_peer_topk(const bf16_t* __restrict__ qp, const float* __restrict__ qnw, const bf16_t* __restrict__ subk, int* __restrict__ eidx, float* __restrict__ gate, int vb, char* lds) {
    float (*sq)[256] = (float (*)[256])lds;
    const int tid = threadIdx.x, lane = tid & 63, wid = tid >> 6;
    const int gw = vb * 4 + wid; const size_t tok = gw >> 3; const int h = gw & 7;
    {
        const u32x2 v = *(const u32x2*)(qp + tok * 2048 + h * 256 + lane * 4);
        const float a0 = bflo(v.x), a1 = bfhi(v.x), a2 = bflo(v.y), a3 = bfhi(v.y);
        const float ss = wave_sum(a0 * a0 + a1 * a1 + a2 * a2 + a3 * a3);
        const float r = rsqrtf(ss * (1.0f / 256) + EPS);
        const f32x4 wv = *(const f32x4*)(qnw + lane * 4);
        *(f32x4*)&sq[wid][lane * 4] = (f32x4){a0 * r * wv.x, a1 * r * wv.y, a2 * r * wv.z, a3 * r * wv.w};
    }
    __syncthreads();
    float sc[2][2];
#pragma unroll
    for (int k = 0; k < 2; ++k)
#pragma unroll
        for (int hf = 0; hf < 2; ++hf) {
            const int n = lane + 64 * hf;
            const bf16_t* kr = subk + ((size_t)(h * 2 + k) * 128 + n) * 128;
            float s = 0.f;
#pragma unroll 4
            for (int c = 0; c < 16; ++c) {
                const u32x4 kv = *(const u32x4*)(kr + c * 8);
                const f32x4 q0 = *(const f32x4*)&sq[wid][k * 128 + c * 8], q1 = *(const f32x4*)&sq[wid][k * 128 + c * 8 + 4];
                s += q0.x * bflo(kv.x) + q0.y * bfhi(kv.x) + q0.z * bflo(kv.y) + q0.w * bfhi(kv.y)
                   + q1.x * bflo(kv.z) + q1.y * bfhi(kv.z) + q1.z * bflo(kv.w) + q1.w * bfhi(kv.w);
            }
            sc[k][hf] = s;
            __builtin_amdgcn_sched_barrier(0);
        }
    float s1v = 0.f, s2v = 0.f; int i1v = 0, i2v = 0;
#pragma unroll
    for (int k = 0; k < 2; ++k) {
        float v0 = sc[k][0], v1 = sc[k][1];
        for (int it = 0; it < 16; ++it) {
            float bv; int bi;
            if (v0 >= v1) { bv = v0; bi = lane; } else { bv = v1; bi = lane + 64; }
            argmax_bfly(bv, bi);
            if (lane == it) { if (k == 0) { s1v = bv; i1v = bi; } else { s2v = bv; i2v = bi; } }
            if (bi == lane) v0 = -3e38f;
            if (bi == lane + 64) v1 = -3e38f;
        }
    }
    float cs[4]; int ci[4];
#pragma unroll
    for (int e = 0; e < 4; ++e) {
        const int a = lane >> 2, bb = (lane & 3) * 4 + e;
        cs[e] = __shfl(s1v, a) + __shfl(s2v, bb);
        ci[e] = __shfl(i1v, a) * 128 + __shfl(i2v, bb);
    }
    float tsv = -3e38f; int tev = 0;
    for (int it = 0; it < 16; ++it) {
        float bv = cs[0]; int bc = lane * 4;
#pragma unroll
        for (int e = 1; e < 4; ++e) if (cs[e] > bv) { bv = cs[e]; bc = lane * 4 + e; }
        argmax_bfly(bv, bc);
        const int owner = bc >> 2, oe = bc & 3;
        int ev = 0;
#pragma unroll
        for (int e = 0; e < 4; ++e) if (oe == e) ev = ci[e];
        ev = __shfl(ev, owner);
        if (lane == it) { tsv = bv; tev = ev; }
        if (lane == owner) {
#pragma unroll
            for (int e = 0; e < 4; ++e) if (oe == e) cs[e] = -3e38f;
        }
    }
    const float mx = wave_max(tsv);
    const float pe = lane < 16 ? __expf(tsv - mx) : 0.f;
    const float sum = wave_sum(pe);
    if (lane < 16) {
        eidx[(tok * 8 + h) * 16 + lane] = tev;
        gate[(tok * 8 + h) * 16 + lane] = pe / sum;
    }
}

__device__ __forceinline__ void d_peer_expert(const bf16_t* __restrict__ h2, const bf16_t* __restrict__ down, const bf16_t* __restrict__ up, const int* __restrict__ eidx,
                                                     const float* __restrict__ gate, const float* __restrict__ mod, const float* __restrict__ fw, float* __restrict__ out, int vb) {
    const int tid = threadIdx.x, lane = tid & 63, wid = tid >> 6;
    const size_t tok = (size_t)vb * 4 + wid; const int b = (int)(tok >> 13);
    float hx[16], acc[16];
    {
        const u32x4 v0 = *(const u32x4*)(h2 + tok * DM + lane * 8), v1 = *(const u32x4*)(h2 + tok * DM + 512 + lane * 8);
        hx[0] = bflo(v0.x); hx[1] = bfhi(v0.x); hx[2] = bflo(v0.y); hx[3] = bfhi(v0.y); hx[4] = bflo(v0.z); hx[5] = bfhi(v0.z); hx[6] = bflo(v0.w); hx[7] = bfhi(v0.w);
        hx[8] = bflo(v1.x); hx[9] = bfhi(v1.x); hx[10] = bflo(v1.y); hx[11] = bfhi(v1.y); hx[12] = bflo(v1.z); hx[13] = bfhi(v1.z); hx[14] = bflo(v1.w); hx[15] = bfhi(v1.w);
    }
#pragma unroll
    for (int e = 0; e < 16; ++e) acc[e] = 0.f;
    const int* ep = eidx + tok * 128; const float* gp = gate + tok * 128;
    for (int j0 = 0; j0 < 128; j0 += 4) {
        u32x4 d0[4], d1[4], u0[4], u1[4]; float gt[4];
#pragma unroll
        for (int jj = 0; jj < 4; ++jj) {
            const int e = __builtin_amdgcn_readfirstlane(ep[j0 + jj]);
            gt[jj] = gp[j0 + jj];
            const bf16_t* dr = down + (size_t)e * DM; const bf16_t* ur = up + (size_t)e * DM;
            d0[jj] = *(const u32x4*)(dr + lane * 8); d1[jj] = *(const u32x4*)(dr + 512 + lane * 8);
            u0[jj] = *(const u32x4*)(ur + lane * 8); u1[jj] = *(const u32x4*)(ur + 512 + lane * 8);
        }
#pragma unroll
        for (int jj = 0; jj < 4; ++jj) {
            float s = hx[0] * bflo(d0[jj].x) + hx[1] * bfhi(d0[jj].x) + hx[2] * bflo(d0[jj].y) + hx[3] * bfhi(d0[jj].y)
                    + hx[4] * bflo(d0[jj].z) + hx[5] * bfhi(d0[jj].z) + hx[6] * bflo(d0[jj].w) + hx[7] * bfhi(d0[jj].w)
                    + hx[8] * bflo(d1[jj].x) + hx[9] * bfhi(d1[jj].x) + hx[10] * bflo(d1[jj].y) + hx[11] * bfhi(d1[jj].y)
                    + hx[12] * bflo(d1[jj].z) + hx[13] * bfhi(d1[jj].z) + hx[14] * bflo(d1[jj].w) + hx[15] * bfhi(d1[jj].w);
            s = wave_sum(s);
            const float a = gelu_tanh(s) * gt[jj];
            acc[0] += a * bflo(u0[jj].x); acc[1] += a * bfhi(u0[jj].x); acc[2] += a * bflo(u0[jj].y); acc[3] += a * bfhi(u0[jj].y);
            acc[4] += a * bflo(u0[jj].z); acc[5] += a * bfhi(u0[jj].z); acc[6] += a * bflo(u0[jj].w); acc[7] += a * bfhi(u0[jj].w);
            acc[8] += a * bflo(u1[jj].x); acc[9] += a * bfhi(u1[jj].x); acc[10] += a * bflo(u1[jj].y); acc[11] += a * bfhi(u1[jj].y);
            acc[12] += a * bflo(u1[jj].z); acc[13] += a * bfhi(u1[jj].z); acc[14] += a * bflo(u1[jj].w); acc[15] += a * bfhi(u1[jj].w);
        }
    }
    float x2[16]; float ss = 0.f;
#pragma unroll
    for (int hf = 0; hf < 2; ++hf)
#pragma unroll
        for (int q4 = 0; q4 < 2; ++q4) {
            const int col = hf * 512 + lane * 8 + q4 * 4;
            const f32x4 xv = *(const f32x4*)(out + tok * DM + col);
            const f32x4 g2 = *(const f32x4*)(mod + b * 6144 + 5120 + col);
            const int e0 = hf * 8 + q4 * 4;
            x2[e0 + 0] = xv.x + g2.x * acc[e0 + 0]; x2[e0 + 1] = xv.y + g2.y * acc[e0 + 1]; x2[e0 + 2] = xv.z + g2.z * acc[e0 + 2]; x2[e0 + 3] = xv.w + g2.w * acc[e0 + 3];
            ss += x2[e0] * x2[e0] + x2[e0 + 1] * x2[e0 + 1] + x2[e0 + 2] * x2[e0 + 2] + x2[e0 + 3] * x2[e0 + 3];
        }
    ss = wave_sum(ss);
    const float r = rsqrtf(ss * (1.0f / DM) + EPS);
#pragma unroll
    for (int hf = 0; hf < 2; ++hf)
#pragma unroll
        for (int q4 = 0; q4 < 2; ++q4) {
            const int col = hf * 512 + lane * 8 + q4 * 4;
            const f32x4 w = *(const f32x4*)(fw + col);
            const int e0 = hf * 8 + q4 * 4;
            *(f32x4*)(out + tok * DM + col) = (f32x4){x2[e0] * r * w.x, x2[e0 + 1] * r * w.y, x2[e0 + 2] * r * w.z, x2[e0 + 3] * r * w.w};
        }
}

__device__ __forceinline__ void d_quant_rows(const float* __restrict__ src, unsigned char* __restrict__ dst, float* __restrict__ scale, int vb) {
    const int lane = threadIdx.x & 63, row = vb * 4 + (threadIdx.x >> 6);
    const float* rp = src + (size_t)row * DM + lane * 16;
    f32x4 v[4];
#pragma unroll
    for (int i = 0; i < 4; ++i) v[i] = *(const f32x4*)(rp + i * 4);
    float mx = 0.f;
#pragma unroll
    for (int i = 0; i < 4; ++i) mx = fmaxf(mx, fmaxf(fmaxf(fabsf(v[i].x), fabsf(v[i].y)), fmaxf(fabsf(v[i].z), fabsf(v[i].w))));
    mx = wave_max(mx);
    const float sc = mx > 0.f ? mx * (1.0f / 416.0f) : 1.0f;
    const float inv = 1.0f / sc;
    u32x4 o;
#pragma unroll
    for (int i = 0; i < 4; ++i) {
        int wv = 0;
        wv = __builtin_amdgcn_cvt_pk_fp8_f32(v[i].x * inv, v[i].y * inv, wv, false);
        wv = __builtin_amdgcn_cvt_pk_fp8_f32(v[i].z * inv, v[i].w * inv, wv, true);
        o[i] = (unsigned)wv;
    }
    *(u32x4*)(dst + (size_t)row * DM + lane * 16) = o;
    if (lane == 0) scale[row] = sc;
}

__device__ __forceinline__ unsigned mono_u(float f) { const unsigned u = __float_as_uint(f); return (u & 0x80000000u) ? ~u : (u | 0x80000000u); }
__device__ __forceinline__ float unmono_f(unsigned m) { const unsigned u = (m & 0x80000000u) ? (m & 0x7fffffffu) : ~m; return __uint_as_float(u); }
__device__ __forceinline__ void ins16(unsigned (&L)[16], unsigned x) {
#pragma unroll
    for (int i = 0; i < 16; ++i) { const unsigned hi = L[i] > x ? L[i] : x; x = L[i] > x ? x : L[i]; L[i] = hi; }
}
__device__ __forceinline__ void d_peer_route(const bf16_t* __restrict__ qp, const float* __restrict__ qnw, const bf16_t* __restrict__ subk, int* __restrict__ eidx, float* __restrict__ gate,
                                             int tile, int h, char* lds) {
    const int tid = threadIdx.x, lane = tid & 63, w = tid >> 6, fr = lane & 15, fq = lane >> 4;
    const size_t tok = (size_t)tile * 64 + w * 16 + fr;
    bf16x8 qf[2][4];
    {
        const bf16_t* qrow = qp + tok * 2048 + h * 256;
        u32x4 raw[2][4];
        float ss = 0.f;
#pragma unroll
        for (int k = 0; k < 2; ++k)
#pragma unroll
            for (int ks = 0; ks < 4; ++ks) {
                const u32x4 r = *(const u32x4*)(qrow + k * 128 + ks * 32 + fq * 8);
                raw[k][ks] = r;
                ss += bflo(r.x) * bflo(r.x) + bfhi(r.x) * bfhi(r.x) + bflo(r.y) * bflo(r.y) + bfhi(r.y) * bfhi(r.y)
                    + bflo(r.z) * bflo(r.z) + bfhi(r.z) * bfhi(r.z) + bflo(r.w) * bflo(r.w) + bfhi(r.w) * bfhi(r.w);
            }
        ss += __shfl_xor(ss, 16); ss += __shfl_xor(ss, 32);
        const float rs = rsqrtf(ss * (1.0f / 256) + EPS);
#pragma unroll
        for (int k = 0; k < 2; ++k)
#pragma unroll
            for (int ks = 0; ks < 4; ++ks) {
                const float* wp = qnw + k * 128 + ks * 32 + fq * 8;
                const f32x4 w0 = *(const f32x4*)wp, w1 = *(const f32x4*)(wp + 4);
                const u32x4 r = raw[k][ks];
                u32x4 o;
                o.x = pack2(bflo(r.x) * rs * w0.x, bfhi(r.x) * rs * w0.y); o.y = pack2(bflo(r.y) * rs * w0.z, bfhi(r.y) * rs * w0.w);
                o.z = pack2(bflo(r.z) * rs * w1.x, bfhi(r.z) * rs * w1.y); o.w = pack2(bflo(r.w) * rs * w1.z, bfhi(r.w) * rs * w1.w);
                qf[k][ks] = __builtin_bit_cast(bf16x8, o);
            }
    }
    unsigned L[2][16];
#pragma unroll
    for (int k = 0; k < 2; ++k) {
        f32x4 acc[8];
#pragma unroll
        for (int kt = 0; kt < 8; ++kt) acc[kt] = (f32x4){0.f, 0.f, 0.f, 0.f};
        const bf16_t* kb = subk + (size_t)((h * 2 + k) * 128) * 128;
#pragma unroll
        for (int kt = 0; kt < 8; ++kt)
#pragma unroll
            for (int ks = 0; ks < 4; ++ks) {
                const bf16x8 af = *(const bf16x8*)(kb + (size_t)(kt * 16 + fr) * 128 + ks * 32 + fq * 8);
                acc[kt] = __builtin_amdgcn_mfma_f32_16x16x32_bf16(af, qf[k][ks], acc[kt], 0, 0, 0);
            }
#pragma unroll
        for (int i = 0; i < 16; ++i) L[k][i] = 0u;
#pragma unroll
        for (int kt = 0; kt < 8; ++kt)
#pragma unroll
            for (int jj = 0; jj < 4; ++jj) {
                const int idx = kt * 16 + 4 * fq + jj;
                ins16(L[k], (mono_u(acc[kt][jj]) & ~0x7Fu) | (unsigned)(127 - idx));
            }
#pragma unroll
        for (int r = 16; r <= 32; r <<= 1) {
            unsigned P[16];
#pragma unroll
            for (int i = 0; i < 16; ++i) P[i] = (unsigned)__shfl_xor((int)L[k][i], r);
#pragma unroll
            for (int i = 0; i < 16; ++i) ins16(L[k], P[i]);
        }
    }
    unsigned T[16];
#pragma unroll
    for (int i = 0; i < 16; ++i) T[i] = 0u;
#pragma unroll
    for (int a = 0; a < 16; ++a) {
        const float va = unmono_f(L[0][a] & ~0x7Fu);
#pragma unroll
        for (int bb = 0; bb < 16; ++bb) {
            if (bb <= 16 / (a + 1) - 1) {
                const float sum = va + unmono_f(L[1][bb] & ~0x7Fu);
                ins16(T, (mono_u(sum) & ~0xFFu) | (unsigned)(255 - (a * 16 + bb)));
            }
        }
    }
    unsigned char* li = (unsigned char*)lds + w * 512 + fr * 32;
    if (fq == 0) {
#pragma unroll
        for (int a = 0; a < 16; ++a) { li[a] = (unsigned char)(127 - (L[0][a] & 0x7Fu)); li[16 + a] = (unsigned char)(127 - (L[1][a] & 0x7Fu)); }
    }
    __syncthreads();
    const float s0 = unmono_f(T[0] & ~0xFFu);
    float pe[16]; float sum = 0.f;
#pragma unroll
    for (int i = 0; i < 16; ++i) { pe[i] = __expf(unmono_f(T[i] & ~0xFFu) - s0); sum += pe[i]; }
    const float inv = 1.0f / sum;
    unsigned cod[4] = {0u, 0u, 0u, 0u}; float gv[4] = {0.f, 0.f, 0.f, 0.f};
#pragma unroll
    for (int i = 0; i < 16; ++i) if ((i >> 2) == fq) { cod[i & 3] = 255u - (T[i] & 0xFFu); gv[i & 3] = pe[i] * inv; }
    int ev[4];
#pragma unroll
    for (int i = 0; i < 4; ++i) ev[i] = (int)li[cod[i] >> 4] * 128 + (int)li[16 + (cod[i] & 15u)];
    *(u32x4*)(eidx + (tok * 8 + h) * 16 + fq * 4) = (u32x4){(unsigned)ev[0], (unsigned)ev[1], (unsigned)ev[2], (unsigned)ev[3]};
    *(f32x4*)(gate + (tok * 8 + h) * 16 + fq * 4) = (f32x4){gv[0], gv[1], gv[2], gv[3]};
    __syncthreads();
}

__device__ __forceinline__ void cvt16(const u32x4 q, float (&f)[16]) {
#pragma unroll
    for (int i = 0; i < 4; ++i) {
        const f32x2 lo = __builtin_amdgcn_cvt_pk_f32_fp8((int)q[i], false), hi = __builtin_amdgcn_cvt_pk_f32_fp8((int)q[i], true);
        f[4 * i] = lo.x; f[4 * i + 1] = lo.y; f[4 * i + 2] = hi.x; f[4 * i + 3] = hi.y;
    }
}
__device__ __forceinline__ void d_peer_expert8(const bf16_t* __restrict__ h2, const unsigned char* __restrict__ down8, const unsigned char* __restrict__ up8, const float* __restrict__ dscale,
                                               const float* __restrict__ uscale, const int* __restrict__ eidx, const float* __restrict__ gate, const float* __restrict__ mod,
                                               const float* __restrict__ fw, float* __restrict__ out, int vb) {
    const int tid = threadIdx.x, lane = tid & 63, wid = tid >> 6;
    const size_t tok = (size_t)vb * 4 + wid; const int b = (int)(tok >> 13);
    float hx[16], acc[16];
    {
        const u32x4 v0 = *(const u32x4*)(h2 + tok * DM + lane * 16), v1 = *(const u32x4*)(h2 + tok * DM + lane * 16 + 8);
        hx[0] = bflo(v0.x); hx[1] = bfhi(v0.x); hx[2] = bflo(v0.y); hx[3] = bfhi(v0.y); hx[4] = bflo(v0.z); hx[5] = bfhi(v0.z); hx[6] = bflo(v0.w); hx[7] = bfhi(v0.w);
        hx[8] = bflo(v1.x); hx[9] = bfhi(v1.x); hx[10] = bflo(v1.y); hx[11] = bfhi(v1.y); hx[12] = bflo(v1.z); hx[13] = bfhi(v1.z); hx[14] = bflo(v1.w); hx[15] = bfhi(v1.w);
    }
#pragma unroll
    for (int e = 0; e < 16; ++e) acc[e] = 0.f;
    const int* ep = eidx + tok * 128; const float* gp = gate + tok * 128;
    const int es = lane >> 3;
    for (int j0 = 0; j0 < 128; j0 += 8) {
        u32x4 dq[8], uq[8];
#pragma unroll
        for (int i = 0; i < 8; ++i) {
            const int e = __builtin_amdgcn_readfirstlane(ep[j0 + i]);
            dq[i] = *(const u32x4*)(down8 + (size_t)e * DM + lane * 16);
            uq[i] = *(const u32x4*)(up8 + (size_t)e * DM + lane * 16);
        }
        const int my_e = ep[j0 + es];
        const float my_c = gp[j0 + es] * uscale[my_e], my_ds = dscale[my_e];
        float part[8];
#pragma unroll
        for (int i = 0; i < 8; ++i) {
            float f[16]; cvt16(dq[i], f);
            float s = 0.f;
#pragma unroll
            for (int e = 0; e < 16; ++e) s += hx[e] * f[e];
            part[i] = s;
        }
        float q4[4], q2[2], q1;
#pragma unroll
        for (int i = 0; i < 4; ++i) { const bool up = (lane & 32) != 0; const float send = up ? part[i] : part[i + 4]; const float keep = up ? part[i + 4] : part[i]; q4[i] = keep + __shfl_xor(send, 32); }
#pragma unroll
        for (int i = 0; i < 2; ++i) { const bool up = (lane & 16) != 0; const float send = up ? q4[i] : q4[i + 2]; const float keep = up ? q4[i + 2] : q4[i]; q2[i] = keep + __shfl_xor(send, 16); }
        { const bool up = (lane & 8) != 0; const float send = up ? q2[0] : q2[1]; const float keep = up ? q2[1] : q2[0]; q1 = keep + __shfl_xor(send, 8); }
        q1 += __shfl_xor(q1, 4); q1 += __shfl_xor(q1, 2); q1 += __shfl_xor(q1, 1);
        const float a = gelu_tanh(q1 * my_ds) * my_c;
#pragma unroll
        for (int i = 0; i < 8; ++i) {
            const float c = __uint_as_float((unsigned)__builtin_amdgcn_readlane((int)__float_as_uint(a), 8 * i));
            float f[16]; cvt16(uq[i], f);
#pragma unroll
            for (int e = 0; e < 16; ++e) acc[e] += c * f[e];
        }
    }
    float x2[16]; float ss = 0.f;
#pragma unroll
    for (int q4i = 0; q4i < 4; ++q4i) {
        const int col = lane * 16 + q4i * 4;
        const f32x4 xv = *(const f32x4*)(out + tok * DM + col);
        const f32x4 g2 = *(const f32x4*)(mod + b * 6144 + 5120 + col);
        const int e0 = q4i * 4;
        x2[e0 + 0] = xv.x + g2.x * acc[e0 + 0]; x2[e0 + 1] = xv.y + g2.y * acc[e0 + 1]; x2[e0 + 2] = xv.z + g2.z * acc[e0 + 2]; x2[e0 + 3] = xv.w + g2.w * acc[e0 + 3];
        ss += x2[e0] * x2[e0] + x2[e0 + 1] * x2[e0 + 1] + x2[e0 + 2] * x2[e0 + 2] + x2[e0 + 3] * x2[e0 + 3];
    }
    ss = wave_sum(ss);
    const float r = rsqrtf(ss * (1.0f / DM) + EPS);
#pragma unroll
    for (int q4i = 0; q4i < 4; ++q4i) {
        const int col = lane * 16 + q4i * 4;
        const f32x4 wv = *(const f32x4*)(fw + col);
        const int e0 = q4i * 4;
        *(f32x4*)(out + tok * DM + col) = (f32x4){x2[e0] * r * wv.x, x2[e0 + 1] * r * wv.y, x2[e0 + 2] * r * wv.z, x2[e0 + 3] * r * wv.w};
    }
}

struct Params {
    const float *x, *c, *w_ada, *b_ada, *norm1_w, *w_in, *cmp_pe_k, *cmp_pe_v, *cmp_w1_k, *cmp_w2_k, *cmp_w1_v, *cmp_w2_v, *nsa_norm_w, *conv_w, *conv_b, *dt_bias, *a_log, *d_skip,
        *ssd_norm_w, *w_out, *norm2_w, *peer_wq, *peer_qnorm_w, *peer_sub_keys, *peer_down, *peer_up, *final_norm_w;
    float* out; char* ws;
};
#define LDS_BYTES 53504

__global__ __launch_bounds__(256, 1) void mega(Params p) {
    __shared__ __attribute__((aligned(16))) char lds[LDS_BYTES];
    __shared__ int s_vb;
    cg::grid_group grid = cg::this_grid();
    const int G = gridDim.x, bid = blockIdx.x;
    char* ws = p.ws;
    float* mod = (float*)(ws + OFF_MOD);
    float2* rope = (float2*)(ws + OFF_ROPE);
    float* bias1 = (float*)(ws + OFF_BIAS1);
    bf16_t* win_t = (bf16_t*)(ws + OFF_WIN_T);
    bf16_t* wout_t = (bf16_t*)(ws + OFF_WOUT_T);
    bf16_t* wq_t = (bf16_t*)(ws + OFF_WQ_T);
    bf16_t* subk = (bf16_t*)(ws + OFF_SUBK);
    bf16_t* w1k_t = (bf16_t*)(ws + OFF_W1K_T);
    bf16_t* w1v_t = (bf16_t*)(ws + OFF_W1V_T);
    bf16_t* kc = (bf16_t*)(ws + OFF_KC);
    bf16_t* vc = (bf16_t*)(ws + OFF_VC);
    bf16_t* hidk = (bf16_t*)(ws + OFF_HIDK);
    bf16_t* hidv = (bf16_t*)(ws + OFF_HIDV);
    unsigned char* down8 = (unsigned char*)(ws + OFF_DOWN);
    unsigned char* up8 = (unsigned char*)(ws + OFF_DOWN + ((size_t)16 << 20));
    float* dscale = (float*)(ws + OFF_UP);
    float* uscale = (float*)(ws + OFF_UP + 65536);
    float* small = (float*)(ws + OFF_SMALL);
    bf16_t* hbuf = (bf16_t*)(ws + OFF_H);
    bf16_t* proj = (bf16_t*)(ws + OFF_PROJ);
    bf16_t* qrope = (bf16_t*)(ws + OFF_QROPE);
    float* onsa = (float*)(ws + OFF_ONSA);
    float* yssd = (float*)(ws + OFF_YSSD);
    int* eidx = (int*)(ws + OFF_EIDX);
    float* gate = (float*)(ws + OFF_GATE);
    unsigned* ctr = (unsigned*)(ws + OFF_CTR);

    if (bid == 0 && threadIdx.x == 0) ctr[0] = 0u;
    for (int vb = bid; vb < 15714; vb += G) {
        int v = vb;
        if (v < 2944) { d_transpose_w(p.w_in, win_t, 1024, 2848, 1, v % 92, v / 92, lds); }
        else if ((v -= 2944) < 1024) { d_transpose_w(p.w_out, wout_t, 1024, 1024, 0, v & 31, v >> 5, lds); }
        else if ((v -= 1024) < 2048) { d_transpose_w(p.peer_wq, wq_t, 1024, 2048, 0, v & 63, v >> 6, lds); }
        else if ((v -= 2048) < 512) { d_transpose_w(p.cmp_w1_k, w1k_t, 2048, 256, 0, v & 7, v >> 3, lds); }
        else if ((v -= 512) < 512) { d_transpose_w(p.cmp_w1_v, w1v_t, 2048, 256, 0, v & 7, v >> 3, lds); }
        else if ((v -= 512) < 4096) { d_quant_rows(p.peer_down, down8, dscale, v); }
        else if ((v -= 4096) < 4096) { d_quant_rows(p.peer_up, up8, uscale, v); }
        else if ((v -= 4096) < 128) { d_convert_bf16(p.peer_sub_keys, subk, (size_t)8 * 2 * 128 * 128 / 8, v, 128); }
        else if ((v -= 128) < 96) { d_mod(p.c, p.w_ada, p.b_ada, mod, v, lds); }
        else if ((v -= 96) < 256) { d_rope_table(rope, v); }
        else { v -= 256; d_bias1(p.cmp_pe_k, p.cmp_w1_k, p.cmp_pe_v, p.cmp_w1_v, bias1, v); }
        __syncthreads();
    }
    grid.sync();
    for (int vb = bid; vb < NTOK; vb += G) { d_norm_mod(p.x, p.norm1_w, mod, 0, 1024, hbuf, vb, lds); __syncthreads(); }
    grid.sync();
    {
        const ALoadPlain al{hbuf, DM, 0}; const EpInProj ep{proj, qrope, small, rope, p.dt_bias};
        for (int vb = bid; vb < (NTOK / 128) * (NIN_PAD / 128); vb += G) d_gemm(al, win_t, 1024, NIN_PAD / 128, ep, vb, lds);
    }
    grid.sync();
    for (int vb = bid; vb < 256; vb += G) {
        if (vb < 128) { const ALoadCmp al{proj, C_KCMP, 0}; const EpCmpHid ep{hidk, bias1}; d_gemm(al, w1k_t, 2048, 2, ep, vb, lds); }
        else { const ALoadCmp al{proj, C_VCMP, 0}; const EpCmpHid ep{hidv, bias1 + 256}; d_gemm(al, w1v_t, 2048, 2, ep, vb - 128, lds); }
    }
    grid.sync();
    for (int vb = bid; vb < 2 * 2044; vb += G) {
        if (vb < 2044) d_cmp_out(hidk, p.cmp_w2_k, kc, vb); else d_cmp_out(hidv, p.cmp_w2_v, vc, vb - 2044);
    }
    grid.sync();
    for (int vb = bid; vb < 64; vb += G) { d_ssd(proj, small, p.conv_w, p.conv_b, p.a_log, p.d_skip, yssd, vb, lds); __syncthreads(); }
    for (;;) {
        if (threadIdx.x == 0) s_vb = (int)atomicAdd(&ctr[0], 1u);
        __syncthreads();
        const int i = s_vb;
        __syncthreads();
        if (i >= NB * 2 * 128) break;
        const int qt = 127 - (i >> 4), bg = i & 15;
        d_nsa_tile(proj, qrope, kc, vc, small, onsa, bg >> 1, bg & 1, qt, lds);
        __syncthreads();
    }
    grid.sync();
    for (int vb = bid; vb < NTOK; vb += G) { d_mix_prep(onsa, yssd, proj, p.nsa_norm_w, p.ssd_norm_w, hbuf, vb, lds); __syncthreads(); }
    grid.sync();
    {
        const ALoadPlain al{hbuf, DM, 0}; const EpOutProj ep{p.x, mod, p.out};
        for (int vb = bid; vb < (NTOK / 128) * 8; vb += G) d_gemm(al, wout_t, 1024, 8, ep, vb, lds);
    }
    grid.sync();
    for (int vb = bid; vb < NTOK; vb += G) { d_norm_mod(p.out, p.norm2_w, mod, 3072, 4096, hbuf, vb, lds); __syncthreads(); }
    grid.sync();
    {
        const ALoadPlain al{hbuf, DM, 0}; const EpStoreBf16 ep{proj, 2048, 0};
        for (int vb = bid; vb < (NTOK / 128) * 16; vb += G) d_gemm(al, wq_t, 1024, 16, ep, vb, lds);
    }
    grid.sync();
    for (int vb = bid; vb < 8192; vb += G) d_peer_route(proj, p.peer_qnorm_w, subk, eidx, gate, vb >> 3, vb & 7, lds);
    grid.sync();
    for (int vb = bid; vb < NTOK / 4; vb += G) d_peer_expert8(hbuf, down8, up8, dscale, uscale, eidx, gate, mod, p.final_norm_w, p.out, vb);
}

extern "C" void kernel_launch(void* const* d_in, const int* in_sizes, int n_in, void* d_out, int out_size, void* d_ws, size_t ws_size, hipStream_t stream) {
    if (ws_size < WS_NEED) { fprintf(stderr, "workspace too small\n"); return; }
    static int grid_blocks = 0;
    if (!grid_blocks) {
        int dev = 0, cus = 0, per_cu = 0;
        hipGetDevice(&dev);
        hipDeviceGetAttribute(&cus, hipDeviceAttributeMultiprocessorCount, dev);
        hipOccupancyMaxActiveBlocksPerMultiprocessor(&per_cu, mega, 256, 0);
        if (per_cu > 1) per_cu = 1;
        if (per_cu < 1) per_cu = 1;
        grid_blocks = cus * per_cu;
    }
    Params p{};
    const float** pp = (const float**)&p;
    for (int i = 0; i < 27; ++i) pp[i] = (const float*)d_in[i];
    p.out = (float*)d_out; p.ws = (char*)d_ws;
    void* args[] = {&p};
    hipError_t e = hipLaunchCooperativeKernel((void*)mega, dim3(grid_blocks), dim3(256), args, 0, stream);
    if (e != hipSuccess) fprintf(stderr, "cooperative launch failed: %s (grid %d)\n", hipGetErrorString(e), grid_blocks);
}
```

```cpp
#include <hip/hip_runtime.h>
#include <hip/hip_cooperative_groups.h>
#include <stdint.h>
#include <cstdio>
namespace cg = cooperative_groups;

typedef unsigned short bf16_t;
typedef short bf16x8 __attribute__((ext_vector_type(8)));
typedef float f32x4 __attribute__((ext_vector_type(4)));
typedef float f32x2 __attribute__((ext_vector_type(2)));
typedef unsigned u32x4 __attribute__((ext_vector_type(4)));
typedef unsigned u32x2 __attribute__((ext_vector_type(2)));

#define NB 8
#define SEQ 8192
#define NTOK 65536
#define DM 1024
#define PROJ_LD 2816
#define NIN_PAD 3072
#define C_Q 0
#define C_KCMP 512
#define C_KSEL 768
#define C_VSEL 896
#define C_KWIN 1024
#define C_VWIN 1152
#define C_Z 1280
#define C_XBC 1792
#define NCMP 511
#define EPS 1e-6f
#define KVP_SEG ((size_t)NB * 2 * SEQ * 64)

#define MIB(x) ((size_t)(x) << 20)
#define OFF_MOD    MIB(0)
#define OFF_ROPE   MIB(1)
#define OFF_BIAS1  MIB(2)
#define OFF_WIN_T  MIB(3)
#define OFF_WOUT_T MIB(9)
#define OFF_WQ_T   MIB(11)
#define OFF_SUBK   MIB(15)
#define OFF_W1K_T  MIB(16)
#define OFF_W1V_T  MIB(17)
#define OFF_KC     MIB(18)
#define OFF_VC     MIB(19)
#define OFF_HIDK   MIB(20)
#define OFF_HIDV   MIB(24)
#define OFF_DOWN   MIB(28)
#define OFF_UP     MIB(60)
#define OFF_SMALL  MIB(92)
#define OFF_H      MIB(100)
#define OFF_PROJ   MIB(228)
#define OFF_QROPE  MIB(580)
#define OFF_ONSA   MIB(644)
#define OFF_YSSD   MIB(772)
#define OFF_KVP    MIB(836)
#define OFF_EIDX   MIB(932)
#define OFF_GATE   MIB(964)
#define OFF_CTR    MIB(996)
#define WS_NEED    MIB(997)

__device__ __forceinline__ bf16_t f2bf(float f) { unsigned u = __float_as_uint(f); u += 0x7fffu + ((u >> 16) & 1u); return (bf16_t)(u >> 16); }
__device__ __forceinline__ float bf2f(bf16_t h) { return __uint_as_float(((unsigned)h) << 16); }
__device__ __forceinline__ float bflo(unsigned u) { return __uint_as_float(u << 16); }
__device__ __forceinline__ float bfhi(unsigned u) { return __uint_as_float(u & 0xffff0000u); }
__device__ __forceinline__ unsigned pack2(float a, float b) { return (unsigned)f2bf(a) | ((unsigned)f2bf(b) << 16); }
__device__ __forceinline__ float wave_sum(float v) {
#pragma unroll
    for (int o = 32; o; o >>= 1) v += __shfl_xor(v, o);
    return v;
}
__device__ __forceinline__ float wave_max(float v) {
#pragma unroll
    for (int o = 32; o; o >>= 1) v = fmaxf(v, __shfl_xor(v, o));
    return v;
}
__device__ __forceinline__ int tid_opaque() { int t = threadIdx.x; asm volatile("" : "+v"(t)); return t; }
__device__ __forceinline__ float gelu_tanh(float x) { return 0.5f * x * (1.0f + tanhf(0.7978845608028654f * (x + 0.044715f * x * x * x))); }
__device__ __forceinline__ float silu(float x) { return x / (1.0f + __expf(-x)); }
__device__ __forceinline__ float sigmoidf(float x) { return 1.0f / (1.0f + __expf(-x)); }
__device__ __forceinline__ float softplusf(float x) { return x > 20.f ? x : log1pf(__expf(x)); }

__device__ __forceinline__ int inproj_src(int n) {
    if (n < 1280) return n;
    if (n < 1792) return 1304 + (n - 1280);
    if (n < 2816) return 1816 + (n - 1792);
    if (n < 2840) return 1280 + (n - 2816);
    if (n < 2848) return 2840 + (n - 2840);
    return -1;
}
__device__ __forceinline__ void d_transpose_w(const float* __restrict__ W, bf16_t* __restrict__ Wt, int K, int N, int mode, int nbx, int vb, char* lds) {
    const int tid_ = tid_opaque(); const int half = tid_ >> 8, t256 = tid_ & 255, tile = vb * 2 + half;
    float (*t)[33] = (float (*)[33])(lds + half * 4352);
    const int n0 = (tile % nbx) * 32, k0 = (tile / nbx) * 32, tx = t256 & 31, ty = t256 >> 5;
#pragma unroll
    for (int i = 0; i < 4; ++i) {
        const int k = k0 + ty + 8 * i, n = n0 + tx;
        const int src = mode == 1 ? inproj_src(n) : n;
        t[ty + 8 * i][tx] = (src >= 0 && src < N) ? W[(size_t)k * N + src] : 0.f;
    }
    __syncthreads();
#pragma unroll
    for (int i = 0; i < 4; ++i) Wt[(size_t)(n0 + ty + 8 * i) * K + k0 + tx] = f2bf(t[tx][ty + 8 * i]);
    __syncthreads();
}
__device__ __forceinline__ void d_convert_bf16(const float* __restrict__ in, bf16_t* __restrict__ out, size_t n8, int vb, int nvb) {
    size_t i = (size_t)vb * 512 + tid_opaque();
    const size_t stride = (size_t)nvb * 512;
    for (; i < n8; i += stride) {
        const f32x4 a = ((const f32x4*)in)[2 * i], b = ((const f32x4*)in)[2 * i + 1];
        u32x4 o; o.x = pack2(a.x, a.y); o.y = pack2(a.z, a.w); o.z = pack2(b.x, b.y); o.w = pack2(b.z, b.w);
        ((u32x4*)out)[i] = o;
    }
}
__device__ __forceinline__ void d_mod(const float* __restrict__ c, const float* __restrict__ w_ada, const float* __restrict__ b_ada, float* __restrict__ mod, int vb, char* lds) {
    float (*part)[8][64] = (float (*)[8][64])lds;
    const int tid = tid_opaque(), jl = tid & 63, kq = tid >> 6, j = vb * 64 + jl;
    float acc[8];
#pragma unroll
    for (int b = 0; b < 8; ++b) acc[b] = 0.f;
    for (int k0 = kq * 128; k0 < kq * 128 + 128; k0 += 16) {
        float wv[16];
#pragma unroll
        for (int i = 0; i < 16; ++i) wv[i] = w_ada[(size_t)(k0 + i) * 6144 + j];
#pragma unroll
        for (int i = 0; i < 16; ++i)
#pragma unroll
            for (int b = 0; b < 8; ++b) acc[b] += c[b * 1024 + k0 + i] * wv[i];
    }
#pragma unroll
    for (int b = 0; b < 8; ++b) part[kq][b][jl] = acc[b];
    __syncthreads();
    {
        const int b = tid >> 6, jj = tid & 63;
        float s = b_ada[vb * 64 + jj];
#pragma unroll
        for (int q = 0; q < 8; ++q) s += part[q][b][jj];
        mod[b * 6144 + vb * 64 + jj] = s;
    }
    __syncthreads();
}
__device__ __forceinline__ void d_rope_table(float2* __restrict__ rope, int vb) {
    const int i = vb * 512 + tid_opaque();
    if (i >= SEQ * 8) return;
    const int pos = i >> 3, f = i & 7;
    const double inv = pow(500000.0, -(double)f / 8.0);
    const double ang = (double)pos * inv;
    rope[i] = make_float2((float)cos(ang), (float)sin(ang));
}
__device__ __forceinline__ void d_bias1(const float* __restrict__ pe_k, const float* __restrict__ w1_k, const float* __restrict__ pe_v, const float* __restrict__ w1_v, float* __restrict__ bias1) {
    const int tid_ = tid_opaque(); const int which = tid_ >> 8, j = tid_ & 255;
    const float* pe = which ? pe_v : pe_k; const float* w1 = which ? w1_v : w1_k;
    float a = 0.f;
    for (int k0 = 0; k0 < 2048; k0 += 16) {
        float wv[16];
#pragma unroll
        for (int i = 0; i < 16; ++i) wv[i] = w1[(size_t)(k0 + i) * 256 + j];
#pragma unroll
        for (int i = 0; i < 16; ++i) a += pe[k0 + i] * wv[i];
    }
    bias1[which * 256 + j] = a;
}

__device__ __forceinline__ void d_norm_mod(const float* __restrict__ x, const float* __restrict__ w, const float* __restrict__ mod, int sh_off, int sc_off, bf16_t* __restrict__ out, int vb) {
    const int tid_ = tid_opaque(); const int lane = tid_ & 63, wid = tid_ >> 6;
    const size_t row0 = (size_t)vb * 32 + wid * 4; const int b = (int)(row0 >> 13);
    f32x4 v[4][4];
#pragma unroll
    for (int r = 0; r < 4; ++r)
#pragma unroll
        for (int k = 0; k < 4; ++k) v[r][k] = *(const f32x4*)(x + (row0 + r) * DM + k * 256 + lane * 4);
    float rs[4];
#pragma unroll
    for (int r = 0; r < 4; ++r) {
        float ss = 0.f;
#pragma unroll
        for (int k = 0; k < 4; ++k) ss += v[r][k].x * v[r][k].x + v[r][k].y * v[r][k].y + v[r][k].z * v[r][k].z + v[r][k].w * v[r][k].w;
        rs[r] = rsqrtf(wave_sum(ss) * (1.0f / DM) + EPS);
    }
#pragma unroll
    for (int k = 0; k < 4; ++k) {
        const int col = k * 256 + lane * 4;
        const f32x4 wv = *(const f32x4*)(w + col), sc = *(const f32x4*)(mod + b * 6144 + sc_off + col), sh = *(const f32x4*)(mod + b * 6144 + sh_off + col);
        const f32x4 ws = wv * (sc + 1.0f);
#pragma unroll
        for (int r = 0; r < 4; ++r) {
            const f32x4 y = v[r][k] * rs[r] * ws + sh;
            u32x2 o; o.x = pack2(y.x, y.y); o.y = pack2(y.z, y.w);
            *(u32x2*)(out + (row0 + r) * DM + col) = o;
        }
    }
}

namespace pg8 {
#define PG8_LAS __attribute__((address_space(3)))
constexpr int BM = 256, BK = 64, HALF = 128, HTB = HALF * BK * 2  , STAGE_BYTES = 8 * HTB, NXCD = 8, WGM = 8;
__host__ __device__ __forceinline__ int lds_byte(int r, int c) { const int st = (r >> 4) * 2 + (c >> 5), rr = r & 15, cc = c & 31, ob = rr * 64 + cc * 2; return st * 1024 + (ob ^ (((ob >> 9) & 1) << 5)); }
__host__ __device__ __forceinline__ void stage_rc(int b, int& R, int& C) { const int st = b / 1024, sb = b % 1024, swz = sb ^ (((sb >> 9) & 1) << 5); R = (st >> 1) * 16 + swz / 64; C = (st & 1) * 32 + (swz % 64) / 2; }
struct Unit { int pm, pn; };
struct Gemm { const bf16_t* A; const bf16_t* Bt; int M, N, K, lda; };
struct StaticOrder {
    int nM, nN, nwg, G, c;
    __host__ __device__ void init(int M, int N, int G_, int c_) { nM = M / BM; nN = N / BM; nwg = nM * nN; G = G_; c = c_; }
    __host__ __device__ bool next(int i, Unit& u) const {
        const long L = (long)i * G + c; if (L >= nwg) return false;
        int wgid = (int)L; { const int q = nwg / NXCD, r = nwg % NXCD, xcd = wgid % NXCD, off = wgid / NXCD; wgid = (xcd < r ? xcd * (q + 1) : r * (q + 1) + (xcd - r) * q) + off; }
        const int nig = WGM * nN, gid = wgid / nig, fm = gid * WGM, gsz = (nM - fm) < WGM ? (nM - fm) : WGM;
        u.pm = fm + ((wgid % nig) % gsz); u.pn = (wgid % nig) / gsz; return true;
    }
};
template <class F> struct Epi {
    F f;
    __device__ __forceinline__ void operator()(const f32x4 (&acc)[2][2][4][2], const Unit& u, int wr, int wc, int fr, int fq) const {
#pragma unroll
        for (int ai = 0; ai < 2; ++ai)
#pragma unroll
            for (int m = 0; m < 4; ++m)
#pragma unroll
                for (int bj = 0; bj < 2; ++bj)
#pragma unroll
                    for (int n = 0; n < 2; ++n)
                        f(u.pm * BM + ai * HALF + wr * 64 + m * 16 + fr, u.pn * BM + bj * HALF + wc * 32 + n * 16 + 4 * fq, acc[ai][bj][m][n]);
    }
};
template <class E, class Sched>
__device__ __forceinline__ void gemm_phase(PG8_LAS unsigned char* lds, const Gemm g, const Sched& S, const E& Ep) {
    const int tid = tid_opaque(), wid = __builtin_amdgcn_readfirstlane(tid >> 6), lane = tid & 63, wr = wid >> 2, wc = wid & 3, fr = lane & 15, fq = lane >> 4;
    const int K = g.K, nt = K / BK;
    unsigned voffA[2], voffB[2];
#pragma unroll
    for (int i = 0; i < 2; ++i) { int R, C; stage_rc(tid * 16 + i * 8192, R, C); voffA[i] = (unsigned)(R * g.lda + C) * 2u; voffB[i] = (unsigned)(R * K + C) * 2u; }
    const size_t kstep = (size_t)(BK * 2);
    const size_t hstep = (size_t)HALF * K * 2, hstepA = (size_t)HALF * g.lda * 2;
    const size_t tstep = 2 * hstep, tstepA = 2 * hstepA;
    const unsigned ldsw = (unsigned)wid * 1024u;
    const int aoff = lds_byte(wr * 64 + fr, fq * 8), boff = lds_byte(wc * 32 + fr, fq * 8);
#define PG8_SA(b, h) (((b) * 2 + (h)) * HTB)
#define PG8_SB(b, h) ((4 + (b) * 2 + (h)) * HTB)
#define PG8_STAGE(bufoff, gbase, voff) do { _Pragma("unroll") for (int _i = 0; _i < 2; ++_i) \
        __builtin_amdgcn_global_load_lds((const unsigned*)((const char*)(gbase) + (voff)[_i]), (PG8_LAS unsigned*)(lds + (bufoff) + ldsw + _i * 8192), 16, 0, 0); } while (0)
#define PG8_LDA(dst, b, h) do { _Pragma("unroll") for (int m = 0; m < 4; ++m) _Pragma("unroll") for (int k = 0; k < 2; ++k) dst[m][k] = *(const PG8_LAS bf16x8*)(lds + PG8_SA(b, h) + aoff + m * 2048 + k * 1024); } while (0)
#define PG8_LDB(dst, b, h) do { _Pragma("unroll") for (int n = 0; n < 2; ++n) _Pragma("unroll") for (int k = 0; k < 2; ++k) dst[n][k] = *(const PG8_LAS bf16x8*)(lds + PG8_SB(b, h) + boff + n * 2048 + k * 1024); } while (0)
#define PG8_MMA(ai, bj, At, Bt) do { __builtin_amdgcn_s_setprio(1); _Pragma("unroll") for (int m = 0; m < 4; ++m) _Pragma("unroll") for (int n = 0; n < 2; ++n) _Pragma("unroll") for (int k = 0; k < 2; ++k) \
        acc[ai][bj][m][n] = __builtin_amdgcn_mfma_f32_16x16x32_bf16(Bt[n][k], At[m][k], acc[ai][bj][m][n], 0, 0, 0); __builtin_amdgcn_s_setprio(0); } while (0)
#define PG8_WAIT_V(n) asm volatile("s_waitcnt vmcnt(" #n ")" ::: "memory")
#define PG8_WAIT_L(n) asm volatile("s_waitcnt lgkmcnt(" #n ")" ::: "memory")
#define PG8_BAR __builtin_amdgcn_s_barrier()
#define PG8_SCHED __builtin_amdgcn_sched_barrier(0)
    Unit cur, nxt; int ui = 0;
    if (!S.next(0, cur)) return;
    f32x4 acc[2][2][4][2];
#pragma unroll
    for (int a = 0; a < 2; ++a)
#pragma unroll
        for (int b = 0; b < 2; ++b)
#pragma unroll
            for (int m = 0; m < 4; ++m)
#pragma unroll
                for (int n = 0; n < 2; ++n) acc[a][b][m][n] = (f32x4){0.f, 0.f, 0.f, 0.f};
    bf16x8 At[4][2], B0[2][2], B1[2][2];
    const char* cA = (const char*)g.A + (size_t)cur.pm * tstepA; const char* cB = (const char*)g.Bt + (size_t)cur.pn * tstep;
    PG8_STAGE(PG8_SB(0, 0), cB, voffB); PG8_STAGE(PG8_SB(0, 1), cB + hstep, voffB); PG8_STAGE(PG8_SA(0, 0), cA, voffA); PG8_STAGE(PG8_SA(0, 1), cA + hstepA, voffA);
    if (wr == 1) PG8_BAR;
    PG8_WAIT_V(2); PG8_BAR;
    PG8_STAGE(PG8_SB(1, 0), cB + kstep, voffB); PG8_STAGE(PG8_SA(1, 0), cA + kstep, voffA); PG8_STAGE(PG8_SB(1, 1), cB + hstep + kstep, voffB);
    PG8_WAIT_V(6); PG8_BAR;
    for (;;) {
        const bool has_next = S.next(ui + 1, nxt);
        const char* nA = has_next ? (const char*)g.A + (size_t)nxt.pm * tstepA : cA; const char* nB = has_next ? (const char*)g.Bt + (size_t)nxt.pn * tstep : cB;
        for (int t = 0; t < nt; t += 2) {
            const bool last = (t == nt - 2);
            const char* a1 = cA + (size_t)(t + 1) * kstep;
            const char* a2 = last ? nA : cA + (size_t)(t + 2) * kstep; const char* b2 = last ? nB : cB + (size_t)(t + 2) * kstep;
            const char* a3 = a2 + kstep; const char* b3 = b2 + kstep;
            PG8_LDB(B0, 0, 0); PG8_LDB(B1, 0, 1); PG8_SCHED; PG8_LDA(At, 0, 0); PG8_STAGE(PG8_SA(1, 1), a1 + hstepA, voffA);
            PG8_WAIT_V(8); PG8_WAIT_L(0); PG8_BAR; PG8_MMA(0, 0, At, B0); PG8_MMA(0, 1, At, B1); PG8_BAR; PG8_SCHED;
            PG8_LDA(At, 0, 1); PG8_STAGE(PG8_SB(0, 0), b2, voffB); PG8_STAGE(PG8_SB(0, 1), b2 + hstep, voffB); PG8_STAGE(PG8_SA(0, 0), a2, voffA);
            PG8_WAIT_V(8); PG8_WAIT_L(0); PG8_BAR; PG8_MMA(1, 0, At, B0); PG8_MMA(1, 1, At, B1); PG8_BAR; PG8_SCHED;
            PG8_LDB(B0, 1, 0); PG8_LDB(B1, 1, 1); PG8_SCHED; PG8_LDA(At, 1, 0); PG8_STAGE(PG8_SA(0, 1), a2 + hstepA, voffA);
            PG8_WAIT_V(8); PG8_WAIT_L(0); PG8_BAR; PG8_MMA(0, 0, At, B0); PG8_MMA(0, 1, At, B1); PG8_BAR; PG8_SCHED;
            PG8_LDA(At, 1, 1); PG8_STAGE(PG8_SB(1, 0), b3, voffB); PG8_STAGE(PG8_SB(1, 1), b3 + hstep, voffB); PG8_STAGE(PG8_SA(1, 0), a3, voffA);
            PG8_WAIT_V(8); PG8_WAIT_L(0); PG8_BAR; PG8_MMA(1, 0, At, B0); PG8_MMA(1, 1, At, B1); PG8_BAR; PG8_SCHED;
        }
        if (wr == 0) PG8_BAR;
        Ep(acc, cur, wr, wc, fr, fq);
        if (!has_next) break;
#pragma unroll
        for (int a = 0; a < 2; ++a)
#pragma unroll
            for (int b = 0; b < 2; ++b)
#pragma unroll
                for (int m = 0; m < 4; ++m)
#pragma unroll
                    for (int n = 0; n < 2; ++n) acc[a][b][m][n] = (f32x4){0.f, 0.f, 0.f, 0.f};
        cur = nxt; cA = nA; cB = nB; ++ui;
        if (wr == 1) PG8_BAR;
    }
    PG8_WAIT_V(0);
    PG8_BAR;
#undef PG8_SA
#undef PG8_SB
#undef PG8_STAGE
#undef PG8_LDA
#undef PG8_LDB
#undef PG8_MMA
#undef PG8_WAIT_V
#undef PG8_WAIT_L
#undef PG8_BAR
#undef PG8_SCHED
}
}

struct EpInProj { bf16_t* proj; bf16_t* qrope; bf16_t* kvp; float* small; const float2* rope; const float* dt_bias;
    __device__ __forceinline__ void operator()(int m, int n0, f32x4 v) const {
        if (n0 < 2816) {
            const bool is_q = n0 < 512;
            const bool roped_seg = is_q || (n0 >= C_KSEL && n0 < C_VSEL) || (n0 >= C_KWIN && n0 < C_VWIN);
            const bool rope_dims = roped_seg && ((n0 & 63) < 16);
            u32x2 raw; raw.x = pack2(v.x, v.y); raw.y = pack2(v.z, v.w);
            if (is_q) *(u32x2*)(proj + (size_t)m * PROJ_LD + n0) = raw;
            if (rope_dims) {
                f32x4 p; p.x = __shfl_xor(v.x, 32); p.y = __shfl_xor(v.y, 32); p.z = __shfl_xor(v.z, 32); p.w = __shfl_xor(v.w, 32);
                const int i0 = n0 & 15, pos = m & (SEQ - 1);
                const float sgn = i0 < 8 ? -1.f : 1.f;
                const float2* rp = rope + pos * 8 + (i0 & 7);
                const float2 c0 = rp[0], c1 = rp[1], c2 = rp[2], c3 = rp[3];
                v.x = v.x * c0.x + sgn * p.x * c0.y; v.y = v.y * c1.x + sgn * p.y * c1.y;
                v.z = v.z * c2.x + sgn * p.z * c2.y; v.w = v.w * c3.x + sgn * p.w * c3.y;
            }
            u32x2 o; o.x = pack2(v.x, v.y); o.y = pack2(v.z, v.w);
            if (is_q) *(u32x2*)(qrope + (size_t)m * 512 + n0) = o;
            else if (n0 < C_Z) {
                const int r = n0 - C_KCMP, seg = r >> 7, g = (r >> 6) & 1, d = r & 63, bb = m >> 13, t = m & (SEQ - 1);
                *(u32x2*)(kvp + (size_t)seg * KVP_SEG + ((size_t)(bb * 2 + g) * SEQ + t) * 64 + d) = o;
            }
            else *(u32x2*)(proj + (size_t)m * PROJ_LD + n0) = o;
        } else if (n0 < 2848) {
            const int c = n0 - 2816; f32x4 o;
            if (c < 24) { o.x = sigmoidf(v.x); o.y = sigmoidf(v.y); o.z = sigmoidf(v.z); o.w = sigmoidf(v.w); }
            else { const float* db = dt_bias + (c - 24); o.x = softplusf(v.x + db[0]); o.y = softplusf(v.y + db[1]); o.z = softplusf(v.z + db[2]); o.w = softplusf(v.w + db[3]); }
            *(f32x4*)(small + (size_t)m * 32 + c) = o;
        }
    } };
struct EpCmpHid { bf16_t* hid; const float* bias;
    __device__ __forceinline__ void operator()(int m, int n0, f32x4 v) const {
        const f32x4 b = *(const f32x4*)(bias + n0);
        u32x2 o; o.x = pack2(gelu_tanh(v.x + b.x), gelu_tanh(v.y + b.y)); o.y = pack2(gelu_tanh(v.z + b.z), gelu_tanh(v.w + b.w));
        *(u32x2*)(hid + (size_t)m * 256 + n0) = o;
    } };
struct EpOutProj { const float* x; const float* mod; float* x1;
    __device__ __forceinline__ void operator()(int m, int n0, f32x4 v) const {
        const int b = m >> 13;
        const f32x4 xv = *(const f32x4*)(x + (size_t)m * DM + n0);
        const f32x4 g = *(const f32x4*)(mod + b * 6144 + 2048 + n0);
        f32x4 o; o.x = xv.x + g.x * v.x; o.y = xv.y + g.y * v.y; o.z = xv.z + g.z * v.z; o.w = xv.w + g.w * v.w;
        *(f32x4*)(x1 + (size_t)m * DM + n0) = o;
    } };
struct EpStoreBf16 { bf16_t* out; int ld; int pad;
    __device__ __forceinline__ void operator()(int m, int n0, f32x4 v) const {
        u32x2 o; o.x = pack2(v.x, v.y); o.y = pack2(v.z, v.w);
        *(u32x2*)(out + (size_t)m * ld + n0) = o;
    } };

__device__ __forceinline__ void d_cmp_out(const bf16_t* __restrict__ hid, const float* __restrict__ w2, bf16_t* __restrict__ out, int vb) {
    const int tid_ = tid_opaque(); const int m = vb * 8 + (tid_ >> 6), d = tid_ & 63;
    float a = 0.f;
#pragma unroll 8
    for (int j = 0; j < 256; ++j) a += bf2f(hid[(size_t)m * 256 + j]) * w2[j * 64 + d];
    out[(size_t)m * 64 + d] = f2bf(a);
}

#define KLD 72
#define NSA_OFF_KS0  0
#define NSA_OFF_VT0  9216
#define NSA_OFF_KS1  18432
#define NSA_OFF_VT1  27648
#define NSA_OFF_IMP  36864
#define NSA_OFF_SELW 70656
#define NSA_OFF_ANYW 71680
#define NSA_OFF_BL   71712
#define NSA_OFF_QS   72256
#define NSA_LDS      (72256 + 8 * 32 * KLD * 2)
#define SM_C 0.18033688011112042f

struct KVStage { u32x4 k, v; };
__device__ __forceinline__ void nsa_stage_load(KVStage& st, const bf16_t* kb, const bf16_t* vb, int tid) {
    st.k = *(const u32x4*)(kb + tid * 8); st.v = *(const u32x4*)(vb + tid * 8);
}
__device__ __forceinline__ void nsa_stage_store(bf16_t* Ks, bf16_t* Vt, int tid, const KVStage& st) {
    const int r = tid >> 3, c = tid & 7;
    *(u32x4*)(Ks + r * KLD + c * 8) = st.k;
    bf16_t* vt = Vt + (c * 8) * KLD + r;
    vt[0 * KLD] = (bf16_t)(st.v.x & 0xffffu); vt[1 * KLD] = (bf16_t)(st.v.x >> 16);
    vt[2 * KLD] = (bf16_t)(st.v.y & 0xffffu); vt[3 * KLD] = (bf16_t)(st.v.y >> 16);
    vt[4 * KLD] = (bf16_t)(st.v.z & 0xffffu); vt[5 * KLD] = (bf16_t)(st.v.z >> 16);
    vt[6 * KLD] = (bf16_t)(st.v.w & 0xffffu); vt[7 * KLD] = (bf16_t)(st.v.w >> 16);
}
__device__ __forceinline__ void nsa_load_q(const bf16_t* qsrc, size_t ld, int lane, bf16_t* Qs) {
    u32x4 r[4];
#pragma unroll
    for (int i = 0; i < 4; ++i) { const int p = lane + 64 * i; r[i] = *(const u32x4*)(qsrc + (size_t)(p >> 3) * ld + (p & 7) * 8); }
#pragma unroll
    for (int i = 0; i < 4; ++i) { const int p = lane + 64 * i; *(u32x4*)(Qs + (p >> 3) * KLD + (p & 7) * 8) = r[i]; }
}
__device__ __forceinline__ void nsa_qk(const bf16_t* Ks, const bf16_t* Qs, f32x4 (&s)[4][2], int fr, int fq) {
#pragma unroll
    for (int kt = 0; kt < 4; ++kt)
#pragma unroll
        for (int tt = 0; tt < 2; ++tt) s[kt][tt] = (f32x4){0.f, 0.f, 0.f, 0.f};
#pragma unroll
    for (int ks = 0; ks < 2; ++ks) {
        bf16x8 qf[2];
#pragma unroll
        for (int tt = 0; tt < 2; ++tt) qf[tt] = *(const bf16x8*)(Qs + (tt * 16 + fr) * KLD + ks * 32 + fq * 8);
#pragma unroll
        for (int kt = 0; kt < 4; ++kt) {
            const bf16x8 kf = *(const bf16x8*)(Ks + (kt * 16 + fr) * KLD + ks * 32 + fq * 8);
#pragma unroll
            for (int tt = 0; tt < 2; ++tt) s[kt][tt] = __builtin_amdgcn_mfma_f32_16x16x32_bf16(kf, qf[tt], s[kt][tt], 0, 0, 0);
        }
    }
}
__device__ __forceinline__ void nsa_pv(const bf16_t* Vt, const f32x4 (&p)[4][2], f32x4 (&o)[4][2], int fr, int fq) {
#pragma unroll
    for (int ks2 = 0; ks2 < 2; ++ks2) {
        bf16x8 pf[2];
#pragma unroll
        for (int tt = 0; tt < 2; ++tt) {
            const f32x4 a = p[2 * ks2][tt], b = p[2 * ks2 + 1][tt];
            u32x4 w; w.x = pack2(a.x, a.y); w.y = pack2(a.z, a.w); w.z = pack2(b.x, b.y); w.w = pack2(b.z, b.w);
            pf[tt] = __builtin_bit_cast(bf16x8, w);
        }
#pragma unroll
        for (int dt = 0; dt < 4; ++dt) {
            const bf16_t* vp = Vt + (dt * 16 + fr) * KLD + ks2 * 32 + 4 * fq;
            const u32x2 a0 = *(const u32x2*)vp, a1 = *(const u32x2*)(vp + 16);
            u32x4 w; w.x = a0.x; w.y = a0.y; w.z = a1.x; w.w = a1.y;
            const bf16x8 vf = __builtin_bit_cast(bf16x8, w);
#pragma unroll
            for (int tt = 0; tt < 2; ++tt) o[dt][tt] = __builtin_amdgcn_mfma_f32_16x16x32_bf16(vf, pf[tt], o[dt][tt], 0, 0, 0);
        }
    }
}
template <int MK>
__device__ __forceinline__ bool nsa_valid(int kk, int ti, int n0, int t0) {
    if (MK == 1) return kk <= ti;
    if (MK == 2) return kk > ti;
    return 16 * (n0 + kk) + 31 <= t0 + ti;
}
template <int MK, bool WITH_O>
__device__ __forceinline__ void nsa_softmax(f32x4 (&s)[4][2], float (&m)[2], float (&l)[2], f32x4 (&o)[4][2], const bool (&selb)[2], int tib, int fq, int n0, int t0) {
#pragma unroll
    for (int tt = 0; tt < 2; ++tt) {
        const int ti = tib + tt * 16;
        float mx = -1e30f;
#pragma unroll
        for (int kt = 0; kt < 4; ++kt)
#pragma unroll
            for (int jj = 0; jj < 4; ++jj) {
                const int kk = kt * 16 + 4 * fq + jj;
                const bool v = selb[tt] && nsa_valid<MK>(kk, ti, n0, t0);
                const float sv = v ? s[kt][tt][jj] * SM_C : -1e30f;
                s[kt][tt][jj] = sv; mx = fmaxf(mx, sv);
            }
        mx = fmaxf(mx, __shfl_xor(mx, 16)); mx = fmaxf(mx, __shfl_xor(mx, 32));
        const float mn = fmaxf(m[tt], mx);
        const float alpha = __builtin_amdgcn_exp2f(m[tt] - mn);
        m[tt] = mn;
        float ls = 0.f;
#pragma unroll
        for (int kt = 0; kt < 4; ++kt)
#pragma unroll
            for (int jj = 0; jj < 4; ++jj) {
                const float sv = s[kt][tt][jj];
                const float pv = sv > -1e29f ? __builtin_amdgcn_exp2f(sv - mn) : 0.f;
                s[kt][tt][jj] = pv; ls += pv;
            }
        l[tt] = l[tt] * alpha + ls;
        if (WITH_O) {
#pragma unroll
            for (int dt = 0; dt < 4; ++dt) o[dt][tt] *= alpha;
        }
    }
}
__device__ __forceinline__ void nsa_softmax_fast(f32x4 (&s)[4][2], float (&m)[2], float (&l)[2], f32x4 (&o)[4][2], const float (&bias)[2]) {
#pragma unroll
    for (int tt = 0; tt < 2; ++tt) {
        float mr = fmaxf(fmaxf(s[0][tt][0], s[0][tt][1]), fmaxf(s[0][tt][2], s[0][tt][3]));
#pragma unroll
        for (int kt = 1; kt < 4; ++kt) mr = fmaxf(mr, fmaxf(fmaxf(s[kt][tt][0], s[kt][tt][1]), fmaxf(s[kt][tt][2], s[kt][tt][3])));
        mr = fmaxf(mr, __shfl_xor(mr, 16)); mr = fmaxf(mr, __shfl_xor(mr, 32));
        const float mx = mr * SM_C + bias[tt];
        const float mold = m[tt], mn = fmaxf(mold, mx);
        m[tt] = mn;
        const float off = bias[tt] - mn;
        float ls = 0.f;
#pragma unroll
        for (int kt = 0; kt < 4; ++kt)
#pragma unroll
            for (int jj = 0; jj < 4; ++jj) { const float pv = __builtin_amdgcn_exp2f(__builtin_fmaf(s[kt][tt][jj], SM_C, off)); s[kt][tt][jj] = pv; ls += pv; }
        if (__builtin_amdgcn_ballot_w64(mn > mold) != 0ull) {
            const float alpha = __builtin_amdgcn_exp2f(mold - mn);
            l[tt] = l[tt] * alpha + ls;
#pragma unroll
            for (int dt = 0; dt < 4; ++dt) o[dt][tt] *= alpha;
        } else l[tt] += ls;
    }
}
__device__ __forceinline__ void ins16(unsigned (&L)[16], unsigned x) {
#pragma unroll
    for (int i = 0; i < 16; ++i) { const unsigned hi = L[i] > x ? L[i] : x; x = L[i] > x ? x : L[i]; L[i] = hi; }
}
__device__ __forceinline__ void merge16(unsigned (&L)[16], const unsigned (&P)[16]) {
#pragma unroll
    for (int i = 0; i < 16; ++i) L[i] = L[i] > P[15 - i] ? L[i] : P[15 - i];
#pragma unroll
    for (int st = 8; st >= 1; st >>= 1)
#pragma unroll
        for (int i = 0; i < 16; ++i)
            if ((i & st) == 0) { const unsigned a = L[i], b = L[i + st]; L[i] = a > b ? a : b; L[i + st] = a > b ? b : a; }
}
template <bool ACCUM>
__device__ __forceinline__ void nsa_emit(const f32x4 (&o)[4][2], const float (&l)[2], bool l_is_partial, const float* gsrc, float* obase, int tib, int fq) {
#pragma unroll
    for (int tt = 0; tt < 2; ++tt) {
        float lt = l[tt];
        if (l_is_partial) { lt += __shfl_xor(lt, 16); lt += __shfl_xor(lt, 32); }
        const int ti = tib + tt * 16;
        const float gv = gsrc[(size_t)ti * 32];
        const float sc = l_is_partial ? (lt > 0.f ? gv / lt : 0.f) : gv;
#pragma unroll
        for (int dt = 0; dt < 4; ++dt) {
            float* op = obase + (size_t)ti * 512 + dt * 16 + 4 * fq;
            f32x4 v = o[dt][tt] * sc;
            if (ACCUM) v += *(const f32x4*)op;
            *(f32x4*)op = v;
        }
    }
}
struct NsaBufs { bf16_t *Ks0, *Vt0, *Ks1, *Vt1; };
template <class SRC, class BODY>
__device__ __forceinline__ void nsa_pipeline(int n, const bf16_t* kb, const bf16_t* vb, const NsaBufs& B, int tid, SRC src, BODY body) {
    KVStage sa, sb;
    nsa_stage_load(sa, kb + (size_t)src(0) * 4096, vb + (size_t)src(0) * 4096, tid);
    sb = sa;
    if (n > 1) nsa_stage_load(sb, kb + (size_t)src(1) * 4096, vb + (size_t)src(1) * 4096, tid);
    __syncthreads();
    nsa_stage_store(B.Ks0, B.Vt0, tid, sa);
    sa = sb;
    if (n > 2) nsa_stage_load(sb, kb + (size_t)src(2) * 4096, vb + (size_t)src(2) * 4096, tid);
#pragma unroll 1
    for (int i = 0; i < n; ++i) {
        __syncthreads();
        bf16_t* Ks = (i & 1) ? B.Ks1 : B.Ks0; bf16_t* Vt = (i & 1) ? B.Vt1 : B.Vt0;
        if (i + 1 < n) nsa_stage_store((i & 1) ? B.Ks0 : B.Ks1, (i & 1) ? B.Vt0 : B.Vt1, tid, sa);
        sa = sb;
        if (i + 3 < n) nsa_stage_load(sb, kb + (size_t)src(i + 3) * 4096, vb + (size_t)src(i + 3) * 4096, tid);
        body(src(i), Ks, Vt);
    }
}

__device__ __forceinline__ void d_nsa_cmp(const bf16_t* __restrict__ proj, const bf16_t* __restrict__ kc, const bf16_t* __restrict__ vc,
                                          const float* __restrict__ small, float* __restrict__ onsa, unsigned* __restrict__ selrec, int b, int g, int qt, char* lds) {
    const NsaBufs B{(bf16_t*)(lds + NSA_OFF_KS0), (bf16_t*)(lds + NSA_OFF_VT0), (bf16_t*)(lds + NSA_OFF_KS1), (bf16_t*)(lds + NSA_OFF_VT1)};
    float* imp = (float*)(lds + NSA_OFF_IMP);
    unsigned* selw = (unsigned*)(lds + NSA_OFF_SELW);
    unsigned* anyw = (unsigned*)(lds + NSA_OFF_ANYW);
    int* blist = (int*)(lds + NSA_OFF_BL);
    const int tid = tid_opaque(), lane = tid & 63, w = tid >> 6, hd = w & 3, th = w >> 2, fr = lane & 15, fq = lane >> 4;
    const int tib = th * 32 + fr;
    const size_t tok0 = (size_t)b * SEQ + (size_t)qt * 64;
    const int t0 = qt * 64;
    const float* gbase = small + tok0 * 32 + g * 12 + hd * 3;
    float* obase = onsa + tok0 * 512 + g * 256 + hd * 64;
    const bool sel_all[2] = {true, true};
    const float bias0[2] = {0.f, 0.f};

    for (int i = tid; i < 64 * 132; i += 512) imp[i] = 0.f;
    if (tid < 4) anyw[tid] = 0u;

    bf16_t* Qs = (bf16_t*)(lds + NSA_OFF_QS) + w * 32 * KLD;
    f32x4 s[4][2], o[4][2];
    float m[2], l[2];

    nsa_load_q(proj + (tok0 + th * 32) * PROJ_LD + C_Q + g * 256 + hd * 64, PROJ_LD, lane, Qs);
    const int ncb = (4 * qt + 3 + 63) >> 6;
    {
        const bf16_t* kb = kc + (size_t)(b * 2 + g) * 512 * 64;
        const bf16_t* vb = vc + (size_t)(b * 2 + g) * 512 * 64;
#pragma unroll
        for (int tt = 0; tt < 2; ++tt) { m[tt] = -1e30f; l[tt] = 0.f; }
        nsa_pipeline(ncb, kb, vb, B, tid, [&](int i) { return i; }, [&](int blk_, bf16_t* Ks, bf16_t* Vt) {
            nsa_qk(Ks, Qs, s, fr, fq);
            nsa_softmax<3, false>(s, m, l, o, sel_all, tib, fq, blk_ * 64, t0);
        });
        float linv[2];
#pragma unroll
        for (int tt = 0; tt < 2; ++tt) { float lt = l[tt]; lt += __shfl_xor(lt, 16); lt += __shfl_xor(lt, 32); linv[tt] = lt > 0.f ? 1.0f / lt : 0.f; }
#pragma unroll
        for (int dt = 0; dt < 4; ++dt)
#pragma unroll
            for (int tt = 0; tt < 2; ++tt) o[dt][tt] = (f32x4){0.f, 0.f, 0.f, 0.f};
        nsa_pipeline(ncb, kb, vb, B, tid, [&](int i) { return i; }, [&](int blk_, bf16_t* Ks, bf16_t* Vt) {
            nsa_qk(Ks, Qs, s, fr, fq);
#pragma unroll
            for (int tt = 0; tt < 2; ++tt) {
                const int ti = tib + tt * 16;
#pragma unroll
                for (int kt = 0; kt < 4; ++kt) {
                    f32x4 pv;
#pragma unroll
                    for (int jj = 0; jj < 4; ++jj) {
                        const int kk = kt * 16 + 4 * fq + jj;
                        const bool v = nsa_valid<3>(kk, ti, blk_ * 64, t0);
                        pv[jj] = v ? __builtin_amdgcn_exp2f(s[kt][tt][jj] * SM_C - m[tt]) * linv[tt] : 0.f;
                    }
                    s[kt][tt] = pv;
                    const int j = blk_ * 16 + kt * 4 + fq;
                    atomicAdd(imp + ti * 132 + (j >> 5) * 33 + (j & 31), pv[0] + pv[1] + pv[2] + 0.5f * pv[3]);
                    if (j + 1 < 128) { const int j1 = j + 1; atomicAdd(imp + ti * 132 + (j1 >> 5) * 33 + (j1 & 31), 0.5f * pv[3]); }
                }
            }
            nsa_pv(Vt, s, o, fr, fq);
        });
        nsa_emit<false>(o, l, false, gbase + 0, obase, tib, fq);
    }
    __syncthreads();
    {
        const int ti = tid >> 3, q8 = tid & 7;
        unsigned L[16];
#pragma unroll
        for (int i = 0; i < 16; ++i) L[i] = 0u;
#pragma unroll
        for (int i = 0; i < 16; ++i) {
            const int j = q8 * 16 + i;
            const bool forced = (j == 0) || (j == qt) || (j == qt - 1);
            const float v = imp[ti * 132 + (j >> 5) * 33 + (j & 31)] + (forced ? 1e4f : 0.f) + 1e-30f;
            const unsigned x = (j <= qt) ? ((__float_as_uint(v) & ~0x7Fu) | (unsigned)(127 - j)) : 0u;
            ins16(L, x);
        }
#pragma unroll
        for (int r = 1; r <= 4; r <<= 1) {
            unsigned P[16];
#pragma unroll
            for (int i = 0; i < 16; ++i) P[i] = (unsigned)__shfl_xor((int)L[i], r);
            merge16(L, P);
        }
        if (q8 < 4) {
            unsigned word = 0u;
#pragma unroll
            for (int i = 0; i < 16; ++i) {
                const unsigned e = L[i];
                const int j = 127 - (int)(e & 0x7Fu);
                if (e != 0u && (j >> 5) == q8) word |= 1u << (j & 31);
            }
            selw[ti * 4 + q8] = word;
            atomicOr(&anyw[q8], word);
        }
    }
    __syncthreads();
    int nsel;
    {
        const unsigned a0 = anyw[0], a1 = anyw[1], a2 = anyw[2], a3 = anyw[3];
        if (tid < 128) {
            const unsigned wd = tid < 32 ? a0 : tid < 64 ? a1 : tid < 96 ? a2 : a3;
            if ((wd >> (tid & 31)) & 1u) {
                int pos = __popc(wd & ((1u << (tid & 31)) - 1u));
                if (tid >= 32) pos += __popc(a0);
                if (tid >= 64) pos += __popc(a1);
                if (tid >= 96) pos += __popc(a2);
                blist[pos] = tid;
            }
        }
        nsel = __builtin_amdgcn_readfirstlane(__popc(a0) + __popc(a1) + __popc(a2) + __popc(a3));
    }
    __syncthreads();
    if (tid < 256) selrec[tid] = selw[tid];
    if (tid < 128) selrec[256 + tid] = (unsigned)blist[tid];
    if (tid == 0) selrec[384] = (unsigned)nsel;
    __syncthreads();
}

__device__ __forceinline__ void d_nsa_attn(const bf16_t* __restrict__ qrope, const bf16_t* __restrict__ kvp, const float* __restrict__ small, float* __restrict__ onsa,
                                           const unsigned* __restrict__ selrec, int b, int g, int qt, char* lds) {
    const NsaBufs B{(bf16_t*)(lds + NSA_OFF_KS0), (bf16_t*)(lds + NSA_OFF_VT0), (bf16_t*)(lds + NSA_OFF_KS1), (bf16_t*)(lds + NSA_OFF_VT1)};
    unsigned* selw = (unsigned*)(lds + NSA_OFF_SELW);
    int* blist = (int*)(lds + NSA_OFF_BL);
    const int tid = tid_opaque(), lane = tid & 63, w = tid >> 6, hd = w & 3, th = w >> 2, fr = lane & 15, fq = lane >> 4;
    const int tib = th * 32 + fr;
    const size_t tok0 = (size_t)b * SEQ + (size_t)qt * 64;
    const float* gbase = small + tok0 * 32 + g * 12 + hd * 3;
    float* obase = onsa + tok0 * 512 + g * 256 + hd * 64;
    const bool sel_all[2] = {true, true};
    const float bias0[2] = {0.f, 0.f};
    bf16_t* Qs = (bf16_t*)(lds + NSA_OFF_QS) + w * 32 * KLD;
    f32x4 s[4][2], o[4][2];
    float m[2], l[2];
    if (tid < 256) selw[tid] = selrec[tid];
    if (tid < 128) blist[tid] = (int)selrec[256 + tid];
    const int nsel = __builtin_amdgcn_readfirstlane((int)selrec[384]);
    __syncthreads();
    nsa_load_q(qrope + (tok0 + th * 32) * 512 + g * 256 + hd * 64, 512, lane, Qs);
    {
        const bf16_t* kb = kvp + 2 * KVP_SEG + (size_t)(b * 2 + g) * SEQ * 64;
        const bf16_t* vb = kvp + 3 * KVP_SEG + (size_t)(b * 2 + g) * SEQ * 64;
#pragma unroll
        for (int tt = 0; tt < 2; ++tt) { m[tt] = -1e30f; l[tt] = 0.f; }
#pragma unroll
        for (int dt = 0; dt < 4; ++dt)
#pragma unroll
            for (int tt = 0; tt < 2; ++tt) o[dt][tt] = (f32x4){0.f, 0.f, 0.f, 0.f};
        nsa_pipeline(nsel, kb, vb, B, tid, [&](int i) { return __builtin_amdgcn_readfirstlane(blist[i]); }, [&](int blk_, bf16_t* Ks, bf16_t* Vt) {
            nsa_qk(Ks, Qs, s, fr, fq);
            bool selb[2];
#pragma unroll
            for (int tt = 0; tt < 2; ++tt) selb[tt] = (selw[(tib + tt * 16) * 4 + (blk_ >> 5)] >> (blk_ & 31)) & 1u;
            if (blk_ == qt) nsa_softmax<1, true>(s, m, l, o, selb, tib, fq, 0, 0);
            else {
                float bias[2];
#pragma unroll
                for (int tt = 0; tt < 2; ++tt) bias[tt] = selb[tt] ? 0.f : -1e30f;
                nsa_softmax_fast(s, m, l, o, bias);
            }
            nsa_pv(Vt, s, o, fr, fq);
        });
        nsa_emit<true>(o, l, true, gbase + 1, obase, tib, fq);
    }
    {
        const bf16_t* kb = kvp + 4 * KVP_SEG + (size_t)(b * 2 + g) * SEQ * 64;
        const bf16_t* vb = kvp + 5 * KVP_SEG + (size_t)(b * 2 + g) * SEQ * 64;
#pragma unroll
        for (int tt = 0; tt < 2; ++tt) { m[tt] = -1e30f; l[tt] = 0.f; }
#pragma unroll
        for (int dt = 0; dt < 4; ++dt)
#pragma unroll
            for (int tt = 0; tt < 2; ++tt) o[dt][tt] = (f32x4){0.f, 0.f, 0.f, 0.f};
        const int j0 = qt >= 8 ? qt - 8 : 0;
        nsa_pipeline(qt - j0 + 1, kb, vb, B, tid, [&](int i) { return j0 + i; }, [&](int blk_, bf16_t* Ks, bf16_t* Vt) {
            nsa_qk(Ks, Qs, s, fr, fq);
            if (blk_ == qt) nsa_softmax<1, true>(s, m, l, o, sel_all, tib, fq, 0, 0);
            else if (blk_ == qt - 8) nsa_softmax<2, true>(s, m, l, o, sel_all, tib, fq, 0, 0);
            else nsa_softmax_fast(s, m, l, o, bias0);
            nsa_pv(Vt, s, o, fr, fq);
        });
        nsa_emit<true>(o, l, true, gbase + 2, obase, tib, fq);
    }
    __syncthreads();
}

#define SSD_P 136
#define S3_XST 0
#define S3_BC  69632
#define S3_CC  104448
#define S3_ACS 139264
#define S3_DT  141312
#define S3_END 143360

__device__ __forceinline__ void ssd_acs(const float* __restrict__ small, const float* __restrict__ a_log, size_t tok0, int g, float* acs, float* dtl, int tid) {
    const int w = tid >> 6, lane = tid & 63, hh = 4 * g + (w & 3);
    if (w < 4) {
        const float a = -__expf(a_log[hh]);
        const float d0 = small[(tok0 + 2 * lane) * 32 + 24 + hh], d1 = small[(tok0 + 2 * lane + 1) * 32 + 24 + hh];
        const float s0 = d0 * a, s1 = s0 + d1 * a;
        float tot = s1;
#pragma unroll
        for (int off = 1; off < 64; off <<= 1) { const float t = __shfl_up(tot, off); if (lane >= off) tot += t; }
        const float excl = tot - s1;
        acs[w * 128 + 2 * lane] = excl + s0; acs[w * 128 + 2 * lane + 1] = excl + s1;
        dtl[w * 128 + 2 * lane] = d0; dtl[w * 128 + 2 * lane + 1] = d1;
    }
}
struct ConvCh { float w0, w1, w2, w3, bias, h0, h1, h2; };
__device__ __forceinline__ void conv_init(ConvCh& cc, const float* __restrict__ conv_w, const float* __restrict__ conv_b, int ch, const bf16_t* pb, int c) {
    cc.w0 = conv_w[ch]; cc.w1 = conv_w[1024 + ch]; cc.w2 = conv_w[2048 + ch]; cc.w3 = conv_w[3072 + ch]; cc.bias = conv_b[ch];
    if (c > 0) { cc.h0 = bf2f(pb[-3 * PROJ_LD]); cc.h1 = bf2f(pb[-2 * PROJ_LD]); cc.h2 = bf2f(pb[-1 * PROJ_LD]); } else { cc.h0 = 0.f; cc.h1 = 0.f; cc.h2 = 0.f; }
}
__device__ __forceinline__ float conv_step(ConvCh& cc, float x) {
    const float v = cc.bias + cc.w0 * cc.h0 + cc.w1 * cc.h1 + cc.w2 * cc.h2 + cc.w3 * x;
    cc.h0 = cc.h1; cc.h1 = cc.h2; cc.h2 = x;
    return silu(v);
}

__device__ __forceinline__ void d_ssd_states(const bf16_t* __restrict__ proj, const float* __restrict__ small, const float* __restrict__ conv_w, const float* __restrict__ conv_b,
                                             const float* __restrict__ a_log, float* __restrict__ states, float* __restrict__ cdec, int item, char* lds) {
    const int tid = tid_opaque(), lane = tid & 63, w = tid >> 6, fr = lane & 15, fq = lane >> 4;
    const int b = item >> 7, c = (item >> 1) & 63, g = item & 1;
    bf16_t* XwT = (bf16_t*)(lds + S3_XST); bf16_t* BcT = (bf16_t*)(lds + S3_BC);
    float* acs = (float*)(lds + S3_ACS); float* dtl = (float*)(lds + S3_DT);
    const size_t tok0 = (size_t)b * SEQ + (size_t)c * 128;
    ssd_acs(small, a_log, tok0, g, acs, dtl, tid);
    __syncthreads();
    if (tid < 384) {
        const bool isx = tid < 256;
        const int ch = isx ? g * 256 + tid : 512 + g * 128 + (tid - 256);
        const bf16_t* px = proj + tok0 * PROJ_LD + C_XBC + ch;
        ConvCh cx; conv_init(cx, conv_w, conv_b, ch, px, c);
        const int hw = w & 3;
        const float alast = acs[hw * 128 + 127];
        bf16_t* dst = isx ? XwT + tid * SSD_P : BcT + (tid - 256) * SSD_P;
        for (int l0 = 0; l0 < 128; l0 += 32) {
            float rx[32];
#pragma unroll
            for (int i = 0; i < 32; ++i) rx[i] = bf2f(px[(size_t)(l0 + i) * PROJ_LD]);
#pragma unroll
            for (int i8 = 0; i8 < 4; ++i8) {
                float ox[8];
#pragma unroll
                for (int i = 0; i < 8; ++i) {
                    const int l = l0 + i8 * 8 + i;
                    const float v = conv_step(cx, rx[i8 * 8 + i]);
                    ox[i] = isx ? v * dtl[hw * 128 + l] * __expf(alast - acs[hw * 128 + l]) : v;
                }
                u32x4 o; o.x = pack2(ox[0], ox[1]); o.y = pack2(ox[2], ox[3]); o.z = pack2(ox[4], ox[5]); o.w = pack2(ox[6], ox[7]);
                *(u32x4*)(dst + l0 + i8 * 8) = o;
            }
        }
    }
    __syncthreads();
    {
        const int hw = w & 3, nh = w >> 2;
        f32x4 acc[4][4];
#pragma unroll
        for (int pt = 0; pt < 4; ++pt)
#pragma unroll
            for (int nt = 0; nt < 4; ++nt) acc[pt][nt] = (f32x4){0.f, 0.f, 0.f, 0.f};
#pragma unroll 1
        for (int ks = 0; ks < 4; ++ks) {
            bf16x8 af[4], bfr[4];
#pragma unroll
            for (int pt = 0; pt < 4; ++pt) af[pt] = *(const bf16x8*)(XwT + (hw * 64 + pt * 16 + fr) * SSD_P + ks * 32 + fq * 8);
#pragma unroll
            for (int nt = 0; nt < 4; ++nt) bfr[nt] = *(const bf16x8*)(BcT + ((nh * 4 + nt) * 16 + fr) * SSD_P + ks * 32 + fq * 8);
#pragma unroll
            for (int pt = 0; pt < 4; ++pt)
#pragma unroll
                for (int nt = 0; nt < 4; ++nt) acc[pt][nt] = __builtin_amdgcn_mfma_f32_16x16x32_bf16(af[pt], bfr[nt], acc[pt][nt], 0, 0, 0);
        }
        const int hh = 4 * g + hw;
        float* sp = states + ((size_t)((b * 64 + c) * 8 + hh)) * 8192;
#pragma unroll
        for (int pt = 0; pt < 4; ++pt)
#pragma unroll
            for (int nt = 0; nt < 4; ++nt)
#pragma unroll
                for (int jj = 0; jj < 4; ++jj) sp[(pt * 16 + 4 * fq + jj) * 128 + (nh * 4 + nt) * 16 + fr] = acc[pt][nt][jj];
        if (lane == 0 && nh == 0) cdec[(b * 64 + c) * 8 + hh] = __expf(acs[hw * 128 + 127]);
    }
    __syncthreads();
}

__device__ __forceinline__ void d_ssd_scan(const float* __restrict__ states, const float* __restrict__ cdec, bf16_t* __restrict__ prev, int vb) {
    const int bh = vb >> 1, b = bh >> 3, hh = bh & 7;
    const size_t e0 = (size_t)((vb & 1) * 512 + tid_opaque()) * 8;
    f32x4 h0 = (f32x4){0.f, 0.f, 0.f, 0.f}, h1 = h0;
#pragma unroll 8
    for (int c = 0; c < 64; ++c) {
        const size_t base = ((size_t)((b * 64 + c) * 8 + hh)) * 8192 + e0;
        const f32x4 s0 = *(const f32x4*)(states + base), s1 = *(const f32x4*)(states + base + 4);
        const float d = cdec[(b * 64 + c) * 8 + hh];
        u32x4 o; o.x = pack2(h0.x, h0.y); o.y = pack2(h0.z, h0.w); o.z = pack2(h1.x, h1.y); o.w = pack2(h1.z, h1.w);
        *(u32x4*)(prev + base) = o;
        h0 = h0 * d + s0; h1 = h1 * d + s1;
    }
}

__device__ __forceinline__ void d_ssd_out(const bf16_t* __restrict__ proj, const float* __restrict__ small, const float* __restrict__ conv_w, const float* __restrict__ conv_b,
                                          const float* __restrict__ a_log, const float* __restrict__ d_skip, const bf16_t* __restrict__ prev, bf16_t* __restrict__ yssd, int item, char* lds) {
    const int tid = tid_opaque(), lane = tid & 63, w = tid >> 6, fr = lane & 15, fq = lane >> 4;
    const int b = item >> 7, c = (item >> 1) & 63, g = item & 1;
    bf16_t* XsT = (bf16_t*)(lds + S3_XST); bf16_t* Bc = (bf16_t*)(lds + S3_BC); bf16_t* Cc = (bf16_t*)(lds + S3_CC);
    float* acs = (float*)(lds + S3_ACS); float* dtl = (float*)(lds + S3_DT);
    const size_t tok0 = (size_t)b * SEQ + (size_t)c * 128;
    ssd_acs(small, a_log, tok0, g, acs, dtl, tid);
    {
        const int mode = tid < 256 ? 0 : (tid < 384 ? 1 : 2);
        const int ch = mode == 0 ? g * 256 + tid : (mode == 1 ? 512 + g * 128 + (tid - 256) : 768 + g * 128 + (tid - 384));
        const bf16_t* px = proj + tok0 * PROJ_LD + C_XBC + ch;
        ConvCh cx; conv_init(cx, conv_w, conv_b, ch, px, c);
        bf16_t* dstx = XsT + (tid & 255) * SSD_P;
        bf16_t* dstbc = (mode == 1 ? Bc : Cc) + (tid & 127);
        for (int l0 = 0; l0 < 128; l0 += 32) {
            float rx[32];
#pragma unroll
            for (int i = 0; i < 32; ++i) rx[i] = bf2f(px[(size_t)(l0 + i) * PROJ_LD]);
#pragma unroll
            for (int i8 = 0; i8 < 4; ++i8) {
                float ox[8];
#pragma unroll
                for (int i = 0; i < 8; ++i) ox[i] = conv_step(cx, rx[i8 * 8 + i]);
                if (mode == 0) {
                    u32x4 o; o.x = pack2(ox[0], ox[1]); o.y = pack2(ox[2], ox[3]); o.z = pack2(ox[4], ox[5]); o.w = pack2(ox[6], ox[7]);
                    *(u32x4*)(dstx + l0 + i8 * 8) = o;
                } else {
#pragma unroll
                    for (int i = 0; i < 8; ++i) dstbc[(l0 + i8 * 8 + i) * SSD_P] = f2bf(ox[i]);
                }
            }
        }
    }
    __syncthreads();
    const int hw = w & 3, lh = w >> 2, hh = 4 * g + hw;
    const float dsk = d_skip[hh];
    const bf16_t* pp = prev + ((size_t)((b * 64 + c) * 8 + hh)) * 8192;
#pragma unroll 1
    for (int lk = 0; lk < 4; ++lk) {
        const int lt = lh + 2 * lk;
        const int l = lt * 16 + fr;
        const float acs_l = acs[hw * 128 + l];
        bf16x8 cf[4];
#pragma unroll
        for (int ks = 0; ks < 4; ++ks) cf[ks] = *(const bf16x8*)(Cc + (lt * 16 + fr) * SSD_P + ks * 32 + fq * 8);
        f32x4 y[4], yo[4];
#pragma unroll
        for (int pt = 0; pt < 4; ++pt) { y[pt] = (f32x4){0.f, 0.f, 0.f, 0.f}; yo[pt] = (f32x4){0.f, 0.f, 0.f, 0.f}; }
#pragma unroll
        for (int ks2 = 0; ks2 < 4; ++ks2) {
            if (2 * ks2 <= lt) {
                f32x4 cb[2];
#pragma unroll
                for (int h2 = 0; h2 < 2; ++h2) {
                    const int st = 2 * ks2 + h2;
                    cb[h2] = (f32x4){0.f, 0.f, 0.f, 0.f};
                    if (st <= lt) {
#pragma unroll
                        for (int ks = 0; ks < 4; ++ks)
                            cb[h2] = __builtin_amdgcn_mfma_f32_16x16x32_bf16(*(const bf16x8*)(Bc + (st * 16 + fr) * SSD_P + ks * 32 + fq * 8), cf[ks], cb[h2], 0, 0, 0);
#pragma unroll
                        for (int jj = 0; jj < 4; ++jj) {
                            const int sidx = st * 16 + 4 * fq + jj;
                            cb[h2][jj] = (sidx <= l) ? cb[h2][jj] * __expf(acs_l - acs[hw * 128 + sidx]) * dtl[hw * 128 + sidx] : 0.f;
                        }
                    }
                }
                u32x4 wv; wv.x = pack2(cb[0].x, cb[0].y); wv.y = pack2(cb[0].z, cb[0].w); wv.z = pack2(cb[1].x, cb[1].y); wv.w = pack2(cb[1].z, cb[1].w);
                const bf16x8 mf = __builtin_bit_cast(bf16x8, wv);
#pragma unroll
                for (int pt = 0; pt < 4; ++pt) {
                    const bf16_t* xp = XsT + (hw * 64 + pt * 16 + fr) * SSD_P + ks2 * 32 + 4 * fq;
                    const u32x2 a0 = *(const u32x2*)xp, a1 = *(const u32x2*)(xp + 16);
                    u32x4 xv; xv.x = a0.x; xv.y = a0.y; xv.z = a1.x; xv.w = a1.y;
                    y[pt] = __builtin_amdgcn_mfma_f32_16x16x32_bf16(__builtin_bit_cast(bf16x8, xv), mf, y[pt], 0, 0, 0);
                }
            }
            __builtin_amdgcn_sched_barrier(0);
        }
        __builtin_amdgcn_sched_barrier(0);
#pragma unroll
        for (int pt = 0; pt < 4; ++pt)
#pragma unroll
            for (int ks = 0; ks < 4; ++ks) yo[pt] = __builtin_amdgcn_mfma_f32_16x16x32_bf16(*(const bf16x8*)(pp + (pt * 16 + fr) * 128 + ks * 32 + fq * 8), cf[ks], yo[pt], 0, 0, 0);
        __builtin_amdgcn_sched_barrier(0);
        const float el = __expf(acs_l);
#pragma unroll
        for (int pt = 0; pt < 4; ++pt) {
            const int p0 = pt * 16 + 4 * fq;
            const u32x2 zz = *(const u32x2*)(proj + (tok0 + l) * PROJ_LD + C_Z + hh * 64 + p0);
            const float z0 = bflo(zz.x), z1 = bfhi(zz.x), z2 = bflo(zz.y), z3 = bfhi(zz.y);
            const bf16_t* xq = XsT + (hw * 64 + p0) * SSD_P + l;
            const float x0 = bf2f(xq[0]), x1 = bf2f(xq[SSD_P]), x2 = bf2f(xq[2 * SSD_P]), x3 = bf2f(xq[3 * SSD_P]);
            u32x2 ob;
            ob.x = pack2((y[pt].x + el * yo[pt].x + dsk * x0) * silu(z0), (y[pt].y + el * yo[pt].y + dsk * x1) * silu(z1));
            ob.y = pack2((y[pt].z + el * yo[pt].z + dsk * x2) * silu(z2), (y[pt].w + el * yo[pt].w + dsk * x3) * silu(z3));
            *(u32x2*)(yssd + (tok0 + l) * 512 + hh * 64 + p0) = ob;
        }
    }
    __syncthreads();
}

__device__ __forceinline__ void d_mix_prep(const float* __restrict__ onsa, const bf16_t* __restrict__ yssd, const float* __restrict__ nsa_w, const float* __restrict__ ssd_w, bf16_t* __restrict__ A2, int vb) {
    const int tid_ = tid_opaque(); const int lane = tid_ & 63, wid = tid_ >> 6;
    const size_t row0 = (size_t)vb * 32 + wid * 4;
    f32x4 a[4][2], y[4][2];
#pragma unroll
    for (int r = 0; r < 4; ++r)
#pragma unroll
        for (int k = 0; k < 2; ++k) {
            a[r][k] = *(const f32x4*)(onsa + (row0 + r) * 512 + k * 256 + lane * 4);
            const u32x2 yy = *(const u32x2*)(yssd + (row0 + r) * 512 + k * 256 + lane * 4);
            y[r][k] = (f32x4){bflo(yy.x), bfhi(yy.x), bflo(yy.y), bfhi(yy.y)};
        }
    float ra[4], ry[4];
#pragma unroll
    for (int r = 0; r < 4; ++r) {
        float s0 = 0.f, s1 = 0.f;
#pragma unroll
        for (int k = 0; k < 2; ++k) {
            s0 += a[r][k].x * a[r][k].x + a[r][k].y * a[r][k].y + a[r][k].z * a[r][k].z + a[r][k].w * a[r][k].w;
            s1 += y[r][k].x * y[r][k].x + y[r][k].y * y[r][k].y + y[r][k].z * y[r][k].z + y[r][k].w * y[r][k].w;
        }
        ra[r] = rsqrtf(wave_sum(s0) * (1.0f / 512) + EPS); ry[r] = rsqrtf(wave_sum(s1) * (1.0f / 512) + EPS);
    }
#pragma unroll
    for (int k = 0; k < 2; ++k) {
        const int col = k * 256 + lane * 4;
        const f32x4 wn = *(const f32x4*)(nsa_w + col), wsd = *(const f32x4*)(ssd_w + col);
#pragma unroll
        for (int r = 0; r < 4; ++r) {
            const f32x4 p = a[r][k] * ra[r] * wn, q = y[r][k] * ry[r] * wsd;
            u32x2 o; o.x = pack2(p.x, p.y); o.y = pack2(p.z, p.w);
            *(u32x2*)(A2 + (row0 + r) * DM + col) = o;
            u32x2 o2; o2.x = pack2(q.x, q.y); o2.y = pack2(q.z, q.w);
            *(u32x2*)(A2 + (row0 + r) * DM + 512 + col) = o2;
        }
    }
}

__device__ __forceinline__ void d_quant_rows(const float* __restrict__ src, unsigned char* __restrict__ dst, float* __restrict__ scale, int vb) {
    const int tid_ = tid_opaque(); const int lane = tid_ & 63, row = vb * 8 + (tid_ >> 6);
    const float* rp = src + (size_t)row * DM + lane * 16;
    f32x4 v[4];
#pragma unroll
    for (int i = 0; i < 4; ++i) v[i] = *(const f32x4*)(rp + i * 4);
    float mx = 0.f;
#pragma unroll
    for (int i = 0; i < 4; ++i) mx = fmaxf(mx, fmaxf(fmaxf(fabsf(v[i].x), fabsf(v[i].y)), fmaxf(fabsf(v[i].z), fabsf(v[i].w))));
    mx = wave_max(mx);
    const float sc = mx > 0.f ? mx * (1.0f / 416.0f) : 1.0f;
    const float inv = 1.0f / sc;
    u32x4 o;
#pragma unroll
    for (int i = 0; i < 4; ++i) {
        int wv = 0;
        wv = __builtin_amdgcn_cvt_pk_fp8_f32(v[i].x * inv, v[i].y * inv, wv, false);
        wv = __builtin_amdgcn_cvt_pk_fp8_f32(v[i].z * inv, v[i].w * inv, wv, true);
        o[i] = (unsigned)wv;
    }
    *(u32x4*)(dst + (size_t)row * DM + lane * 16) = o;
    if (lane == 0) scale[row] = sc;
}

__device__ __forceinline__ unsigned mono_u(float f) { const unsigned u = __float_as_uint(f); return (u & 0x80000000u) ? ~u : (u | 0x80000000u); }
__device__ __forceinline__ float unmono_f(unsigned m) { const unsigned u = (m & 0x80000000u) ? (m & 0x7fffffffu) : ~m; return __uint_as_float(u); }
__device__ __forceinline__ void d_peer_route(const bf16_t* __restrict__ qp, const float* __restrict__ qnw, const bf16_t* __restrict__ subk, int* __restrict__ eidx, float* __restrict__ gate,
                                             int tile, int h, char* lds) {
    const int tid = tid_opaque(), lane = tid & 63, w = tid >> 6, fr = lane & 15, fq = lane >> 4;
    const size_t tok = (size_t)tile * 128 + w * 16 + fr;
    bf16x8 qf[2][4];
    {
        const bf16_t* qrow = qp + tok * 2048 + h * 256;
        u32x4 raw[2][4];
        float ss = 0.f;
#pragma unroll
        for (int k = 0; k < 2; ++k)
#pragma unroll
            for (int ks = 0; ks < 4; ++ks) {
                const u32x4 r = *(const u32x4*)(qrow + k * 128 + ks * 32 + fq * 8);
                raw[k][ks] = r;
                ss += bflo(r.x) * bflo(r.x) + bfhi(r.x) * bfhi(r.x) + bflo(r.y) * bflo(r.y) + bfhi(r.y) * bfhi(r.y)
                    + bflo(r.z) * bflo(r.z) + bfhi(r.z) * bfhi(r.z) + bflo(r.w) * bflo(r.w) + bfhi(r.w) * bfhi(r.w);
            }
        ss += __shfl_xor(ss, 16); ss += __shfl_xor(ss, 32);
        const float rs = rsqrtf(ss * (1.0f / 256) + EPS);
#pragma unroll
        for (int k = 0; k < 2; ++k)
#pragma unroll
            for (int ks = 0; ks < 4; ++ks) {
                const float* wp = qnw + k * 128 + ks * 32 + fq * 8;
                const f32x4 w0 = *(const f32x4*)wp, w1 = *(const f32x4*)(wp + 4);
                const u32x4 r = raw[k][ks];
                u32x4 o;
                o.x = pack2(bflo(r.x) * rs * w0.x, bfhi(r.x) * rs * w0.y); o.y = pack2(bflo(r.y) * rs * w0.z, bfhi(r.y) * rs * w0.w);
                o.z = pack2(bflo(r.z) * rs * w1.x, bfhi(r.z) * rs * w1.y); o.w = pack2(bflo(r.w) * rs * w1.z, bfhi(r.w) * rs * w1.w);
                qf[k][ks] = __builtin_bit_cast(bf16x8, o);
            }
    }
    unsigned L[2][16];
#pragma unroll
    for (int k = 0; k < 2; ++k) {
        f32x4 acc[8];
#pragma unroll
        for (int kt = 0; kt < 8; ++kt) acc[kt] = (f32x4){0.f, 0.f, 0.f, 0.f};
        const bf16_t* kb = subk + (size_t)((h * 2 + k) * 128) * 128;
#pragma unroll
        for (int kt = 0; kt < 8; ++kt)
#pragma unroll
            for (int ks = 0; ks < 4; ++ks) {
                const bf16x8 af = *(const bf16x8*)(kb + (size_t)(kt * 16 + fr) * 128 + ks * 32 + fq * 8);
                acc[kt] = __builtin_amdgcn_mfma_f32_16x16x32_bf16(af, qf[k][ks], acc[kt], 0, 0, 0);
            }
#pragma unroll
        for (int i = 0; i < 16; ++i) L[k][i] = 0u;
#pragma unroll
        for (int kt = 0; kt < 8; ++kt)
#pragma unroll
            for (int jj = 0; jj < 4; ++jj) {
                const int idx = kt * 16 + 4 * fq + jj;
                ins16(L[k], (mono_u(acc[kt][jj]) & ~0x7Fu) | (unsigned)(127 - idx));
            }
#pragma unroll
        for (int r = 16; r <= 32; r <<= 1) {
            unsigned P[16];
#pragma unroll
            for (int i = 0; i < 16; ++i) P[i] = (unsigned)__shfl_xor((int)L[k][i], r);
            merge16(L[k], P);
        }
    }
    unsigned T[16];
#pragma unroll
    for (int i = 0; i < 16; ++i) T[i] = 0u;
#pragma unroll
    for (int a = 0; a < 16; ++a) {
        const float va = unmono_f(L[0][a] & ~0x7Fu);
#pragma unroll
        for (int bb = 0; bb < 16; ++bb) {
            if (bb <= 16 / (a + 1) - 1) {
                const float sum = va + unmono_f(L[1][bb] & ~0x7Fu);
                ins16(T, (mono_u(sum) & ~0xFFu) | (unsigned)(255 - (a * 16 + bb)));
            }
        }
    }
    unsigned char* li = (unsigned char*)lds + w * 512 + fr * 32;
    if (fq == 0) {
#pragma unroll
        for (int a = 0; a < 16; ++a) { li[a] = (unsigned char)(127 - (L[0][a] & 0x7Fu)); li[16 + a] = (unsigned char)(127 - (L[1][a] & 0x7Fu)); }
    }
    __syncthreads();
    const float s0 = unmono_f(T[0] & ~0xFFu);
    float pe[16]; float sum = 0.f;
#pragma unroll
    for (int i = 0; i < 16; ++i) { pe[i] = __expf(unmono_f(T[i] & ~0xFFu) - s0); sum += pe[i]; }
    const float inv = 1.0f / sum;
    unsigned cod[4] = {0u, 0u, 0u, 0u}; float gv[4] = {0.f, 0.f, 0.f, 0.f};
#pragma unroll
    for (int i = 0; i < 16; ++i) if ((i >> 2) == fq) { cod[i & 3] = 255u - (T[i] & 0xFFu); gv[i & 3] = pe[i] * inv; }
    int ev[4];
#pragma unroll
    for (int i = 0; i < 4; ++i) ev[i] = (int)li[cod[i] >> 4] * 128 + (int)li[16 + (cod[i] & 15u)];
    *(u32x4*)(eidx + (tok * 8 + h) * 16 + fq * 4) = (u32x4){(unsigned)ev[0], (unsigned)ev[1], (unsigned)ev[2], (unsigned)ev[3]};
    *(f32x4*)(gate + (tok * 8 + h) * 16 + fq * 4) = (f32x4){gv[0], gv[1], gv[2], gv[3]};
    __syncthreads();
}

__device__ __forceinline__ void cvt16(const u32x4 q, float (&f)[16]) {
#pragma unroll
    for (int i = 0; i < 4; ++i) {
        const f32x2 lo = __builtin_amdgcn_cvt_pk_f32_fp8((int)q[i], false), hi = __builtin_amdgcn_cvt_pk_f32_fp8((int)q[i], true);
        f[4 * i] = lo.x; f[4 * i + 1] = lo.y; f[4 * i + 2] = hi.x; f[4 * i + 3] = hi.y;
    }
}
__device__ __forceinline__ void d_peer_expert8(const bf16_t* __restrict__ h2, const unsigned char* __restrict__ down8, const unsigned char* __restrict__ up8, const float* __restrict__ dscale,
                                               const float* __restrict__ uscale, const int* __restrict__ eidx, const float* __restrict__ gate, const float* __restrict__ mod,
                                               const float* __restrict__ fw, float* __restrict__ out, int vb) {
    const int tid = tid_opaque(), lane = tid & 63, wid = tid >> 6;
    const size_t tok = (size_t)vb * 8 + wid; const int b = (int)(tok >> 13);
    const int e_lo = eidx[tok * 128 + lane], e_hi = eidx[tok * 128 + 64 + lane];
    const float c_lo = gate[tok * 128 + lane] * uscale[e_lo], c_hi = gate[tok * 128 + 64 + lane] * uscale[e_hi];
    const float d_lo = dscale[e_lo], d_hi = dscale[e_hi];
    float hx[16], acc[16];
    {
        const u32x4 v0 = *(const u32x4*)(h2 + tok * DM + lane * 16), v1 = *(const u32x4*)(h2 + tok * DM + lane * 16 + 8);
        hx[0] = bflo(v0.x); hx[1] = bfhi(v0.x); hx[2] = bflo(v0.y); hx[3] = bfhi(v0.y); hx[4] = bflo(v0.z); hx[5] = bfhi(v0.z); hx[6] = bflo(v0.w); hx[7] = bfhi(v0.w);
        hx[8] = bflo(v1.x); hx[9] = bfhi(v1.x); hx[10] = bflo(v1.y); hx[11] = bfhi(v1.y); hx[12] = bflo(v1.z); hx[13] = bfhi(v1.z); hx[14] = bflo(v1.w); hx[15] = bfhi(v1.w);
    }
#pragma unroll
    for (int e = 0; e < 16; ++e) acc[e] = 0.f;
    const int es = lane >> 3;
    u32x4 dq[8], uq[8], dn[8], un[8];
#pragma unroll
    for (int i = 0; i < 8; ++i) {
        const int e = __builtin_amdgcn_readlane(e_lo, i);
        dq[i] = *(const u32x4*)(down8 + (size_t)e * DM + lane * 16);
        uq[i] = *(const u32x4*)(up8 + (size_t)e * DM + lane * 16);
    }
#pragma unroll 1
    for (int j0 = 0; j0 < 128; j0 += 8) {
        if (j0 + 8 < 128) {
            const int jn = j0 + 8;
#pragma unroll
            for (int i = 0; i < 8; ++i) {
                const int e = jn < 64 ? __builtin_amdgcn_readlane(e_lo, jn + i) : __builtin_amdgcn_readlane(e_hi, jn - 64 + i);
                dn[i] = *(const u32x4*)(down8 + (size_t)e * DM + lane * 16);
                un[i] = *(const u32x4*)(up8 + (size_t)e * DM + lane * 16);
            }
        }
        const int sl = (j0 & 63) + es;
        const float my_c = j0 < 64 ? __shfl(c_lo, sl) : __shfl(c_hi, sl);
        const float my_ds = j0 < 64 ? __shfl(d_lo, sl) : __shfl(d_hi, sl);
        float part[8];
#pragma unroll
        for (int i = 0; i < 8; ++i) {
            float f[16]; cvt16(dq[i], f);
            float s = 0.f;
#pragma unroll
            for (int e = 0; e < 16; ++e) s += hx[e] * f[e];
            part[i] = s;
        }
        float q4[4], q2[2], q1;
#pragma unroll
        for (int i = 0; i < 4; ++i) { const bool up = (lane & 32) != 0; const float send = up ? part[i] : part[i + 4]; const float keep = up ? part[i + 4] : part[i]; q4[i] = keep + __shfl_xor(send, 32); }
#pragma unroll
        for (int i = 0; i < 2; ++i) { const bool up = (lane & 16) != 0; const float send = up ? q4[i] : q4[i + 2]; const float keep = up ? q4[i + 2] : q4[i]; q2[i] = keep + __shfl_xor(send, 16); }
        { const bool up = (lane & 8) != 0; const float send = up ? q2[0] : q2[1]; const float keep = up ? q2[1] : q2[0]; q1 = keep + __shfl_xor(send, 8); }
        q1 += __shfl_xor(q1, 4); q1 += __shfl_xor(q1, 2); q1 += __shfl_xor(q1, 1);
        const float a = gelu_tanh(q1 * my_ds) * my_c;
#pragma unroll
        for (int i = 0; i < 8; ++i) {
            const float c = __uint_as_float((unsigned)__builtin_amdgcn_readlane((int)__float_as_uint(a), 8 * i));
            float f[16]; cvt16(uq[i], f);
#pragma unroll
            for (int e = 0; e < 16; ++e) acc[e] += c * f[e];
        }
#pragma unroll
        for (int i = 0; i < 8; ++i) { dq[i] = dn[i]; uq[i] = un[i]; }
    }
    float x2[16]; float ss = 0.f;
#pragma unroll
    for (int q4i = 0; q4i < 4; ++q4i) {
        const int col = lane * 16 + q4i * 4;
        const f32x4 xv = *(const f32x4*)(out + tok * DM + col);
        const f32x4 g2 = *(const f32x4*)(mod + b * 6144 + 5120 + col);
        const int e0 = q4i * 4;
        x2[e0 + 0] = xv.x + g2.x * acc[e0 + 0]; x2[e0 + 1] = xv.y + g2.y * acc[e0 + 1]; x2[e0 + 2] = xv.z + g2.z * acc[e0 + 2]; x2[e0 + 3] = xv.w + g2.w * acc[e0 + 3];
        ss += x2[e0] * x2[e0] + x2[e0 + 1] * x2[e0 + 1] + x2[e0 + 2] * x2[e0 + 2] + x2[e0 + 3] * x2[e0 + 3];
    }
    ss = wave_sum(ss);
    const float r = rsqrtf(ss * (1.0f / DM) + EPS);
#pragma unroll
    for (int q4i = 0; q4i < 4; ++q4i) {
        const int col = lane * 16 + q4i * 4;
        const f32x4 wv = *(const f32x4*)(fw + col);
        const int e0 = q4i * 4;
        *(f32x4*)(out + tok * DM + col) = (f32x4){x2[e0] * r * wv.x, x2[e0 + 1] * r * wv.y, x2[e0 + 2] * r * wv.z, x2[e0 + 3] * r * wv.w};
    }
}

struct Params {
    const float *x, *c, *w_ada, *b_ada, *norm1_w, *w_in, *cmp_pe_k, *cmp_pe_v, *cmp_w1_k, *cmp_w2_k, *cmp_w1_v, *cmp_w2_v, *nsa_norm_w, *conv_w, *conv_b, *dt_bias, *a_log, *d_skip,
        *ssd_norm_w, *w_out, *norm2_w, *peer_wq, *peer_qnorm_w, *peer_sub_keys, *peer_down, *peer_up, *final_norm_w;
    float* out; char* ws;
};
#define LDS_BYTES 147456
#define LDS_MISC  (LDS_BYTES - 64)

__global__ __launch_bounds__(512, 2) void mega(Params p) {
    __shared__ __attribute__((aligned(16))) unsigned char lds_raw[LDS_BYTES];
    char* lds = (char*)lds_raw;
    PG8_LAS unsigned char* lds3 = (PG8_LAS unsigned char*)lds_raw;
    int* s_vb = (int*)(lds + LDS_MISC);
    cg::grid_group grid = cg::this_grid();
    const int G = gridDim.x, bid = blockIdx.x;
    if (bid == 0 && threadIdx.x == 0) { ((unsigned*)(p.ws + OFF_CTR))[0] = 0u; ((unsigned*)(p.ws + OFF_CTR))[64] = 0u; ((unsigned*)(p.ws + OFF_CTR))[128] = 0u; }
    for (int vb = bid; vb < 7906; vb += G) {
        int v = vb;
        if (v < 1536) { d_transpose_w(p.w_in, ((bf16_t*)(p.ws + OFF_WIN_T)), 1024, 2848, 1, 96, v, lds); }
        else if ((v -= 1536) < 512) { d_transpose_w(p.w_out, ((bf16_t*)(p.ws + OFF_WOUT_T)), 1024, 1024, 0, 32, v, lds); }
        else if ((v -= 512) < 1024) { d_transpose_w(p.peer_wq, ((bf16_t*)(p.ws + OFF_WQ_T)), 1024, 2048, 0, 64, v, lds); }
        else if ((v -= 1024) < 256) { d_transpose_w(p.cmp_w1_k, ((bf16_t*)(p.ws + OFF_W1K_T)), 2048, 256, 0, 8, v, lds); }
        else if ((v -= 256) < 256) { d_transpose_w(p.cmp_w1_v, ((bf16_t*)(p.ws + OFF_W1V_T)), 2048, 256, 0, 8, v, lds); }
        else if ((v -= 256) < 2048) { d_quant_rows(p.peer_down, ((unsigned char*)(p.ws + OFF_DOWN)), ((float*)(p.ws + OFF_UP)), v); }
        else if ((v -= 2048) < 2048) { d_quant_rows(p.peer_up, ((unsigned char*)(p.ws + OFF_DOWN + MIB(16))), ((float*)(p.ws + OFF_UP + 65536)), v); }
        else if ((v -= 2048) < 1) { d_convert_bf16(p.peer_sub_keys, ((bf16_t*)(p.ws + OFF_SUBK)), (size_t)8 * 2 * 128 * 128 / 8, 0, 1); }
        else if ((v -= 1) < 96) { d_mod(p.c, p.w_ada, p.b_ada, ((float*)(p.ws + OFF_MOD)), v, lds); }
        else if ((v -= 96) < 128) { d_rope_table(((float2*)(p.ws + OFF_ROPE)), v); }
        else { d_bias1(p.cmp_pe_k, p.cmp_w1_k, p.cmp_pe_v, p.cmp_w1_v, ((float*)(p.ws + OFF_BIAS1))); }
    }
    grid.sync();
    for (int vb = bid; vb < NTOK / 32; vb += G) d_norm_mod(p.x, p.norm1_w, ((float*)(p.ws + OFF_MOD)), 0, 1024, ((bf16_t*)(p.ws + OFF_H)), vb);
    grid.sync();
    {
        const pg8::Gemm g{((bf16_t*)(p.ws + OFF_H)), ((bf16_t*)(p.ws + OFF_WIN_T)), NTOK, NIN_PAD, 1024, 1024};
        pg8::StaticOrder S; S.init(NTOK, NIN_PAD, G, bid);
        const pg8::Epi<EpInProj> E{{((bf16_t*)(p.ws + OFF_PROJ)), ((bf16_t*)(p.ws + OFF_QROPE)), ((bf16_t*)(p.ws + OFF_KVP)), ((float*)(p.ws + OFF_SMALL)), ((float2*)(p.ws + OFF_ROPE)), p.dt_bias}};
        pg8::gemm_phase(lds3, g, S, E);
    }
    grid.sync();
    {
        {
            const pg8::Gemm g{((bf16_t*)(p.ws + OFF_KVP)) + 0 * KVP_SEG, ((bf16_t*)(p.ws + OFF_W1K_T)), 8192, 256, 2048, 1024};
            pg8::StaticOrder S; S.init(8192, 256, G, bid);
            const pg8::Epi<EpCmpHid> E{{((bf16_t*)(p.ws + OFF_HIDK)), ((float*)(p.ws + OFF_BIAS1))}};
            pg8::gemm_phase(lds3, g, S, E);
        }
        {
            const pg8::Gemm g{((bf16_t*)(p.ws + OFF_KVP)) + 1 * KVP_SEG, ((bf16_t*)(p.ws + OFF_W1V_T)), 8192, 256, 2048, 1024};
            pg8::StaticOrder S; S.init(8192, 256, G, (bid + G / 2) % G);
            const pg8::Epi<EpCmpHid> E{{((bf16_t*)(p.ws + OFF_HIDV)), ((float*)(p.ws + OFF_BIAS1)) + 256}};
            pg8::gemm_phase(lds3, g, S, E);
        }
        __syncthreads();
        for (int vb = bid; vb < 1024; vb += G) d_ssd_states(((bf16_t*)(p.ws + OFF_PROJ)), ((float*)(p.ws + OFF_SMALL)), p.conv_w, p.conv_b, p.a_log, ((float*)(p.ws + OFF_ONSA)), ((float*)(p.ws + OFF_CTR + 4096)), vb, lds);
    }
    grid.sync();
    for (int vb = bid; vb < 2048 + 128; vb += G) {
        if (vb < 1024) d_cmp_out(((bf16_t*)(p.ws + OFF_HIDK)), p.cmp_w2_k, ((bf16_t*)(p.ws + OFF_KC)), vb); else if (vb < 2048) d_cmp_out(((bf16_t*)(p.ws + OFF_HIDV)), p.cmp_w2_v, ((bf16_t*)(p.ws + OFF_VC)), vb - 1024);
        else d_ssd_scan(((float*)(p.ws + OFF_ONSA)), ((float*)(p.ws + OFF_CTR + 4096)), ((bf16_t*)(p.ws + OFF_EIDX)), vb - 2048);
    }
    grid.sync();
    for (;;) {
        if (threadIdx.x == 0) *s_vb = (int)atomicAdd(&((unsigned*)(p.ws + OFF_CTR))[0], 1u);
        __syncthreads();
        const int i = *s_vb;
        __syncthreads();
        if (i >= 2048) break;
        const int qt = 127 - (i >> 4), bg = i & 15;
        d_nsa_cmp(((bf16_t*)(p.ws + OFF_PROJ)), ((bf16_t*)(p.ws + OFF_KC)), ((bf16_t*)(p.ws + OFF_VC)), ((float*)(p.ws + OFF_SMALL)), ((float*)(p.ws + OFF_ONSA)), ((unsigned*)(p.ws + OFF_HIDK)) + (size_t)(bg * 128 + qt) * 512, bg >> 1, bg & 1, qt, lds);
    }
    for (;;) {
        if (threadIdx.x == 0) *s_vb = (int)atomicAdd(&((unsigned*)(p.ws + OFF_CTR))[64], 1u);
        __syncthreads();
        const int i = *s_vb;
        __syncthreads();
        if (i >= 1024) break;
        d_ssd_out(((bf16_t*)(p.ws + OFF_PROJ)), ((float*)(p.ws + OFF_SMALL)), p.conv_w, p.conv_b, p.a_log, p.d_skip, ((bf16_t*)(p.ws + OFF_EIDX)), ((bf16_t*)(p.ws + OFF_YSSD)), i, lds);
    }
    grid.sync();
    for (;;) {
        if (threadIdx.x == 0) *s_vb = (int)atomicAdd(&((unsigned*)(p.ws + OFF_CTR))[128], 1u);
        __syncthreads();
        const int i = *s_vb;
        __syncthreads();
        if (i >= 2048) break;
        const int qt = 127 - (i >> 4), bg = i & 15;
        d_nsa_attn(((bf16_t*)(p.ws + OFF_QROPE)), ((bf16_t*)(p.ws + OFF_KVP)), ((float*)(p.ws + OFF_SMALL)), ((float*)(p.ws + OFF_ONSA)), ((unsigned*)(p.ws + OFF_HIDK)) + (size_t)(bg * 128 + qt) * 512, bg >> 1, bg & 1, qt, lds);
    }
    grid.sync();
    for (int vb = bid; vb < NTOK / 32; vb += G) d_mix_prep(((float*)(p.ws + OFF_ONSA)), ((bf16_t*)(p.ws + OFF_YSSD)), p.nsa_norm_w, p.ssd_norm_w, ((bf16_t*)(p.ws + OFF_H)), vb);
    grid.sync();
    {
        const pg8::Gemm g{((bf16_t*)(p.ws + OFF_H)), ((bf16_t*)(p.ws + OFF_WOUT_T)), NTOK, 1024, 1024, 1024};
        pg8::StaticOrder S; S.init(NTOK, 1024, G, bid);
        const pg8::Epi<EpOutProj> E{{p.x, ((float*)(p.ws + OFF_MOD)), p.out}};
        pg8::gemm_phase(lds3, g, S, E);
    }
    grid.sync();
    for (int vb = bid; vb < NTOK / 32; vb += G) d_norm_mod(p.out, p.norm2_w, ((float*)(p.ws + OFF_MOD)), 3072, 4096, ((bf16_t*)(p.ws + OFF_H)), vb);
    grid.sync();
    {
        const pg8::Gemm g{((bf16_t*)(p.ws + OFF_H)), ((bf16_t*)(p.ws + OFF_WQ_T)), NTOK, 2048, 1024, 1024};
        pg8::StaticOrder S; S.init(NTOK, 2048, G, bid);
        const pg8::Epi<EpStoreBf16> E{{((bf16_t*)(p.ws + OFF_PROJ)), 2048, 0}};
        pg8::gemm_phase(lds3, g, S, E);
    }
    grid.sync();
    for (int vb = bid; vb < 4096; vb += G) d_peer_route(((bf16_t*)(p.ws + OFF_PROJ)), p.peer_qnorm_w, ((bf16_t*)(p.ws + OFF_SUBK)), ((int*)(p.ws + OFF_EIDX)), ((float*)(p.ws + OFF_GATE)), vb >> 3, vb & 7, lds);
    grid.sync();
    for (int vb = bid; vb < NTOK / 8; vb += G) d_peer_expert8(((bf16_t*)(p.ws + OFF_H)), ((unsigned char*)(p.ws + OFF_DOWN)), ((unsigned char*)(p.ws + OFF_DOWN + MIB(16))), ((float*)(p.ws + OFF_UP)), ((float*)(p.ws + OFF_UP + 65536)), ((int*)(p.ws + OFF_EIDX)), ((float*)(p.ws + OFF_GATE)), ((float*)(p.ws + OFF_MOD)), p.final_norm_w, p.out, vb);
}

extern "C" void kernel_launch(void* const* d_in, const int* in_sizes, int n_in, void* d_out, int out_size, void* d_ws, size_t ws_size, hipStream_t stream) {
    if (ws_size < WS_NEED) { fprintf(stderr, "workspace too small\n"); return; }
    static int grid_blocks = 0;
    if (!grid_blocks) {
        int dev = 0, cus = 0, per_cu = 0;
        (void)hipGetDevice(&dev);
        (void)hipDeviceGetAttribute(&cus, hipDeviceAttributeMultiprocessorCount, dev);
        (void)hipOccupancyMaxActiveBlocksPerMultiprocessor(&per_cu, mega, 512, 0);
        if (per_cu < 1) fprintf(stderr, "occupancy query reports %d blocks per CU\n", per_cu);
        grid_blocks = cus;
    }
    Params p{};
    const float** pp = (const float**)&p;
    for (int i = 0; i < 27; ++i) pp[i] = (const float*)d_in[i];
    p.out = (float*)d_out; p.ws = (char*)d_ws;
    void* args[] = {&p};
    hipError_t e = hipLaunchCooperativeKernel((void*)mega, dim3(grid_blocks), dim3(512), args, 0, stream);
    if (e != hipSuccess) fprintf(stderr, "cooperative launch failed: %s (grid %d)\n", hipGetErrorString(e), grid_blocks);
}
```

```cpp
#include <hip/hip_runtime.h>
#include <hip/hip_cooperative_groups.h>
#include <stdint.h>
#include <cstdio>
namespace cg = cooperative_groups;

typedef unsigned short bf16_t;
typedef short bf16x8 __attribute__((ext_vector_type(8)));
typedef float f32x4 __attribute__((ext_vector_type(4)));
typedef float f32x2 __attribute__((ext_vector_type(2)));
typedef unsigned u32x4 __attribute__((ext_vector_type(4)));
typedef unsigned u32x2 __attribute__((ext_vector_type(2)));

#define NB 8
#define SEQ 8192
#define NTOK 65536
#define DM 1024
#define PROJ_LD 2816
#define NIN_PAD 3072
#define C_Q 0
#define C_KCMP 512
#define C_KSEL 768
#define C_VSEL 896
#define C_KWIN 1024
#define C_VWIN 1152
#define C_Z 1280
#define C_XBC 1792
#define NCMP 511
#define EPS 1e-6f
#define KVP_SEG ((size_t)NB * 2 * SEQ * 64)

#define MIB(x) ((size_t)(x) << 20)
#define OFF_MOD    MIB(0)
#define OFF_ROPE   MIB(1)
#define OFF_BIAS1  MIB(2)
#define OFF_WIN_T  MIB(3)
#define OFF_WOUT_T MIB(9)
#define OFF_WQ_T   MIB(11)
#define OFF_SUBK   MIB(15)
#define OFF_W1K_T  MIB(16)
#define OFF_W1V_T  MIB(17)
#define OFF_KC     MIB(18)
#define OFF_VC     MIB(19)
#define OFF_HIDK   MIB(20)
#define OFF_HIDV   MIB(24)
#define OFF_DOWN   MIB(28)
#define OFF_UP     MIB(60)
#define OFF_SMALL  MIB(92)
#define OFF_H      MIB(100)
#define OFF_PROJ   MIB(228)
#define OFF_QROPE  MIB(580)
#define OFF_ONSA   MIB(644)
#define OFF_YSSD   MIB(772)
#define OFF_KVP    MIB(836)
#define OFF_EIDX   MIB(932)
#define OFF_GATE   MIB(964)
#define OFF_CTR    MIB(996)
#define OFF_BAR    (MIB(996) + 65536)
#define WS_NEED    MIB(997)

__device__ __forceinline__ bf16_t f2bf(float f) { unsigned u = __float_as_uint(f); u += 0x7fffu + ((u >> 16) & 1u); return (bf16_t)(u >> 16); }
__device__ __forceinline__ float bf2f(bf16_t h) { return __uint_as_float(((unsigned)h) << 16); }
__device__ __forceinline__ float bflo(unsigned u) { return __uint_as_float(u << 16); }
__device__ __forceinline__ float bfhi(unsigned u) { return __uint_as_float(u & 0xffff0000u); }
__device__ __forceinline__ unsigned pack2(float a, float b) { return (unsigned)f2bf(a) | ((unsigned)f2bf(b) << 16); }
__device__ __forceinline__ float wave_sum(float v) {
#pragma unroll
    for (int o = 32; o; o >>= 1) v += __shfl_xor(v, o);
    return v;
}
__device__ __forceinline__ float wave_max(float v) {
#pragma unroll
    for (int o = 32; o; o >>= 1) v = fmaxf(v, __shfl_xor(v, o));
    return v;
}
__device__ __forceinline__ int tid_opaque() { int t = threadIdx.x; asm volatile("" : "+v"(t)); return t; }
__device__ __forceinline__ float gelu_tanh(float x) { return 0.5f * x * (1.0f + tanhf(0.7978845608028654f * (x + 0.044715f * x * x * x))); }
__device__ __forceinline__ float silu(float x) { return x / (1.0f + __expf(-x)); }
__device__ __forceinline__ float sigmoidf(float x) { return 1.0f / (1.0f + __expf(-x)); }
__device__ __forceinline__ float softplusf(float x) { return x > 20.f ? x : log1pf(__expf(x)); }

__device__ __forceinline__ int inproj_src(int n) {
    if (n < 1280) return n;
    if (n < 1792) return 1304 + (n - 1280);
    if (n < 2816) return 1816 + (n - 1792);
    if (n < 2840) return 1280 + (n - 2816);
    if (n < 2848) return 2840 + (n - 2840);
    return -1;
}
__device__ __forceinline__ void d_transpose_w(const float* __restrict__ W, bf16_t* __restrict__ Wt, int K, int N, int mode, int nbx, int vb, char* lds) {
    const int tid_ = tid_opaque(); const int half = tid_ >> 8, t256 = tid_ & 255, tile = vb * 2 + half;
    float (*t)[33] = (float (*)[33])(lds + half * 4352);
    const int n0 = (tile % nbx) * 32, k0 = (tile / nbx) * 32, tx = t256 & 31, ty = t256 >> 5;
#pragma unroll
    for (int i = 0; i < 4; ++i) {
        const int k = k0 + ty + 8 * i, n = n0 + tx;
        const int src = mode == 1 ? inproj_src(n) : n;
        t[ty + 8 * i][tx] = (src >= 0 && src < N) ? W[(size_t)k * N + src] : 0.f;
    }
    __syncthreads();
#pragma unroll
    for (int i = 0; i < 4; ++i) Wt[(size_t)(n0 + ty + 8 * i) * K + k0 + tx] = f2bf(t[tx][ty + 8 * i]);
    __syncthreads();
}
__device__ __forceinline__ void d_convert_bf16(const float* __restrict__ in, bf16_t* __restrict__ out, size_t n8, int vb, int nvb) {
    size_t i = (size_t)vb * 512 + tid_opaque();
    const size_t stride = (size_t)nvb * 512;
    for (; i < n8; i += stride) {
        const f32x4 a = ((const f32x4*)in)[2 * i], b = ((const f32x4*)in)[2 * i + 1];
        u32x4 o; o.x = pack2(a.x, a.y); o.y = pack2(a.z, a.w); o.z = pack2(b.x, b.y); o.w = pack2(b.z, b.w);
        ((u32x4*)out)[i] = o;
    }
}
__device__ __forceinline__ void d_mod(const float* __restrict__ c, const float* __restrict__ w_ada, const float* __restrict__ b_ada, float* __restrict__ mod, int vb, char* lds) {
    float (*part)[8][64] = (float (*)[8][64])lds;
    const int tid = tid_opaque(), jl = tid & 63, kq = tid >> 6, j = vb * 64 + jl;
    float acc[8];
#pragma unroll
    for (int b = 0; b < 8; ++b) acc[b] = 0.f;
    for (int k0 = kq * 128; k0 < kq * 128 + 128; k0 += 16) {
        float wv[16];
#pragma unroll
        for (int i = 0; i < 16; ++i) wv[i] = w_ada[(size_t)(k0 + i) * 6144 + j];
#pragma unroll
        for (int i = 0; i < 16; ++i)
#pragma unroll
            for (int b = 0; b < 8; ++b) acc[b] += c[b * 1024 + k0 + i] * wv[i];
    }
#pragma unroll
    for (int b = 0; b < 8; ++b) part[kq][b][jl] = acc[b];
    __syncthreads();
    {
        const int b = tid >> 6, jj = tid & 63;
        float s = b_ada[vb * 64 + jj];
#pragma unroll
        for (int q = 0; q < 8; ++q) s += part[q][b][jj];
        mod[b * 6144 + vb * 64 + jj] = s;
    }
    __syncthreads();
}
__device__ __forceinline__ void d_rope_table(float2* __restrict__ rope, int vb) {
    const int i = vb * 512 + tid_opaque();
    if (i >= SEQ * 8) return;
    const int pos = i >> 3, f = i & 7;
    const double inv = pow(500000.0, -(double)f / 8.0);
    const double ang = (double)pos * inv;
    rope[i] = make_float2((float)cos(ang), (float)sin(ang));
}
__device__ __forceinline__ void d_bias1(const float* __restrict__ pe_k, const float* __restrict__ w1_k, const float* __restrict__ pe_v, const float* __restrict__ w1_v, float* __restrict__ bias1) {
    const int tid_ = tid_opaque(); const int which = tid_ >> 8, j = tid_ & 255;
    const float* pe = which ? pe_v : pe_k; const float* w1 = which ? w1_v : w1_k;
    float a = 0.f;
    for (int k0 = 0; k0 < 2048; k0 += 16) {
        float wv[16];
#pragma unroll
        for (int i = 0; i < 16; ++i) wv[i] = w1[(size_t)(k0 + i) * 256 + j];
#pragma unroll
        for (int i = 0; i < 16; ++i) a += pe[k0 + i] * wv[i];
    }
    bias1[which * 256 + j] = a;
}

__device__ __forceinline__ void d_norm_mod(const float* __restrict__ x, const float* __restrict__ w, const float* __restrict__ mod, int sh_off, int sc_off, bf16_t* __restrict__ out, int vb) {
    const int tid_ = tid_opaque(); const int lane = tid_ & 63, wid = tid_ >> 6;
    const size_t row0 = (size_t)vb * 32 + wid * 4; const int b = (int)(row0 >> 13);
    f32x4 v[4][4];
#pragma unroll
    for (int r = 0; r < 4; ++r)
#pragma unroll
        for (int k = 0; k < 4; ++k) v[r][k] = *(const f32x4*)(x + (row0 + r) * DM + k * 256 + lane * 4);
    float rs[4];
#pragma unroll
    for (int r = 0; r < 4; ++r) {
        float ss = 0.f;
#pragma unroll
        for (int k = 0; k < 4; ++k) ss += v[r][k].x * v[r][k].x + v[r][k].y * v[r][k].y + v[r][k].z * v[r][k].z + v[r][k].w * v[r][k].w;
        rs[r] = rsqrtf(wave_sum(ss) * (1.0f / DM) + EPS);
    }
#pragma unroll
    for (int k = 0; k < 4; ++k) {
        const int col = k * 256 + lane * 4;
        const f32x4 wv = *(const f32x4*)(w + col), sc = *(const f32x4*)(mod + b * 6144 + sc_off + col), sh = *(const f32x4*)(mod + b * 6144 + sh_off + col);
        const f32x4 ws = wv * (sc + 1.0f);
#pragma unroll
        for (int r = 0; r < 4; ++r) {
            const f32x4 y = v[r][k] * rs[r] * ws + sh;
            u32x2 o; o.x = pack2(y.x, y.y); o.y = pack2(y.z, y.w);
            *(u32x2*)(out + (row0 + r) * DM + col) = o;
        }
    }
}

namespace pg8 {
#define PG8_LAS __attribute__((address_space(3)))
constexpr int BM = 256, BK = 64, HALF = 128, HTB = HALF * BK * 2  , STAGE_BYTES = 8 * HTB, NXCD = 8, WGM = 8;
__host__ __device__ __forceinline__ int lds_byte(int r, int c) { const int st = (r >> 4) * 2 + (c >> 5), rr = r & 15, cc = c & 31, ob = rr * 64 + cc * 2; return st * 1024 + (ob ^ (((ob >> 9) & 1) << 5)); }
__host__ __device__ __forceinline__ void stage_rc(int b, int& R, int& C) { const int st = b / 1024, sb = b % 1024, swz = sb ^ (((sb >> 9) & 1) << 5); R = (st >> 1) * 16 + swz / 64; C = (st & 1) * 32 + (swz % 64) / 2; }
struct Unit { int pm, pn; };
struct Gemm { const bf16_t* A; const bf16_t* Bt; int M, N, K, lda; };
struct StaticOrder {
    int nM, nN, nwg, G, c;
    __host__ __device__ void init(int M, int N, int G_, int c_) { nM = M / BM; nN = N / BM; nwg = nM * nN; G = G_; c = c_; }
    __host__ __device__ bool next(int i, Unit& u) const {
        const long L = (long)i * G + c; if (L >= nwg) return false;
        int wgid = (int)L; { const int q = nwg / NXCD, r = nwg % NXCD, xcd = wgid % NXCD, off = wgid / NXCD; wgid = (xcd < r ? xcd * (q + 1) : r * (q + 1) + (xcd - r) * q) + off; }
        const int nig = WGM * nN, gid = wgid / nig, fm = gid * WGM, gsz = (nM - fm) < WGM ? (nM - fm) : WGM;
        u.pm = fm + ((wgid % nig) % gsz); u.pn = (wgid % nig) / gsz; return true;
    }
};
template <class F> struct Epi {
    F f;
    __device__ __forceinline__ void operator()(const f32x4 (&acc)[2][2][4][2], const Unit& u, int wr, int wc, int fr, int fq) const {
#pragma unroll
        for (int ai = 0; ai < 2; ++ai)
#pragma unroll
            for (int m = 0; m < 4; ++m)
#pragma unroll
                for (int bj = 0; bj < 2; ++bj)
#pragma unroll
                    for (int n = 0; n < 2; ++n)
                        f(u.pm * BM + ai * HALF + wr * 64 + m * 16 + fr, u.pn * BM + bj * HALF + wc * 32 + n * 16 + 4 * fq, acc[ai][bj][m][n]);
    }
};
template <class E, class Sched>
__device__ __forceinline__ void gemm_phase(PG8_LAS unsigned char* lds, const Gemm g, const Sched& S, const E& Ep) {
    const int tid = tid_opaque(), wid = __builtin_amdgcn_readfirstlane(tid >> 6), lane = tid & 63, wr = wid >> 2, wc = wid & 3, fr = lane & 15, fq = lane >> 4;
    const int K = g.K, nt = K / BK;
    unsigned voffA[2], voffB[2];
#pragma unroll
    for (int i = 0; i < 2; ++i) { int R, C; stage_rc(tid * 16 + i * 8192, R, C); voffA[i] = (unsigned)(R * g.lda + C) * 2u; voffB[i] = (unsigned)(R * K + C) * 2u; }
    const size_t kstep = (size_t)(BK * 2);
    const size_t hstep = (size_t)HALF * K * 2, hstepA = (size_t)HALF * g.lda * 2;
    const size_t tstep = 2 * hstep, tstepA = 2 * hstepA;
    const unsigned ldsw = (unsigned)wid * 1024u;
    const int aoff = lds_byte(wr * 64 + fr, fq * 8), boff = lds_byte(wc * 32 + fr, fq * 8);
#define PG8_SA(b, h) (((b) * 2 + (h)) * HTB)
#define PG8_SB(b, h) ((4 + (b) * 2 + (h)) * HTB)
#define PG8_STAGE(bufoff, gbase, voff) do { _Pragma("unroll") for (int _i = 0; _i < 2; ++_i) \
        __builtin_amdgcn_global_load_lds((const unsigned*)((const char*)(gbase) + (voff)[_i]), (PG8_LAS unsigned*)(lds + (bufoff) + ldsw + _i * 8192), 16, 0, 0); } while (0)
#define PG8_LDA(dst, b, h) do { _Pragma("unroll") for (int m = 0; m < 4; ++m) _Pragma("unroll") for (int k = 0; k < 2; ++k) dst[m][k] = *(const PG8_LAS bf16x8*)(lds + PG8_SA(b, h) + aoff + m * 2048 + k * 1024); } while (0)
#define PG8_LDB(dst, b, h) do { _Pragma("unroll") for (int n = 0; n < 2; ++n) _Pragma("unroll") for (int k = 0; k < 2; ++k) dst[n][k] = *(const PG8_LAS bf16x8*)(lds + PG8_SB(b, h) + boff + n * 2048 + k * 1024); } while (0)
#define PG8_MMA(ai, bj, At, Bt) do { __builtin_amdgcn_s_setprio(1); _Pragma("unroll") for (int m = 0; m < 4; ++m) _Pragma("unroll") for (int n = 0; n < 2; ++n) _Pragma("unroll") for (int k = 0; k < 2; ++k) \
        acc[ai][bj][m][n] = __builtin_amdgcn_mfma_f32_16x16x32_bf16(Bt[n][k], At[m][k], acc[ai][bj][m][n], 0, 0, 0); __builtin_amdgcn_s_setprio(0); } while (0)
#define PG8_WAIT_V(n) asm volatile("s_waitcnt vmcnt(" #n ")" ::: "memory")
#define PG8_WAIT_L(n) asm volatile("s_waitcnt lgkmcnt(" #n ")" ::: "memory")
#define PG8_BAR __builtin_amdgcn_s_barrier()
#define PG8_SCHED __builtin_amdgcn_sched_barrier(0)
    Unit cur, nxt; int ui = 0;
    if (!S.next(0, cur)) return;
    f32x4 acc[2][2][4][2];
#pragma unroll
    for (int a = 0; a < 2; ++a)
#pragma unroll
        for (int b = 0; b < 2; ++b)
#pragma unroll
            for (int m = 0; m < 4; ++m)
#pragma unroll
                for (int n = 0; n < 2; ++n) acc[a][b][m][n] = (f32x4){0.f, 0.f, 0.f, 0.f};
    bf16x8 At[4][2], B0[2][2], B1[2][2];
    const char* cA = (const char*)g.A + (size_t)cur.pm * tstepA; const char* cB = (const char*)g.Bt + (size_t)cur.pn * tstep;
    PG8_STAGE(PG8_SB(0, 0), cB, voffB); PG8_STAGE(PG8_SB(0, 1), cB + hstep, voffB); PG8_STAGE(PG8_SA(0, 0), cA, voffA); PG8_STAGE(PG8_SA(0, 1), cA + hstepA, voffA);
    if (wr == 1) PG8_BAR;
    PG8_WAIT_V(2); PG8_BAR;
    PG8_STAGE(PG8_SB(1, 0), cB + kstep, voffB); PG8_STAGE(PG8_SA(1, 0), cA + kstep, voffA); PG8_STAGE(PG8_SB(1, 1), cB + hstep + kstep, voffB);
    PG8_WAIT_V(6); PG8_BAR;
    for (;;) {
        const bool has_next = S.next(ui + 1, nxt);
        const char* nA = has_next ? (const char*)g.A + (size_t)nxt.pm * tstepA : cA; const char* nB = has_next ? (const char*)g.Bt + (size_t)nxt.pn * tstep : cB;
        for (int t = 0; t < nt; t += 2) {
            const bool last = (t == nt - 2);
            const char* a1 = cA + (size_t)(t + 1) * kstep;
            const char* a2 = last ? nA : cA + (size_t)(t + 2) * kstep; const char* b2 = last ? nB : cB + (size_t)(t + 2) * kstep;
            const char* a3 = a2 + kstep; const char* b3 = b2 + kstep;
            PG8_LDB(B0, 0, 0); PG8_LDB(B1, 0, 1); PG8_SCHED; PG8_LDA(At, 0, 0); PG8_STAGE(PG8_SA(1, 1), a1 + hstepA, voffA);
            PG8_WAIT_V(8); PG8_WAIT_L(0); PG8_BAR; PG8_MMA(0, 0, At, B0); PG8_MMA(0, 1, At, B1); PG8_BAR; PG8_SCHED;
            PG8_LDA(At, 0, 1); PG8_STAGE(PG8_SB(0, 0), b2, voffB); PG8_STAGE(PG8_SB(0, 1), b2 + hstep, voffB); PG8_STAGE(PG8_SA(0, 0), a2, voffA);
            PG8_WAIT_V(8); PG8_WAIT_L(0); PG8_BAR; PG8_MMA(1, 0, At, B0); PG8_MMA(1, 1, At, B1); PG8_BAR; PG8_SCHED;
            PG8_LDB(B0, 1, 0); PG8_LDB(B1, 1, 1); PG8_SCHED; PG8_LDA(At, 1, 0); PG8_STAGE(PG8_SA(0, 1), a2 + hstepA, voffA);
            PG8_WAIT_V(8); PG8_WAIT_L(0); PG8_BAR; PG8_MMA(0, 0, At, B0); PG8_MMA(0, 1, At, B1); PG8_BAR; PG8_SCHED;
            PG8_LDA(At, 1, 1); PG8_STAGE(PG8_SB(1, 0), b3, voffB); PG8_STAGE(PG8_SB(1, 1), b3 + hstep, voffB); PG8_STAGE(PG8_SA(1, 0), a3, voffA);
            PG8_WAIT_V(8); PG8_WAIT_L(0); PG8_BAR; PG8_MMA(1, 0, At, B0); PG8_MMA(1, 1, At, B1); PG8_BAR; PG8_SCHED;
        }
        if (wr == 0) PG8_BAR;
        Ep(acc, cur, wr, wc, fr, fq);
        if (!has_next) break;
#pragma unroll
        for (int a = 0; a < 2; ++a)
#pragma unroll
            for (int b = 0; b < 2; ++b)
#pragma unroll
                for (int m = 0; m < 4; ++m)
#pragma unroll
                    for (int n = 0; n < 2; ++n) acc[a][b][m][n] = (f32x4){0.f, 0.f, 0.f, 0.f};
        cur = nxt; cA = nA; cB = nB; ++ui;
        if (wr == 1) PG8_BAR;
    }
    PG8_WAIT_V(0);
    PG8_BAR;
#undef PG8_SA
#undef PG8_SB
#undef PG8_STAGE
#undef PG8_LDA
#undef PG8_LDB
#undef PG8_MMA
#undef PG8_WAIT_V
#undef PG8_WAIT_L
#undef PG8_BAR
#undef PG8_SCHED
}
}

struct EpInProj { bf16_t* proj; bf16_t* qrope; bf16_t* kvp; float* small; const float2* rope; const float* dt_bias;
    __device__ __forceinline__ void operator()(int m, int n0, f32x4 v) const {
        if (n0 < 2816) {
            const bool is_q = n0 < 512;
            const bool roped_seg = is_q || (n0 >= C_KSEL && n0 < C_VSEL) || (n0 >= C_KWIN && n0 < C_VWIN);
            const bool rope_dims = roped_seg && ((n0 & 63) < 16);
            u32x2 raw; raw.x = pack2(v.x, v.y); raw.y = pack2(v.z, v.w);
            if (is_q) *(u32x2*)(proj + (size_t)m * PROJ_LD + n0) = raw;
            if (rope_dims) {
                f32x4 p; p.x = __shfl_xor(v.x, 32); p.y = __shfl_xor(v.y, 32); p.z = __shfl_xor(v.z, 32); p.w = __shfl_xor(v.w, 32);
                const int i0 = n0 & 15, pos = m & (SEQ - 1);
                const float sgn = i0 < 8 ? -1.f : 1.f;
                const float2* rp = rope + pos * 8 + (i0 & 7);
                const float2 c0 = rp[0], c1 = rp[1], c2 = rp[2], c3 = rp[3];
                v.x = v.x * c0.x + sgn * p.x * c0.y; v.y = v.y * c1.x + sgn * p.y * c1.y;
                v.z = v.z * c2.x + sgn * p.z * c2.y; v.w = v.w * c3.x + sgn * p.w * c3.y;
            }
            u32x2 o; o.x = pack2(v.x, v.y); o.y = pack2(v.z, v.w);
            if (is_q) *(u32x2*)(qrope + (size_t)m * 512 + n0) = o;
            else if (n0 < C_Z) {
                const int r = n0 - C_KCMP, seg = r >> 7, g = (r >> 6) & 1, d = r & 63, bb = m >> 13, t = m & (SEQ - 1);
                *(u32x2*)(kvp + (size_t)seg * KVP_SEG + ((size_t)(bb * 2 + g) * SEQ + t) * 64 + d) = o;
            }
            else *(u32x2*)(proj + (size_t)m * PROJ_LD + n0) = o;
        } else if (n0 < 2848) {
            const int c = n0 - 2816; f32x4 o;
            if (c < 24) { o.x = sigmoidf(v.x); o.y = sigmoidf(v.y); o.z = sigmoidf(v.z); o.w = sigmoidf(v.w); }
            else { const float* db = dt_bias + (c - 24); o.x = softplusf(v.x + db[0]); o.y = softplusf(v.y + db[1]); o.z = softplusf(v.z + db[2]); o.w = softplusf(v.w + db[3]); }
            *(f32x4*)(small + (size_t)m * 32 + c) = o;
        }
    } };
struct EpCmpHid { bf16_t* hid; const float* bias;
    __device__ __forceinline__ void operator()(int m, int n0, f32x4 v) const {
        const f32x4 b = *(const f32x4*)(bias + n0);
        u32x2 o; o.x = pack2(gelu_tanh(v.x + b.x), gelu_tanh(v.y + b.y)); o.y = pack2(gelu_tanh(v.z + b.z), gelu_tanh(v.w + b.w));
        *(u32x2*)(hid + (size_t)m * 256 + n0) = o;
    } };
struct EpOutProj { const float* x; const float* mod; float* x1;
    __device__ __forceinline__ void operator()(int m, int n0, f32x4 v) const {
        const int b = m >> 13;
        const f32x4 xv = *(const f32x4*)(x + (size_t)m * DM + n0);
        const f32x4 g = *(const f32x4*)(mod + b * 6144 + 2048 + n0);
        f32x4 o; o.x = xv.x + g.x * v.x; o.y = xv.y + g.y * v.y; o.z = xv.z + g.z * v.z; o.w = xv.w + g.w * v.w;
        *(f32x4*)(x1 + (size_t)m * DM + n0) = o;
    } };
struct EpStoreBf16 { bf16_t* out; int ld; int pad;
    __device__ __forceinline__ void operator()(int m, int n0, f32x4 v) const {
        u32x2 o; o.x = pack2(v.x, v.y); o.y = pack2(v.z, v.w);
        *(u32x2*)(out + (size_t)m * ld + n0) = o;
    } };

__device__ __forceinline__ void d_cmp_out(const bf16_t* __restrict__ hid, const float* __restrict__ w2, bf16_t* __restrict__ out, int vb) {
    const int tid_ = tid_opaque(); const int m = vb * 8 + (tid_ >> 6), d = tid_ & 63;
    float a = 0.f;
#pragma unroll 8
    for (int j = 0; j < 256; ++j) a += bf2f(hid[(size_t)m * 256 + j]) * w2[j * 64 + d];
    out[(size_t)m * 64 + d] = f2bf(a);
}

#define KLD 72
#define NSA_OFF_KS0  0
#define NSA_OFF_VT0  9216
#define NSA_OFF_KS1  18432
#define NSA_OFF_VT1  27648
#define NSA_OFF_IMP  36864
#define NSA_OFF_SELW 70656
#define NSA_OFF_ANYW 71680
#define NSA_OFF_BL   71712
#define NSA_OFF_QS   72256
#define NSA_LDS      (72256 + 8 * 32 * KLD * 2)
#define SM_C 0.18033688011112042f

struct KVStage { u32x4 k, v; };
__device__ __forceinline__ void nsa_stage_load(KVStage& st, const bf16_t* kb, const bf16_t* vb, int tid) {
    st.k = *(const u32x4*)(kb + tid * 8); st.v = *(const u32x4*)(vb + tid * 8);
}
__device__ __forceinline__ void nsa_stage_store(bf16_t* Ks, bf16_t* Vt, int tid, const KVStage& st) {
    const int r = tid >> 3, c = tid & 7;
    *(u32x4*)(Ks + r * KLD + c * 8) = st.k;
    bf16_t* vt = Vt + (c * 8) * KLD + r;
    vt[0 * KLD] = (bf16_t)(st.v.x & 0xffffu); vt[1 * KLD] = (bf16_t)(st.v.x >> 16);
    vt[2 * KLD] = (bf16_t)(st.v.y & 0xffffu); vt[3 * KLD] = (bf16_t)(st.v.y >> 16);
    vt[4 * KLD] = (bf16_t)(st.v.z & 0xffffu); vt[5 * KLD] = (bf16_t)(st.v.z >> 16);
    vt[6 * KLD] = (bf16_t)(st.v.w & 0xffffu); vt[7 * KLD] = (bf16_t)(st.v.w >> 16);
}
__device__ __forceinline__ void nsa_load_q(const bf16_t* qsrc, size_t ld, int lane, bf16_t* Qs) {
    u32x4 r[4];
#pragma unroll
    for (int i = 0; i < 4; ++i) { const int p = lane + 64 * i; r[i] = *(const u32x4*)(qsrc + (size_t)(p >> 3) * ld + (p & 7) * 8); }
#pragma unroll
    for (int i = 0; i < 4; ++i) { const int p = lane + 64 * i; *(u32x4*)(Qs + (p >> 3) * KLD + (p & 7) * 8) = r[i]; }
}
__device__ __forceinline__ void nsa_qk(const bf16_t* Ks, const bf16_t* Qs, f32x4 (&s)[4][2], int fr, int fq) {
#pragma unroll
    for (int kt = 0; kt < 4; ++kt)
#pragma unroll
        for (int tt = 0; tt < 2; ++tt) s[kt][tt] = (f32x4){0.f, 0.f, 0.f, 0.f};
#pragma unroll
    for (int ks = 0; ks < 2; ++ks) {
        bf16x8 qf[2];
#pragma unroll
        for (int tt = 0; tt < 2; ++tt) qf[tt] = *(const bf16x8*)(Qs + (tt * 16 + fr) * KLD + ks * 32 + fq * 8);
#pragma unroll
        for (int kt = 0; kt < 4; ++kt) {
            const bf16x8 kf = *(const bf16x8*)(Ks + (kt * 16 + fr) * KLD + ks * 32 + fq * 8);
#pragma unroll
            for (int tt = 0; tt < 2; ++tt) s[kt][tt] = __builtin_amdgcn_mfma_f32_16x16x32_bf16(kf, qf[tt], s[kt][tt], 0, 0, 0);
        }
    }
}
__device__ __forceinline__ void nsa_pv(const bf16_t* Vt, const f32x4 (&p)[4][2], f32x4 (&o)[4][2], int fr, int fq) {
#pragma unroll
    for (int ks2 = 0; ks2 < 2; ++ks2) {
        bf16x8 pf[2];
#pragma unroll
        for (int tt = 0; tt < 2; ++tt) {
            const f32x4 a = p[2 * ks2][tt], b = p[2 * ks2 + 1][tt];
            u32x4 w; w.x = pack2(a.x, a.y); w.y = pack2(a.z, a.w); w.z = pack2(b.x, b.y); w.w = pack2(b.z, b.w);
            pf[tt] = __builtin_bit_cast(bf16x8, w);
        }
#pragma unroll
        for (int dt = 0; dt < 4; ++dt) {
            const bf16_t* vp = Vt + (dt * 16 + fr) * KLD + ks2 * 32 + 4 * fq;
            const u32x2 a0 = *(const u32x2*)vp, a1 = *(const u32x2*)(vp + 16);
            u32x4 w; w.x = a0.x; w.y = a0.y; w.z = a1.x; w.w = a1.y;
            const bf16x8 vf = __builtin_bit_cast(bf16x8, w);
#pragma unroll
            for (int tt = 0; tt < 2; ++tt) o[dt][tt] = __builtin_amdgcn_mfma_f32_16x16x32_bf16(vf, pf[tt], o[dt][tt], 0, 0, 0);
        }
    }
}
template <int MK>
__device__ __forceinline__ bool nsa_valid(int kk, int ti, int n0, int t0) {
    if (MK == 1) return kk <= ti;
    if (MK == 2) return kk > ti;
    return 16 * (n0 + kk) + 31 <= t0 + ti;
}
template <int MK, bool WITH_O>
__device__ __forceinline__ void nsa_softmax(f32x4 (&s)[4][2], float (&m)[2], float (&l)[2], f32x4 (&o)[4][2], const bool (&selb)[2], int tib, int fq, int n0, int t0) {
#pragma unroll
    for (int tt = 0; tt < 2; ++tt) {
        const int ti = tib + tt * 16;
        float mx = -1e30f;
#pragma unroll
        for (int kt = 0; kt < 4; ++kt)
#pragma unroll
            for (int jj = 0; jj < 4; ++jj) {
                const int kk = kt * 16 + 4 * fq + jj;
                const bool v = selb[tt] && nsa_valid<MK>(kk, ti, n0, t0);
                const float sv = v ? s[kt][tt][jj] * SM_C : -1e30f;
                s[kt][tt][jj] = sv; mx = fmaxf(mx, sv);
            }
        mx = fmaxf(mx, __shfl_xor(mx, 16)); mx = fmaxf(mx, __shfl_xor(mx, 32));
        const float mn = fmaxf(m[tt], mx);
        const float alpha = __builtin_amdgcn_exp2f(m[tt] - mn);
        m[tt] = mn;
        float ls = 0.f;
#pragma unroll
        for (int kt = 0; kt < 4; ++kt)
#pragma unroll
            for (int jj = 0; jj < 4; ++jj) {
                const float sv = s[kt][tt][jj];
                const float pv = sv > -1e29f ? __builtin_amdgcn_exp2f(sv - mn) : 0.f;
                s[kt][tt][jj] = pv; ls += pv;
            }
        l[tt] = l[tt] * alpha + ls;
        if (WITH_O) {
#pragma unroll
            for (int dt = 0; dt < 4; ++dt) o[dt][tt] *= alpha;
        }
    }
}
__device__ __forceinline__ void nsa_softmax_fast(f32x4 (&s)[4][2], float (&m)[2], float (&l)[2], f32x4 (&o)[4][2], const float (&bias)[2]) {
#pragma unroll
    for (int tt = 0; tt < 2; ++tt) {
        float mr = fmaxf(fmaxf(s[0][tt][0], s[0][tt][1]), fmaxf(s[0][tt][2], s[0][tt][3]));
#pragma unroll
        for (int kt = 1; kt < 4; ++kt) mr = fmaxf(mr, fmaxf(fmaxf(s[kt][tt][0], s[kt][tt][1]), fmaxf(s[kt][tt][2], s[kt][tt][3])));
        mr = fmaxf(mr, __shfl_xor(mr, 16)); mr = fmaxf(mr, __shfl_xor(mr, 32));
        const float mx = mr * SM_C + bias[tt];
        const float mold = m[tt], mn = fmaxf(mold, mx);
        m[tt] = mn;
        const float off = bias[tt] - mn;
        float ls = 0.f;
#pragma unroll
        for (int kt = 0; kt < 4; ++kt)
#pragma unroll
            for (int jj = 0; jj < 4; ++jj) { const float pv = __builtin_amdgcn_exp2f(__builtin_fmaf(s[kt][tt][jj], SM_C, off)); s[kt][tt][jj] = pv; ls += pv; }
        if (__builtin_amdgcn_ballot_w64(mn > mold) != 0ull) {
            const float alpha = __builtin_amdgcn_exp2f(mold - mn);
            l[tt] = l[tt] * alpha + ls;
#pragma unroll
            for (int dt = 0; dt < 4; ++dt) o[dt][tt] *= alpha;
        } else l[tt] += ls;
    }
}
__device__ __forceinline__ void ins16(unsigned (&L)[16], unsigned x) {
#pragma unroll
    for (int i = 0; i < 16; ++i) { const unsigned hi = L[i] > x ? L[i] : x; x = L[i] > x ? x : L[i]; L[i] = hi; }
}
__device__ __forceinline__ void merge16(unsigned (&L)[16], const unsigned (&P)[16]) {
#pragma unroll
    for (int i = 0; i < 16; ++i) L[i] = L[i] > P[15 - i] ? L[i] : P[15 - i];
#pragma unroll
    for (int st = 8; st >= 1; st >>= 1)
#pragma unroll
        for (int i = 0; i < 16; ++i)
            if ((i & st) == 0) { const unsigned a = L[i], b = L[i + st]; L[i] = a > b ? a : b; L[i + st] = a > b ? b : a; }
}
template <bool ACCUM>
__device__ __forceinline__ void nsa_emit(const f32x4 (&o)[4][2], const float (&l)[2], bool l_is_partial, const float* gsrc, float* obase, int tib, int fq) {
#pragma unroll
    for (int tt = 0; tt < 2; ++tt) {
        float lt = l[tt];
        if (l_is_partial) { lt += __shfl_xor(lt, 16); lt += __shfl_xor(lt, 32); }
        const int ti = tib + tt * 16;
        const float gv = gsrc[(size_t)ti * 32];
        const float sc = l_is_partial ? (lt > 0.f ? gv / lt : 0.f) : gv;
#pragma unroll
        for (int dt = 0; dt < 4; ++dt) {
            float* op = obase + (size_t)ti * 512 + dt * 16 + 4 * fq;
            f32x4 v = o[dt][tt] * sc;
            if (ACCUM) v += *(const f32x4*)op;
            *(f32x4*)op = v;
        }
    }
}
struct NsaBufs { bf16_t *Ks0, *Vt0, *Ks1, *Vt1; };
template <class SRC, class BODY>
__device__ __forceinline__ void nsa_pipeline(int n, const bf16_t* kb, const bf16_t* vb, const NsaBufs& B, int tid, SRC src, BODY body) {
    KVStage sa, sb;
    nsa_stage_load(sa, kb + (size_t)src(0) * 4096, vb + (size_t)src(0) * 4096, tid);
    sb = sa;
    if (n > 1) nsa_stage_load(sb, kb + (size_t)src(1) * 4096, vb + (size_t)src(1) * 4096, tid);
    __syncthreads();
    nsa_stage_store(B.Ks0, B.Vt0, tid, sa);
    sa = sb;
    if (n > 2) nsa_stage_load(sb, kb + (size_t)src(2) * 4096, vb + (size_t)src(2) * 4096, tid);
#pragma unroll 1
    for (int i = 0; i < n; ++i) {
        __syncthreads();
        bf16_t* Ks = (i & 1) ? B.Ks1 : B.Ks0; bf16_t* Vt = (i & 1) ? B.Vt1 : B.Vt0;
        if (i + 1 < n) nsa_stage_store((i & 1) ? B.Ks0 : B.Ks1, (i & 1) ? B.Vt0 : B.Vt1, tid, sa);
        sa = sb;
        if (i + 3 < n) nsa_stage_load(sb, kb + (size_t)src(i + 3) * 4096, vb + (size_t)src(i + 3) * 4096, tid);
        body(src(i), Ks, Vt);
    }
}

__device__ __forceinline__ void d_nsa_cmp(const bf16_t* __restrict__ proj, const bf16_t* __restrict__ kc, const bf16_t* __restrict__ vc,
                                          const float* __restrict__ small, float* __restrict__ onsa, unsigned* __restrict__ selrec, int b, int g, int qt, char* lds) {
    const NsaBufs B{(bf16_t*)(lds + NSA_OFF_KS0), (bf16_t*)(lds + NSA_OFF_VT0), (bf16_t*)(lds + NSA_OFF_KS1), (bf16_t*)(lds + NSA_OFF_VT1)};
    float* imp = (float*)(lds + NSA_OFF_IMP);
    unsigned* selw = (unsigned*)(lds + NSA_OFF_SELW);
    unsigned* anyw = (unsigned*)(lds + NSA_OFF_ANYW);
    int* blist = (int*)(lds + NSA_OFF_BL);
    const int tid = tid_opaque(), lane = tid & 63, w = tid >> 6, hd = w & 3, th = w >> 2, fr = lane & 15, fq = lane >> 4;
    const int tib = th * 32 + fr;
    const size_t tok0 = (size_t)b * SEQ + (size_t)qt * 64;
    const int t0 = qt * 64;
    const float* gbase = small + tok0 * 32 + g * 12 + hd * 3;
    float* obase = onsa + tok0 * 512 + g * 256 + hd * 64;
    const bool sel_all[2] = {true, true};
    const float bias0[2] = {0.f, 0.f};

    for (int i = tid; i < 64 * 132; i += 512) imp[i] = 0.f;
    if (tid < 4) anyw[tid] = 0u;

    bf16_t* Qs = (bf16_t*)(lds + NSA_OFF_QS) + w * 32 * KLD;
    f32x4 s[4][2], o[4][2];
    float m[2], l[2];

    nsa_load_q(proj + (tok0 + th * 32) * PROJ_LD + C_Q + g * 256 + hd * 64, PROJ_LD, lane, Qs);
    const int ncb = (4 * qt + 3 + 63) >> 6;
    {
        const bf16_t* kb = kc + (size_t)(b * 2 + g) * 512 * 64;
        const bf16_t* vb = vc + (size_t)(b * 2 + g) * 512 * 64;
#pragma unroll
        for (int tt = 0; tt < 2; ++tt) { m[tt] = -1e30f; l[tt] = 0.f; }
        nsa_pipeline(ncb, kb, vb, B, tid, [&](int i) { return i; }, [&](int blk_, bf16_t* Ks, bf16_t* Vt) {
            nsa_qk(Ks, Qs, s, fr, fq);
            nsa_softmax<3, false>(s, m, l, o, sel_all, tib, fq, blk_ * 64, t0);
        });
        float linv[2];
#pragma unroll
        for (int tt = 0; tt < 2; ++tt) { float lt = l[tt]; lt += __shfl_xor(lt, 16); lt += __shfl_xor(lt, 32); linv[tt] = lt > 0.f ? 1.0f / lt : 0.f; }
#pragma unroll
        for (int dt = 0; dt < 4; ++dt)
#pragma unroll
            for (int tt = 0; tt < 2; ++tt) o[dt][tt] = (f32x4){0.f, 0.f, 0.f, 0.f};
        nsa_pipeline(ncb, kb, vb, B, tid, [&](int i) { return i; }, [&](int blk_, bf16_t* Ks, bf16_t* Vt) {
            nsa_qk(Ks, Qs, s, fr, fq);
#pragma unroll
            for (int tt = 0; tt < 2; ++tt) {
                const int ti = tib + tt * 16;
#pragma unroll
                for (int kt = 0; kt < 4; ++kt) {
                    f32x4 pv;
#pragma unroll
                    for (int jj = 0; jj < 4; ++jj) {
                        const int kk = kt * 16 + 4 * fq + jj;
                        const bool v = nsa_valid<3>(kk, ti, blk_ * 64, t0);
                        pv[jj] = v ? __builtin_amdgcn_exp2f(s[kt][tt][jj] * SM_C - m[tt]) * linv[tt] : 0.f;
                    }
                    s[kt][tt] = pv;
                    const int j = blk_ * 16 + kt * 4 + fq;
                    atomicAdd(imp + ti * 132 + (j >> 5) * 33 + (j & 31), pv[0] + pv[1] + pv[2] + 0.5f * pv[3]);
                    if (j + 1 < 128) { const int j1 = j + 1; atomicAdd(imp + ti * 132 + (j1 >> 5) * 33 + (j1 & 31), 0.5f * pv[3]); }
                }
            }
            nsa_pv(Vt, s, o, fr, fq);
        });
        nsa_emit<false>(o, l, false, gbase + 0, obase, tib, fq);
    }
    __syncthreads();
    {
        const int ti = tid >> 3, q8 = tid & 7;
        unsigned L[16];
#pragma unroll
        for (int i = 0; i < 16; ++i) L[i] = 0u;
#pragma unroll
        for (int i = 0; i < 16; ++i) {
            const int j = q8 * 16 + i;
            const bool forced = (j == 0) || (j == qt) || (j == qt - 1);
            const float v = imp[ti * 132 + (j >> 5) * 33 + (j & 31)] + (forced ? 1e4f : 0.f) + 1e-30f;
            const unsigned x = (j <= qt) ? ((__float_as_uint(v) & ~0x7Fu) | (unsigned)(127 - j)) : 0u;
            ins16(L, x);
        }
#pragma unroll
        for (int r = 1; r <= 4; r <<= 1) {
            unsigned P[16];
#pragma unroll
            for (int i = 0; i < 16; ++i) P[i] = (unsigned)__shfl_xor((int)L[i], r);
            merge16(L, P);
        }
        if (q8 < 4) {
            unsigned word = 0u;
#pragma unroll
            for (int i = 0; i < 16; ++i) {
                const unsigned e = L[i];
                const int j = 127 - (int)(e & 0x7Fu);
                if (e != 0u && (j >> 5) == q8) word |= 1u << (j & 31);
            }
            selw[ti * 4 + q8] = word;
            atomicOr(&anyw[q8], word);
        }
    }
    __syncthreads();
    int nsel;
    {
        const unsigned a0 = anyw[0], a1 = anyw[1], a2 = anyw[2], a3 = anyw[3];
        if (tid < 128) {
            const unsigned wd = tid < 32 ? a0 : tid < 64 ? a1 : tid < 96 ? a2 : a3;
            if ((wd >> (tid & 31)) & 1u) {
                int pos = __popc(wd & ((1u << (tid & 31)) - 1u));
                if (tid >= 32) pos += __popc(a0);
                if (tid >= 64) pos += __popc(a1);
                if (tid >= 96) pos += __popc(a2);
                blist[pos] = tid;
            }
        }
        nsel = __builtin_amdgcn_readfirstlane(__popc(a0) + __popc(a1) + __popc(a2) + __popc(a3));
    }
    __syncthreads();
    if (tid < 256) selrec[tid] = selw[tid];
    if (tid < 128) selrec[256 + tid] = (unsigned)blist[tid];
    if (tid == 0) selrec[384] = (unsigned)nsel;
    __syncthreads();
}

__device__ __forceinline__ void d_nsa_attn(const bf16_t* __restrict__ qrope, const bf16_t* __restrict__ kvp, const float* __restrict__ small, float* __restrict__ onsa,
                                           const unsigned* __restrict__ selrec, int b, int g, int qt, char* lds) {
    const NsaBufs B{(bf16_t*)(lds + NSA_OFF_KS0), (bf16_t*)(lds + NSA_OFF_VT0), (bf16_t*)(lds + NSA_OFF_KS1), (bf16_t*)(lds + NSA_OFF_VT1)};
    unsigned* selw = (unsigned*)(lds + NSA_OFF_SELW);
    int* blist = (int*)(lds + NSA_OFF_BL);
    const int tid = tid_opaque(), lane = tid & 63, w = tid >> 6, hd = w & 3, th = w >> 2, fr = lane & 15, fq = lane >> 4;
    const int tib = th * 32 + fr;
    const size_t tok0 = (size_t)b * SEQ + (size_t)qt * 64;
    const float* gbase = small + tok0 * 32 + g * 12 + hd * 3;
    float* obase = onsa + tok0 * 512 + g * 256 + hd * 64;
    const bool sel_all[2] = {true, true};
    const float bias0[2] = {0.f, 0.f};
    bf16_t* Qs = (bf16_t*)(lds + NSA_OFF_QS) + w * 32 * KLD;
    f32x4 s[4][2], o[4][2];
    float m[2], l[2];
    if (tid < 256) selw[tid] = selrec[tid];
    if (tid < 128) blist[tid] = (int)selrec[256 + tid];
    const int nsel = __builtin_amdgcn_readfirstlane((int)selrec[384]);
    __syncthreads();
    nsa_load_q(qrope + (tok0 + th * 32) * 512 + g * 256 + hd * 64, 512, lane, Qs);
    {
        const bf16_t* kb = kvp + 2 * KVP_SEG + (size_t)(b * 2 + g) * SEQ * 64;
        const bf16_t* vb = kvp + 3 * KVP_SEG + (size_t)(b * 2 + g) * SEQ * 64;
#pragma unroll
        for (int tt = 0; tt < 2; ++tt) { m[tt] = -1e30f; l[tt] = 0.f; }
#pragma unroll
        for (int dt = 0; dt < 4; ++dt)
#pragma unroll
            for (int tt = 0; tt < 2; ++tt) o[dt][tt] = (f32x4){0.f, 0.f, 0.f, 0.f};
        nsa_pipeline(nsel, kb, vb, B, tid, [&](int i) { return __builtin_amdgcn_readfirstlane(blist[i]); }, [&](int blk_, bf16_t* Ks, bf16_t* Vt) {
            nsa_qk(Ks, Qs, s, fr, fq);
            bool selb[2];
#pragma unroll
            for (int tt = 0; tt < 2; ++tt) selb[tt] = (selw[(tib + tt * 16) * 4 + (blk_ >> 5)] >> (blk_ & 31)) & 1u;
            if (blk_ == qt) nsa_softmax<1, true>(s, m, l, o, selb, tib, fq, 0, 0);
            else {
                float bias[2];
#pragma unroll
                for (int tt = 0; tt < 2; ++tt) bias[tt] = selb[tt] ? 0.f : -1e30f;
                nsa_softmax_fast(s, m, l, o, bias);
            }
            nsa_pv(Vt, s, o, fr, fq);
        });
        nsa_emit<true>(o, l, true, gbase + 1, obase, tib, fq);
    }
    {
        const bf16_t* kb = kvp + 4 * KVP_SEG + (size_t)(b * 2 + g) * SEQ * 64;
        const bf16_t* vb = kvp + 5 * KVP_SEG + (size_t)(b * 2 + g) * SEQ * 64;
#pragma unroll
        for (int tt = 0; tt < 2; ++tt) { m[tt] = -1e30f; l[tt] = 0.f; }
#pragma unroll
        for (int dt = 0; dt < 4; ++dt)
#pragma unroll
            for (int tt = 0; tt < 2; ++tt) o[dt][tt] = (f32x4){0.f, 0.f, 0.f, 0.f};
        const int j0 = qt >= 8 ? qt - 8 : 0;
        nsa_pipeline(qt - j0 + 1, kb, vb, B, tid, [&](int i) { return j0 + i; }, [&](int blk_, bf16_t* Ks, bf16_t* Vt) {
            nsa_qk(Ks, Qs, s, fr, fq);
            if (blk_ == qt) nsa_softmax<1, true>(s, m, l, o, sel_all, tib, fq, 0, 0);
            else if (blk_ == qt - 8) nsa_softmax<2, true>(s, m, l, o, sel_all, tib, fq, 0, 0);
            else nsa_softmax_fast(s, m, l, o, bias0);
            nsa_pv(Vt, s, o, fr, fq);
        });
        nsa_emit<true>(o, l, true, gbase + 2, obase, tib, fq);
    }
    __syncthreads();
}

#define SSD_P 136
#define S3_XST 0
#define S3_BC  69632
#define S3_CC  104448
#define S3_ACS 139264
#define S3_DT  141312
#define S3_END 143360

__device__ __forceinline__ void ssd_acs(const float* __restrict__ small, const float* __restrict__ a_log, size_t tok0, int g, float* acs, float* dtl, int tid) {
    const int w = tid >> 6, lane = tid & 63, hh = 4 * g + (w & 3);
    if (w < 4) {
        const float a = -__expf(a_log[hh]);
        const float d0 = small[(tok0 + 2 * lane) * 32 + 24 + hh], d1 = small[(tok0 + 2 * lane + 1) * 32 + 24 + hh];
        const float s0 = d0 * a, s1 = s0 + d1 * a;
        float tot = s1;
#pragma unroll
        for (int off = 1; off < 64; off <<= 1) { const float t = __shfl_up(tot, off); if (lane >= off) tot += t; }
        const float excl = tot - s1;
        acs[w * 128 + 2 * lane] = excl + s0; acs[w * 128 + 2 * lane + 1] = excl + s1;
        dtl[w * 128 + 2 * lane] = d0; dtl[w * 128 + 2 * lane + 1] = d1;
    }
}
struct ConvCh { float w0, w1, w2, w3, bias, h0, h1, h2; };
__device__ __forceinline__ void conv_init(ConvCh& cc, const float* __restrict__ conv_w, const float* __restrict__ conv_b, int ch, const bf16_t* pb, int c) {
    cc.w0 = conv_w[ch]; cc.w1 = conv_w[1024 + ch]; cc.w2 = conv_w[2048 + ch]; cc.w3 = conv_w[3072 + ch]; cc.bias = conv_b[ch];
    if (c > 0) { cc.h0 = bf2f(pb[-3 * PROJ_LD]); cc.h1 = bf2f(pb[-2 * PROJ_LD]); cc.h2 = bf2f(pb[-1 * PROJ_LD]); } else { cc.h0 = 0.f; cc.h1 = 0.f; cc.h2 = 0.f; }
}
__device__ __forceinline__ float conv_step(ConvCh& cc, float x) {
    const float v = cc.bias + cc.w0 * cc.h0 + cc.w1 * cc.h1 + cc.w2 * cc.h2 + cc.w3 * x;
    cc.h0 = cc.h1; cc.h1 = cc.h2; cc.h2 = x;
    return silu(v);
}

__device__ __forceinline__ void d_ssd_states(const bf16_t* __restrict__ proj, const float* __restrict__ small, const float* __restrict__ conv_w, const float* __restrict__ conv_b,
                                             const float* __restrict__ a_log, float* __restrict__ states, float* __restrict__ cdec, int item, char* lds) {
    const int tid = tid_opaque(), lane = tid & 63, w = tid >> 6, fr = lane & 15, fq = lane >> 4;
    const int b = item >> 7, c = (item >> 1) & 63, g = item & 1;
    bf16_t* XwT = (bf16_t*)(lds + S3_XST); bf16_t* BcT = (bf16_t*)(lds + S3_BC);
    float* acs = (float*)(lds + S3_ACS); float* dtl = (float*)(lds + S3_DT);
    const size_t tok0 = (size_t)b * SEQ + (size_t)c * 128;
    ssd_acs(small, a_log, tok0, g, acs, dtl, tid);
    __syncthreads();
    if (tid < 384) {
        const bool isx = tid < 256;
        const int ch = isx ? g * 256 + tid : 512 + g * 128 + (tid - 256);
        const bf16_t* px = proj + tok0 * PROJ_LD + C_XBC + ch;
        ConvCh cx; conv_init(cx, conv_w, conv_b, ch, px, c);
        const int hw = w & 3;
        const float alast = acs[hw * 128 + 127];
        bf16_t* dst = isx ? XwT + tid * SSD_P : BcT + (tid - 256) * SSD_P;
        for (int l0 = 0; l0 < 128; l0 += 32) {
            float rx[32];
#pragma unroll
            for (int i = 0; i < 32; ++i) rx[i] = bf2f(px[(size_t)(l0 + i) * PROJ_LD]);
#pragma unroll
            for (int i8 = 0; i8 < 4; ++i8) {
                float ox[8];
#pragma unroll
                for (int i = 0; i < 8; ++i) {
                    const int l = l0 + i8 * 8 + i;
                    const float v = conv_step(cx, rx[i8 * 8 + i]);
                    ox[i] = isx ? v * dtl[hw * 128 + l] * __expf(alast - acs[hw * 128 + l]) : v;
                }
                u32x4 o; o.x = pack2(ox[0], ox[1]); o.y = pack2(ox[2], ox[3]); o.z = pack2(ox[4], ox[5]); o.w = pack2(ox[6], ox[7]);
                *(u32x4*)(dst + l0 + i8 * 8) = o;
            }
        }
    }
    __syncthreads();
    {
        const int hw = w & 3, nh = w >> 2;
        f32x4 acc[4][4];
#pragma unroll
        for (int pt = 0; pt < 4; ++pt)
#pragma unroll
            for (int nt = 0; nt < 4; ++nt) acc[pt][nt] = (f32x4){0.f, 0.f, 0.f, 0.f};
#pragma unroll 1
        for (int ks = 0; ks < 4; ++ks) {
            bf16x8 af[4], bfr[4];
#pragma unroll
            for (int pt = 0; pt < 4; ++pt) af[pt] = *(const bf16x8*)(XwT + (hw * 64 + pt * 16 + fr) * SSD_P + ks * 32 + fq * 8);
#pragma unroll
            for (int nt = 0; nt < 4; ++nt) bfr[nt] = *(const bf16x8*)(BcT + ((nh * 4 + nt) * 16 + fr) * SSD_P + ks * 32 + fq * 8);
#pragma unroll
            for (int pt = 0; pt < 4; ++pt)
#pragma unroll
                for (int nt = 0; nt < 4; ++nt) acc[pt][nt] = __builtin_amdgcn_mfma_f32_16x16x32_bf16(af[pt], bfr[nt], acc[pt][nt], 0, 0, 0);
        }
        const int hh = 4 * g + hw;
        float* sp = states + ((size_t)((b * 64 + c) * 8 + hh)) * 8192;
#pragma unroll
        for (int pt = 0; pt < 4; ++pt)
#pragma unroll
            for (int nt = 0; nt < 4; ++nt)
#pragma unroll
                for (int jj = 0; jj < 4; ++jj) sp[(pt * 16 + 4 * fq + jj) * 128 + (nh * 4 + nt) * 16 + fr] = acc[pt][nt][jj];
        if (lane == 0 && nh == 0) cdec[(b * 64 + c) * 8 + hh] = __expf(acs[hw * 128 + 127]);
    }
    __syncthreads();
}

__device__ __forceinline__ void d_ssd_scan(const float* __restrict__ states, const float* __restrict__ cdec, bf16_t* __restrict__ prev, int vb) {
    const int bh = vb >> 1, b = bh >> 3, hh = bh & 7;
    const size_t e0 = (size_t)((vb & 1) * 512 + tid_opaque()) * 8;
    f32x4 h0 = (f32x4){0.f, 0.f, 0.f, 0.f}, h1 = h0;
#pragma unroll 8
    for (int c = 0; c < 64; ++c) {
        const size_t base = ((size_t)((b * 64 + c) * 8 + hh)) * 8192 + e0;
        const f32x4 s0 = *(const f32x4*)(states + base), s1 = *(const f32x4*)(states + base + 4);
        const float d = cdec[(b * 64 + c) * 8 + hh];
        u32x4 o; o.x = pack2(h0.x, h0.y); o.y = pack2(h0.z, h0.w); o.z = pack2(h1.x, h1.y); o.w = pack2(h1.z, h1.w);
        *(u32x4*)(prev + base) = o;
        h0 = h0 * d + s0; h1 = h1 * d + s1;
    }
}

__device__ __forceinline__ void d_ssd_out(const bf16_t* __restrict__ proj, const float* __restrict__ small, const float* __restrict__ conv_w, const float* __restrict__ conv_b,
                                          const float* __restrict__ a_log, const float* __restrict__ d_skip, const bf16_t* __restrict__ prev, bf16_t* __restrict__ yssd, int item, char* lds) {
    const int tid = tid_opaque(), lane = tid & 63, w = tid >> 6, fr = lane & 15, fq = lane >> 4;
    const int b = item >> 7, c = (item >> 1) & 63, g = item & 1;
    bf16_t* XsT = (bf16_t*)(lds + S3_XST); bf16_t* Bc = (bf16_t*)(lds + S3_BC); bf16_t* Cc = (bf16_t*)(lds + S3_CC);
    float* acs = (float*)(lds + S3_ACS); float* dtl = (float*)(lds + S3_DT);
    const size_t tok0 = (size_t)b * SEQ + (size_t)c * 128;
    ssd_acs(small, a_log, tok0, g, acs, dtl, tid);
    {
        const int mode = tid < 256 ? 0 : (tid < 384 ? 1 : 2);
        const int ch = mode == 0 ? g * 256 + tid : (mode == 1 ? 512 + g * 128 + (tid - 256) : 768 + g * 128 + (tid - 384));
        const bf16_t* px = proj + tok0 * PROJ_LD + C_XBC + ch;
        ConvCh cx; conv_init(cx, conv_w, conv_b, ch, px, c);
        bf16_t* dstx = XsT + (tid & 255) * SSD_P;
        bf16_t* dstbc = (mode == 1 ? Bc : Cc) + (tid & 127);
        for (int l0 = 0; l0 < 128; l0 += 32) {
            float rx[32];
#pragma unroll
            for (int i = 0; i < 32; ++i) rx[i] = bf2f(px[(size_t)(l0 + i) * PROJ_LD]);
#pragma unroll
            for (int i8 = 0; i8 < 4; ++i8) {
                float ox[8];
#pragma unroll
                for (int i = 0; i < 8; ++i) ox[i] = conv_step(cx, rx[i8 * 8 + i]);
                if (mode == 0) {
                    u32x4 o; o.x = pack2(ox[0], ox[1]); o.y = pack2(ox[2], ox[3]); o.z = pack2(ox[4], ox[5]); o.w = pack2(ox[6], ox[7]);
                    *(u32x4*)(dstx + l0 + i8 * 8) = o;
                } else {
#pragma unroll
                    for (int i = 0; i < 8; ++i) dstbc[(l0 + i8 * 8 + i) * SSD_P] = f2bf(ox[i]);
                }
            }
        }
    }
    __syncthreads();
    const int hw = w & 3, lh = w >> 2, hh = 4 * g + hw;
    const float dsk = d_skip[hh];
    const bf16_t* pp = prev + ((size_t)((b * 64 + c) * 8 + hh)) * 8192;
#pragma unroll 1
    for (int lk = 0; lk < 4; ++lk) {
        const int lt = lh + 2 * lk;
        const int l = lt * 16 + fr;
        const float acs_l = acs[hw * 128 + l];
        bf16x8 cf[4];
#pragma unroll
        for (int ks = 0; ks < 4; ++ks) cf[ks] = *(const bf16x8*)(Cc + (lt * 16 + fr) * SSD_P + ks * 32 + fq * 8);
        f32x4 y[4], yo[4];
#pragma unroll
        for (int pt = 0; pt < 4; ++pt) { y[pt] = (f32x4){0.f, 0.f, 0.f, 0.f}; yo[pt] = (f32x4){0.f, 0.f, 0.f, 0.f}; }
#pragma unroll
        for (int ks2 = 0; ks2 < 4; ++ks2) {
            if (2 * ks2 <= lt) {
                f32x4 cb[2];
#pragma unroll
                for (int h2 = 0; h2 < 2; ++h2) {
                    const int st = 2 * ks2 + h2;
                    cb[h2] = (f32x4){0.f, 0.f, 0.f, 0.f};
                    if (st <= lt) {
#pragma unroll
                        for (int ks = 0; ks < 4; ++ks)
                            cb[h2] = __builtin_amdgcn_mfma_f32_16x16x32_bf16(*(const bf16x8*)(Bc + (st * 16 + fr) * SSD_P + ks * 32 + fq * 8), cf[ks], cb[h2], 0, 0, 0);
#pragma unroll
                        for (int jj = 0; jj < 4; ++jj) {
                            const int sidx = st * 16 + 4 * fq + jj;
                            cb[h2][jj] = (sidx <= l) ? cb[h2][jj] * __expf(acs_l - acs[hw * 128 + sidx]) * dtl[hw * 128 + sidx] : 0.f;
                        }
                    }
                }
                u32x4 wv; wv.x = pack2(cb[0].x, cb[0].y); wv.y = pack2(cb[0].z, cb[0].w); wv.z = pack2(cb[1].x, cb[1].y); wv.w = pack2(cb[1].z, cb[1].w);
                const bf16x8 mf = __builtin_bit_cast(bf16x8, wv);
#pragma unroll
                for (int pt = 0; pt < 4; ++pt) {
                    const bf16_t* xp = XsT + (hw * 64 + pt * 16 + fr) * SSD_P + ks2 * 32 + 4 * fq;
                    const u32x2 a0 = *(const u32x2*)xp, a1 = *(const u32x2*)(xp + 16);
                    u32x4 xv; xv.x = a0.x; xv.y = a0.y; xv.z = a1.x; xv.w = a1.y;
                    y[pt] = __builtin_amdgcn_mfma_f32_16x16x32_bf16(__builtin_bit_cast(bf16x8, xv), mf, y[pt], 0, 0, 0);
                }
            }
            __builtin_amdgcn_sched_barrier(0);
        }
        __builtin_amdgcn_sched_barrier(0);
#pragma unroll
        for (int pt = 0; pt < 4; ++pt)
#pragma unroll
            for (int ks = 0; ks < 4; ++ks) yo[pt] = __builtin_amdgcn_mfma_f32_16x16x32_bf16(*(const bf16x8*)(pp + (pt * 16 + fr) * 128 + ks * 32 + fq * 8), cf[ks], yo[pt], 0, 0, 0);
        __builtin_amdgcn_sched_barrier(0);
        const float el = __expf(acs_l);
#pragma unroll
        for (int pt = 0; pt < 4; ++pt) {
            const int p0 = pt * 16 + 4 * fq;
            const u32x2 zz = *(const u32x2*)(proj + (tok0 + l) * PROJ_LD + C_Z + hh * 64 + p0);
            const float z0 = bflo(zz.x), z1 = bfhi(zz.x), z2 = bflo(zz.y), z3 = bfhi(zz.y);
            const bf16_t* xq = XsT + (hw * 64 + p0) * SSD_P + l;
            const float x0 = bf2f(xq[0]), x1 = bf2f(xq[SSD_P]), x2 = bf2f(xq[2 * SSD_P]), x3 = bf2f(xq[3 * SSD_P]);
            u32x2 ob;
            ob.x = pack2((y[pt].x + el * yo[pt].x + dsk * x0) * silu(z0), (y[pt].y + el * yo[pt].y + dsk * x1) * silu(z1));
            ob.y = pack2((y[pt].z + el * yo[pt].z + dsk * x2) * silu(z2), (y[pt].w + el * yo[pt].w + dsk * x3) * silu(z3));
            *(u32x2*)(yssd + (tok0 + l) * 512 + hh * 64 + p0) = ob;
        }
    }
    __syncthreads();
}

__device__ __forceinline__ void d_mix_prep(const float* __restrict__ onsa, const bf16_t* __restrict__ yssd, const float* __restrict__ nsa_w, const float* __restrict__ ssd_w, bf16_t* __restrict__ A2, int vb) {
    const int tid_ = tid_opaque(); const int lane = tid_ & 63, wid = tid_ >> 6;
    const size_t row0 = (size_t)vb * 32 + wid * 4;
    f32x4 a[4][2], y[4][2];
#pragma unroll
    for (int r = 0; r < 4; ++r)
#pragma unroll
        for (int k = 0; k < 2; ++k) {
            a[r][k] = *(const f32x4*)(onsa + (row0 + r) * 512 + k * 256 + lane * 4);
            const u32x2 yy = *(const u32x2*)(yssd + (row0 + r) * 512 + k * 256 + lane * 4);
            y[r][k] = (f32x4){bflo(yy.x), bfhi(yy.x), bflo(yy.y), bfhi(yy.y)};
        }
    float ra[4], ry[4];
#pragma unroll
    for (int r = 0; r < 4; ++r) {
        float s0 = 0.f, s1 = 0.f;
#pragma unroll
        for (int k = 0; k < 2; ++k) {
            s0 += a[r][k].x * a[r][k].x + a[r][k].y * a[r][k].y + a[r][k].z * a[r][k].z + a[r][k].w * a[r][k].w;
            s1 += y[r][k].x * y[r][k].x + y[r][k].y * y[r][k].y + y[r][k].z * y[r][k].z + y[r][k].w * y[r][k].w;
        }
        ra[r] = rsqrtf(wave_sum(s0) * (1.0f / 512) + EPS); ry[r] = rsqrtf(wave_sum(s1) * (1.0f / 512) + EPS);
    }
#pragma unroll
    for (int k = 0; k < 2; ++k) {
        const int col = k * 256 + lane * 4;
        const f32x4 wn = *(const f32x4*)(nsa_w + col), wsd = *(const f32x4*)(ssd_w + col);
#pragma unroll
        for (int r = 0; r < 4; ++r) {
            const f32x4 p = a[r][k] * ra[r] * wn, q = y[r][k] * ry[r] * wsd;
            u32x2 o; o.x = pack2(p.x, p.y); o.y = pack2(p.z, p.w);
            *(u32x2*)(A2 + (row0 + r) * DM + col) = o;
            u32x2 o2; o2.x = pack2(q.x, q.y); o2.y = pack2(q.z, q.w);
            *(u32x2*)(A2 + (row0 + r) * DM + 512 + col) = o2;
        }
    }
}

__device__ __forceinline__ void d_quant_rows(const float* __restrict__ src, unsigned char* __restrict__ dst, float* __restrict__ scale, int vb) {
    const int tid_ = tid_opaque(); const int lane = tid_ & 63, row = vb * 8 + (tid_ >> 6);
    const float* rp = src + (size_t)row * DM + lane * 16;
    f32x4 v[4];
#pragma unroll
    for (int i = 0; i < 4; ++i) v[i] = *(const f32x4*)(rp + i * 4);
    float mx = 0.f;
#pragma unroll
    for (int i = 0; i < 4; ++i) mx = fmaxf(mx, fmaxf(fmaxf(fabsf(v[i].x), fabsf(v[i].y)), fmaxf(fabsf(v[i].z), fabsf(v[i].w))));
    mx = wave_max(mx);
    const float sc = mx > 0.f ? mx * (1.0f / 416.0f) : 1.0f;
    const float inv = 1.0f / sc;
    u32x4 o;
#pragma unroll
    for (int i = 0; i < 4; ++i) {
        int wv = 0;
        wv = __builtin_amdgcn_cvt_pk_fp8_f32(v[i].x * inv, v[i].y * inv, wv, false);
        wv = __builtin_amdgcn_cvt_pk_fp8_f32(v[i].z * inv, v[i].w * inv, wv, true);
        o[i] = (unsigned)wv;
    }
    *(u32x4*)(dst + (size_t)row * DM + lane * 16) = o;
    if (lane == 0) scale[row] = sc;
}

__device__ __forceinline__ unsigned mono_u(float f) { const unsigned u = __float_as_uint(f); return (u & 0x80000000u) ? ~u : (u | 0x80000000u); }
__device__ __forceinline__ float unmono_f(unsigned m) { const unsigned u = (m & 0x80000000u) ? (m & 0x7fffffffu) : ~m; return __uint_as_float(u); }
__device__ __forceinline__ void d_peer_route(const bf16_t* __restrict__ qp, const float* __restrict__ qnw, const bf16_t* __restrict__ subk, int* __restrict__ eidx, float* __restrict__ gate,
                                             int tile, int h, char* lds) {
    const int tid = tid_opaque(), lane = tid & 63, w = tid >> 6, fr = lane & 15, fq = lane >> 4;
    const size_t tok = (size_t)tile * 128 + w * 16 + fr;
    bf16x8 qf[2][4];
    {
        const bf16_t* qrow = qp + tok * 2048 + h * 256;
        u32x4 raw[2][4];
        float ss = 0.f;
#pragma unroll
        for (int k = 0; k < 2; ++k)
#pragma unroll
            for (int ks = 0; ks < 4; ++ks) {
                const u32x4 r = *(const u32x4*)(qrow + k * 128 + ks * 32 + fq * 8);
                raw[k][ks] = r;
                ss += bflo(r.x) * bflo(r.x) + bfhi(r.x) * bfhi(r.x) + bflo(r.y) * bflo(r.y) + bfhi(r.y) * bfhi(r.y)
                    + bflo(r.z) * bflo(r.z) + bfhi(r.z) * bfhi(r.z) + bflo(r.w) * bflo(r.w) + bfhi(r.w) * bfhi(r.w);
            }
        ss += __shfl_xor(ss, 16); ss += __shfl_xor(ss, 32);
        const float rs = rsqrtf(ss * (1.0f / 256) + EPS);
#pragma unroll
        for (int k = 0; k < 2; ++k)
#pragma unroll
            for (int ks = 0; ks < 4; ++ks) {
                const float* wp = qnw + k * 128 + ks * 32 + fq * 8;
                const f32x4 w0 = *(const f32x4*)wp, w1 = *(const f32x4*)(wp + 4);
                const u32x4 r = raw[k][ks];
                u32x4 o;
                o.x = pack2(bflo(r.x) * rs * w0.x, bfhi(r.x) * rs * w0.y); o.y = pack2(bflo(r.y) * rs * w0.z, bfhi(r.y) * rs * w0.w);
                o.z = pack2(bflo(r.z) * rs * w1.x, bfhi(r.z) * rs * w1.y); o.w = pack2(bflo(r.w) * rs * w1.z, bfhi(r.w) * rs * w1.w);
                qf[k][ks] = __builtin_bit_cast(bf16x8, o);
            }
    }
    unsigned L[2][16];
#pragma unroll
    for (int k = 0; k < 2; ++k) {
        f32x4 acc[8];
#pragma unroll
        for (int kt = 0; kt < 8; ++kt) acc[kt] = (f32x4){0.f, 0.f, 0.f, 0.f};
        const bf16_t* kb = subk + (size_t)((h * 2 + k) * 128) * 128;
#pragma unroll
        for (int kt = 0; kt < 8; ++kt)
#pragma unroll
            for (int ks = 0; ks < 4; ++ks) {
                const bf16x8 af = *(const bf16x8*)(kb + (size_t)(kt * 16 + fr) * 128 + ks * 32 + fq * 8);
                acc[kt] = __builtin_amdgcn_mfma_f32_16x16x32_bf16(af, qf[k][ks], acc[kt], 0, 0, 0);
            }
#pragma unroll
        for (int i = 0; i < 16; ++i) L[k][i] = 0u;
#pragma unroll
        for (int kt = 0; kt < 8; ++kt)
#pragma unroll
            for (int jj = 0; jj < 4; ++jj) {
                const int idx = kt * 16 + 4 * fq + jj;
                ins16(L[k], (mono_u(acc[kt][jj]) & ~0x7Fu) | (unsigned)(127 - idx));
            }
#pragma unroll
        for (int r = 16; r <= 32; r <<= 1) {
            unsigned P[16];
#pragma unroll
            for (int i = 0; i < 16; ++i) P[i] = (unsigned)__shfl_xor((int)L[k][i], r);
            merge16(L[k], P);
        }
    }
    unsigned T[16];
#pragma unroll
    for (int i = 0; i < 16; ++i) T[i] = 0u;
#pragma unroll
    for (int a = 0; a < 16; ++a) {
        const float va = unmono_f(L[0][a] & ~0x7Fu);
#pragma unroll
        for (int bb = 0; bb < 16; ++bb) {
            if (bb <= 16 / (a + 1) - 1) {
                const float sum = va + unmono_f(L[1][bb] & ~0x7Fu);
                ins16(T, (mono_u(sum) & ~0xFFu) | (unsigned)(255 - (a * 16 + bb)));
            }
        }
    }
    unsigned char* li = (unsigned char*)lds + w * 512 + fr * 32;
    if (fq == 0) {
#pragma unroll
        for (int a = 0; a < 16; ++a) { li[a] = (unsigned char)(127 - (L[0][a] & 0x7Fu)); li[16 + a] = (unsigned char)(127 - (L[1][a] & 0x7Fu)); }
    }
    __syncthreads();
    const float s0 = unmono_f(T[0] & ~0xFFu);
    float pe[16]; float sum = 0.f;
#pragma unroll
    for (int i = 0; i < 16; ++i) { pe[i] = __expf(unmono_f(T[i] & ~0xFFu) - s0); sum += pe[i]; }
    const float inv = 1.0f / sum;
    unsigned cod[4] = {0u, 0u, 0u, 0u}; float gv[4] = {0.f, 0.f, 0.f, 0.f};
#pragma unroll
    for (int i = 0; i < 16; ++i) if ((i >> 2) == fq) { cod[i & 3] = 255u - (T[i] & 0xFFu); gv[i & 3] = pe[i] * inv; }
    int ev[4];
#pragma unroll
    for (int i = 0; i < 4; ++i) ev[i] = (int)li[cod[i] >> 4] * 128 + (int)li[16 + (cod[i] & 15u)];
    *(u32x4*)(eidx + (tok * 8 + h) * 16 + fq * 4) = (u32x4){(unsigned)ev[0], (unsigned)ev[1], (unsigned)ev[2], (unsigned)ev[3]};
    *(f32x4*)(gate + (tok * 8 + h) * 16 + fq * 4) = (f32x4){gv[0], gv[1], gv[2], gv[3]};
    __syncthreads();
}

__device__ __forceinline__ void cvt16(const u32x4 q, float (&f)[16]) {
#pragma unroll
    for (int i = 0; i < 4; ++i) {
        const f32x2 lo = __builtin_amdgcn_cvt_pk_f32_fp8((int)q[i], false), hi = __builtin_amdgcn_cvt_pk_f32_fp8((int)q[i], true);
        f[4 * i] = lo.x; f[4 * i + 1] = lo.y; f[4 * i + 2] = hi.x; f[4 * i + 3] = hi.y;
    }
}
__device__ __forceinline__ void d_peer_expert8(const bf16_t* __restrict__ h2, const unsigned char* __restrict__ down8, const unsigned char* __restrict__ up8, const float* __restrict__ dscale,
                                               const float* __restrict__ uscale, const int* __restrict__ eidx, const float* __restrict__ gate, const float* __restrict__ mod,
                                               const float* __restrict__ fw, float* __restrict__ out, int vb) {
    const int tid = tid_opaque(), lane = tid & 63, wid = tid >> 6;
    const size_t tok = (size_t)vb * 8 + wid; const int b = (int)(tok >> 13);
    const int e_lo = eidx[tok * 128 + lane], e_hi = eidx[tok * 128 + 64 + lane];
    const float c_lo = gate[tok * 128 + lane] * uscale[e_lo], c_hi = gate[tok * 128 + 64 + lane] * uscale[e_hi];
    const float d_lo = dscale[e_lo], d_hi = dscale[e_hi];
    float hx[16], acc[16];
    {
        const u32x4 v0 = *(const u32x4*)(h2 + tok * DM + lane * 16), v1 = *(const u32x4*)(h2 + tok * DM + lane * 16 + 8);
        hx[0] = bflo(v0.x); hx[1] = bfhi(v0.x); hx[2] = bflo(v0.y); hx[3] = bfhi(v0.y); hx[4] = bflo(v0.z); hx[5] = bfhi(v0.z); hx[6] = bflo(v0.w); hx[7] = bfhi(v0.w);
        hx[8] = bflo(v1.x); hx[9] = bfhi(v1.x); hx[10] = bflo(v1.y); hx[11] = bfhi(v1.y); hx[12] = bflo(v1.z); hx[13] = bfhi(v1.z); hx[14] = bflo(v1.w); hx[15] = bfhi(v1.w);
    }
#pragma unroll
    for (int e = 0; e < 16; ++e) acc[e] = 0.f;
    const int es = lane >> 3;
    u32x4 dq[8], uq[8], dn[8], un[8];
#pragma unroll
    for (int i = 0; i < 8; ++i) {
        const int e = __builtin_amdgcn_readlane(e_lo, i);
        dq[i] = *(const u32x4*)(down8 + (size_t)e * DM + lane * 16);
        uq[i] = *(const u32x4*)(up8 + (size_t)e * DM + lane * 16);
    }
#pragma unroll 1
    for (int j0 = 0; j0 < 128; j0 += 8) {
        if (j0 + 8 < 128) {
            const int jn = j0 + 8;
#pragma unroll
            for (int i = 0; i < 8; ++i) {
                const int e = jn < 64 ? __builtin_amdgcn_readlane(e_lo, jn + i) : __builtin_amdgcn_readlane(e_hi, jn - 64 + i);
                dn[i] = *(const u32x4*)(down8 + (size_t)e * DM + lane * 16);
                un[i] = *(const u32x4*)(up8 + (size_t)e * DM + lane * 16);
            }
        }
        const int sl = (j0 & 63) + es;
        const float my_c = j0 < 64 ? __shfl(c_lo, sl) : __shfl(c_hi, sl);
        const float my_ds = j0 < 64 ? __shfl(d_lo, sl) : __shfl(d_hi, sl);
        float part[8];
#pragma unroll
        for (int i = 0; i < 8; ++i) {
            float f[16]; cvt16(dq[i], f);
            float s = 0.f;
#pragma unroll
            for (int e = 0; e < 16; ++e) s += hx[e] * f[e];
            part[i] = s;
        }
        float q4[4], q2[2], q1;
#pragma unroll
        for (int i = 0; i < 4; ++i) { const bool up = (lane & 32) != 0; const float send = up ? part[i] : part[i + 4]; const float keep = up ? part[i + 4] : part[i]; q4[i] = keep + __shfl_xor(send, 32); }
#pragma unroll
        for (int i = 0; i < 2; ++i) { const bool up = (lane & 16) != 0; const float send = up ? q4[i] : q4[i + 2]; const float keep = up ? q4[i + 2] : q4[i]; q2[i] = keep + __shfl_xor(send, 16); }
        { const bool up = (lane & 8) != 0; const float send = up ? q2[0] : q2[1]; const float keep = up ? q2[1] : q2[0]; q1 = keep + __shfl_xor(send, 8); }
        q1 += __shfl_xor(q1, 4); q1 += __shfl_xor(q1, 2); q1 += __shfl_xor(q1, 1);
        const float a = gelu_tanh(q1 * my_ds) * my_c;
#pragma unroll
        for (int i = 0; i < 8; ++i) {
            const float c = __uint_as_float((unsigned)__builtin_amdgcn_readlane((int)__float_as_uint(a), 8 * i));
            float f[16]; cvt16(uq[i], f);
#pragma unroll
            for (int e = 0; e < 16; ++e) acc[e] += c * f[e];
        }
#pragma unroll
        for (int i = 0; i < 8; ++i) { dq[i] = dn[i]; uq[i] = un[i]; }
    }
    float x2[16]; float ss = 0.f;
#pragma unroll
    for (int q4i = 0; q4i < 4; ++q4i) {
        const int col = lane * 16 + q4i * 4;
        const f32x4 xv = *(const f32x4*)(out + tok * DM + col);
        const f32x4 g2 = *(const f32x4*)(mod + b * 6144 + 5120 + col);
        const int e0 = q4i * 4;
        x2[e0 + 0] = xv.x + g2.x * acc[e0 + 0]; x2[e0 + 1] = xv.y + g2.y * acc[e0 + 1]; x2[e0 + 2] = xv.z + g2.z * acc[e0 + 2]; x2[e0 + 3] = xv.w + g2.w * acc[e0 + 3];
        ss += x2[e0] * x2[e0] + x2[e0 + 1] * x2[e0 + 1] + x2[e0 + 2] * x2[e0 + 2] + x2[e0 + 3] * x2[e0 + 3];
    }
    ss = wave_sum(ss);
    const float r = rsqrtf(ss * (1.0f / DM) + EPS);
#pragma unroll
    for (int q4i = 0; q4i < 4; ++q4i) {
        const int col = lane * 16 + q4i * 4;
        const f32x4 wv = *(const f32x4*)(fw + col);
        const int e0 = q4i * 4;
        *(f32x4*)(out + tok * DM + col) = (f32x4){x2[e0] * r * wv.x, x2[e0 + 1] * r * wv.y, x2[e0 + 2] * r * wv.z, x2[e0 + 3] * r * wv.w};
    }
}

#define XB_TMO      128
#define XB_XCNT(j)  (256  + 64 * (j))
#define XB_XSUB(j)  (1280 + 64 * (j))
#define XB_XGEN(j)  (2304 + 64 * (j))
#define XB_TOP      3328
#define XB_TOPGEN   3392
#define XCD_BAR_WORDS 3456
#define XB_SPIN_CAP (1u << 18)

__device__ __forceinline__ unsigned xb_ld(unsigned* p)              { return __hip_atomic_load(p, __ATOMIC_RELAXED, __HIP_MEMORY_SCOPE_AGENT); }
__device__ __forceinline__ unsigned xb_add(unsigned* p, unsigned v) { return __hip_atomic_fetch_add(p, v, __ATOMIC_RELAXED, __HIP_MEMORY_SCOPE_AGENT); }
__device__ __forceinline__ unsigned xb_xcc_id() { return (unsigned)__builtin_amdgcn_s_getreg((3 << 11) | 20) & 0xFu; }
#define XB_SPIN(cond, bar) do { unsigned _sp = 0; while (cond) { __builtin_amdgcn_s_sleep(1); \
    if ((++_sp & 255u) == 0u) { if (xb_ld(&(bar)[XB_TMO])) break; if (_sp > XB_SPIN_CAP) { atomicAdd(&(bar)[XB_TMO], 1u); break; } } } } while (0)

struct XcdBarrier {
    unsigned* bar; unsigned x;
    volatile __attribute__((address_space(3))) unsigned* st;
};

__device__ __forceinline__ XcdBarrier xcd_barrier_post(unsigned* bar, volatile __attribute__((address_space(3))) unsigned* st) {
    XcdBarrier b; b.bar = bar; b.x = xb_xcc_id(); b.st = st;
    if (threadIdx.x == 0) (void)xb_add(&bar[XB_XCNT(b.x)], 1u);
    return b;
}
__device__ __forceinline__ void xcd_barrier_complete(unsigned* bar, unsigned x, unsigned& nloc, unsigned& nx) {
    const unsigned G = gridDim.x * gridDim.y * gridDim.z;
    unsigned sum, cnt, mine, sp = 0u;
    for (;;) {
        sum = 0u; cnt = 0u; mine = 0u;
#pragma unroll
        for (unsigned j = 0; j < 16; ++j) { const unsigned c = xb_ld(&bar[XB_XCNT(j)]); sum += c; cnt += (c > 0u) ? 1u : 0u; mine = (j == x) ? c : mine; }
        if (sum == G) break;
        __builtin_amdgcn_s_sleep(1);
        if ((++sp & 255u) == 0u) { if (xb_ld(&bar[XB_TMO])) break; if (sp > XB_SPIN_CAP) { atomicAdd(&bar[XB_TMO], 1u); break; } }
    }
    nloc = mine > 0u ? mine : 1u; nx = cnt > 0u ? cnt : 1u;
}

__device__ __forceinline__ void xcd_barrier(const XcdBarrier& b) {
    asm volatile("s_waitcnt vmcnt(0)" ::: "memory");
    __syncthreads();
    if (threadIdx.x == 0) {
        unsigned* bar = b.bar;
        __builtin_amdgcn_s_waitcnt(0);
        unsigned nloc = b.st[0], nx = b.st[1];
        if (nloc == 0u) { xcd_barrier_complete(bar, b.x, nloc, nx); b.st[0] = nloc; b.st[1] = nx; }
        const unsigned old = xb_add(&bar[XB_XSUB(b.x)], 1u);
        const unsigned gen = old / nloc;
        if (old + 1u == (gen + 1u) * nloc) {
            __builtin_amdgcn_fence(__ATOMIC_RELEASE, "agent");
            asm volatile("s_waitcnt vmcnt(0)" ::: "memory");
            const unsigned og = xb_add(&bar[XB_TOP], 1u);
            const unsigned tg = og / nx;
            if (og + 1u == (tg + 1u) * nx) xb_add(&bar[XB_TOPGEN], 1u);
            else XB_SPIN(xb_ld(&bar[XB_TOPGEN]) == tg, bar);
            __builtin_amdgcn_fence(__ATOMIC_ACQUIRE, "agent");
            xb_add(&bar[XB_XGEN(b.x)], 1u);
            asm volatile("s_waitcnt vmcnt(0)" ::: "memory");
        } else {
            XB_SPIN(xb_ld(&bar[XB_XGEN(b.x)]) == gen, bar);
            __builtin_amdgcn_fence(__ATOMIC_ACQUIRE, "agent");
            asm volatile("s_waitcnt vmcnt(0)" ::: "memory");
        }
    }
    __syncthreads();
}


struct Params {
    const float *x, *c, *w_ada, *b_ada, *norm1_w, *w_in, *cmp_pe_k, *cmp_pe_v, *cmp_w1_k, *cmp_w2_k, *cmp_w1_v, *cmp_w2_v, *nsa_norm_w, *conv_w, *conv_b, *dt_bias, *a_log, *d_skip,
        *ssd_norm_w, *w_out, *norm2_w, *peer_wq, *peer_qnorm_w, *peer_sub_keys, *peer_down, *peer_up, *final_norm_w;
    float* out; char* ws;
};
#define LDS_BYTES 147456
#define LDS_MISC  (LDS_BYTES - 64)

__global__ __launch_bounds__(512, 2) void mega(Params p) {
    __shared__ __attribute__((aligned(16))) unsigned char lds_raw[LDS_BYTES];
    char* lds = (char*)lds_raw;
    PG8_LAS unsigned char* lds3 = (PG8_LAS unsigned char*)lds_raw;
    int* s_vb = (int*)(lds + LDS_MISC);
    cg::grid_group grid = cg::this_grid();
    volatile __attribute__((address_space(3))) unsigned* xb_st = (volatile __attribute__((address_space(3))) unsigned*)((PG8_LAS unsigned char*)lds_raw + LDS_MISC + 16);
    if (threadIdx.x == 0) { xb_st[0] = 0u; xb_st[1] = 0u; }
    __syncthreads();
    const XcdBarrier xbar = xcd_barrier_post((unsigned*)(p.ws + OFF_BAR), xb_st);
    const int G = gridDim.x, bid = blockIdx.x;
    if (bid == 0 && threadIdx.x == 0) { ((unsigned*)(p.ws + OFF_CTR))[0] = 0u; ((unsigned*)(p.ws + OFF_CTR))[64] = 0u; ((unsigned*)(p.ws + OFF_CTR))[128] = 0u; }
    for (int vb = bid; vb < 7906; vb += G) {
        int v = vb;
        if (v < 1536) { d_transpose_w(p.w_in, ((bf16_t*)(p.ws + OFF_WIN_T)), 1024, 2848, 1, 96, v, lds); }
        else if ((v -= 1536) < 512) { d_transpose_w(p.w_out, ((bf16_t*)(p.ws + OFF_WOUT_T)), 1024, 1024, 0, 32, v, lds); }
        else if ((v -= 512) < 1024) { d_transpose_w(p.peer_wq, ((bf16_t*)(p.ws + OFF_WQ_T)), 1024, 2048, 0, 64, v, lds); }
        else if ((v -= 1024) < 256) { d_transpose_w(p.cmp_w1_k, ((bf16_t*)(p.ws + OFF_W1K_T)), 2048, 256, 0, 8, v, lds); }
        else if ((v -= 256) < 256) { d_transpose_w(p.cmp_w1_v, ((bf16_t*)(p.ws + OFF_W1V_T)), 2048, 256, 0, 8, v, lds); }
        else if ((v -= 256) < 2048) { d_quant_rows(p.peer_down, ((unsigned char*)(p.ws + OFF_DOWN)), ((float*)(p.ws + OFF_UP)), v); }
        else if ((v -= 2048) < 2048) { d_quant_rows(p.peer_up, ((unsigned char*)(p.ws + OFF_DOWN + MIB(16))), ((float*)(p.ws + OFF_UP + 65536)), v); }
        else if ((v -= 2048) < 1) { d_convert_bf16(p.peer_sub_keys, ((bf16_t*)(p.ws + OFF_SUBK)), (size_t)8 * 2 * 128 * 128 / 8, 0, 1); }
        else if ((v -= 1) < 96) { d_mod(p.c, p.w_ada, p.b_ada, ((float*)(p.ws + OFF_MOD)), v, lds); }
        else if ((v -= 96) < 128) { d_rope_table(((float2*)(p.ws + OFF_ROPE)), v); }
        else { d_bias1(p.cmp_pe_k, p.cmp_w1_k, p.cmp_pe_v, p.cmp_w1_v, ((float*)(p.ws + OFF_BIAS1))); }
    }
    grid.sync();
    for (int vb = bid; vb < NTOK / 32; vb += G) d_norm_mod(p.x, p.norm1_w, ((float*)(p.ws + OFF_MOD)), 0, 1024, ((bf16_t*)(p.ws + OFF_H)), vb);
    xcd_barrier(xbar);
    {
        const pg8::Gemm g{((bf16_t*)(p.ws + OFF_H)), ((bf16_t*)(p.ws + OFF_WIN_T)), NTOK, NIN_PAD, 1024, 1024};
        pg8::StaticOrder S; S.init(NTOK, NIN_PAD, G, bid);
        const pg8::Epi<EpInProj> E{{((bf16_t*)(p.ws + OFF_PROJ)), ((bf16_t*)(p.ws + OFF_QROPE)), ((bf16_t*)(p.ws + OFF_KVP)), ((float*)(p.ws + OFF_SMALL)), ((float2*)(p.ws + OFF_ROPE)), p.dt_bias}};
        pg8::gemm_phase(lds3, g, S, E);
    }
    xcd_barrier(xbar);
    {
        {
            const pg8::Gemm g{((bf16_t*)(p.ws + OFF_KVP)) + 0 * KVP_SEG, ((bf16_t*)(p.ws + OFF_W1K_T)), 8192, 256, 2048, 1024};
            pg8::StaticOrder S; S.init(8192, 256, G, bid);
            const pg8::Epi<EpCmpHid> E{{((bf16_t*)(p.ws + OFF_HIDK)), ((float*)(p.ws + OFF_BIAS1))}};
            pg8::gemm_phase(lds3, g, S, E);
        }
        {
            const pg8::Gemm g{((bf16_t*)(p.ws + OFF_KVP)) + 1 * KVP_SEG, ((bf16_t*)(p.ws + OFF_W1V_T)), 8192, 256, 2048, 1024};
            pg8::StaticOrder S; S.init(8192, 256, G, (bid + G / 2) % G);
            const pg8::Epi<EpCmpHid> E{{((bf16_t*)(p.ws + OFF_HIDV)), ((float*)(p.ws + OFF_BIAS1)) + 256}};
            pg8::gemm_phase(lds3, g, S, E);
        }
        __syncthreads();
        for (int vb = bid; vb < 1024; vb += G) d_ssd_states(((bf16_t*)(p.ws + OFF_PROJ)), ((float*)(p.ws + OFF_SMALL)), p.conv_w, p.conv_b, p.a_log, ((float*)(p.ws + OFF_ONSA)), ((float*)(p.ws + OFF_CTR + 4096)), vb, lds);
    }
    xcd_barrier(xbar);
    for (int vb = bid; vb < 2048 + 128; vb += G) {
        if (vb < 1024) d_cmp_out(((bf16_t*)(p.ws + OFF_HIDK)), p.cmp_w2_k, ((bf16_t*)(p.ws + OFF_KC)), vb); else if (vb < 2048) d_cmp_out(((bf16_t*)(p.ws + OFF_HIDV)), p.cmp_w2_v, ((bf16_t*)(p.ws + OFF_VC)), vb - 1024);
        else d_ssd_scan(((float*)(p.ws + OFF_ONSA)), ((float*)(p.ws + OFF_CTR + 4096)), ((bf16_t*)(p.ws + OFF_EIDX)), vb - 2048);
    }
    xcd_barrier(xbar);
    for (;;) {
        if (threadIdx.x == 0) *s_vb = (int)atomicAdd(&((unsigned*)(p.ws + OFF_CTR))[0], 1u);
        __syncthreads();
        const int i = *s_vb;
        __syncthreads();
        if (i >= 2048) break;
        const int qt = 127 - (i >> 4), bg = i & 15;
        d_nsa_cmp(((bf16_t*)(p.ws + OFF_PROJ)), ((bf16_t*)(p.ws + OFF_KC)), ((bf16_t*)(p.ws + OFF_VC)), ((float*)(p.ws + OFF_SMALL)), ((float*)(p.ws + OFF_ONSA)), ((unsigned*)(p.ws + OFF_HIDK)) + (size_t)(bg * 128 + qt) * 512, bg >> 1, bg & 1, qt, lds);
    }
    for (;;) {
        if (threadIdx.x == 0) *s_vb = (int)atomicAdd(&((unsigned*)(p.ws + OFF_CTR))[64], 1u);
        __syncthreads();
        const int i = *s_vb;
        __syncthreads();
        if (i >= 1024) break;
        d_ssd_out(((bf16_t*)(p.ws + OFF_PROJ)), ((float*)(p.ws + OFF_SMALL)), p.conv_w, p.conv_b, p.a_log, p.d_skip, ((bf16_t*)(p.ws + OFF_EIDX)), ((bf16_t*)(p.ws + OFF_YSSD)), i, lds);
    }
    xcd_barrier(xbar);
    for (;;) {
        if (threadIdx.x == 0) *s_vb = (int)atomicAdd(&((unsigned*)(p.ws + OFF_CTR))[128], 1u);
        __syncthreads();
        const int i = *s_vb;
        __syncthreads();
        if (i >= 2048) break;
        const int qt = 127 - (i >> 4), bg = i & 15;
        d_nsa_attn(((bf16_t*)(p.ws + OFF_QROPE)), ((bf16_t*)(p.ws + OFF_KVP)), ((float*)(p.ws + OFF_SMALL)), ((float*)(p.ws + OFF_ONSA)), ((unsigned*)(p.ws + OFF_HIDK)) + (size_t)(bg * 128 + qt) * 512, bg >> 1, bg & 1, qt, lds);
    }
    xcd_barrier(xbar);
    for (int vb = bid; vb < NTOK / 32; vb += G) d_mix_prep(((float*)(p.ws + OFF_ONSA)), ((bf16_t*)(p.ws + OFF_YSSD)), p.nsa_norm_w, p.ssd_norm_w, ((bf16_t*)(p.ws + OFF_H)), vb);
    xcd_barrier(xbar);
    {
        const pg8::Gemm g{((bf16_t*)(p.ws + OFF_H)), ((bf16_t*)(p.ws + OFF_WOUT_T)), NTOK, 1024, 1024, 1024};
        pg8::StaticOrder S; S.init(NTOK, 1024, G, bid);
        const pg8::Epi<EpOutProj> E{{p.x, ((float*)(p.ws + OFF_MOD)), p.out}};
        pg8::gemm_phase(lds3, g, S, E);
    }
    xcd_barrier(xbar);
    for (int vb = bid; vb < NTOK / 32; vb += G) d_norm_mod(p.out, p.norm2_w, ((float*)(p.ws + OFF_MOD)), 3072, 4096, ((bf16_t*)(p.ws + OFF_H)), vb);
    xcd_barrier(xbar);
    {
        const pg8::Gemm g{((bf16_t*)(p.ws + OFF_H)), ((bf16_t*)(p.ws + OFF_WQ_T)), NTOK, 2048, 1024, 1024};
        pg8::StaticOrder S; S.init(NTOK, 2048, G, bid);
        const pg8::Epi<EpStoreBf16> E{{((bf16_t*)(p.ws + OFF_PROJ)), 2048, 0}};
        pg8::gemm_phase(lds3, g, S, E);
    }
    xcd_barrier(xbar);
    for (int vb = bid; vb < 4096; vb += G) d_peer_route(((bf16_t*)(p.ws + OFF_PROJ)), p.peer_qnorm_w, ((bf16_t*)(p.ws + OFF_SUBK)), ((int*)(p.ws + OFF_EIDX)), ((float*)(p.ws + OFF_GATE)), vb >> 3, vb & 7, lds);
    xcd_barrier(xbar);
    for (int vb = bid; vb < NTOK / 8; vb += G) d_peer_expert8(((bf16_t*)(p.ws + OFF_H)), ((unsigned char*)(p.ws + OFF_DOWN)), ((unsigned char*)(p.ws + OFF_DOWN + MIB(16))), ((float*)(p.ws + OFF_UP)), ((float*)(p.ws + OFF_UP + 65536)), ((int*)(p.ws + OFF_EIDX)), ((float*)(p.ws + OFF_GATE)), ((float*)(p.ws + OFF_MOD)), p.final_norm_w, p.out, vb);
}

extern "C" void kernel_launch(void* const* d_in, const int* in_sizes, int n_in, void* d_out, int out_size, void* d_ws, size_t ws_size, hipStream_t stream) {
    if (ws_size < WS_NEED) { fprintf(stderr, "workspace too small\n"); return; }
    static int grid_blocks = 0;
    if (!grid_blocks) {
        int dev = 0, cus = 0, per_cu = 0;
        (void)hipGetDevice(&dev);
        (void)hipDeviceGetAttribute(&cus, hipDeviceAttributeMultiprocessorCount, dev);
        (void)hipOccupancyMaxActiveBlocksPerMultiprocessor(&per_cu, mega, 512, 0);
        if (per_cu < 1) fprintf(stderr, "occupancy query reports %d blocks per CU\n", per_cu);
        grid_blocks = cus;
    }
    Params p{};
    const float** pp = (const float**)&p;
    for (int i = 0; i < 27; ++i) pp[i] = (const float*)d_in[i];
    p.out = (float*)d_out; p.ws = (char*)d_ws;
    (void)hipMemsetAsync((char*)d_ws + OFF_BAR, 0, XCD_BAR_WORDS * 4, stream);
    void* args[] = {&p};
    hipError_t e = hipLaunchCooperativeKernel((void*)mega, dim3(grid_blocks), dim3(512), args, 0, stream);
    if (e != hipSuccess) fprintf(stderr, "cooperative launch failed: %s (grid %d)\n", hipGetErrorString(e), grid_blocks);
}
```

```cpp
#include <hip/hip_runtime.h>
#include <hip/hip_cooperative_groups.h>
#include <stdint.h>
#include <cstdio>
namespace cg = cooperative_groups;

typedef unsigned short bf16_t;
typedef short bf16x8 __attribute__((ext_vector_type(8)));
typedef float f32x4 __attribute__((ext_vector_type(4)));
typedef float f32x2 __attribute__((ext_vector_type(2)));
typedef unsigned u32x4 __attribute__((ext_vector_type(4)));
typedef unsigned u32x2 __attribute__((ext_vector_type(2)));

#define NB 8
#define SEQ 8192
#define NTOK 65536
#define DM 1024
#define PROJ_LD 2816
#define NIN_PAD 3072
#define C_Q 0
#define C_KCMP 512
#define C_KSEL 768
#define C_VSEL 896
#define C_KWIN 1024
#define C_VWIN 1152
#define C_Z 1280
#define C_XBC 1792
#define NCMP 511
#define EPS 1e-6f
#define KVP_SEG ((size_t)NB * 2 * SEQ * 64)

#define MIB(x) ((size_t)(x) << 20)
#define OFF_MOD    MIB(0)
#define OFF_ROPE   MIB(1)
#define OFF_BIAS1  MIB(2)
#define OFF_WIN_T  MIB(3)
#define OFF_WOUT_T MIB(9)
#define OFF_WQ_T   MIB(11)
#define OFF_SUBK   MIB(15)
#define OFF_W1K_T  MIB(16)
#define OFF_W1V_T  MIB(17)
#define OFF_KC     MIB(18)
#define OFF_VC     MIB(19)
#define OFF_HIDK   MIB(20)
#define OFF_HIDV   MIB(24)
#define OFF_DOWN   MIB(28)
#define OFF_UP     MIB(60)
#define OFF_SMALL  MIB(92)
#define OFF_H      MIB(100)
#define OFF_PROJ   MIB(228)
#define OFF_QROPE  MIB(580)
#define OFF_ONSA   MIB(644)
#define OFF_YSSD   MIB(772)
#define OFF_KVP    MIB(836)
#define OFF_EIDX   MIB(932)
#define OFF_GATE   MIB(964)
#define OFF_CTR    MIB(996)
#define OFF_BAR    (MIB(996) + 65536)
#define WS_NEED    MIB(997)

typedef __bf16 hwbf2 __attribute__((ext_vector_type(2)));
__device__ __forceinline__ bf16_t f2bf(float f) { const __bf16 h = (__bf16)f; return __builtin_bit_cast(bf16_t, h); }
__device__ __forceinline__ float bf2f(bf16_t h) { return __uint_as_float(((unsigned)h) << 16); }
__device__ __forceinline__ float bflo(unsigned u) { return __uint_as_float(u << 16); }
__device__ __forceinline__ float bfhi(unsigned u) { return __uint_as_float(u & 0xffff0000u); }
__device__ __forceinline__ unsigned pack2(float a, float b) { const f32x2 v = {a, b}; const hwbf2 r = __builtin_convertvector(v, hwbf2); return __builtin_bit_cast(unsigned, r); }
__device__ __forceinline__ float wave_sum(float v) {
#pragma unroll
    for (int o = 32; o; o >>= 1) v += __shfl_xor(v, o);
    return v;
}
__device__ __forceinline__ float wave_max(float v) {
#pragma unroll
    for (int o = 32; o; o >>= 1) v = fmaxf(v, __shfl_xor(v, o));
    return v;
}
__device__ __forceinline__ int tid_opaque() { int t = threadIdx.x; asm volatile("" : "+v"(t)); return t; }
__device__ __forceinline__ float gelu_tanh(float x) { return 0.5f * x * (1.0f + tanhf(0.7978845608028654f * (x + 0.044715f * x * x * x))); }
__device__ __forceinline__ float silu(float x) { return x / (1.0f + __expf(-x)); }
__device__ __forceinline__ float sigmoidf(float x) { return 1.0f / (1.0f + __expf(-x)); }
__device__ __forceinline__ float softplusf(float x) { return x > 20.f ? x : log1pf(__expf(x)); }

__device__ __forceinline__ int inproj_src(int n) {
    if (n < 1280) return n;
    if (n < 1792) return 1304 + (n - 1280);
    if (n < 2816) return 1816 + (n - 1792);
    if (n < 2840) return 1280 + (n - 2816);
    if (n < 2848) return 2840 + (n - 2840);
    return -1;
}
__device__ __forceinline__ void d_transpose_w(const float* __restrict__ W, bf16_t* __restrict__ Wt, int K, int N, int mode, int nbx, int vb, char* lds) {
    const int tid_ = tid_opaque(); const int half = tid_ >> 8, t256 = tid_ & 255, tile = vb * 2 + half;
    float (*t)[33] = (float (*)[33])(lds + half * 4352);
    const int n0 = (tile % nbx) * 32, k0 = (tile / nbx) * 32, tx = t256 & 31, ty = t256 >> 5;
#pragma unroll
    for (int i = 0; i < 4; ++i) {
        const int k = k0 + ty + 8 * i, n = n0 + tx;
        const int src = mode == 1 ? inproj_src(n) : n;
        t[ty + 8 * i][tx] = (src >= 0 && src < N) ? W[(size_t)k * N + src] : 0.f;
    }
    __syncthreads();
#pragma unroll
    for (int i = 0; i < 4; ++i) Wt[(size_t)(n0 + ty + 8 * i) * K + k0 + tx] = f2bf(t[tx][ty + 8 * i]);
    __syncthreads();
}
__device__ __forceinline__ void d_convert_bf16(const float* __restrict__ in, bf16_t* __restrict__ out, size_t n8, int vb, int nvb) {
    size_t i = (size_t)vb * 512 + tid_opaque();
    const size_t stride = (size_t)nvb * 512;
    for (; i < n8; i += stride) {
        const f32x4 a = ((const f32x4*)in)[2 * i], b = ((const f32x4*)in)[2 * i + 1];
        u32x4 o; o.x = pack2(a.x, a.y); o.y = pack2(a.z, a.w); o.z = pack2(b.x, b.y); o.w = pack2(b.z, b.w);
        ((u32x4*)out)[i] = o;
    }
}
__device__ __forceinline__ void d_mod(const float* __restrict__ c, const float* __restrict__ w_ada, const float* __restrict__ b_ada, float* __restrict__ mod, int vb, char* lds) {
    float (*part)[8][64] = (float (*)[8][64])lds;
    const int tid = tid_opaque(), jl = tid & 63, kq = tid >> 6, j = vb * 64 + jl;
    float acc[8];
#pragma unroll
    for (int b = 0; b < 8; ++b) acc[b] = 0.f;
    for (int k0 = kq * 128; k0 < kq * 128 + 128; k0 += 16) {
        float wv[16];
#pragma unroll
        for (int i = 0; i < 16; ++i) wv[i] = w_ada[(size_t)(k0 + i) * 6144 + j];
#pragma unroll
        for (int i = 0; i < 16; ++i)
#pragma unroll
            for (int b = 0; b < 8; ++b) acc[b] += c[b * 1024 + k0 + i] * wv[i];
    }
#pragma unroll
    for (int b = 0; b < 8; ++b) part[kq][b][jl] = acc[b];
    __syncthreads();
    {
        const int b = tid >> 6, jj = tid & 63;
        float s = b_ada[vb * 64 + jj];
#pragma unroll
        for (int q = 0; q < 8; ++q) s += part[q][b][jj];
        mod[b * 6144 + vb * 64 + jj] = s;
    }
    __syncthreads();
}
__device__ __forceinline__ void d_rope_table(float2* __restrict__ rope, int vb) {
    const int i = vb * 512 + tid_opaque();
    if (i >= SEQ * 8) return;
    const int pos = i >> 3, f = i & 7;
    const double inv = pow(500000.0, -(double)f / 8.0);
    const double ang = (double)pos * inv;
    rope[i] = make_float2((float)cos(ang), (float)sin(ang));
}
__device__ __forceinline__ void d_bias1(const float* __restrict__ pe_k, const float* __restrict__ w1_k, const float* __restrict__ pe_v, const float* __restrict__ w1_v, float* __restrict__ bias1) {
    const int tid_ = tid_opaque(); const int which = tid_ >> 8, j = tid_ & 255;
    const float* pe = which ? pe_v : pe_k; const float* w1 = which ? w1_v : w1_k;
    float a = 0.f;
    for (int k0 = 0; k0 < 2048; k0 += 16) {
        float wv[16];
#pragma unroll
        for (int i = 0; i < 16; ++i) wv[i] = w1[(size_t)(k0 + i) * 256 + j];
#pragma unroll
        for (int i = 0; i < 16; ++i) a += pe[k0 + i] * wv[i];
    }
    bias1[which * 256 + j] = a;
}

__device__ __forceinline__ void d_norm_mod(const float* __restrict__ x, const float* __restrict__ w, const float* __restrict__ mod, int sh_off, int sc_off, bf16_t* __restrict__ out, int vb) {
    const int tid_ = tid_opaque(); const int lane = tid_ & 63, wid = tid_ >> 6;
    const size_t row0 = (size_t)vb * 32 + wid * 4; const int b = (int)(row0 >> 13);
    f32x4 v[4][4];
#pragma unroll
    for (int r = 0; r < 4; ++r)
#pragma unroll
        for (int k = 0; k < 4; ++k) v[r][k] = *(const f32x4*)(x + (row0 + r) * DM + k * 256 + lane * 4);
    float rs[4];
#pragma unroll
    for (int r = 0; r < 4; ++r) {
        float ss = 0.f;
#pragma unroll
        for (int k = 0; k < 4; ++k) ss += v[r][k].x * v[r][k].x + v[r][k].y * v[r][k].y + v[r][k].z * v[r][k].z + v[r][k].w * v[r][k].w;
        rs[r] = rsqrtf(wave_sum(ss) * (1.0f / DM) + EPS);
    }
#pragma unroll
    for (int k = 0; k < 4; ++k) {
        const int col = k * 256 + lane * 4;
        const f32x4 wv = *(const f32x4*)(w + col), sc = *(const f32x4*)(mod + b * 6144 + sc_off + col), sh = *(const f32x4*)(mod + b * 6144 + sh_off + col);
        const f32x4 ws = wv * (sc + 1.0f);
#pragma unroll
        for (int r = 0; r < 4; ++r) {
            const f32x4 y = v[r][k] * rs[r] * ws + sh;
            u32x2 o; o.x = pack2(y.x, y.y); o.y = pack2(y.z, y.w);
            *(u32x2*)(out + (row0 + r) * DM + col) = o;
        }
    }
}

namespace pg8 {
#define PG8_LAS __attribute__((address_space(3)))
constexpr int BM = 256, BK = 64, HALF = 128, HTB = HALF * BK * 2  , STAGE_BYTES = 8 * HTB, NXCD = 8, WGM = 8;
__host__ __device__ __forceinline__ int lds_byte(int r, int c) { const int st = (r >> 4) * 2 + (c >> 5), rr = r & 15, cc = c & 31, ob = rr * 64 + cc * 2; return st * 1024 + (ob ^ (((ob >> 9) & 1) << 5)); }
__host__ __device__ __forceinline__ void stage_rc(int b, int& R, int& C) { const int st = b / 1024, sb = b % 1024, swz = sb ^ (((sb >> 9) & 1) << 5); R = (st >> 1) * 16 + swz / 64; C = (st & 1) * 32 + (swz % 64) / 2; }
struct Unit { int pm, pn; };
struct Gemm { const bf16_t* A; const bf16_t* Bt; int M, N, K, lda; };
struct StaticOrder {
    int nM, nN, nwg, G, c;
    __host__ __device__ void init(int M, int N, int G_, int c_) { nM = M / BM; nN = N / BM; nwg = nM * nN; G = G_; c = c_; }
    __host__ __device__ bool next(int i, Unit& u) const {
        const long L = (long)i * G + c; if (L >= nwg) return false;
        int wgid = (int)L; { const int q = nwg / NXCD, r = nwg % NXCD, xcd = wgid % NXCD, off = wgid / NXCD; wgid = (xcd < r ? xcd * (q + 1) : r * (q + 1) + (xcd - r) * q) + off; }
        const int nig = WGM * nN, gid = wgid / nig, fm = gid * WGM, gsz = (nM - fm) < WGM ? (nM - fm) : WGM;
        u.pm = fm + ((wgid % nig) % gsz); u.pn = (wgid % nig) / gsz; return true;
    }
};
template <class F> struct Epi {
    F f;
    __device__ __forceinline__ void operator()(const f32x4 (&acc)[2][2][4][2], const Unit& u, int wr, int wc, int fr, int fq) const {
#pragma unroll
        for (int ai = 0; ai < 2; ++ai)
#pragma unroll
            for (int m = 0; m < 4; ++m)
#pragma unroll
                for (int bj = 0; bj < 2; ++bj)
#pragma unroll
                    for (int n = 0; n < 2; ++n)
                        f(u.pm * BM + ai * HALF + wr * 64 + m * 16 + fr, u.pn * BM + bj * HALF + wc * 32 + n * 16 + 4 * fq, acc[ai][bj][m][n]);
    }
};
template <class E, class Sched>
__device__ __forceinline__ void gemm_phase(PG8_LAS unsigned char* lds, const Gemm g, const Sched& S, const E& Ep) {
    const int tid = tid_opaque(), wid = __builtin_amdgcn_readfirstlane(tid >> 6), lane = tid & 63, wr = wid >> 2, wc = wid & 3, fr = lane & 15, fq = lane >> 4;
    const int K = g.K, nt = K / BK;
    unsigned voffA[2], voffB[2];
#pragma unroll
    for (int i = 0; i < 2; ++i) { int R, C; stage_rc(tid * 16 + i * 8192, R, C); voffA[i] = (unsigned)(R * g.lda + C) * 2u; voffB[i] = (unsigned)(R * K + C) * 2u; }
    const size_t kstep = (size_t)(BK * 2);
    const size_t hstep = (size_t)HALF * K * 2, hstepA = (size_t)HALF * g.lda * 2;
    const size_t tstep = 2 * hstep, tstepA = 2 * hstepA;
    const unsigned ldsw = (unsigned)wid * 1024u;
    const int aoff = lds_byte(wr * 64 + fr, fq * 8), boff = lds_byte(wc * 32 + fr, fq * 8);
#define PG8_SA(b, h) (((b) * 2 + (h)) * HTB)
#define PG8_SB(b, h) ((4 + (b) * 2 + (h)) * HTB)
#define PG8_STAGE(bufoff, gbase, voff) do { _Pragma("unroll") for (int _i = 0; _i < 2; ++_i) \
        __builtin_amdgcn_global_load_lds((const unsigned*)((const char*)(gbase) + (voff)[_i]), (PG8_LAS unsigned*)(lds + (bufoff) + ldsw + _i * 8192), 16, 0, 0); } while (0)
#define PG8_LDA(dst, b, h) do { _Pragma("unroll") for (int m = 0; m < 4; ++m) _Pragma("unroll") for (int k = 0; k < 2; ++k) dst[m][k] = *(const PG8_LAS bf16x8*)(lds + PG8_SA(b, h) + aoff + m * 2048 + k * 1024); } while (0)
#define PG8_LDB(dst, b, h) do { _Pragma("unroll") for (int n = 0; n < 2; ++n) _Pragma("unroll") for (int k = 0; k < 2; ++k) dst[n][k] = *(const PG8_LAS bf16x8*)(lds + PG8_SB(b, h) + boff + n * 2048 + k * 1024); } while (0)
#define PG8_MMA(ai, bj, At, Bt) do { __builtin_amdgcn_s_setprio(1); _Pragma("unroll") for (int m = 0; m < 4; ++m) _Pragma("unroll") for (int n = 0; n < 2; ++n) _Pragma("unroll") for (int k = 0; k < 2; ++k) \
        acc[ai][bj][m][n] = __builtin_amdgcn_mfma_f32_16x16x32_bf16(Bt[n][k], At[m][k], acc[ai][bj][m][n], 0, 0, 0); __builtin_amdgcn_s_setprio(0); } while (0)
#define PG8_WAIT_V(n) asm volatile("s_waitcnt vmcnt(" #n ")" ::: "memory")
#define PG8_WAIT_L(n) asm volatile("s_waitcnt lgkmcnt(" #n ")" ::: "memory")
#define PG8_BAR __builtin_amdgcn_s_barrier()
#define PG8_SCHED __builtin_amdgcn_sched_barrier(0)
    Unit cur, nxt; int ui = 0;
    if (!S.next(0, cur)) return;
    f32x4 acc[2][2][4][2];
#pragma unroll
    for (int a = 0; a < 2; ++a)
#pragma unroll
        for (int b = 0; b < 2; ++b)
#pragma unroll
            for (int m = 0; m < 4; ++m)
#pragma unroll
                for (int n = 0; n < 2; ++n) acc[a][b][m][n] = (f32x4){0.f, 0.f, 0.f, 0.f};
    bf16x8 At[4][2], B0[2][2], B1[2][2];
    const char* cA = (const char*)g.A + (size_t)cur.pm * tstepA; const char* cB = (const char*)g.Bt + (size_t)cur.pn * tstep;
    PG8_STAGE(PG8_SB(0, 0), cB, voffB); PG8_STAGE(PG8_SB(0, 1), cB + hstep, voffB); PG8_STAGE(PG8_SA(0, 0), cA, voffA); PG8_STAGE(PG8_SA(0, 1), cA + hstepA, voffA);
    if (wr == 1) PG8_BAR;
    PG8_WAIT_V(2); PG8_BAR;
    PG8_STAGE(PG8_SB(1, 0), cB + kstep, voffB); PG8_STAGE(PG8_SA(1, 0), cA + kstep, voffA); PG8_STAGE(PG8_SB(1, 1), cB + hstep + kstep, voffB);
    PG8_WAIT_V(6); PG8_BAR;
    for (;;) {
        const bool has_next = S.next(ui + 1, nxt);
        const char* nA = has_next ? (const char*)g.A + (size_t)nxt.pm * tstepA : cA; const char* nB = has_next ? (const char*)g.Bt + (size_t)nxt.pn * tstep : cB;
        for (int t = 0; t < nt; t += 2) {
            const bool last = (t == nt - 2);
            const char* a1 = cA + (size_t)(t + 1) * kstep;
            const char* a2 = last ? nA : cA + (size_t)(t + 2) * kstep; const char* b2 = last ? nB : cB + (size_t)(t + 2) * kstep;
            const char* a3 = a2 + kstep; const char* b3 = b2 + kstep;
            PG8_LDB(B0, 0, 0); PG8_LDB(B1, 0, 1); PG8_SCHED; PG8_LDA(At, 0, 0); PG8_STAGE(PG8_SA(1, 1), a1 + hstepA, voffA);
            PG8_WAIT_V(8); PG8_WAIT_L(0); PG8_BAR; PG8_MMA(0, 0, At, B0); PG8_MMA(0, 1, At, B1); PG8_BAR; PG8_SCHED;
            PG8_LDA(At, 0, 1); PG8_STAGE(PG8_SB(0, 0), b2, voffB); PG8_STAGE(PG8_SB(0, 1), b2 + hstep, voffB); PG8_STAGE(PG8_SA(0, 0), a2, voffA);
            PG8_WAIT_V(8); PG8_WAIT_L(0); PG8_BAR; PG8_MMA(1, 0, At, B0); PG8_MMA(1, 1, At, B1); PG8_BAR; PG8_SCHED;
            PG8_LDB(B0, 1, 0); PG8_LDB(B1, 1, 1); PG8_SCHED; PG8_LDA(At, 1, 0); PG8_STAGE(PG8_SA(0, 1), a2 + hstepA, voffA);
            PG8_WAIT_V(8); PG8_WAIT_L(0); PG8_BAR; PG8_MMA(0, 0, At, B0); PG8_MMA(0, 1, At, B1); PG8_BAR; PG8_SCHED;
            PG8_LDA(At, 1, 1); PG8_STAGE(PG8_SB(1, 0), b3, voffB); PG8_STAGE(PG8_SB(1, 1), b3 + hstep, voffB); PG8_STAGE(PG8_SA(1, 0), a3, voffA);
            PG8_WAIT_V(8); PG8_WAIT_L(0); PG8_BAR; PG8_MMA(1, 0, At, B0); PG8_MMA(1, 1, At, B1); PG8_BAR; PG8_SCHED;
        }
        if (wr == 0) PG8_BAR;
        Ep(acc, cur, wr, wc, fr, fq);
        if (!has_next) break;
#pragma unroll
        for (int a = 0; a < 2; ++a)
#pragma unroll
            for (int b = 0; b < 2; ++b)
#pragma unroll
                for (int m = 0; m < 4; ++m)
#pragma unroll
                    for (int n = 0; n < 2; ++n) acc[a][b][m][n] = (f32x4){0.f, 0.f, 0.f, 0.f};
        cur = nxt; cA = nA; cB = nB; ++ui;
        if (wr == 1) PG8_BAR;
    }
    PG8_WAIT_V(0);
    PG8_BAR;
#undef PG8_SA
#undef PG8_SB
#undef PG8_STAGE
#undef PG8_LDA
#undef PG8_LDB
#undef PG8_MMA
#undef PG8_WAIT_V
#undef PG8_WAIT_L
#undef PG8_BAR
#undef PG8_SCHED
}
}

struct EpInProj { bf16_t* proj; bf16_t* qrope; bf16_t* kvp; float* small; const float2* rope; const float* dt_bias;
    __device__ __forceinline__ void operator()(int m, int n0, f32x4 v) const {
        if (n0 < 2816) {
            const bool is_q = n0 < 512;
            const bool roped_seg = is_q || (n0 >= C_KSEL && n0 < C_VSEL) || (n0 >= C_KWIN && n0 < C_VWIN);
            const bool rope_dims = roped_seg && ((n0 & 63) < 16);
            u32x2 raw; raw.x = pack2(v.x, v.y); raw.y = pack2(v.z, v.w);
            if (is_q) *(u32x2*)(proj + (size_t)m * PROJ_LD + n0) = raw;
            if (rope_dims) {
                f32x4 p; p.x = __shfl_xor(v.x, 32); p.y = __shfl_xor(v.y, 32); p.z = __shfl_xor(v.z, 32); p.w = __shfl_xor(v.w, 32);
                const int i0 = n0 & 15, pos = m & (SEQ - 1);
                const float sgn = i0 < 8 ? -1.f : 1.f;
                const float2* rp = rope + pos * 8 + (i0 & 7);
                const float2 c0 = rp[0], c1 = rp[1], c2 = rp[2], c3 = rp[3];
                v.x = v.x * c0.x + sgn * p.x * c0.y; v.y = v.y * c1.x + sgn * p.y * c1.y;
                v.z = v.z * c2.x + sgn * p.z * c2.y; v.w = v.w * c3.x + sgn * p.w * c3.y;
            }
            u32x2 o; o.x = pack2(v.x, v.y); o.y = pack2(v.z, v.w);
            if (is_q) *(u32x2*)(qrope + (size_t)m * 512 + n0) = o;
            else if (n0 < C_Z) {
                const int r = n0 - C_KCMP, seg = r >> 7, g = (r >> 6) & 1, d = r & 63, bb = m >> 13, t = m & (SEQ - 1);
                *(u32x2*)(kvp + (size_t)seg * KVP_SEG + ((size_t)(bb * 2 + g) * SEQ + t) * 64 + d) = o;
            }
            else *(u32x2*)(proj + (size_t)m * PROJ_LD + n0) = o;
        } else if (n0 < 2848) {
            const int c = n0 - 2816; f32x4 o;
            if (c < 24) { o.x = sigmoidf(v.x); o.y = sigmoidf(v.y); o.z = sigmoidf(v.z); o.w = sigmoidf(v.w); }
            else { const float* db = dt_bias + (c - 24); o.x = softplusf(v.x + db[0]); o.y = softplusf(v.y + db[1]); o.z = softplusf(v.z + db[2]); o.w = softplusf(v.w + db[3]); }
            *(f32x4*)(small + (size_t)m * 32 + c) = o;
        }
    } };
struct EpCmpHid { bf16_t* hid; const float* bias;
    __device__ __forceinline__ void operator()(int m, int n0, f32x4 v) const {
        const f32x4 b = *(const f32x4*)(bias + n0);
        u32x2 o; o.x = pack2(gelu_tanh(v.x + b.x), gelu_tanh(v.y + b.y)); o.y = pack2(gelu_tanh(v.z + b.z), gelu_tanh(v.w + b.w));
        *(u32x2*)(hid + (size_t)m * 256 + n0) = o;
    } };
struct EpOutProj { const float* x; const float* mod; float* x1;
    __device__ __forceinline__ void operator()(int m, int n0, f32x4 v) const {
        const int b = m >> 13;
        const f32x4 xv = *(const f32x4*)(x + (size_t)m * DM + n0);
        const f32x4 g = *(const f32x4*)(mod + b * 6144 + 2048 + n0);
        f32x4 o; o.x = xv.x + g.x * v.x; o.y = xv.y + g.y * v.y; o.z = xv.z + g.z * v.z; o.w = xv.w + g.w * v.w;
        *(f32x4*)(x1 + (size_t)m * DM + n0) = o;
    } };
struct EpStoreBf16 { bf16_t* out; int ld; int pad;
    __device__ __forceinline__ void operator()(int m, int n0, f32x4 v) const {
        u32x2 o; o.x = pack2(v.x, v.y); o.y = pack2(v.z, v.w);
        *(u32x2*)(out + (size_t)m * ld + n0) = o;
    } };

__device__ __forceinline__ void d_cmp_out(const bf16_t* __restrict__ hid, const float* __restrict__ w2, bf16_t* __restrict__ out, int vb) {
    const int tid_ = tid_opaque(); const int m = vb * 8 + (tid_ >> 6), d = tid_ & 63;
    float a = 0.f;
#pragma unroll 8
    for (int j = 0; j < 256; ++j) a += bf2f(hid[(size_t)m * 256 + j]) * w2[j * 64 + d];
    out[(size_t)m * 64 + d] = f2bf(a);
}

#define KLD 72
#define NSA_OFF_KS0  0
#define NSA_OFF_VT0  9216
#define NSA_OFF_KS1  18432
#define NSA_OFF_VT1  27648
#define NSA_OFF_IMP  36864
#define NSA_OFF_SELW 70656
#define NSA_OFF_ANYW 71680
#define NSA_OFF_BL   71712
#define NSA_OFF_QS   72256
#define NSA_LDS      (72256 + 8 * 32 * KLD * 2)
#define SM_C 0.18033688011112042f

struct KVStage { u32x4 k, v; };
__device__ __forceinline__ void nsa_stage_load(KVStage& st, const bf16_t* kb, const bf16_t* vb, int tid) {
    st.k = *(const u32x4*)(kb + tid * 8); st.v = *(const u32x4*)(vb + tid * 8);
}
__device__ __forceinline__ void nsa_stage_store(bf16_t* Ks, bf16_t* Vt, int tid, const KVStage& st) {
    const int r = tid >> 3, c = tid & 7;
    *(u32x4*)(Ks + r * KLD + c * 8) = st.k;
    *(u32x4*)(Vt + r * KLD + c * 8) = st.v;
}
__device__ __forceinline__ void nsa_load_q(const bf16_t* qsrc, size_t ld, int lane, bf16_t* Qs) {
    u32x4 r[4];
#pragma unroll
    for (int i = 0; i < 4; ++i) { const int p = lane + 64 * i; r[i] = *(const u32x4*)(qsrc + (size_t)(p >> 3) * ld + (p & 7) * 8); }
#pragma unroll
    for (int i = 0; i < 4; ++i) { const int p = lane + 64 * i; *(u32x4*)(Qs + (p >> 3) * KLD + (p & 7) * 8) = r[i]; }
}
__device__ __forceinline__ void nsa_qk(const bf16_t* Ks, const bf16_t* Qs, f32x4 (&s)[4][2], int fr, int fq) {
#pragma unroll
    for (int kt = 0; kt < 4; ++kt)
#pragma unroll
        for (int tt = 0; tt < 2; ++tt) s[kt][tt] = (f32x4){0.f, 0.f, 0.f, 0.f};
#pragma unroll
    for (int ks = 0; ks < 2; ++ks) {
        bf16x8 qf[2];
#pragma unroll
        for (int tt = 0; tt < 2; ++tt) qf[tt] = *(const bf16x8*)(Qs + (tt * 16 + fr) * KLD + ks * 32 + fq * 8);
#pragma unroll
        for (int kt = 0; kt < 4; ++kt) {
            const bf16x8 kf = *(const bf16x8*)(Ks + (kt * 16 + fr) * KLD + ks * 32 + fq * 8);
#pragma unroll
            for (int tt = 0; tt < 2; ++tt) s[kt][tt] = __builtin_amdgcn_mfma_f32_16x16x32_bf16(kf, qf[tt], s[kt][tt], 0, 0, 0);
        }
    }
}
__device__ __forceinline__ void nsa_pv(const bf16_t* Vt, const f32x4 (&p)[4][2], f32x4 (&o)[4][2], int fr, int fq) {
#pragma unroll
    for (int ks2 = 0; ks2 < 2; ++ks2) {
        bf16x8 pf[2];
#pragma unroll
        for (int tt = 0; tt < 2; ++tt) {
            const f32x4 a = p[2 * ks2][tt], b = p[2 * ks2 + 1][tt];
            u32x4 w; w.x = pack2(a.x, a.y); w.y = pack2(a.z, a.w); w.z = pack2(b.x, b.y); w.w = pack2(b.z, b.w);
            pf[tt] = __builtin_bit_cast(bf16x8, w);
        }
#pragma unroll
        for (int dt = 0; dt < 4; ++dt) {
            typedef short s16x4 __attribute__((ext_vector_type(4)));
            const bf16_t* vp = Vt + (ks2 * 32 + 4 * fq + (fr >> 2)) * KLD + dt * 16 + 4 * (fr & 3);
            const s16x4 a0 = __builtin_amdgcn_ds_read_tr16_b64_v4i16((__attribute__((address_space(3))) s16x4*)vp);
            const s16x4 a1 = __builtin_amdgcn_ds_read_tr16_b64_v4i16((__attribute__((address_space(3))) s16x4*)(vp + 16 * KLD));
            const bf16x8 vf = (bf16x8){a0.x, a0.y, a0.z, a0.w, a1.x, a1.y, a1.z, a1.w};
#pragma unroll
            for (int tt = 0; tt < 2; ++tt) o[dt][tt] = __builtin_amdgcn_mfma_f32_16x16x32_bf16(vf, pf[tt], o[dt][tt], 0, 0, 0);
        }
    }
}
template <int MK>
__device__ __forceinline__ bool nsa_valid(int kk, int ti, int n0, int t0) {
    if (MK == 1) return kk <= ti;
    if (MK == 2) return kk > ti;
    return 16 * (n0 + kk) + 31 <= t0 + ti;
}
template <int MK, bool WITH_O>
__device__ __forceinline__ void nsa_softmax(f32x4 (&s)[4][2], float (&m)[2], float (&l)[2], f32x4 (&o)[4][2], const bool (&selb)[2], int tib, int fq, int n0, int t0) {
#pragma unroll
    for (int tt = 0; tt < 2; ++tt) {
        const int ti = tib + tt * 16;
        float mx = -1e30f;
#pragma unroll
        for (int kt = 0; kt < 4; ++kt)
#pragma unroll
            for (int jj = 0; jj < 4; ++jj) {
                const int kk = kt * 16 + 4 * fq + jj;
                const bool v = selb[tt] && nsa_valid<MK>(kk, ti, n0, t0);
                const float sv = v ? s[kt][tt][jj] * SM_C : -1e30f;
                s[kt][tt][jj] = sv; mx = fmaxf(mx, sv);
            }
        mx = fmaxf(mx, __shfl_xor(mx, 16)); mx = fmaxf(mx, __shfl_xor(mx, 32));
        const float mn = fmaxf(m[tt], mx);
        const float alpha = __builtin_amdgcn_exp2f(m[tt] - mn);
        m[tt] = mn;
        float ls = 0.f;
#pragma unroll
        for (int kt = 0; kt < 4; ++kt)
#pragma unroll
            for (int jj = 0; jj < 4; ++jj) {
                const float sv = s[kt][tt][jj];
                const float pv = sv > -1e29f ? __builtin_amdgcn_exp2f(sv - mn) : 0.f;
                s[kt][tt][jj] = pv; ls += pv;
            }
        l[tt] = l[tt] * alpha + ls;
        if (WITH_O) {
#pragma unroll
            for (int dt = 0; dt < 4; ++dt) o[dt][tt] *= alpha;
        }
    }
}
__device__ __forceinline__ void nsa_softmax_fast(f32x4 (&s)[4][2], float (&m)[2], float (&l)[2], f32x4 (&o)[4][2], const float (&bias)[2]) {
#pragma unroll
    for (int tt = 0; tt < 2; ++tt) {
        float mr = fmaxf(fmaxf(s[0][tt][0], s[0][tt][1]), fmaxf(s[0][tt][2], s[0][tt][3]));
#pragma unroll
        for (int kt = 1; kt < 4; ++kt) mr = fmaxf(mr, fmaxf(fmaxf(s[kt][tt][0], s[kt][tt][1]), fmaxf(s[kt][tt][2], s[kt][tt][3])));
        mr = fmaxf(mr, __shfl_xor(mr, 16)); mr = fmaxf(mr, __shfl_xor(mr, 32));
        const float mx = mr * SM_C + bias[tt];
        const float mold = m[tt], mn = fmaxf(mold, mx);
        m[tt] = mn;
        const float off = bias[tt] - mn;
        float ls = 0.f;
#pragma unroll
        for (int kt = 0; kt < 4; ++kt)
#pragma unroll
            for (int jj = 0; jj < 4; ++jj) { const float pv = __builtin_amdgcn_exp2f(__builtin_fmaf(s[kt][tt][jj], SM_C, off)); s[kt][tt][jj] = pv; ls += pv; }
        if (__builtin_amdgcn_ballot_w64(mn > mold) != 0ull) {
            const float alpha = __builtin_amdgcn_exp2f(mold - mn);
            l[tt] = l[tt] * alpha + ls;
#pragma unroll
            for (int dt = 0; dt < 4; ++dt) o[dt][tt] *= alpha;
        } else l[tt] += ls;
    }
}
__device__ __forceinline__ void ins16(unsigned (&L)[16], unsigned x) {
#pragma unroll
    for (int i = 0; i < 16; ++i) { const unsigned hi = L[i] > x ? L[i] : x; x = L[i] > x ? x : L[i]; L[i] = hi; }
}
__device__ __forceinline__ void merge16(unsigned (&L)[16], const unsigned (&P)[16]) {
#pragma unroll
    for (int i = 0; i < 16; ++i) L[i] = L[i] > P[15 - i] ? L[i] : P[15 - i];
#pragma unroll
    for (int st = 8; st >= 1; st >>= 1)
#pragma unroll
        for (int i = 0; i < 16; ++i)
            if ((i & st) == 0) { const unsigned a = L[i], b = L[i + st]; L[i] = a > b ? a : b; L[i + st] = a > b ? b : a; }
}
template <bool ACCUM>
__device__ __forceinline__ void nsa_emit(const f32x4 (&o)[4][2], const float (&l)[2], bool l_is_partial, const float* gsrc, float* obase, int tib, int fq) {
#pragma unroll
    for (int tt = 0; tt < 2; ++tt) {
        float lt = l[tt];
        if (l_is_partial) { lt += __shfl_xor(lt, 16); lt += __shfl_xor(lt, 32); }
        const int ti = tib + tt * 16;
        const float gv = gsrc[(size_t)ti * 32];
        const float sc = l_is_partial ? (lt > 0.f ? gv / lt : 0.f) : gv;
#pragma unroll
        for (int dt = 0; dt < 4; ++dt) {
            float* op = obase + (size_t)ti * 512 + dt * 16 + 4 * fq;
            f32x4 v = o[dt][tt] * sc;
            if (ACCUM) v += *(const f32x4*)op;
            *(f32x4*)op = v;
        }
    }
}
struct NsaBufs { bf16_t *Ks0, *Vt0, *Ks1, *Vt1; };
template <class SRC, class BODY>
__device__ __forceinline__ void nsa_pipeline(int n, const bf16_t* kb, const bf16_t* vb, const NsaBufs& B, int tid, SRC src, BODY body) {
    KVStage sa, sb;
    nsa_stage_load(sa, kb + (size_t)src(0) * 4096, vb + (size_t)src(0) * 4096, tid);
    sb = sa;
    if (n > 1) nsa_stage_load(sb, kb + (size_t)src(1) * 4096, vb + (size_t)src(1) * 4096, tid);
    __syncthreads();
    nsa_stage_store(B.Ks0, B.Vt0, tid, sa);
    sa = sb;
    if (n > 2) nsa_stage_load(sb, kb + (size_t)src(2) * 4096, vb + (size_t)src(2) * 4096, tid);
#pragma unroll 1
    for (int i = 0; i < n; ++i) {
        __syncthreads();
        bf16_t* Ks = (i & 1) ? B.Ks1 : B.Ks0; bf16_t* Vt = (i & 1) ? B.Vt1 : B.Vt0;
        if (i + 1 < n) nsa_stage_store((i & 1) ? B.Ks0 : B.Ks1, (i & 1) ? B.Vt0 : B.Vt1, tid, sa);
        sa = sb;
        if (i + 3 < n) nsa_stage_load(sb, kb + (size_t)src(i + 3) * 4096, vb + (size_t)src(i + 3) * 4096, tid);
        body(src(i), Ks, Vt);
    }
}

__device__ __forceinline__ void d_nsa_cmp(const bf16_t* __restrict__ proj, const bf16_t* __restrict__ kc, const bf16_t* __restrict__ vc,
                                          const float* __restrict__ small, float* __restrict__ onsa, unsigned* __restrict__ selrec, int b, int g, int qt, char* lds) {
    const NsaBufs B{(bf16_t*)(lds + NSA_OFF_KS0), (bf16_t*)(lds + NSA_OFF_VT0), (bf16_t*)(lds + NSA_OFF_KS1), (bf16_t*)(lds + NSA_OFF_VT1)};
    float* imp = (float*)(lds + NSA_OFF_IMP);
    unsigned* selw = (unsigned*)(lds + NSA_OFF_SELW);
    unsigned* anyw = (unsigned*)(lds + NSA_OFF_ANYW);
    int* blist = (int*)(lds + NSA_OFF_BL);
    const int tid = tid_opaque(), lane = tid & 63, w = tid >> 6, hd = w & 3, th = w >> 2, fr = lane & 15, fq = lane >> 4;
    const int tib = th * 32 + fr;
    const size_t tok0 = (size_t)b * SEQ + (size_t)qt * 64;
    const int t0 = qt * 64;
    const float* gbase = small + tok0 * 32 + g * 12 + hd * 3;
    float* obase = onsa + tok0 * 512 + g * 256 + hd * 64;
    const bool sel_all[2] = {true, true};
    const float bias0[2] = {0.f, 0.f};

    for (int i = tid; i < 64 * 132; i += 512) imp[i] = 0.f;
    if (tid < 4) anyw[tid] = 0u;

    bf16_t* Qs = (bf16_t*)(lds + NSA_OFF_QS) + w * 32 * KLD;
    f32x4 s[4][2], o[4][2];
    float m[2], l[2];

    nsa_load_q(proj + (tok0 + th * 32) * PROJ_LD + C_Q + g * 256 + hd * 64, PROJ_LD, lane, Qs);
    const int ncb = (4 * qt + 3 + 63) >> 6;
    {
        const bf16_t* kb = kc + (size_t)(b * 2 + g) * 512 * 64;
        const bf16_t* vb = vc + (size_t)(b * 2 + g) * 512 * 64;
#pragma unroll
        for (int tt = 0; tt < 2; ++tt) { m[tt] = -1e30f; l[tt] = 0.f; }
        nsa_pipeline(ncb, kb, vb, B, tid, [&](int i) { return i; }, [&](int blk_, bf16_t* Ks, bf16_t* Vt) {
            nsa_qk(Ks, Qs, s, fr, fq);
            nsa_softmax<3, false>(s, m, l, o, sel_all, tib, fq, blk_ * 64, t0);
        });
        float linv[2];
#pragma unroll
        for (int tt = 0; tt < 2; ++tt) { float lt = l[tt]; lt += __shfl_xor(lt, 16); lt += __shfl_xor(lt, 32); linv[tt] = lt > 0.f ? 1.0f / lt : 0.f; }
#pragma unroll
        for (int dt = 0; dt < 4; ++dt)
#pragma unroll
            for (int tt = 0; tt < 2; ++tt) o[dt][tt] = (f32x4){0.f, 0.f, 0.f, 0.f};
        nsa_pipeline(ncb, kb, vb, B, tid, [&](int i) { return i; }, [&](int blk_, bf16_t* Ks, bf16_t* Vt) {
            nsa_qk(Ks, Qs, s, fr, fq);
#pragma unroll
            for (int tt = 0; tt < 2; ++tt) {
                const int ti = tib + tt * 16;
#pragma unroll
                for (int kt = 0; kt < 4; ++kt) {
                    f32x4 pv;
#pragma unroll
                    for (int jj = 0; jj < 4; ++jj) {
                        const int kk = kt * 16 + 4 * fq + jj;
                        const bool v = nsa_valid<3>(kk, ti, blk_ * 64, t0);
                        pv[jj] = v ? __builtin_amdgcn_exp2f(s[kt][tt][jj] * SM_C - m[tt]) * linv[tt] : 0.f;
                    }
                    s[kt][tt] = pv;
                    const int j = blk_ * 16 + kt * 4 + fq;
                    atomicAdd(imp + ti * 132 + (j >> 5) * 33 + (j & 31), pv[0] + pv[1] + pv[2] + 0.5f * pv[3]);
                    if (j + 1 < 128) { const int j1 = j + 1; atomicAdd(imp + ti * 132 + (j1 >> 5) * 33 + (j1 & 31), 0.5f * pv[3]); }
                }
            }
            nsa_pv(Vt, s, o, fr, fq);
        });
        nsa_emit<false>(o, l, false, gbase + 0, obase, tib, fq);
    }
    __syncthreads();
    {
        const int ti = tid >> 3, q8 = tid & 7;
        unsigned L[16];
#pragma unroll
        for (int i = 0; i < 16; ++i) L[i] = 0u;
#pragma unroll
        for (int i = 0; i < 16; ++i) {
            const int j = q8 * 16 + i;
            const bool forced = (j == 0) || (j == qt) || (j == qt - 1);
            const float v = imp[ti * 132 + (j >> 5) * 33 + (j & 31)] + (forced ? 1e4f : 0.f) + 1e-30f;
            const unsigned x = (j <= qt) ? ((__float_as_uint(v) & ~0x7Fu) | (unsigned)(127 - j)) : 0u;
            ins16(L, x);
        }
#pragma unroll
        for (int r = 1; r <= 4; r <<= 1) {
            unsigned P[16];
#pragma unroll
            for (int i = 0; i < 16; ++i) P[i] = (unsigned)__shfl_xor((int)L[i], r);
            merge16(L, P);
        }
        if (q8 < 4) {
            unsigned word = 0u;
#pragma unroll
            for (int i = 0; i < 16; ++i) {
                const unsigned e = L[i];
                const int j = 127 - (int)(e & 0x7Fu);
                if (e != 0u && (j >> 5) == q8) word |= 1u << (j & 31);
            }
            selw[ti * 4 + q8] = word;
            atomicOr(&anyw[q8], word);
        }
    }
    __syncthreads();
    int nsel;
    {
        const unsigned a0 = anyw[0], a1 = anyw[1], a2 = anyw[2], a3 = anyw[3];
        if (tid < 128) {
            const unsigned wd = tid < 32 ? a0 : tid < 64 ? a1 : tid < 96 ? a2 : a3;
            if ((wd >> (tid & 31)) & 1u) {
                int pos = __popc(wd & ((1u << (tid & 31)) - 1u));
                if (tid >= 32) pos += __popc(a0);
                if (tid >= 64) pos += __popc(a1);
                if (tid >= 96) pos += __popc(a2);
                blist[pos] = tid;
            }
        }
        nsel = __builtin_amdgcn_readfirstlane(__popc(a0) + __popc(a1) + __popc(a2) + __popc(a3));
    }
    __syncthreads();
    if (tid < 256) selrec[tid] = selw[tid];
    if (tid < 128) selrec[256 + tid] = (unsigned)blist[tid];
    if (tid == 0) selrec[384] = (unsigned)nsel;
    __syncthreads();
}

__device__ __forceinline__ void d_nsa_attn(const bf16_t* __restrict__ qrope, const bf16_t* __restrict__ kvp, const float* __restrict__ small, float* __restrict__ onsa,
                                           const unsigned* __restrict__ selrec, int b, int g, int qt, char* lds) {
    const NsaBufs B{(bf16_t*)(lds + NSA_OFF_KS0), (bf16_t*)(lds + NSA_OFF_VT0), (bf16_t*)(lds + NSA_OFF_KS1), (bf16_t*)(lds + NSA_OFF_VT1)};
    unsigned* selw = (unsigned*)(lds + NSA_OFF_SELW);
    int* blist = (int*)(lds + NSA_OFF_BL);
    const int tid = tid_opaque(), lane = tid & 63, w = tid >> 6, hd = w & 3, th = w >> 2, fr = lane & 15, fq = lane >> 4;
    const int tib = th * 32 + fr;
    const size_t tok0 = (size_t)b * SEQ + (size_t)qt * 64;
    const float* gbase = small + tok0 * 32 + g * 12 + hd * 3;
    float* obase = onsa + tok0 * 512 + g * 256 + hd * 64;
    const bool sel_all[2] = {true, true};
    const float bias0[2] = {0.f, 0.f};
    bf16_t* Qs = (bf16_t*)(lds + NSA_OFF_QS) + w * 32 * KLD;
    f32x4 s[4][2], o[4][2];
    float m[2], l[2];
    if (tid < 256) selw[tid] = selrec[tid];
    if (tid < 128) blist[tid] = (int)selrec[256 + tid];
    const int nsel = __builtin_amdgcn_readfirstlane((int)selrec[384]);
    __syncthreads();
    nsa_load_q(qrope + (tok0 + th * 32) * 512 + g * 256 + hd * 64, 512, lane, Qs);
    {
        const bf16_t* kb = kvp + 2 * KVP_SEG + (size_t)(b * 2 + g) * SEQ * 64;
        const bf16_t* vb = kvp + 3 * KVP_SEG + (size_t)(b * 2 + g) * SEQ * 64;
#pragma unroll
        for (int tt = 0; tt < 2; ++tt) { m[tt] = -1e30f; l[tt] = 0.f; }
#pragma unroll
        for (int dt = 0; dt < 4; ++dt)
#pragma unroll
            for (int tt = 0; tt < 2; ++tt) o[dt][tt] = (f32x4){0.f, 0.f, 0.f, 0.f};
        nsa_pipeline(nsel, kb, vb, B, tid, [&](int i) { return __builtin_amdgcn_readfirstlane(blist[i]); }, [&](int blk_, bf16_t* Ks, bf16_t* Vt) {
            nsa_qk(Ks, Qs, s, fr, fq);
            bool selb[2];
#pragma unroll
            for (int tt = 0; tt < 2; ++tt) selb[tt] = (selw[(tib + tt * 16) * 4 + (blk_ >> 5)] >> (blk_ & 31)) & 1u;
            if (blk_ == qt) nsa_softmax<1, true>(s, m, l, o, selb, tib, fq, 0, 0);
            else {
                float bias[2];
#pragma unroll
                for (int tt = 0; tt < 2; ++tt) bias[tt] = selb[tt] ? 0.f : -1e30f;
                nsa_softmax_fast(s, m, l, o, bias);
            }
            nsa_pv(Vt, s, o, fr, fq);
        });
        nsa_emit<true>(o, l, true, gbase + 1, obase, tib, fq);
    }
    {
        const bf16_t* kb = kvp + 4 * KVP_SEG + (size_t)(b * 2 + g) * SEQ * 64;
        const bf16_t* vb = kvp + 5 * KVP_SEG + (size_t)(b * 2 + g) * SEQ * 64;
#pragma unroll
        for (int tt = 0; tt < 2; ++tt) { m[tt] = -1e30f; l[tt] = 0.f; }
#pragma unroll
        for (int dt = 0; dt < 4; ++dt)
#pragma unroll
            for (int tt = 0; tt < 2; ++tt) o[dt][tt] = (f32x4){0.f, 0.f, 0.f, 0.f};
        const int j0 = qt >= 8 ? qt - 8 : 0;
        nsa_pipeline(qt - j0 + 1, kb, vb, B, tid, [&](int i) { return j0 + i; }, [&](int blk_, bf16_t* Ks, bf16_t* Vt) {
            nsa_qk(Ks, Qs, s, fr, fq);
            if (blk_ == qt) nsa_softmax<1, true>(s, m, l, o, sel_all, tib, fq, 0, 0);
            else if (blk_ == qt - 8) nsa_softmax<2, true>(s, m, l, o, sel_all, tib, fq, 0, 0);
            else nsa_softmax_fast(s, m, l, o, bias0);
            nsa_pv(Vt, s, o, fr, fq);
        });
        nsa_emit<true>(o, l, true, gbase + 2, obase, tib, fq);
    }
    __syncthreads();
}

#define SSD_P 136
#define S3_XST 0
#define S3_BC  69632
#define S3_CC  104448
#define S3_ACS 139264
#define S3_DT  141312
#define S3_END 143360

__device__ __forceinline__ void ssd_acs(const float* __restrict__ small, const float* __restrict__ a_log, size_t tok0, int g, float* acs, float* dtl, int tid) {
    const int w = tid >> 6, lane = tid & 63, hh = 4 * g + (w & 3);
    if (w < 4) {
        const float a = -__expf(a_log[hh]);
        const float d0 = small[(tok0 + 2 * lane) * 32 + 24 + hh], d1 = small[(tok0 + 2 * lane + 1) * 32 + 24 + hh];
        const float s0 = d0 * a, s1 = s0 + d1 * a;
        float tot = s1;
#pragma unroll
        for (int off = 1; off < 64; off <<= 1) { const float t = __shfl_up(tot, off); if (lane >= off) tot += t; }
        const float excl = tot - s1;
        acs[w * 128 + 2 * lane] = excl + s0; acs[w * 128 + 2 * lane + 1] = excl + s1;
        dtl[w * 128 + 2 * lane] = d0; dtl[w * 128 + 2 * lane + 1] = d1;
    }
}
struct ConvCh { float w0, w1, w2, w3, bias, h0, h1, h2; };
__device__ __forceinline__ void conv_init(ConvCh& cc, const float* __restrict__ conv_w, const float* __restrict__ conv_b, int ch, const bf16_t* pb, int c) {
    cc.w0 = conv_w[ch]; cc.w1 = conv_w[1024 + ch]; cc.w2 = conv_w[2048 + ch]; cc.w3 = conv_w[3072 + ch]; cc.bias = conv_b[ch];
    if (c > 0) { cc.h0 = bf2f(pb[-3 * PROJ_LD]); cc.h1 = bf2f(pb[-2 * PROJ_LD]); cc.h2 = bf2f(pb[-1 * PROJ_LD]); } else { cc.h0 = 0.f; cc.h1 = 0.f; cc.h2 = 0.f; }
}
__device__ __forceinline__ float conv_step(ConvCh& cc, float x) {
    const float v = cc.bias + cc.w0 * cc.h0 + cc.w1 * cc.h1 + cc.w2 * cc.h2 + cc.w3 * x;
    cc.h0 = cc.h1; cc.h1 = cc.h2; cc.h2 = x;
    return silu(v);
}

__device__ __forceinline__ void d_ssd_states(const bf16_t* __restrict__ proj, const float* __restrict__ small, const float* __restrict__ conv_w, const float* __restrict__ conv_b,
                                             const float* __restrict__ a_log, float* __restrict__ states, float* __restrict__ cdec, int item, char* lds) {
    const int tid = tid_opaque(), lane = tid & 63, w = tid >> 6, fr = lane & 15, fq = lane >> 4;
    const int b = item >> 7, c = (item >> 1) & 63, g = item & 1;
    bf16_t* XwT = (bf16_t*)(lds + S3_XST); bf16_t* BcT = (bf16_t*)(lds + S3_BC);
    float* acs = (float*)(lds + S3_ACS); float* dtl = (float*)(lds + S3_DT);
    const size_t tok0 = (size_t)b * SEQ + (size_t)c * 128;
    ssd_acs(small, a_log, tok0, g, acs, dtl, tid);
    __syncthreads();
    if (tid < 384) {
        const bool isx = tid < 256;
        const int ch = isx ? g * 256 + tid : 512 + g * 128 + (tid - 256);
        const bf16_t* px = proj + tok0 * PROJ_LD + C_XBC + ch;
        ConvCh cx; conv_init(cx, conv_w, conv_b, ch, px, c);
        const int hw = w & 3;
        const float alast = acs[hw * 128 + 127];
        bf16_t* dst = isx ? XwT + tid * SSD_P : BcT + (tid - 256) * SSD_P;
        for (int l0 = 0; l0 < 128; l0 += 32) {
            float rx[32];
#pragma unroll
            for (int i = 0; i < 32; ++i) rx[i] = bf2f(px[(size_t)(l0 + i) * PROJ_LD]);
#pragma unroll
            for (int i8 = 0; i8 < 4; ++i8) {
                float ox[8];
#pragma unroll
                for (int i = 0; i < 8; ++i) {
                    const int l = l0 + i8 * 8 + i;
                    const float v = conv_step(cx, rx[i8 * 8 + i]);
                    ox[i] = isx ? v * dtl[hw * 128 + l] * __expf(alast - acs[hw * 128 + l]) : v;
                }
                u32x4 o; o.x = pack2(ox[0], ox[1]); o.y = pack2(ox[2], ox[3]); o.z = pack2(ox[4], ox[5]); o.w = pack2(ox[6], ox[7]);
                *(u32x4*)(dst + l0 + i8 * 8) = o;
            }
        }
    }
    __syncthreads();
    {
        const int hw = w & 3, nh = w >> 2;
        f32x4 acc[4][4];
#pragma unroll
        for (int pt = 0; pt < 4; ++pt)
#pragma unroll
            for (int nt = 0; nt < 4; ++nt) acc[pt][nt] = (f32x4){0.f, 0.f, 0.f, 0.f};
#pragma unroll 1
        for (int ks = 0; ks < 4; ++ks) {
            bf16x8 af[4], bfr[4];
#pragma unroll
            for (int pt = 0; pt < 4; ++pt) af[pt] = *(const bf16x8*)(XwT + (hw * 64 + pt * 16 + fr) * SSD_P + ks * 32 + fq * 8);
#pragma unroll
            for (int nt = 0; nt < 4; ++nt) bfr[nt] = *(const bf16x8*)(BcT + ((nh * 4 + nt) * 16 + fr) * SSD_P + ks * 32 + fq * 8);
#pragma unroll
            for (int pt = 0; pt < 4; ++pt)
#pragma unroll
                for (int nt = 0; nt < 4; ++nt) acc[pt][nt] = __builtin_amdgcn_mfma_f32_16x16x32_bf16(af[pt], bfr[nt], acc[pt][nt], 0, 0, 0);
        }
        const int hh = 4 * g + hw;
        float* sp = states + ((size_t)((b * 64 + c) * 8 + hh)) * 8192;
#pragma unroll
        for (int pt = 0; pt < 4; ++pt)
#pragma unroll
            for (int nt = 0; nt < 4; ++nt)
#pragma unroll
                for (int jj = 0; jj < 4; ++jj) sp[(pt * 16 + 4 * fq + jj) * 128 + (nh * 4 + nt) * 16 + fr] = acc[pt][nt][jj];
        if (lane == 0 && nh == 0) cdec[(b * 64 + c) * 8 + hh] = __expf(acs[hw * 128 + 127]);
    }
    __syncthreads();
}

__device__ __forceinline__ void d_ssd_scan(const float* __restrict__ states, const float* __restrict__ cdec, bf16_t* __restrict__ prev, int vb) {
    const int bh = vb >> 1, b = bh >> 3, hh = bh & 7;
    const size_t e0 = (size_t)((vb & 1) * 512 + tid_opaque()) * 8;
    f32x4 h0 = (f32x4){0.f, 0.f, 0.f, 0.f}, h1 = h0;
#pragma unroll 8
    for (int c = 0; c < 64; ++c) {
        const size_t base = ((size_t)((b * 64 + c) * 8 + hh)) * 8192 + e0;
        const f32x4 s0 = *(const f32x4*)(states + base), s1 = *(const f32x4*)(states + base + 4);
        const float d = cdec[(b * 64 + c) * 8 + hh];
        u32x4 o; o.x = pack2(h0.x, h0.y); o.y = pack2(h0.z, h0.w); o.z = pack2(h1.x, h1.y); o.w = pack2(h1.z, h1.w);
        *(u32x4*)(prev + base) = o;
        h0 = h0 * d + s0; h1 = h1 * d + s1;
    }
}

__device__ __forceinline__ void d_ssd_out(const bf16_t* __restrict__ proj, const float* __restrict__ small, const float* __restrict__ conv_w, const float* __restrict__ conv_b,
                                          const float* __restrict__ a_log, const float* __restrict__ d_skip, const bf16_t* __restrict__ prev, bf16_t* __restrict__ yssd, int item, char* lds) {
    const int tid = tid_opaque(), lane = tid & 63, w = tid >> 6, fr = lane & 15, fq = lane >> 4;
    const int b = item >> 7, c = (item >> 1) & 63, g = item & 1;
    bf16_t* XsT = (bf16_t*)(lds + S3_XST); bf16_t* Bc = (bf16_t*)(lds + S3_BC); bf16_t* Cc = (bf16_t*)(lds + S3_CC);
    float* acs = (float*)(lds + S3_ACS); float* dtl = (float*)(lds + S3_DT);
    const size_t tok0 = (size_t)b * SEQ + (size_t)c * 128;
    ssd_acs(small, a_log, tok0, g, acs, dtl, tid);
    {
        const int mode = tid < 256 ? 0 : (tid < 384 ? 1 : 2);
        const int ch = mode == 0 ? g * 256 + tid : (mode == 1 ? 512 + g * 128 + (tid - 256) : 768 + g * 128 + (tid - 384));
        const bf16_t* px = proj + tok0 * PROJ_LD + C_XBC + ch;
        ConvCh cx; conv_init(cx, conv_w, conv_b, ch, px, c);
        bf16_t* dstx = XsT + (tid & 255) * SSD_P;
        bf16_t* dstbc = (mode == 1 ? Bc : Cc) + (tid & 127);
        for (int l0 = 0; l0 < 128; l0 += 32) {
            float rx[32];
#pragma unroll
            for (int i = 0; i < 32; ++i) rx[i] = bf2f(px[(size_t)(l0 + i) * PROJ_LD]);
#pragma unroll
            for (int i8 = 0; i8 < 4; ++i8) {
                float ox[8];
#pragma unroll
                for (int i = 0; i < 8; ++i) ox[i] = conv_step(cx, rx[i8 * 8 + i]);
                if (mode == 0) {
                    u32x4 o; o.x = pack2(ox[0], ox[1]); o.y = pack2(ox[2], ox[3]); o.z = pack2(ox[4], ox[5]); o.w = pack2(ox[6], ox[7]);
                    *(u32x4*)(dstx + l0 + i8 * 8) = o;
                } else {
#pragma unroll
                    for (int i = 0; i < 8; ++i) dstbc[(l0 + i8 * 8 + i) * SSD_P] = f2bf(ox[i]);
                }
            }
        }
    }
    __syncthreads();
    const int hw = w & 3, lh = w >> 2, hh = 4 * g + hw;
    const float dsk = d_skip[hh];
    const bf16_t* pp = prev + ((size_t)((b * 64 + c) * 8 + hh)) * 8192;
#pragma unroll 1
    for (int lk = 0; lk < 4; ++lk) {
        const int lt = lh + 2 * lk;
        const int l = lt * 16 + fr;
        const float acs_l = acs[hw * 128 + l];
        bf16x8 cf[4];
#pragma unroll
        for (int ks = 0; ks < 4; ++ks) cf[ks] = *(const bf16x8*)(Cc + (lt * 16 + fr) * SSD_P + ks * 32 + fq * 8);
        f32x4 y[4], yo[4];
#pragma unroll
        for (int pt = 0; pt < 4; ++pt) { y[pt] = (f32x4){0.f, 0.f, 0.f, 0.f}; yo[pt] = (f32x4){0.f, 0.f, 0.f, 0.f}; }
#pragma unroll
        for (int ks2 = 0; ks2 < 4; ++ks2) {
            if (2 * ks2 <= lt) {
                f32x4 cb[2];
#pragma unroll
                for (int h2 = 0; h2 < 2; ++h2) {
                    const int st = 2 * ks2 + h2;
                    cb[h2] = (f32x4){0.f, 0.f, 0.f, 0.f};
                    if (st <= lt) {
#pragma unroll
                        for (int ks = 0; ks < 4; ++ks)
                            cb[h2] = __builtin_amdgcn_mfma_f32_16x16x32_bf16(*(const bf16x8*)(Bc + (st * 16 + fr) * SSD_P + ks * 32 + fq * 8), cf[ks], cb[h2], 0, 0, 0);
#pragma unroll
                        for (int jj = 0; jj < 4; ++jj) {
                            const int sidx = st * 16 + 4 * fq + jj;
                            cb[h2][jj] = (sidx <= l) ? cb[h2][jj] * __expf(acs_l - acs[hw * 128 + sidx]) * dtl[hw * 128 + sidx] : 0.f;
                        }
                    }
                }
                u32x4 wv; wv.x = pack2(cb[0].x, cb[0].y); wv.y = pack2(cb[0].z, cb[0].w); wv.z = pack2(cb[1].x, cb[1].y); wv.w = pack2(cb[1].z, cb[1].w);
                const bf16x8 mf = __builtin_bit_cast(bf16x8, wv);
#pragma unroll
                for (int pt = 0; pt < 4; ++pt) {
                    const bf16_t* xp = XsT + (hw * 64 + pt * 16 + fr) * SSD_P + ks2 * 32 + 4 * fq;
                    const u32x2 a0 = *(const u32x2*)xp, a1 = *(const u32x2*)(xp + 16);
                    u32x4 xv; xv.x = a0.x; xv.y = a0.y; xv.z = a1.x; xv.w = a1.y;
                    y[pt] = __builtin_amdgcn_mfma_f32_16x16x32_bf16(__builtin_bit_cast(bf16x8, xv), mf, y[pt], 0, 0, 0);
                }
            }
            __builtin_amdgcn_sched_barrier(0);
        }
        __builtin_amdgcn_sched_barrier(0);
#pragma unroll
        for (int pt = 0; pt < 4; ++pt)
#pragma unroll
            for (int ks = 0; ks < 4; ++ks) yo[pt] = __builtin_amdgcn_mfma_f32_16x16x32_bf16(*(const bf16x8*)(pp + (pt * 16 + fr) * 128 + ks * 32 + fq * 8), cf[ks], yo[pt], 0, 0, 0);
        __builtin_amdgcn_sched_barrier(0);
        const float el = __expf(acs_l);
#pragma unroll
        for (int pt = 0; pt < 4; ++pt) {
            const int p0 = pt * 16 + 4 * fq;
            const u32x2 zz = *(const u32x2*)(proj + (tok0 + l) * PROJ_LD + C_Z + hh * 64 + p0);
            const float z0 = bflo(zz.x), z1 = bfhi(zz.x), z2 = bflo(zz.y), z3 = bfhi(zz.y);
            const bf16_t* xq = XsT + (hw * 64 + p0) * SSD_P + l;
            const float x0 = bf2f(xq[0]), x1 = bf2f(xq[SSD_P]), x2 = bf2f(xq[2 * SSD_P]), x3 = bf2f(xq[3 * SSD_P]);
            u32x2 ob;
            ob.x = pack2((y[pt].x + el * yo[pt].x + dsk * x0) * silu(z0), (y[pt].y + el * yo[pt].y + dsk * x1) * silu(z1));
            ob.y = pack2((y[pt].z + el * yo[pt].z + dsk * x2) * silu(z2), (y[pt].w + el * yo[pt].w + dsk * x3) * silu(z3));
            *(u32x2*)(yssd + (tok0 + l) * 512 + hh * 64 + p0) = ob;
        }
    }
    __syncthreads();
}

__device__ __forceinline__ void d_mix_prep(const float* __restrict__ onsa, const bf16_t* __restrict__ yssd, const float* __restrict__ nsa_w, const float* __restrict__ ssd_w, bf16_t* __restrict__ A2, int vb) {
    const int tid_ = tid_opaque(); const int lane = tid_ & 63, wid = tid_ >> 6;
    const size_t row0 = (size_t)vb * 32 + wid * 4;
    f32x4 a[4][2], y[4][2];
#pragma unroll
    for (int r = 0; r < 4; ++r)
#pragma unroll
        for (int k = 0; k < 2; ++k) {
            a[r][k] = *(const f32x4*)(onsa + (row0 + r) * 512 + k * 256 + lane * 4);
            const u32x2 yy = *(const u32x2*)(yssd + (row0 + r) * 512 + k * 256 + lane * 4);
            y[r][k] = (f32x4){bflo(yy.x), bfhi(yy.x), bflo(yy.y), bfhi(yy.y)};
        }
    float ra[4], ry[4];
#pragma unroll
    for (int r = 0; r < 4; ++r) {
        float s0 = 0.f, s1 = 0.f;
#pragma unroll
        for (int k = 0; k < 2; ++k) {
            s0 += a[r][k].x * a[r][k].x + a[r][k].y * a[r][k].y + a[r][k].z * a[r][k].z + a[r][k].w * a[r][k].w;
            s1 += y[r][k].x * y[r][k].x + y[r][k].y * y[r][k].y + y[r][k].z * y[r][k].z + y[r][k].w * y[r][k].w;
        }
        ra[r] = rsqrtf(wave_sum(s0) * (1.0f / 512) + EPS); ry[r] = rsqrtf(wave_sum(s1) * (1.0f / 512) + EPS);
    }
#pragma unroll
    for (int k = 0; k < 2; ++k) {
        const int col = k * 256 + lane * 4;
        const f32x4 wn = *(const f32x4*)(nsa_w + col), wsd = *(const f32x4*)(ssd_w + col);
#pragma unroll
        for (int r = 0; r < 4; ++r) {
            const f32x4 p = a[r][k] * ra[r] * wn, q = y[r][k] * ry[r] * wsd;
            u32x2 o; o.x = pack2(p.x, p.y); o.y = pack2(p.z, p.w);
            *(u32x2*)(A2 + (row0 + r) * DM + col) = o;
            u32x2 o2; o2.x = pack2(q.x, q.y); o2.y = pack2(q.z, q.w);
            *(u32x2*)(A2 + (row0 + r) * DM + 512 + col) = o2;
        }
    }
}

__device__ __forceinline__ void d_quant_rows(const float* __restrict__ src, unsigned char* __restrict__ dst, float* __restrict__ scale, int vb) {
    const int tid_ = tid_opaque(); const int lane = tid_ & 63, row = vb * 8 + (tid_ >> 6);
    const float* rp = src + (size_t)row * DM + lane * 16;
    f32x4 v[4];
#pragma unroll
    for (int i = 0; i < 4; ++i) v[i] = *(const f32x4*)(rp + i * 4);
    float mx = 0.f;
#pragma unroll
    for (int i = 0; i < 4; ++i) mx = fmaxf(mx, fmaxf(fmaxf(fabsf(v[i].x), fabsf(v[i].y)), fmaxf(fabsf(v[i].z), fabsf(v[i].w))));
    mx = wave_max(mx);
    const float sc = mx > 0.f ? mx * (1.0f / 416.0f) : 1.0f;
    const float inv = 1.0f / sc;
    u32x4 o;
#pragma unroll
    for (int i = 0; i < 4; ++i) {
        int wv = 0;
        wv = __builtin_amdgcn_cvt_pk_fp8_f32(v[i].x * inv, v[i].y * inv, wv, false);
        wv = __builtin_amdgcn_cvt_pk_fp8_f32(v[i].z * inv, v[i].w * inv, wv, true);
        o[i] = (unsigned)wv;
    }
    *(u32x4*)(dst + (size_t)row * DM + lane * 16) = o;
    if (lane == 0) scale[row] = sc;
}

__device__ __forceinline__ unsigned mono_u(float f) { const unsigned u = __float_as_uint(f); return (u & 0x80000000u) ? ~u : (u | 0x80000000u); }
__device__ __forceinline__ float unmono_f(unsigned m) { const unsigned u = (m & 0x80000000u) ? (m & 0x7fffffffu) : ~m; return __uint_as_float(u); }
__device__ __forceinline__ void d_peer_route(const bf16_t* __restrict__ qp, const float* __restrict__ qnw, const bf16_t* __restrict__ subk, int* __restrict__ eidx, float* __restrict__ gate,
                                             int tile, int h, char* lds) {
    const int tid = tid_opaque(), lane = tid & 63, w = tid >> 6, fr = lane & 15, fq = lane >> 4;
    const size_t tok = (size_t)tile * 128 + w * 16 + fr;
    bf16x8 qf[2][4];
    {
        const bf16_t* qrow = qp + tok * 2048 + h * 256;
        u32x4 raw[2][4];
        float ss = 0.f;
#pragma unroll
        for (int k = 0; k < 2; ++k)
#pragma unroll
            for (int ks = 0; ks < 4; ++ks) {
                const u32x4 r = *(const u32x4*)(qrow + k * 128 + ks * 32 + fq * 8);
                raw[k][ks] = r;
                ss += bflo(r.x) * bflo(r.x) + bfhi(r.x) * bfhi(r.x) + bflo(r.y) * bflo(r.y) + bfhi(r.y) * bfhi(r.y)
                    + bflo(r.z) * bflo(r.z) + bfhi(r.z) * bfhi(r.z) + bflo(r.w) * bflo(r.w) + bfhi(r.w) * bfhi(r.w);
            }
        ss += __shfl_xor(ss, 16); ss += __shfl_xor(ss, 32);
        const float rs = rsqrtf(ss * (1.0f / 256) + EPS);
#pragma unroll
        for (int k = 0; k < 2; ++k)
#pragma unroll
            for (int ks = 0; ks < 4; ++ks) {
                const float* wp = qnw + k * 128 + ks * 32 + fq * 8;
                const f32x4 w0 = *(const f32x4*)wp, w1 = *(const f32x4*)(wp + 4);
                const u32x4 r = raw[k][ks];
                u32x4 o;
                o.x = pack2(bflo(r.x) * rs * w0.x, bfhi(r.x) * rs * w0.y); o.y = pack2(bflo(r.y) * rs * w0.z, bfhi(r.y) * rs * w0.w);
                o.z = pack2(bflo(r.z) * rs * w1.x, bfhi(r.z) * rs * w1.y); o.w = pack2(bflo(r.w) * rs * w1.z, bfhi(r.w) * rs * w1.w);
                qf[k][ks] = __builtin_bit_cast(bf16x8, o);
            }
    }
    unsigned L[2][16];
#pragma unroll
    for (int k = 0; k < 2; ++k) {
        f32x4 acc[8];
#pragma unroll
        for (int kt = 0; kt < 8; ++kt) acc[kt] = (f32x4){0.f, 0.f, 0.f, 0.f};
        const bf16_t* kb = subk + (size_t)((h * 2 + k) * 128) * 128;
#pragma unroll
        for (int kt = 0; kt < 8; ++kt)
#pragma unroll
            for (int ks = 0; ks < 4; ++ks) {
                const bf16x8 af = *(const bf16x8*)(kb + (size_t)(kt * 16 + fr) * 128 + ks * 32 + fq * 8);
                acc[kt] = __builtin_amdgcn_mfma_f32_16x16x32_bf16(af, qf[k][ks], acc[kt], 0, 0, 0);
            }
#pragma unroll
        for (int i = 0; i < 16; ++i) L[k][i] = 0u;
#pragma unroll
        for (int kt = 0; kt < 8; ++kt)
#pragma unroll
            for (int jj = 0; jj < 4; ++jj) {
                const int idx = kt * 16 + 4 * fq + jj;
                ins16(L[k], (mono_u(acc[kt][jj]) & ~0x7Fu) | (unsigned)(127 - idx));
            }
#pragma unroll
        for (int r = 16; r <= 32; r <<= 1) {
            unsigned P[16];
#pragma unroll
            for (int i = 0; i < 16; ++i) P[i] = (unsigned)__shfl_xor((int)L[k][i], r);
            merge16(L[k], P);
        }
    }
    unsigned T[16];
#pragma unroll
    for (int i = 0; i < 16; ++i) T[i] = 0u;
#pragma unroll
    for (int a = 0; a < 16; ++a) {
        const float va = unmono_f(L[0][a] & ~0x7Fu);
#pragma unroll
        for (int bb = 0; bb < 16; ++bb) {
            if (bb <= 16 / (a + 1) - 1) {
                const float sum = va + unmono_f(L[1][bb] & ~0x7Fu);
                ins16(T, (mono_u(sum) & ~0xFFu) | (unsigned)(255 - (a * 16 + bb)));
            }
        }
    }
    unsigned char* li = (unsigned char*)lds + w * 512 + fr * 32;
    if (fq == 0) {
#pragma unroll
        for (int a = 0; a < 16; ++a) { li[a] = (unsigned char)(127 - (L[0][a] & 0x7Fu)); li[16 + a] = (unsigned char)(127 - (L[1][a] & 0x7Fu)); }
    }
    __syncthreads();
    const float s0 = unmono_f(T[0] & ~0xFFu);
    float pe[16]; float sum = 0.f;
#pragma unroll
    for (int i = 0; i < 16; ++i) { pe[i] = __expf(unmono_f(T[i] & ~0xFFu) - s0); sum += pe[i]; }
    const float inv = 1.0f / sum;
    unsigned cod[4] = {0u, 0u, 0u, 0u}; float gv[4] = {0.f, 0.f, 0.f, 0.f};
#pragma unroll
    for (int i = 0; i < 16; ++i) if ((i >> 2) == fq) { cod[i & 3] = 255u - (T[i] & 0xFFu); gv[i & 3] = pe[i] * inv; }
    int ev[4];
#pragma unroll
    for (int i = 0; i < 4; ++i) ev[i] = (int)li[cod[i] >> 4] * 128 + (int)li[16 + (cod[i] & 15u)];
    *(u32x4*)(eidx + (tok * 8 + h) * 16 + fq * 4) = (u32x4){(unsigned)ev[0], (unsigned)ev[1], (unsigned)ev[2], (unsigned)ev[3]};
    *(f32x4*)(gate + (tok * 8 + h) * 16 + fq * 4) = (f32x4){gv[0], gv[1], gv[2], gv[3]};
    __syncthreads();
}

__device__ __forceinline__ void cvt16(const u32x4 q, float (&f)[16]) {
#pragma unroll
    for (int i = 0; i < 4; ++i) {
        const f32x2 lo = __builtin_amdgcn_cvt_pk_f32_fp8((int)q[i], false), hi = __builtin_amdgcn_cvt_pk_f32_fp8((int)q[i], true);
        f[4 * i] = lo.x; f[4 * i + 1] = lo.y; f[4 * i + 2] = hi.x; f[4 * i + 3] = hi.y;
    }
}
__device__ __forceinline__ void d_peer_expert8(const bf16_t* __restrict__ h2, const unsigned char* __restrict__ down8, const unsigned char* __restrict__ up8, const float* __restrict__ dscale,
                                               const float* __restrict__ uscale, const int* __restrict__ eidx, const float* __restrict__ gate, const float* __restrict__ mod,
                                               const float* __restrict__ fw, float* __restrict__ out, int vb) {
    const int tid = tid_opaque(), lane = tid & 63, wid = tid >> 6;
    const size_t tok = (size_t)vb * 8 + wid; const int b = (int)(tok >> 13);
    const int e_lo = eidx[tok * 128 + lane], e_hi = eidx[tok * 128 + 64 + lane];
    const float c_lo = gate[tok * 128 + lane] * uscale[e_lo], c_hi = gate[tok * 128 + 64 + lane] * uscale[e_hi];
    const float d_lo = dscale[e_lo], d_hi = dscale[e_hi];
    float hx[16], acc[16];
    {
        const u32x4 v0 = *(const u32x4*)(h2 + tok * DM + lane * 16), v1 = *(const u32x4*)(h2 + tok * DM + lane * 16 + 8);
        hx[0] = bflo(v0.x); hx[1] = bfhi(v0.x); hx[2] = bflo(v0.y); hx[3] = bfhi(v0.y); hx[4] = bflo(v0.z); hx[5] = bfhi(v0.z); hx[6] = bflo(v0.w); hx[7] = bfhi(v0.w);
        hx[8] = bflo(v1.x); hx[9] = bfhi(v1.x); hx[10] = bflo(v1.y); hx[11] = bfhi(v1.y); hx[12] = bflo(v1.z); hx[13] = bfhi(v1.z); hx[14] = bflo(v1.w); hx[15] = bfhi(v1.w);
    }
#pragma unroll
    for (int e = 0; e < 16; ++e) acc[e] = 0.f;
    const int es = lane >> 3;
    u32x4 dq[8], uq[8], dn[8], un[8];
#pragma unroll
    for (int i = 0; i < 8; ++i) {
        const int e = __builtin_amdgcn_readlane(e_lo, i);
        dq[i] = *(const u32x4*)(down8 + (size_t)e * DM + lane * 16);
        uq[i] = *(const u32x4*)(up8 + (size_t)e * DM + lane * 16);
    }
#pragma unroll 1
    for (int j0 = 0; j0 < 128; j0 += 8) {
        if (j0 + 8 < 128) {
            const int jn = j0 + 8;
#pragma unroll
            for (int i = 0; i < 8; ++i) {
                const int e = jn < 64 ? __builtin_amdgcn_readlane(e_lo, jn + i) : __builtin_amdgcn_readlane(e_hi, jn - 64 + i);
                dn[i] = *(const u32x4*)(down8 + (size_t)e * DM + lane * 16);
                un[i] = *(const u32x4*)(up8 + (size_t)e * DM + lane * 16);
            }
        }
        const int sl = (j0 & 63) + es;
        const float my_c = j0 < 64 ? __shfl(c_lo, sl) : __shfl(c_hi, sl);
        const float my_ds = j0 < 64 ? __shfl(d_lo, sl) : __shfl(d_hi, sl);
        float part[8];
#pragma unroll
        for (int i = 0; i < 8; ++i) {
            float f[16]; cvt16(dq[i], f);
            float s = 0.f;
#pragma unroll
            for (int e = 0; e < 16; ++e) s += hx[e] * f[e];
            part[i] = s;
        }
        float q4[4], q2[2], q1;
#pragma unroll
        for (int i = 0; i < 4; ++i) { const bool up = (lane & 32) != 0; const float send = up ? part[i] : part[i + 4]; const float keep = up ? part[i + 4] : part[i]; q4[i] = keep + __shfl_xor(send, 32); }
#pragma unroll
        for (int i = 0; i < 2; ++i) { const bool up = (lane & 16) != 0; const float send = up ? q4[i] : q4[i + 2]; const float keep = up ? q4[i + 2] : q4[i]; q2[i] = keep + __shfl_xor(send, 16); }
        { const bool up = (lane & 8) != 0; const float send = up ? q2[0] : q2[1]; const float keep = up ? q2[1] : q2[0]; q1 = keep + __shfl_xor(send, 8); }
        q1 += __shfl_xor(q1, 4); q1 += __shfl_xor(q1, 2); q1 += __shfl_xor(q1, 1);
        const float a = gelu_tanh(q1 * my_ds) * my_c;
#pragma unroll
        for (int i = 0; i < 8; ++i) {
            const float c = __uint_as_float((unsigned)__builtin_amdgcn_readlane((int)__float_as_uint(a), 8 * i));
            float f[16]; cvt16(uq[i], f);
#pragma unroll
            for (int e = 0; e < 16; ++e) acc[e] += c * f[e];
        }
#pragma unroll
        for (int i = 0; i < 8; ++i) { dq[i] = dn[i]; uq[i] = un[i]; }
    }
    float x2[16]; float ss = 0.f;
#pragma unroll
    for (int q4i = 0; q4i < 4; ++q4i) {
        const int col = lane * 16 + q4i * 4;
        const f32x4 xv = *(const f32x4*)(out + tok * DM + col);
        const f32x4 g2 = *(const f32x4*)(mod + b * 6144 + 5120 + col);
        const int e0 = q4i * 4;
        x2[e0 + 0] = xv.x + g2.x * acc[e0 + 0]; x2[e0 + 1] = xv.y + g2.y * acc[e0 + 1]; x2[e0 + 2] = xv.z + g2.z * acc[e0 + 2]; x2[e0 + 3] = xv.w + g2.w * acc[e0 + 3];
        ss += x2[e0] * x2[e0] + x2[e0 + 1] * x2[e0 + 1] + x2[e0 + 2] * x2[e0 + 2] + x2[e0 + 3] * x2[e0 + 3];
    }
    ss = wave_sum(ss);
    const float r = rsqrtf(ss * (1.0f / DM) + EPS);
#pragma unroll
    for (int q4i = 0; q4i < 4; ++q4i) {
        const int col = lane * 16 + q4i * 4;
        const f32x4 wv = *(const f32x4*)(fw + col);
        const int e0 = q4i * 4;
        *(f32x4*)(out + tok * DM + col) = (f32x4){x2[e0] * r * wv.x, x2[e0 + 1] * r * wv.y, x2[e0 + 2] * r * wv.z, x2[e0 + 3] * r * wv.w};
    }
}

#define XB_TMO      128
#define XB_XCNT(j)  (256  + 64 * (j))
#define XB_XSUB(j)  (1280 + 64 * (j))
#define XB_XGEN(j)  (2304 + 64 * (j))
#define XB_TOP      3328
#define XB_TOPGEN   3392
#define XCD_BAR_WORDS 3456
#define XB_SPIN_CAP (1u << 18)

__device__ __forceinline__ unsigned xb_ld(unsigned* p)              { return __hip_atomic_load(p, __ATOMIC_RELAXED, __HIP_MEMORY_SCOPE_AGENT); }
__device__ __forceinline__ unsigned xb_add(unsigned* p, unsigned v) { return __hip_atomic_fetch_add(p, v, __ATOMIC_RELAXED, __HIP_MEMORY_SCOPE_AGENT); }
__device__ __forceinline__ unsigned xb_xcc_id() { return (unsigned)__builtin_amdgcn_s_getreg((3 << 11) | 20) & 0xFu; }
#define XB_SPIN(cond, bar) do { unsigned _sp = 0; while (cond) { __builtin_amdgcn_s_sleep(1); \
    if ((++_sp & 255u) == 0u) { if (xb_ld(&(bar)[XB_TMO])) break; if (_sp > XB_SPIN_CAP) { atomicAdd(&(bar)[XB_TMO], 1u); break; } } } } while (0)

struct XcdBarrier {
    unsigned* bar; unsigned x;
    volatile __attribute__((address_space(3))) unsigned* st;
};

__device__ __forceinline__ XcdBarrier xcd_barrier_post(unsigned* bar, volatile __attribute__((address_space(3))) unsigned* st) {
    XcdBarrier b; b.bar = bar; b.x = xb_xcc_id(); b.st = st;
    if (threadIdx.x == 0) (void)xb_add(&bar[XB_XCNT(b.x)], 1u);
    return b;
}
__device__ __forceinline__ void xcd_barrier_complete(unsigned* bar, unsigned x, unsigned& nloc, unsigned& nx) {
    const unsigned G = gridDim.x * gridDim.y * gridDim.z;
    unsigned sum, cnt, mine, sp = 0u;
    for (;;) {
        sum = 0u; cnt = 0u; mine = 0u;
#pragma unroll
        for (unsigned j = 0; j < 16; ++j) { const unsigned c = xb_ld(&bar[XB_XCNT(j)]); sum += c; cnt += (c > 0u) ? 1u : 0u; mine = (j == x) ? c : mine; }
        if (sum == G) break;
        __builtin_amdgcn_s_sleep(1);
        if ((++sp & 255u) == 0u) { if (xb_ld(&bar[XB_TMO])) break; if (sp > XB_SPIN_CAP) { atomicAdd(&bar[XB_TMO], 1u); break; } }
    }
    nloc = mine > 0u ? mine : 1u; nx = cnt > 0u ? cnt : 1u;
}

__device__ __forceinline__ void xcd_barrier(const XcdBarrier& b) {
    asm volatile("s_waitcnt vmcnt(0)" ::: "memory");
    __syncthreads();
    if (threadIdx.x == 0) {
        unsigned* bar = b.bar;
        __builtin_amdgcn_s_waitcnt(0);
        unsigned nloc = b.st[0], nx = b.st[1];
        if (nloc == 0u) { xcd_barrier_complete(bar, b.x, nloc, nx); b.st[0] = nloc; b.st[1] = nx; }
        const unsigned old = xb_add(&bar[XB_XSUB(b.x)], 1u);
        const unsigned gen = old / nloc;
        if (old + 1u == (gen + 1u) * nloc) {
            __builtin_amdgcn_fence(__ATOMIC_RELEASE, "agent");
            asm volatile("s_waitcnt vmcnt(0)" ::: "memory");
            const unsigned og = xb_add(&bar[XB_TOP], 1u);
            const unsigned tg = og / nx;
            if (og + 1u == (tg + 1u) * nx) xb_add(&bar[XB_TOPGEN], 1u);
            else XB_SPIN(xb_ld(&bar[XB_TOPGEN]) == tg, bar);
            __builtin_amdgcn_fence(__ATOMIC_ACQUIRE, "agent");
            xb_add(&bar[XB_XGEN(b.x)], 1u);
            asm volatile("s_waitcnt vmcnt(0)" ::: "memory");
        } else {
            XB_SPIN(xb_ld(&bar[XB_XGEN(b.x)]) == gen, bar);
            __builtin_amdgcn_fence(__ATOMIC_ACQUIRE, "agent");
            asm volatile("s_waitcnt vmcnt(0)" ::: "memory");
        }
    }
    __syncthreads();
}


struct Params {
    const float *x, *c, *w_ada, *b_ada, *norm1_w, *w_in, *cmp_pe_k, *cmp_pe_v, *cmp_w1_k, *cmp_w2_k, *cmp_w1_v, *cmp_w2_v, *nsa_norm_w, *conv_w, *conv_b, *dt_bias, *a_log, *d_skip,
        *ssd_norm_w, *w_out, *norm2_w, *peer_wq, *peer_qnorm_w, *peer_sub_keys, *peer_down, *peer_up, *final_norm_w;
    float* out; char* ws;
};
#define LDS_BYTES 147456
#define LDS_MISC  (LDS_BYTES - 64)

__global__ __launch_bounds__(512, 2) void mega(Params p) {
    __shared__ __attribute__((aligned(16))) unsigned char lds_raw[LDS_BYTES];
    char* lds = (char*)lds_raw;
    PG8_LAS unsigned char* lds3 = (PG8_LAS unsigned char*)lds_raw;
    int* s_vb = (int*)(lds + LDS_MISC);
    cg::grid_group grid = cg::this_grid();
    volatile __attribute__((address_space(3))) unsigned* xb_st = (volatile __attribute__((address_space(3))) unsigned*)((PG8_LAS unsigned char*)lds_raw + LDS_MISC + 16);
    if (threadIdx.x == 0) { xb_st[0] = 0u; xb_st[1] = 0u; }
    __syncthreads();
    const XcdBarrier xbar = xcd_barrier_post((unsigned*)(p.ws + OFF_BAR), xb_st);
    const int G = gridDim.x, bid = blockIdx.x;
    if (bid == 0 && threadIdx.x == 0) { ((unsigned*)(p.ws + OFF_CTR))[0] = 0u; ((unsigned*)(p.ws + OFF_CTR))[64] = 0u; ((unsigned*)(p.ws + OFF_CTR))[128] = 0u; }
    for (int vb = bid; vb < 7906; vb += G) {
        int v = vb;
        if (v < 1536) { d_transpose_w(p.w_in, ((bf16_t*)(p.ws + OFF_WIN_T)), 1024, 2848, 1, 96, v, lds); }
        else if ((v -= 1536) < 512) { d_transpose_w(p.w_out, ((bf16_t*)(p.ws + OFF_WOUT_T)), 1024, 1024, 0, 32, v, lds); }
        else if ((v -= 512) < 1024) { d_transpose_w(p.peer_wq, ((bf16_t*)(p.ws + OFF_WQ_T)), 1024, 2048, 0, 64, v, lds); }
        else if ((v -= 1024) < 256) { d_transpose_w(p.cmp_w1_k, ((bf16_t*)(p.ws + OFF_W1K_T)), 2048, 256, 0, 8, v, lds); }
        else if ((v -= 256) < 256) { d_transpose_w(p.cmp_w1_v, ((bf16_t*)(p.ws + OFF_W1V_T)), 2048, 256, 0, 8, v, lds); }
        else if ((v -= 256) < 2048) { d_quant_rows(p.peer_down, ((unsigned char*)(p.ws + OFF_DOWN)), ((float*)(p.ws + OFF_UP)), v); }
        else if ((v -= 2048) < 2048) { d_quant_rows(p.peer_up, ((unsigned char*)(p.ws + OFF_DOWN + MIB(16))), ((float*)(p.ws + OFF_UP + 65536)), v); }
        else if ((v -= 2048) < 1) { d_convert_bf16(p.peer_sub_keys, ((bf16_t*)(p.ws + OFF_SUBK)), (size_t)8 * 2 * 128 * 128 / 8, 0, 1); }
        else if ((v -= 1) < 96) { d_mod(p.c, p.w_ada, p.b_ada, ((float*)(p.ws + OFF_MOD)), v, lds); }
        else if ((v -= 96) < 128) { d_rope_table(((float2*)(p.ws + OFF_ROPE)), v); }
        else { d_bias1(p.cmp_pe_k, p.cmp_w1_k, p.cmp_pe_v, p.cmp_w1_v, ((float*)(p.ws + OFF_BIAS1))); }
    }
    grid.sync();
    for (int vb = bid; vb < NTOK / 32; vb += G) d_norm_mod(p.x, p.norm1_w, ((float*)(p.ws + OFF_MOD)), 0, 1024, ((bf16_t*)(p.ws + OFF_H)), vb);
    xcd_barrier(xbar);
    {
        const pg8::Gemm g{((bf16_t*)(p.ws + OFF_H)), ((bf16_t*)(p.ws + OFF_WIN_T)), NTOK, NIN_PAD, 1024, 1024};
        pg8::StaticOrder S; S.init(NTOK, NIN_PAD, G, bid);
        const pg8::Epi<EpInProj> E{{((bf16_t*)(p.ws + OFF_PROJ)), ((bf16_t*)(p.ws + OFF_QROPE)), ((bf16_t*)(p.ws + OFF_KVP)), ((float*)(p.ws + OFF_SMALL)), ((float2*)(p.ws + OFF_ROPE)), p.dt_bias}};
        pg8::gemm_phase(lds3, g, S, E);
    }
    xcd_barrier(xbar);
    {
        {
            const pg8::Gemm g{((bf16_t*)(p.ws + OFF_KVP)) + 0 * KVP_SEG, ((bf16_t*)(p.ws + OFF_W1K_T)), 8192, 256, 2048, 1024};
            pg8::StaticOrder S; S.init(8192, 256, G, bid);
            const pg8::Epi<EpCmpHid> E{{((bf16_t*)(p.ws + OFF_HIDK)), ((float*)(p.ws + OFF_BIAS1))}};
            pg8::gemm_phase(lds3, g, S, E);
        }
        {
            const pg8::Gemm g{((bf16_t*)(p.ws + OFF_KVP)) + 1 * KVP_SEG, ((bf16_t*)(p.ws + OFF_W1V_T)), 8192, 256, 2048, 1024};
            pg8::StaticOrder S; S.init(8192, 256, G, (bid + G / 2) % G);
            const pg8::Epi<EpCmpHid> E{{((bf16_t*)(p.ws + OFF_HIDV)), ((float*)(p.ws + OFF_BIAS1)) + 256}};
            pg8::gemm_phase(lds3, g, S, E);
        }
        __syncthreads();
        for (int vb = bid; vb < 1024; vb += G) d_ssd_states(((bf16_t*)(p.ws + OFF_PROJ)), ((float*)(p.ws + OFF_SMALL)), p.conv_w, p.conv_b, p.a_log, ((float*)(p.ws + OFF_ONSA)), ((float*)(p.ws + OFF_CTR + 4096)), vb, lds);
    }
    xcd_barrier(xbar);
    for (int vb = bid; vb < 2048 + 128; vb += G) {
        if (vb < 1024) d_cmp_out(((bf16_t*)(p.ws + OFF_HIDK)), p.cmp_w2_k, ((bf16_t*)(p.ws + OFF_KC)), vb); else if (vb < 2048) d_cmp_out(((bf16_t*)(p.ws + OFF_HIDV)), p.cmp_w2_v, ((bf16_t*)(p.ws + OFF_VC)), vb - 1024);
        else d_ssd_scan(((float*)(p.ws + OFF_ONSA)), ((float*)(p.ws + OFF_CTR + 4096)), ((bf16_t*)(p.ws + OFF_EIDX)), vb - 2048);
    }
    xcd_barrier(xbar);
    for (;;) {
        if (threadIdx.x == 0) *s_vb = (int)atomicAdd(&((unsigned*)(p.ws + OFF_CTR))[0], 1u);
        __syncthreads();
        const int i = *s_vb;
        __syncthreads();
        if (i >= 2048) break;
        const int qt = 127 - (i >> 4), bg = i & 15;
        d_nsa_cmp(((bf16_t*)(p.ws + OFF_PROJ)), ((bf16_t*)(p.ws + OFF_KC)), ((bf16_t*)(p.ws + OFF_VC)), ((float*)(p.ws + OFF_SMALL)), ((float*)(p.ws + OFF_ONSA)), ((unsigned*)(p.ws + OFF_HIDK)) + (size_t)(bg * 128 + qt) * 512, bg >> 1, bg & 1, qt, lds);
    }
    for (;;) {
        if (threadIdx.x == 0) *s_vb = (int)atomicAdd(&((unsigned*)(p.ws + OFF_CTR))[64], 1u);
        __syncthreads();
        const int i = *s_vb;
        __syncthreads();
        if (i >= 1024) break;
        d_ssd_out(((bf16_t*)(p.ws + OFF_PROJ)), ((float*)(p.ws + OFF_SMALL)), p.conv_w, p.conv_b, p.a_log, p.d_skip, ((bf16_t*)(p.ws + OFF_EIDX)), ((bf16_t*)(p.ws + OFF_YSSD)), i, lds);
    }
    xcd_barrier(xbar);
    for (;;) {
        if (threadIdx.x == 0) *s_vb = (int)atomicAdd(&((unsigned*)(p.ws + OFF_CTR))[128], 1u);
        __syncthreads();
        const int i = *s_vb;
        __syncthreads();
        if (i >= 2048) break;
        const int qt = 127 - (i >> 4), bg = i & 15;
        d_nsa_attn(((bf16_t*)(p.ws + OFF_QROPE)), ((bf16_t*)(p.ws + OFF_KVP)), ((float*)(p.ws + OFF_SMALL)), ((float*)(p.ws + OFF_ONSA)), ((unsigned*)(p.ws + OFF_HIDK)) + (size_t)(bg * 128 + qt) * 512, bg >> 1, bg & 1, qt, lds);
    }
    xcd_barrier(xbar);
    for (int vb = bid; vb < NTOK / 32; vb += G) d_mix_prep(((float*)(p.ws + OFF_ONSA)), ((bf16_t*)(p.ws + OFF_YSSD)), p.nsa_norm_w, p.ssd_norm_w, ((bf16_t*)(p.ws + OFF_H)), vb);
    xcd_barrier(xbar);
    {
        const pg8::Gemm g{((bf16_t*)(p.ws + OFF_H)), ((bf16_t*)(p.ws + OFF_WOUT_T)), NTOK, 1024, 1024, 1024};
        pg8::StaticOrder S; S.init(NTOK, 1024, G, bid);
        const pg8::Epi<EpOutProj> E{{p.x, ((float*)(p.ws + OFF_MOD)), p.out}};
        pg8::gemm_phase(lds3, g, S, E);
    }
    xcd_barrier(xbar);
    for (int vb = bid; vb < NTOK / 32; vb += G) d_norm_mod(p.out, p.norm2_w, ((float*)(p.ws + OFF_MOD)), 3072, 4096, ((bf16_t*)(p.ws + OFF_H)), vb);
    xcd_barrier(xbar);
    {
        const pg8::Gemm g{((bf16_t*)(p.ws + OFF_H)), ((bf16_t*)(p.ws + OFF_WQ_T)), NTOK, 2048, 1024, 1024};
        pg8::StaticOrder S; S.init(NTOK, 2048, G, bid);
        const pg8::Epi<EpStoreBf16> E{{((bf16_t*)(p.ws + OFF_PROJ)), 2048, 0}};
        pg8::gemm_phase(lds3, g, S, E);
    }
    xcd_barrier(xbar);
    for (int vb = bid; vb < 4096; vb += G) d_peer_route(((bf16_t*)(p.ws + OFF_PROJ)), p.peer_qnorm_w, ((bf16_t*)(p.ws + OFF_SUBK)), ((int*)(p.ws + OFF_EIDX)), ((float*)(p.ws + OFF_GATE)), vb >> 3, vb & 7, lds);
    xcd_barrier(xbar);
    for (int vb = bid; vb < NTOK / 8; vb += G) d_peer_expert8(((bf16_t*)(p.ws + OFF_H)), ((unsigned char*)(p.ws + OFF_DOWN)), ((unsigned char*)(p.ws + OFF_DOWN + MIB(16))), ((float*)(p.ws + OFF_UP)), ((float*)(p.ws + OFF_UP + 65536)), ((int*)(p.ws + OFF_EIDX)), ((float*)(p.ws + OFF_GATE)), ((float*)(p.ws + OFF_MOD)), p.final_norm_w, p.out, vb);
}

extern "C" void kernel_launch(void* const* d_in, const int* in_sizes, int n_in, void* d_out, int out_size, void* d_ws, size_t ws_size, hipStream_t stream) {
    if (ws_size < WS_NEED) { fprintf(stderr, "workspace too small\n"); return; }
    static int grid_blocks = 0;
    if (!grid_blocks) {
        int dev = 0, cus = 0, per_cu = 0;
        (void)hipGetDevice(&dev);
        (void)hipDeviceGetAttribute(&cus, hipDeviceAttributeMultiprocessorCount, dev);
        (void)hipOccupancyMaxActiveBlocksPerMultiprocessor(&per_cu, mega, 512, 0);
        if (per_cu < 1) fprintf(stderr, "occupancy query reports %d blocks per CU\n", per_cu);
        grid_blocks = cus;
    }
    Params p{};
    const float** pp = (const float**)&p;
    for (int i = 0; i < 27; ++i) pp[i] = (const float*)d_in[i];
    p.out = (float*)d_out; p.ws = (char*)d_ws;
    (void)hipMemsetAsync((char*)d_ws + OFF_BAR, 0, XCD_BAR_WORDS * 4, stream);
    void* args[] = {&p};
    hipError_t e = hipLaunchCooperativeKernel((void*)mega, dim3(grid_blocks), dim3(512), args, 0, stream);
    if (e != hipSuccess) fprintf(stderr, "cooperative launch failed: %s (grid %d)\n", hipGetErrorString(e), grid_blocks);
}
```

```cpp
#include <hip/hip_runtime.h>
#include <hip/hip_cooperative_groups.h>
#include <stdint.h>
#include <cstdio>
namespace cg = cooperative_groups;

typedef unsigned short bf16_t;
typedef short bf16x8 __attribute__((ext_vector_type(8)));
typedef float f32x4 __attribute__((ext_vector_type(4)));
typedef float f32x2 __attribute__((ext_vector_type(2)));
typedef unsigned u32x4 __attribute__((ext_vector_type(4)));
typedef unsigned u32x2 __attribute__((ext_vector_type(2)));

#define NB 8
#define SEQ 8192
#define NTOK 65536
#define DM 1024
#define PROJ_LD 2816
#define NIN_PAD 3072
#define C_Q 0
#define C_KCMP 512
#define C_KSEL 768
#define C_VSEL 896
#define C_KWIN 1024
#define C_VWIN 1152
#define C_Z 1280
#define C_XBC 1792
#define NCMP 511
#define EPS 1e-6f
#define KVP_SEG ((size_t)NB * 2 * SEQ * 64)

#define MIB(x) ((size_t)(x) << 20)
#define OFF_MOD    MIB(0)
#define OFF_ROPE   MIB(1)
#define OFF_BIAS1  MIB(2)
#define OFF_WIN_T  MIB(3)
#define OFF_WOUT_T MIB(9)
#define OFF_WQ_T   MIB(11)
#define OFF_SUBK   MIB(15)
#define OFF_W1K_T  MIB(16)
#define OFF_W1V_T  MIB(17)
#define OFF_KC     MIB(18)
#define OFF_VC     MIB(19)
#define OFF_HIDK   MIB(20)
#define OFF_HIDV   MIB(24)
#define OFF_DOWN   MIB(28)
#define OFF_UP     MIB(60)
#define OFF_SMALL  MIB(92)
#define OFF_H      MIB(100)
#define OFF_PROJ   MIB(228)
#define OFF_QROPE  MIB(580)
#define OFF_ONSA   MIB(644)
#define OFF_YSSD   MIB(772)
#define OFF_KVP    MIB(836)
#define OFF_EIDX   MIB(932)
#define OFF_GATE   MIB(964)
#define OFF_CTR    MIB(996)
#define OFF_BAR    (MIB(996) + 65536)
#define WS_NEED    MIB(997)

typedef __bf16 hwbf2 __attribute__((ext_vector_type(2)));
__device__ __forceinline__ bf16_t f2bf(float f) { const __bf16 h = (__bf16)f; return __builtin_bit_cast(bf16_t, h); }
__device__ __forceinline__ float bf2f(bf16_t h) { return __uint_as_float(((unsigned)h) << 16); }
__device__ __forceinline__ float bflo(unsigned u) { return __uint_as_float(u << 16); }
__device__ __forceinline__ float bfhi(unsigned u) { return __uint_as_float(u & 0xffff0000u); }
__device__ __forceinline__ unsigned pack2(float a, float b) { const f32x2 v = {a, b}; const hwbf2 r = __builtin_convertvector(v, hwbf2); return __builtin_bit_cast(unsigned, r); }
__device__ __forceinline__ float wave_sum(float v) {
#pragma unroll
    for (int o = 32; o; o >>= 1) v += __shfl_xor(v, o);
    return v;
}
__device__ __forceinline__ float wave_max(float v) {
#pragma unroll
    for (int o = 32; o; o >>= 1) v = fmaxf(v, __shfl_xor(v, o));
    return v;
}
__device__ __forceinline__ int tid_opaque() { int t = threadIdx.x; asm volatile("" : "+v"(t)); return t; }
__device__ __forceinline__ float gelu_tanh(float x) { return 0.5f * x * (1.0f + tanhf(0.7978845608028654f * (x + 0.044715f * x * x * x))); }
__device__ __forceinline__ float silu(float x) { return x / (1.0f + __expf(-x)); }
__device__ __forceinline__ float sigmoidf(float x) { return 1.0f / (1.0f + __expf(-x)); }
__device__ __forceinline__ float softplusf(float x) { return x > 20.f ? x : log1pf(__expf(x)); }

__device__ __forceinline__ int inproj_src(int n) {
    if (n < 1280) return n;
    if (n < 1792) return 1304 + (n - 1280);
    if (n < 2816) return 1816 + (n - 1792);
    if (n < 2840) return 1280 + (n - 2816);
    if (n < 2848) return 2840 + (n - 2840);
    return -1;
}
__device__ __forceinline__ void d_transpose_w(const float* __restrict__ W, bf16_t* __restrict__ Wt, int K, int N, int mode, int nbx, int vb, char* lds) {
    const int tid_ = tid_opaque(); const int half = tid_ >> 8, t256 = tid_ & 255, tile = vb * 2 + half;
    float (*t)[33] = (float (*)[33])(lds + half * 4352);
    const int n0 = (tile % nbx) * 32, k0 = (tile / nbx) * 32, tx = t256 & 31, ty = t256 >> 5;
#pragma unroll
    for (int i = 0; i < 4; ++i) {
        const int k = k0 + ty + 8 * i, n = n0 + tx;
        const int src = mode == 1 ? inproj_src(n) : n;
        t[ty + 8 * i][tx] = (src >= 0 && src < N) ? W[(size_t)k * N + src] : 0.f;
    }
    __syncthreads();
#pragma unroll
    for (int i = 0; i < 4; ++i) Wt[(size_t)(n0 + ty + 8 * i) * K + k0 + tx] = f2bf(t[tx][ty + 8 * i]);
    __syncthreads();
}
__device__ __forceinline__ void d_convert_bf16(const float* __restrict__ in, bf16_t* __restrict__ out, size_t n8, int vb, int nvb) {
    size_t i = (size_t)vb * 512 + tid_opaque();
    const size_t stride = (size_t)nvb * 512;
    for (; i < n8; i += stride) {
        const f32x4 a = ((const f32x4*)in)[2 * i], b = ((const f32x4*)in)[2 * i + 1];
        u32x4 o; o.x = pack2(a.x, a.y); o.y = pack2(a.z, a.w); o.z = pack2(b.x, b.y); o.w = pack2(b.z, b.w);
        ((u32x4*)out)[i] = o;
    }
}
__device__ __forceinline__ void d_mod(const float* __restrict__ c, const float* __restrict__ w_ada, const float* __restrict__ b_ada, float* __restrict__ mod, int vb, char* lds) {
    float (*part)[8][64] = (float (*)[8][64])lds;
    const int tid = tid_opaque(), jl = tid & 63, kq = tid >> 6, j = vb * 64 + jl;
    float acc[8];
#pragma unroll
    for (int b = 0; b < 8; ++b) acc[b] = 0.f;
    for (int k0 = kq * 128; k0 < kq * 128 + 128; k0 += 16) {
        float wv[16];
#pragma unroll
        for (int i = 0; i < 16; ++i) wv[i] = w_ada[(size_t)(k0 + i) * 6144 + j];
#pragma unroll
        for (int i = 0; i < 16; ++i)
#pragma unroll
            for (int b = 0; b < 8; ++b) acc[b] += c[b * 1024 + k0 + i] * wv[i];
    }
#pragma unroll
    for (int b = 0; b < 8; ++b) part[kq][b][jl] = acc[b];
    __syncthreads();
    {
        const int b = tid >> 6, jj = tid & 63;
        float s = b_ada[vb * 64 + jj];
#pragma unroll
        for (int q = 0; q < 8; ++q) s += part[q][b][jj];
        mod[b * 6144 + vb * 64 + jj] = s;
    }
    __syncthreads();
}
__device__ __forceinline__ void d_rope_table(float2* __restrict__ rope, int vb) {
    const int i = vb * 512 + tid_opaque();
    if (i >= SEQ * 8) return;
    const int pos = i >> 3, f = i & 7;
    const double inv = pow(500000.0, -(double)f / 8.0);
    const double ang = (double)pos * inv;
    rope[i] = make_float2((float)cos(ang), (float)sin(ang));
}
__device__ __forceinline__ void d_bias1(const float* __restrict__ pe_k, const float* __restrict__ w1_k, const float* __restrict__ pe_v, const float* __restrict__ w1_v, float* __restrict__ bias1) {
    const int tid_ = tid_opaque(); const int which = tid_ >> 8, j = tid_ & 255;
    const float* pe = which ? pe_v : pe_k; const float* w1 = which ? w1_v : w1_k;
    float a = 0.f;
    for (int k0 = 0; k0 < 2048; k0 += 16) {
        float wv[16];
#pragma unroll
        for (int i = 0; i < 16; ++i) wv[i] = w1[(size_t)(k0 + i) * 256 + j];
#pragma unroll
        for (int i = 0; i < 16; ++i) a += pe[k0 + i] * wv[i];
    }
    bias1[which * 256 + j] = a;
}

__device__ __forceinline__ void d_norm_mod(const float* __restrict__ x, const float* __restrict__ w, const float* __restrict__ mod, int sh_off, int sc_off, bf16_t* __restrict__ out, int vb) {
    const int tid_ = tid_opaque(); const int lane = tid_ & 63, wid = tid_ >> 6;
    const size_t row0 = (size_t)vb * 32 + wid * 4; const int b = (int)(row0 >> 13);
    f32x4 v[4][4];
#pragma unroll
    for (int r = 0; r < 4; ++r)
#pragma unroll
        for (int k = 0; k < 4; ++k) v[r][k] = *(const f32x4*)(x + (row0 + r) * DM + k * 256 + lane * 4);
    float rs[4];
#pragma unroll
    for (int r = 0; r < 4; ++r) {
        float ss = 0.f;
#pragma unroll
        for (int k = 0; k < 4; ++k) ss += v[r][k].x * v[r][k].x + v[r][k].y * v[r][k].y + v[r][k].z * v[r][k].z + v[r][k].w * v[r][k].w;
        rs[r] = rsqrtf(wave_sum(ss) * (1.0f / DM) + EPS);
    }
#pragma unroll
    for (int k = 0; k < 4; ++k) {
        const int col = k * 256 + lane * 4;
        const f32x4 wv = *(const f32x4*)(w + col), sc = *(const f32x4*)(mod + b * 6144 + sc_off + col), sh = *(const f32x4*)(mod + b * 6144 + sh_off + col);
        const f32x4 ws = wv * (sc + 1.0f);
#pragma unroll
        for (int r = 0; r < 4; ++r) {
            const f32x4 y = v[r][k] * rs[r] * ws + sh;
            u32x2 o; o.x = pack2(y.x, y.y); o.y = pack2(y.z, y.w);
            *(u32x2*)(out + (row0 + r) * DM + col) = o;
        }
    }
}

namespace pg8 {
#define PG8_LAS __attribute__((address_space(3)))
constexpr int BM = 256, BK = 64, HALF = 128, HTB = HALF * BK * 2  , STAGE_BYTES = 8 * HTB, NXCD = 8, WGM = 8;
__host__ __device__ __forceinline__ int lds_byte(int r, int c) { const int st = (r >> 4) * 2 + (c >> 5), rr = r & 15, cc = c & 31, ob = rr * 64 + cc * 2; return st * 1024 + (ob ^ (((ob >> 9) & 1) << 5)); }
__host__ __device__ __forceinline__ void stage_rc(int b, int& R, int& C) { const int st = b / 1024, sb = b % 1024, swz = sb ^ (((sb >> 9) & 1) << 5); R = (st >> 1) * 16 + swz / 64; C = (st & 1) * 32 + (swz % 64) / 2; }
struct Unit { int pm, pn; };
struct Gemm { const bf16_t* A; const bf16_t* Bt; int M, N, K, lda; };
struct StaticOrder {
    int nM, nN, nwg, G, c;
    __host__ __device__ void init(int M, int N, int G_, int c_) { nM = M / BM; nN = N / BM; nwg = nM * nN; G = G_; c = c_; }
    __host__ __device__ bool next(int i, Unit& u) const {
        const long L = (long)i * G + c; if (L >= nwg) return false;
        int wgid = (int)L; { const int q = nwg / NXCD, r = nwg % NXCD, xcd = wgid % NXCD, off = wgid / NXCD; wgid = (xcd < r ? xcd * (q + 1) : r * (q + 1) + (xcd - r) * q) + off; }
        const int nig = WGM * nN, gid = wgid / nig, fm = gid * WGM, gsz = (nM - fm) < WGM ? (nM - fm) : WGM;
        u.pm = fm + ((wgid % nig) % gsz); u.pn = (wgid % nig) / gsz; return true;
    }
};
template <class F> struct Epi {
    F f;
    __device__ __forceinline__ void operator()(const f32x4 (&acc)[2][2][4][2], const Unit& u, int wr, int wc, int fr, int fq) const {
#pragma unroll
        for (int ai = 0; ai < 2; ++ai)
#pragma unroll
            for (int m = 0; m < 4; ++m)
#pragma unroll
                for (int bj = 0; bj < 2; ++bj)
#pragma unroll
                    for (int n = 0; n < 2; ++n)
                        f(u.pm * BM + ai * HALF + wr * 64 + m * 16 + fr, u.pn * BM + bj * HALF + wc * 32 + n * 16 + 4 * fq, acc[ai][bj][m][n]);
    }
};
template <class E, class Sched>
__device__ __forceinline__ void gemm_phase(PG8_LAS unsigned char* lds, const Gemm g, const Sched& S, const E& Ep) {
    const int tid = tid_opaque(), wid = __builtin_amdgcn_readfirstlane(tid >> 6), lane = tid & 63, wr = wid >> 2, wc = wid & 3, fr = lane & 15, fq = lane >> 4;
    const int K = g.K, nt = K / BK;
    unsigned voffA[2], voffB[2];
#pragma unroll
    for (int i = 0; i < 2; ++i) { int R, C; stage_rc(tid * 16 + i * 8192, R, C); voffA[i] = (unsigned)(R * g.lda + C) * 2u; voffB[i] = (unsigned)(R * K + C) * 2u; }
    const size_t kstep = (size_t)(BK * 2);
    const size_t hstep = (size_t)HALF * K * 2, hstepA = (size_t)HALF * g.lda * 2;
    const size_t tstep = 2 * hstep, tstepA = 2 * hstepA;
    const unsigned ldsw = (unsigned)wid * 1024u;
    const int aoff = lds_byte(wr * 64 + fr, fq * 8), boff = lds_byte(wc * 32 + fr, fq * 8);
#define PG8_SA(b, h) (((b) * 2 + (h)) * HTB)
#define PG8_SB(b, h) ((4 + (b) * 2 + (h)) * HTB)
#define PG8_STAGE(bufoff, gbase, voff) do { _Pragma("unroll") for (int _i = 0; _i < 2; ++_i) \
        __builtin_amdgcn_global_load_lds((const unsigned*)((const char*)(gbase) + (voff)[_i]), (PG8_LAS unsigned*)(lds + (bufoff) + ldsw + _i * 8192), 16, 0, 0); } while (0)
#define PG8_LDA(dst, b, h) do { _Pragma("unroll") for (int m = 0; m < 4; ++m) _Pragma("unroll") for (int k = 0; k < 2; ++k) dst[m][k] = *(const PG8_LAS bf16x8*)(lds + PG8_SA(b, h) + aoff + m * 2048 + k * 1024); } while (0)
#define PG8_LDB(dst, b, h) do { _Pragma("unroll") for (int n = 0; n < 2; ++n) _Pragma("unroll") for (int k = 0; k < 2; ++k) dst[n][k] = *(const PG8_LAS bf16x8*)(lds + PG8_SB(b, h) + boff + n * 2048 + k * 1024); } while (0)
#define PG8_MMA(ai, bj, At, Bt) do { __builtin_amdgcn_s_setprio(1); _Pragma("unroll") for (int m = 0; m < 4; ++m) _Pragma("unroll") for (int n = 0; n < 2; ++n) _Pragma("unroll") for (int k = 0; k < 2; ++k) \
        acc[ai][bj][m][n] = __builtin_amdgcn_mfma_f32_16x16x32_bf16(Bt[n][k], At[m][k], acc[ai][bj][m][n], 0, 0, 0); __builtin_amdgcn_s_setprio(0); } while (0)
#define PG8_WAIT_V(n) asm volatile("s_waitcnt vmcnt(" #n ")" ::: "memory")
#define PG8_WAIT_L(n) asm volatile("s_waitcnt lgkmcnt(" #n ")" ::: "memory")
#define PG8_BAR __builtin_amdgcn_s_barrier()
#define PG8_SCHED __builtin_amdgcn_sched_barrier(0)
    Unit cur, nxt; int ui = 0;
    if (!S.next(0, cur)) return;
    f32x4 acc[2][2][4][2];
#pragma unroll
    for (int a = 0; a < 2; ++a)
#pragma unroll
        for (int b = 0; b < 2; ++b)
#pragma unroll
            for (int m = 0; m < 4; ++m)
#pragma unroll
                for (int n = 0; n < 2; ++n) acc[a][b][m][n] = (f32x4){0.f, 0.f, 0.f, 0.f};
    bf16x8 At[4][2], B0[2][2], B1[2][2];
    const char* cA = (const char*)g.A + (size_t)cur.pm * tstepA; const char* cB = (const char*)g.Bt + (size_t)cur.pn * tstep;
    PG8_STAGE(PG8_SB(0, 0), cB, voffB); PG8_STAGE(PG8_SB(0, 1), cB + hstep, voffB); PG8_STAGE(PG8_SA(0, 0), cA, voffA); PG8_STAGE(PG8_SA(0, 1), cA + hstepA, voffA);
    if (wr == 1) PG8_BAR;
    PG8_WAIT_V(2); PG8_BAR;
    PG8_STAGE(PG8_SB(1, 0), cB + kstep, voffB); PG8_STAGE(PG8_SA(1, 0), cA + kstep, voffA); PG8_STAGE(PG8_SB(1, 1), cB + hstep + kstep, voffB);
    PG8_WAIT_V(6); PG8_BAR;
    for (;;) {
        const bool has_next = S.next(ui + 1, nxt);
        const char* nA = has_next ? (const char*)g.A + (size_t)nxt.pm * tstepA : cA; const char* nB = has_next ? (const char*)g.Bt + (size_t)nxt.pn * tstep : cB;
        for (int t = 0; t < nt; t += 2) {
            const bool last = (t == nt - 2);
            const char* a1 = cA + (size_t)(t + 1) * kstep;
            const char* a2 = last ? nA : cA + (size_t)(t + 2) * kstep; const char* b2 = last ? nB : cB + (size_t)(t + 2) * kstep;
            const char* a3 = a2 + kstep; const char* b3 = b2 + kstep;
            PG8_LDB(B0, 0, 0); PG8_LDB(B1, 0, 1); PG8_SCHED; PG8_LDA(At, 0, 0); PG8_STAGE(PG8_SA(1, 1), a1 + hstepA, voffA);
            PG8_WAIT_V(8); PG8_WAIT_L(0); PG8_BAR; PG8_MMA(0, 0, At, B0); PG8_MMA(0, 1, At, B1); PG8_BAR; PG8_SCHED;
            PG8_LDA(At, 0, 1); PG8_STAGE(PG8_SB(0, 0), b2, voffB); PG8_STAGE(PG8_SB(0, 1), b2 + hstep, voffB); PG8_STAGE(PG8_SA(0, 0), a2, voffA);
            PG8_WAIT_V(8); PG8_WAIT_L(0); PG8_BAR; PG8_MMA(1, 0, At, B0); PG8_MMA(1, 1, At, B1); PG8_BAR; PG8_SCHED;
            PG8_LDB(B0, 1, 0); PG8_LDB(B1, 1, 1); PG8_SCHED; PG8_LDA(At, 1, 0); PG8_STAGE(PG8_SA(0, 1), a2 + hstepA, voffA);
            PG8_WAIT_V(8); PG8_WAIT_L(0); PG8_BAR; PG8_MMA(0, 0, At, B0); PG8_MMA(0, 1, At, B1); PG8_BAR; PG8_SCHED;
            PG8_LDA(At, 1, 1); PG8_STAGE(PG8_SB(1, 0), b3, voffB); PG8_STAGE(PG8_SB(1, 1), b3 + hstep, voffB); PG8_STAGE(PG8_SA(1, 0), a3, voffA);
            PG8_WAIT_V(8); PG8_WAIT_L(0); PG8_BAR; PG8_MMA(1, 0, At, B0); PG8_MMA(1, 1, At, B1); PG8_BAR; PG8_SCHED;
        }
        if (wr == 0) PG8_BAR;
        Ep(acc, cur, wr, wc, fr, fq);
        if (!has_next) break;
#pragma unroll
        for (int a = 0; a < 2; ++a)
#pragma unroll
            for (int b = 0; b < 2; ++b)
#pragma unroll
                for (int m = 0; m < 4; ++m)
#pragma unroll
                    for (int n = 0; n < 2; ++n) acc[a][b][m][n] = (f32x4){0.f, 0.f, 0.f, 0.f};
        cur = nxt; cA = nA; cB = nB; ++ui;
        if (wr == 1) PG8_BAR;
    }
    PG8_WAIT_V(0);
    PG8_BAR;
#undef PG8_SA
#undef PG8_SB
#undef PG8_STAGE
#undef PG8_LDA
#undef PG8_LDB
#undef PG8_MMA
#undef PG8_WAIT_V
#undef PG8_WAIT_L
#undef PG8_BAR
#undef PG8_SCHED
}
}

struct EpInProj { bf16_t* proj; bf16_t* qrope; bf16_t* kvp; float* small; const float2* rope; const float* dt_bias;
    __device__ __forceinline__ void operator()(int m, int n0, f32x4 v) const {
        if (n0 < 2816) {
            const bool is_q = n0 < 512;
            const bool roped_seg = is_q || (n0 >= C_KSEL && n0 < C_VSEL) || (n0 >= C_KWIN && n0 < C_VWIN);
            const bool rope_dims = roped_seg && ((n0 & 63) < 16);
            u32x2 raw; raw.x = pack2(v.x, v.y); raw.y = pack2(v.z, v.w);
            if (is_q) *(u32x2*)(proj + (size_t)m * PROJ_LD + n0) = raw;
            if (rope_dims) {
                f32x4 p; p.x = __shfl_xor(v.x, 32); p.y = __shfl_xor(v.y, 32); p.z = __shfl_xor(v.z, 32); p.w = __shfl_xor(v.w, 32);
                const int i0 = n0 & 15, pos = m & (SEQ - 1);
                const float sgn = i0 < 8 ? -1.f : 1.f;
                const float2* rp = rope + pos * 8 + (i0 & 7);
                const float2 c0 = rp[0], c1 = rp[1], c2 = rp[2], c3 = rp[3];
                v.x = v.x * c0.x + sgn * p.x * c0.y; v.y = v.y * c1.x + sgn * p.y * c1.y;
                v.z = v.z * c2.x + sgn * p.z * c2.y; v.w = v.w * c3.x + sgn * p.w * c3.y;
            }
            u32x2 o; o.x = pack2(v.x, v.y); o.y = pack2(v.z, v.w);
            if (is_q) *(u32x2*)(qrope + (size_t)m * 512 + n0) = o;
            else if (n0 < C_Z) {
                const int r = n0 - C_KCMP, seg = r >> 7, g = (r >> 6) & 1, d = r & 63, bb = m >> 13, t = m & (SEQ - 1);
                *(u32x2*)(kvp + (size_t)seg * KVP_SEG + ((size_t)(bb * 2 + g) * SEQ + t) * 64 + d) = o;
            }
            else *(u32x2*)(proj + (size_t)m * PROJ_LD + n0) = o;
        } else if (n0 < 2848) {
            const int c = n0 - 2816; f32x4 o;
            if (c < 24) { o.x = sigmoidf(v.x); o.y = sigmoidf(v.y); o.z = sigmoidf(v.z); o.w = sigmoidf(v.w); }
            else { const float* db = dt_bias + (c - 24); o.x = softplusf(v.x + db[0]); o.y = softplusf(v.y + db[1]); o.z = softplusf(v.z + db[2]); o.w = softplusf(v.w + db[3]); }
            *(f32x4*)(small + (size_t)m * 32 + c) = o;
        }
    } };
struct EpCmpHid { bf16_t* hid; const float* bias;
    __device__ __forceinline__ void operator()(int m, int n0, f32x4 v) const {
        const f32x4 b = *(const f32x4*)(bias + n0);
        u32x2 o; o.x = pack2(gelu_tanh(v.x + b.x), gelu_tanh(v.y + b.y)); o.y = pack2(gelu_tanh(v.z + b.z), gelu_tanh(v.w + b.w));
        *(u32x2*)(hid + (size_t)m * 256 + n0) = o;
    } };
struct EpOutProj { const float* x; const float* mod; float* x1;
    __device__ __forceinline__ void operator()(int m, int n0, f32x4 v) const {
        const int b = m >> 13;
        const f32x4 xv = *(const f32x4*)(x + (size_t)m * DM + n0);
        const f32x4 g = *(const f32x4*)(mod + b * 6144 + 2048 + n0);
        f32x4 o; o.x = xv.x + g.x * v.x; o.y = xv.y + g.y * v.y; o.z = xv.z + g.z * v.z; o.w = xv.w + g.w * v.w;
        *(f32x4*)(x1 + (size_t)m * DM + n0) = o;
    } };
struct EpStoreBf16 { bf16_t* out; int ld; int pad;
    __device__ __forceinline__ void operator()(int m, int n0, f32x4 v) const {
        u32x2 o; o.x = pack2(v.x, v.y); o.y = pack2(v.z, v.w);
        *(u32x2*)(out + (size_t)m * ld + n0) = o;
    } };

__device__ __forceinline__ void d_cmp_out(const bf16_t* __restrict__ hid, const float* __restrict__ w2, bf16_t* __restrict__ out, int vb) {
    const int tid_ = tid_opaque(); const int m = vb * 8 + (tid_ >> 6), d = tid_ & 63;
    float a = 0.f;
#pragma unroll 8
    for (int j = 0; j < 256; ++j) a += bf2f(hid[(size_t)m * 256 + j]) * w2[j * 64 + d];
    out[(size_t)m * 64 + d] = f2bf(a);
}

#define KLD 80
#define NSA_OFF_KS0  0
#define NSA_OFF_VT0  10240
#define NSA_OFF_KS1  20480
#define NSA_OFF_VT1  30720
#define NSA_OFF_IMP  40960
#define NSA_OFF_SELW 74752
#define NSA_OFF_ANYW 75776
#define NSA_OFF_BL   75808
#define NSA_OFF_QS   76352
#define NSA_LDS      (76352 + 8 * 32 * KLD * 2)
#define SM_C 0.18033688011112042f

struct KVStage { u32x4 k, v; };
__device__ __forceinline__ void nsa_stage_load(KVStage& st, const bf16_t* kb, const bf16_t* vb, int tid) {
    st.k = *(const u32x4*)(kb + tid * 8); st.v = *(const u32x4*)(vb + tid * 8);
}
__device__ __forceinline__ void nsa_stage_store(bf16_t* Ks, bf16_t* Vt, int tid, const KVStage& st) {
    const int r = tid >> 3, c = tid & 7;
    *(u32x4*)(Ks + r * KLD + c * 8) = st.k;
    *(u32x4*)(Vt + r * KLD + c * 8) = st.v;
}
__device__ __forceinline__ void nsa_load_q(const bf16_t* qsrc, size_t ld, int lane, bf16_t* Qs) {
    u32x4 r[4];
#pragma unroll
    for (int i = 0; i < 4; ++i) { const int p = lane + 64 * i; r[i] = *(const u32x4*)(qsrc + (size_t)(p >> 3) * ld + (p & 7) * 8); }
#pragma unroll
    for (int i = 0; i < 4; ++i) { const int p = lane + 64 * i; *(u32x4*)(Qs + (p >> 3) * KLD + (p & 7) * 8) = r[i]; }
}
__device__ __forceinline__ void nsa_qk(const bf16_t* Ks, const bf16_t* Qs, f32x4 (&s)[4][2], int fr, int fq) {
#pragma unroll
    for (int kt = 0; kt < 4; ++kt)
#pragma unroll
        for (int tt = 0; tt < 2; ++tt) s[kt][tt] = (f32x4){0.f, 0.f, 0.f, 0.f};
#pragma unroll
    for (int ks = 0; ks < 2; ++ks) {
        bf16x8 qf[2];
#pragma unroll
        for (int tt = 0; tt < 2; ++tt) qf[tt] = *(const bf16x8*)(Qs + (tt * 16 + fr) * KLD + ks * 32 + fq * 8);
#pragma unroll
        for (int kt = 0; kt < 4; ++kt) {
            const bf16x8 kf = *(const bf16x8*)(Ks + (kt * 16 + fr) * KLD + ks * 32 + fq * 8);
#pragma unroll
            for (int tt = 0; tt < 2; ++tt) s[kt][tt] = __builtin_amdgcn_mfma_f32_16x16x32_bf16(kf, qf[tt], s[kt][tt], 0, 0, 0);
        }
    }
}
__device__ __forceinline__ void nsa_pv(const bf16_t* Vt, const f32x4 (&p)[4][2], f32x4 (&o)[4][2], int fr, int fq) {
#pragma unroll
    for (int ks2 = 0; ks2 < 2; ++ks2) {
        bf16x8 pf[2];
#pragma unroll
        for (int tt = 0; tt < 2; ++tt) {
            const f32x4 a = p[2 * ks2][tt], b = p[2 * ks2 + 1][tt];
            u32x4 w; w.x = pack2(a.x, a.y); w.y = pack2(a.z, a.w); w.z = pack2(b.x, b.y); w.w = pack2(b.z, b.w);
            pf[tt] = __builtin_bit_cast(bf16x8, w);
        }
#pragma unroll
        for (int dt = 0; dt < 4; ++dt) {
            typedef short s16x4 __attribute__((ext_vector_type(4)));
            const bf16_t* vp = Vt + (ks2 * 32 + 4 * fq + (fr >> 2)) * KLD + dt * 16 + 4 * (fr & 3);
            const s16x4 a0 = __builtin_amdgcn_ds_read_tr16_b64_v4i16((__attribute__((address_space(3))) s16x4*)vp);
            const s16x4 a1 = __builtin_amdgcn_ds_read_tr16_b64_v4i16((__attribute__((address_space(3))) s16x4*)(vp + 16 * KLD));
            const bf16x8 vf = (bf16x8){a0.x, a0.y, a0.z, a0.w, a1.x, a1.y, a1.z, a1.w};
#pragma unroll
            for (int tt = 0; tt < 2; ++tt) o[dt][tt] = __builtin_amdgcn_mfma_f32_16x16x32_bf16(vf, pf[tt], o[dt][tt], 0, 0, 0);
        }
    }
}
template <int MK>
__device__ __forceinline__ bool nsa_valid(int kk, int ti, int n0, int t0) {
    if (MK == 1) return kk <= ti;
    if (MK == 2) return kk > ti;
    return 16 * (n0 + kk) + 31 <= t0 + ti;
}
template <int MK, bool WITH_O>
__device__ __forceinline__ void nsa_softmax(f32x4 (&s)[4][2], float (&m)[2], float (&l)[2], f32x4 (&o)[4][2], const bool (&selb)[2], int tib, int fq, int n0, int t0) {
#pragma unroll
    for (int tt = 0; tt < 2; ++tt) {
        const int ti = tib + tt * 16;
        float mx = -1e30f;
#pragma unroll
        for (int kt = 0; kt < 4; ++kt)
#pragma unroll
            for (int jj = 0; jj < 4; ++jj) {
                const int kk = kt * 16 + 4 * fq + jj;
                const bool v = selb[tt] && nsa_valid<MK>(kk, ti, n0, t0);
                const float sv = v ? s[kt][tt][jj] * SM_C : -1e30f;
                s[kt][tt][jj] = sv; mx = fmaxf(mx, sv);
            }
        mx = fmaxf(mx, __shfl_xor(mx, 16)); mx = fmaxf(mx, __shfl_xor(mx, 32));
        const float mn = fmaxf(m[tt], mx);
        const float alpha = __builtin_amdgcn_exp2f(m[tt] - mn);
        m[tt] = mn;
        float ls = 0.f;
#pragma unroll
        for (int kt = 0; kt < 4; ++kt)
#pragma unroll
            for (int jj = 0; jj < 4; ++jj) {
                const float sv = s[kt][tt][jj];
                const float pv = sv > -1e29f ? __builtin_amdgcn_exp2f(sv - mn) : 0.f;
                s[kt][tt][jj] = pv; ls += pv;
            }
        l[tt] = l[tt] * alpha + ls;
        if (WITH_O) {
#pragma unroll
            for (int dt = 0; dt < 4; ++dt) o[dt][tt] *= alpha;
        }
    }
}
__device__ __forceinline__ void nsa_softmax_fast(f32x4 (&s)[4][2], float (&m)[2], float (&l)[2], f32x4 (&o)[4][2], const float (&bias)[2]) {
#pragma unroll
    for (int tt = 0; tt < 2; ++tt) {
        float mr = fmaxf(fmaxf(s[0][tt][0], s[0][tt][1]), fmaxf(s[0][tt][2], s[0][tt][3]));
#pragma unroll
        for (int kt = 1; kt < 4; ++kt) mr = fmaxf(mr, fmaxf(fmaxf(s[kt][tt][0], s[kt][tt][1]), fmaxf(s[kt][tt][2], s[kt][tt][3])));
        mr = fmaxf(mr, __shfl_xor(mr, 16)); mr = fmaxf(mr, __shfl_xor(mr, 32));
        const float mx = mr * SM_C + bias[tt];
        const float mold = m[tt], mn = fmaxf(mold, mx);
        m[tt] = mn;
        const float off = bias[tt] - mn;
        float ls = 0.f;
#pragma unroll
        for (int kt = 0; kt < 4; ++kt)
#pragma unroll
            for (int jj = 0; jj < 4; ++jj) { const float pv = __builtin_amdgcn_exp2f(__builtin_fmaf(s[kt][tt][jj], SM_C, off)); s[kt][tt][jj] = pv; ls += pv; }
        if (__builtin_amdgcn_ballot_w64(mn > mold) != 0ull) {
            const float alpha = __builtin_amdgcn_exp2f(mold - mn);
            l[tt] = l[tt] * alpha + ls;
#pragma unroll
            for (int dt = 0; dt < 4; ++dt) o[dt][tt] *= alpha;
        } else l[tt] += ls;
    }
}
__device__ __forceinline__ void ins16(unsigned (&L)[16], unsigned x) {
#pragma unroll
    for (int i = 0; i < 16; ++i) { const unsigned hi = L[i] > x ? L[i] : x; x = L[i] > x ? x : L[i]; L[i] = hi; }
}
__device__ __forceinline__ void merge16(unsigned (&L)[16], const unsigned (&P)[16]) {
#pragma unroll
    for (int i = 0; i < 16; ++i) L[i] = L[i] > P[15 - i] ? L[i] : P[15 - i];
#pragma unroll
    for (int st = 8; st >= 1; st >>= 1)
#pragma unroll
        for (int i = 0; i < 16; ++i)
            if ((i & st) == 0) { const unsigned a = L[i], b = L[i + st]; L[i] = a > b ? a : b; L[i + st] = a > b ? b : a; }
}
template <bool ACCUM>
__device__ __forceinline__ void nsa_emit(const f32x4 (&o)[4][2], const float (&l)[2], bool l_is_partial, const float* gsrc, float* obase, int tib, int fq) {
#pragma unroll
    for (int tt = 0; tt < 2; ++tt) {
        float lt = l[tt];
        if (l_is_partial) { lt += __shfl_xor(lt, 16); lt += __shfl_xor(lt, 32); }
        const int ti = tib + tt * 16;
        const float gv = gsrc[(size_t)ti * 32];
        const float sc = l_is_partial ? (lt > 0.f ? gv / lt : 0.f) : gv;
#pragma unroll
        for (int dt = 0; dt < 4; ++dt) {
            float* op = obase + (size_t)ti * 512 + dt * 16 + 4 * fq;
            f32x4 v = o[dt][tt] * sc;
            if (ACCUM) v += *(const f32x4*)op;
            *(f32x4*)op = v;
        }
    }
}
struct NsaBufs { bf16_t *Ks0, *Vt0, *Ks1, *Vt1; };
template <class SRC, class BODY>
__device__ __forceinline__ void nsa_pipeline(int n, const bf16_t* kb, const bf16_t* vb, const NsaBufs& B, int tid, SRC src, BODY body) {
    KVStage s0, s1;
    nsa_stage_load(s0, kb + (size_t)src(0) * 4096, vb + (size_t)src(0) * 4096, tid);
    s1 = s0;
    if (n > 1) nsa_stage_load(s1, kb + (size_t)src(1) * 4096, vb + (size_t)src(1) * 4096, tid);
    __syncthreads();
    nsa_stage_store(B.Ks0, B.Vt0, tid, s0);
    if (n > 2) nsa_stage_load(s0, kb + (size_t)src(2) * 4096, vb + (size_t)src(2) * 4096, tid);
#pragma unroll 1
    for (int i = 0; i < n; i += 2) {
        __syncthreads();
        if (i + 1 < n) nsa_stage_store(B.Ks1, B.Vt1, tid, s1);
        if (i + 3 < n) nsa_stage_load(s1, kb + (size_t)src(i + 3) * 4096, vb + (size_t)src(i + 3) * 4096, tid);
        body(src(i), B.Ks0, B.Vt0);
        if (i + 1 < n) {
            __syncthreads();
            if (i + 2 < n) nsa_stage_store(B.Ks0, B.Vt0, tid, s0);
            if (i + 4 < n) nsa_stage_load(s0, kb + (size_t)src(i + 4) * 4096, vb + (size_t)src(i + 4) * 4096, tid);
            body(src(i + 1), B.Ks1, B.Vt1);
        }
    }
}

__device__ __forceinline__ void d_nsa_cmp(const bf16_t* __restrict__ proj, const bf16_t* __restrict__ kc, const bf16_t* __restrict__ vc,
                                          const float* __restrict__ small, float* __restrict__ onsa, unsigned* __restrict__ selrec, int b, int g, int qt, char* lds) {
    const NsaBufs B{(bf16_t*)(lds + NSA_OFF_KS0), (bf16_t*)(lds + NSA_OFF_VT0), (bf16_t*)(lds + NSA_OFF_KS1), (bf16_t*)(lds + NSA_OFF_VT1)};
    float* imp = (float*)(lds + NSA_OFF_IMP);
    unsigned* selw = (unsigned*)(lds + NSA_OFF_SELW);
    unsigned* anyw = (unsigned*)(lds + NSA_OFF_ANYW);
    int* blist = (int*)(lds + NSA_OFF_BL);
    const int tid = tid_opaque(), lane = tid & 63, w = tid >> 6, hd = w & 3, th = w >> 2, fr = lane & 15, fq = lane >> 4;
    const int tib = th * 32 + fr;
    const size_t tok0 = (size_t)b * SEQ + (size_t)qt * 64;
    const int t0 = qt * 64;
    const float* gbase = small + tok0 * 32 + g * 12 + hd * 3;
    float* obase = onsa + tok0 * 512 + g * 256 + hd * 64;
    const bool sel_all[2] = {true, true};
    const float bias0[2] = {0.f, 0.f};

    for (int i = tid; i < 64 * 132; i += 512) imp[i] = 0.f;
    if (tid < 4) anyw[tid] = 0u;

    bf16_t* Qs = (bf16_t*)(lds + NSA_OFF_QS) + w * 32 * KLD;
    f32x4 s[4][2], o[4][2];
    float m[2], l[2];

    nsa_load_q(proj + (tok0 + th * 32) * PROJ_LD + C_Q + g * 256 + hd * 64, PROJ_LD, lane, Qs);
    const int ncb = (4 * qt + 3 + 63) >> 6;
    {
        const bf16_t* kb = kc + (size_t)(b * 2 + g) * 512 * 64;
        const bf16_t* vb = vc + (size_t)(b * 2 + g) * 512 * 64;
#pragma unroll
        for (int tt = 0; tt < 2; ++tt) { m[tt] = -1e30f; l[tt] = 0.f; }
        nsa_pipeline(ncb, kb, vb, B, tid, [&](int i) { return i; }, [&](int blk_, bf16_t* Ks, bf16_t* Vt) {
            nsa_qk(Ks, Qs, s, fr, fq);
            nsa_softmax<3, false>(s, m, l, o, sel_all, tib, fq, blk_ * 64, t0);
        });
        float linv[2];
#pragma unroll
        for (int tt = 0; tt < 2; ++tt) { float lt = l[tt]; lt += __shfl_xor(lt, 16); lt += __shfl_xor(lt, 32); linv[tt] = lt > 0.f ? 1.0f / lt : 0.f; }
#pragma unroll
        for (int dt = 0; dt < 4; ++dt)
#pragma unroll
            for (int tt = 0; tt < 2; ++tt) o[dt][tt] = (f32x4){0.f, 0.f, 0.f, 0.f};
        nsa_pipeline(ncb, kb, vb, B, tid, [&](int i) { return i; }, [&](int blk_, bf16_t* Ks, bf16_t* Vt) {
            nsa_qk(Ks, Qs, s, fr, fq);
#pragma unroll
            for (int tt = 0; tt < 2; ++tt) {
                const int ti = tib + tt * 16;
#pragma unroll
                for (int kt = 0; kt < 4; ++kt) {
                    f32x4 pv;
#pragma unroll
                    for (int jj = 0; jj < 4; ++jj) {
                        const int kk = kt * 16 + 4 * fq + jj;
                        const bool v = nsa_valid<3>(kk, ti, blk_ * 64, t0);
                        pv[jj] = v ? __builtin_amdgcn_exp2f(s[kt][tt][jj] * SM_C - m[tt]) * linv[tt] : 0.f;
                    }
                    s[kt][tt] = pv;
                    const int j = blk_ * 16 + kt * 4 + fq;
                    atomicAdd(imp + ti * 132 + (j >> 5) * 33 + (j & 31), pv[0] + pv[1] + pv[2] + 0.5f * pv[3]);
                    if (j + 1 < 128) { const int j1 = j + 1; atomicAdd(imp + ti * 132 + (j1 >> 5) * 33 + (j1 & 31), 0.5f * pv[3]); }
                }
            }
            nsa_pv(Vt, s, o, fr, fq);
        });
        nsa_emit<false>(o, l, false, gbase + 0, obase, tib, fq);
    }
    __syncthreads();
    {
        const int ti = tid >> 3, q8 = tid & 7;
        unsigned L[16];
#pragma unroll
        for (int i = 0; i < 16; ++i) L[i] = 0u;
#pragma unroll
        for (int i = 0; i < 16; ++i) {
            const int j = q8 * 16 + i;
            const bool forced = (j == 0) || (j == qt) || (j == qt - 1);
            const float v = imp[ti * 132 + (j >> 5) * 33 + (j & 31)] + (forced ? 1e4f : 0.f) + 1e-30f;
            const unsigned x = (j <= qt) ? ((__float_as_uint(v) & ~0x7Fu) | (unsigned)(127 - j)) : 0u;
            ins16(L, x);
        }
#pragma unroll
        for (int r = 1; r <= 4; r <<= 1) {
            unsigned P[16];
#pragma unroll
            for (int i = 0; i < 16; ++i) P[i] = (unsigned)__shfl_xor((int)L[i], r);
            merge16(L, P);
        }
        if (q8 < 4) {
            unsigned word = 0u;
#pragma unroll
            for (int i = 0; i < 16; ++i) {
                const unsigned e = L[i];
                const int j = 127 - (int)(e & 0x7Fu);
                if (e != 0u && (j >> 5) == q8) word |= 1u << (j & 31);
            }
            selw[ti * 4 + q8] = word;
            atomicOr(&anyw[q8], word);
        }
    }
    __syncthreads();
    int nsel;
    {
        const unsigned a0 = anyw[0], a1 = anyw[1], a2 = anyw[2], a3 = anyw[3];
        if (tid < 128) {
            const unsigned wd = tid < 32 ? a0 : tid < 64 ? a1 : tid < 96 ? a2 : a3;
            if ((wd >> (tid & 31)) & 1u) {
                int pos = __popc(wd & ((1u << (tid & 31)) - 1u));
                if (tid >= 32) pos += __popc(a0);
                if (tid >= 64) pos += __popc(a1);
                if (tid >= 96) pos += __popc(a2);
                blist[pos] = tid;
            }
        }
        nsel = __builtin_amdgcn_readfirstlane(__popc(a0) + __popc(a1) + __popc(a2) + __popc(a3));
    }
    __syncthreads();
    if (tid < 256) selrec[tid] = selw[tid];
    if (tid < 128) selrec[256 + tid] = (unsigned)blist[tid];
    if (tid == 0) selrec[384] = (unsigned)nsel;
    __syncthreads();
}

__device__ __forceinline__ void d_nsa_attn(const bf16_t* __restrict__ qrope, const bf16_t* __restrict__ kvp, const float* __restrict__ small, float* __restrict__ onsa,
                                           const unsigned* __restrict__ selrec, int b, int g, int qt, char* lds) {
    const NsaBufs B{(bf16_t*)(lds + NSA_OFF_KS0), (bf16_t*)(lds + NSA_OFF_VT0), (bf16_t*)(lds + NSA_OFF_KS1), (bf16_t*)(lds + NSA_OFF_VT1)};
    unsigned* selw = (unsigned*)(lds + NSA_OFF_SELW);
    int* blist = (int*)(lds + NSA_OFF_BL);
    const int tid = tid_opaque(), lane = tid & 63, w = tid >> 6, hd = w & 3, th = w >> 2, fr = lane & 15, fq = lane >> 4;
    const int tib = th * 32 + fr;
    const size_t tok0 = (size_t)b * SEQ + (size_t)qt * 64;
    const float* gbase = small + tok0 * 32 + g * 12 + hd * 3;
    float* obase = onsa + tok0 * 512 + g * 256 + hd * 64;
    const bool sel_all[2] = {true, true};
    const float bias0[2] = {0.f, 0.f};
    bf16_t* Qs = (bf16_t*)(lds + NSA_OFF_QS) + w * 32 * KLD;
    f32x4 s[4][2], o[4][2];
    float m[2], l[2];
    if (tid < 256) selw[tid] = selrec[tid];
    if (tid < 128) blist[tid] = (int)selrec[256 + tid];
    const int nsel = __builtin_amdgcn_readfirstlane((int)selrec[384]);
    __syncthreads();
    nsa_load_q(qrope + (tok0 + th * 32) * 512 + g * 256 + hd * 64, 512, lane, Qs);
    {
        const bf16_t* kb = kvp + 2 * KVP_SEG + (size_t)(b * 2 + g) * SEQ * 64;
        const bf16_t* vb = kvp + 3 * KVP_SEG + (size_t)(b * 2 + g) * SEQ * 64;
#pragma unroll
        for (int tt = 0; tt < 2; ++tt) { m[tt] = -1e30f; l[tt] = 0.f; }
#pragma unroll
        for (int dt = 0; dt < 4; ++dt)
#pragma unroll
            for (int tt = 0; tt < 2; ++tt) o[dt][tt] = (f32x4){0.f, 0.f, 0.f, 0.f};
        nsa_pipeline(nsel, kb, vb, B, tid, [&](int i) { return __builtin_amdgcn_readfirstlane(blist[i]); }, [&](int blk_, bf16_t* Ks, bf16_t* Vt) {
            nsa_qk(Ks, Qs, s, fr, fq);
            bool selb[2];
#pragma unroll
            for (int tt = 0; tt < 2; ++tt) selb[tt] = (selw[(tib + tt * 16) * 4 + (blk_ >> 5)] >> (blk_ & 31)) & 1u;
            if (blk_ == qt) nsa_softmax<1, true>(s, m, l, o, selb, tib, fq, 0, 0);
            else {
                float bias[2];
#pragma unroll
                for (int tt = 0; tt < 2; ++tt) bias[tt] = selb[tt] ? 0.f : -1e30f;
                nsa_softmax_fast(s, m, l, o, bias);
            }
            nsa_pv(Vt, s, o, fr, fq);
        });
        nsa_emit<true>(o, l, true, gbase + 1, obase, tib, fq);
    }
    {
        const bf16_t* kb = kvp + 4 * KVP_SEG + (size_t)(b * 2 + g) * SEQ * 64;
        const bf16_t* vb = kvp + 5 * KVP_SEG + (size_t)(b * 2 + g) * SEQ * 64;
#pragma unroll
        for (int tt = 0; tt < 2; ++tt) { m[tt] = -1e30f; l[tt] = 0.f; }
#pragma unroll
        for (int dt = 0; dt < 4; ++dt)
#pragma unroll
            for (int tt = 0; tt < 2; ++tt) o[dt][tt] = (f32x4){0.f, 0.f, 0.f, 0.f};
        const int j0 = qt >= 8 ? qt - 8 : 0;
        nsa_pipeline(qt - j0 + 1, kb, vb, B, tid, [&](int i) { return j0 + i; }, [&](int blk_, bf16_t* Ks, bf16_t* Vt) {
            nsa_qk(Ks, Qs, s, fr, fq);
            if (blk_ == qt) nsa_softmax<1, true>(s, m, l, o, sel_all, tib, fq, 0, 0);
            else if (blk_ == qt - 8) nsa_softmax<2, true>(s, m, l, o, sel_all, tib, fq, 0, 0);
            else nsa_softmax_fast(s, m, l, o, bias0);
            nsa_pv(Vt, s, o, fr, fq);
        });
        nsa_emit<true>(o, l, true, gbase + 2, obase, tib, fq);
    }
    __syncthreads();
}

#define SSD_P 136
#define S3_XST 0
#define S3_BC  69632
#define S3_CC  104448
#define S3_ACS 139264
#define S3_DT  141312
#define S3_END 143360

__device__ __forceinline__ void ssd_acs(const float* __restrict__ small, const float* __restrict__ a_log, size_t tok0, int g, float* acs, float* dtl, int tid) {
    const int w = tid >> 6, lane = tid & 63, hh = 4 * g + (w & 3);
    if (w < 4) {
        const float a = -__expf(a_log[hh]);
        const float d0 = small[(tok0 + 2 * lane) * 32 + 24 + hh], d1 = small[(tok0 + 2 * lane + 1) * 32 + 24 + hh];
        const float s0 = d0 * a, s1 = s0 + d1 * a;
        float tot = s1;
#pragma unroll
        for (int off = 1; off < 64; off <<= 1) { const float t = __shfl_up(tot, off); if (lane >= off) tot += t; }
        const float excl = tot - s1;
        acs[w * 128 + 2 * lane] = excl + s0; acs[w * 128 + 2 * lane + 1] = excl + s1;
        dtl[w * 128 + 2 * lane] = d0; dtl[w * 128 + 2 * lane + 1] = d1;
    }
}
struct ConvCh { float w0, w1, w2, w3, bias, h0, h1, h2; };
__device__ __forceinline__ void conv_init(ConvCh& cc, const float* __restrict__ conv_w, const float* __restrict__ conv_b, int ch, const bf16_t* pb, int c) {
    cc.w0 = conv_w[ch]; cc.w1 = conv_w[1024 + ch]; cc.w2 = conv_w[2048 + ch]; cc.w3 = conv_w[3072 + ch]; cc.bias = conv_b[ch];
    if (c > 0) { cc.h0 = bf2f(pb[-3 * PROJ_LD]); cc.h1 = bf2f(pb[-2 * PROJ_LD]); cc.h2 = bf2f(pb[-1 * PROJ_LD]); } else { cc.h0 = 0.f; cc.h1 = 0.f; cc.h2 = 0.f; }
}
__device__ __forceinline__ float conv_step(ConvCh& cc, float x) {
    const float v = cc.bias + cc.w0 * cc.h0 + cc.w1 * cc.h1 + cc.w2 * cc.h2 + cc.w3 * x;
    cc.h0 = cc.h1; cc.h1 = cc.h2; cc.h2 = x;
    return silu(v);
}

__device__ __forceinline__ void d_ssd_states(const bf16_t* __restrict__ proj, const float* __restrict__ small, const float* __restrict__ conv_w, const float* __restrict__ conv_b,
                                             const float* __restrict__ a_log, float* __restrict__ states, float* __restrict__ cdec, int item, char* lds) {
    const int tid = tid_opaque(), lane = tid & 63, w = tid >> 6, fr = lane & 15, fq = lane >> 4;
    const int b = item >> 7, c = (item >> 1) & 63, g = item & 1;
    bf16_t* XwT = (bf16_t*)(lds + S3_XST); bf16_t* BcT = (bf16_t*)(lds + S3_BC);
    float* acs = (float*)(lds + S3_ACS); float* dtl = (float*)(lds + S3_DT);
    const size_t tok0 = (size_t)b * SEQ + (size_t)c * 128;
    ssd_acs(small, a_log, tok0, g, acs, dtl, tid);
    __syncthreads();
    if (tid < 384) {
        const bool isx = tid < 256;
        const int ch = isx ? g * 256 + tid : 512 + g * 128 + (tid - 256);
        const bf16_t* px = proj + tok0 * PROJ_LD + C_XBC + ch;
        ConvCh cx; conv_init(cx, conv_w, conv_b, ch, px, c);
        const int hw = w & 3;
        const float alast = acs[hw * 128 + 127];
        bf16_t* dst = isx ? XwT + tid * SSD_P : BcT + (tid - 256) * SSD_P;
        for (int l0 = 0; l0 < 128; l0 += 32) {
            float rx[32];
#pragma unroll
            for (int i = 0; i < 32; ++i) rx[i] = bf2f(px[(size_t)(l0 + i) * PROJ_LD]);
#pragma unroll
            for (int i8 = 0; i8 < 4; ++i8) {
                float ox[8];
#pragma unroll
                for (int i = 0; i < 8; ++i) {
                    const int l = l0 + i8 * 8 + i;
                    const float v = conv_step(cx, rx[i8 * 8 + i]);
                    ox[i] = isx ? v * dtl[hw * 128 + l] * __expf(alast - acs[hw * 128 + l]) : v;
                }
                u32x4 o; o.x = pack2(ox[0], ox[1]); o.y = pack2(ox[2], ox[3]); o.z = pack2(ox[4], ox[5]); o.w = pack2(ox[6], ox[7]);
                *(u32x4*)(dst + l0 + i8 * 8) = o;
            }
        }
    }
    __syncthreads();
    {
        const int hw = w & 3, nh = w >> 2;
        f32x4 acc[4][4];
#pragma unroll
        for (int pt = 0; pt < 4; ++pt)
#pragma unroll
            for (int nt = 0; nt < 4; ++nt) acc[pt][nt] = (f32x4){0.f, 0.f, 0.f, 0.f};
#pragma unroll 1
        for (int ks = 0; ks < 4; ++ks) {
            bf16x8 af[4], bfr[4];
#pragma unroll
            for (int pt = 0; pt < 4; ++pt) af[pt] = *(const bf16x8*)(XwT + (hw * 64 + pt * 16 + fr) * SSD_P + ks * 32 + fq * 8);
#pragma unroll
            for (int nt = 0; nt < 4; ++nt) bfr[nt] = *(const bf16x8*)(BcT + ((nh * 4 + nt) * 16 + fr) * SSD_P + ks * 32 + fq * 8);
#pragma unroll
            for (int pt = 0; pt < 4; ++pt)
#pragma unroll
                for (int nt = 0; nt < 4; ++nt) acc[pt][nt] = __builtin_amdgcn_mfma_f32_16x16x32_bf16(af[pt], bfr[nt], acc[pt][nt], 0, 0, 0);
        }
        const int hh = 4 * g + hw;
        float* sp = states + ((size_t)((b * 64 + c) * 8 + hh)) * 8192;
#pragma unroll
        for (int pt = 0; pt < 4; ++pt)
#pragma unroll
            for (int nt = 0; nt < 4; ++nt)
#pragma unroll
                for (int jj = 0; jj < 4; ++jj) sp[(pt * 16 + 4 * fq + jj) * 128 + (nh * 4 + nt) * 16 + fr] = acc[pt][nt][jj];
        if (lane == 0 && nh == 0) cdec[(b * 64 + c) * 8 + hh] = __expf(acs[hw * 128 + 127]);
    }
    __syncthreads();
}

__device__ __forceinline__ void d_ssd_scan(const float* __restrict__ states, const float* __restrict__ cdec, bf16_t* __restrict__ prev, int vb) {
    const int bh = vb >> 1, b = bh >> 3, hh = bh & 7;
    const size_t e0 = (size_t)((vb & 1) * 512 + tid_opaque()) * 8;
    f32x4 h0 = (f32x4){0.f, 0.f, 0.f, 0.f}, h1 = h0;
#pragma unroll 8
    for (int c = 0; c < 64; ++c) {
        const size_t base = ((size_t)((b * 64 + c) * 8 + hh)) * 8192 + e0;
        const f32x4 s0 = *(const f32x4*)(states + base), s1 = *(const f32x4*)(states + base + 4);
        const float d = cdec[(b * 64 + c) * 8 + hh];
        u32x4 o; o.x = pack2(h0.x, h0.y); o.y = pack2(h0.z, h0.w); o.z = pack2(h1.x, h1.y); o.w = pack2(h1.z, h1.w);
        *(u32x4*)(prev + base) = o;
        h0 = h0 * d + s0; h1 = h1 * d + s1;
    }
}

__device__ __forceinline__ void d_ssd_out(const bf16_t* __restrict__ proj, const float* __restrict__ small, const float* __restrict__ conv_w, const float* __restrict__ conv_b,
                                          const float* __restrict__ a_log, const float* __restrict__ d_skip, const bf16_t* __restrict__ prev, bf16_t* __restrict__ yssd, int item, char* lds) {
    const int tid = tid_opaque(), lane = tid & 63, w = tid >> 6, fr = lane & 15, fq = lane >> 4;
    const int b = item >> 7, c = (item >> 1) & 63, g = item & 1;
    bf16_t* XsT = (bf16_t*)(lds + S3_XST); bf16_t* Bc = (bf16_t*)(lds + S3_BC); bf16_t* Cc = (bf16_t*)(lds + S3_CC);
    float* acs = (float*)(lds + S3_ACS); float* dtl = (float*)(lds + S3_DT);
    const size_t tok0 = (size_t)b * SEQ + (size_t)c * 128;
    ssd_acs(small, a_log, tok0, g, acs, dtl, tid);
    {
        const int mode = tid < 256 ? 0 : (tid < 384 ? 1 : 2);
        const int ch = mode == 0 ? g * 256 + tid : (mode == 1 ? 512 + g * 128 + (tid - 256) : 768 + g * 128 + (tid - 384));
        const bf16_t* px = proj + tok0 * PROJ_LD + C_XBC + ch;
        ConvCh cx; conv_init(cx, conv_w, conv_b, ch, px, c);
        bf16_t* dstx = XsT + (tid & 255) * SSD_P;
        bf16_t* dstbc = (mode == 1 ? Bc : Cc) + (tid & 127);
        for (int l0 = 0; l0 < 128; l0 += 32) {
            float rx[32];
#pragma unroll
            for (int i = 0; i < 32; ++i) rx[i] = bf2f(px[(size_t)(l0 + i) * PROJ_LD]);
#pragma unroll
            for (int i8 = 0; i8 < 4; ++i8) {
                float ox[8];
#pragma unroll
                for (int i = 0; i < 8; ++i) ox[i] = conv_step(cx, rx[i8 * 8 + i]);
                if (mode == 0) {
                    u32x4 o; o.x = pack2(ox[0], ox[1]); o.y = pack2(ox[2], ox[3]); o.z = pack2(ox[4], ox[5]); o.w = pack2(ox[6], ox[7]);
                    *(u32x4*)(dstx + l0 + i8 * 8) = o;
                } else {
#pragma unroll
                    for (int i = 0; i < 8; ++i) dstbc[(l0 + i8 * 8 + i) * SSD_P] = f2bf(ox[i]);
                }
            }
        }
    }
    __syncthreads();
    const int hw = w & 3, lh = w >> 2, hh = 4 * g + hw;
    const float dsk = d_skip[hh];
    const bf16_t* pp = prev + ((size_t)((b * 64 + c) * 8 + hh)) * 8192;
#pragma unroll 1
    for (int lk = 0; lk < 4; ++lk) {
        const int lt = lh + 2 * lk;
        const int l = lt * 16 + fr;
        const float acs_l = acs[hw * 128 + l];
        bf16x8 cf[4];
#pragma unroll
        for (int ks = 0; ks < 4; ++ks) cf[ks] = *(const bf16x8*)(Cc + (lt * 16 + fr) * SSD_P + ks * 32 + fq * 8);
        f32x4 y[4], yo[4];
#pragma unroll
        for (int pt = 0; pt < 4; ++pt) { y[pt] = (f32x4){0.f, 0.f, 0.f, 0.f}; yo[pt] = (f32x4){0.f, 0.f, 0.f, 0.f}; }
#pragma unroll
        for (int ks2 = 0; ks2 < 4; ++ks2) {
            if (2 * ks2 <= lt) {
                f32x4 cb[2];
#pragma unroll
                for (int h2 = 0; h2 < 2; ++h2) {
                    const int st = 2 * ks2 + h2;
                    cb[h2] = (f32x4){0.f, 0.f, 0.f, 0.f};
                    if (st <= lt) {
#pragma unroll
                        for (int ks = 0; ks < 4; ++ks)
                            cb[h2] = __builtin_amdgcn_mfma_f32_16x16x32_bf16(*(const bf16x8*)(Bc + (st * 16 + fr) * SSD_P + ks * 32 + fq * 8), cf[ks], cb[h2], 0, 0, 0);
#pragma unroll
                        for (int jj = 0; jj < 4; ++jj) {
                            const int sidx = st * 16 + 4 * fq + jj;
                            cb[h2][jj] = (sidx <= l) ? cb[h2][jj] * __expf(acs_l - acs[hw * 128 + sidx]) * dtl[hw * 128 + sidx] : 0.f;
                        }
                    }
                }
                u32x4 wv; wv.x = pack2(cb[0].x, cb[0].y); wv.y = pack2(cb[0].z, cb[0].w); wv.z = pack2(cb[1].x, cb[1].y); wv.w = pack2(cb[1].z, cb[1].w);
                const bf16x8 mf = __builtin_bit_cast(bf16x8, wv);
#pragma unroll
                for (int pt = 0; pt < 4; ++pt) {
                    const bf16_t* xp = XsT + (hw * 64 + pt * 16 + fr) * SSD_P + ks2 * 32 + 4 * fq;
                    const u32x2 a0 = *(const u32x2*)xp, a1 = *(const u32x2*)(xp + 16);
                    u32x4 xv; xv.x = a0.x; xv.y = a0.y; xv.z = a1.x; xv.w = a1.y;
                    y[pt] = __builtin_amdgcn_mfma_f32_16x16x32_bf16(__builtin_bit_cast(bf16x8, xv), mf, y[pt], 0, 0, 0);
                }
            }
            __builtin_amdgcn_sched_barrier(0);
        }
        __builtin_amdgcn_sched_barrier(0);
#pragma unroll
        for (int pt = 0; pt < 4; ++pt)
#pragma unroll
            for (int ks = 0; ks < 4; ++ks) yo[pt] = __builtin_amdgcn_mfma_f32_16x16x32_bf16(*(const bf16x8*)(pp + (pt * 16 + fr) * 128 + ks * 32 + fq * 8), cf[ks], yo[pt], 0, 0, 0);
        __builtin_amdgcn_sched_barrier(0);
        const float el = __expf(acs_l);
#pragma unroll
        for (int pt = 0; pt < 4; ++pt) {
            const int p0 = pt * 16 + 4 * fq;
            const u32x2 zz = *(const u32x2*)(proj + (tok0 + l) * PROJ_LD + C_Z + hh * 64 + p0);
            const float z0 = bflo(zz.x), z1 = bfhi(zz.x), z2 = bflo(zz.y), z3 = bfhi(zz.y);
            const bf16_t* xq = XsT + (hw * 64 + p0) * SSD_P + l;
            const float x0 = bf2f(xq[0]), x1 = bf2f(xq[SSD_P]), x2 = bf2f(xq[2 * SSD_P]), x3 = bf2f(xq[3 * SSD_P]);
            u32x2 ob;
            ob.x = pack2((y[pt].x + el * yo[pt].x + dsk * x0) * silu(z0), (y[pt].y + el * yo[pt].y + dsk * x1) * silu(z1));
            ob.y = pack2((y[pt].z + el * yo[pt].z + dsk * x2) * silu(z2), (y[pt].w + el * yo[pt].w + dsk * x3) * silu(z3));
            *(u32x2*)(yssd + (tok0 + l) * 512 + hh * 64 + p0) = ob;
        }
    }
    __syncthreads();
}

__device__ __forceinline__ void d_mix_prep(const float* __restrict__ onsa, const bf16_t* __restrict__ yssd, const float* __restrict__ nsa_w, const float* __restrict__ ssd_w, bf16_t* __restrict__ A2, int vb) {
    const int tid_ = tid_opaque(); const int lane = tid_ & 63, wid = tid_ >> 6;
    const size_t row0 = (size_t)vb * 32 + wid * 4;
    f32x4 a[4][2], y[4][2];
#pragma unroll
    for (int r = 0; r < 4; ++r)
#pragma unroll
        for (int k = 0; k < 2; ++k) {
            a[r][k] = *(const f32x4*)(onsa + (row0 + r) * 512 + k * 256 + lane * 4);
            const u32x2 yy = *(const u32x2*)(yssd + (row0 + r) * 512 + k * 256 + lane * 4);
            y[r][k] = (f32x4){bflo(yy.x), bfhi(yy.x), bflo(yy.y), bfhi(yy.y)};
        }
    float ra[4], ry[4];
#pragma unroll
    for (int r = 0; r < 4; ++r) {
        float s0 = 0.f, s1 = 0.f;
#pragma unroll
        for (int k = 0; k < 2; ++k) {
            s0 += a[r][k].x * a[r][k].x + a[r][k].y * a[r][k].y + a[r][k].z * a[r][k].z + a[r][k].w * a[r][k].w;
            s1 += y[r][k].x * y[r][k].x + y[r][k].y * y[r][k].y + y[r][k].z * y[r][k].z + y[r][k].w * y[r][k].w;
        }
        ra[r] = rsqrtf(wave_sum(s0) * (1.0f / 512) + EPS); ry[r] = rsqrtf(wave_sum(s1) * (1.0f / 512) + EPS);
    }
#pragma unroll
    for (int k = 0; k < 2; ++k) {
        const int col = k * 256 + lane * 4;
        const f32x4 wn = *(const f32x4*)(nsa_w + col), wsd = *(const f32x4*)(ssd_w + col);
#pragma unroll
        for (int r = 0; r < 4; ++r) {
            const f32x4 p = a[r][k] * ra[r] * wn, q = y[r][k] * ry[r] * wsd;
            u32x2 o; o.x = pack2(p.x, p.y); o.y = pack2(p.z, p.w);
            *(u32x2*)(A2 + (row0 + r) * DM + col) = o;
            u32x2 o2; o2.x = pack2(q.x, q.y); o2.y = pack2(q.z, q.w);
            *(u32x2*)(A2 + (row0 + r) * DM + 512 + col) = o2;
        }
    }
}

__device__ __forceinline__ void d_quant_rows(const float* __restrict__ src, unsigned char* __restrict__ dst, float* __restrict__ scale, int vb) {
    const int tid_ = tid_opaque(); const int lane = tid_ & 63, row = vb * 8 + (tid_ >> 6);
    const float* rp = src + (size_t)row * DM + lane * 16;
    f32x4 v[4];
#pragma unroll
    for (int i = 0; i < 4; ++i) v[i] = *(const f32x4*)(rp + i * 4);
    float mx = 0.f;
#pragma unroll
    for (int i = 0; i < 4; ++i) mx = fmaxf(mx, fmaxf(fmaxf(fabsf(v[i].x), fabsf(v[i].y)), fmaxf(fabsf(v[i].z), fabsf(v[i].w))));
    mx = wave_max(mx);
    const float sc = mx > 0.f ? mx * (1.0f / 416.0f) : 1.0f;
    const float inv = 1.0f / sc;
    u32x4 o;
#pragma unroll
    for (int i = 0; i < 4; ++i) {
        int wv = 0;
        wv = __builtin_amdgcn_cvt_pk_fp8_f32(v[i].x * inv, v[i].y * inv, wv, false);
        wv = __builtin_amdgcn_cvt_pk_fp8_f32(v[i].z * inv, v[i].w * inv, wv, true);
        o[i] = (unsigned)wv;
    }
    *(u32x4*)(dst + (size_t)row * DM + lane * 16) = o;
    if (lane == 0) scale[row] = sc;
}

__device__ __forceinline__ unsigned mono_u(float f) { const unsigned u = __float_as_uint(f); return (u & 0x80000000u) ? ~u : (u | 0x80000000u); }
__device__ __forceinline__ float unmono_f(unsigned m) { const unsigned u = (m & 0x80000000u) ? (m & 0x7fffffffu) : ~m; return __uint_as_float(u); }
__device__ __forceinline__ void d_peer_route(const bf16_t* __restrict__ qp, const float* __restrict__ qnw, const bf16_t* __restrict__ subk, int* __restrict__ eidx, float* __restrict__ gate,
                                             int tile, int h, char* lds) {
    const int tid = tid_opaque(), lane = tid & 63, w = tid >> 6, fr = lane & 15, fq = lane >> 4;
    const size_t tok = (size_t)tile * 128 + w * 16 + fr;
    bf16x8 qf[2][4];
    {
        const bf16_t* qrow = qp + tok * 2048 + h * 256;
        u32x4 raw[2][4];
        float ss = 0.f;
#pragma unroll
        for (int k = 0; k < 2; ++k)
#pragma unroll
            for (int ks = 0; ks < 4; ++ks) {
                const u32x4 r = *(const u32x4*)(qrow + k * 128 + ks * 32 + fq * 8);
                raw[k][ks] = r;
                ss += bflo(r.x) * bflo(r.x) + bfhi(r.x) * bfhi(r.x) + bflo(r.y) * bflo(r.y) + bfhi(r.y) * bfhi(r.y)
                    + bflo(r.z) * bflo(r.z) + bfhi(r.z) * bfhi(r.z) + bflo(r.w) * bflo(r.w) + bfhi(r.w) * bfhi(r.w);
            }
        ss += __shfl_xor(ss, 16); ss += __shfl_xor(ss, 32);
        const float rs = rsqrtf(ss * (1.0f / 256) + EPS);
#pragma unroll
        for (int k = 0; k < 2; ++k)
#pragma unroll
            for (int ks = 0; ks < 4; ++ks) {
                const float* wp = qnw + k * 128 + ks * 32 + fq * 8;
                const f32x4 w0 = *(const f32x4*)wp, w1 = *(const f32x4*)(wp + 4);
                const u32x4 r = raw[k][ks];
                u32x4 o;
                o.x = pack2(bflo(r.x) * rs * w0.x, bfhi(r.x) * rs * w0.y); o.y = pack2(bflo(r.y) * rs * w0.z, bfhi(r.y) * rs * w0.w);
                o.z = pack2(bflo(r.z) * rs * w1.x, bfhi(r.z) * rs * w1.y); o.w = pack2(bflo(r.w) * rs * w1.z, bfhi(r.w) * rs * w1.w);
                qf[k][ks] = __builtin_bit_cast(bf16x8, o);
            }
    }
    unsigned L[2][16];
#pragma unroll
    for (int k = 0; k < 2; ++k) {
        f32x4 acc[8];
#pragma unroll
        for (int kt = 0; kt < 8; ++kt) acc[kt] = (f32x4){0.f, 0.f, 0.f, 0.f};
        const bf16_t* kb = subk + (size_t)((h * 2 + k) * 128) * 128;
#pragma unroll
        for (int kt = 0; kt < 8; ++kt)
#pragma unroll
            for (int ks = 0; ks < 4; ++ks) {
                const bf16x8 af = *(const bf16x8*)(kb + (size_t)(kt * 16 + fr) * 128 + ks * 32 + fq * 8);
                acc[kt] = __builtin_amdgcn_mfma_f32_16x16x32_bf16(af, qf[k][ks], acc[kt], 0, 0, 0);
            }
#pragma unroll
        for (int i = 0; i < 16; ++i) L[k][i] = 0u;
#pragma unroll
        for (int kt = 0; kt < 8; ++kt)
#pragma unroll
            for (int jj = 0; jj < 4; ++jj) {
                const int idx = kt * 16 + 4 * fq + jj;
                ins16(L[k], (mono_u(acc[kt][jj]) & ~0x7Fu) | (unsigned)(127 - idx));
            }
#pragma unroll
        for (int r = 16; r <= 32; r <<= 1) {
            unsigned P[16];
#pragma unroll
            for (int i = 0; i < 16; ++i) P[i] = (unsigned)__shfl_xor((int)L[k][i], r);
            merge16(L[k], P);
        }
    }
    unsigned T[16];
#pragma unroll
    for (int i = 0; i < 16; ++i) T[i] = 0u;
#pragma unroll
    for (int a = 0; a < 16; ++a) {
        const float va = unmono_f(L[0][a] & ~0x7Fu);
#pragma unroll
        for (int bb = 0; bb < 16; ++bb) {
            if (bb <= 16 / (a + 1) - 1) {
                const float sum = va + unmono_f(L[1][bb] & ~0x7Fu);
                ins16(T, (mono_u(sum) & ~0xFFu) | (unsigned)(255 - (a * 16 + bb)));
            }
        }
    }
    unsigned char* li = (unsigned char*)lds + w * 512 + fr * 32;
    if (fq == 0) {
#pragma unroll
        for (int a = 0; a < 16; ++a) { li[a] = (unsigned char)(127 - (L[0][a] & 0x7Fu)); li[16 + a] = (unsigned char)(127 - (L[1][a] & 0x7Fu)); }
    }
    __syncthreads();
    const float s0 = unmono_f(T[0] & ~0xFFu);
    float pe[16]; float sum = 0.f;
#pragma unroll
    for (int i = 0; i < 16; ++i) { pe[i] = __expf(unmono_f(T[i] & ~0xFFu) - s0); sum += pe[i]; }
    const float inv = 1.0f / sum;
    unsigned cod[4] = {0u, 0u, 0u, 0u}; float gv[4] = {0.f, 0.f, 0.f, 0.f};
#pragma unroll
    for (int i = 0; i < 16; ++i) if ((i >> 2) == fq) { cod[i & 3] = 255u - (T[i] & 0xFFu); gv[i & 3] = pe[i] * inv; }
    int ev[4];
#pragma unroll
    for (int i = 0; i < 4; ++i) ev[i] = (int)li[cod[i] >> 4] * 128 + (int)li[16 + (cod[i] & 15u)];
    *(u32x4*)(eidx + (tok * 8 + h) * 16 + fq * 4) = (u32x4){(unsigned)ev[0], (unsigned)ev[1], (unsigned)ev[2], (unsigned)ev[3]};
    *(f32x4*)(gate + (tok * 8 + h) * 16 + fq * 4) = (f32x4){gv[0], gv[1], gv[2], gv[3]};
    __syncthreads();
}

__device__ __forceinline__ void cvt16(const u32x4 q, float (&f)[16]) {
#pragma unroll
    for (int i = 0; i < 4; ++i) {
        const f32x2 lo = __builtin_amdgcn_cvt_pk_f32_fp8((int)q[i], false), hi = __builtin_amdgcn_cvt_pk_f32_fp8((int)q[i], true);
        f[4 * i] = lo.x; f[4 * i + 1] = lo.y; f[4 * i + 2] = hi.x; f[4 * i + 3] = hi.y;
    }
}
__device__ __forceinline__ void d_peer_expert8(const bf16_t* __restrict__ h2, const unsigned char* __restrict__ down8, const unsigned char* __restrict__ up8, const float* __restrict__ dscale,
                                               const float* __restrict__ uscale, const int* __restrict__ eidx, const float* __restrict__ gate, const float* __restrict__ mod,
                                               const float* __restrict__ fw, float* __restrict__ out, int vb) {
    const int tid = tid_opaque(), lane = tid & 63, wid = tid >> 6;
    const size_t tok = (size_t)vb * 8 + wid; const int b = (int)(tok >> 13);
    const int e_lo = eidx[tok * 128 + lane], e_hi = eidx[tok * 128 + 64 + lane];
    const float c_lo = gate[tok * 128 + lane] * uscale[e_lo], c_hi = gate[tok * 128 + 64 + lane] * uscale[e_hi];
    const float d_lo = dscale[e_lo], d_hi = dscale[e_hi];
    float hx[16], acc[16];
    {
        const u32x4 v0 = *(const u32x4*)(h2 + tok * DM + lane * 16), v1 = *(const u32x4*)(h2 + tok * DM + lane * 16 + 8);
        hx[0] = bflo(v0.x); hx[1] = bfhi(v0.x); hx[2] = bflo(v0.y); hx[3] = bfhi(v0.y); hx[4] = bflo(v0.z); hx[5] = bfhi(v0.z); hx[6] = bflo(v0.w); hx[7] = bfhi(v0.w);
        hx[8] = bflo(v1.x); hx[9] = bfhi(v1.x); hx[10] = bflo(v1.y); hx[11] = bfhi(v1.y); hx[12] = bflo(v1.z); hx[13] = bfhi(v1.z); hx[14] = bflo(v1.w); hx[15] = bfhi(v1.w);
    }
#pragma unroll
    for (int e = 0; e < 16; ++e) acc[e] = 0.f;
    const int es = lane >> 3;
    u32x4 dq[8], uq[8], dn[8], un[8];
#pragma unroll
    for (int i = 0; i < 8; ++i) {
        const int e = __builtin_amdgcn_readlane(e_lo, i);
        dq[i] = *(const u32x4*)(down8 + (size_t)e * DM + lane * 16);
        uq[i] = *(const u32x4*)(up8 + (size_t)e * DM + lane * 16);
    }
#pragma unroll 1
    for (int j0 = 0; j0 < 128; j0 += 8) {
        if (j0 + 8 < 128) {
            const int jn = j0 + 8;
#pragma unroll
            for (int i = 0; i < 8; ++i) {
                const int e = jn < 64 ? __builtin_amdgcn_readlane(e_lo, jn + i) : __builtin_amdgcn_readlane(e_hi, jn - 64 + i);
                dn[i] = *(const u32x4*)(down8 + (size_t)e * DM + lane * 16);
                un[i] = *(const u32x4*)(up8 + (size_t)e * DM + lane * 16);
            }
        }
        const int sl = (j0 & 63) + es;
        const float my_c = j0 < 64 ? __shfl(c_lo, sl) : __shfl(c_hi, sl);
        const float my_ds = j0 < 64 ? __shfl(d_lo, sl) : __shfl(d_hi, sl);
        float part[8];
#pragma unroll
        for (int i = 0; i < 8; ++i) {
            float f[16]; cvt16(dq[i], f);
            float s = 0.f;
#pragma unroll
            for (int e = 0; e < 16; ++e) s += hx[e] * f[e];
            part[i] = s;
        }
        float q4[4], q2[2], q1;
#pragma unroll
        for (int i = 0; i < 4; ++i) { const bool up = (lane & 32) != 0; const float send = up ? part[i] : part[i + 4]; const float keep = up ? part[i + 4] : part[i]; q4[i] = keep + __shfl_xor(send, 32); }
#pragma unroll
        for (int i = 0; i < 2; ++i) { const bool up = (lane & 16) != 0; const float send = up ? q4[i] : q4[i + 2]; const float keep = up ? q4[i + 2] : q4[i]; q2[i] = keep + __shfl_xor(send, 16); }
        { const bool up = (lane & 8) != 0; const float send = up ? q2[0] : q2[1]; const float keep = up ? q2[1] : q2[0]; q1 = keep + __shfl_xor(send, 8); }
        q1 += __shfl_xor(q1, 4); q1 += __shfl_xor(q1, 2); q1 += __shfl_xor(q1, 1);
        const float a = gelu_tanh(q1 * my_ds) * my_c;
#pragma unroll
        for (int i = 0; i < 8; ++i) {
            const float c = __uint_as_float((unsigned)__builtin_amdgcn_readlane((int)__float_as_uint(a), 8 * i));
            float f[16]; cvt16(uq[i], f);
#pragma unroll
            for (int e = 0; e < 16; ++e) acc[e] += c * f[e];
        }
#pragma unroll
        for (int i = 0; i < 8; ++i) { dq[i] = dn[i]; uq[i] = un[i]; }
    }
    float x2[16]; float ss = 0.f;
#pragma unroll
    for (int q4i = 0; q4i < 4; ++q4i) {
        const int col = lane * 16 + q4i * 4;
        const f32x4 xv = *(const f32x4*)(out + tok * DM + col);
        const f32x4 g2 = *(const f32x4*)(mod + b * 6144 + 5120 + col);
        const int e0 = q4i * 4;
        x2[e0 + 0] = xv.x + g2.x * acc[e0 + 0]; x2[e0 + 1] = xv.y + g2.y * acc[e0 + 1]; x2[e0 + 2] = xv.z + g2.z * acc[e0 + 2]; x2[e0 + 3] = xv.w + g2.w * acc[e0 + 3];
        ss += x2[e0] * x2[e0] + x2[e0 + 1] * x2[e0 + 1] + x2[e0 + 2] * x2[e0 + 2] + x2[e0 + 3] * x2[e0 + 3];
    }
    ss = wave_sum(ss);
    const float r = rsqrtf(ss * (1.0f / DM) + EPS);
#pragma unroll
    for (int q4i = 0; q4i < 4; ++q4i) {
        const int col = lane * 16 + q4i * 4;
        const f32x4 wv = *(const f32x4*)(fw + col);
        const int e0 = q4i * 4;
        *(f32x4*)(out + tok * DM + col) = (f32x4){x2[e0] * r * wv.x, x2[e0 + 1] * r * wv.y, x2[e0 + 2] * r * wv.z, x2[e0 + 3] * r * wv.w};
    }
}

#define XB_TMO      128
#define XB_XCNT(j)  (256  + 64 * (j))
#define XB_XSUB(j)  (1280 + 64 * (j))
#define XB_XGEN(j)  (2304 + 64 * (j))
#define XB_TOP      3328
#define XB_TOPGEN   3392
#define XCD_BAR_WORDS 3456
#define XB_SPIN_CAP (1u << 18)

__device__ __forceinline__ unsigned xb_ld(unsigned* p)              { return __hip_atomic_load(p, __ATOMIC_RELAXED, __HIP_MEMORY_SCOPE_AGENT); }
__device__ __forceinline__ unsigned xb_add(unsigned* p, unsigned v) { return __hip_atomic_fetch_add(p, v, __ATOMIC_RELAXED, __HIP_MEMORY_SCOPE_AGENT); }
__device__ __forceinline__ unsigned xb_xcc_id() { return (unsigned)__builtin_amdgcn_s_getreg((3 << 11) | 20) & 0xFu; }
#define XB_SPIN(cond, bar) do { unsigned _sp = 0; while (cond) { __builtin_amdgcn_s_sleep(1); \
    if ((++_sp & 255u) == 0u) { if (xb_ld(&(bar)[XB_TMO])) break; if (_sp > XB_SPIN_CAP) { atomicAdd(&(bar)[XB_TMO], 1u); break; } } } } while (0)

struct XcdBarrier {
    unsigned* bar; unsigned x;
    volatile __attribute__((address_space(3))) unsigned* st;
};

__device__ __forceinline__ XcdBarrier xcd_barrier_post(unsigned* bar, volatile __attribute__((address_space(3))) unsigned* st) {
    XcdBarrier b; b.bar = bar; b.x = xb_xcc_id(); b.st = st;
    if (threadIdx.x == 0) (void)xb_add(&bar[XB_XCNT(b.x)], 1u);
    return b;
}
__device__ __forceinline__ void xcd_barrier_complete(unsigned* bar, unsigned x, unsigned& nloc, unsigned& nx) {
    const unsigned G = gridDim.x * gridDim.y * gridDim.z;
    unsigned sum, cnt, mine, sp = 0u;
    for (;;) {
        sum = 0u; cnt = 0u; mine = 0u;
#pragma unroll
        for (unsigned j = 0; j < 16; ++j) { const unsigned c = xb_ld(&bar[XB_XCNT(j)]); sum += c; cnt += (c > 0u) ? 1u : 0u; mine = (j == x) ? c : mine; }
        if (sum == G) break;
        __builtin_amdgcn_s_sleep(1);
        if ((++sp & 255u) == 0u) { if (xb_ld(&bar[XB_TMO])) break; if (sp > XB_SPIN_CAP) { atomicAdd(&bar[XB_TMO], 1u); break; } }
    }
    nloc = mine > 0u ? mine : 1u; nx = cnt > 0u ? cnt : 1u;
}

__device__ __forceinline__ void xcd_barrier(const XcdBarrier& b) {
    asm volatile("s_waitcnt vmcnt(0)" ::: "memory");
    __syncthreads();
    if (threadIdx.x == 0) {
        unsigned* bar = b.bar;
        __builtin_amdgcn_s_waitcnt(0);
        unsigned nloc = b.st[0], nx = b.st[1];
        if (nloc == 0u) { xcd_barrier_complete(bar, b.x, nloc, nx); b.st[0] = nloc; b.st[1] = nx; }
        const unsigned old = xb_add(&bar[XB_XSUB(b.x)], 1u);
        const unsigned gen = old / nloc;
        if (old + 1u == (gen + 1u) * nloc) {
            __builtin_amdgcn_fence(__ATOMIC_RELEASE, "agent");
            asm volatile("s_waitcnt vmcnt(0)" ::: "memory");
            const unsigned og = xb_add(&bar[XB_TOP], 1u);
            const unsigned tg = og / nx;
            if (og + 1u == (tg + 1u) * nx) xb_add(&bar[XB_TOPGEN], 1u);
            else XB_SPIN(xb_ld(&bar[XB_TOPGEN]) == tg, bar);
            __builtin_amdgcn_fence(__ATOMIC_ACQUIRE, "agent");
            xb_add(&bar[XB_XGEN(b.x)], 1u);
            asm volatile("s_waitcnt vmcnt(0)" ::: "memory");
        } else {
            XB_SPIN(xb_ld(&bar[XB_XGEN(b.x)]) == gen, bar);
            __builtin_amdgcn_fence(__ATOMIC_ACQUIRE, "agent");
            asm volatile("s_waitcnt vmcnt(0)" ::: "memory");
        }
    }
    __syncthreads();
}


struct Params {
    const float *x, *c, *w_ada, *b_ada, *norm1_w, *w_in, *cmp_pe_k, *cmp_pe_v, *cmp_w1_k, *cmp_w2_k, *cmp_w1_v, *cmp_w2_v, *nsa_norm_w, *conv_w, *conv_b, *dt_bias, *a_log, *d_skip,
        *ssd_norm_w, *w_out, *norm2_w, *peer_wq, *peer_qnorm_w, *peer_sub_keys, *peer_down, *peer_up, *final_norm_w;
    float* out; char* ws;
};
#define LDS_BYTES 147456
#define LDS_MISC  (LDS_BYTES - 64)

__global__ __launch_bounds__(512, 2) void mega(Params p) {
    __shared__ __attribute__((aligned(16))) unsigned char lds_raw[LDS_BYTES];
    char* lds = (char*)lds_raw;
    PG8_LAS unsigned char* lds3 = (PG8_LAS unsigned char*)lds_raw;
    int* s_vb = (int*)(lds + LDS_MISC);
    cg::grid_group grid = cg::this_grid();
    volatile __attribute__((address_space(3))) unsigned* xb_st = (volatile __attribute__((address_space(3))) unsigned*)((PG8_LAS unsigned char*)lds_raw + LDS_MISC + 16);
    if (threadIdx.x == 0) { xb_st[0] = 0u; xb_st[1] = 0u; }
    __syncthreads();
    const XcdBarrier xbar = xcd_barrier_post((unsigned*)(p.ws + OFF_BAR), xb_st);
    const int G = gridDim.x, bid = blockIdx.x;
    if (bid == 0 && threadIdx.x == 0) { ((unsigned*)(p.ws + OFF_CTR))[0] = 0u; ((unsigned*)(p.ws + OFF_CTR))[64] = 0u; ((unsigned*)(p.ws + OFF_CTR))[128] = 0u; }
    for (int vb = bid; vb < 7906; vb += G) {
        int v = vb;
        if (v < 1536) { d_transpose_w(p.w_in, ((bf16_t*)(p.ws + OFF_WIN_T)), 1024, 2848, 1, 96, v, lds); }
        else if ((v -= 1536) < 512) { d_transpose_w(p.w_out, ((bf16_t*)(p.ws + OFF_WOUT_T)), 1024, 1024, 0, 32, v, lds); }
        else if ((v -= 512) < 1024) { d_transpose_w(p.peer_wq, ((bf16_t*)(p.ws + OFF_WQ_T)), 1024, 2048, 0, 64, v, lds); }
        else if ((v -= 1024) < 256) { d_transpose_w(p.cmp_w1_k, ((bf16_t*)(p.ws + OFF_W1K_T)), 2048, 256, 0, 8, v, lds); }
        else if ((v -= 256) < 256) { d_transpose_w(p.cmp_w1_v, ((bf16_t*)(p.ws + OFF_W1V_T)), 2048, 256, 0, 8, v, lds); }
        else if ((v -= 256) < 2048) { d_quant_rows(p.peer_down, ((unsigned char*)(p.ws + OFF_DOWN)), ((float*)(p.ws + OFF_UP)), v); }
        else if ((v -= 2048) < 2048) { d_quant_rows(p.peer_up, ((unsigned char*)(p.ws + OFF_DOWN + MIB(16))), ((float*)(p.ws + OFF_UP + 65536)), v); }
        else if ((v -= 2048) < 1) { d_convert_bf16(p.peer_sub_keys, ((bf16_t*)(p.ws + OFF_SUBK)), (size_t)8 * 2 * 128 * 128 / 8, 0, 1); }
        else if ((v -= 1) < 96) { d_mod(p.c, p.w_ada, p.b_ada, ((float*)(p.ws + OFF_MOD)), v, lds); }
        else if ((v -= 96) < 128) { d_rope_table(((float2*)(p.ws + OFF_ROPE)), v); }
        else { d_bias1(p.cmp_pe_k, p.cmp_w1_k, p.cmp_pe_v, p.cmp_w1_v, ((float*)(p.ws + OFF_BIAS1))); }
    }
    grid.sync();
    for (int vb = bid; vb < NTOK / 32; vb += G) d_norm_mod(p.x, p.norm1_w, ((float*)(p.ws + OFF_MOD)), 0, 1024, ((bf16_t*)(p.ws + OFF_H)), vb);
    xcd_barrier(xbar);
    {
        const pg8::Gemm g{((bf16_t*)(p.ws + OFF_H)), ((bf16_t*)(p.ws + OFF_WIN_T)), NTOK, NIN_PAD, 1024, 1024};
        pg8::StaticOrder S; S.init(NTOK, NIN_PAD, G, bid);
        const pg8::Epi<EpInProj> E{{((bf16_t*)(p.ws + OFF_PROJ)), ((bf16_t*)(p.ws + OFF_QROPE)), ((bf16_t*)(p.ws + OFF_KVP)), ((float*)(p.ws + OFF_SMALL)), ((float2*)(p.ws + OFF_ROPE)), p.dt_bias}};
        pg8::gemm_phase(lds3, g, S, E);
    }
    xcd_barrier(xbar);
    {
        {
            const pg8::Gemm g{((bf16_t*)(p.ws + OFF_KVP)) + 0 * KVP_SEG, ((bf16_t*)(p.ws + OFF_W1K_T)), 8192, 256, 2048, 1024};
            pg8::StaticOrder S; S.init(8192, 256, G, bid);
            const pg8::Epi<EpCmpHid> E{{((bf16_t*)(p.ws + OFF_HIDK)), ((float*)(p.ws + OFF_BIAS1))}};
            pg8::gemm_phase(lds3, g, S, E);
        }
        {
            const pg8::Gemm g{((bf16_t*)(p.ws + OFF_KVP)) + 1 * KVP_SEG, ((bf16_t*)(p.ws + OFF_W1V_T)), 8192, 256, 2048, 1024};
            pg8::StaticOrder S; S.init(8192, 256, G, (bid + G / 2) % G);
            const pg8::Epi<EpCmpHid> E{{((bf16_t*)(p.ws + OFF_HIDV)), ((float*)(p.ws + OFF_BIAS1)) + 256}};
            pg8::gemm_phase(lds3, g, S, E);
        }
        __syncthreads();
        for (int vb = bid; vb < 1024; vb += G) d_ssd_states(((bf16_t*)(p.ws + OFF_PROJ)), ((float*)(p.ws + OFF_SMALL)), p.conv_w, p.conv_b, p.a_log, ((float*)(p.ws + OFF_ONSA)), ((float*)(p.ws + OFF_CTR + 4096)), vb, lds);
    }
    xcd_barrier(xbar);
    for (int vb = bid; vb < 2048 + 128; vb += G) {
        if (vb < 1024) d_cmp_out(((bf16_t*)(p.ws + OFF_HIDK)), p.cmp_w2_k, ((bf16_t*)(p.ws + OFF_KC)), vb); else if (vb < 2048) d_cmp_out(((bf16_t*)(p.ws + OFF_HIDV)), p.cmp_w2_v, ((bf16_t*)(p.ws + OFF_VC)), vb - 1024);
        else d_ssd_scan(((float*)(p.ws + OFF_ONSA)), ((float*)(p.ws + OFF_CTR + 4096)), ((bf16_t*)(p.ws + OFF_EIDX)), vb - 2048);
    }
    xcd_barrier(xbar);
    for (;;) {
        if (threadIdx.x == 0) *s_vb = (int)atomicAdd(&((unsigned*)(p.ws + OFF_CTR))[0], 1u);
        __syncthreads();
        const int i = *s_vb;
        __syncthreads();
        if (i >= 2048) break;
        const int qt = 127 - (i >> 4), bg = i & 15;
        d_nsa_cmp(((bf16_t*)(p.ws + OFF_PROJ)), ((bf16_t*)(p.ws + OFF_KC)), ((bf16_t*)(p.ws + OFF_VC)), ((float*)(p.ws + OFF_SMALL)), ((float*)(p.ws + OFF_ONSA)), ((unsigned*)(p.ws + OFF_HIDK)) + (size_t)(bg * 128 + qt) * 512, bg >> 1, bg & 1, qt, lds);
    }
    for (;;) {
        if (threadIdx.x == 0) *s_vb = (int)atomicAdd(&((unsigned*)(p.ws + OFF_CTR))[64], 1u);
        __syncthreads();
        const int i = *s_vb;
        __syncthreads();
        if (i >= 1024) break;
        d_ssd_out(((bf16_t*)(p.ws + OFF_PROJ)), ((float*)(p.ws + OFF_SMALL)), p.conv_w, p.conv_b, p.a_log, p.d_skip, ((bf16_t*)(p.ws + OFF_EIDX)), ((bf16_t*)(p.ws + OFF_YSSD)), i, lds);
    }
    xcd_barrier(xbar);
    for (;;) {
        if (threadIdx.x == 0) *s_vb = (int)atomicAdd(&((unsigned*)(p.ws + OFF_CTR))[128], 1u);
        __syncthreads();
        const int i = *s_vb;
        __syncthreads();
        if (i >= 2048) break;
        const int qt = 127 - (i >> 4), bg = i & 15;
        d_nsa_attn(((bf16_t*)(p.ws + OFF_QROPE)), ((bf16_t*)(p.ws + OFF_KVP)), ((float*)(p.ws + OFF_SMALL)), ((float*)(p.ws + OFF_ONSA)), ((unsigned*)(p.ws + OFF_HIDK)) + (size_t)(bg * 128 + qt) * 512, bg >> 1, bg & 1, qt, lds);
    }
    xcd_barrier(xbar);
    for (int vb = bid; vb < NTOK / 32; vb += G) d_mix_prep(((float*)(p.ws + OFF_ONSA)), ((bf16_t*)(p.ws + OFF_YSSD)), p.nsa_norm_w, p.ssd_norm_w, ((bf16_t*)(p.ws + OFF_H)), vb);
    xcd_barrier(xbar);
    {
        const pg8::Gemm g{((bf16_t*)(p.ws + OFF_H)), ((bf16_t*)(p.ws + OFF_WOUT_T)), NTOK, 1024, 1024, 1024};
        pg8::StaticOrder S; S.init(NTOK, 1024, G, bid);
        const pg8::Epi<EpOutProj> E{{p.x, ((float*)(p.ws + OFF_MOD)), p.out}};
        pg8::gemm_phase(lds3, g, S, E);
    }
    xcd_barrier(xbar);
    for (int vb = bid; vb < NTOK / 32; vb += G) d_norm_mod(p.out, p.norm2_w, ((float*)(p.ws + OFF_MOD)), 3072, 4096, ((bf16_t*)(p.ws + OFF_H)), vb);
    xcd_barrier(xbar);
    {
        const pg8::Gemm g{((bf16_t*)(p.ws + OFF_H)), ((bf16_t*)(p.ws + OFF_WQ_T)), NTOK, 2048, 1024, 1024};
        pg8::StaticOrder S; S.init(NTOK, 2048, G, bid);
        const pg8::Epi<EpStoreBf16> E{{((bf16_t*)(p.ws + OFF_PROJ)), 2048, 0}};
        pg8::gemm_phase(lds3, g, S, E);
    }
    xcd_barrier(xbar);
    for (int vb = bid; vb < 4096; vb += G) d_peer_route(((bf16_t*)(p.ws + OFF_PROJ)), p.peer_qnorm_w, ((bf16_t*)(p.ws + OFF_SUBK)), ((int*)(p.ws + OFF_EIDX)), ((float*)(p.ws + OFF_GATE)), vb >> 3, vb & 7, lds);
    xcd_barrier(xbar);
    for (int vb = bid; vb < NTOK / 8; vb += G) d_peer_expert8(((bf16_t*)(p.ws + OFF_H)), ((unsigned char*)(p.ws + OFF_DOWN)), ((unsigned char*)(p.ws + OFF_DOWN + MIB(16))), ((float*)(p.ws + OFF_UP)), ((float*)(p.ws + OFF_UP + 65536)), ((int*)(p.ws + OFF_EIDX)), ((float*)(p.ws + OFF_GATE)), ((float*)(p.ws + OFF_MOD)), p.final_norm_w, p.out, vb);
}

extern "C" void kernel_launch(void* const* d_in, const int* in_sizes, int n_in, void* d_out, int out_size, void* d_ws, size_t ws_size, hipStream_t stream) {
    if (ws_size < WS_NEED) { fprintf(stderr, "workspace too small\n"); return; }
    static int grid_blocks = 0;
    if (!grid_blocks) {
        int dev = 0, cus = 0, per_cu = 0;
        (void)hipGetDevice(&dev);
        (void)hipDeviceGetAttribute(&cus, hipDeviceAttributeMultiprocessorCount, dev);
        (void)hipOccupancyMaxActiveBlocksPerMultiprocessor(&per_cu, mega, 512, 0);
        if (per_cu < 1) fprintf(stderr, "occupancy query reports %d blocks per CU\n", per_cu);
        grid_blocks = cus;
    }
    Params p{};
    const float** pp = (const float**)&p;
    for (int i = 0; i < 27; ++i) pp[i] = (const float*)d_in[i];
    p.out = (float*)d_out; p.ws = (char*)d_ws;
    (void)hipMemsetAsync((char*)d_ws + OFF_BAR, 0, XCD_BAR_WORDS * 4, stream);
    void* args[] = {&p};
    hipError_t e = hipLaunchCooperativeKernel((void*)mega, dim3(grid_blocks), dim3(512), args, 0, stream);
    if (e != hipSuccess) fprintf(stderr, "cooperative launch failed: %s (grid %d)\n", hipGetErrorString(e), grid_blocks);
}
```

```cpp
#include <hip/hip_runtime.h>
#include <hip/hip_cooperative_groups.h>
#include <stdint.h>
#include <cstdio>
namespace cg = cooperative_groups;

typedef unsigned short bf16_t;
typedef short bf16x8 __attribute__((ext_vector_type(8)));
typedef float f32x4 __attribute__((ext_vector_type(4)));
typedef float f32x2 __attribute__((ext_vector_type(2)));
typedef unsigned u32x4 __attribute__((ext_vector_type(4)));
typedef unsigned u32x2 __attribute__((ext_vector_type(2)));

#define NB 8
#define SEQ 8192
#define NTOK 65536
#define DM 1024
#define PROJ_LD 2816
#define NIN_PAD 3072
#define C_Q 0
#define C_KCMP 512
#define C_KSEL 768
#define C_VSEL 896
#define C_KWIN 1024
#define C_VWIN 1152
#define C_Z 1280
#define C_XBC 1792
#define NCMP 511
#define EPS 1e-6f
#define KVP_SEG ((size_t)NB * 2 * SEQ * 64)

#define MIB(x) ((size_t)(x) << 20)
#define OFF_MOD    MIB(0)
#define OFF_ROPE   MIB(1)
#define OFF_BIAS1  MIB(2)
#define OFF_WIN_T  MIB(3)
#define OFF_WOUT_T MIB(9)
#define OFF_WQ_T   MIB(11)
#define OFF_SUBK   MIB(15)
#define OFF_W1K_T  MIB(16)
#define OFF_W1V_T  MIB(17)
#define OFF_KC     MIB(18)
#define OFF_VC     MIB(19)
#define OFF_HIDK   MIB(20)
#define OFF_HIDV   MIB(24)
#define OFF_DOWN   MIB(28)
#define OFF_UP     MIB(60)
#define OFF_SMALL  MIB(92)
#define OFF_H      MIB(100)
#define OFF_PROJ   MIB(228)
#define OFF_QROPE  MIB(580)
#define OFF_ONSA   MIB(644)
#define OFF_YSSD   MIB(772)
#define OFF_KVP    MIB(836)
#define OFF_EIDX   MIB(932)
#define OFF_GATE   MIB(964)
#define OFF_CTR    MIB(996)
#define OFF_BAR    (MIB(996) + 65536)
#define WS_NEED    MIB(997)

typedef __bf16 hwbf2 __attribute__((ext_vector_type(2)));
__device__ __forceinline__ bf16_t f2bf(float f) { const __bf16 h = (__bf16)f; return __builtin_bit_cast(bf16_t, h); }
__device__ __forceinline__ float bf2f(bf16_t h) { return __uint_as_float(((unsigned)h) << 16); }
__device__ __forceinline__ float bflo(unsigned u) { return __uint_as_float(u << 16); }
__device__ __forceinline__ float bfhi(unsigned u) { return __uint_as_float(u & 0xffff0000u); }
__device__ __forceinline__ unsigned pack2(float a, float b) { const f32x2 v = {a, b}; const hwbf2 r = __builtin_convertvector(v, hwbf2); return __builtin_bit_cast(unsigned, r); }
__device__ __forceinline__ float wave_sum(float v) {
#pragma unroll
    for (int o = 32; o; o >>= 1) v += __shfl_xor(v, o);
    return v;
}
__device__ __forceinline__ float wave_max(float v) {
#pragma unroll
    for (int o = 32; o; o >>= 1) v = fmaxf(v, __shfl_xor(v, o));
    return v;
}
__device__ __forceinline__ int tid_opaque() { int t = threadIdx.x; asm volatile("" : "+v"(t)); return t; }
__device__ __forceinline__ float gelu_tanh(float x) { return 0.5f * x * (1.0f + tanhf(0.7978845608028654f * (x + 0.044715f * x * x * x))); }
__device__ __forceinline__ float silu(float x) { return x / (1.0f + __expf(-x)); }
__device__ __forceinline__ float sigmoidf(float x) { return 1.0f / (1.0f + __expf(-x)); }
__device__ __forceinline__ float softplusf(float x) { return x > 20.f ? x : log1pf(__expf(x)); }

__device__ __forceinline__ int inproj_src(int n) {
    if (n < 1280) return n;
    if (n < 1792) return 1304 + (n - 1280);
    if (n < 2816) return 1816 + (n - 1792);
    if (n < 2840) return 1280 + (n - 2816);
    if (n < 2848) return 2840 + (n - 2840);
    return -1;
}
__device__ __forceinline__ void d_transpose_w(const float* __restrict__ W, bf16_t* __restrict__ Wt, int K, int N, int mode, int nbx, int vb, char* lds) {
    const int tid_ = tid_opaque(); const int half = tid_ >> 8, t256 = tid_ & 255, tile = vb * 2 + half;
    float (*t)[33] = (float (*)[33])(lds + half * 4352);
    const int n0 = (tile % nbx) * 32, k0 = (tile / nbx) * 32, tx = t256 & 31, ty = t256 >> 5;
#pragma unroll
    for (int i = 0; i < 4; ++i) {
        const int k = k0 + ty + 8 * i, n = n0 + tx;
        const int src = mode == 1 ? inproj_src(n) : n;
        t[ty + 8 * i][tx] = (src >= 0 && src < N) ? W[(size_t)k * N + src] : 0.f;
    }
    __syncthreads();
#pragma unroll
    for (int i = 0; i < 4; ++i) Wt[(size_t)(n0 + ty + 8 * i) * K + k0 + tx] = f2bf(t[tx][ty + 8 * i]);
    __syncthreads();
}
__device__ __forceinline__ void d_convert_bf16(const float* __restrict__ in, bf16_t* __restrict__ out, size_t n8, int vb, int nvb) {
    size_t i = (size_t)vb * 512 + tid_opaque();
    const size_t stride = (size_t)nvb * 512;
    for (; i < n8; i += stride) {
        const f32x4 a = ((const f32x4*)in)[2 * i], b = ((const f32x4*)in)[2 * i + 1];
        u32x4 o; o.x = pack2(a.x, a.y); o.y = pack2(a.z, a.w); o.z = pack2(b.x, b.y); o.w = pack2(b.z, b.w);
        ((u32x4*)out)[i] = o;
    }
}
__device__ __forceinline__ void d_mod(const float* __restrict__ c, const float* __restrict__ w_ada, const float* __restrict__ b_ada, float* __restrict__ mod, int vb, char* lds) {
    float (*part)[8][64] = (float (*)[8][64])lds;
    const int tid = tid_opaque(), jl = tid & 63, kq = tid >> 6, j = vb * 64 + jl;
    float acc[8];
#pragma unroll
    for (int b = 0; b < 8; ++b) acc[b] = 0.f;
    for (int k0 = kq * 128; k0 < kq * 128 + 128; k0 += 16) {
        float wv[16];
#pragma unroll
        for (int i = 0; i < 16; ++i) wv[i] = w_ada[(size_t)(k0 + i) * 6144 + j];
#pragma unroll
        for (int i = 0; i < 16; ++i)
#pragma unroll
            for (int b = 0; b < 8; ++b) acc[b] += c[b * 1024 + k0 + i] * wv[i];
    }
#pragma unroll
    for (int b = 0; b < 8; ++b) part[kq][b][jl] = acc[b];
    __syncthreads();
    {
        const int b = tid >> 6, jj = tid & 63;
        float s = b_ada[vb * 64 + jj];
#pragma unroll
        for (int q = 0; q < 8; ++q) s += part[q][b][jj];
        mod[b * 6144 + vb * 64 + jj] = s;
    }
    __syncthreads();
}
__device__ __forceinline__ void d_rope_table(float2* __restrict__ rope, int vb) {
    const int i = vb * 512 + tid_opaque();
    if (i >= SEQ * 8) return;
    const int pos = i >> 3, f = i & 7;
    const double inv = pow(500000.0, -(double)f / 8.0);
    const double ang = (double)pos * inv;
    rope[i] = make_float2((float)cos(ang), (float)sin(ang));
}
__device__ __forceinline__ void d_bias1(const float* __restrict__ pe_k, const float* __restrict__ w1_k, const float* __restrict__ pe_v, const float* __restrict__ w1_v, float* __restrict__ bias1) {
    const int tid_ = tid_opaque(); const int which = tid_ >> 8, j = tid_ & 255;
    const float* pe = which ? pe_v : pe_k; const float* w1 = which ? w1_v : w1_k;
    float a = 0.f;
    for (int k0 = 0; k0 < 2048; k0 += 16) {
        float wv[16];
#pragma unroll
        for (int i = 0; i < 16; ++i) wv[i] = w1[(size_t)(k0 + i) * 256 + j];
#pragma unroll
        for (int i = 0; i < 16; ++i) a += pe[k0 + i] * wv[i];
    }
    bias1[which * 256 + j] = a;
}

__device__ __forceinline__ void d_norm_mod(const float* __restrict__ x, const float* __restrict__ w, const float* __restrict__ mod, int sh_off, int sc_off, bf16_t* __restrict__ out, int vb) {
    const int tid_ = tid_opaque(); const int lane = tid_ & 63, wid = tid_ >> 6;
    const size_t row0 = (size_t)vb * 32 + wid * 4; const int b = (int)(row0 >> 13);
    f32x4 v[4][4];
#pragma unroll
    for (int r = 0; r < 4; ++r)
#pragma unroll
        for (int k = 0; k < 4; ++k) v[r][k] = *(const f32x4*)(x + (row0 + r) * DM + k * 256 + lane * 4);
    float rs[4];
#pragma unroll
    for (int r = 0; r < 4; ++r) {
        float ss = 0.f;
#pragma unroll
        for (int k = 0; k < 4; ++k) ss += v[r][k].x * v[r][k].x + v[r][k].y * v[r][k].y + v[r][k].z * v[r][k].z + v[r][k].w * v[r][k].w;
        rs[r] = rsqrtf(wave_sum(ss) * (1.0f / DM) + EPS);
    }
#pragma unroll
    for (int k = 0; k < 4; ++k) {
        const int col = k * 256 + lane * 4;
        const f32x4 wv = *(const f32x4*)(w + col), sc = *(const f32x4*)(mod + b * 6144 + sc_off + col), sh = *(const f32x4*)(mod + b * 6144 + sh_off + col);
        const f32x4 ws = wv * (sc + 1.0f);
#pragma unroll
        for (int r = 0; r < 4; ++r) {
            const f32x4 y = v[r][k] * rs[r] * ws + sh;
            u32x2 o; o.x = pack2(y.x, y.y); o.y = pack2(y.z, y.w);
            *(u32x2*)(out + (row0 + r) * DM + col) = o;
        }
    }
}

namespace pg8 {
#define PG8_LAS __attribute__((address_space(3)))
constexpr int BM = 256, BK = 64, HALF = 128, HTB = HALF * BK * 2  , STAGE_BYTES = 8 * HTB, NXCD = 8, WGM = 8;
__host__ __device__ __forceinline__ int lds_byte(int r, int c) { const int st = (r >> 4) * 2 + (c >> 5), rr = r & 15, cc = c & 31, ob = rr * 64 + cc * 2; return st * 1024 + (ob ^ (((ob >> 9) & 1) << 5)); }
__host__ __device__ __forceinline__ void stage_rc(int b, int& R, int& C) { const int st = b / 1024, sb = b % 1024, swz = sb ^ (((sb >> 9) & 1) << 5); R = (st >> 1) * 16 + swz / 64; C = (st & 1) * 32 + (swz % 64) / 2; }
struct Unit { int pm, pn; };
struct Gemm { const bf16_t* A; const bf16_t* Bt; int M, N, K, lda; };
struct StaticOrder {
    int nM, nN, nwg, G, c;
    __host__ __device__ void init(int M, int N, int G_, int c_) { nM = M / BM; nN = N / BM; nwg = nM * nN; G = G_; c = c_; }
    __host__ __device__ bool next(int i, Unit& u) const {
        const long L = (long)i * G + c; if (L >= nwg) return false;
        int wgid = (int)L; { const int q = nwg / NXCD, r = nwg % NXCD, xcd = wgid % NXCD, off = wgid / NXCD; wgid = (xcd < r ? xcd * (q + 1) : r * (q + 1) + (xcd - r) * q) + off; }
        const int nig = WGM * nN, gid = wgid / nig, fm = gid * WGM, gsz = (nM - fm) < WGM ? (nM - fm) : WGM;
        u.pm = fm + ((wgid % nig) % gsz); u.pn = (wgid % nig) / gsz; return true;
    }
};
template <class F> struct Epi {
    F f;
    __device__ __forceinline__ void operator()(const f32x4 (&acc)[2][2][4][2], const Unit& u, int wr, int wc, int fr, int fq) const {
#pragma unroll
        for (int ai = 0; ai < 2; ++ai)
#pragma unroll
            for (int m = 0; m < 4; ++m)
#pragma unroll
                for (int bj = 0; bj < 2; ++bj)
#pragma unroll
                    for (int n = 0; n < 2; ++n)
                        f(u.pm * BM + ai * HALF + wr * 64 + m * 16 + fr, u.pn * BM + bj * HALF + wc * 32 + n * 16 + 4 * fq, acc[ai][bj][m][n]);
    }
};
template <class E, class Sched>
__device__ __forceinline__ void gemm_phase(PG8_LAS unsigned char* lds, const Gemm g, const Sched& S, const E& Ep) {
    const int tid = tid_opaque(), wid = __builtin_amdgcn_readfirstlane(tid >> 6), lane = tid & 63, wr = wid >> 2, wc = wid & 3, fr = lane & 15, fq = lane >> 4;
    const int K = g.K, nt = K / BK;
    unsigned voffA[2], voffB[2];
#pragma unroll
    for (int i = 0; i < 2; ++i) { int R, C; stage_rc(tid * 16 + i * 8192, R, C); voffA[i] = (unsigned)(R * g.lda + C) * 2u; voffB[i] = (unsigned)(R * K + C) * 2u; }
    const size_t kstep = (size_t)(BK * 2);
    const size_t hstep = (size_t)HALF * K * 2, hstepA = (size_t)HALF * g.lda * 2;
    const size_t tstep = 2 * hstep, tstepA = 2 * hstepA;
    const unsigned ldsw = (unsigned)wid * 1024u;
    const int aoff = lds_byte(wr * 64 + fr, fq * 8), boff = lds_byte(wc * 32 + fr, fq * 8);
#define PG8_SA(b, h) (((b) * 2 + (h)) * HTB)
#define PG8_SB(b, h) ((4 + (b) * 2 + (h)) * HTB)
#define PG8_STAGE(bufoff, gbase, voff) do { _Pragma("unroll") for (int _i = 0; _i < 2; ++_i) \
        __builtin_amdgcn_global_load_lds((const unsigned*)((const char*)(gbase) + (voff)[_i]), (PG8_LAS unsigned*)(lds + (bufoff) + ldsw + _i * 8192), 16, 0, 0); } while (0)
#define PG8_LDA(dst, b, h) do { _Pragma("unroll") for (int m = 0; m < 4; ++m) _Pragma("unroll") for (int k = 0; k < 2; ++k) dst[m][k] = *(const PG8_LAS bf16x8*)(lds + PG8_SA(b, h) + aoff + m * 2048 + k * 1024); } while (0)
#define PG8_LDB(dst, b, h) do { _Pragma("unroll") for (int n = 0; n < 2; ++n) _Pragma("unroll") for (int k = 0; k < 2; ++k) dst[n][k] = *(const PG8_LAS bf16x8*)(lds + PG8_SB(b, h) + boff + n * 2048 + k * 1024); } while (0)
#define PG8_MMA(ai, bj, At, Bt) do { __builtin_amdgcn_s_setprio(1); _Pragma("unroll") for (int m = 0; m < 4; ++m) _Pragma("unroll") for (int n = 0; n < 2; ++n) _Pragma("unroll") for (int k = 0; k < 2; ++k) \
        acc[ai][bj][m][n] = __builtin_amdgcn_mfma_f32_16x16x32_bf16(Bt[n][k], At[m][k], acc[ai][bj][m][n], 0, 0, 0); __builtin_amdgcn_s_setprio(0); } while (0)
#define PG8_WAIT_V(n) asm volatile("s_waitcnt vmcnt(" #n ")" ::: "memory")
#define PG8_WAIT_L(n) asm volatile("s_waitcnt lgkmcnt(" #n ")" ::: "memory")
#define PG8_BAR __builtin_amdgcn_s_barrier()
#define PG8_SCHED __builtin_amdgcn_sched_barrier(0)
    Unit cur, nxt; int ui = 0;
    if (!S.next(0, cur)) return;
    f32x4 acc[2][2][4][2];
#pragma unroll
    for (int a = 0; a < 2; ++a)
#pragma unroll
        for (int b = 0; b < 2; ++b)
#pragma unroll
            for (int m = 0; m < 4; ++m)
#pragma unroll
                for (int n = 0; n < 2; ++n) acc[a][b][m][n] = (f32x4){0.f, 0.f, 0.f, 0.f};
    bf16x8 At[4][2], B0[2][2], B1[2][2];
    const char* cA = (const char*)g.A + (size_t)cur.pm * tstepA; const char* cB = (const char*)g.Bt + (size_t)cur.pn * tstep;
    PG8_STAGE(PG8_SB(0, 0), cB, voffB); PG8_STAGE(PG8_SB(0, 1), cB + hstep, voffB); PG8_STAGE(PG8_SA(0, 0), cA, voffA); PG8_STAGE(PG8_SA(0, 1), cA + hstepA, voffA);
    if (wr == 1) PG8_BAR;
    PG8_WAIT_V(2); PG8_BAR;
    PG8_STAGE(PG8_SB(1, 0), cB + kstep, voffB); PG8_STAGE(PG8_SA(1, 0), cA + kstep, voffA); PG8_STAGE(PG8_SB(1, 1), cB + hstep + kstep, voffB);
    PG8_WAIT_V(6); PG8_BAR;
    for (;;) {
        const bool has_next = S.next(ui + 1, nxt);
        const char* nA = has_next ? (const char*)g.A + (size_t)nxt.pm * tstepA : cA; const char* nB = has_next ? (const char*)g.Bt + (size_t)nxt.pn * tstep : cB;
        for (int t = 0; t < nt; t += 2) {
            const bool last = (t == nt - 2);
            const char* a1 = cA + (size_t)(t + 1) * kstep;
            const char* a2 = last ? nA : cA + (size_t)(t + 2) * kstep; const char* b2 = last ? nB : cB + (size_t)(t + 2) * kstep;
            const char* a3 = a2 + kstep; const char* b3 = b2 + kstep;
            PG8_LDB(B0, 0, 0); PG8_LDB(B1, 0, 1); PG8_SCHED; PG8_LDA(At, 0, 0); PG8_STAGE(PG8_SA(1, 1), a1 + hstepA, voffA);
            PG8_WAIT_V(8); PG8_WAIT_L(0); PG8_BAR; PG8_MMA(0, 0, At, B0); PG8_MMA(0, 1, At, B1); PG8_BAR; PG8_SCHED;
            PG8_LDA(At, 0, 1); PG8_STAGE(PG8_SB(0, 0), b2, voffB); PG8_STAGE(PG8_SB(0, 1), b2 + hstep, voffB); PG8_STAGE(PG8_SA(0, 0), a2, voffA);
            PG8_WAIT_V(8); PG8_WAIT_L(0); PG8_BAR; PG8_MMA(1, 0, At, B0); PG8_MMA(1, 1, At, B1); PG8_BAR; PG8_SCHED;
            PG8_LDB(B0, 1, 0); PG8_LDB(B1, 1, 1); PG8_SCHED; PG8_LDA(At, 1, 0); PG8_STAGE(PG8_SA(0, 1), a2 + hstepA, voffA);
            PG8_WAIT_V(8); PG8_WAIT_L(0); PG8_BAR; PG8_MMA(0, 0, At, B0); PG8_MMA(0, 1, At, B1); PG8_BAR; PG8_SCHED;
            PG8_LDA(At, 1, 1); PG8_STAGE(PG8_SB(1, 0), b3, voffB); PG8_STAGE(PG8_SB(1, 1), b3 + hstep, voffB); PG8_STAGE(PG8_SA(1, 0), a3, voffA);
            PG8_WAIT_V(8); PG8_WAIT_L(0); PG8_BAR; PG8_MMA(1, 0, At, B0); PG8_MMA(1, 1, At, B1); PG8_BAR; PG8_SCHED;
        }
        if (wr == 0) PG8_BAR;
        Ep(acc, cur, wr, wc, fr, fq);
        if (!has_next) break;
#pragma unroll
        for (int a = 0; a < 2; ++a)
#pragma unroll
            for (int b = 0; b < 2; ++b)
#pragma unroll
                for (int m = 0; m < 4; ++m)
#pragma unroll
                    for (int n = 0; n < 2; ++n) acc[a][b][m][n] = (f32x4){0.f, 0.f, 0.f, 0.f};
        cur = nxt; cA = nA; cB = nB; ++ui;
        if (wr == 1) PG8_BAR;
    }
    PG8_WAIT_V(0);
    PG8_BAR;
#undef PG8_SA
#undef PG8_SB
#undef PG8_STAGE
#undef PG8_LDA
#undef PG8_LDB
#undef PG8_MMA
#undef PG8_WAIT_V
#undef PG8_WAIT_L
#undef PG8_BAR
#undef PG8_SCHED
}
}

struct EpInProj { bf16_t* proj; bf16_t* qrope; bf16_t* kvp; float* small; const float2* rope; const float* dt_bias;
    __device__ __forceinline__ void operator()(int m, int n0, f32x4 v) const {
        if (n0 < 2816) {
            const bool is_q = n0 < 512;
            const bool roped_seg = is_q || (n0 >= C_KSEL && n0 < C_VSEL) || (n0 >= C_KWIN && n0 < C_VWIN);
            const bool rope_dims = roped_seg && ((n0 & 63) < 16);
            u32x2 raw; raw.x = pack2(v.x, v.y); raw.y = pack2(v.z, v.w);
            if (is_q) *(u32x2*)(proj + (size_t)m * PROJ_LD + n0) = raw;
            if (rope_dims) {
                f32x4 p; p.x = __shfl_xor(v.x, 32); p.y = __shfl_xor(v.y, 32); p.z = __shfl_xor(v.z, 32); p.w = __shfl_xor(v.w, 32);
                const int i0 = n0 & 15, pos = m & (SEQ - 1);
                const float sgn = i0 < 8 ? -1.f : 1.f;
                const float2* rp = rope + pos * 8 + (i0 & 7);
                const float2 c0 = rp[0], c1 = rp[1], c2 = rp[2], c3 = rp[3];
                v.x = v.x * c0.x + sgn * p.x * c0.y; v.y = v.y * c1.x + sgn * p.y * c1.y;
                v.z = v.z * c2.x + sgn * p.z * c2.y; v.w = v.w * c3.x + sgn * p.w * c3.y;
            }
            u32x2 o; o.x = pack2(v.x, v.y); o.y = pack2(v.z, v.w);
            if (is_q) *(u32x2*)(qrope + (size_t)m * 512 + n0) = o;
            else if (n0 < C_Z) {
                const int r = n0 - C_KCMP, seg = r >> 7, g = (r >> 6) & 1, d = r & 63, bb = m >> 13, t = m & (SEQ - 1);
                *(u32x2*)(kvp + (size_t)seg * KVP_SEG + ((size_t)(bb * 2 + g) * SEQ + t) * 64 + d) = o;
            }
            else *(u32x2*)(proj + (size_t)m * PROJ_LD + n0) = o;
        } else if (n0 < 2848) {
            const int c = n0 - 2816; f32x4 o;
            if (c < 24) { o.x = sigmoidf(v.x); o.y = sigmoidf(v.y); o.z = sigmoidf(v.z); o.w = sigmoidf(v.w); }
            else { const float* db = dt_bias + (c - 24); o.x = softplusf(v.x + db[0]); o.y = softplusf(v.y + db[1]); o.z = softplusf(v.z + db[2]); o.w = softplusf(v.w + db[3]); }
            *(f32x4*)(small + (size_t)m * 32 + c) = o;
        }
    } };
struct EpCmpHid { bf16_t* hid; const float* bias;
    __device__ __forceinline__ void operator()(int m, int n0, f32x4 v) const {
        const f32x4 b = *(const f32x4*)(bias + n0);
        u32x2 o; o.x = pack2(gelu_tanh(v.x + b.x), gelu_tanh(v.y + b.y)); o.y = pack2(gelu_tanh(v.z + b.z), gelu_tanh(v.w + b.w));
        *(u32x2*)(hid + (size_t)m * 256 + n0) = o;
    } };
struct EpOutProj { const float* x; const float* mod; float* x1;
    __device__ __forceinline__ void operator()(int m, int n0, f32x4 v) const {
        const int b = m >> 13;
        const f32x4 xv = *(const f32x4*)(x + (size_t)m * DM + n0);
        const f32x4 g = *(const f32x4*)(mod + b * 6144 + 2048 + n0);
        f32x4 o; o.x = xv.x + g.x * v.x; o.y = xv.y + g.y * v.y; o.z = xv.z + g.z * v.z; o.w = xv.w + g.w * v.w;
        *(f32x4*)(x1 + (size_t)m * DM + n0) = o;
    } };
struct EpStoreBf16 { bf16_t* out; int ld; int pad;
    __device__ __forceinline__ void operator()(int m, int n0, f32x4 v) const {
        u32x2 o; o.x = pack2(v.x, v.y); o.y = pack2(v.z, v.w);
        *(u32x2*)(out + (size_t)m * ld + n0) = o;
    } };

__device__ __forceinline__ void d_cmp_out(const bf16_t* __restrict__ hid, const float* __restrict__ w2, bf16_t* __restrict__ out, int vb) {
    const int tid_ = tid_opaque(); const int m = vb * 8 + (tid_ >> 6), d = tid_ & 63;
    float a = 0.f;
#pragma unroll 8
    for (int j = 0; j < 256; ++j) a += bf2f(hid[(size_t)m * 256 + j]) * w2[j * 64 + d];
    out[(size_t)m * 64 + d] = f2bf(a);
}

#define KLD 80
#define NSA_OFF_KS0  0
#define NSA_OFF_VT0  10240
#define NSA_OFF_KS1  20480
#define NSA_OFF_VT1  30720
#define NSA_OFF_IMP  40960
#define NSA_OFF_SELW 74752
#define NSA_OFF_ANYW 75776
#define NSA_OFF_BL   75808
#define NSA_OFF_QS   76352
#define NSA_LDS      (76352 + 8 * 32 * KLD * 2)
#define SM_C 0.18033688011112042f

struct KVStage { u32x4 k, v; };
__device__ __forceinline__ void nsa_stage_load(KVStage& st, const bf16_t* kb, const bf16_t* vb, int tid) {
    st.k = *(const u32x4*)(kb + tid * 8); st.v = *(const u32x4*)(vb + tid * 8);
}
__device__ __forceinline__ void nsa_stage_store(bf16_t* Ks, bf16_t* Vt, int tid, const KVStage& st) {
    const int r = tid >> 3, c = tid & 7;
    *(u32x4*)(Ks + r * KLD + c * 8) = st.k;
    *(u32x4*)(Vt + r * KLD + c * 8) = st.v;
}
__device__ __forceinline__ void nsa_load_q(const bf16_t* qsrc, size_t ld, int lane, bf16_t* Qs) {
    u32x4 r[4];
#pragma unroll
    for (int i = 0; i < 4; ++i) { const int p = lane + 64 * i; r[i] = *(const u32x4*)(qsrc + (size_t)(p >> 3) * ld + (p & 7) * 8); }
#pragma unroll
    for (int i = 0; i < 4; ++i) { const int p = lane + 64 * i; *(u32x4*)(Qs + (p >> 3) * KLD + (p & 7) * 8) = r[i]; }
}
__device__ __forceinline__ void nsa_qk(const bf16_t* Ks, const bf16_t* Qs, f32x4 (&s)[4][2], int fr, int fq) {
#pragma unroll
    for (int kt = 0; kt < 4; ++kt)
#pragma unroll
        for (int tt = 0; tt < 2; ++tt) s[kt][tt] = (f32x4){0.f, 0.f, 0.f, 0.f};
#pragma unroll
    for (int ks = 0; ks < 2; ++ks) {
        bf16x8 qf[2];
#pragma unroll
        for (int tt = 0; tt < 2; ++tt) qf[tt] = *(const bf16x8*)(Qs + (tt * 16 + fr) * KLD + ks * 32 + fq * 8);
#pragma unroll
        for (int kt = 0; kt < 4; ++kt) {
            const bf16x8 kf = *(const bf16x8*)(Ks + (kt * 16 + fr) * KLD + ks * 32 + fq * 8);
#pragma unroll
            for (int tt = 0; tt < 2; ++tt) s[kt][tt] = __builtin_amdgcn_mfma_f32_16x16x32_bf16(kf, qf[tt], s[kt][tt], 0, 0, 0);
        }
    }
}
__device__ __forceinline__ void nsa_pv(const bf16_t* Vt, const f32x4 (&p)[4][2], f32x4 (&o)[4][2], int fr, int fq) {
#pragma unroll
    for (int ks2 = 0; ks2 < 2; ++ks2) {
        bf16x8 pf[2];
#pragma unroll
        for (int tt = 0; tt < 2; ++tt) {
            const f32x4 a = p[2 * ks2][tt], b = p[2 * ks2 + 1][tt];
            u32x4 w; w.x = pack2(a.x, a.y); w.y = pack2(a.z, a.w); w.z = pack2(b.x, b.y); w.w = pack2(b.z, b.w);
            pf[tt] = __builtin_bit_cast(bf16x8, w);
        }
#pragma unroll
        for (int dt = 0; dt < 4; ++dt) {
            typedef short s16x4 __attribute__((ext_vector_type(4)));
            const bf16_t* vp = Vt + (ks2 * 32 + 4 * fq + (fr >> 2)) * KLD + dt * 16 + 4 * (fr & 3);
            const s16x4 a0 = __builtin_amdgcn_ds_read_tr16_b64_v4i16((__attribute__((address_space(3))) s16x4*)vp);
            const s16x4 a1 = __builtin_amdgcn_ds_read_tr16_b64_v4i16((__attribute__((address_space(3))) s16x4*)(vp + 16 * KLD));
            const bf16x8 vf = (bf16x8){a0.x, a0.y, a0.z, a0.w, a1.x, a1.y, a1.z, a1.w};
#pragma unroll
            for (int tt = 0; tt < 2; ++tt) o[dt][tt] = __builtin_amdgcn_mfma_f32_16x16x32_bf16(vf, pf[tt], o[dt][tt], 0, 0, 0);
        }
    }
}
template <int MK>
__device__ __forceinline__ bool nsa_valid(int kk, int ti, int n0, int t0) {
    if (MK == 1) return kk <= ti;
    if (MK == 2) return kk > ti;
    return 16 * (n0 + kk) + 31 <= t0 + ti;
}
template <int MK, bool WITH_O>
__device__ __forceinline__ void nsa_softmax(f32x4 (&s)[4][2], float (&m)[2], float (&l)[2], f32x4 (&o)[4][2], const bool (&selb)[2], int tib, int fq, int n0, int t0) {
#pragma unroll
    for (int tt = 0; tt < 2; ++tt) {
        const int ti = tib + tt * 16;
        float mx = -1e30f;
#pragma unroll
        for (int kt = 0; kt < 4; ++kt)
#pragma unroll
            for (int jj = 0; jj < 4; ++jj) {
                const int kk = kt * 16 + 4 * fq + jj;
                const bool v = selb[tt] && nsa_valid<MK>(kk, ti, n0, t0);
                const float sv = v ? s[kt][tt][jj] * SM_C : -1e30f;
                s[kt][tt][jj] = sv; mx = fmaxf(mx, sv);
            }
        mx = fmaxf(mx, __shfl_xor(mx, 16)); mx = fmaxf(mx, __shfl_xor(mx, 32));
        const float mn = fmaxf(m[tt], mx);
        const float alpha = __builtin_amdgcn_exp2f(m[tt] - mn);
        m[tt] = mn;
        float ls = 0.f;
#pragma unroll
        for (int kt = 0; kt < 4; ++kt)
#pragma unroll
            for (int jj = 0; jj < 4; ++jj) {
                const float sv = s[kt][tt][jj];
                const float pv = sv > -1e29f ? __builtin_amdgcn_exp2f(sv - mn) : 0.f;
                s[kt][tt][jj] = pv; ls += pv;
            }
        l[tt] = l[tt] * alpha + ls;
        if (WITH_O) {
#pragma unroll
            for (int dt = 0; dt < 4; ++dt) o[dt][tt] *= alpha;
        }
    }
}
__device__ __forceinline__ void nsa_softmax_fast(f32x4 (&s)[4][2], float (&m)[2], float (&l)[2], f32x4 (&o)[4][2], const float (&bias)[2]) {
#pragma unroll
    for (int tt = 0; tt < 2; ++tt) {
        float mr = fmaxf(fmaxf(s[0][tt][0], s[0][tt][1]), fmaxf(s[0][tt][2], s[0][tt][3]));
#pragma unroll
        for (int kt = 1; kt < 4; ++kt) mr = fmaxf(mr, fmaxf(fmaxf(s[kt][tt][0], s[kt][tt][1]), fmaxf(s[kt][tt][2], s[kt][tt][3])));
        mr = fmaxf(mr, __shfl_xor(mr, 16)); mr = fmaxf(mr, __shfl_xor(mr, 32));
        const float mx = mr * SM_C + bias[tt];
        const float mold = m[tt], mn = fmaxf(mold, mx);
        m[tt] = mn;
        const float off = bias[tt] - mn;
        float ls = 0.f;
#pragma unroll
        for (int kt = 0; kt < 4; ++kt)
#pragma unroll
            for (int jj = 0; jj < 4; ++jj) { const float pv = __builtin_amdgcn_exp2f(__builtin_fmaf(s[kt][tt][jj], SM_C, off)); s[kt][tt][jj] = pv; ls += pv; }
        if (__builtin_amdgcn_ballot_w64(mn > mold) != 0ull) {
            const float alpha = __builtin_amdgcn_exp2f(mold - mn);
            l[tt] = l[tt] * alpha + ls;
#pragma unroll
            for (int dt = 0; dt < 4; ++dt) o[dt][tt] *= alpha;
        } else l[tt] += ls;
    }
}
__device__ __forceinline__ void ins16(unsigned (&L)[16], unsigned x) {
#pragma unroll
    for (int i = 0; i < 16; ++i) { const unsigned hi = L[i] > x ? L[i] : x; x = L[i] > x ? x : L[i]; L[i] = hi; }
}
__device__ __forceinline__ void merge16(unsigned (&L)[16], const unsigned (&P)[16]) {
#pragma unroll
    for (int i = 0; i < 16; ++i) L[i] = L[i] > P[15 - i] ? L[i] : P[15 - i];
#pragma unroll
    for (int st = 8; st >= 1; st >>= 1)
#pragma unroll
        for (int i = 0; i < 16; ++i)
            if ((i & st) == 0) { const unsigned a = L[i], b = L[i + st]; L[i] = a > b ? a : b; L[i + st] = a > b ? b : a; }
}
template <bool ACCUM>
__device__ __forceinline__ void nsa_emit(const f32x4 (&o)[4][2], const float (&l)[2], bool l_is_partial, const float* gsrc, float* obase, int tib, int fq) {
#pragma unroll
    for (int tt = 0; tt < 2; ++tt) {
        float lt = l[tt];
        if (l_is_partial) { lt += __shfl_xor(lt, 16); lt += __shfl_xor(lt, 32); }
        const int ti = tib + tt * 16;
        const float gv = gsrc[(size_t)ti * 32];
        const float sc = l_is_partial ? (lt > 0.f ? gv / lt : 0.f) : gv;
#pragma unroll
        for (int dt = 0; dt < 4; ++dt) {
            float* op = obase + (size_t)ti * 512 + dt * 16 + 4 * fq;
            f32x4 v = o[dt][tt] * sc;
            if (ACCUM) v += *(const f32x4*)op;
            *(f32x4*)op = v;
        }
    }
}
struct NsaBufs { bf16_t *Ks0, *Vt0, *Ks1, *Vt1; };
template <class SRC, class BODY>
__device__ __forceinline__ void nsa_pipeline(int n, const bf16_t* kb, const bf16_t* vb, const NsaBufs& B, int tid, SRC src, BODY body) {
    KVStage s0, s1;
    nsa_stage_load(s0, kb + (size_t)src(0) * 4096, vb + (size_t)src(0) * 4096, tid);
    s1 = s0;
    if (n > 1) nsa_stage_load(s1, kb + (size_t)src(1) * 4096, vb + (size_t)src(1) * 4096, tid);
    __syncthreads();
    nsa_stage_store(B.Ks0, B.Vt0, tid, s0);
    if (n > 2) nsa_stage_load(s0, kb + (size_t)src(2) * 4096, vb + (size_t)src(2) * 4096, tid);
#pragma unroll 1
    for (int i = 0; i < n; i += 2) {
        __syncthreads();
        if (i + 1 < n) nsa_stage_store(B.Ks1, B.Vt1, tid, s1);
        if (i + 3 < n) nsa_stage_load(s1, kb + (size_t)src(i + 3) * 4096, vb + (size_t)src(i + 3) * 4096, tid);
        body(src(i), B.Ks0, B.Vt0);
        if (i + 1 < n) {
            __syncthreads();
            if (i + 2 < n) nsa_stage_store(B.Ks0, B.Vt0, tid, s0);
            if (i + 4 < n) nsa_stage_load(s0, kb + (size_t)src(i + 4) * 4096, vb + (size_t)src(i + 4) * 4096, tid);
            body(src(i + 1), B.Ks1, B.Vt1);
        }
    }
}

__device__ __forceinline__ void d_nsa_cmp(const bf16_t* __restrict__ proj, const bf16_t* __restrict__ kc, const bf16_t* __restrict__ vc,
                                          const float* __restrict__ small, float* __restrict__ onsa, unsigned* __restrict__ selrec, int b, int g, int qt, char* lds) {
    const NsaBufs B{(bf16_t*)(lds + NSA_OFF_KS0), (bf16_t*)(lds + NSA_OFF_VT0), (bf16_t*)(lds + NSA_OFF_KS1), (bf16_t*)(lds + NSA_OFF_VT1)};
    float* imp = (float*)(lds + NSA_OFF_IMP);
    unsigned* selw = (unsigned*)(lds + NSA_OFF_SELW);
    unsigned* anyw = (unsigned*)(lds + NSA_OFF_ANYW);
    int* blist = (int*)(lds + NSA_OFF_BL);
    const int tid = tid_opaque(), lane = tid & 63, w = tid >> 6, hd = w & 3, th = w >> 2, fr = lane & 15, fq = lane >> 4;
    const int tib = th * 32 + fr;
    const size_t tok0 = (size_t)b * SEQ + (size_t)qt * 64;
    const int t0 = qt * 64;
    const float* gbase = small + tok0 * 32 + g * 12 + hd * 3;
    float* obase = onsa + tok0 * 512 + g * 256 + hd * 64;
    const bool sel_all[2] = {true, true};
    const float bias0[2] = {0.f, 0.f};

    for (int i = tid; i < 64 * 132; i += 512) imp[i] = 0.f;
    if (tid < 4) anyw[tid] = 0u;

    bf16_t* Qs = (bf16_t*)(lds + NSA_OFF_QS) + w * 32 * KLD;
    f32x4 s[4][2], o[4][2];
    float m[2], l[2];

    nsa_load_q(proj + (tok0 + th * 32) * PROJ_LD + C_Q + g * 256 + hd * 64, PROJ_LD, lane, Qs);
    const int ncb = (4 * qt + 3 + 63) >> 6;
    {
        const bf16_t* kb = kc + (size_t)(b * 2 + g) * 512 * 64;
        const bf16_t* vb = vc + (size_t)(b * 2 + g) * 512 * 64;
#pragma unroll
        for (int tt = 0; tt < 2; ++tt) { m[tt] = -1e30f; l[tt] = 0.f; }
        nsa_pipeline(ncb, kb, vb, B, tid, [&](int i) { return i; }, [&](int blk_, bf16_t* Ks, bf16_t* Vt) {
            nsa_qk(Ks, Qs, s, fr, fq);
            nsa_softmax<3, false>(s, m, l, o, sel_all, tib, fq, blk_ * 64, t0);
        });
        float linv[2];
#pragma unroll
        for (int tt = 0; tt < 2; ++tt) { float lt = l[tt]; lt += __shfl_xor(lt, 16); lt += __shfl_xor(lt, 32); linv[tt] = lt > 0.f ? 1.0f / lt : 0.f; }
#pragma unroll
        for (int dt = 0; dt < 4; ++dt)
#pragma unroll
            for (int tt = 0; tt < 2; ++tt) o[dt][tt] = (f32x4){0.f, 0.f, 0.f, 0.f};
        nsa_pipeline(ncb, kb, vb, B, tid, [&](int i) { return i; }, [&](int blk_, bf16_t* Ks, bf16_t* Vt) {
            nsa_qk(Ks, Qs, s, fr, fq);
#pragma unroll
            for (int tt = 0; tt < 2; ++tt) {
                const int ti = tib + tt * 16;
#pragma unroll
                for (int kt = 0; kt < 4; ++kt) {
                    f32x4 pv;
#pragma unroll
                    for (int jj = 0; jj < 4; ++jj) {
                        const int kk = kt * 16 + 4 * fq + jj;
                        const bool v = nsa_valid<3>(kk, ti, blk_ * 64, t0);
                        pv[jj] = v ? __builtin_amdgcn_exp2f(s[kt][tt][jj] * SM_C - m[tt]) * linv[tt] : 0.f;
                    }
                    s[kt][tt] = pv;
                    const int j = blk_ * 16 + kt * 4 + fq;
                    atomicAdd(imp + ti * 132 + (j >> 5) * 33 + (j & 31), pv[0] + pv[1] + pv[2] + 0.5f * pv[3]);
                    if (j + 1 < 128) { const int j1 = j + 1; atomicAdd(imp + ti * 132 + (j1 >> 5) * 33 + (j1 & 31), 0.5f * pv[3]); }
                }
            }
            nsa_pv(Vt, s, o, fr, fq);
        });
        nsa_emit<false>(o, l, false, gbase + 0, obase, tib, fq);
    }
    __syncthreads();
    {
        const int ti = tid >> 3, q8 = tid & 7;
        unsigned L[16];
#pragma unroll
        for (int i = 0; i < 16; ++i) L[i] = 0u;
#pragma unroll
        for (int i = 0; i < 16; ++i) {
            const int j = q8 * 16 + i;
            const bool forced = (j == 0) || (j == qt) || (j == qt - 1);
            const float v = imp[ti * 132 + (j >> 5) * 33 + (j & 31)] + (forced ? 1e4f : 0.f) + 1e-30f;
            const unsigned x = (j <= qt) ? ((__float_as_uint(v) & ~0x7Fu) | (unsigned)(127 - j)) : 0u;
            ins16(L, x);
        }
#pragma unroll
        for (int r = 1; r <= 4; r <<= 1) {
            unsigned P[16];
#pragma unroll
            for (int i = 0; i < 16; ++i) P[i] = (unsigned)__shfl_xor((int)L[i], r);
            merge16(L, P);
        }
        if (q8 < 4) {
            unsigned word = 0u;
#pragma unroll
            for (int i = 0; i < 16; ++i) {
                const unsigned e = L[i];
                const int j = 127 - (int)(e & 0x7Fu);
                if (e != 0u && (j >> 5) == q8) word |= 1u << (j & 31);
            }
            selw[ti * 4 + q8] = word;
            atomicOr(&anyw[q8], word);
        }
    }
    __syncthreads();
    int nsel;
    {
        const unsigned a0 = anyw[0], a1 = anyw[1], a2 = anyw[2], a3 = anyw[3];
        if (tid < 128) {
            const unsigned wd = tid < 32 ? a0 : tid < 64 ? a1 : tid < 96 ? a2 : a3;
            if ((wd >> (tid & 31)) & 1u) {
                int pos = __popc(wd & ((1u << (tid & 31)) - 1u));
                if (tid >= 32) pos += __popc(a0);
                if (tid >= 64) pos += __popc(a1);
                if (tid >= 96) pos += __popc(a2);
                blist[pos] = tid;
            }
        }
        nsel = __builtin_amdgcn_readfirstlane(__popc(a0) + __popc(a1) + __popc(a2) + __popc(a3));
    }
    __syncthreads();
    if (tid < 256) selrec[tid] = selw[tid];
    if (tid < 128) selrec[256 + tid] = (unsigned)blist[tid];
    if (tid == 0) selrec[384] = (unsigned)nsel;
    __syncthreads();
}

__device__ __forceinline__ void d_nsa_attn(const bf16_t* __restrict__ qrope, const bf16_t* __restrict__ kvp, const float* __restrict__ small, float* __restrict__ onsa,
                                           const unsigned* __restrict__ selrec, int b, int g, int qt, char* lds) {
    const NsaBufs B{(bf16_t*)(lds + NSA_OFF_KS0), (bf16_t*)(lds + NSA_OFF_VT0), (bf16_t*)(lds + NSA_OFF_KS1), (bf16_t*)(lds + NSA_OFF_VT1)};
    unsigned* selw = (unsigned*)(lds + NSA_OFF_SELW);
    int* blist = (int*)(lds + NSA_OFF_BL);
    const int tid = tid_opaque(), lane = tid & 63, w = tid >> 6, hd = w & 3, th = w >> 2, fr = lane & 15, fq = lane >> 4;
    const int tib = th * 32 + fr;
    const size_t tok0 = (size_t)b * SEQ + (size_t)qt * 64;
    const float* gbase = small + tok0 * 32 + g * 12 + hd * 3;
    float* obase = onsa + tok0 * 512 + g * 256 + hd * 64;
    const bool sel_all[2] = {true, true};
    const float bias0[2] = {0.f, 0.f};
    bf16_t* Qs = (bf16_t*)(lds + NSA_OFF_QS) + w * 32 * KLD;
    f32x4 s[4][2], o[4][2];
    float m[2], l[2];
    if (tid < 256) selw[tid] = selrec[tid];
    if (tid < 128) blist[tid] = (int)selrec[256 + tid];
    const int nsel = __builtin_amdgcn_readfirstlane((int)selrec[384]);
    __syncthreads();
    nsa_load_q(qrope + (tok0 + th * 32) * 512 + g * 256 + hd * 64, 512, lane, Qs);
    {
        const bf16_t* kb = kvp + 2 * KVP_SEG + (size_t)(b * 2 + g) * SEQ * 64;
        const bf16_t* vb = kvp + 3 * KVP_SEG + (size_t)(b * 2 + g) * SEQ * 64;
#pragma unroll
        for (int tt = 0; tt < 2; ++tt) { m[tt] = -1e30f; l[tt] = 0.f; }
#pragma unroll
        for (int dt = 0; dt < 4; ++dt)
#pragma unroll
            for (int tt = 0; tt < 2; ++tt) o[dt][tt] = (f32x4){0.f, 0.f, 0.f, 0.f};
        nsa_pipeline(nsel, kb, vb, B, tid, [&](int i) { return __builtin_amdgcn_readfirstlane(blist[i]); }, [&](int blk_, bf16_t* Ks, bf16_t* Vt) {
            nsa_qk(Ks, Qs, s, fr, fq);
            bool selb[2];
#pragma unroll
            for (int tt = 0; tt < 2; ++tt) selb[tt] = (selw[(tib + tt * 16) * 4 + (blk_ >> 5)] >> (blk_ & 31)) & 1u;
            if (blk_ == qt) nsa_softmax<1, true>(s, m, l, o, selb, tib, fq, 0, 0);
            else {
                float bias[2];
#pragma unroll
                for (int tt = 0; tt < 2; ++tt) bias[tt] = selb[tt] ? 0.f : -1e30f;
                nsa_softmax_fast(s, m, l, o, bias);
            }
            nsa_pv(Vt, s, o, fr, fq);
        });
        nsa_emit<true>(o, l, true, gbase + 1, obase, tib, fq);
    }
    {
        const bf16_t* kb = kvp + 4 * KVP_SEG + (size_t)(b * 2 + g) * SEQ * 64;
        const bf16_t* vb = kvp + 5 * KVP_SEG + (size_t)(b * 2 + g) * SEQ * 64;
#pragma unroll
        for (int tt = 0; tt < 2; ++tt) { m[tt] = -1e30f; l[tt] = 0.f; }
#pragma unroll
        for (int dt = 0; dt < 4; ++dt)
#pragma unroll
            for (int tt = 0; tt < 2; ++tt) o[dt][tt] = (f32x4){0.f, 0.f, 0.f, 0.f};
        const int j0 = qt >= 8 ? qt - 8 : 0;
        nsa_pipeline(qt - j0 + 1, kb, vb, B, tid, [&](int i) { return j0 + i; }, [&](int blk_, bf16_t* Ks, bf16_t* Vt) {
            nsa_qk(Ks, Qs, s, fr, fq);
            if (blk_ == qt) nsa_softmax<1, true>(s, m, l, o, sel_all, tib, fq, 0, 0);
            else if (blk_ == qt - 8) nsa_softmax<2, true>(s, m, l, o, sel_all, tib, fq, 0, 0);
            else nsa_softmax_fast(s, m, l, o, bias0);
            nsa_pv(Vt, s, o, fr, fq);
        });
        nsa_emit<true>(o, l, true, gbase + 2, obase, tib, fq);
    }
    __syncthreads();
}

#define SSD_P 136
#define S3_XST 0
#define S3_BC  69632
#define S3_CC  104448
#define S3_ACS 139264
#define S3_DT  141312
#define S3_END 143360

__device__ __forceinline__ void ssd_acs(const float* __restrict__ small, const float* __restrict__ a_log, size_t tok0, int g, float* acs, float* dtl, int tid) {
    const int w = tid >> 6, lane = tid & 63, hh = 4 * g + (w & 3);
    if (w < 4) {
        const float a = -__expf(a_log[hh]);
        const float d0 = small[(tok0 + 2 * lane) * 32 + 24 + hh], d1 = small[(tok0 + 2 * lane + 1) * 32 + 24 + hh];
        const float s0 = d0 * a, s1 = s0 + d1 * a;
        float tot = s1;
#pragma unroll
        for (int off = 1; off < 64; off <<= 1) { const float t = __shfl_up(tot, off); if (lane >= off) tot += t; }
        const float excl = tot - s1;
        acs[w * 128 + 2 * lane] = excl + s0; acs[w * 128 + 2 * lane + 1] = excl + s1;
        dtl[w * 128 + 2 * lane] = d0; dtl[w * 128 + 2 * lane + 1] = d1;
    }
}
struct ConvCh { float w0, w1, w2, w3, bias, h0, h1, h2; };
__device__ __forceinline__ void conv_init(ConvCh& cc, const float* __restrict__ conv_w, const float* __restrict__ conv_b, int ch, const bf16_t* pb, int c) {
    cc.w0 = conv_w[ch]; cc.w1 = conv_w[1024 + ch]; cc.w2 = conv_w[2048 + ch]; cc.w3 = conv_w[3072 + ch]; cc.bias = conv_b[ch];
    if (c > 0) { cc.h0 = bf2f(pb[-3 * PROJ_LD]); cc.h1 = bf2f(pb[-2 * PROJ_LD]); cc.h2 = bf2f(pb[-1 * PROJ_LD]); } else { cc.h0 = 0.f; cc.h1 = 0.f; cc.h2 = 0.f; }
}
__device__ __forceinline__ float conv_step(ConvCh& cc, float x) {
    const float v = cc.bias + cc.w0 * cc.h0 + cc.w1 * cc.h1 + cc.w2 * cc.h2 + cc.w3 * x;
    cc.h0 = cc.h1; cc.h1 = cc.h2; cc.h2 = x;
    return silu(v);
}

__device__ __forceinline__ void d_ssd_states(const bf16_t* __restrict__ proj, const float* __restrict__ small, const float* __restrict__ conv_w, const float* __restrict__ conv_b,
                                             const float* __restrict__ a_log, float* __restrict__ states, float* __restrict__ cdec, int item, char* lds) {
    const int tid = tid_opaque(), lane = tid & 63, w = tid >> 6, fr = lane & 15, fq = lane >> 4;
    const int b = item >> 7, c = (item >> 1) & 63, g = item & 1;
    bf16_t* XwT = (bf16_t*)(lds + S3_XST); bf16_t* BcT = (bf16_t*)(lds + S3_BC);
    float* acs = (float*)(lds + S3_ACS); float* dtl = (float*)(lds + S3_DT);
    const size_t tok0 = (size_t)b * SEQ + (size_t)c * 128;
    ssd_acs(small, a_log, tok0, g, acs, dtl, tid);
    __syncthreads();
    if (tid < 384) {
        const bool isx = tid < 256;
        const int ch = isx ? g * 256 + tid : 512 + g * 128 + (tid - 256);
        const bf16_t* px = proj + tok0 * PROJ_LD + C_XBC + ch;
        ConvCh cx; conv_init(cx, conv_w, conv_b, ch, px, c);
        const int hw = w & 3;
        const float alast = acs[hw * 128 + 127];
        bf16_t* dst = isx ? XwT + tid * SSD_P : BcT + (tid - 256) * SSD_P;
        for (int l0 = 0; l0 < 128; l0 += 32) {
            float rx[32];
#pragma unroll
            for (int i = 0; i < 32; ++i) rx[i] = bf2f(px[(size_t)(l0 + i) * PROJ_LD]);
#pragma unroll
            for (int i8 = 0; i8 < 4; ++i8) {
                float ox[8];
#pragma unroll
                for (int i = 0; i < 8; ++i) {
                    const int l = l0 + i8 * 8 + i;
                    const float v = conv_step(cx, rx[i8 * 8 + i]);
                    ox[i] = isx ? v * dtl[hw * 128 + l] * __expf(alast - acs[hw * 128 + l]) : v;
                }
                u32x4 o; o.x = pack2(ox[0], ox[1]); o.y = pack2(ox[2], ox[3]); o.z = pack2(ox[4], ox[5]); o.w = pack2(ox[6], ox[7]);
                *(u32x4*)(dst + l0 + i8 * 8) = o;
            }
        }
    }
    __syncthreads();
    {
        const int hw = w & 3, nh = w >> 2;
        f32x4 acc[4][4];
#pragma unroll
        for (int pt = 0; pt < 4; ++pt)
#pragma unroll
            for (int nt = 0; nt < 4; ++nt) acc[pt][nt] = (f32x4){0.f, 0.f, 0.f, 0.f};
#pragma unroll 1
        for (int ks = 0; ks < 4; ++ks) {
            bf16x8 af[4], bfr[4];
#pragma unroll
            for (int pt = 0; pt < 4; ++pt) af[pt] = *(const bf16x8*)(XwT + (hw * 64 + pt * 16 + fr) * SSD_P + ks * 32 + fq * 8);
#pragma unroll
            for (int nt = 0; nt < 4; ++nt) bfr[nt] = *(const bf16x8*)(BcT + ((nh * 4 + nt) * 16 + fr) * SSD_P + ks * 32 + fq * 8);
#pragma unroll
            for (int pt = 0; pt < 4; ++pt)
#pragma unroll
                for (int nt = 0; nt < 4; ++nt) acc[pt][nt] = __builtin_amdgcn_mfma_f32_16x16x32_bf16(af[pt], bfr[nt], acc[pt][nt], 0, 0, 0);
        }
        const int hh = 4 * g + hw;
        float* sp = states + ((size_t)((b * 64 + c) * 8 + hh)) * 8192;
#pragma unroll
        for (int pt = 0; pt < 4; ++pt)
#pragma unroll
            for (int nt = 0; nt < 4; ++nt)
#pragma unroll
                for (int jj = 0; jj < 4; ++jj) sp[(pt * 16 + 4 * fq + jj) * 128 + (nh * 4 + nt) * 16 + fr] = acc[pt][nt][jj];
        if (lane == 0 && nh == 0) cdec[(b * 64 + c) * 8 + hh] = __expf(acs[hw * 128 + 127]);
    }
    __syncthreads();
}

__device__ __forceinline__ void d_ssd_scan(const float* __restrict__ states, const float* __restrict__ cdec, bf16_t* __restrict__ prev, int vb) {
    const int bh = vb >> 1, b = bh >> 3, hh = bh & 7;
    const size_t e0 = (size_t)((vb & 1) * 512 + tid_opaque()) * 8;
    f32x4 h0 = (f32x4){0.f, 0.f, 0.f, 0.f}, h1 = h0;
#pragma unroll 8
    for (int c = 0; c < 64; ++c) {
        const size_t base = ((size_t)((b * 64 + c) * 8 + hh)) * 8192 + e0;
        const f32x4 s0 = *(const f32x4*)(states + base), s1 = *(const f32x4*)(states + base + 4);
        const float d = cdec[(b * 64 + c) * 8 + hh];
        u32x4 o; o.x = pack2(h0.x, h0.y); o.y = pack2(h0.z, h0.w); o.z = pack2(h1.x, h1.y); o.w = pack2(h1.z, h1.w);
        *(u32x4*)(prev + base) = o;
        h0 = h0 * d + s0; h1 = h1 * d + s1;
    }
}

__device__ __forceinline__ void d_ssd_out(const bf16_t* __restrict__ proj, const float* __restrict__ small, const float* __restrict__ conv_w, const float* __restrict__ conv_b,
                                          const float* __restrict__ a_log, const float* __restrict__ d_skip, const bf16_t* __restrict__ prev, bf16_t* __restrict__ yssd, int item, char* lds) {
    const int tid = tid_opaque(), lane = tid & 63, w = tid >> 6, fr = lane & 15, fq = lane >> 4;
    const int b = item >> 7, c = (item >> 1) & 63, g = item & 1;
    bf16_t* XsT = (bf16_t*)(lds + S3_XST); bf16_t* Bc = (bf16_t*)(lds + S3_BC); bf16_t* Cc = (bf16_t*)(lds + S3_CC);
    float* acs = (float*)(lds + S3_ACS); float* dtl = (float*)(lds + S3_DT);
    const size_t tok0 = (size_t)b * SEQ + (size_t)c * 128;
    ssd_acs(small, a_log, tok0, g, acs, dtl, tid);
    {
        const int mode = tid < 256 ? 0 : (tid < 384 ? 1 : 2);
        const int ch = mode == 0 ? g * 256 + tid : (mode == 1 ? 512 + g * 128 + (tid - 256) : 768 + g * 128 + (tid - 384));
        const bf16_t* px = proj + tok0 * PROJ_LD + C_XBC + ch;
        ConvCh cx; conv_init(cx, conv_w, conv_b, ch, px, c);
        bf16_t* dstx = XsT + (tid & 255) * SSD_P;
        bf16_t* dstbc = (mode == 1 ? Bc : Cc) + (tid & 127);
        for (int l0 = 0; l0 < 128; l0 += 32) {
            float rx[32];
#pragma unroll
            for (int i = 0; i < 32; ++i) rx[i] = bf2f(px[(size_t)(l0 + i) * PROJ_LD]);
#pragma unroll
            for (int i8 = 0; i8 < 4; ++i8) {
                float ox[8];
#pragma unroll
                for (int i = 0; i < 8; ++i) ox[i] = conv_step(cx, rx[i8 * 8 + i]);
                if (mode == 0) {
                    u32x4 o; o.x = pack2(ox[0], ox[1]); o.y = pack2(ox[2], ox[3]); o.z = pack2(ox[4], ox[5]); o.w = pack2(ox[6], ox[7]);
                    *(u32x4*)(dstx + l0 + i8 * 8) = o;
                } else {
#pragma unroll
                    for (int i = 0; i < 8; ++i) dstbc[(l0 + i8 * 8 + i) * SSD_P] = f2bf(ox[i]);
                }
            }
        }
    }
    __syncthreads();
    const int hw = w & 3, lh = w >> 2, hh = 4 * g + hw;
    const float dsk = d_skip[hh];
    const bf16_t* pp = prev + ((size_t)((b * 64 + c) * 8 + hh)) * 8192;
#pragma unroll 1
    for (int lk = 0; lk < 4; ++lk) {
        const int lt = lh + 2 * lk;
        const int l = lt * 16 + fr;
        const float acs_l = acs[hw * 128 + l];
        bf16x8 cf[4];
#pragma unroll
        for (int ks = 0; ks < 4; ++ks) cf[ks] = *(const bf16x8*)(Cc + (lt * 16 + fr) * SSD_P + ks * 32 + fq * 8);
        f32x4 y[4], yo[4];
#pragma unroll
        for (int pt = 0; pt < 4; ++pt) { y[pt] = (f32x4){0.f, 0.f, 0.f, 0.f}; yo[pt] = (f32x4){0.f, 0.f, 0.f, 0.f}; }
#pragma unroll
        for (int ks2 = 0; ks2 < 4; ++ks2) {
            if (2 * ks2 <= lt) {
                f32x4 cb[2];
#pragma unroll
                for (int h2 = 0; h2 < 2; ++h2) {
                    const int st = 2 * ks2 + h2;
                    cb[h2] = (f32x4){0.f, 0.f, 0.f, 0.f};
                    if (st <= lt) {
#pragma unroll
                        for (int ks = 0; ks < 4; ++ks)
                            cb[h2] = __builtin_amdgcn_mfma_f32_16x16x32_bf16(*(const bf16x8*)(Bc + (st * 16 + fr) * SSD_P + ks * 32 + fq * 8), cf[ks], cb[h2], 0, 0, 0);
#pragma unroll
                        for (int jj = 0; jj < 4; ++jj) {
                            const int sidx = st * 16 + 4 * fq + jj;
                            cb[h2][jj] = (sidx <= l) ? cb[h2][jj] * __expf(acs_l - acs[hw * 128 + sidx]) * dtl[hw * 128 + sidx] : 0.f;
                        }
                    }
                }
                u32x4 wv; wv.x = pack2(cb[0].x, cb[0].y); wv.y = pack2(cb[0].z, cb[0].w); wv.z = pack2(cb[1].x, cb[1].y); wv.w = pack2(cb[1].z, cb[1].w);
                const bf16x8 mf = __builtin_bit_cast(bf16x8, wv);
#pragma unroll
                for (int pt = 0; pt < 4; ++pt) {
                    const bf16_t* xp = XsT + (hw * 64 + pt * 16 + fr) * SSD_P + ks2 * 32 + 4 * fq;
                    const u32x2 a0 = *(const u32x2*)xp, a1 = *(const u32x2*)(xp + 16);
                    u32x4 xv; xv.x = a0.x; xv.y = a0.y; xv.z = a1.x; xv.w = a1.y;
                    y[pt] = __builtin_amdgcn_mfma_f32_16x16x32_bf16(__builtin_bit_cast(bf16x8, xv), mf, y[pt], 0, 0, 0);
                }
            }
            __builtin_amdgcn_sched_barrier(0);
        }
        __builtin_amdgcn_sched_barrier(0);
#pragma unroll
        for (int pt = 0; pt < 4; ++pt)
#pragma unroll
            for (int ks = 0; ks < 4; ++ks) yo[pt] = __builtin_amdgcn_mfma_f32_16x16x32_bf16(*(const bf16x8*)(pp + (pt * 16 + fr) * 128 + ks * 32 + fq * 8), cf[ks], yo[pt], 0, 0, 0);
        __builtin_amdgcn_sched_barrier(0);
        const float el = __expf(acs_l);
#pragma unroll
        for (int pt = 0; pt < 4; ++pt) {
            const int p0 = pt * 16 + 4 * fq;
            const u32x2 zz = *(const u32x2*)(proj + (tok0 + l) * PROJ_LD + C_Z + hh * 64 + p0);
            const float z0 = bflo(zz.x), z1 = bfhi(zz.x), z2 = bflo(zz.y), z3 = bfhi(zz.y);
            const bf16_t* xq = XsT + (hw * 64 + p0) * SSD_P + l;
            const float x0 = bf2f(xq[0]), x1 = bf2f(xq[SSD_P]), x2 = bf2f(xq[2 * SSD_P]), x3 = bf2f(xq[3 * SSD_P]);
            u32x2 ob;
            ob.x = pack2((y[pt].x + el * yo[pt].x + dsk * x0) * silu(z0), (y[pt].y + el * yo[pt].y + dsk * x1) * silu(z1));
            ob.y = pack2((y[pt].z + el * yo[pt].z + dsk * x2) * silu(z2), (y[pt].w + el * yo[pt].w + dsk * x3) * silu(z3));
            *(u32x2*)(yssd + (tok0 + l) * 512 + hh * 64 + p0) = ob;
        }
    }
    __syncthreads();
}

__device__ __forceinline__ void d_mix_prep(const float* __restrict__ onsa, const bf16_t* __restrict__ yssd, const float* __restrict__ nsa_w, const float* __restrict__ ssd_w, bf16_t* __restrict__ A2, int vb) {
    const int tid_ = tid_opaque(); const int lane = tid_ & 63, wid = tid_ >> 6;
    const size_t row0 = (size_t)vb * 32 + wid * 4;
    f32x4 a[4][2], y[4][2];
#pragma unroll
    for (int r = 0; r < 4; ++r)
#pragma unroll
        for (int k = 0; k < 2; ++k) {
            a[r][k] = *(const f32x4*)(onsa + (row0 + r) * 512 + k * 256 + lane * 4);
            const u32x2 yy = *(const u32x2*)(yssd + (row0 + r) * 512 + k * 256 + lane * 4);
            y[r][k] = (f32x4){bflo(yy.x), bfhi(yy.x), bflo(yy.y), bfhi(yy.y)};
        }
    float ra[4], ry[4];
#pragma unroll
    for (int r = 0; r < 4; ++r) {
        float s0 = 0.f, s1 = 0.f;
#pragma unroll
        for (int k = 0; k < 2; ++k) {
            s0 += a[r][k].x * a[r][k].x + a[r][k].y * a[r][k].y + a[r][k].z * a[r][k].z + a[r][k].w * a[r][k].w;
            s1 += y[r][k].x * y[r][k].x + y[r][k].y * y[r][k].y + y[r][k].z * y[r][k].z + y[r][k].w * y[r][k].w;
        }
        ra[r] = rsqrtf(wave_sum(s0) * (1.0f / 512) + EPS); ry[r] = rsqrtf(wave_sum(s1) * (1.0f / 512) + EPS);
    }
#pragma unroll
    for (int k = 0; k < 2; ++k) {
        const int col = k * 256 + lane * 4;
        const f32x4 wn = *(const f32x4*)(nsa_w + col), wsd = *(const f32x4*)(ssd_w + col);
#pragma unroll
        for (int r = 0; r < 4; ++r) {
            const f32x4 p = a[r][k] * ra[r] * wn, q = y[r][k] * ry[r] * wsd;
            u32x2 o; o.x = pack2(p.x, p.y); o.y = pack2(p.z, p.w);
            *(u32x2*)(A2 + (row0 + r) * DM + col) = o;
            u32x2 o2; o2.x = pack2(q.x, q.y); o2.y = pack2(q.z, q.w);
            *(u32x2*)(A2 + (row0 + r) * DM + 512 + col) = o2;
        }
    }
}

__device__ __forceinline__ void d_quant_rows(const float* __restrict__ src, unsigned char* __restrict__ dst, float* __restrict__ scale, int vb) {
    const int tid_ = tid_opaque(); const int lane = tid_ & 63, row = vb * 8 + (tid_ >> 6);
    const float* rp = src + (size_t)row * DM + lane * 16;
    f32x4 v[4];
#pragma unroll
    for (int i = 0; i < 4; ++i) v[i] = *(const f32x4*)(rp + i * 4);
    float mx = 0.f;
#pragma unroll
    for (int i = 0; i < 4; ++i) mx = fmaxf(mx, fmaxf(fmaxf(fabsf(v[i].x), fabsf(v[i].y)), fmaxf(fabsf(v[i].z), fabsf(v[i].w))));
    mx = wave_max(mx);
    const float sc = mx > 0.f ? mx * (1.0f / 6.0f) : 1.0f;
    const float inv = 1.0f / sc;
    u32x2 o;
#pragma unroll
    for (int h = 0; h < 2; ++h) {
        unsigned wv = 0u;
        wv = __builtin_amdgcn_cvt_scalef32_pk_fp4_f32(wv, v[2 * h].x * inv, v[2 * h].y * inv, 1.0f, 0);
        wv = __builtin_amdgcn_cvt_scalef32_pk_fp4_f32(wv, v[2 * h].z * inv, v[2 * h].w * inv, 1.0f, 1);
        wv = __builtin_amdgcn_cvt_scalef32_pk_fp4_f32(wv, v[2 * h + 1].x * inv, v[2 * h + 1].y * inv, 1.0f, 2);
        wv = __builtin_amdgcn_cvt_scalef32_pk_fp4_f32(wv, v[2 * h + 1].z * inv, v[2 * h + 1].w * inv, 1.0f, 3);
        o[h] = wv;
    }
    *(u32x2*)(dst + (size_t)row * 512 + lane * 8) = o;
    if (lane == 0) scale[row] = sc;
}

__device__ __forceinline__ unsigned mono_u(float f) { const unsigned u = __float_as_uint(f); return (u & 0x80000000u) ? ~u : (u | 0x80000000u); }
__device__ __forceinline__ float unmono_f(unsigned m) { const unsigned u = (m & 0x80000000u) ? (m & 0x7fffffffu) : ~m; return __uint_as_float(u); }
__device__ __forceinline__ void d_peer_route(const bf16_t* __restrict__ qp, const float* __restrict__ qnw, const bf16_t* __restrict__ subk, int* __restrict__ eidx, float* __restrict__ gate,
                                             int tile, int h, char* lds) {
    const int tid = tid_opaque(), lane = tid & 63, w = tid >> 6, fr = lane & 15, fq = lane >> 4;
    const size_t tok = (size_t)tile * 128 + w * 16 + fr;
    bf16x8 qf[2][4];
    {
        const bf16_t* qrow = qp + tok * 2048 + h * 256;
        u32x4 raw[2][4];
        float ss = 0.f;
#pragma unroll
        for (int k = 0; k < 2; ++k)
#pragma unroll
            for (int ks = 0; ks < 4; ++ks) {
                const u32x4 r = *(const u32x4*)(qrow + k * 128 + ks * 32 + fq * 8);
                raw[k][ks] = r;
                ss += bflo(r.x) * bflo(r.x) + bfhi(r.x) * bfhi(r.x) + bflo(r.y) * bflo(r.y) + bfhi(r.y) * bfhi(r.y)
                    + bflo(r.z) * bflo(r.z) + bfhi(r.z) * bfhi(r.z) + bflo(r.w) * bflo(r.w) + bfhi(r.w) * bfhi(r.w);
            }
        ss += __shfl_xor(ss, 16); ss += __shfl_xor(ss, 32);
        const float rs = rsqrtf(ss * (1.0f / 256) + EPS);
#pragma unroll
        for (int k = 0; k < 2; ++k)
#pragma unroll
            for (int ks = 0; ks < 4; ++ks) {
                const float* wp = qnw + k * 128 + ks * 32 + fq * 8;
                const f32x4 w0 = *(const f32x4*)wp, w1 = *(const f32x4*)(wp + 4);
                const u32x4 r = raw[k][ks];
                u32x4 o;
                o.x = pack2(bflo(r.x) * rs * w0.x, bfhi(r.x) * rs * w0.y); o.y = pack2(bflo(r.y) * rs * w0.z, bfhi(r.y) * rs * w0.w);
                o.z = pack2(bflo(r.z) * rs * w1.x, bfhi(r.z) * rs * w1.y); o.w = pack2(bflo(r.w) * rs * w1.z, bfhi(r.w) * rs * w1.w);
                qf[k][ks] = __builtin_bit_cast(bf16x8, o);
            }
    }
    unsigned L[2][16];
#pragma unroll
    for (int k = 0; k < 2; ++k) {
        f32x4 acc[8];
#pragma unroll
        for (int kt = 0; kt < 8; ++kt) acc[kt] = (f32x4){0.f, 0.f, 0.f, 0.f};
        const bf16_t* kb = subk + (size_t)((h * 2 + k) * 128) * 128;
#pragma unroll
        for (int kt = 0; kt < 8; ++kt)
#pragma unroll
            for (int ks = 0; ks < 4; ++ks) {
                const bf16x8 af = *(const bf16x8*)(kb + (size_t)(kt * 16 + fr) * 128 + ks * 32 + fq * 8);
                acc[kt] = __builtin_amdgcn_mfma_f32_16x16x32_bf16(af, qf[k][ks], acc[kt], 0, 0, 0);
            }
#pragma unroll
        for (int i = 0; i < 16; ++i) L[k][i] = 0u;
#pragma unroll
        for (int kt = 0; kt < 8; ++kt)
#pragma unroll
            for (int jj = 0; jj < 4; ++jj) {
                const int idx = kt * 16 + 4 * fq + jj;
                ins16(L[k], (mono_u(acc[kt][jj]) & ~0x7Fu) | (unsigned)(127 - idx));
            }
#pragma unroll
        for (int r = 16; r <= 32; r <<= 1) {
            unsigned P[16];
#pragma unroll
            for (int i = 0; i < 16; ++i) P[i] = (unsigned)__shfl_xor((int)L[k][i], r);
            merge16(L[k], P);
        }
    }
    unsigned T[16];
#pragma unroll
    for (int i = 0; i < 16; ++i) T[i] = 0u;
#pragma unroll
    for (int a = 0; a < 16; ++a) {
        const float va = unmono_f(L[0][a] & ~0x7Fu);
#pragma unroll
        for (int bb = 0; bb < 16; ++bb) {
            if (bb <= 16 / (a + 1) - 1) {
                const float sum = va + unmono_f(L[1][bb] & ~0x7Fu);
                ins16(T, (mono_u(sum) & ~0xFFu) | (unsigned)(255 - (a * 16 + bb)));
            }
        }
    }
    unsigned char* li = (unsigned char*)lds + w * 512 + fr * 32;
    if (fq == 0) {
#pragma unroll
        for (int a = 0; a < 16; ++a) { li[a] = (unsigned char)(127 - (L[0][a] & 0x7Fu)); li[16 + a] = (unsigned char)(127 - (L[1][a] & 0x7Fu)); }
    }
    __syncthreads();
    const float s0 = unmono_f(T[0] & ~0xFFu);
    float pe[16]; float sum = 0.f;
#pragma unroll
    for (int i = 0; i < 16; ++i) { pe[i] = __expf(unmono_f(T[i] & ~0xFFu) - s0); sum += pe[i]; }
    const float inv = 1.0f / sum;
    unsigned cod[4] = {0u, 0u, 0u, 0u}; float gv[4] = {0.f, 0.f, 0.f, 0.f};
#pragma unroll
    for (int i = 0; i < 16; ++i) if ((i >> 2) == fq) { cod[i & 3] = 255u - (T[i] & 0xFFu); gv[i & 3] = pe[i] * inv; }
    int ev[4];
#pragma unroll
    for (int i = 0; i < 4; ++i) ev[i] = (int)li[cod[i] >> 4] * 128 + (int)li[16 + (cod[i] & 15u)];
    *(u32x4*)(eidx + (tok * 8 + h) * 16 + fq * 4) = (u32x4){(unsigned)ev[0], (unsigned)ev[1], (unsigned)ev[2], (unsigned)ev[3]};
    *(f32x4*)(gate + (tok * 8 + h) * 16 + fq * 4) = (f32x4){gv[0], gv[1], gv[2], gv[3]};
    __syncthreads();
}

__device__ __forceinline__ void cvt16(const u32x2 q, f32x2 (&f)[8]) {
#pragma unroll
    for (int i = 0; i < 2; ++i) {
        f[4 * i] = __builtin_amdgcn_cvt_scalef32_pk_f32_fp4(q[i], 1.0f, 0); f[4 * i + 1] = __builtin_amdgcn_cvt_scalef32_pk_f32_fp4(q[i], 1.0f, 1);
        f[4 * i + 2] = __builtin_amdgcn_cvt_scalef32_pk_f32_fp4(q[i], 1.0f, 2); f[4 * i + 3] = __builtin_amdgcn_cvt_scalef32_pk_f32_fp4(q[i], 1.0f, 3);
    }
}
__device__ __forceinline__ void d_peer_expert8(const bf16_t* __restrict__ h2, const unsigned char* __restrict__ down8, const unsigned char* __restrict__ up8, const float* __restrict__ dscale,
                                               const float* __restrict__ uscale, const int* __restrict__ eidx, const float* __restrict__ gate, const float* __restrict__ mod,
                                               const float* __restrict__ fw, float* __restrict__ out, int vb) {
    const int tid = tid_opaque(), lane = tid & 63, wid = tid >> 6;
    const size_t tok = (size_t)vb * 8 + wid; const int b = (int)(tok >> 13);
    const int e_lo = eidx[tok * 128 + lane], e_hi = eidx[tok * 128 + 64 + lane];
    const float c_lo = gate[tok * 128 + lane] * uscale[e_lo], c_hi = gate[tok * 128 + 64 + lane] * uscale[e_hi];
    const float d_lo = dscale[e_lo], d_hi = dscale[e_hi];
    f32x2 hx[8], acc[8];
    {
        const u32x4 v0 = *(const u32x4*)(h2 + tok * DM + lane * 16), v1 = *(const u32x4*)(h2 + tok * DM + lane * 16 + 8);
        hx[0] = (f32x2){bflo(v0.x), bfhi(v0.x)}; hx[1] = (f32x2){bflo(v0.y), bfhi(v0.y)}; hx[2] = (f32x2){bflo(v0.z), bfhi(v0.z)}; hx[3] = (f32x2){bflo(v0.w), bfhi(v0.w)};
        hx[4] = (f32x2){bflo(v1.x), bfhi(v1.x)}; hx[5] = (f32x2){bflo(v1.y), bfhi(v1.y)}; hx[6] = (f32x2){bflo(v1.z), bfhi(v1.z)}; hx[7] = (f32x2){bflo(v1.w), bfhi(v1.w)};
    }
#pragma unroll
    for (int e = 0; e < 8; ++e) acc[e] = (f32x2){0.f, 0.f};
    const int es = lane >> 3;
    u32x2 dq[8], uq[8], dn[8], un[8];
#pragma unroll
    for (int i = 0; i < 8; ++i) {
        const int e = __builtin_amdgcn_readlane(e_lo, i);
        dq[i] = *(const u32x2*)(down8 + (size_t)e * 512 + lane * 8);
        uq[i] = *(const u32x2*)(up8 + (size_t)e * 512 + lane * 8);
    }
#pragma unroll 1
    for (int j0 = 0; j0 < 128; j0 += 8) {
        if (j0 + 8 < 128) {
            const int jn = j0 + 8;
#pragma unroll
            for (int i = 0; i < 8; ++i) {
                const int e = jn < 64 ? __builtin_amdgcn_readlane(e_lo, jn + i) : __builtin_amdgcn_readlane(e_hi, jn - 64 + i);
                dn[i] = *(const u32x2*)(down8 + (size_t)e * 512 + lane * 8);
                un[i] = *(const u32x2*)(up8 + (size_t)e * 512 + lane * 8);
            }
        }
        const int sl = (j0 & 63) + es;
        const float my_c = j0 < 64 ? __shfl(c_lo, sl) : __shfl(c_hi, sl);
        const float my_ds = j0 < 64 ? __shfl(d_lo, sl) : __shfl(d_hi, sl);
        float part[8];
#pragma unroll
        for (int i = 0; i < 8; ++i) {
            f32x2 f[8]; cvt16(dq[i], f);
            f32x2 s2 = hx[0] * f[0];
#pragma unroll
            for (int e = 1; e < 8; ++e) s2 = __builtin_elementwise_fma(hx[e], f[e], s2);
            part[i] = s2.x + s2.y;
        }
        float q4[4], q2[2], q1;
#pragma unroll
        for (int i = 0; i < 4; ++i) { const bool up = (lane & 32) != 0; const float send = up ? part[i] : part[i + 4]; const float keep = up ? part[i + 4] : part[i]; q4[i] = keep + __shfl_xor(send, 32); }
#pragma unroll
        for (int i = 0; i < 2; ++i) { const bool up = (lane & 16) != 0; const float send = up ? q4[i] : q4[i + 2]; const float keep = up ? q4[i + 2] : q4[i]; q2[i] = keep + __shfl_xor(send, 16); }
        { const bool up = (lane & 8) != 0; const float send = up ? q2[0] : q2[1]; const float keep = up ? q2[1] : q2[0]; q1 = keep + __shfl_xor(send, 8); }
        q1 += __shfl_xor(q1, 4); q1 += __shfl_xor(q1, 2); q1 += __shfl_xor(q1, 1);
        const float a = gelu_tanh(q1 * my_ds) * my_c;
#pragma unroll
        for (int i = 0; i < 8; ++i) {
            const float c = __uint_as_float((unsigned)__builtin_amdgcn_readlane((int)__float_as_uint(a), 8 * i));
            const f32x2 c2 = {c, c};
            f32x2 f[8]; cvt16(uq[i], f);
#pragma unroll
            for (int e = 0; e < 8; ++e) acc[e] = __builtin_elementwise_fma(f[e], c2, acc[e]);
        }
#pragma unroll
        for (int i = 0; i < 8; ++i) { dq[i] = dn[i]; uq[i] = un[i]; }
    }
    float x2[16]; float ss = 0.f;
#pragma unroll
    for (int q4i = 0; q4i < 4; ++q4i) {
        const int col = lane * 16 + q4i * 4;
        const f32x4 xv = *(const f32x4*)(out + tok * DM + col);
        const f32x4 g2 = *(const f32x4*)(mod + b * 6144 + 5120 + col);
        const int e0 = q4i * 4;
        x2[e0 + 0] = xv.x + g2.x * acc[2 * q4i].x; x2[e0 + 1] = xv.y + g2.y * acc[2 * q4i].y; x2[e0 + 2] = xv.z + g2.z * acc[2 * q4i + 1].x; x2[e0 + 3] = xv.w + g2.w * acc[2 * q4i + 1].y;
        ss += x2[e0] * x2[e0] + x2[e0 + 1] * x2[e0 + 1] + x2[e0 + 2] * x2[e0 + 2] + x2[e0 + 3] * x2[e0 + 3];
    }
    ss = wave_sum(ss);
    const float r = rsqrtf(ss * (1.0f / DM) + EPS);
#pragma unroll
    for (int q4i = 0; q4i < 4; ++q4i) {
        const int col = lane * 16 + q4i * 4;
        const f32x4 wv = *(const f32x4*)(fw + col);
        const int e0 = q4i * 4;
        *(f32x4*)(out + tok * DM + col) = (f32x4){x2[e0] * r * wv.x, x2[e0 + 1] * r * wv.y, x2[e0 + 2] * r * wv.z, x2[e0 + 3] * r * wv.w};
    }
}

#define XB_TMO      128
#define XB_XCNT(j)  (256  + 64 * (j))
#define XB_XSUB(j)  (1280 + 64 * (j))
#define XB_XGEN(j)  (2304 + 64 * (j))
#define XB_TOP      3328
#define XB_TOPGEN   3392
#define XCD_BAR_WORDS 3456
#define XB_SPIN_CAP (1u << 18)

__device__ __forceinline__ unsigned xb_ld(unsigned* p)              { return __hip_atomic_load(p, __ATOMIC_RELAXED, __HIP_MEMORY_SCOPE_AGENT); }
__device__ __forceinline__ unsigned xb_add(unsigned* p, unsigned v) { return __hip_atomic_fetch_add(p, v, __ATOMIC_RELAXED, __HIP_MEMORY_SCOPE_AGENT); }
__device__ __forceinline__ unsigned xb_xcc_id() { return (unsigned)__builtin_amdgcn_s_getreg((3 << 11) | 20) & 0xFu; }
#define XB_SPIN(cond, bar) do { unsigned _sp = 0; while (cond) { __builtin_amdgcn_s_sleep(1); \
    if ((++_sp & 255u) == 0u) { if (xb_ld(&(bar)[XB_TMO])) break; if (_sp > XB_SPIN_CAP) { atomicAdd(&(bar)[XB_TMO], 1u); break; } } } } while (0)

struct XcdBarrier {
    unsigned* bar; unsigned x;
    volatile __attribute__((address_space(3))) unsigned* st;
};

__device__ __forceinline__ XcdBarrier xcd_barrier_post(unsigned* bar, volatile __attribute__((address_space(3))) unsigned* st) {
    XcdBarrier b; b.bar = bar; b.x = xb_xcc_id(); b.st = st;
    if (threadIdx.x == 0) (void)xb_add(&bar[XB_XCNT(b.x)], 1u);
    return b;
}
__device__ __forceinline__ void xcd_barrier_complete(unsigned* bar, unsigned x, unsigned& nloc, unsigned& nx) {
    const unsigned G = gridDim.x * gridDim.y * gridDim.z;
    unsigned sum, cnt, mine, sp = 0u;
    for (;;) {
        sum = 0u; cnt = 0u; mine = 0u;
#pragma unroll
        for (unsigned j = 0; j < 16; ++j) { const unsigned c = xb_ld(&bar[XB_XCNT(j)]); sum += c; cnt += (c > 0u) ? 1u : 0u; mine = (j == x) ? c : mine; }
        if (sum == G) break;
        __builtin_amdgcn_s_sleep(1);
        if ((++sp & 255u) == 0u) { if (xb_ld(&bar[XB_TMO])) break; if (sp > XB_SPIN_CAP) { atomicAdd(&bar[XB_TMO], 1u); break; } }
    }
    nloc = mine > 0u ? mine : 1u; nx = cnt > 0u ? cnt : 1u;
}

__device__ __forceinline__ void xcd_barrier(const XcdBarrier& b) {
    asm volatile("s_waitcnt vmcnt(0)" ::: "memory");
    __syncthreads();
    if (threadIdx.x == 0) {
        unsigned* bar = b.bar;
        __builtin_amdgcn_s_waitcnt(0);
        unsigned nloc = b.st[0], nx = b.st[1];
        if (nloc == 0u) { xcd_barrier_complete(bar, b.x, nloc, nx); b.st[0] = nloc; b.st[1] = nx; }
        const unsigned old = xb_add(&bar[XB_XSUB(b.x)], 1u);
        const unsigned gen = old / nloc;
        if (old + 1u == (gen + 1u) * nloc) {
            __builtin_amdgcn_fence(__ATOMIC_RELEASE, "agent");
            asm volatile("s_waitcnt vmcnt(0)" ::: "memory");
            const unsigned og = xb_add(&bar[XB_TOP], 1u);
            const unsigned tg = og / nx;
            if (og + 1u == (tg + 1u) * nx) xb_add(&bar[XB_TOPGEN], 1u);
            else XB_SPIN(xb_ld(&bar[XB_TOPGEN]) == tg, bar);
            __builtin_amdgcn_fence(__ATOMIC_ACQUIRE, "agent");
            xb_add(&bar[XB_XGEN(b.x)], 1u);
            asm volatile("s_waitcnt vmcnt(0)" ::: "memory");
        } else {
            XB_SPIN(xb_ld(&bar[XB_XGEN(b.x)]) == gen, bar);
            __builtin_amdgcn_fence(__ATOMIC_ACQUIRE, "agent");
            asm volatile("s_waitcnt vmcnt(0)" ::: "memory");
        }
    }
    __syncthreads();
}


struct Params {
    const float *x, *c, *w_ada, *b_ada, *norm1_w, *w_in, *cmp_pe_k, *cmp_pe_v, *cmp_w1_k, *cmp_w2_k, *cmp_w1_v, *cmp_w2_v, *nsa_norm_w, *conv_w, *conv_b, *dt_bias, *a_log, *d_skip,
        *ssd_norm_w, *w_out, *norm2_w, *peer_wq, *peer_qnorm_w, *peer_sub_keys, *peer_down, *peer_up, *final_norm_w;
    float* out; char* ws;
};
#define LDS_BYTES 147456
#define LDS_MISC  (LDS_BYTES - 64)

__global__ __launch_bounds__(512, 2) void mega(Params p) {
    __shared__ __attribute__((aligned(16))) unsigned char lds_raw[LDS_BYTES];
    char* lds = (char*)lds_raw;
    PG8_LAS unsigned char* lds3 = (PG8_LAS unsigned char*)lds_raw;
    int* s_vb = (int*)(lds + LDS_MISC);
    cg::grid_group grid = cg::this_grid();
    volatile __attribute__((address_space(3))) unsigned* xb_st = (volatile __attribute__((address_space(3))) unsigned*)((PG8_LAS unsigned char*)lds_raw + LDS_MISC + 16);
    if (threadIdx.x == 0) { xb_st[0] = 0u; xb_st[1] = 0u; }
    __syncthreads();
    const XcdBarrier xbar = xcd_barrier_post((unsigned*)(p.ws + OFF_BAR), xb_st);
    const int G = gridDim.x, bid = blockIdx.x;
    if (bid == 0 && threadIdx.x == 0) { ((unsigned*)(p.ws + OFF_CTR))[0] = 0u; ((unsigned*)(p.ws + OFF_CTR))[64] = 0u; ((unsigned*)(p.ws + OFF_CTR))[128] = 0u; }
    for (int vb = bid; vb < 7906; vb += G) {
        int v = vb;
        if (v < 1536) { d_transpose_w(p.w_in, ((bf16_t*)(p.ws + OFF_WIN_T)), 1024, 2848, 1, 96, v, lds); }
        else if ((v -= 1536) < 512) { d_transpose_w(p.w_out, ((bf16_t*)(p.ws + OFF_WOUT_T)), 1024, 1024, 0, 32, v, lds); }
        else if ((v -= 512) < 1024) { d_transpose_w(p.peer_wq, ((bf16_t*)(p.ws + OFF_WQ_T)), 1024, 2048, 0, 64, v, lds); }
        else if ((v -= 1024) < 256) { d_transpose_w(p.cmp_w1_k, ((bf16_t*)(p.ws + OFF_W1K_T)), 2048, 256, 0, 8, v, lds); }
        else if ((v -= 256) < 256) { d_transpose_w(p.cmp_w1_v, ((bf16_t*)(p.ws + OFF_W1V_T)), 2048, 256, 0, 8, v, lds); }
        else if ((v -= 256) < 2048) { d_quant_rows(p.peer_down, ((unsigned char*)(p.ws + OFF_DOWN)), ((float*)(p.ws + OFF_UP)), v); }
        else if ((v -= 2048) < 2048) { d_quant_rows(p.peer_up, ((unsigned char*)(p.ws + OFF_DOWN + MIB(8))), ((float*)(p.ws + OFF_UP + 65536)), v); }
        else if ((v -= 2048) < 1) { d_convert_bf16(p.peer_sub_keys, ((bf16_t*)(p.ws + OFF_SUBK)), (size_t)8 * 2 * 128 * 128 / 8, 0, 1); }
        else if ((v -= 1) < 96) { d_mod(p.c, p.w_ada, p.b_ada, ((float*)(p.ws + OFF_MOD)), v, lds); }
        else if ((v -= 96) < 128) { d_rope_table(((float2*)(p.ws + OFF_ROPE)), v); }
        else { d_bias1(p.cmp_pe_k, p.cmp_w1_k, p.cmp_pe_v, p.cmp_w1_v, ((float*)(p.ws + OFF_BIAS1))); }
    }
    grid.sync();
    for (int vb = bid; vb < NTOK / 32; vb += G) d_norm_mod(p.x, p.norm1_w, ((float*)(p.ws + OFF_MOD)), 0, 1024, ((bf16_t*)(p.ws + OFF_H)), vb);
    xcd_barrier(xbar);
    {
        const pg8::Gemm g{((bf16_t*)(p.ws + OFF_H)), ((bf16_t*)(p.ws + OFF_WIN_T)), NTOK, NIN_PAD, 1024, 1024};
        pg8::StaticOrder S; S.init(NTOK, NIN_PAD, G, bid);
        const pg8::Epi<EpInProj> E{{((bf16_t*)(p.ws + OFF_PROJ)), ((bf16_t*)(p.ws + OFF_QROPE)), ((bf16_t*)(p.ws + OFF_KVP)), ((float*)(p.ws + OFF_SMALL)), ((float2*)(p.ws + OFF_ROPE)), p.dt_bias}};
        pg8::gemm_phase(lds3, g, S, E);
    }
    xcd_barrier(xbar);
    {
        {
            const pg8::Gemm g{((bf16_t*)(p.ws + OFF_KVP)) + 0 * KVP_SEG, ((bf16_t*)(p.ws + OFF_W1K_T)), 8192, 256, 2048, 1024};
            pg8::StaticOrder S; S.init(8192, 256, G, bid);
            const pg8::Epi<EpCmpHid> E{{((bf16_t*)(p.ws + OFF_HIDK)), ((float*)(p.ws + OFF_BIAS1))}};
            pg8::gemm_phase(lds3, g, S, E);
        }
        {
            const pg8::Gemm g{((bf16_t*)(p.ws + OFF_KVP)) + 1 * KVP_SEG, ((bf16_t*)(p.ws + OFF_W1V_T)), 8192, 256, 2048, 1024};
            pg8::StaticOrder S; S.init(8192, 256, G, (bid + G / 2) % G);
            const pg8::Epi<EpCmpHid> E{{((bf16_t*)(p.ws + OFF_HIDV)), ((float*)(p.ws + OFF_BIAS1)) + 256}};
            pg8::gemm_phase(lds3, g, S, E);
        }
        __syncthreads();
        for (int vb = bid; vb < 1024; vb += G) d_ssd_states(((bf16_t*)(p.ws + OFF_PROJ)), ((float*)(p.ws + OFF_SMALL)), p.conv_w, p.conv_b, p.a_log, ((float*)(p.ws + OFF_ONSA)), ((float*)(p.ws + OFF_CTR + 4096)), vb, lds);
    }
    xcd_barrier(xbar);
    for (int vb = bid; vb < 2048 + 128; vb += G) {
        if (vb < 1024) d_cmp_out(((bf16_t*)(p.ws + OFF_HIDK)), p.cmp_w2_k, ((bf16_t*)(p.ws + OFF_KC)), vb); else if (vb < 2048) d_cmp_out(((bf16_t*)(p.ws + OFF_HIDV)), p.cmp_w2_v, ((bf16_t*)(p.ws + OFF_VC)), vb - 1024);
        else d_ssd_scan(((float*)(p.ws + OFF_ONSA)), ((float*)(p.ws + OFF_CTR + 4096)), ((bf16_t*)(p.ws + OFF_EIDX)), vb - 2048);
    }
    xcd_barrier(xbar);
    for (;;) {
        if (threadIdx.x == 0) *s_vb = (int)atomicAdd(&((unsigned*)(p.ws + OFF_CTR))[0], 1u);
        __syncthreads();
        const int i = *s_vb;
        __syncthreads();
        if (i >= 2048) break;
        const int qt = 127 - (i >> 4), bg = i & 15;
        d_nsa_cmp(((bf16_t*)(p.ws + OFF_PROJ)), ((bf16_t*)(p.ws + OFF_KC)), ((bf16_t*)(p.ws + OFF_VC)), ((float*)(p.ws + OFF_SMALL)), ((float*)(p.ws + OFF_ONSA)), ((unsigned*)(p.ws + OFF_HIDK)) + (size_t)(bg * 128 + qt) * 512, bg >> 1, bg & 1, qt, lds);
    }
    for (;;) {
        if (threadIdx.x == 0) *s_vb = (int)atomicAdd(&((unsigned*)(p.ws + OFF_CTR))[64], 1u);
        __syncthreads();
        const int i = *s_vb;
        __syncthreads();
        if (i >= 1024) break;
        d_ssd_out(((bf16_t*)(p.ws + OFF_PROJ)), ((float*)(p.ws + OFF_SMALL)), p.conv_w, p.conv_b, p.a_log, p.d_skip, ((bf16_t*)(p.ws + OFF_EIDX)), ((bf16_t*)(p.ws + OFF_YSSD)), i, lds);
    }
    xcd_barrier(xbar);
    for (;;) {
        if (threadIdx.x == 0) *s_vb = (int)atomicAdd(&((unsigned*)(p.ws + OFF_CTR))[128], 1u);
        __syncthreads();
        const int i = *s_vb;
        __syncthreads();
        if (i >= 2048) break;
        const int qt = 127 - (i >> 4), bg = i & 15;
        d_nsa_attn(((bf16_t*)(p.ws + OFF_QROPE)), ((bf16_t*)(p.ws + OFF_KVP)), ((float*)(p.ws + OFF_SMALL)), ((float*)(p.ws + OFF_ONSA)), ((unsigned*)(p.ws + OFF_HIDK)) + (size_t)(bg * 128 + qt) * 512, bg >> 1, bg & 1, qt, lds);
    }
    xcd_barrier(xbar);
    for (int vb = bid; vb < NTOK / 32; vb += G) d_mix_prep(((float*)(p.ws + OFF_ONSA)), ((bf16_t*)(p.ws + OFF_YSSD)), p.nsa_norm_w, p.ssd_norm_w, ((bf16_t*)(p.ws + OFF_H)), vb);
    xcd_barrier(xbar);
    {
        const pg8::Gemm g{((bf16_t*)(p.ws + OFF_H)), ((bf16_t*)(p.ws + OFF_WOUT_T)), NTOK, 1024, 1024, 1024};
        pg8::StaticOrder S; S.init(NTOK, 1024, G, bid);
        const pg8::Epi<EpOutProj> E{{p.x, ((float*)(p.ws + OFF_MOD)), p.out}};
        pg8::gemm_phase(lds3, g, S, E);
    }
    xcd_barrier(xbar);
    for (int vb = bid; vb < NTOK / 32; vb += G) d_norm_mod(p.out, p.norm2_w, ((float*)(p.ws + OFF_MOD)), 3072, 4096, ((bf16_t*)(p.ws + OFF_H)), vb);
    xcd_barrier(xbar);
    {
        const pg8::Gemm g{((bf16_t*)(p.ws + OFF_H)), ((bf16_t*)(p.ws + OFF_WQ_T)), NTOK, 2048, 1024, 1024};
        pg8::StaticOrder S; S.init(NTOK, 2048, G, bid);
        const pg8::Epi<EpStoreBf16> E{{((bf16_t*)(p.ws + OFF_PROJ)), 2048, 0}};
        pg8::gemm_phase(lds3, g, S, E);
    }
    xcd_barrier(xbar);
    for (int vb = bid; vb < 4096; vb += G) d_peer_route(((bf16_t*)(p.ws + OFF_PROJ)), p.peer_qnorm_w, ((bf16_t*)(p.ws + OFF_SUBK)), ((int*)(p.ws + OFF_EIDX)), ((float*)(p.ws + OFF_GATE)), vb >> 3, vb & 7, lds);
    xcd_barrier(xbar);
    for (int vb = bid; vb < NTOK / 8; vb += G) d_peer_expert8(((bf16_t*)(p.ws + OFF_H)), ((unsigned char*)(p.ws + OFF_DOWN)), ((unsigned char*)(p.ws + OFF_DOWN + MIB(8))), ((float*)(p.ws + OFF_UP)), ((float*)(p.ws + OFF_UP + 65536)), ((int*)(p.ws + OFF_EIDX)), ((float*)(p.ws + OFF_GATE)), ((float*)(p.ws + OFF_MOD)), p.final_norm_w, p.out, vb);
}

extern "C" void kernel_launch(void* const* d_in, const int* in_sizes, int n_in, void* d_out, int out_size, void* d_ws, size_t ws_size, hipStream_t stream) {
    if (ws_size < WS_NEED) { fprintf(stderr, "workspace too small\n"); return; }
    static int grid_blocks = 0;
    if (!grid_blocks) {
        int dev = 0, cus = 0, per_cu = 0;
        (void)hipGetDevice(&dev);
        (void)hipDeviceGetAttribute(&cus, hipDeviceAttributeMultiprocessorCount, dev);
        (void)hipOccupancyMaxActiveBlocksPerMultiprocessor(&per_cu, mega, 512, 0);
        if (per_cu < 1) fprintf(stderr, "occupancy query reports %d blocks per CU\n", per_cu);
        grid_blocks = cus;
    }
    Params p{};
    const float** pp = (const float**)&p;
    for (int i = 0; i < 27; ++i) pp[i] = (const float*)d_in[i];
    p.out = (float*)d_out; p.ws = (char*)d_ws;
    (void)hipMemsetAsync((char*)d_ws + OFF_BAR, 0, XCD_BAR_WORDS * 4, stream);
    void* args[] = {&p};
    hipError_t e = hipLaunchCooperativeKernel((void*)mega, dim3(grid_blocks), dim3(512), args, 0, stream);
    if (e != hipSuccess) fprintf(stderr, "cooperative launch failed: %s (grid %d)\n", hipGetErrorString(e), grid_blocks);
}
```

```cpp
#include <hip/hip_runtime.h>
#include <hip/hip_cooperative_groups.h>
#include <stdint.h>
#include <cstdio>
namespace cg = cooperative_groups;

typedef unsigned short bf16_t;
typedef short bf16x8 __attribute__((ext_vector_type(8)));
typedef float f32x4 __attribute__((ext_vector_type(4)));
typedef float f32x2 __attribute__((ext_vector_type(2)));
typedef unsigned u32x4 __attribute__((ext_vector_type(4)));
typedef unsigned u32x2 __attribute__((ext_vector_type(2)));

#define NB 8
#define SEQ 8192
#define NTOK 65536
#define DM 1024
#define PROJ_LD 2816
#define NIN_PAD 3072
#define C_Q 0
#define C_KCMP 512
#define C_KSEL 768
#define C_VSEL 896
#define C_KWIN 1024
#define C_VWIN 1152
#define C_Z 1280
#define C_XBC 1792
#define NCMP 511
#define EPS 1e-6f
#define KVP_SEG ((size_t)NB * 2 * SEQ * 64)

#define MIB(x) ((size_t)(x) << 20)
#define OFF_MOD    MIB(0)
#define OFF_ROPE   MIB(1)
#define OFF_BIAS1  MIB(2)
#define OFF_WIN_T  MIB(3)
#define OFF_WOUT_T MIB(9)
#define OFF_WQ_T   MIB(11)
#define OFF_SUBK   MIB(15)
#define OFF_W1K_T  MIB(16)
#define OFF_W1V_T  MIB(17)
#define OFF_KC     MIB(18)
#define OFF_VC     MIB(19)
#define OFF_HIDK   MIB(20)
#define OFF_HIDV   MIB(24)
#define OFF_DOWN   MIB(28)
#define OFF_UP     MIB(60)
#define OFF_SMALL  MIB(92)
#define OFF_H      MIB(100)
#define OFF_PROJ   MIB(228)
#define OFF_QROPE  MIB(580)
#define OFF_ONSA   MIB(644)
#define OFF_YSSD   MIB(772)
#define OFF_KVP    MIB(836)
#define OFF_EIDX   MIB(932)
#define OFF_GATE   MIB(964)
#define OFF_CTR    MIB(996)
#define OFF_BAR    (MIB(996) + 65536)
#define WS_NEED    MIB(997)

typedef __bf16 hwbf2 __attribute__((ext_vector_type(2)));
__device__ __forceinline__ bf16_t f2bf(float f) { const __bf16 h = (__bf16)f; return __builtin_bit_cast(bf16_t, h); }
__device__ __forceinline__ float bf2f(bf16_t h) { return __uint_as_float(((unsigned)h) << 16); }
__device__ __forceinline__ float bflo(unsigned u) { return __uint_as_float(u << 16); }
__device__ __forceinline__ float bfhi(unsigned u) { return __uint_as_float(u & 0xffff0000u); }
__device__ __forceinline__ unsigned pack2(float a, float b) { const f32x2 v = {a, b}; const hwbf2 r = __builtin_convertvector(v, hwbf2); return __builtin_bit_cast(unsigned, r); }
__device__ __forceinline__ float wave_sum(float v) {
#pragma unroll
    for (int o = 32; o; o >>= 1) v += __shfl_xor(v, o);
    return v;
}
__device__ __forceinline__ float wave_max(float v) {
#pragma unroll
    for (int o = 32; o; o >>= 1) v = fmaxf(v, __shfl_xor(v, o));
    return v;
}
__device__ __forceinline__ int tid_opaque() { int t = threadIdx.x; asm volatile("" : "+v"(t)); return t; }
__device__ __forceinline__ float gelu_tanh(float x) { return 0.5f * x * (1.0f + tanhf(0.7978845608028654f * (x + 0.044715f * x * x * x))); }
__device__ __forceinline__ float silu(float x) { return x / (1.0f + __expf(-x)); }
__device__ __forceinline__ float sigmoidf(float x) { return 1.0f / (1.0f + __expf(-x)); }
__device__ __forceinline__ float softplusf(float x) { return x > 20.f ? x : log1pf(__expf(x)); }

__device__ __forceinline__ int inproj_src(int n) {
    if (n < 1280) return n;
    if (n < 1792) return 1304 + (n - 1280);
    if (n < 2816) return 1816 + (n - 1792);
    if (n < 2840) return 1280 + (n - 2816);
    if (n < 2848) return 2840 + (n - 2840);
    return -1;
}
__device__ __forceinline__ void d_transpose_w(const float* __restrict__ W, bf16_t* __restrict__ Wt, int K, int N, int mode, int nbx, int vb, char* lds) {
    const int tid_ = tid_opaque(); const int half = tid_ >> 8, t256 = tid_ & 255, tile = vb * 2 + half;
    float (*t)[33] = (float (*)[33])(lds + half * 4352);
    const int n0 = (tile % nbx) * 32, k0 = (tile / nbx) * 32, tx = t256 & 31, ty = t256 >> 5;
#pragma unroll
    for (int i = 0; i < 4; ++i) {
        const int k = k0 + ty + 8 * i, n = n0 + tx;
        const int src = mode == 1 ? inproj_src(n) : n;
        t[ty + 8 * i][tx] = (src >= 0 && src < N) ? W[(size_t)k * N + src] : 0.f;
    }
    __syncthreads();
#pragma unroll
    for (int i = 0; i < 4; ++i) Wt[(size_t)(n0 + ty + 8 * i) * K + k0 + tx] = f2bf(t[tx][ty + 8 * i]);
    __syncthreads();
}
__device__ __forceinline__ void d_convert_bf16(const float* __restrict__ in, bf16_t* __restrict__ out, size_t n8, int vb, int nvb) {
    size_t i = (size_t)vb * 512 + tid_opaque();
    const size_t stride = (size_t)nvb * 512;
    for (; i < n8; i += stride) {
        const f32x4 a = ((const f32x4*)in)[2 * i], b = ((const f32x4*)in)[2 * i + 1];
        u32x4 o; o.x = pack2(a.x, a.y); o.y = pack2(a.z, a.w); o.z = pack2(b.x, b.y); o.w = pack2(b.z, b.w);
        ((u32x4*)out)[i] = o;
    }
}
__device__ __forceinline__ void d_mod(const float* __restrict__ c, const float* __restrict__ w_ada, const float* __restrict__ b_ada, float* __restrict__ mod, int vb, char* lds) {
    float (*part)[8][64] = (float (*)[8][64])lds;
    const int tid = tid_opaque(), jl = tid & 63, kq = tid >> 6, j = vb * 64 + jl;
    float acc[8];
#pragma unroll
    for (int b = 0; b < 8; ++b) acc[b] = 0.f;
    for (int k0 = kq * 128; k0 < kq * 128 + 128; k0 += 16) {
        float wv[16];
#pragma unroll
        for (int i = 0; i < 16; ++i) wv[i] = w_ada[(size_t)(k0 + i) * 6144 + j];
#pragma unroll
        for (int i = 0; i < 16; ++i)
#pragma unroll
            for (int b = 0; b < 8; ++b) acc[b] += c[b * 1024 + k0 + i] * wv[i];
    }
#pragma unroll
    for (int b = 0; b < 8; ++b) part[kq][b][jl] = acc[b];
    __syncthreads();
    {
        const int b = tid >> 6, jj = tid & 63;
        float s = b_ada[vb * 64 + jj];
#pragma unroll
        for (int q = 0; q < 8; ++q) s += part[q][b][jj];
        mod[b * 6144 + vb * 64 + jj] = s;
    }
    __syncthreads();
}
__device__ __forceinline__ void d_rope_table(float2* __restrict__ rope, int vb) {
    const int i = vb * 512 + tid_opaque();
    if (i >= SEQ * 8) return;
    const int pos = i >> 3, f = i & 7;
    const double inv = pow(500000.0, -(double)f / 8.0);
    const double ang = (double)pos * inv;
    rope[i] = make_float2((float)cos(ang), (float)sin(ang));
}
__device__ __forceinline__ void d_bias1(const float* __restrict__ pe_k, const float* __restrict__ w1_k, const float* __restrict__ pe_v, const float* __restrict__ w1_v, float* __restrict__ bias1) {
    const int tid_ = tid_opaque(); const int which = tid_ >> 8, j = tid_ & 255;
    const float* pe = which ? pe_v : pe_k; const float* w1 = which ? w1_v : w1_k;
    float a = 0.f;
    for (int k0 = 0; k0 < 2048; k0 += 16) {
        float wv[16];
#pragma unroll
        for (int i = 0; i < 16; ++i) wv[i] = w1[(size_t)(k0 + i) * 256 + j];
#pragma unroll
        for (int i = 0; i < 16; ++i) a += pe[k0 + i] * wv[i];
    }
    bias1[which * 256 + j] = a;
}

__device__ __forceinline__ void d_norm_mod(const float* __restrict__ x, const float* __restrict__ w, const float* __restrict__ mod, int sh_off, int sc_off, bf16_t* __restrict__ out, int vb) {
    const int tid_ = tid_opaque(); const int lane = tid_ & 63, wid = tid_ >> 6;
    const size_t row0 = (size_t)vb * 32 + wid * 4; const int b = (int)(row0 >> 13);
    f32x4 v[4][4];
#pragma unroll
    for (int r = 0; r < 4; ++r)
#pragma unroll
        for (int k = 0; k < 4; ++k) v[r][k] = *(const f32x4*)(x + (row0 + r) * DM + k * 256 + lane * 4);
    float rs[4];
#pragma unroll
    for (int r = 0; r < 4; ++r) {
        float ss = 0.f;
#pragma unroll
        for (int k = 0; k < 4; ++k) ss += v[r][k].x * v[r][k].x + v[r][k].y * v[r][k].y + v[r][k].z * v[r][k].z + v[r][k].w * v[r][k].w;
        rs[r] = rsqrtf(wave_sum(ss) * (1.0f / DM) + EPS);
    }
#pragma unroll
    for (int k = 0; k < 4; ++k) {
        const int col = k * 256 + lane * 4;
        const f32x4 wv = *(const f32x4*)(w + col), sc = *(const f32x4*)(mod + b * 6144 + sc_off + col), sh = *(const f32x4*)(mod + b * 6144 + sh_off + col);
        const f32x4 ws = wv * (sc + 1.0f);
#pragma unroll
        for (int r = 0; r < 4; ++r) {
            const f32x4 y = v[r][k] * rs[r] * ws + sh;
            u32x2 o; o.x = pack2(y.x, y.y); o.y = pack2(y.z, y.w);
            *(u32x2*)(out + (row0 + r) * DM + col) = o;
        }
    }
}

namespace pg8 {
#define PG8_LAS __attribute__((address_space(3)))
constexpr int BM = 256, BK = 64, HALF = 128, HTB = HALF * BK * 2  , STAGE_BYTES = 8 * HTB, NXCD = 8, WGM = 8;
__host__ __device__ __forceinline__ int lds_byte(int r, int c) { const int st = (r >> 4) * 2 + (c >> 5), rr = r & 15, cc = c & 31, ob = rr * 64 + cc * 2; return st * 1024 + (ob ^ (((ob >> 9) & 1) << 5)); }
__host__ __device__ __forceinline__ void stage_rc(int b, int& R, int& C) { const int st = b / 1024, sb = b % 1024, swz = sb ^ (((sb >> 9) & 1) << 5); R = (st >> 1) * 16 + swz / 64; C = (st & 1) * 32 + (swz % 64) / 2; }
struct Unit { int pm, pn; };
struct Gemm { const bf16_t* A; const bf16_t* Bt; int M, N, K, lda; };
struct StaticOrder {
    int nM, nN, nwg, G, c;
    __host__ __device__ void init(int M, int N, int G_, int c_) { nM = M / BM; nN = N / BM; nwg = nM * nN; G = G_; c = c_; }
    __host__ __device__ bool next(int i, Unit& u) const {
        const long L = (long)i * G + c; if (L >= nwg) return false;
        int wgid = (int)L; { const int q = nwg / NXCD, r = nwg % NXCD, xcd = wgid % NXCD, off = wgid / NXCD; wgid = (xcd < r ? xcd * (q + 1) : r * (q + 1) + (xcd - r) * q) + off; }
        const int nig = WGM * nN, gid = wgid / nig, fm = gid * WGM, gsz = (nM - fm) < WGM ? (nM - fm) : WGM;
        u.pm = fm + ((wgid % nig) % gsz); u.pn = (wgid % nig) / gsz; return true;
    }
};
template <class F> struct Epi {
    F f;
    __device__ __forceinline__ void operator()(const f32x4 (&acc)[2][2][4][2], const Unit& u, int wr, int wc, int fr, int fq) const {
#pragma unroll
        for (int ai = 0; ai < 2; ++ai)
#pragma unroll
            for (int m = 0; m < 4; ++m)
#pragma unroll
                for (int bj = 0; bj < 2; ++bj)
#pragma unroll
                    for (int n = 0; n < 2; ++n)
                        f(u.pm * BM + ai * HALF + wr * 64 + m * 16 + fr, u.pn * BM + bj * HALF + wc * 32 + n * 16 + 4 * fq, acc[ai][bj][m][n]);
    }
};
template <class E, class Sched>
__device__ __forceinline__ void gemm_phase(PG8_LAS unsigned char* lds, const Gemm g, const Sched& S, const E& Ep) {
    const int tid = tid_opaque(), wid = __builtin_amdgcn_readfirstlane(tid >> 6), lane = tid & 63, wr = wid >> 2, wc = wid & 3, fr = lane & 15, fq = lane >> 4;
    const int K = g.K, nt = K / BK;
    unsigned voffA[2], voffB[2];
#pragma unroll
    for (int i = 0; i < 2; ++i) { int R, C; stage_rc(tid * 16 + i * 8192, R, C); voffA[i] = (unsigned)(R * g.lda + C) * 2u; voffB[i] = (unsigned)(R * K + C) * 2u; }
    const size_t kstep = (size_t)(BK * 2);
    const size_t hstep = (size_t)HALF * K * 2, hstepA = (size_t)HALF * g.lda * 2;
    const size_t tstep = 2 * hstep, tstepA = 2 * hstepA;
    const unsigned ldsw = (unsigned)wid * 1024u;
    const int aoff = lds_byte(wr * 64 + fr, fq * 8), boff = lds_byte(wc * 32 + fr, fq * 8);
#define PG8_SA(b, h) (((b) * 2 + (h)) * HTB)
#define PG8_SB(b, h) ((4 + (b) * 2 + (h)) * HTB)
#define PG8_STAGE(bufoff, gbase, voff) do { _Pragma("unroll") for (int _i = 0; _i < 2; ++_i) \
        __builtin_amdgcn_global_load_lds((const unsigned*)((const char*)(gbase) + (voff)[_i]), (PG8_LAS unsigned*)(lds + (bufoff) + ldsw + _i * 8192), 16, 0, 0); } while (0)
#define PG8_LDA(dst, b, h) do { _Pragma("unroll") for (int m = 0; m < 4; ++m) _Pragma("unroll") for (int k = 0; k < 2; ++k) dst[m][k] = *(const PG8_LAS bf16x8*)(lds + PG8_SA(b, h) + aoff + m * 2048 + k * 1024); } while (0)
#define PG8_LDB(dst, b, h) do { _Pragma("unroll") for (int n = 0; n < 2; ++n) _Pragma("unroll") for (int k = 0; k < 2; ++k) dst[n][k] = *(const PG8_LAS bf16x8*)(lds + PG8_SB(b, h) + boff + n * 2048 + k * 1024); } while (0)
#define PG8_MMA(ai, bj, At, Bt) do { __builtin_amdgcn_s_setprio(1); _Pragma("unroll") for (int m = 0; m < 4; ++m) _Pragma("unroll") for (int n = 0; n < 2; ++n) _Pragma("unroll") for (int k = 0; k < 2; ++k) \
        acc[ai][bj][m][n] = __builtin_amdgcn_mfma_f32_16x16x32_bf16(Bt[n][k], At[m][k], acc[ai][bj][m][n], 0, 0, 0); __builtin_amdgcn_s_setprio(0); } while (0)
#define PG8_WAIT_V(n) asm volatile("s_waitcnt vmcnt(" #n ")" ::: "memory")
#define PG8_WAIT_L(n) asm volatile("s_waitcnt lgkmcnt(" #n ")" ::: "memory")
#define PG8_BAR __builtin_amdgcn_s_barrier()
#define PG8_SCHED __builtin_amdgcn_sched_barrier(0)
    Unit cur, nxt; int ui = 0;
    if (!S.next(0, cur)) return;
    f32x4 acc[2][2][4][2];
#pragma unroll
    for (int a = 0; a < 2; ++a)
#pragma unroll
        for (int b = 0; b < 2; ++b)
#pragma unroll
            for (int m = 0; m < 4; ++m)
#pragma unroll
                for (int n = 0; n < 2; ++n) acc[a][b][m][n] = (f32x4){0.f, 0.f, 0.f, 0.f};
    bf16x8 At[4][2], B0[2][2], B1[2][2];
    const char* cA = (const char*)g.A + (size_t)cur.pm * tstepA; const char* cB = (const char*)g.Bt + (size_t)cur.pn * tstep;
    PG8_STAGE(PG8_SB(0, 0), cB, voffB); PG8_STAGE(PG8_SB(0, 1), cB + hstep, voffB); PG8_STAGE(PG8_SA(0, 0), cA, voffA); PG8_STAGE(PG8_SA(0, 1), cA + hstepA, voffA);
    if (wr == 1) PG8_BAR;
    PG8_WAIT_V(2); PG8_BAR;
    PG8_STAGE(PG8_SB(1, 0), cB + kstep, voffB); PG8_STAGE(PG8_SA(1, 0), cA + kstep, voffA); PG8_STAGE(PG8_SB(1, 1), cB + hstep + kstep, voffB);
    PG8_WAIT_V(6); PG8_BAR;
    for (;;) {
        const bool has_next = S.next(ui + 1, nxt);
        const char* nA = has_next ? (const char*)g.A + (size_t)nxt.pm * tstepA : cA; const char* nB = has_next ? (const char*)g.Bt + (size_t)nxt.pn * tstep : cB;
        for (int t = 0; t < nt; t += 2) {
            const bool last = (t == nt - 2);
            const char* a1 = cA + (size_t)(t + 1) * kstep;
            const char* a2 = last ? nA : cA + (size_t)(t + 2) * kstep; const char* b2 = last ? nB : cB + (size_t)(t + 2) * kstep;
            const char* a3 = a2 + kstep; const char* b3 = b2 + kstep;
            PG8_LDB(B0, 0, 0); PG8_LDB(B1, 0, 1); PG8_SCHED; PG8_LDA(At, 0, 0); PG8_STAGE(PG8_SA(1, 1), a1 + hstepA, voffA);
            PG8_WAIT_V(8); PG8_WAIT_L(0); PG8_BAR; PG8_MMA(0, 0, At, B0); PG8_MMA(0, 1, At, B1); PG8_BAR; PG8_SCHED;
            PG8_LDA(At, 0, 1); PG8_STAGE(PG8_SB(0, 0), b2, voffB); PG8_STAGE(PG8_SB(0, 1), b2 + hstep, voffB); PG8_STAGE(PG8_SA(0, 0), a2, voffA);
            PG8_WAIT_V(8); PG8_WAIT_L(0); PG8_BAR; PG8_MMA(1, 0, At, B0); PG8_MMA(1, 1, At, B1); PG8_BAR; PG8_SCHED;
            PG8_LDB(B0, 1, 0); PG8_LDB(B1, 1, 1); PG8_SCHED; PG8_LDA(At, 1, 0); PG8_STAGE(PG8_SA(0, 1), a2 + hstepA, voffA);
            PG8_WAIT_V(8); PG8_WAIT_L(0); PG8_BAR; PG8_MMA(0, 0, At, B0); PG8_MMA(0, 1, At, B1); PG8_BAR; PG8_SCHED;
            PG8_LDA(At, 1, 1); PG8_STAGE(PG8_SB(1, 0), b3, voffB); PG8_STAGE(PG8_SB(1, 1), b3 + hstep, voffB); PG8_STAGE(PG8_SA(1, 0), a3, voffA);
            PG8_WAIT_V(8); PG8_WAIT_L(0); PG8_BAR; PG8_MMA(1, 0, At, B0); PG8_MMA(1, 1, At, B1); PG8_BAR; PG8_SCHED;
        }
        if (wr == 0) PG8_BAR;
        Ep(acc, cur, wr, wc, fr, fq);
        if (!has_next) break;
#pragma unroll
        for (int a = 0; a < 2; ++a)
#pragma unroll
            for (int b = 0; b < 2; ++b)
#pragma unroll
                for (int m = 0; m < 4; ++m)
#pragma unroll
                    for (int n = 0; n < 2; ++n) acc[a][b][m][n] = (f32x4){0.f, 0.f, 0.f, 0.f};
        cur = nxt; cA = nA; cB = nB; ++ui;
        if (wr == 1) PG8_BAR;
    }
    PG8_WAIT_V(0);
    PG8_BAR;
#undef PG8_SA
#undef PG8_SB
#undef PG8_STAGE
#undef PG8_LDA
#undef PG8_LDB
#undef PG8_MMA
#undef PG8_WAIT_V
#undef PG8_WAIT_L
#undef PG8_BAR
#undef PG8_SCHED
}
}

struct EpInProj { bf16_t* proj; bf16_t* qrope; bf16_t* kvp; float* small; const float2* rope; const float* dt_bias;
    __device__ __forceinline__ void operator()(int m, int n0, f32x4 v) const {
        if (n0 < 2816) {
            const bool is_q = n0 < 512;
            const bool roped_seg = is_q || (n0 >= C_KSEL && n0 < C_VSEL) || (n0 >= C_KWIN && n0 < C_VWIN);
            const bool rope_dims = roped_seg && ((n0 & 63) < 16);
            u32x2 raw; raw.x = pack2(v.x, v.y); raw.y = pack2(v.z, v.w);
            if (is_q) *(u32x2*)(proj + (size_t)m * PROJ_LD + n0) = raw;
            if (rope_dims) {
                f32x4 p; p.x = __shfl_xor(v.x, 32); p.y = __shfl_xor(v.y, 32); p.z = __shfl_xor(v.z, 32); p.w = __shfl_xor(v.w, 32);
                const int i0 = n0 & 15, pos = m & (SEQ - 1);
                const float sgn = i0 < 8 ? -1.f : 1.f;
                const float2* rp = rope + pos * 8 + (i0 & 7);
                const float2 c0 = rp[0], c1 = rp[1], c2 = rp[2], c3 = rp[3];
                v.x = v.x * c0.x + sgn * p.x * c0.y; v.y = v.y * c1.x + sgn * p.y * c1.y;
                v.z = v.z * c2.x + sgn * p.z * c2.y; v.w = v.w * c3.x + sgn * p.w * c3.y;
            }
            u32x2 o; o.x = pack2(v.x, v.y); o.y = pack2(v.z, v.w);
            if (is_q) *(u32x2*)(qrope + (size_t)m * 512 + n0) = o;
            else if (n0 < C_Z) {
                const int r = n0 - C_KCMP, seg = r >> 7, g = (r >> 6) & 1, d = r & 63, bb = m >> 13, t = m & (SEQ - 1);
                *(u32x2*)(kvp + (size_t)seg * KVP_SEG + ((size_t)(bb * 2 + g) * SEQ + t) * 64 + d) = o;
            }
            else *(u32x2*)(proj + (size_t)m * PROJ_LD + n0) = o;
        } else if (n0 < 2848) {
            const int c = n0 - 2816; f32x4 o;
            if (c < 24) { o.x = sigmoidf(v.x); o.y = sigmoidf(v.y); o.z = sigmoidf(v.z); o.w = sigmoidf(v.w); }
            else { const float* db = dt_bias + (c - 24); o.x = softplusf(v.x + db[0]); o.y = softplusf(v.y + db[1]); o.z = softplusf(v.z + db[2]); o.w = softplusf(v.w + db[3]); }
            *(f32x4*)(small + (size_t)m * 32 + c) = o;
        }
    } };
struct EpCmpHid { bf16_t* hid; const float* bias;
    __device__ __forceinline__ void operator()(int m, int n0, f32x4 v) const {
        const f32x4 b = *(const f32x4*)(bias + n0);
        u32x2 o; o.x = pack2(gelu_tanh(v.x + b.x), gelu_tanh(v.y + b.y)); o.y = pack2(gelu_tanh(v.z + b.z), gelu_tanh(v.w + b.w));
        *(u32x2*)(hid + (size_t)m * 256 + n0) = o;
    } };
struct EpOutProj { const float* x; const float* mod; float* x1;
    __device__ __forceinline__ void operator()(int m, int n0, f32x4 v) const {
        const int b = m >> 13;
        const f32x4 xv = *(const f32x4*)(x + (size_t)m * DM + n0);
        const f32x4 g = *(const f32x4*)(mod + b * 6144 + 2048 + n0);
        f32x4 o; o.x = xv.x + g.x * v.x; o.y = xv.y + g.y * v.y; o.z = xv.z + g.z * v.z; o.w = xv.w + g.w * v.w;
        *(f32x4*)(x1 + (size_t)m * DM + n0) = o;
    } };
struct EpStoreBf16 { bf16_t* out; int ld; int pad;
    __device__ __forceinline__ void operator()(int m, int n0, f32x4 v) const {
        u32x2 o; o.x = pack2(v.x, v.y); o.y = pack2(v.z, v.w);
        *(u32x2*)(out + (size_t)m * ld + n0) = o;
    } };

__device__ __forceinline__ void d_cmp_out(const bf16_t* __restrict__ hid, const float* __restrict__ w2, bf16_t* __restrict__ out, int vb) {
    const int tid_ = tid_opaque(); const int m = vb * 8 + (tid_ >> 6), d = tid_ & 63;
    float a = 0.f;
#pragma unroll 8
    for (int j = 0; j < 256; ++j) a += bf2f(hid[(size_t)m * 256 + j]) * w2[j * 64 + d];
    out[(size_t)m * 64 + d] = f2bf(a);
}

#define KLD 80
#define NSA_OFF_KS0  0
#define NSA_OFF_VT0  10240
#define NSA_OFF_KS1  20480
#define NSA_OFF_VT1  30720
#define NSA_OFF_IMP  40960
#define NSA_OFF_SELW 74752
#define NSA_OFF_ANYW 75776
#define NSA_OFF_BL   75808
#define NSA_OFF_QS   76352
#define NSA_LDS      (76352 + 8 * 32 * KLD * 2)
#define SM_C 0.18033688011112042f

struct KVStage { u32x4 k, v; };
__device__ __forceinline__ void nsa_stage_load(KVStage& st, const bf16_t* kb, const bf16_t* vb, int tid) {
    st.k = *(const u32x4*)(kb + tid * 8); st.v = *(const u32x4*)(vb + tid * 8);
}
__device__ __forceinline__ void nsa_stage_store(bf16_t* Ks, bf16_t* Vt, int tid, const KVStage& st) {
    const int r = tid >> 3, c = tid & 7;
    *(u32x4*)(Ks + r * KLD + c * 8) = st.k;
    *(u32x4*)(Vt + r * KLD + c * 8) = st.v;
}
__device__ __forceinline__ void nsa_load_q(const bf16_t* qsrc, size_t ld, int lane, bf16_t* Qs) {
    u32x4 r[4];
#pragma unroll
    for (int i = 0; i < 4; ++i) { const int p = lane + 64 * i; r[i] = *(const u32x4*)(qsrc + (size_t)(p >> 3) * ld + (p & 7) * 8); }
#pragma unroll
    for (int i = 0; i < 4; ++i) { const int p = lane + 64 * i; *(u32x4*)(Qs + (p >> 3) * KLD + (p & 7) * 8) = r[i]; }
}
__device__ __forceinline__ void nsa_qk(const bf16_t* Ks, const bf16_t* Qs, f32x4 (&s)[4][2], int fr, int fq) {
#pragma unroll
    for (int kt = 0; kt < 4; ++kt)
#pragma unroll
        for (int tt = 0; tt < 2; ++tt) s[kt][tt] = (f32x4){0.f, 0.f, 0.f, 0.f};
#pragma unroll
    for (int ks = 0; ks < 2; ++ks) {
        bf16x8 qf[2];
#pragma unroll
        for (int tt = 0; tt < 2; ++tt) qf[tt] = *(const bf16x8*)(Qs + (tt * 16 + fr) * KLD + ks * 32 + fq * 8);
#pragma unroll
        for (int kt = 0; kt < 4; ++kt) {
            const bf16x8 kf = *(const bf16x8*)(Ks + (kt * 16 + fr) * KLD + ks * 32 + fq * 8);
#pragma unroll
            for (int tt = 0; tt < 2; ++tt) s[kt][tt] = __builtin_amdgcn_mfma_f32_16x16x32_bf16(kf, qf[tt], s[kt][tt], 0, 0, 0);
        }
    }
}
__device__ __forceinline__ void nsa_pv(const bf16_t* Vt, const f32x4 (&p)[4][2], f32x4 (&o)[4][2], int fr, int fq) {
#pragma unroll
    for (int ks2 = 0; ks2 < 2; ++ks2) {
        bf16x8 pf[2];
#pragma unroll
        for (int tt = 0; tt < 2; ++tt) {
            const f32x4 a = p[2 * ks2][tt], b = p[2 * ks2 + 1][tt];
            u32x4 w; w.x = pack2(a.x, a.y); w.y = pack2(a.z, a.w); w.z = pack2(b.x, b.y); w.w = pack2(b.z, b.w);
            pf[tt] = __builtin_bit_cast(bf16x8, w);
        }
#pragma unroll
        for (int dt = 0; dt < 4; ++dt) {
            typedef short s16x4 __attribute__((ext_vector_type(4)));
            const bf16_t* vp = Vt + (ks2 * 32 + 4 * fq + (fr >> 2)) * KLD + dt * 16 + 4 * (fr & 3);
            const s16x4 a0 = __builtin_amdgcn_ds_read_tr16_b64_v4i16((__attribute__((address_space(3))) s16x4*)vp);
            const s16x4 a1 = __builtin_amdgcn_ds_read_tr16_b64_v4i16((__attribute__((address_space(3))) s16x4*)(vp + 16 * KLD));
            const bf16x8 vf = (bf16x8){a0.x, a0.y, a0.z, a0.w, a1.x, a1.y, a1.z, a1.w};
#pragma unroll
            for (int tt = 0; tt < 2; ++tt) o[dt][tt] = __builtin_amdgcn_mfma_f32_16x16x32_bf16(vf, pf[tt], o[dt][tt], 0, 0, 0);
        }
    }
}
template <int MK>
__device__ __forceinline__ bool nsa_valid(int kk, int ti, int n0, int t0) {
    if (MK == 1) return kk <= ti;
    if (MK == 2) return kk > ti;
    return 16 * (n0 + kk) + 31 <= t0 + ti;
}
template <int MK, bool WITH_O>
__device__ __forceinline__ void nsa_softmax(f32x4 (&s)[4][2], float (&m)[2], float (&l)[2], f32x4 (&o)[4][2], const bool (&selb)[2], int tib, int fq, int n0, int t0) {
#pragma unroll
    for (int tt = 0; tt < 2; ++tt) {
        const int ti = tib + tt * 16;
        float mx = -1e30f;
#pragma unroll
        for (int kt = 0; kt < 4; ++kt)
#pragma unroll
            for (int jj = 0; jj < 4; ++jj) {
                const int kk = kt * 16 + 4 * fq + jj;
                const bool v = selb[tt] && nsa_valid<MK>(kk, ti, n0, t0);
                const float sv = v ? s[kt][tt][jj] * SM_C : -1e30f;
                s[kt][tt][jj] = sv; mx = fmaxf(mx, sv);
            }
        mx = fmaxf(mx, __shfl_xor(mx, 16)); mx = fmaxf(mx, __shfl_xor(mx, 32));
        const float mn = fmaxf(m[tt], mx);
        const float alpha = __builtin_amdgcn_exp2f(m[tt] - mn);
        m[tt] = mn;
        float ls = 0.f;
#pragma unroll
        for (int kt = 0; kt < 4; ++kt)
#pragma unroll
            for (int jj = 0; jj < 4; ++jj) {
                const float sv = s[kt][tt][jj];
                const float pv = sv > -1e29f ? __builtin_amdgcn_exp2f(sv - mn) : 0.f;
                s[kt][tt][jj] = pv; ls += pv;
            }
        l[tt] = l[tt] * alpha + ls;
        if (WITH_O) {
#pragma unroll
            for (int dt = 0; dt < 4; ++dt) o[dt][tt] *= alpha;
        }
    }
}
template <bool WITH_O = true>
__device__ __forceinline__ void nsa_softmax_fast(f32x4 (&s)[4][2], float (&m)[2], float (&l)[2], f32x4 (&o)[4][2], const float (&bias)[2]) {
#pragma unroll
    for (int tt = 0; tt < 2; ++tt) {
        float mr = fmaxf(fmaxf(s[0][tt][0], s[0][tt][1]), fmaxf(s[0][tt][2], s[0][tt][3]));
#pragma unroll
        for (int kt = 1; kt < 4; ++kt) mr = fmaxf(mr, fmaxf(fmaxf(s[kt][tt][0], s[kt][tt][1]), fmaxf(s[kt][tt][2], s[kt][tt][3])));
        mr = fmaxf(mr, __shfl_xor(mr, 16)); mr = fmaxf(mr, __shfl_xor(mr, 32));
        const float mx = mr * SM_C + bias[tt];
        const float mold = m[tt], mn = fmaxf(mold, mx);
        m[tt] = mn;
        const float off = bias[tt] - mn;
        float ls = 0.f;
#pragma unroll
        for (int kt = 0; kt < 4; ++kt)
#pragma unroll
            for (int jj = 0; jj < 4; ++jj) { const float pv = __builtin_amdgcn_exp2f(__builtin_fmaf(s[kt][tt][jj], SM_C, off)); s[kt][tt][jj] = pv; ls += pv; }
        if (__builtin_amdgcn_ballot_w64(mn > mold) != 0ull) {
            const float alpha = __builtin_amdgcn_exp2f(mold - mn);
            l[tt] = l[tt] * alpha + ls;
            if (WITH_O) {
#pragma unroll
                for (int dt = 0; dt < 4; ++dt) o[dt][tt] *= alpha;
            }
        } else l[tt] += ls;
    }
}
__device__ __forceinline__ void ins16(unsigned (&L)[16], unsigned x) {
#pragma unroll
    for (int i = 0; i < 16; ++i) { const unsigned hi = L[i] > x ? L[i] : x; x = L[i] > x ? x : L[i]; L[i] = hi; }
}
__device__ __forceinline__ void merge16(unsigned (&L)[16], const unsigned (&P)[16]) {
#pragma unroll
    for (int i = 0; i < 16; ++i) L[i] = L[i] > P[15 - i] ? L[i] : P[15 - i];
#pragma unroll
    for (int st = 8; st >= 1; st >>= 1)
#pragma unroll
        for (int i = 0; i < 16; ++i)
            if ((i & st) == 0) { const unsigned a = L[i], b = L[i + st]; L[i] = a > b ? a : b; L[i + st] = a > b ? b : a; }
}
template <bool ACCUM>
__device__ __forceinline__ void nsa_emit(const f32x4 (&o)[4][2], const float (&l)[2], bool l_is_partial, const float* gsrc, float* obase, int tib, int fq) {
#pragma unroll
    for (int tt = 0; tt < 2; ++tt) {
        float lt = l[tt];
        if (l_is_partial) { lt += __shfl_xor(lt, 16); lt += __shfl_xor(lt, 32); }
        const int ti = tib + tt * 16;
        const float gv = gsrc[(size_t)ti * 32];
        const float sc = l_is_partial ? (lt > 0.f ? gv / lt : 0.f) : gv;
#pragma unroll
        for (int dt = 0; dt < 4; ++dt) {
            float* op = obase + (size_t)ti * 512 + dt * 16 + 4 * fq;
            f32x4 v = o[dt][tt] * sc;
            if (ACCUM) v += *(const f32x4*)op;
            *(f32x4*)op = v;
        }
    }
}
struct NsaBufs { bf16_t *Ks0, *Vt0, *Ks1, *Vt1; };
template <class SRC, class BODY>
__device__ __forceinline__ void nsa_pipeline(int n, const bf16_t* kb, const bf16_t* vb, const NsaBufs& B, int tid, SRC src, BODY body) {
    KVStage s0, s1;
    nsa_stage_load(s0, kb + (size_t)src(0) * 4096, vb + (size_t)src(0) * 4096, tid);
    s1 = s0;
    if (n > 1) nsa_stage_load(s1, kb + (size_t)src(1) * 4096, vb + (size_t)src(1) * 4096, tid);
    __syncthreads();
    nsa_stage_store(B.Ks0, B.Vt0, tid, s0);
    if (n > 2) nsa_stage_load(s0, kb + (size_t)src(2) * 4096, vb + (size_t)src(2) * 4096, tid);
#pragma unroll 1
    for (int i = 0; i < n; i += 2) {
        __syncthreads();
        if (i + 1 < n) nsa_stage_store(B.Ks1, B.Vt1, tid, s1);
        if (i + 3 < n) nsa_stage_load(s1, kb + (size_t)src(i + 3) * 4096, vb + (size_t)src(i + 3) * 4096, tid);
        body(src(i), B.Ks0, B.Vt0);
        if (i + 1 < n) {
            __syncthreads();
            if (i + 2 < n) nsa_stage_store(B.Ks0, B.Vt0, tid, s0);
            if (i + 4 < n) nsa_stage_load(s0, kb + (size_t)src(i + 4) * 4096, vb + (size_t)src(i + 4) * 4096, tid);
            body(src(i + 1), B.Ks1, B.Vt1);
        }
    }
}

__device__ __forceinline__ void d_nsa_cmp(const bf16_t* __restrict__ proj, const bf16_t* __restrict__ kc, const bf16_t* __restrict__ vc,
                                          const float* __restrict__ small, float* __restrict__ onsa, unsigned* __restrict__ selrec, int b, int g, int qt, char* lds) {
    const NsaBufs B{(bf16_t*)(lds + NSA_OFF_KS0), (bf16_t*)(lds + NSA_OFF_VT0), (bf16_t*)(lds + NSA_OFF_KS1), (bf16_t*)(lds + NSA_OFF_VT1)};
    float* imp = (float*)(lds + NSA_OFF_IMP);
    unsigned* selw = (unsigned*)(lds + NSA_OFF_SELW);
    unsigned* anyw = (unsigned*)(lds + NSA_OFF_ANYW);
    int* blist = (int*)(lds + NSA_OFF_BL);
    const int tid = tid_opaque(), lane = tid & 63, w = tid >> 6, hd = w & 3, th = w >> 2, fr = lane & 15, fq = lane >> 4;
    const int tib = th * 32 + fr;
    const size_t tok0 = (size_t)b * SEQ + (size_t)qt * 64;
    const int t0 = qt * 64;
    const float* gbase = small + tok0 * 32 + g * 12 + hd * 3;
    float* obase = onsa + tok0 * 512 + g * 256 + hd * 64;
    const bool sel_all[2] = {true, true};
    const float bias0[2] = {0.f, 0.f};

    for (int i = tid; i < 64 * 132; i += 512) imp[i] = 0.f;
    if (tid < 4) anyw[tid] = 0u;

    bf16_t* Qs = (bf16_t*)(lds + NSA_OFF_QS) + w * 32 * KLD;
    f32x4 s[4][2], o[4][2];
    float m[2], l[2];

    nsa_load_q(proj + (tok0 + th * 32) * PROJ_LD + C_Q + g * 256 + hd * 64, PROJ_LD, lane, Qs);
    const int ncb = (4 * qt + 3 + 63) >> 6;
    {
        const bf16_t* kb = kc + (size_t)(b * 2 + g) * 512 * 64;
        const bf16_t* vb = vc + (size_t)(b * 2 + g) * 512 * 64;
#pragma unroll
        for (int tt = 0; tt < 2; ++tt) { m[tt] = -1e30f; l[tt] = 0.f; }
        nsa_pipeline(ncb, kb, vb, B, tid, [&](int i) { return i; }, [&](int blk_, bf16_t* Ks, bf16_t* Vt) {
            nsa_qk(Ks, Qs, s, fr, fq);
            if (16 * (blk_ * 64 + 63) + 31 <= t0) nsa_softmax_fast<false>(s, m, l, o, bias0);
            else nsa_softmax<3, false>(s, m, l, o, sel_all, tib, fq, blk_ * 64, t0);
        });
        float linv[2];
#pragma unroll
        for (int tt = 0; tt < 2; ++tt) { float lt = l[tt]; lt += __shfl_xor(lt, 16); lt += __shfl_xor(lt, 32); linv[tt] = lt > 0.f ? 1.0f / lt : 0.f; }
#pragma unroll
        for (int dt = 0; dt < 4; ++dt)
#pragma unroll
            for (int tt = 0; tt < 2; ++tt) o[dt][tt] = (f32x4){0.f, 0.f, 0.f, 0.f};
        nsa_pipeline(ncb, kb, vb, B, tid, [&](int i) { return i; }, [&](int blk_, bf16_t* Ks, bf16_t* Vt) {
            nsa_qk(Ks, Qs, s, fr, fq);
            const bool full = 16 * (blk_ * 64 + 63) + 31 <= t0;
#pragma unroll
            for (int tt = 0; tt < 2; ++tt) {
                const int ti = tib + tt * 16;
                const float nm = -m[tt], li = linv[tt];
                float hs[4], as[4];
#pragma unroll
                for (int kt = 0; kt < 4; ++kt) {
                    f32x4 pv;
                    if (full) {
#pragma unroll
                        for (int jj = 0; jj < 4; ++jj) pv[jj] = __builtin_amdgcn_exp2f(__builtin_fmaf(s[kt][tt][jj], SM_C, nm)) * li;
                    } else {
#pragma unroll
                        for (int jj = 0; jj < 4; ++jj) {
                            const int kk = kt * 16 + 4 * fq + jj;
                            pv[jj] = nsa_valid<3>(kk, ti, blk_ * 64, t0) ? __builtin_amdgcn_exp2f(__builtin_fmaf(s[kt][tt][jj], SM_C, nm)) * li : 0.f;
                        }
                    }
                    s[kt][tt] = pv;
                    hs[kt] = 0.5f * pv[3]; as[kt] = pv[0] + pv[1] + pv[2] + hs[kt];
                }
                float r1[4];
#pragma unroll
                for (int kt = 0; kt < 4; ++kt) r1[kt] = __shfl(hs[kt], (lane + 48) & 63);
#pragma unroll
                for (int kt = 0; kt < 4; ++kt) {
                    const float recv = fq > 0 ? r1[kt] : (kt > 0 ? r1[kt - 1] : 0.f);
                    const int j = blk_ * 16 + kt * 4 + fq;
                    atomicAdd(imp + ti * 132 + (j >> 5) * 33 + (j & 31), as[kt] + recv);
                }
                if (fq == 3) { const int j1 = blk_ * 16 + 16; if (j1 < 128) atomicAdd(imp + ti * 132 + (j1 >> 5) * 33 + (j1 & 31), hs[3]); }
            }
            nsa_pv(Vt, s, o, fr, fq);
        });
        nsa_emit<false>(o, l, false, gbase + 0, obase, tib, fq);
    }
    __syncthreads();
    {
        const int ti = tid >> 3, q8 = tid & 7;
        unsigned L[16];
#pragma unroll
        for (int i = 0; i < 16; ++i) L[i] = 0u;
#pragma unroll
        for (int i = 0; i < 16; ++i) {
            const int j = q8 * 16 + i;
            const bool forced = (j == 0) || (j == qt) || (j == qt - 1);
            const float v = imp[ti * 132 + (j >> 5) * 33 + (j & 31)] + (forced ? 1e4f : 0.f) + 1e-30f;
            const unsigned x = (j <= qt) ? ((__float_as_uint(v) & ~0x7Fu) | (unsigned)(127 - j)) : 0u;
            ins16(L, x);
        }
#pragma unroll
        for (int r = 1; r <= 4; r <<= 1) {
            unsigned P[16];
#pragma unroll
            for (int i = 0; i < 16; ++i) P[i] = (unsigned)__shfl_xor((int)L[i], r);
            merge16(L, P);
        }
        if (q8 < 4) {
            unsigned word = 0u;
#pragma unroll
            for (int i = 0; i < 16; ++i) {
                const unsigned e = L[i];
                const int j = 127 - (int)(e & 0x7Fu);
                if (e != 0u && (j >> 5) == q8) word |= 1u << (j & 31);
            }
            selw[ti * 4 + q8] = word;
            atomicOr(&anyw[q8], word);
        }
    }
    __syncthreads();
    int nsel;
    {
        const unsigned a0 = anyw[0], a1 = anyw[1], a2 = anyw[2], a3 = anyw[3];
        if (tid < 128) {
            const unsigned wd = tid < 32 ? a0 : tid < 64 ? a1 : tid < 96 ? a2 : a3;
            if ((wd >> (tid & 31)) & 1u) {
                int pos = __popc(wd & ((1u << (tid & 31)) - 1u));
                if (tid >= 32) pos += __popc(a0);
                if (tid >= 64) pos += __popc(a1);
                if (tid >= 96) pos += __popc(a2);
                blist[pos] = tid;
            }
        }
        nsel = __builtin_amdgcn_readfirstlane(__popc(a0) + __popc(a1) + __popc(a2) + __popc(a3));
    }
    __syncthreads();
    if (tid < 256) selrec[tid] = selw[tid];
    if (tid < 128) selrec[256 + tid] = (unsigned)blist[tid];
    if (tid == 0) selrec[384] = (unsigned)nsel;
    __syncthreads();
}

__device__ __forceinline__ void d_nsa_attn(const bf16_t* __restrict__ qrope, const bf16_t* __restrict__ kvp, const float* __restrict__ small, float* __restrict__ onsa,
                                           const unsigned* __restrict__ selrec, int b, int g, int qt, char* lds) {
    const NsaBufs B{(bf16_t*)(lds + NSA_OFF_KS0), (bf16_t*)(lds + NSA_OFF_VT0), (bf16_t*)(lds + NSA_OFF_KS1), (bf16_t*)(lds + NSA_OFF_VT1)};
    unsigned* selw = (unsigned*)(lds + NSA_OFF_SELW);
    int* blist = (int*)(lds + NSA_OFF_BL);
    const int tid = tid_opaque(), lane = tid & 63, w = tid >> 6, hd = w & 3, th = w >> 2, fr = lane & 15, fq = lane >> 4;
    const int tib = th * 32 + fr;
    const size_t tok0 = (size_t)b * SEQ + (size_t)qt * 64;
    const float* gbase = small + tok0 * 32 + g * 12 + hd * 3;
    float* obase = onsa + tok0 * 512 + g * 256 + hd * 64;
    const bool sel_all[2] = {true, true};
    const float bias0[2] = {0.f, 0.f};
    bf16_t* Qs = (bf16_t*)(lds + NSA_OFF_QS) + w * 32 * KLD;
    f32x4 s[4][2], o[4][2];
    float m[2], l[2];
    if (tid < 256) selw[tid] = selrec[tid];
    if (tid < 128) blist[tid] = (int)selrec[256 + tid];
    const int nsel = __builtin_amdgcn_readfirstlane((int)selrec[384]);
    __syncthreads();
    nsa_load_q(qrope + (tok0 + th * 32) * 512 + g * 256 + hd * 64, 512, lane, Qs);
    {
        const bf16_t* kb = kvp + 2 * KVP_SEG + (size_t)(b * 2 + g) * SEQ * 64;
        const bf16_t* vb = kvp + 3 * KVP_SEG + (size_t)(b * 2 + g) * SEQ * 64;
#pragma unroll
        for (int tt = 0; tt < 2; ++tt) { m[tt] = -1e30f; l[tt] = 0.f; }
#pragma unroll
        for (int dt = 0; dt < 4; ++dt)
#pragma unroll
            for (int tt = 0; tt < 2; ++tt) o[dt][tt] = (f32x4){0.f, 0.f, 0.f, 0.f};
        nsa_pipeline(nsel, kb, vb, B, tid, [&](int i) { return __builtin_amdgcn_readfirstlane(blist[i]); }, [&](int blk_, bf16_t* Ks, bf16_t* Vt) {
            nsa_qk(Ks, Qs, s, fr, fq);
            bool selb[2];
#pragma unroll
            for (int tt = 0; tt < 2; ++tt) selb[tt] = (selw[(tib + tt * 16) * 4 + (blk_ >> 5)] >> (blk_ & 31)) & 1u;
            if (blk_ == qt) nsa_softmax<1, true>(s, m, l, o, selb, tib, fq, 0, 0);
            else {
                float bias[2];
#pragma unroll
                for (int tt = 0; tt < 2; ++tt) bias[tt] = selb[tt] ? 0.f : -1e30f;
                nsa_softmax_fast(s, m, l, o, bias);
            }
            nsa_pv(Vt, s, o, fr, fq);
        });
        nsa_emit<true>(o, l, true, gbase + 1, obase, tib, fq);
    }
    {
        const bf16_t* kb = kvp + 4 * KVP_SEG + (size_t)(b * 2 + g) * SEQ * 64;
        const bf16_t* vb = kvp + 5 * KVP_SEG + (size_t)(b * 2 + g) * SEQ * 64;
#pragma unroll
        for (int tt = 0; tt < 2; ++tt) { m[tt] = -1e30f; l[tt] = 0.f; }
#pragma unroll
        for (int dt = 0; dt < 4; ++dt)
#pragma unroll
            for (int tt = 0; tt < 2; ++tt) o[dt][tt] = (f32x4){0.f, 0.f, 0.f, 0.f};
        const int j0 = qt >= 8 ? qt - 8 : 0;
        nsa_pipeline(qt - j0 + 1, kb, vb, B, tid, [&](int i) { return j0 + i; }, [&](int blk_, bf16_t* Ks, bf16_t* Vt) {
            nsa_qk(Ks, Qs, s, fr, fq);
            if (blk_ == qt) nsa_softmax<1, true>(s, m, l, o, sel_all, tib, fq, 0, 0);
            else if (blk_ == qt - 8) nsa_softmax<2, true>(s, m, l, o, sel_all, tib, fq, 0, 0);
            else nsa_softmax_fast(s, m, l, o, bias0);
            nsa_pv(Vt, s, o, fr, fq);
        });
        nsa_emit<true>(o, l, true, gbase + 2, obase, tib, fq);
    }
    __syncthreads();
}

#define SSD_P 136
#define S3_XST 0
#define S3_BC  69632
#define S3_CC  104448
#define S3_ACS 139264
#define S3_DT  141312
#define S3_END 143360

__device__ __forceinline__ void ssd_acs(const float* __restrict__ small, const float* __restrict__ a_log, size_t tok0, int g, float* acs, float* dtl, int tid) {
    const int w = tid >> 6, lane = tid & 63, hh = 4 * g + (w & 3);
    if (w < 4) {
        const float a = -__expf(a_log[hh]);
        const float d0 = small[(tok0 + 2 * lane) * 32 + 24 + hh], d1 = small[(tok0 + 2 * lane + 1) * 32 + 24 + hh];
        const float s0 = d0 * a, s1 = s0 + d1 * a;
        float tot = s1;
#pragma unroll
        for (int off = 1; off < 64; off <<= 1) { const float t = __shfl_up(tot, off); if (lane >= off) tot += t; }
        const float excl = tot - s1;
        acs[w * 128 + 2 * lane] = excl + s0; acs[w * 128 + 2 * lane + 1] = excl + s1;
        dtl[w * 128 + 2 * lane] = d0; dtl[w * 128 + 2 * lane + 1] = d1;
    }
}
struct ConvCh { float w0, w1, w2, w3, bias, h0, h1, h2; };
__device__ __forceinline__ void conv_init(ConvCh& cc, const float* __restrict__ conv_w, const float* __restrict__ conv_b, int ch, const bf16_t* pb, int c) {
    cc.w0 = conv_w[ch]; cc.w1 = conv_w[1024 + ch]; cc.w2 = conv_w[2048 + ch]; cc.w3 = conv_w[3072 + ch]; cc.bias = conv_b[ch];
    if (c > 0) { cc.h0 = bf2f(pb[-3 * PROJ_LD]); cc.h1 = bf2f(pb[-2 * PROJ_LD]); cc.h2 = bf2f(pb[-1 * PROJ_LD]); } else { cc.h0 = 0.f; cc.h1 = 0.f; cc.h2 = 0.f; }
}
__device__ __forceinline__ float conv_step(ConvCh& cc, float x) {
    const float v = cc.bias + cc.w0 * cc.h0 + cc.w1 * cc.h1 + cc.w2 * cc.h2 + cc.w3 * x;
    cc.h0 = cc.h1; cc.h1 = cc.h2; cc.h2 = x;
    return silu(v);
}

__device__ __forceinline__ void d_ssd_states(const bf16_t* __restrict__ proj, const float* __restrict__ small, const float* __restrict__ conv_w, const float* __restrict__ conv_b,
                                             const float* __restrict__ a_log, float* __restrict__ states, float* __restrict__ cdec, int item, char* lds) {
    const int tid = tid_opaque(), lane = tid & 63, w = tid >> 6, fr = lane & 15, fq = lane >> 4;
    const int b = item >> 7, c = (item >> 1) & 63, g = item & 1;
    bf16_t* XwT = (bf16_t*)(lds + S3_XST); bf16_t* BcT = (bf16_t*)(lds + S3_BC);
    float* acs = (float*)(lds + S3_ACS); float* dtl = (float*)(lds + S3_DT);
    const size_t tok0 = (size_t)b * SEQ + (size_t)c * 128;
    ssd_acs(small, a_log, tok0, g, acs, dtl, tid);
    __syncthreads();
    if (tid < 384) {
        const bool isx = tid < 256;
        const int ch = isx ? g * 256 + tid : 512 + g * 128 + (tid - 256);
        const bf16_t* px = proj + tok0 * PROJ_LD + C_XBC + ch;
        ConvCh cx; conv_init(cx, conv_w, conv_b, ch, px, c);
        const int hw = w & 3;
        const float alast = acs[hw * 128 + 127];
        bf16_t* dst = isx ? XwT + tid * SSD_P : BcT + (tid - 256) * SSD_P;
        for (int l0 = 0; l0 < 128; l0 += 32) {
            float rx[32];
#pragma unroll
            for (int i = 0; i < 32; ++i) rx[i] = bf2f(px[(size_t)(l0 + i) * PROJ_LD]);
#pragma unroll
            for (int i8 = 0; i8 < 4; ++i8) {
                float ox[8];
#pragma unroll
                for (int i = 0; i < 8; ++i) {
                    const int l = l0 + i8 * 8 + i;
                    const float v = conv_step(cx, rx[i8 * 8 + i]);
                    ox[i] = isx ? v * dtl[hw * 128 + l] * __expf(alast - acs[hw * 128 + l]) : v;
                }
                u32x4 o; o.x = pack2(ox[0], ox[1]); o.y = pack2(ox[2], ox[3]); o.z = pack2(ox[4], ox[5]); o.w = pack2(ox[6], ox[7]);
                *(u32x4*)(dst + l0 + i8 * 8) = o;
            }
        }
    }
    __syncthreads();
    {
        const int hw = w & 3, nh = w >> 2;
        f32x4 acc[4][4];
#pragma unroll
        for (int pt = 0; pt < 4; ++pt)
#pragma unroll
            for (int nt = 0; nt < 4; ++nt) acc[pt][nt] = (f32x4){0.f, 0.f, 0.f, 0.f};
#pragma unroll 1
        for (int ks = 0; ks < 4; ++ks) {
            bf16x8 af[4], bfr[4];
#pragma unroll
            for (int pt = 0; pt < 4; ++pt) af[pt] = *(const bf16x8*)(XwT + (hw * 64 + pt * 16 + fr) * SSD_P + ks * 32 + fq * 8);
#pragma unroll
            for (int nt = 0; nt < 4; ++nt) bfr[nt] = *(const bf16x8*)(BcT + ((nh * 4 + nt) * 16 + fr) * SSD_P + ks * 32 + fq * 8);
#pragma unroll
            for (int pt = 0; pt < 4; ++pt)
#pragma unroll
                for (int nt = 0; nt < 4; ++nt) acc[pt][nt] = __builtin_amdgcn_mfma_f32_16x16x32_bf16(af[pt], bfr[nt], acc[pt][nt], 0, 0, 0);
        }
        const int hh = 4 * g + hw;
        float* sp = states + ((size_t)((b * 64 + c) * 8 + hh)) * 8192;
#pragma unroll
        for (int pt = 0; pt < 4; ++pt)
#pragma unroll
            for (int nt = 0; nt < 4; ++nt)
#pragma unroll
                for (int jj = 0; jj < 4; ++jj) sp[(pt * 16 + 4 * fq + jj) * 128 + (nh * 4 + nt) * 16 + fr] = acc[pt][nt][jj];
        if (lane == 0 && nh == 0) cdec[(b * 64 + c) * 8 + hh] = __expf(acs[hw * 128 + 127]);
    }
    __syncthreads();
}

__device__ __forceinline__ void d_ssd_scan(const float* __restrict__ states, const float* __restrict__ cdec, bf16_t* __restrict__ prev, int vb) {
    const int bh = vb >> 1, b = bh >> 3, hh = bh & 7;
    const size_t e0 = (size_t)((vb & 1) * 512 + tid_opaque()) * 8;
    f32x4 h0 = (f32x4){0.f, 0.f, 0.f, 0.f}, h1 = h0;
#pragma unroll 8
    for (int c = 0; c < 64; ++c) {
        const size_t base = ((size_t)((b * 64 + c) * 8 + hh)) * 8192 + e0;
        const f32x4 s0 = *(const f32x4*)(states + base), s1 = *(const f32x4*)(states + base + 4);
        const float d = cdec[(b * 64 + c) * 8 + hh];
        u32x4 o; o.x = pack2(h0.x, h0.y); o.y = pack2(h0.z, h0.w); o.z = pack2(h1.x, h1.y); o.w = pack2(h1.z, h1.w);
        *(u32x4*)(prev + base) = o;
        h0 = h0 * d + s0; h1 = h1 * d + s1;
    }
}

__device__ __forceinline__ void d_ssd_out(const bf16_t* __restrict__ proj, const float* __restrict__ small, const float* __restrict__ conv_w, const float* __restrict__ conv_b,
                                          const float* __restrict__ a_log, const float* __restrict__ d_skip, const bf16_t* __restrict__ prev, bf16_t* __restrict__ yssd, int item, char* lds) {
    const int tid = tid_opaque(), lane = tid & 63, w = tid >> 6, fr = lane & 15, fq = lane >> 4;
    const int b = item >> 7, c = (item >> 1) & 63, g = item & 1;
    bf16_t* XsT = (bf16_t*)(lds + S3_XST); bf16_t* Bc = (bf16_t*)(lds + S3_BC); bf16_t* Cc = (bf16_t*)(lds + S3_CC);
    float* acs = (float*)(lds + S3_ACS); float* dtl = (float*)(lds + S3_DT);
    const size_t tok0 = (size_t)b * SEQ + (size_t)c * 128;
    ssd_acs(small, a_log, tok0, g, acs, dtl, tid);
    {
        const int mode = tid < 256 ? 0 : (tid < 384 ? 1 : 2);
        const int ch = mode == 0 ? g * 256 + tid : (mode == 1 ? 512 + g * 128 + (tid - 256) : 768 + g * 128 + (tid - 384));
        const bf16_t* px = proj + tok0 * PROJ_LD + C_XBC + ch;
        ConvCh cx; conv_init(cx, conv_w, conv_b, ch, px, c);
        bf16_t* dstx = XsT + (tid & 255) * SSD_P;
        bf16_t* dstbc = (mode == 1 ? Bc : Cc) + (tid & 127);
        for (int l0 = 0; l0 < 128; l0 += 32) {
            float rx[32];
#pragma unroll
            for (int i = 0; i < 32; ++i) rx[i] = bf2f(px[(size_t)(l0 + i) * PROJ_LD]);
#pragma unroll
            for (int i8 = 0; i8 < 4; ++i8) {
                float ox[8];
#pragma unroll
                for (int i = 0; i < 8; ++i) ox[i] = conv_step(cx, rx[i8 * 8 + i]);
                if (mode == 0) {
                    u32x4 o; o.x = pack2(ox[0], ox[1]); o.y = pack2(ox[2], ox[3]); o.z = pack2(ox[4], ox[5]); o.w = pack2(ox[6], ox[7]);
                    *(u32x4*)(dstx + l0 + i8 * 8) = o;
                } else {
#pragma unroll
                    for (int i = 0; i < 8; ++i) dstbc[(l0 + i8 * 8 + i) * SSD_P] = f2bf(ox[i]);
                }
            }
        }
    }
    __syncthreads();
    const int hw = w & 3, lh = w >> 2, hh = 4 * g + hw;
    const float dsk = d_skip[hh];
    const bf16_t* pp = prev + ((size_t)((b * 64 + c) * 8 + hh)) * 8192;
#pragma unroll 1
    for (int lk = 0; lk < 4; ++lk) {
        const int lt = lh + 2 * lk;
        const int l = lt * 16 + fr;
        const float acs_l = acs[hw * 128 + l];
        bf16x8 cf[4];
#pragma unroll
        for (int ks = 0; ks < 4; ++ks) cf[ks] = *(const bf16x8*)(Cc + (lt * 16 + fr) * SSD_P + ks * 32 + fq * 8);
        f32x4 y[4], yo[4];
#pragma unroll
        for (int pt = 0; pt < 4; ++pt) { y[pt] = (f32x4){0.f, 0.f, 0.f, 0.f}; yo[pt] = (f32x4){0.f, 0.f, 0.f, 0.f}; }
#pragma unroll
        for (int ks2 = 0; ks2 < 4; ++ks2) {
            if (2 * ks2 <= lt) {
                f32x4 cb[2];
#pragma unroll
                for (int h2 = 0; h2 < 2; ++h2) {
                    const int st = 2 * ks2 + h2;
                    cb[h2] = (f32x4){0.f, 0.f, 0.f, 0.f};
                    if (st <= lt) {
#pragma unroll
                        for (int ks = 0; ks < 4; ++ks)
                            cb[h2] = __builtin_amdgcn_mfma_f32_16x16x32_bf16(*(const bf16x8*)(Bc + (st * 16 + fr) * SSD_P + ks * 32 + fq * 8), cf[ks], cb[h2], 0, 0, 0);
#pragma unroll
                        for (int jj = 0; jj < 4; ++jj) {
                            const int sidx = st * 16 + 4 * fq + jj;
                            cb[h2][jj] = (sidx <= l) ? cb[h2][jj] * __expf(acs_l - acs[hw * 128 + sidx]) * dtl[hw * 128 + sidx] : 0.f;
                        }
                    }
                }
                u32x4 wv; wv.x = pack2(cb[0].x, cb[0].y); wv.y = pack2(cb[0].z, cb[0].w); wv.z = pack2(cb[1].x, cb[1].y); wv.w = pack2(cb[1].z, cb[1].w);
                const bf16x8 mf = __builtin_bit_cast(bf16x8, wv);
#pragma unroll
                for (int pt = 0; pt < 4; ++pt) {
                    const bf16_t* xp = XsT + (hw * 64 + pt * 16 + fr) * SSD_P + ks2 * 32 + 4 * fq;
                    const u32x2 a0 = *(const u32x2*)xp, a1 = *(const u32x2*)(xp + 16);
                    u32x4 xv; xv.x = a0.x; xv.y = a0.y; xv.z = a1.x; xv.w = a1.y;
                    y[pt] = __builtin_amdgcn_mfma_f32_16x16x32_bf16(__builtin_bit_cast(bf16x8, xv), mf, y[pt], 0, 0, 0);
                }
            }
            __builtin_amdgcn_sched_barrier(0);
        }
        __builtin_amdgcn_sched_barrier(0);
#pragma unroll
        for (int pt = 0; pt < 4; ++pt)
#pragma unroll
            for (int ks = 0; ks < 4; ++ks) yo[pt] = __builtin_amdgcn_mfma_f32_16x16x32_bf16(*(const bf16x8*)(pp + (pt * 16 + fr) * 128 + ks * 32 + fq * 8), cf[ks], yo[pt], 0, 0, 0);
        __builtin_amdgcn_sched_barrier(0);
        const float el = __expf(acs_l);
#pragma unroll
        for (int pt = 0; pt < 4; ++pt) {
            const int p0 = pt * 16 + 4 * fq;
            const u32x2 zz = *(const u32x2*)(proj + (tok0 + l) * PROJ_LD + C_Z + hh * 64 + p0);
            const float z0 = bflo(zz.x), z1 = bfhi(zz.x), z2 = bflo(zz.y), z3 = bfhi(zz.y);
            const bf16_t* xq = XsT + (hw * 64 + p0) * SSD_P + l;
            const float x0 = bf2f(xq[0]), x1 = bf2f(xq[SSD_P]), x2 = bf2f(xq[2 * SSD_P]), x3 = bf2f(xq[3 * SSD_P]);
            u32x2 ob;
            ob.x = pack2((y[pt].x + el * yo[pt].x + dsk * x0) * silu(z0), (y[pt].y + el * yo[pt].y + dsk * x1) * silu(z1));
            ob.y = pack2((y[pt].z + el * yo[pt].z + dsk * x2) * silu(z2), (y[pt].w + el * yo[pt].w + dsk * x3) * silu(z3));
            *(u32x2*)(yssd + (tok0 + l) * 512 + hh * 64 + p0) = ob;
        }
    }
    __syncthreads();
}

__device__ __forceinline__ void d_mix_prep(const float* __restrict__ onsa, const bf16_t* __restrict__ yssd, const float* __restrict__ nsa_w, const float* __restrict__ ssd_w, bf16_t* __restrict__ A2, int vb) {
    const int tid_ = tid_opaque(); const int lane = tid_ & 63, wid = tid_ >> 6;
    const size_t row0 = (size_t)vb * 32 + wid * 4;
    f32x4 a[4][2], y[4][2];
#pragma unroll
    for (int r = 0; r < 4; ++r)
#pragma unroll
        for (int k = 0; k < 2; ++k) {
            a[r][k] = *(const f32x4*)(onsa + (row0 + r) * 512 + k * 256 + lane * 4);
            const u32x2 yy = *(const u32x2*)(yssd + (row0 + r) * 512 + k * 256 + lane * 4);
            y[r][k] = (f32x4){bflo(yy.x), bfhi(yy.x), bflo(yy.y), bfhi(yy.y)};
        }
    float ra[4], ry[4];
#pragma unroll
    for (int r = 0; r < 4; ++r) {
        float s0 = 0.f, s1 = 0.f;
#pragma unroll
        for (int k = 0; k < 2; ++k) {
            s0 += a[r][k].x * a[r][k].x + a[r][k].y * a[r][k].y + a[r][k].z * a[r][k].z + a[r][k].w * a[r][k].w;
            s1 += y[r][k].x * y[r][k].x + y[r][k].y * y[r][k].y + y[r][k].z * y[r][k].z + y[r][k].w * y[r][k].w;
        }
        ra[r] = rsqrtf(wave_sum(s0) * (1.0f / 512) + EPS); ry[r] = rsqrtf(wave_sum(s1) * (1.0f / 512) + EPS);
    }
#pragma unroll
    for (int k = 0; k < 2; ++k) {
        const int col = k * 256 + lane * 4;
        const f32x4 wn = *(const f32x4*)(nsa_w + col), wsd = *(const f32x4*)(ssd_w + col);
#pragma unroll
        for (int r = 0; r < 4; ++r) {
            const f32x4 p = a[r][k] * ra[r] * wn, q = y[r][k] * ry[r] * wsd;
            u32x2 o; o.x = pack2(p.x, p.y); o.y = pack2(p.z, p.w);
            *(u32x2*)(A2 + (row0 + r) * DM + col) = o;
            u32x2 o2; o2.x = pack2(q.x, q.y); o2.y = pack2(q.z, q.w);
            *(u32x2*)(A2 + (row0 + r) * DM + 512 + col) = o2;
        }
    }
}

__device__ __forceinline__ void d_quant_rows(const float* __restrict__ src, unsigned char* __restrict__ dst, float* __restrict__ scale, int vb) {
    const int tid_ = tid_opaque(); const int lane = tid_ & 63, row = vb * 8 + (tid_ >> 6);
    const float* rp = src + (size_t)row * DM + lane * 16;
    f32x4 v[4];
#pragma unroll
    for (int i = 0; i < 4; ++i) v[i] = *(const f32x4*)(rp + i * 4);
    float mx = 0.f;
#pragma unroll
    for (int i = 0; i < 4; ++i) mx = fmaxf(mx, fmaxf(fmaxf(fabsf(v[i].x), fabsf(v[i].y)), fmaxf(fabsf(v[i].z), fabsf(v[i].w))));
    mx = wave_max(mx);
    const float sc = mx > 0.f ? mx * (1.0f / 6.0f) : 1.0f;
    const float inv = 1.0f / sc;
    u32x2 o;
#pragma unroll
    for (int h = 0; h < 2; ++h) {
        unsigned wv = 0u;
        wv = __builtin_amdgcn_cvt_scalef32_pk_fp4_f32(wv, v[2 * h].x * inv, v[2 * h].y * inv, 1.0f, 0);
        wv = __builtin_amdgcn_cvt_scalef32_pk_fp4_f32(wv, v[2 * h].z * inv, v[2 * h].w * inv, 1.0f, 1);
        wv = __builtin_amdgcn_cvt_scalef32_pk_fp4_f32(wv, v[2 * h + 1].x * inv, v[2 * h + 1].y * inv, 1.0f, 2);
        wv = __builtin_amdgcn_cvt_scalef32_pk_fp4_f32(wv, v[2 * h + 1].z * inv, v[2 * h + 1].w * inv, 1.0f, 3);
        o[h] = wv;
    }
    *(u32x2*)(dst + (size_t)row * 512 + lane * 8) = o;
    if (lane == 0) scale[row] = sc;
}

__device__ __forceinline__ unsigned mono_u(float f) { const unsigned u = __float_as_uint(f); return (u & 0x80000000u) ? ~u : (u | 0x80000000u); }
__device__ __forceinline__ float unmono_f(unsigned m) { const unsigned u = (m & 0x80000000u) ? (m & 0x7fffffffu) : ~m; return __uint_as_float(u); }
__device__ __forceinline__ void d_peer_route(const bf16_t* __restrict__ qp, const float* __restrict__ qnw, const bf16_t* __restrict__ subk, int* __restrict__ eidx, float* __restrict__ gate,
                                             int tile, int h, char* lds) {
    const int tid = tid_opaque(), lane = tid & 63, w = tid >> 6, fr = lane & 15, fq = lane >> 4;
    const size_t tok = (size_t)tile * 128 + w * 16 + fr;
    bf16x8 qf[2][4];
    {
        const bf16_t* qrow = qp + tok * 2048 + h * 256;
        u32x4 raw[2][4];
        float ss = 0.f;
#pragma unroll
        for (int k = 0; k < 2; ++k)
#pragma unroll
            for (int ks = 0; ks < 4; ++ks) {
                const u32x4 r = *(const u32x4*)(qrow + k * 128 + ks * 32 + fq * 8);
                raw[k][ks] = r;
                ss += bflo(r.x) * bflo(r.x) + bfhi(r.x) * bfhi(r.x) + bflo(r.y) * bflo(r.y) + bfhi(r.y) * bfhi(r.y)
                    + bflo(r.z) * bflo(r.z) + bfhi(r.z) * bfhi(r.z) + bflo(r.w) * bflo(r.w) + bfhi(r.w) * bfhi(r.w);
            }
        ss += __shfl_xor(ss, 16); ss += __shfl_xor(ss, 32);
        const float rs = rsqrtf(ss * (1.0f / 256) + EPS);
#pragma unroll
        for (int k = 0; k < 2; ++k)
#pragma unroll
            for (int ks = 0; ks < 4; ++ks) {
                const float* wp = qnw + k * 128 + ks * 32 + fq * 8;
                const f32x4 w0 = *(const f32x4*)wp, w1 = *(const f32x4*)(wp + 4);
                const u32x4 r = raw[k][ks];
                u32x4 o;
                o.x = pack2(bflo(r.x) * rs * w0.x, bfhi(r.x) * rs * w0.y); o.y = pack2(bflo(r.y) * rs * w0.z, bfhi(r.y) * rs * w0.w);
                o.z = pack2(bflo(r.z) * rs * w1.x, bfhi(r.z) * rs * w1.y); o.w = pack2(bflo(r.w) * rs * w1.z, bfhi(r.w) * rs * w1.w);
                qf[k][ks] = __builtin_bit_cast(bf16x8, o);
            }
    }
    unsigned L[2][16];
#pragma unroll
    for (int k = 0; k < 2; ++k) {
        f32x4 acc[8];
#pragma unroll
        for (int kt = 0; kt < 8; ++kt) acc[kt] = (f32x4){0.f, 0.f, 0.f, 0.f};
        const bf16_t* kb = subk + (size_t)((h * 2 + k) * 128) * 128;
#pragma unroll
        for (int kt = 0; kt < 8; ++kt)
#pragma unroll
            for (int ks = 0; ks < 4; ++ks) {
                const bf16x8 af = *(const bf16x8*)(kb + (size_t)(kt * 16 + fr) * 128 + ks * 32 + fq * 8);
                acc[kt] = __builtin_amdgcn_mfma_f32_16x16x32_bf16(af, qf[k][ks], acc[kt], 0, 0, 0);
            }
#pragma unroll
        for (int i = 0; i < 16; ++i) L[k][i] = 0u;
#pragma unroll
        for (int kt = 0; kt < 8; ++kt)
#pragma unroll
            for (int jj = 0; jj < 4; ++jj) {
                const int idx = kt * 16 + 4 * fq + jj;
                ins16(L[k], (mono_u(acc[kt][jj]) & ~0x7Fu) | (unsigned)(127 - idx));
            }
#pragma unroll
        for (int r = 16; r <= 32; r <<= 1) {
            unsigned P[16];
#pragma unroll
            for (int i = 0; i < 16; ++i) P[i] = (unsigned)__shfl_xor((int)L[k][i], r);
            merge16(L[k], P);
        }
    }
    unsigned T[16];
#pragma unroll
    for (int i = 0; i < 16; ++i) T[i] = 0u;
#pragma unroll
    for (int a = 0; a < 16; ++a) {
        const float va = unmono_f(L[0][a] & ~0x7Fu);
#pragma unroll
        for (int bb = 0; bb < 16; ++bb) {
            if (bb <= 16 / (a + 1) - 1) {
                const float sum = va + unmono_f(L[1][bb] & ~0x7Fu);
                ins16(T, (mono_u(sum) & ~0xFFu) | (unsigned)(255 - (a * 16 + bb)));
            }
        }
    }
    unsigned char* li = (unsigned char*)lds + w * 512 + fr * 32;
    if (fq == 0) {
#pragma unroll
        for (int a = 0; a < 16; ++a) { li[a] = (unsigned char)(127 - (L[0][a] & 0x7Fu)); li[16 + a] = (unsigned char)(127 - (L[1][a] & 0x7Fu)); }
    }
    __syncthreads();
    const float s0 = unmono_f(T[0] & ~0xFFu);
    float pe[16]; float sum = 0.f;
#pragma unroll
    for (int i = 0; i < 16; ++i) { pe[i] = __expf(unmono_f(T[i] & ~0xFFu) - s0); sum += pe[i]; }
    const float inv = 1.0f / sum;
    unsigned cod[4] = {0u, 0u, 0u, 0u}; float gv[4] = {0.f, 0.f, 0.f, 0.f};
#pragma unroll
    for (int i = 0; i < 16; ++i) if ((i >> 2) == fq) { cod[i & 3] = 255u - (T[i] & 0xFFu); gv[i & 3] = pe[i] * inv; }
    int ev[4];
#pragma unroll
    for (int i = 0; i < 4; ++i) ev[i] = (int)li[cod[i] >> 4] * 128 + (int)li[16 + (cod[i] & 15u)];
    *(u32x4*)(eidx + (tok * 8 + h) * 16 + fq * 4) = (u32x4){(unsigned)ev[0], (unsigned)ev[1], (unsigned)ev[2], (unsigned)ev[3]};
    *(f32x4*)(gate + (tok * 8 + h) * 16 + fq * 4) = (f32x4){gv[0], gv[1], gv[2], gv[3]};
    __syncthreads();
}

__device__ __forceinline__ void cvt16(const u32x2 q, f32x2 (&f)[8]) {
#pragma unroll
    for (int i = 0; i < 2; ++i) {
        f[4 * i] = __builtin_amdgcn_cvt_scalef32_pk_f32_fp4(q[i], 1.0f, 0); f[4 * i + 1] = __builtin_amdgcn_cvt_scalef32_pk_f32_fp4(q[i], 1.0f, 1);
        f[4 * i + 2] = __builtin_amdgcn_cvt_scalef32_pk_f32_fp4(q[i], 1.0f, 2); f[4 * i + 3] = __builtin_amdgcn_cvt_scalef32_pk_f32_fp4(q[i], 1.0f, 3);
    }
}
__device__ __forceinline__ void d_peer_expert8(const bf16_t* __restrict__ h2, const unsigned char* __restrict__ down8, const unsigned char* __restrict__ up8, const float* __restrict__ dscale,
                                               const float* __restrict__ uscale, const int* __restrict__ eidx, const float* __restrict__ gate, const float* __restrict__ mod,
                                               const float* __restrict__ fw, float* __restrict__ out, int vb) {
    const int tid = tid_opaque(), lane = tid & 63, wid = tid >> 6;
    const size_t tok = (size_t)vb * 8 + wid; const int b = (int)(tok >> 13);
    const int e_lo = eidx[tok * 128 + lane], e_hi = eidx[tok * 128 + 64 + lane];
    const float c_lo = gate[tok * 128 + lane] * uscale[e_lo], c_hi = gate[tok * 128 + 64 + lane] * uscale[e_hi];
    const float d_lo = dscale[e_lo], d_hi = dscale[e_hi];
    f32x2 hx[8], acc[8];
    {
        const u32x4 v0 = *(const u32x4*)(h2 + tok * DM + lane * 16), v1 = *(const u32x4*)(h2 + tok * DM + lane * 16 + 8);
        hx[0] = (f32x2){bflo(v0.x), bfhi(v0.x)}; hx[1] = (f32x2){bflo(v0.y), bfhi(v0.y)}; hx[2] = (f32x2){bflo(v0.z), bfhi(v0.z)}; hx[3] = (f32x2){bflo(v0.w), bfhi(v0.w)};
        hx[4] = (f32x2){bflo(v1.x), bfhi(v1.x)}; hx[5] = (f32x2){bflo(v1.y), bfhi(v1.y)}; hx[6] = (f32x2){bflo(v1.z), bfhi(v1.z)}; hx[7] = (f32x2){bflo(v1.w), bfhi(v1.w)};
    }
#pragma unroll
    for (int e = 0; e < 8; ++e) acc[e] = (f32x2){0.f, 0.f};
    const int es = lane >> 3;
    u32x2 dq[8], uq[8], dn[8], un[8];
#pragma unroll
    for (int i = 0; i < 8; ++i) {
        const int e = __builtin_amdgcn_readlane(e_lo, i);
        dq[i] = *(const u32x2*)(down8 + (size_t)e * 512 + lane * 8);
        uq[i] = *(const u32x2*)(up8 + (size_t)e * 512 + lane * 8);
    }
#pragma unroll 1
    for (int j0 = 0; j0 < 128; j0 += 8) {
        if (j0 + 8 < 128) {
            const int jn = j0 + 8;
#pragma unroll
            for (int i = 0; i < 8; ++i) {
                const int e = jn < 64 ? __builtin_amdgcn_readlane(e_lo, jn + i) : __builtin_amdgcn_readlane(e_hi, jn - 64 + i);
                dn[i] = *(const u32x2*)(down8 + (size_t)e * 512 + lane * 8);
                un[i] = *(const u32x2*)(up8 + (size_t)e * 512 + lane * 8);
            }
        }
        const int sl = (j0 & 63) + es;
        const float my_c = j0 < 64 ? __shfl(c_lo, sl) : __shfl(c_hi, sl);
        const float my_ds = j0 < 64 ? __shfl(d_lo, sl) : __shfl(d_hi, sl);
        float part[8];
#pragma unroll
        for (int i = 0; i < 8; ++i) {
            f32x2 f[8]; cvt16(dq[i], f);
            f32x2 s2 = hx[0] * f[0];
#pragma unroll
            for (int e = 1; e < 8; ++e) s2 = __builtin_elementwise_fma(hx[e], f[e], s2);
            part[i] = s2.x + s2.y;
        }
        float q4[4], q2[2], q1;
#pragma unroll
        for (int i = 0; i < 4; ++i) { const bool up = (lane & 32) != 0; const float send = up ? part[i] : part[i + 4]; const float keep = up ? part[i + 4] : part[i]; q4[i] = keep + __shfl_xor(send, 32); }
#pragma unroll
        for (int i = 0; i < 2; ++i) { const bool up = (lane & 16) != 0; const float send = up ? q4[i] : q4[i + 2]; const float keep = up ? q4[i + 2] : q4[i]; q2[i] = keep + __shfl_xor(send, 16); }
        { const bool up = (lane & 8) != 0; const float send = up ? q2[0] : q2[1]; const float keep = up ? q2[1] : q2[0]; q1 = keep + __shfl_xor(send, 8); }
        q1 += __shfl_xor(q1, 4); q1 += __shfl_xor(q1, 2); q1 += __shfl_xor(q1, 1);
        const float a = gelu_tanh(q1 * my_ds) * my_c;
#pragma unroll
        for (int i = 0; i < 8; ++i) {
            const float c = __uint_as_float((unsigned)__builtin_amdgcn_readlane((int)__float_as_uint(a), 8 * i));
            const f32x2 c2 = {c, c};
            f32x2 f[8]; cvt16(uq[i], f);
#pragma unroll
            for (int e = 0; e < 8; ++e) acc[e] = __builtin_elementwise_fma(f[e], c2, acc[e]);
        }
#pragma unroll
        for (int i = 0; i < 8; ++i) { dq[i] = dn[i]; uq[i] = un[i]; }
    }
    float x2[16]; float ss = 0.f;
#pragma unroll
    for (int q4i = 0; q4i < 4; ++q4i) {
        const int col = lane * 16 + q4i * 4;
        const f32x4 xv = *(const f32x4*)(out + tok * DM + col);
        const f32x4 g2 = *(const f32x4*)(mod + b * 6144 + 5120 + col);
        const int e0 = q4i * 4;
        x2[e0 + 0] = xv.x + g2.x * acc[2 * q4i].x; x2[e0 + 1] = xv.y + g2.y * acc[2 * q4i].y; x2[e0 + 2] = xv.z + g2.z * acc[2 * q4i + 1].x; x2[e0 + 3] = xv.w + g2.w * acc[2 * q4i + 1].y;
        ss += x2[e0] * x2[e0] + x2[e0 + 1] * x2[e0 + 1] + x2[e0 + 2] * x2[e0 + 2] + x2[e0 + 3] * x2[e0 + 3];
    }
    ss = wave_sum(ss);
    const float r = rsqrtf(ss * (1.0f / DM) + EPS);
#pragma unroll
    for (int q4i = 0; q4i < 4; ++q4i) {
        const int col = lane * 16 + q4i * 4;
        const f32x4 wv = *(const f32x4*)(fw + col);
        const int e0 = q4i * 4;
        *(f32x4*)(out + tok * DM + col) = (f32x4){x2[e0] * r * wv.x, x2[e0 + 1] * r * wv.y, x2[e0 + 2] * r * wv.z, x2[e0 + 3] * r * wv.w};
    }
}

#define XB_TMO      128
#define XB_XCNT(j)  (256  + 64 * (j))
#define XB_XSUB(j)  (1280 + 64 * (j))
#define XB_XGEN(j)  (2304 + 64 * (j))
#define XB_TOP      3328
#define XB_TOPGEN   3392
#define XCD_BAR_WORDS 3456
#define XB_SPIN_CAP (1u << 18)

__device__ __forceinline__ unsigned xb_ld(unsigned* p)              { return __hip_atomic_load(p, __ATOMIC_RELAXED, __HIP_MEMORY_SCOPE_AGENT); }
__device__ __forceinline__ unsigned xb_add(unsigned* p, unsigned v) { return __hip_atomic_fetch_add(p, v, __ATOMIC_RELAXED, __HIP_MEMORY_SCOPE_AGENT); }
__device__ __forceinline__ unsigned xb_xcc_id() { return (unsigned)__builtin_amdgcn_s_getreg((3 << 11) | 20) & 0xFu; }
#define XB_SPIN(cond, bar) do { unsigned _sp = 0; while (cond) { __builtin_amdgcn_s_sleep(1); \
    if ((++_sp & 255u) == 0u) { if (xb_ld(&(bar)[XB_TMO])) break; if (_sp > XB_SPIN_CAP) { atomicAdd(&(bar)[XB_TMO], 1u); break; } } } } while (0)

struct XcdBarrier {
    unsigned* bar; unsigned x;
    volatile __attribute__((address_space(3))) unsigned* st;
};

__device__ __forceinline__ XcdBarrier xcd_barrier_post(unsigned* bar, volatile __attribute__((address_space(3))) unsigned* st) {
    XcdBarrier b; b.bar = bar; b.x = xb_xcc_id(); b.st = st;
    if (threadIdx.x == 0) (void)xb_add(&bar[XB_XCNT(b.x)], 1u);
    return b;
}
__device__ __forceinline__ void xcd_barrier_complete(unsigned* bar, unsigned x, unsigned& nloc, unsigned& nx) {
    const unsigned G = gridDim.x * gridDim.y * gridDim.z;
    unsigned sum, cnt, mine, sp = 0u;
    for (;;) {
        sum = 0u; cnt = 0u; mine = 0u;
#pragma unroll
        for (unsigned j = 0; j < 16; ++j) { const unsigned c = xb_ld(&bar[XB_XCNT(j)]); sum += c; cnt += (c > 0u) ? 1u : 0u; mine = (j == x) ? c : mine; }
        if (sum == G) break;
        __builtin_amdgcn_s_sleep(1);
        if ((++sp & 255u) == 0u) { if (xb_ld(&bar[XB_TMO])) break; if (sp > XB_SPIN_CAP) { atomicAdd(&bar[XB_TMO], 1u); break; } }
    }
    nloc = mine > 0u ? mine : 1u; nx = cnt > 0u ? cnt : 1u;
}

__device__ __forceinline__ void xcd_barrier(const XcdBarrier& b) {
    asm volatile("s_waitcnt vmcnt(0)" ::: "memory");
    __syncthreads();
    if (threadIdx.x == 0) {
        unsigned* bar = b.bar;
        __builtin_amdgcn_s_waitcnt(0);
        unsigned nloc = b.st[0], nx = b.st[1];
        if (nloc == 0u) { xcd_barrier_complete(bar, b.x, nloc, nx); b.st[0] = nloc; b.st[1] = nx; }
        const unsigned old = xb_add(&bar[XB_XSUB(b.x)], 1u);
        const unsigned gen = old / nloc;
        if (old + 1u == (gen + 1u) * nloc) {
            __builtin_amdgcn_fence(__ATOMIC_RELEASE, "agent");
            asm volatile("s_waitcnt vmcnt(0)" ::: "memory");
            const unsigned og = xb_add(&bar[XB_TOP], 1u);
            const unsigned tg = og / nx;
            if (og + 1u == (tg + 1u) * nx) xb_add(&bar[XB_TOPGEN], 1u);
            else XB_SPIN(xb_ld(&bar[XB_TOPGEN]) == tg, bar);
            __builtin_amdgcn_fence(__ATOMIC_ACQUIRE, "agent");
            xb_add(&bar[XB_XGEN(b.x)], 1u);
            asm volatile("s_waitcnt vmcnt(0)" ::: "memory");
        } else {
            XB_SPIN(xb_ld(&bar[XB_XGEN(b.x)]) == gen, bar);
            __builtin_amdgcn_fence(__ATOMIC_ACQUIRE, "agent");
            asm volatile("s_waitcnt vmcnt(0)" ::: "memory");
        }
    }
    __syncthreads();
}


struct Params {
    const float *x, *c, *w_ada, *b_ada, *norm1_w, *w_in, *cmp_pe_k, *cmp_pe_v, *cmp_w1_k, *cmp_w2_k, *cmp_w1_v, *cmp_w2_v, *nsa_norm_w, *conv_w, *conv_b, *dt_bias, *a_log, *d_skip,
        *ssd_norm_w, *w_out, *norm2_w, *peer_wq, *peer_qnorm_w, *peer_sub_keys, *peer_down, *peer_up, *final_norm_w;
    float* out; char* ws;
};
#define LDS_BYTES 147456
#define LDS_MISC  (LDS_BYTES - 64)

__global__ __launch_bounds__(512, 2) void mega(Params p) {
    __shared__ __attribute__((aligned(16))) unsigned char lds_raw[LDS_BYTES];
    char* lds = (char*)lds_raw;
    PG8_LAS unsigned char* lds3 = (PG8_LAS unsigned char*)lds_raw;
    int* s_vb = (int*)(lds + LDS_MISC);
    cg::grid_group grid = cg::this_grid();
    volatile __attribute__((address_space(3))) unsigned* xb_st = (volatile __attribute__((address_space(3))) unsigned*)((PG8_LAS unsigned char*)lds_raw + LDS_MISC + 16);
    if (threadIdx.x == 0) { xb_st[0] = 0u; xb_st[1] = 0u; }
    __syncthreads();
    const XcdBarrier xbar = xcd_barrier_post((unsigned*)(p.ws + OFF_BAR), xb_st);
    const int G = gridDim.x, bid = blockIdx.x;
    if (bid == 0 && threadIdx.x == 0) { ((unsigned*)(p.ws + OFF_CTR))[0] = 0u; ((unsigned*)(p.ws + OFF_CTR))[64] = 0u; ((unsigned*)(p.ws + OFF_CTR))[128] = 0u; }
    for (int vb = bid; vb < 7906; vb += G) {
        int v = vb;
        if (v < 1536) { d_transpose_w(p.w_in, ((bf16_t*)(p.ws + OFF_WIN_T)), 1024, 2848, 1, 96, v, lds); }
        else if ((v -= 1536) < 512) { d_transpose_w(p.w_out, ((bf16_t*)(p.ws + OFF_WOUT_T)), 1024, 1024, 0, 32, v, lds); }
        else if ((v -= 512) < 1024) { d_transpose_w(p.peer_wq, ((bf16_t*)(p.ws + OFF_WQ_T)), 1024, 2048, 0, 64, v, lds); }
        else if ((v -= 1024) < 256) { d_transpose_w(p.cmp_w1_k, ((bf16_t*)(p.ws + OFF_W1K_T)), 2048, 256, 0, 8, v, lds); }
        else if ((v -= 256) < 256) { d_transpose_w(p.cmp_w1_v, ((bf16_t*)(p.ws + OFF_W1V_T)), 2048, 256, 0, 8, v, lds); }
        else if ((v -= 256) < 2048) { d_quant_rows(p.peer_down, ((unsigned char*)(p.ws + OFF_DOWN)), ((float*)(p.ws + OFF_UP)), v); }
        else if ((v -= 2048) < 2048) { d_quant_rows(p.peer_up, ((unsigned char*)(p.ws + OFF_DOWN + MIB(8))), ((float*)(p.ws + OFF_UP + 65536)), v); }
        else if ((v -= 2048) < 1) { d_convert_bf16(p.peer_sub_keys, ((bf16_t*)(p.ws + OFF_SUBK)), (size_t)8 * 2 * 128 * 128 / 8, 0, 1); }
        else if ((v -= 1) < 96) { d_mod(p.c, p.w_ada, p.b_ada, ((float*)(p.ws + OFF_MOD)), v, lds); }
        else if ((v -= 96) < 128) { d_rope_table(((float2*)(p.ws + OFF_ROPE)), v); }
        else { d_bias1(p.cmp_pe_k, p.cmp_w1_k, p.cmp_pe_v, p.cmp_w1_v, ((float*)(p.ws + OFF_BIAS1))); }
    }
    grid.sync();
    for (int vb = bid; vb < NTOK / 32; vb += G) d_norm_mod(p.x, p.norm1_w, ((float*)(p.ws + OFF_MOD)), 0, 1024, ((bf16_t*)(p.ws + OFF_H)), vb);
    xcd_barrier(xbar);
    {
        const pg8::Gemm g{((bf16_t*)(p.ws + OFF_H)), ((bf16_t*)(p.ws + OFF_WIN_T)), NTOK, NIN_PAD, 1024, 1024};
        pg8::StaticOrder S; S.init(NTOK, NIN_PAD, G, bid);
        const pg8::Epi<EpInProj> E{{((bf16_t*)(p.ws + OFF_PROJ)), ((bf16_t*)(p.ws + OFF_QROPE)), ((bf16_t*)(p.ws + OFF_KVP)), ((float*)(p.ws + OFF_SMALL)), ((float2*)(p.ws + OFF_ROPE)), p.dt_bias}};
        pg8::gemm_phase(lds3, g, S, E);
    }
    xcd_barrier(xbar);
    {
        {
            const pg8::Gemm g{((bf16_t*)(p.ws + OFF_KVP)) + 0 * KVP_SEG, ((bf16_t*)(p.ws + OFF_W1K_T)), 8192, 256, 2048, 1024};
            pg8::StaticOrder S; S.init(8192, 256, G, bid);
            const pg8::Epi<EpCmpHid> E{{((bf16_t*)(p.ws + OFF_HIDK)), ((float*)(p.ws + OFF_BIAS1))}};
            pg8::gemm_phase(lds3, g, S, E);
        }
        {
            const pg8::Gemm g{((bf16_t*)(p.ws + OFF_KVP)) + 1 * KVP_SEG, ((bf16_t*)(p.ws + OFF_W1V_T)), 8192, 256, 2048, 1024};
            pg8::StaticOrder S; S.init(8192, 256, G, (bid + G / 2) % G);
            const pg8::Epi<EpCmpHid> E{{((bf16_t*)(p.ws + OFF_HIDV)), ((float*)(p.ws + OFF_BIAS1)) + 256}};
            pg8::gemm_phase(lds3, g, S, E);
        }
        __syncthreads();
        for (int vb = bid; vb < 1024; vb += G) d_ssd_states(((bf16_t*)(p.ws + OFF_PROJ)), ((float*)(p.ws + OFF_SMALL)), p.conv_w, p.conv_b, p.a_log, ((float*)(p.ws + OFF_ONSA)), ((float*)(p.ws + OFF_CTR + 4096)), vb, lds);
    }
    xcd_barrier(xbar);
    for (int vb = bid; vb < 2048 + 128; vb += G) {
        if (vb < 1024) d_cmp_out(((bf16_t*)(p.ws + OFF_HIDK)), p.cmp_w2_k, ((bf16_t*)(p.ws + OFF_KC)), vb); else if (vb < 2048) d_cmp_out(((bf16_t*)(p.ws + OFF_HIDV)), p.cmp_w2_v, ((bf16_t*)(p.ws + OFF_VC)), vb - 1024);
        else d_ssd_scan(((float*)(p.ws + OFF_ONSA)), ((float*)(p.ws + OFF_CTR + 4096)), ((bf16_t*)(p.ws + OFF_EIDX)), vb - 2048);
    }
    xcd_barrier(xbar);
    for (;;) {
        if (threadIdx.x == 0) *s_vb = (int)atomicAdd(&((unsigned*)(p.ws + OFF_CTR))[0], 1u);
        __syncthreads();
        const int i = *s_vb;
        __syncthreads();
        if (i >= 2048) break;
        const int qt = 127 - (i >> 4), bg = i & 15;
        d_nsa_cmp(((bf16_t*)(p.ws + OFF_PROJ)), ((bf16_t*)(p.ws + OFF_KC)), ((bf16_t*)(p.ws + OFF_VC)), ((float*)(p.ws + OFF_SMALL)), ((float*)(p.ws + OFF_ONSA)), ((unsigned*)(p.ws + OFF_HIDK)) + (size_t)(bg * 128 + qt) * 512, bg >> 1, bg & 1, qt, lds);
    }
    for (;;) {
        if (threadIdx.x == 0) *s_vb = (int)atomicAdd(&((unsigned*)(p.ws + OFF_CTR))[64], 1u);
        __syncthreads();
        const int i = *s_vb;
        __syncthreads();
        if (i >= 1024) break;
        d_ssd_out(((bf16_t*)(p.ws + OFF_PROJ)), ((float*)(p.ws + OFF_SMALL)), p.conv_w, p.conv_b, p.a_log, p.d_skip, ((bf16_t*)(p.ws + OFF_EIDX)), ((bf16_t*)(p.ws + OFF_YSSD)), i, lds);
    }
    xcd_barrier(xbar);
    for (;;) {
        if (threadIdx.x == 0) *s_vb = (int)atomicAdd(&((unsigned*)(p.ws + OFF_CTR))[128], 1u);
        __syncthreads();
        const int i = *s_vb;
        __syncthreads();
        if (i >= 2048) break;
        const int qt = 127 - (i >> 4), bg = i & 15;
        d_nsa_attn(((bf16_t*)(p.ws + OFF_QROPE)), ((bf16_t*)(p.ws + OFF_KVP)), ((float*)(p.ws + OFF_SMALL)), ((float*)(p.ws + OFF_ONSA)), ((unsigned*)(p.ws + OFF_HIDK)) + (size_t)(bg * 128 + qt) * 512, bg >> 1, bg & 1, qt, lds);
    }
    xcd_barrier(xbar);
    for (int vb = bid; vb < NTOK / 32; vb += G) d_mix_prep(((float*)(p.ws + OFF_ONSA)), ((bf16_t*)(p.ws + OFF_YSSD)), p.nsa_norm_w, p.ssd_norm_w, ((bf16_t*)(p.ws + OFF_H)), vb);
    xcd_barrier(xbar);
    {
        const pg8::Gemm g{((bf16_t*)(p.ws + OFF_H)), ((bf16_t*)(p.ws + OFF_WOUT_T)), NTOK, 1024, 1024, 1024};
        pg8::StaticOrder S; S.init(NTOK, 1024, G, bid);
        const pg8::Epi<EpOutProj> E{{p.x, ((float*)(p.ws + OFF_MOD)), p.out}};
        pg8::gemm_phase(lds3, g, S, E);
    }
    xcd_barrier(xbar);
    for (int vb = bid; vb < NTOK / 32; vb += G) d_norm_mod(p.out, p.norm2_w, ((float*)(p.ws + OFF_MOD)), 3072, 4096, ((bf16_t*)(p.ws + OFF_H)), vb);
    xcd_barrier(xbar);
    {
        const pg8::Gemm g{((bf16_t*)(p.ws + OFF_H)), ((bf16_t*)(p.ws + OFF_WQ_T)), NTOK, 2048, 1024, 1024};
        pg8::StaticOrder S; S.init(NTOK, 2048, G, bid);
        const pg8::Epi<EpStoreBf16> E{{((bf16_t*)(p.ws + OFF_PROJ)), 2048, 0}};
        pg8::gemm_phase(lds3, g, S, E);
    }
    xcd_barrier(xbar);
    for (int vb = bid; vb < 4096; vb += G) d_peer_route(((bf16_t*)(p.ws + OFF_PROJ)), p.peer_qnorm_w, ((bf16_t*)(p.ws + OFF_SUBK)), ((int*)(p.ws + OFF_EIDX)), ((float*)(p.ws + OFF_GATE)), vb >> 3, vb & 7, lds);
    xcd_barrier(xbar);
    for (int vb = bid; vb < NTOK / 8; vb += G) d_peer_expert8(((bf16_t*)(p.ws + OFF_H)), ((unsigned char*)(p.ws + OFF_DOWN)), ((unsigned char*)(p.ws + OFF_DOWN + MIB(8))), ((float*)(p.ws + OFF_UP)), ((float*)(p.ws + OFF_UP + 65536)), ((int*)(p.ws + OFF_EIDX)), ((float*)(p.ws + OFF_GATE)), ((float*)(p.ws + OFF_MOD)), p.final_norm_w, p.out, vb);
}

extern "C" void kernel_launch(void* const* d_in, const int* in_sizes, int n_in, void* d_out, int out_size, void* d_ws, size_t ws_size, hipStream_t stream) {
    if (ws_size < WS_NEED) { fprintf(stderr, "workspace too small\n"); return; }
    static int grid_blocks = 0;
    if (!grid_blocks) {
        int dev = 0, cus = 0, per_cu = 0;
        (void)hipGetDevice(&dev);
        (void)hipDeviceGetAttribute(&cus, hipDeviceAttributeMultiprocessorCount, dev);
        (void)hipOccupancyMaxActiveBlocksPerMultiprocessor(&per_cu, mega, 512, 0);
        if (per_cu < 1) fprintf(stderr, "occupancy query reports %d blocks per CU\n", per_cu);
        grid_blocks = cus;
    }
    Params p{};
    const float** pp = (const float**)&p;
    for (int i = 0; i < 27; ++i) pp[i] = (const float*)d_in[i];
    p.out = (float*)d_out; p.ws = (char*)d_ws;
    (void)hipMemsetAsync((char*)d_ws + OFF_BAR, 0, XCD_BAR_WORDS * 4, stream);
    void* args[] = {&p};
    hipError_t e = hipLaunchCooperativeKernel((void*)mega, dim3(grid_blocks), dim3(512), args, 0, stream);
    if (e != hipSuccess) fprintf(stderr, "cooperative launch failed: %s (grid %d)\n", hipGetErrorString(e), grid_blocks);
}
```

```cpp
#include <hip/hip_runtime.h>
#include <hip/hip_cooperative_groups.h>
#include <stdint.h>
#include <cstdio>
namespace cg = cooperative_groups;

typedef unsigned short bf16_t;
typedef short bf16x8 __attribute__((ext_vector_type(8)));
typedef float f32x4 __attribute__((ext_vector_type(4)));
typedef float f32x2 __attribute__((ext_vector_type(2)));
typedef unsigned u32x4 __attribute__((ext_vector_type(4)));
typedef unsigned u32x2 __attribute__((ext_vector_type(2)));

#define NB 8
#define SEQ 8192
#define NTOK 65536
#define DM 1024
#define PROJ_LD 2816
#define NIN_PAD 3072
#define C_Q 0
#define C_KCMP 512
#define C_KSEL 768
#define C_VSEL 896
#define C_KWIN 1024
#define C_VWIN 1152
#define C_Z 1280
#define C_XBC 1792
#define NCMP 511
#define EPS 1e-6f
#define KVP_SEG ((size_t)NB * 2 * SEQ * 64)

#define MIB(x) ((size_t)(x) << 20)
#define OFF_MOD    MIB(0)
#define OFF_ROPE   MIB(1)
#define OFF_BIAS1  MIB(2)
#define OFF_WIN_T  MIB(3)
#define OFF_WOUT_T MIB(9)
#define OFF_WQ_T   MIB(11)
#define OFF_SUBK   MIB(15)
#define OFF_W1K_T  MIB(16)
#define OFF_W1V_T  MIB(17)
#define OFF_KC     MIB(18)
#define OFF_VC     MIB(19)
#define OFF_HIDK   MIB(20)
#define OFF_HIDV   MIB(24)
#define OFF_DOWN   MIB(28)
#define OFF_UP     MIB(60)
#define OFF_SMALL  MIB(92)
#define OFF_H      MIB(100)
#define OFF_PROJ   MIB(228)
#define OFF_QROPE  MIB(580)
#define OFF_ONSA   MIB(644)
#define OFF_YSSD   MIB(772)
#define OFF_KVP    MIB(836)
#define OFF_EIDX   MIB(932)
#define OFF_GATE   MIB(964)
#define OFF_CTR    MIB(996)
#define OFF_BAR    (MIB(996) + 65536)
#define WS_NEED    MIB(997)

typedef __bf16 hwbf2 __attribute__((ext_vector_type(2)));
__device__ __forceinline__ bf16_t f2bf(float f) { const __bf16 h = (__bf16)f; return __builtin_bit_cast(bf16_t, h); }
__device__ __forceinline__ float bf2f(bf16_t h) { return __uint_as_float(((unsigned)h) << 16); }
__device__ __forceinline__ float bflo(unsigned u) { return __uint_as_float(u << 16); }
__device__ __forceinline__ float bfhi(unsigned u) { return __uint_as_float(u & 0xffff0000u); }
__device__ __forceinline__ unsigned pack2(float a, float b) { const f32x2 v = {a, b}; const hwbf2 r = __builtin_convertvector(v, hwbf2); return __builtin_bit_cast(unsigned, r); }
__device__ __forceinline__ float wave_sum(float v) {
#pragma unroll
    for (int o = 32; o; o >>= 1) v += __shfl_xor(v, o);
    return v;
}
__device__ __forceinline__ float wave_max(float v) {
#pragma unroll
    for (int o = 32; o; o >>= 1) v = fmaxf(v, __shfl_xor(v, o));
    return v;
}
__device__ __forceinline__ int tid_opaque() { int t = threadIdx.x; asm volatile("" : "+v"(t)); return t; }
__device__ __forceinline__ float gelu_tanh(float x) { const float u2 = 1.5957691216057308f * (x + 0.044715f * x * x * x); return x * __builtin_amdgcn_rcpf(1.0f + __expf(-u2)); }
__device__ __forceinline__ float silu(float x) { return x / (1.0f + __expf(-x)); }
__device__ __forceinline__ float sigmoidf(float x) { return 1.0f / (1.0f + __expf(-x)); }
__device__ __forceinline__ float softplusf(float x) { return x > 20.f ? x : log1pf(__expf(x)); }

__device__ __forceinline__ int inproj_src(int n) {
    if (n < 1280) return n;
    if (n < 1792) return 1304 + (n - 1280);
    if (n < 2816) return 1816 + (n - 1792);
    if (n < 2840) return 1280 + (n - 2816);
    if (n < 2848) return 2840 + (n - 2840);
    return -1;
}
__device__ __forceinline__ void d_transpose_w(const float* __restrict__ W, bf16_t* __restrict__ Wt, int K, int N, int mode, int nbx, int vb, char* lds) {
    const int tid_ = tid_opaque(); const int half = tid_ >> 8, t256 = tid_ & 255, tile = vb * 2 + half;
    float (*t)[33] = (float (*)[33])(lds + half * 4352);
    const int n0 = (tile % nbx) * 32, k0 = (tile / nbx) * 32, tx = t256 & 31, ty = t256 >> 5;
#pragma unroll
    for (int i = 0; i < 4; ++i) {
        const int k = k0 + ty + 8 * i, n = n0 + tx;
        const int src = mode == 1 ? inproj_src(n) : n;
        t[ty + 8 * i][tx] = (src >= 0 && src < N) ? W[(size_t)k * N + src] : 0.f;
    }
    __syncthreads();
#pragma unroll
    for (int i = 0; i < 4; ++i) Wt[(size_t)(n0 + ty + 8 * i) * K + k0 + tx] = f2bf(t[tx][ty + 8 * i]);
    __syncthreads();
}
__device__ __forceinline__ void d_convert_bf16(const float* __restrict__ in, bf16_t* __restrict__ out, size_t n8, int vb, int nvb) {
    size_t i = (size_t)vb * 512 + tid_opaque();
    const size_t stride = (size_t)nvb * 512;
    for (; i < n8; i += stride) {
        const f32x4 a = ((const f32x4*)in)[2 * i], b = ((const f32x4*)in)[2 * i + 1];
        u32x4 o; o.x = pack2(a.x, a.y); o.y = pack2(a.z, a.w); o.z = pack2(b.x, b.y); o.w = pack2(b.z, b.w);
        ((u32x4*)out)[i] = o;
    }
}
__device__ __forceinline__ void d_mod(const float* __restrict__ c, const float* __restrict__ w_ada, const float* __restrict__ b_ada, float* __restrict__ mod, int vb, char* lds) {
    float (*part)[8][64] = (float (*)[8][64])lds;
    const int tid = tid_opaque(), jl = tid & 63, kq = tid >> 6, j = vb * 64 + jl;
    float acc[8];
#pragma unroll
    for (int b = 0; b < 8; ++b) acc[b] = 0.f;
    for (int k0 = kq * 128; k0 < kq * 128 + 128; k0 += 16) {
        float wv[16];
#pragma unroll
        for (int i = 0; i < 16; ++i) wv[i] = w_ada[(size_t)(k0 + i) * 6144 + j];
#pragma unroll
        for (int i = 0; i < 16; ++i)
#pragma unroll
            for (int b = 0; b < 8; ++b) acc[b] += c[b * 1024 + k0 + i] * wv[i];
    }
#pragma unroll
    for (int b = 0; b < 8; ++b) part[kq][b][jl] = acc[b];
    __syncthreads();
    {
        const int b = tid >> 6, jj = tid & 63;
        float s = b_ada[vb * 64 + jj];
#pragma unroll
        for (int q = 0; q < 8; ++q) s += part[q][b][jj];
        mod[b * 6144 + vb * 64 + jj] = s;
    }
    __syncthreads();
}
__device__ __forceinline__ void d_rope_table(float2* __restrict__ rope, int vb) {
    const int i = vb * 512 + tid_opaque();
    if (i >= SEQ * 8) return;
    const int pos = i >> 3, f = i & 7;
    const double inv = pow(500000.0, -(double)f / 8.0);
    const double ang = (double)pos * inv;
    rope[i] = make_float2((float)cos(ang), (float)sin(ang));
}
__device__ __forceinline__ void d_bias1(const float* __restrict__ pe_k, const float* __restrict__ w1_k, const float* __restrict__ pe_v, const float* __restrict__ w1_v, float* __restrict__ bias1) {
    const int tid_ = tid_opaque(); const int which = tid_ >> 8, j = tid_ & 255;
    const float* pe = which ? pe_v : pe_k; const float* w1 = which ? w1_v : w1_k;
    float a = 0.f;
    for (int k0 = 0; k0 < 2048; k0 += 16) {
        float wv[16];
#pragma unroll
        for (int i = 0; i < 16; ++i) wv[i] = w1[(size_t)(k0 + i) * 256 + j];
#pragma unroll
        for (int i = 0; i < 16; ++i) a += pe[k0 + i] * wv[i];
    }
    bias1[which * 256 + j] = a;
}

__device__ __forceinline__ void d_norm_mod(const float* __restrict__ x, const float* __restrict__ w, const float* __restrict__ mod, int sh_off, int sc_off, bf16_t* __restrict__ out, int vb) {
    const int tid_ = tid_opaque(); const int lane = tid_ & 63, wid = tid_ >> 6;
    const size_t row0 = (size_t)vb * 32 + wid * 4; const int b = (int)(row0 >> 13);
    f32x4 v[4][4];
#pragma unroll
    for (int r = 0; r < 4; ++r)
#pragma unroll
        for (int k = 0; k < 4; ++k) v[r][k] = *(const f32x4*)(x + (row0 + r) * DM + k * 256 + lane * 4);
    float rs[4];
#pragma unroll
    for (int r = 0; r < 4; ++r) {
        float ss = 0.f;
#pragma unroll
        for (int k = 0; k < 4; ++k) ss += v[r][k].x * v[r][k].x + v[r][k].y * v[r][k].y + v[r][k].z * v[r][k].z + v[r][k].w * v[r][k].w;
        rs[r] = rsqrtf(wave_sum(ss) * (1.0f / DM) + EPS);
    }
#pragma unroll
    for (int k = 0; k < 4; ++k) {
        const int col = k * 256 + lane * 4;
        const f32x4 wv = *(const f32x4*)(w + col), sc = *(const f32x4*)(mod + b * 6144 + sc_off + col), sh = *(const f32x4*)(mod + b * 6144 + sh_off + col);
        const f32x4 ws = wv * (sc + 1.0f);
#pragma unroll
        for (int r = 0; r < 4; ++r) {
            const f32x4 y = v[r][k] * rs[r] * ws + sh;
            u32x2 o; o.x = pack2(y.x, y.y); o.y = pack2(y.z, y.w);
            *(u32x2*)(out + (row0 + r) * DM + col) = o;
        }
    }
}

namespace pg8 {
#define PG8_LAS __attribute__((address_space(3)))
constexpr int BM = 256, BK = 64, HALF = 128, HTB = HALF * BK * 2  , STAGE_BYTES = 8 * HTB, NXCD = 8, WGM = 8;
__host__ __device__ __forceinline__ int lds_byte(int r, int c) { const int st = (r >> 4) * 2 + (c >> 5), rr = r & 15, cc = c & 31, ob = rr * 64 + cc * 2; return st * 1024 + (ob ^ (((ob >> 9) & 1) << 5)); }
__host__ __device__ __forceinline__ void stage_rc(int b, int& R, int& C) { const int st = b / 1024, sb = b % 1024, swz = sb ^ (((sb >> 9) & 1) << 5); R = (st >> 1) * 16 + swz / 64; C = (st & 1) * 32 + (swz % 64) / 2; }
__host__ __device__ __forceinline__ int perm32(int rho) { const int n = rho >> 4, i = rho & 15; return 8 * (i >> 2) + 4 * n + (i & 3); }
struct Unit { int pm, pn; };
struct Gemm { const bf16_t* A; const bf16_t* Bt; int M, N, K, lda; };
struct StaticOrder {
    int nM, nN, nwg, G, c;
    __host__ __device__ void init(int M, int N, int G_, int c_) { nM = M / BM; nN = N / BM; nwg = nM * nN; G = G_; c = c_; }
    __host__ __device__ bool next(int i, Unit& u) const {
        const long L = (long)i * G + c; if (L >= nwg) return false;
        int wgid = (int)L; { const int q = nwg / NXCD, r = nwg % NXCD, xcd = wgid % NXCD, off = wgid / NXCD; wgid = (xcd < r ? xcd * (q + 1) : r * (q + 1) + (xcd - r) * q) + off; }
        const int nig = WGM * nN, gid = wgid / nig, fm = gid * WGM, gsz = (nM - fm) < WGM ? (nM - fm) : WGM;
        u.pm = fm + ((wgid % nig) % gsz); u.pn = (wgid % nig) / gsz; return true;
    }
};
template <class F> struct Epi {
    F f;
    __device__ __forceinline__ void operator()(const f32x4 (&acc)[2][2][4][2], const Unit& u, int wr, int wc, int fr, int fq) const {
#pragma unroll
        for (int ai = 0; ai < 2; ++ai)
#pragma unroll
            for (int m = 0; m < 4; ++m)
#pragma unroll
                for (int bj = 0; bj < 2; ++bj)
                    f(u.pm * BM + ai * HALF + wr * 64 + m * 16 + fr, u.pn * BM + bj * HALF + wc * 32 + 8 * fq, acc[ai][bj][m][0], acc[ai][bj][m][1]);
    }
};
template <class E, class Sched>
__device__ __forceinline__ void gemm_phase(PG8_LAS unsigned char* lds, const Gemm g, const Sched& S, const E& Ep) {
    const int tid = tid_opaque(), wid = __builtin_amdgcn_readfirstlane(tid >> 6), lane = tid & 63, wr = wid >> 2, wc = wid & 3, fr = lane & 15, fq = lane >> 4;
    const int K = g.K, nt = K / BK;
    unsigned voffA[2], voffB[2];
#pragma unroll
    for (int i = 0; i < 2; ++i) { int R, C; stage_rc(tid * 16 + i * 8192, R, C); const int Rb = (R & ~31) + perm32(R & 31); voffA[i] = (unsigned)(R * g.lda + C) * 2u; voffB[i] = (unsigned)(Rb * K + C) * 2u; }
    const size_t kstep = (size_t)(BK * 2);
    const size_t hstep = (size_t)HALF * K * 2, hstepA = (size_t)HALF * g.lda * 2;
    const size_t tstep = 2 * hstep, tstepA = 2 * hstepA;
    const unsigned ldsw = (unsigned)wid * 1024u;
    const int aoff = lds_byte(wr * 64 + fr, fq * 8), boff = lds_byte(wc * 32 + fr, fq * 8);
#define PG8_SA(b, h) (((b) * 2 + (h)) * HTB)
#define PG8_SB(b, h) ((4 + (b) * 2 + (h)) * HTB)
#define PG8_STAGE(bufoff, gbase, voff) do { _Pragma("unroll") for (int _i = 0; _i < 2; ++_i) \
        __builtin_amdgcn_global_load_lds((const unsigned*)((const char*)(gbase) + (voff)[_i]), (PG8_LAS unsigned*)(lds + (bufoff) + ldsw + _i * 8192), 16, 0, 0); } while (0)
#define PG8_LDA(dst, b, h) do { _Pragma("unroll") for (int m = 0; m < 4; ++m) _Pragma("unroll") for (int k = 0; k < 2; ++k) dst[m][k] = *(const PG8_LAS bf16x8*)(lds + PG8_SA(b, h) + aoff + m * 2048 + k * 1024); } while (0)
#define PG8_LDB(dst, b, h) do { _Pragma("unroll") for (int n = 0; n < 2; ++n) _Pragma("unroll") for (int k = 0; k < 2; ++k) dst[n][k] = *(const PG8_LAS bf16x8*)(lds + PG8_SB(b, h) + boff + n * 2048 + k * 1024); } while (0)
#define PG8_MMA(ai, bj, At, Bt) do { __builtin_amdgcn_s_setprio(1); _Pragma("unroll") for (int m = 0; m < 4; ++m) _Pragma("unroll") for (int n = 0; n < 2; ++n) _Pragma("unroll") for (int k = 0; k < 2; ++k) \
        acc[ai][bj][m][n] = __builtin_amdgcn_mfma_f32_16x16x32_bf16(Bt[n][k], At[m][k], acc[ai][bj][m][n], 0, 0, 0); __builtin_amdgcn_s_setprio(0); } while (0)
#define PG8_WAIT_V(n) asm volatile("s_waitcnt vmcnt(" #n ")" ::: "memory")
#define PG8_WAIT_L(n) asm volatile("s_waitcnt lgkmcnt(" #n ")" ::: "memory")
#define PG8_BAR __builtin_amdgcn_s_barrier()
#define PG8_SCHED __builtin_amdgcn_sched_barrier(0)
    Unit cur, nxt; int ui = 0;
    if (!S.next(0, cur)) return;
    f32x4 acc[2][2][4][2];
#pragma unroll
    for (int a = 0; a < 2; ++a)
#pragma unroll
        for (int b = 0; b < 2; ++b)
#pragma unroll
            for (int m = 0; m < 4; ++m)
#pragma unroll
                for (int n = 0; n < 2; ++n) acc[a][b][m][n] = (f32x4){0.f, 0.f, 0.f, 0.f};
    bf16x8 At[4][2], B0[2][2], B1[2][2];
    const char* cA = (const char*)g.A + (size_t)cur.pm * tstepA; const char* cB = (const char*)g.Bt + (size_t)cur.pn * tstep;
    PG8_STAGE(PG8_SB(0, 0), cB, voffB); PG8_STAGE(PG8_SB(0, 1), cB + hstep, voffB); PG8_STAGE(PG8_SA(0, 0), cA, voffA); PG8_STAGE(PG8_SA(0, 1), cA + hstepA, voffA);
    if (wr == 1) PG8_BAR;
    PG8_WAIT_V(2); PG8_BAR;
    PG8_STAGE(PG8_SB(1, 0), cB + kstep, voffB); PG8_STAGE(PG8_SA(1, 0), cA + kstep, voffA); PG8_STAGE(PG8_SB(1, 1), cB + hstep + kstep, voffB);
    PG8_WAIT_V(6); PG8_BAR;
    for (;;) {
        const bool has_next = S.next(ui + 1, nxt);
        const char* nA = has_next ? (const char*)g.A + (size_t)nxt.pm * tstepA : cA; const char* nB = has_next ? (const char*)g.Bt + (size_t)nxt.pn * tstep : cB;
        for (int t = 0; t < nt; t += 2) {
            const bool last = (t == nt - 2);
            const char* a1 = cA + (size_t)(t + 1) * kstep;
            const char* a2 = last ? nA : cA + (size_t)(t + 2) * kstep; const char* b2 = last ? nB : cB + (size_t)(t + 2) * kstep;
            const char* a3 = a2 + kstep; const char* b3 = b2 + kstep;
            PG8_LDB(B0, 0, 0); PG8_LDB(B1, 0, 1); PG8_SCHED; PG8_LDA(At, 0, 0); PG8_STAGE(PG8_SA(1, 1), a1 + hstepA, voffA);
            PG8_WAIT_V(8); PG8_WAIT_L(0); PG8_BAR; PG8_MMA(0, 0, At, B0); PG8_MMA(0, 1, At, B1); PG8_BAR; PG8_SCHED;
            PG8_LDA(At, 0, 1); PG8_STAGE(PG8_SB(0, 0), b2, voffB); PG8_STAGE(PG8_SB(0, 1), b2 + hstep, voffB); PG8_STAGE(PG8_SA(0, 0), a2, voffA);
            PG8_WAIT_V(8); PG8_WAIT_L(0); PG8_BAR; PG8_MMA(1, 0, At, B0); PG8_MMA(1, 1, At, B1); PG8_BAR; PG8_SCHED;
            PG8_LDB(B0, 1, 0); PG8_LDB(B1, 1, 1); PG8_SCHED; PG8_LDA(At, 1, 0); PG8_STAGE(PG8_SA(0, 1), a2 + hstepA, voffA);
            PG8_WAIT_V(8); PG8_WAIT_L(0); PG8_BAR; PG8_MMA(0, 0, At, B0); PG8_MMA(0, 1, At, B1); PG8_BAR; PG8_SCHED;
            PG8_LDA(At, 1, 1); PG8_STAGE(PG8_SB(1, 0), b3, voffB); PG8_STAGE(PG8_SB(1, 1), b3 + hstep, voffB); PG8_STAGE(PG8_SA(1, 0), a3, voffA);
            PG8_WAIT_V(8); PG8_WAIT_L(0); PG8_BAR; PG8_MMA(1, 0, At, B0); PG8_MMA(1, 1, At, B1); PG8_BAR; PG8_SCHED;
        }
        if (wr == 0) PG8_BAR;
        Ep(acc, cur, wr, wc, fr, fq);
        if (!has_next) break;
#pragma unroll
        for (int a = 0; a < 2; ++a)
#pragma unroll
            for (int b = 0; b < 2; ++b)
#pragma unroll
                for (int m = 0; m < 4; ++m)
#pragma unroll
                    for (int n = 0; n < 2; ++n) acc[a][b][m][n] = (f32x4){0.f, 0.f, 0.f, 0.f};
        cur = nxt; cA = nA; cB = nB; ++ui;
        if (wr == 1) PG8_BAR;
    }
    PG8_WAIT_V(0);
    PG8_BAR;
#undef PG8_SA
#undef PG8_SB
#undef PG8_STAGE
#undef PG8_LDA
#undef PG8_LDB
#undef PG8_MMA
#undef PG8_WAIT_V
#undef PG8_WAIT_L
#undef PG8_BAR
#undef PG8_SCHED
}
}

__device__ __forceinline__ u32x4 pack8(f32x4 a, f32x4 b) { u32x4 o; o.x = pack2(a.x, a.y); o.y = pack2(a.z, a.w); o.z = pack2(b.x, b.y); o.w = pack2(b.z, b.w); return o; }
struct EpInProj { bf16_t* proj; bf16_t* qrope; bf16_t* kvp; float* small; const float2* rope; const float* dt_bias;
    __device__ __forceinline__ void operator()(int m, int n0, f32x4 a, f32x4 b) const {
        if (n0 < 2816) {
            const bool is_q = n0 < 512;
            const bool roped_seg = is_q || (n0 >= C_KSEL && n0 < C_VSEL) || (n0 >= C_KWIN && n0 < C_VWIN);
            if (is_q) *(u32x4*)(proj + (size_t)m * PROJ_LD + n0) = pack8(a, b);
            if (roped_seg && (n0 & 32) == 0) {
                f32x4 pa, pb;
                pa.x = __shfl_xor(a.x, 16); pa.y = __shfl_xor(a.y, 16); pa.z = __shfl_xor(a.z, 16); pa.w = __shfl_xor(a.w, 16);
                pb.x = __shfl_xor(b.x, 16); pb.y = __shfl_xor(b.y, 16); pb.z = __shfl_xor(b.z, 16); pb.w = __shfl_xor(b.w, 16);
                if ((n0 & 63) < 16) {
                    const float sgn = (n0 & 8) ? 1.f : -1.f;
                    const f32x4* rp = (const f32x4*)(rope + (m & (SEQ - 1)) * 8);
                    const f32x4 c01 = rp[0], c23 = rp[1], c45 = rp[2], c67 = rp[3];
                    a.x = a.x * c01.x + sgn * pa.x * c01.y; a.y = a.y * c01.z + sgn * pa.y * c01.w;
                    a.z = a.z * c23.x + sgn * pa.z * c23.y; a.w = a.w * c23.z + sgn * pa.w * c23.w;
                    b.x = b.x * c45.x + sgn * pb.x * c45.y; b.y = b.y * c45.z + sgn * pb.y * c45.w;
                    b.z = b.z * c67.x + sgn * pb.z * c67.y; b.w = b.w * c67.z + sgn * pb.w * c67.w;
                }
            }
            const u32x4 o = pack8(a, b);
            if (is_q) *(u32x4*)(qrope + (size_t)m * 512 + n0) = o;
            else if (n0 < C_Z) {
                const int r = n0 - C_KCMP, seg = r >> 7, g = (r >> 6) & 1, d = r & 63, bb = m >> 13, t = m & (SEQ - 1);
                *(u32x4*)(kvp + (size_t)seg * KVP_SEG + ((size_t)(bb * 2 + g) * SEQ + t) * 64 + d) = o;
            }
            else *(u32x4*)(proj + (size_t)m * PROJ_LD + n0) = o;
        } else if (n0 < 2848) {
            const int c = n0 - 2816; f32x4 o0, o1;
            if (c < 24) { o0.x = sigmoidf(a.x); o0.y = sigmoidf(a.y); o0.z = sigmoidf(a.z); o0.w = sigmoidf(a.w); o1.x = sigmoidf(b.x); o1.y = sigmoidf(b.y); o1.z = sigmoidf(b.z); o1.w = sigmoidf(b.w); }
            else { const float* db = dt_bias; o0.x = softplusf(a.x + db[0]); o0.y = softplusf(a.y + db[1]); o0.z = softplusf(a.z + db[2]); o0.w = softplusf(a.w + db[3]);
                   o1.x = softplusf(b.x + db[4]); o1.y = softplusf(b.y + db[5]); o1.z = softplusf(b.z + db[6]); o1.w = softplusf(b.w + db[7]); }
            *(f32x4*)(small + (size_t)m * 32 + c) = o0; *(f32x4*)(small + (size_t)m * 32 + c + 4) = o1;
        }
    } };
struct EpCmpHid { bf16_t* hid; const float* bias;
    __device__ __forceinline__ void operator()(int m, int n0, f32x4 a, f32x4 b) const {
        const f32x4 b0 = *(const f32x4*)(bias + n0), b1 = *(const f32x4*)(bias + n0 + 4);
        a.x = gelu_tanh(a.x + b0.x); a.y = gelu_tanh(a.y + b0.y); a.z = gelu_tanh(a.z + b0.z); a.w = gelu_tanh(a.w + b0.w);
        b.x = gelu_tanh(b.x + b1.x); b.y = gelu_tanh(b.y + b1.y); b.z = gelu_tanh(b.z + b1.z); b.w = gelu_tanh(b.w + b1.w);
        *(u32x4*)(hid + (size_t)m * 256 + n0) = pack8(a, b);
    } };
struct EpOutProj { const float* x; const float* mod; float* x1;
    __device__ __forceinline__ void operator()(int m, int n0, f32x4 a, f32x4 b) const {
        const int bb = m >> 13;
        const f32x4 x0 = *(const f32x4*)(x + (size_t)m * DM + n0), x4 = *(const f32x4*)(x + (size_t)m * DM + n0 + 4);
        const f32x4 g0 = *(const f32x4*)(mod + bb * 6144 + 2048 + n0), g4 = *(const f32x4*)(mod + bb * 6144 + 2048 + n0 + 4);
        *(f32x4*)(x1 + (size_t)m * DM + n0) = x0 + g0 * a;
        *(f32x4*)(x1 + (size_t)m * DM + n0 + 4) = x4 + g4 * b;
    } };
struct EpStoreBf16 { bf16_t* out; int ld; int pad;
    __device__ __forceinline__ void operator()(int m, int n0, f32x4 a, f32x4 b) const { *(u32x4*)(out + (size_t)m * ld + n0) = pack8(a, b); } };

__device__ __forceinline__ void d_cmp_out(const bf16_t* __restrict__ hid, const float* __restrict__ w2, bf16_t* __restrict__ out, int vb) {
    const int tid_ = tid_opaque(); const int m = vb * 8 + (tid_ >> 6), d = tid_ & 63;
    float a = 0.f;
#pragma unroll 8
    for (int j = 0; j < 256; ++j) a += bf2f(hid[(size_t)m * 256 + j]) * w2[j * 64 + d];
    out[(size_t)m * 64 + d] = f2bf(a);
}

#define KLD 80
#define NSA_OFF_KS0  0
#define NSA_OFF_VT0  10240
#define NSA_OFF_KS1  20480
#define NSA_OFF_VT1  30720
#define NSA_OFF_IMP  40960
#define NSA_OFF_SELW 74752
#define NSA_OFF_ANYW 75776
#define NSA_OFF_BL   75808
#define NSA_OFF_QS   76352
#define NSA_LDS      (76352 + 8 * 32 * KLD * 2)
#define SM_C 0.18033688011112042f

struct KVStage { u32x4 k, v; };
__device__ __forceinline__ void nsa_stage_load(KVStage& st, const bf16_t* kb, const bf16_t* vb, int tid) {
    st.k = *(const u32x4*)(kb + tid * 8); st.v = *(const u32x4*)(vb + tid * 8);
}
__device__ __forceinline__ void nsa_stage_store(bf16_t* Ks, bf16_t* Vt, int tid, const KVStage& st) {
    const int r = tid >> 3, c = tid & 7;
    *(u32x4*)(Ks + r * KLD + c * 8) = st.k;
    *(u32x4*)(Vt + r * KLD + c * 8) = st.v;
}
__device__ __forceinline__ void nsa_load_q(const bf16_t* qsrc, size_t ld, int lane, bf16_t* Qs) {
    u32x4 r[4];
#pragma unroll
    for (int i = 0; i < 4; ++i) { const int p = lane + 64 * i; r[i] = *(const u32x4*)(qsrc + (size_t)(p >> 3) * ld + (p & 7) * 8); }
#pragma unroll
    for (int i = 0; i < 4; ++i) { const int p = lane + 64 * i; *(u32x4*)(Qs + (p >> 3) * KLD + (p & 7) * 8) = r[i]; }
}
__device__ __forceinline__ void nsa_qk(const bf16_t* Ks, const bf16_t* Qs, f32x4 (&s)[4][2], int fr, int fq) {
#pragma unroll
    for (int kt = 0; kt < 4; ++kt)
#pragma unroll
        for (int tt = 0; tt < 2; ++tt) s[kt][tt] = (f32x4){0.f, 0.f, 0.f, 0.f};
#pragma unroll
    for (int ks = 0; ks < 2; ++ks) {
        bf16x8 qf[2];
#pragma unroll
        for (int tt = 0; tt < 2; ++tt) qf[tt] = *(const bf16x8*)(Qs + (tt * 16 + fr) * KLD + ks * 32 + fq * 8);
#pragma unroll
        for (int kt = 0; kt < 4; ++kt) {
            const bf16x8 kf = *(const bf16x8*)(Ks + (kt * 16 + fr) * KLD + ks * 32 + fq * 8);
#pragma unroll
            for (int tt = 0; tt < 2; ++tt) s[kt][tt] = __builtin_amdgcn_mfma_f32_16x16x32_bf16(kf, qf[tt], s[kt][tt], 0, 0, 0);
        }
    }
}
__device__ __forceinline__ void nsa_pv(const bf16_t* Vt, const f32x4 (&p)[4][2], f32x4 (&o)[4][2], int fr, int fq) {
#pragma unroll
    for (int ks2 = 0; ks2 < 2; ++ks2) {
        bf16x8 pf[2];
#pragma unroll
        for (int tt = 0; tt < 2; ++tt) {
            const f32x4 a = p[2 * ks2][tt], b = p[2 * ks2 + 1][tt];
            u32x4 w; w.x = pack2(a.x, a.y); w.y = pack2(a.z, a.w); w.z = pack2(b.x, b.y); w.w = pack2(b.z, b.w);
            pf[tt] = __builtin_bit_cast(bf16x8, w);
        }
#pragma unroll
        for (int dt = 0; dt < 4; ++dt) {
            typedef short s16x4 __attribute__((ext_vector_type(4)));
            const bf16_t* vp = Vt + (ks2 * 32 + 4 * fq + (fr >> 2)) * KLD + dt * 16 + 4 * (fr & 3);
            const s16x4 a0 = __builtin_amdgcn_ds_read_tr16_b64_v4i16((__attribute__((address_space(3))) s16x4*)vp);
            const s16x4 a1 = __builtin_amdgcn_ds_read_tr16_b64_v4i16((__attribute__((address_space(3))) s16x4*)(vp + 16 * KLD));
            const bf16x8 vf = (bf16x8){a0.x, a0.y, a0.z, a0.w, a1.x, a1.y, a1.z, a1.w};
#pragma unroll
            for (int tt = 0; tt < 2; ++tt) o[dt][tt] = __builtin_amdgcn_mfma_f32_16x16x32_bf16(vf, pf[tt], o[dt][tt], 0, 0, 0);
        }
    }
}
template <int MK>
__device__ __forceinline__ bool nsa_valid(int kk, int ti, int n0, int t0) {
    if (MK == 1) return kk <= ti;
    if (MK == 2) return kk > ti;
    return 16 * (n0 + kk) + 31 <= t0 + ti;
}
template <int MK, bool WITH_O>
__device__ __forceinline__ void nsa_softmax(f32x4 (&s)[4][2], float (&m)[2], float (&l)[2], f32x4 (&o)[4][2], const bool (&selb)[2], int tib, int fq, int n0, int t0) {
#pragma unroll
    for (int tt = 0; tt < 2; ++tt) {
        const int ti = tib + tt * 16;
        float mx = -1e30f;
#pragma unroll
        for (int kt = 0; kt < 4; ++kt)
#pragma unroll
            for (int jj = 0; jj < 4; ++jj) {
                const int kk = kt * 16 + 4 * fq + jj;
                const bool v = selb[tt] && nsa_valid<MK>(kk, ti, n0, t0);
                const float sv = v ? s[kt][tt][jj] * SM_C : -1e30f;
                s[kt][tt][jj] = sv; mx = fmaxf(mx, sv);
            }
        mx = fmaxf(mx, __shfl_xor(mx, 16)); mx = fmaxf(mx, __shfl_xor(mx, 32));
        const float mn = fmaxf(m[tt], mx);
        const float alpha = __builtin_amdgcn_exp2f(m[tt] - mn);
        m[tt] = mn;
        float ls = 0.f;
#pragma unroll
        for (int kt = 0; kt < 4; ++kt)
#pragma unroll
            for (int jj = 0; jj < 4; ++jj) {
                const float sv = s[kt][tt][jj];
                const float pv = sv > -1e29f ? __builtin_amdgcn_exp2f(sv - mn) : 0.f;
                s[kt][tt][jj] = pv; ls += pv;
            }
        l[tt] = l[tt] * alpha + ls;
        if (WITH_O) {
#pragma unroll
            for (int dt = 0; dt < 4; ++dt) o[dt][tt] *= alpha;
        }
    }
}
template <bool WITH_O = true>
__device__ __forceinline__ void nsa_softmax_fast(f32x4 (&s)[4][2], float (&m)[2], float (&l)[2], f32x4 (&o)[4][2], const float (&bias)[2]) {
#pragma unroll
    for (int tt = 0; tt < 2; ++tt) {
        float mr = fmaxf(fmaxf(s[0][tt][0], s[0][tt][1]), fmaxf(s[0][tt][2], s[0][tt][3]));
#pragma unroll
        for (int kt = 1; kt < 4; ++kt) mr = fmaxf(mr, fmaxf(fmaxf(s[kt][tt][0], s[kt][tt][1]), fmaxf(s[kt][tt][2], s[kt][tt][3])));
        mr = fmaxf(mr, __shfl_xor(mr, 16)); mr = fmaxf(mr, __shfl_xor(mr, 32));
        const float mx = mr * SM_C + bias[tt];
        const float mold = m[tt], mn = fmaxf(mold, mx);
        m[tt] = mn;
        const float off = bias[tt] - mn;
        float ls = 0.f;
#pragma unroll
        for (int kt = 0; kt < 4; ++kt)
#pragma unroll
            for (int jj = 0; jj < 4; ++jj) { const float pv = __builtin_amdgcn_exp2f(__builtin_fmaf(s[kt][tt][jj], SM_C, off)); s[kt][tt][jj] = pv; ls += pv; }
        if (__builtin_amdgcn_ballot_w64(mn > mold) != 0ull) {
            const float alpha = __builtin_amdgcn_exp2f(mold - mn);
            l[tt] = l[tt] * alpha + ls;
            if (WITH_O) {
#pragma unroll
                for (int dt = 0; dt < 4; ++dt) o[dt][tt] *= alpha;
            }
        } else l[tt] += ls;
    }
}
__device__ __forceinline__ void ins16(unsigned (&L)[16], unsigned x) {
#pragma unroll
    for (int i = 0; i < 16; ++i) { const unsigned hi = L[i] > x ? L[i] : x; x = L[i] > x ? x : L[i]; L[i] = hi; }
}
__device__ __forceinline__ void merge16(unsigned (&L)[16], const unsigned (&P)[16]) {
#pragma unroll
    for (int i = 0; i < 16; ++i) L[i] = L[i] > P[15 - i] ? L[i] : P[15 - i];
#pragma unroll
    for (int st = 8; st >= 1; st >>= 1)
#pragma unroll
        for (int i = 0; i < 16; ++i)
            if ((i & st) == 0) { const unsigned a = L[i], b = L[i + st]; L[i] = a > b ? a : b; L[i + st] = a > b ? b : a; }
}
template <bool ACCUM>
__device__ __forceinline__ void nsa_emit(const f32x4 (&o)[4][2], const float (&l)[2], bool l_is_partial, const float* gsrc, float* obase, int tib, int fq) {
#pragma unroll
    for (int tt = 0; tt < 2; ++tt) {
        float lt = l[tt];
        if (l_is_partial) { lt += __shfl_xor(lt, 16); lt += __shfl_xor(lt, 32); }
        const int ti = tib + tt * 16;
        const float gv = gsrc[(size_t)ti * 32];
        const float sc = l_is_partial ? (lt > 0.f ? gv / lt : 0.f) : gv;
#pragma unroll
        for (int dt = 0; dt < 4; ++dt) {
            float* op = obase + (size_t)ti * 512 + dt * 16 + 4 * fq;
            f32x4 v = o[dt][tt] * sc;
            if (ACCUM) v += *(const f32x4*)op;
            *(f32x4*)op = v;
        }
    }
}
struct NsaBufs { bf16_t *Ks0, *Vt0, *Ks1, *Vt1; };
template <class SRC, class BODY>
__device__ __forceinline__ void nsa_pipeline(int n, const bf16_t* kb, const bf16_t* vb, const NsaBufs& B, int tid, SRC src, BODY body) {
    KVStage s0, s1;
    nsa_stage_load(s0, kb + (size_t)src(0) * 4096, vb + (size_t)src(0) * 4096, tid);
    s1 = s0;
    if (n > 1) nsa_stage_load(s1, kb + (size_t)src(1) * 4096, vb + (size_t)src(1) * 4096, tid);
    __syncthreads();
    nsa_stage_store(B.Ks0, B.Vt0, tid, s0);
    if (n > 2) nsa_stage_load(s0, kb + (size_t)src(2) * 4096, vb + (size_t)src(2) * 4096, tid);
#pragma unroll 1
    for (int i = 0; i < n; i += 2) {
        __syncthreads();
        if (i + 1 < n) nsa_stage_store(B.Ks1, B.Vt1, tid, s1);
        if (i + 3 < n) nsa_stage_load(s1, kb + (size_t)src(i + 3) * 4096, vb + (size_t)src(i + 3) * 4096, tid);
        body(src(i), B.Ks0, B.Vt0);
        if (i + 1 < n) {
            __syncthreads();
            if (i + 2 < n) nsa_stage_store(B.Ks0, B.Vt0, tid, s0);
            if (i + 4 < n) nsa_stage_load(s0, kb + (size_t)src(i + 4) * 4096, vb + (size_t)src(i + 4) * 4096, tid);
            body(src(i + 1), B.Ks1, B.Vt1);
        }
    }
}

__device__ __forceinline__ void d_nsa_cmp(const bf16_t* __restrict__ proj, const bf16_t* __restrict__ kc, const bf16_t* __restrict__ vc,
                                          const float* __restrict__ small, float* __restrict__ onsa, unsigned* __restrict__ selrec, int b, int g, int qt, char* lds) {
    const NsaBufs B{(bf16_t*)(lds + NSA_OFF_KS0), (bf16_t*)(lds + NSA_OFF_VT0), (bf16_t*)(lds + NSA_OFF_KS1), (bf16_t*)(lds + NSA_OFF_VT1)};
    float* imp = (float*)(lds + NSA_OFF_IMP);
    unsigned* selw = (unsigned*)(lds + NSA_OFF_SELW);
    unsigned* anyw = (unsigned*)(lds + NSA_OFF_ANYW);
    int* blist = (int*)(lds + NSA_OFF_BL);
    const int tid = tid_opaque(), lane = tid & 63, w = tid >> 6, hd = w & 3, th = w >> 2, fr = lane & 15, fq = lane >> 4;
    const int tib = th * 32 + fr;
    const size_t tok0 = (size_t)b * SEQ + (size_t)qt * 64;
    const int t0 = qt * 64;
    const float* gbase = small + tok0 * 32 + g * 12 + hd * 3;
    float* obase = onsa + tok0 * 512 + g * 256 + hd * 64;
    const bool sel_all[2] = {true, true};
    const float bias0[2] = {0.f, 0.f};

    for (int i = tid; i < 64 * 132; i += 512) imp[i] = 0.f;
    if (tid < 4) anyw[tid] = 0u;

    bf16_t* Qs = (bf16_t*)(lds + NSA_OFF_QS) + w * 32 * KLD;
    f32x4 s[4][2], o[4][2];
    float m[2], l[2];

    nsa_load_q(proj + (tok0 + th * 32) * PROJ_LD + C_Q + g * 256 + hd * 64, PROJ_LD, lane, Qs);
    const int ncb = (4 * qt + 3 + 63) >> 6;
    {
        const bf16_t* kb = kc + (size_t)(b * 2 + g) * 512 * 64;
        const bf16_t* vb = vc + (size_t)(b * 2 + g) * 512 * 64;
#pragma unroll
        for (int tt = 0; tt < 2; ++tt) { m[tt] = -1e30f; l[tt] = 0.f; }
        nsa_pipeline(ncb, kb, vb, B, tid, [&](int i) { return i; }, [&](int blk_, bf16_t* Ks, bf16_t* Vt) {
            nsa_qk(Ks, Qs, s, fr, fq);
            if (16 * (blk_ * 64 + 63) + 31 <= t0) nsa_softmax_fast<false>(s, m, l, o, bias0);
            else nsa_softmax<3, false>(s, m, l, o, sel_all, tib, fq, blk_ * 64, t0);
        });
        float linv[2];
#pragma unroll
        for (int tt = 0; tt < 2; ++tt) { float lt = l[tt]; lt += __shfl_xor(lt, 16); lt += __shfl_xor(lt, 32); linv[tt] = lt > 0.f ? 1.0f / lt : 0.f; }
#pragma unroll
        for (int dt = 0; dt < 4; ++dt)
#pragma unroll
            for (int tt = 0; tt < 2; ++tt) o[dt][tt] = (f32x4){0.f, 0.f, 0.f, 0.f};
        nsa_pipeline(ncb, kb, vb, B, tid, [&](int i) { return i; }, [&](int blk_, bf16_t* Ks, bf16_t* Vt) {
            nsa_qk(Ks, Qs, s, fr, fq);
            const bool full = 16 * (blk_ * 64 + 63) + 31 <= t0;
#pragma unroll
            for (int tt = 0; tt < 2; ++tt) {
                const int ti = tib + tt * 16;
                const float nm = -m[tt], li = linv[tt];
                float hs[4], as[4];
#pragma unroll
                for (int kt = 0; kt < 4; ++kt) {
                    f32x4 pv;
                    if (full) {
#pragma unroll
                        for (int jj = 0; jj < 4; ++jj) pv[jj] = __builtin_amdgcn_exp2f(__builtin_fmaf(s[kt][tt][jj], SM_C, nm)) * li;
                    } else {
#pragma unroll
                        for (int jj = 0; jj < 4; ++jj) {
                            const int kk = kt * 16 + 4 * fq + jj;
                            pv[jj] = nsa_valid<3>(kk, ti, blk_ * 64, t0) ? __builtin_amdgcn_exp2f(__builtin_fmaf(s[kt][tt][jj], SM_C, nm)) * li : 0.f;
                        }
                    }
                    s[kt][tt] = pv;
                    hs[kt] = 0.5f * pv[3]; as[kt] = pv[0] + pv[1] + pv[2] + hs[kt];
                }
                float r1[4];
#pragma unroll
                for (int kt = 0; kt < 4; ++kt) r1[kt] = __shfl(hs[kt], (lane + 48) & 63);
#pragma unroll
                for (int kt = 0; kt < 4; ++kt) {
                    const float recv = fq > 0 ? r1[kt] : (kt > 0 ? r1[kt - 1] : 0.f);
                    const int j = blk_ * 16 + kt * 4 + fq;
                    atomicAdd(imp + ti * 132 + (j >> 5) * 33 + (j & 31), as[kt] + recv);
                }
                if (fq == 3) { const int j1 = blk_ * 16 + 16; if (j1 < 128) atomicAdd(imp + ti * 132 + (j1 >> 5) * 33 + (j1 & 31), hs[3]); }
            }
            nsa_pv(Vt, s, o, fr, fq);
        });
        nsa_emit<false>(o, l, false, gbase + 0, obase, tib, fq);
    }
    __syncthreads();
    {
        const int ti = tid >> 3, q8 = tid & 7;
        unsigned L[16];
#pragma unroll
        for (int i = 0; i < 16; ++i) L[i] = 0u;
#pragma unroll
        for (int i = 0; i < 16; ++i) {
            const int j = q8 * 16 + i;
            const bool forced = (j == 0) || (j == qt) || (j == qt - 1);
            const float v = imp[ti * 132 + (j >> 5) * 33 + (j & 31)] + (forced ? 1e4f : 0.f) + 1e-30f;
            const unsigned x = (j <= qt) ? ((__float_as_uint(v) & ~0x7Fu) | (unsigned)(127 - j)) : 0u;
            ins16(L, x);
        }
#pragma unroll
        for (int r = 1; r <= 4; r <<= 1) {
            unsigned P[16];
#pragma unroll
            for (int i = 0; i < 16; ++i) P[i] = (unsigned)__shfl_xor((int)L[i], r);
            merge16(L, P);
        }
        if (q8 < 4) {
            unsigned word = 0u;
#pragma unroll
            for (int i = 0; i < 16; ++i) {
                const unsigned e = L[i];
                const int j = 127 - (int)(e & 0x7Fu);
                if (e != 0u && (j >> 5) == q8) word |= 1u << (j & 31);
            }
            selw[ti * 4 + q8] = word;
            atomicOr(&anyw[q8], word);
        }
    }
    __syncthreads();
    int nsel;
    {
        const unsigned a0 = anyw[0], a1 = anyw[1], a2 = anyw[2], a3 = anyw[3];
        if (tid < 128) {
            const unsigned wd = tid < 32 ? a0 : tid < 64 ? a1 : tid < 96 ? a2 : a3;
            if ((wd >> (tid & 31)) & 1u) {
                int pos = __popc(wd & ((1u << (tid & 31)) - 1u));
                if (tid >= 32) pos += __popc(a0);
                if (tid >= 64) pos += __popc(a1);
                if (tid >= 96) pos += __popc(a2);
                blist[pos] = tid;
            }
        }
        nsel = __builtin_amdgcn_readfirstlane(__popc(a0) + __popc(a1) + __popc(a2) + __popc(a3));
    }
    __syncthreads();
    if (tid < 256) selrec[tid] = selw[tid];
    if (tid < 128) selrec[256 + tid] = (unsigned)blist[tid];
    if (tid == 0) selrec[384] = (unsigned)nsel;
    __syncthreads();
}

__device__ __forceinline__ void d_nsa_attn(const bf16_t* __restrict__ qrope, const bf16_t* __restrict__ kvp, const float* __restrict__ small, float* __restrict__ onsa,
                                           const unsigned* __restrict__ selrec, int b, int g, int qt, char* lds) {
    const NsaBufs B{(bf16_t*)(lds + NSA_OFF_KS0), (bf16_t*)(lds + NSA_OFF_VT0), (bf16_t*)(lds + NSA_OFF_KS1), (bf16_t*)(lds + NSA_OFF_VT1)};
    unsigned* selw = (unsigned*)(lds + NSA_OFF_SELW);
    int* blist = (int*)(lds + NSA_OFF_BL);
    const int tid = tid_opaque(), lane = tid & 63, w = tid >> 6, hd = w & 3, th = w >> 2, fr = lane & 15, fq = lane >> 4;
    const int tib = th * 32 + fr;
    const size_t tok0 = (size_t)b * SEQ + (size_t)qt * 64;
    const float* gbase = small + tok0 * 32 + g * 12 + hd * 3;
    float* obase = onsa + tok0 * 512 + g * 256 + hd * 64;
    const bool sel_all[2] = {true, true};
    const float bias0[2] = {0.f, 0.f};
    bf16_t* Qs = (bf16_t*)(lds + NSA_OFF_QS) + w * 32 * KLD;
    f32x4 s[4][2], o[4][2];
    float m[2], l[2];
    if (tid < 256) selw[tid] = selrec[tid];
    if (tid < 128) blist[tid] = (int)selrec[256 + tid];
    const int nsel = __builtin_amdgcn_readfirstlane((int)selrec[384]);
    __syncthreads();
    nsa_load_q(qrope + (tok0 + th * 32) * 512 + g * 256 + hd * 64, 512, lane, Qs);
    {
        const bf16_t* kb = kvp + 2 * KVP_SEG + (size_t)(b * 2 + g) * SEQ * 64;
        const bf16_t* vb = kvp + 3 * KVP_SEG + (size_t)(b * 2 + g) * SEQ * 64;
#pragma unroll
        for (int tt = 0; tt < 2; ++tt) { m[tt] = -1e30f; l[tt] = 0.f; }
#pragma unroll
        for (int dt = 0; dt < 4; ++dt)
#pragma unroll
            for (int tt = 0; tt < 2; ++tt) o[dt][tt] = (f32x4){0.f, 0.f, 0.f, 0.f};
        nsa_pipeline(nsel, kb, vb, B, tid, [&](int i) { return __builtin_amdgcn_readfirstlane(blist[i]); }, [&](int blk_, bf16_t* Ks, bf16_t* Vt) {
            nsa_qk(Ks, Qs, s, fr, fq);
            bool selb[2];
#pragma unroll
            for (int tt = 0; tt < 2; ++tt) selb[tt] = (selw[(tib + tt * 16) * 4 + (blk_ >> 5)] >> (blk_ & 31)) & 1u;
            if (blk_ == qt) nsa_softmax<1, true>(s, m, l, o, selb, tib, fq, 0, 0);
            else {
                float bias[2];
#pragma unroll
                for (int tt = 0; tt < 2; ++tt) bias[tt] = selb[tt] ? 0.f : -1e30f;
                nsa_softmax_fast(s, m, l, o, bias);
            }
            nsa_pv(Vt, s, o, fr, fq);
        });
        nsa_emit<true>(o, l, true, gbase + 1, obase, tib, fq);
    }
    {
        const bf16_t* kb = kvp + 4 * KVP_SEG + (size_t)(b * 2 + g) * SEQ * 64;
        const bf16_t* vb = kvp + 5 * KVP_SEG + (size_t)(b * 2 + g) * SEQ * 64;
#pragma unroll
        for (int tt = 0; tt < 2; ++tt) { m[tt] = -1e30f; l[tt] = 0.f; }
#pragma unroll
        for (int dt = 0; dt < 4; ++dt)
#pragma unroll
            for (int tt = 0; tt < 2; ++tt) o[dt][tt] = (f32x4){0.f, 0.f, 0.f, 0.f};
        const int j0 = qt >= 8 ? qt - 8 : 0;
        nsa_pipeline(qt - j0 + 1, kb, vb, B, tid, [&](int i) { return j0 + i; }, [&](int blk_, bf16_t* Ks, bf16_t* Vt) {
            nsa_qk(Ks, Qs, s, fr, fq);
            if (blk_ == qt) nsa_softmax<1, true>(s, m, l, o, sel_all, tib, fq, 0, 0);
            else if (blk_ == qt - 8) nsa_softmax<2, true>(s, m, l, o, sel_all, tib, fq, 0, 0);
            else nsa_softmax_fast(s, m, l, o, bias0);
            nsa_pv(Vt, s, o, fr, fq);
        });
        nsa_emit<true>(o, l, true, gbase + 2, obase, tib, fq);
    }
    __syncthreads();
}

#define SSD_P 136
#define S3_XST 0
#define S3_BC  69632
#define S3_CC  104448
#define S3_ACS 139264
#define S3_DT  141312
#define S3_END 143360

__device__ __forceinline__ void ssd_acs(const float* __restrict__ small, const float* __restrict__ a_log, size_t tok0, int g, float* acs, float* dtl, int tid) {
    const int w = tid >> 6, lane = tid & 63, hh = 4 * g + (w & 3);
    if (w < 4) {
        const float a = -__expf(a_log[hh]);
        const float d0 = small[(tok0 + 2 * lane) * 32 + 24 + hh], d1 = small[(tok0 + 2 * lane + 1) * 32 + 24 + hh];
        const float s0 = d0 * a, s1 = s0 + d1 * a;
        float tot = s1;
#pragma unroll
        for (int off = 1; off < 64; off <<= 1) { const float t = __shfl_up(tot, off); if (lane >= off) tot += t; }
        const float excl = tot - s1;
        acs[w * 128 + 2 * lane] = excl + s0; acs[w * 128 + 2 * lane + 1] = excl + s1;
        dtl[w * 128 + 2 * lane] = d0; dtl[w * 128 + 2 * lane + 1] = d1;
    }
}
struct ConvCh { float w0, w1, w2, w3, bias, h0, h1, h2; };
__device__ __forceinline__ void conv_init(ConvCh& cc, const float* __restrict__ conv_w, const float* __restrict__ conv_b, int ch, const bf16_t* pb, int c) {
    cc.w0 = conv_w[ch]; cc.w1 = conv_w[1024 + ch]; cc.w2 = conv_w[2048 + ch]; cc.w3 = conv_w[3072 + ch]; cc.bias = conv_b[ch];
    if (c > 0) { cc.h0 = bf2f(pb[-3 * PROJ_LD]); cc.h1 = bf2f(pb[-2 * PROJ_LD]); cc.h2 = bf2f(pb[-1 * PROJ_LD]); } else { cc.h0 = 0.f; cc.h1 = 0.f; cc.h2 = 0.f; }
}
__device__ __forceinline__ float conv_step(ConvCh& cc, float x) {
    const float v = cc.bias + cc.w0 * cc.h0 + cc.w1 * cc.h1 + cc.w2 * cc.h2 + cc.w3 * x;
    cc.h0 = cc.h1; cc.h1 = cc.h2; cc.h2 = x;
    return silu(v);
}

__device__ __forceinline__ void d_ssd_states(const bf16_t* __restrict__ proj, const float* __restrict__ small, const float* __restrict__ conv_w, const float* __restrict__ conv_b,
                                             const float* __restrict__ a_log, float* __restrict__ states, float* __restrict__ cdec, int item, char* lds) {
    const int tid = tid_opaque(), lane = tid & 63, w = tid >> 6, fr = lane & 15, fq = lane >> 4;
    const int b = item >> 7, c = (item >> 1) & 63, g = item & 1;
    bf16_t* XwT = (bf16_t*)(lds + S3_XST); bf16_t* BcT = (bf16_t*)(lds + S3_BC);
    float* acs = (float*)(lds + S3_ACS); float* dtl = (float*)(lds + S3_DT);
    const size_t tok0 = (size_t)b * SEQ + (size_t)c * 128;
    ssd_acs(small, a_log, tok0, g, acs, dtl, tid);
    __syncthreads();
    if (tid < 384) {
        const bool isx = tid < 256;
        const int ch = isx ? g * 256 + tid : 512 + g * 128 + (tid - 256);
        const bf16_t* px = proj + tok0 * PROJ_LD + C_XBC + ch;
        ConvCh cx; conv_init(cx, conv_w, conv_b, ch, px, c);
        const int hw = w & 3;
        const float alast = acs[hw * 128 + 127];
        bf16_t* dst = isx ? XwT + tid * SSD_P : BcT + (tid - 256) * SSD_P;
        for (int l0 = 0; l0 < 128; l0 += 32) {
            float rx[32];
#pragma unroll
            for (int i = 0; i < 32; ++i) rx[i] = bf2f(px[(size_t)(l0 + i) * PROJ_LD]);
#pragma unroll
            for (int i8 = 0; i8 < 4; ++i8) {
                float ox[8];
#pragma unroll
                for (int i = 0; i < 8; ++i) {
                    const int l = l0 + i8 * 8 + i;
                    const float v = conv_step(cx, rx[i8 * 8 + i]);
                    ox[i] = isx ? v * dtl[hw * 128 + l] * __expf(alast - acs[hw * 128 + l]) : v;
                }
                u32x4 o; o.x = pack2(ox[0], ox[1]); o.y = pack2(ox[2], ox[3]); o.z = pack2(ox[4], ox[5]); o.w = pack2(ox[6], ox[7]);
                *(u32x4*)(dst + l0 + i8 * 8) = o;
            }
        }
    }
    __syncthreads();
    {
        const int hw = w & 3, nh = w >> 2;
        f32x4 acc[4][4];
#pragma unroll
        for (int pt = 0; pt < 4; ++pt)
#pragma unroll
            for (int nt = 0; nt < 4; ++nt) acc[pt][nt] = (f32x4){0.f, 0.f, 0.f, 0.f};
#pragma unroll 1
        for (int ks = 0; ks < 4; ++ks) {
            bf16x8 af[4], bfr[4];
#pragma unroll
            for (int pt = 0; pt < 4; ++pt) af[pt] = *(const bf16x8*)(XwT + (hw * 64 + pt * 16 + fr) * SSD_P + ks * 32 + fq * 8);
#pragma unroll
            for (int nt = 0; nt < 4; ++nt) bfr[nt] = *(const bf16x8*)(BcT + ((nh * 4 + nt) * 16 + fr) * SSD_P + ks * 32 + fq * 8);
#pragma unroll
            for (int pt = 0; pt < 4; ++pt)
#pragma unroll
                for (int nt = 0; nt < 4; ++nt) acc[pt][nt] = __builtin_amdgcn_mfma_f32_16x16x32_bf16(af[pt], bfr[nt], acc[pt][nt], 0, 0, 0);
        }
        const int hh = 4 * g + hw;
        float* sp = states + ((size_t)((b * 64 + c) * 8 + hh)) * 8192;
#pragma unroll
        for (int pt = 0; pt < 4; ++pt)
#pragma unroll
            for (int nt = 0; nt < 4; ++nt)
#pragma unroll
                for (int jj = 0; jj < 4; ++jj) sp[(pt * 16 + 4 * fq + jj) * 128 + (nh * 4 + nt) * 16 + fr] = acc[pt][nt][jj];
        if (lane == 0 && nh == 0) cdec[(b * 64 + c) * 8 + hh] = __expf(acs[hw * 128 + 127]);
    }
    __syncthreads();
}

__device__ __forceinline__ void d_ssd_scan(const float* __restrict__ states, const float* __restrict__ cdec, bf16_t* __restrict__ prev, int vb) {
    const int bh = vb >> 1, b = bh >> 3, hh = bh & 7;
    const size_t e0 = (size_t)((vb & 1) * 512 + tid_opaque()) * 8;
    f32x4 h0 = (f32x4){0.f, 0.f, 0.f, 0.f}, h1 = h0;
#pragma unroll 8
    for (int c = 0; c < 64; ++c) {
        const size_t base = ((size_t)((b * 64 + c) * 8 + hh)) * 8192 + e0;
        const f32x4 s0 = *(const f32x4*)(states + base), s1 = *(const f32x4*)(states + base + 4);
        const float d = cdec[(b * 64 + c) * 8 + hh];
        u32x4 o; o.x = pack2(h0.x, h0.y); o.y = pack2(h0.z, h0.w); o.z = pack2(h1.x, h1.y); o.w = pack2(h1.z, h1.w);
        *(u32x4*)(prev + base) = o;
        h0 = h0 * d + s0; h1 = h1 * d + s1;
    }
}

__device__ __forceinline__ void d_ssd_out(const bf16_t* __restrict__ proj, const float* __restrict__ small, const float* __restrict__ conv_w, const float* __restrict__ conv_b,
                                          const float* __restrict__ a_log, const float* __restrict__ d_skip, const bf16_t* __restrict__ prev, bf16_t* __restrict__ yssd, int item, char* lds) {
    const int tid = tid_opaque(), lane = tid & 63, w = tid >> 6, fr = lane & 15, fq = lane >> 4;
    const int b = item >> 7, c = (item >> 1) & 63, g = item & 1;
    bf16_t* XsT = (bf16_t*)(lds + S3_XST); bf16_t* Bc = (bf16_t*)(lds + S3_BC); bf16_t* Cc = (bf16_t*)(lds + S3_CC);
    float* acs = (float*)(lds + S3_ACS); float* dtl = (float*)(lds + S3_DT);
    const size_t tok0 = (size_t)b * SEQ + (size_t)c * 128;
    ssd_acs(small, a_log, tok0, g, acs, dtl, tid);
    {
        const int mode = tid < 256 ? 0 : (tid < 384 ? 1 : 2);
        const int ch = mode == 0 ? g * 256 + tid : (mode == 1 ? 512 + g * 128 + (tid - 256) : 768 + g * 128 + (tid - 384));
        const bf16_t* px = proj + tok0 * PROJ_LD + C_XBC + ch;
        ConvCh cx; conv_init(cx, conv_w, conv_b, ch, px, c);
        bf16_t* dstx = XsT + (tid & 255) * SSD_P;
        bf16_t* dstbc = (mode == 1 ? Bc : Cc) + (tid & 127);
        for (int l0 = 0; l0 < 128; l0 += 32) {
            float rx[32];
#pragma unroll
            for (int i = 0; i < 32; ++i) rx[i] = bf2f(px[(size_t)(l0 + i) * PROJ_LD]);
#pragma unroll
            for (int i8 = 0; i8 < 4; ++i8) {
                float ox[8];
#pragma unroll
                for (int i = 0; i < 8; ++i) ox[i] = conv_step(cx, rx[i8 * 8 + i]);
                if (mode == 0) {
                    u32x4 o; o.x = pack2(ox[0], ox[1]); o.y = pack2(ox[2], ox[3]); o.z = pack2(ox[4], ox[5]); o.w = pack2(ox[6], ox[7]);
                    *(u32x4*)(dstx + l0 + i8 * 8) = o;
                } else {
#pragma unroll
                    for (int i = 0; i < 8; ++i) dstbc[(l0 + i8 * 8 + i) * SSD_P] = f2bf(ox[i]);
                }
            }
        }
    }
    __syncthreads();
    const int hw = w & 3, lh = w >> 2, hh = 4 * g + hw;
    const float dsk = d_skip[hh];
    const bf16_t* pp = prev + ((size_t)((b * 64 + c) * 8 + hh)) * 8192;
#pragma unroll 1
    for (int lk = 0; lk < 4; ++lk) {
        const int lt = lh + 2 * lk;
        const int l = lt * 16 + fr;
        const float acs_l = acs[hw * 128 + l];
        bf16x8 cf[4];
#pragma unroll
        for (int ks = 0; ks < 4; ++ks) cf[ks] = *(const bf16x8*)(Cc + (lt * 16 + fr) * SSD_P + ks * 32 + fq * 8);
        f32x4 y[4], yo[4];
#pragma unroll
        for (int pt = 0; pt < 4; ++pt) { y[pt] = (f32x4){0.f, 0.f, 0.f, 0.f}; yo[pt] = (f32x4){0.f, 0.f, 0.f, 0.f}; }
#pragma unroll
        for (int ks2 = 0; ks2 < 4; ++ks2) {
            if (2 * ks2 <= lt) {
                f32x4 cb[2];
#pragma unroll
                for (int h2 = 0; h2 < 2; ++h2) {
                    const int st = 2 * ks2 + h2;
                    cb[h2] = (f32x4){0.f, 0.f, 0.f, 0.f};
                    if (st <= lt) {
#pragma unroll
                        for (int ks = 0; ks < 4; ++ks)
                            cb[h2] = __builtin_amdgcn_mfma_f32_16x16x32_bf16(*(const bf16x8*)(Bc + (st * 16 + fr) * SSD_P + ks * 32 + fq * 8), cf[ks], cb[h2], 0, 0, 0);
#pragma unroll
                        for (int jj = 0; jj < 4; ++jj) {
                            const int sidx = st * 16 + 4 * fq + jj;
                            cb[h2][jj] = (sidx <= l) ? cb[h2][jj] * __expf(acs_l - acs[hw * 128 + sidx]) * dtl[hw * 128 + sidx] : 0.f;
                        }
                    }
                }
                u32x4 wv; wv.x = pack2(cb[0].x, cb[0].y); wv.y = pack2(cb[0].z, cb[0].w); wv.z = pack2(cb[1].x, cb[1].y); wv.w = pack2(cb[1].z, cb[1].w);
                const bf16x8 mf = __builtin_bit_cast(bf16x8, wv);
#pragma unroll
                for (int pt = 0; pt < 4; ++pt) {
                    const bf16_t* xp = XsT + (hw * 64 + pt * 16 + fr) * SSD_P + ks2 * 32 + 4 * fq;
                    const u32x2 a0 = *(const u32x2*)xp, a1 = *(const u32x2*)(xp + 16);
                    u32x4 xv; xv.x = a0.x; xv.y = a0.y; xv.z = a1.x; xv.w = a1.y;
                    y[pt] = __builtin_amdgcn_mfma_f32_16x16x32_bf16(__builtin_bit_cast(bf16x8, xv), mf, y[pt], 0, 0, 0);
                }
            }
            __builtin_amdgcn_sched_barrier(0);
        }
        __builtin_amdgcn_sched_barrier(0);
#pragma unroll
        for (int pt = 0; pt < 4; ++pt)
#pragma unroll
            for (int ks = 0; ks < 4; ++ks) yo[pt] = __builtin_amdgcn_mfma_f32_16x16x32_bf16(*(const bf16x8*)(pp + (pt * 16 + fr) * 128 + ks * 32 + fq * 8), cf[ks], yo[pt], 0, 0, 0);
        __builtin_amdgcn_sched_barrier(0);
        const float el = __expf(acs_l);
#pragma unroll
        for (int pt = 0; pt < 4; ++pt) {
            const int p0 = pt * 16 + 4 * fq;
            const u32x2 zz = *(const u32x2*)(proj + (tok0 + l) * PROJ_LD + C_Z + hh * 64 + p0);
            const float z0 = bflo(zz.x), z1 = bfhi(zz.x), z2 = bflo(zz.y), z3 = bfhi(zz.y);
            const bf16_t* xq = XsT + (hw * 64 + p0) * SSD_P + l;
            const float x0 = bf2f(xq[0]), x1 = bf2f(xq[SSD_P]), x2 = bf2f(xq[2 * SSD_P]), x3 = bf2f(xq[3 * SSD_P]);
            u32x2 ob;
            ob.x = pack2((y[pt].x + el * yo[pt].x + dsk * x0) * silu(z0), (y[pt].y + el * yo[pt].y + dsk * x1) * silu(z1));
            ob.y = pack2((y[pt].z + el * yo[pt].z + dsk * x2) * silu(z2), (y[pt].w + el * yo[pt].w + dsk * x3) * silu(z3));
            *(u32x2*)(yssd + (tok0 + l) * 512 + hh * 64 + p0) = ob;
        }
    }
    __syncthreads();
}

__device__ __forceinline__ void d_mix_prep(const float* __restrict__ onsa, const bf16_t* __restrict__ yssd, const float* __restrict__ nsa_w, const float* __restrict__ ssd_w, bf16_t* __restrict__ A2, int vb) {
    const int tid_ = tid_opaque(); const int lane = tid_ & 63, wid = tid_ >> 6;
    const size_t row0 = (size_t)vb * 32 + wid * 4;
    f32x4 a[4][2], y[4][2];
#pragma unroll
    for (int r = 0; r < 4; ++r)
#pragma unroll
        for (int k = 0; k < 2; ++k) {
            a[r][k] = *(const f32x4*)(onsa + (row0 + r) * 512 + k * 256 + lane * 4);
            const u32x2 yy = *(const u32x2*)(yssd + (row0 + r) * 512 + k * 256 + lane * 4);
            y[r][k] = (f32x4){bflo(yy.x), bfhi(yy.x), bflo(yy.y), bfhi(yy.y)};
        }
    float ra[4], ry[4];
#pragma unroll
    for (int r = 0; r < 4; ++r) {
        float s0 = 0.f, s1 = 0.f;
#pragma unroll
        for (int k = 0; k < 2; ++k) {
            s0 += a[r][k].x * a[r][k].x + a[r][k].y * a[r][k].y + a[r][k].z * a[r][k].z + a[r][k].w * a[r][k].w;
            s1 += y[r][k].x * y[r][k].x + y[r][k].y * y[r][k].y + y[r][k].z * y[r][k].z + y[r][k].w * y[r][k].w;
        }
        ra[r] = rsqrtf(wave_sum(s0) * (1.0f / 512) + EPS); ry[r] = rsqrtf(wave_sum(s1) * (1.0f / 512) + EPS);
    }
#pragma unroll
    for (int k = 0; k < 2; ++k) {
        const int col = k * 256 + lane * 4;
        const f32x4 wn = *(const f32x4*)(nsa_w + col), wsd = *(const f32x4*)(ssd_w + col);
#pragma unroll
        for (int r = 0; r < 4; ++r) {
            const f32x4 p = a[r][k] * ra[r] * wn, q = y[r][k] * ry[r] * wsd;
            u32x2 o; o.x = pack2(p.x, p.y); o.y = pack2(p.z, p.w);
            *(u32x2*)(A2 + (row0 + r) * DM + col) = o;
            u32x2 o2; o2.x = pack2(q.x, q.y); o2.y = pack2(q.z, q.w);
            *(u32x2*)(A2 + (row0 + r) * DM + 512 + col) = o2;
        }
    }
}

__device__ __forceinline__ void d_quant_rows(const float* __restrict__ src, unsigned char* __restrict__ dst, float* __restrict__ scale, int vb) {
    const int tid_ = tid_opaque(); const int lane = tid_ & 63, row = vb * 8 + (tid_ >> 6);
    const float* rp = src + (size_t)row * DM + lane * 16;
    f32x4 v[4];
#pragma unroll
    for (int i = 0; i < 4; ++i) v[i] = *(const f32x4*)(rp + i * 4);
    float mx = 0.f;
#pragma unroll
    for (int i = 0; i < 4; ++i) mx = fmaxf(mx, fmaxf(fmaxf(fabsf(v[i].x), fabsf(v[i].y)), fmaxf(fabsf(v[i].z), fabsf(v[i].w))));
    mx = wave_max(mx);
    const float sc = mx > 0.f ? mx * (1.0f / 6.0f) : 1.0f;
    const float inv = 1.0f / sc;
    u32x2 o;
#pragma unroll
    for (int h = 0; h < 2; ++h) {
        unsigned wv = 0u;
        wv = __builtin_amdgcn_cvt_scalef32_pk_fp4_f32(wv, v[2 * h].x * inv, v[2 * h].y * inv, 1.0f, 0);
        wv = __builtin_amdgcn_cvt_scalef32_pk_fp4_f32(wv, v[2 * h].z * inv, v[2 * h].w * inv, 1.0f, 1);
        wv = __builtin_amdgcn_cvt_scalef32_pk_fp4_f32(wv, v[2 * h + 1].x * inv, v[2 * h + 1].y * inv, 1.0f, 2);
        wv = __builtin_amdgcn_cvt_scalef32_pk_fp4_f32(wv, v[2 * h + 1].z * inv, v[2 * h + 1].w * inv, 1.0f, 3);
        o[h] = wv;
    }
    *(u32x2*)(dst + (size_t)row * 512 + lane * 8) = o;
    if (lane == 0) scale[row] = sc;
}

__device__ __forceinline__ unsigned mono_u(float f) { const unsigned u = __float_as_uint(f); return (u & 0x80000000u) ? ~u : (u | 0x80000000u); }
__device__ __forceinline__ float unmono_f(unsigned m) { const unsigned u = (m & 0x80000000u) ? (m & 0x7fffffffu) : ~m; return __uint_as_float(u); }
__device__ __forceinline__ void d_peer_route(const bf16_t* __restrict__ qp, const float* __restrict__ qnw, const bf16_t* __restrict__ subk, int* __restrict__ eidx, float* __restrict__ gate,
                                             int tile, int h, char* lds) {
    const int tid = tid_opaque(), lane = tid & 63, w = tid >> 6, fr = lane & 15, fq = lane >> 4;
    const size_t tok = (size_t)tile * 128 + w * 16 + fr;
    bf16x8 qf[2][4];
    {
        const bf16_t* qrow = qp + tok * 2048 + h * 256;
        u32x4 raw[2][4];
        float ss = 0.f;
#pragma unroll
        for (int k = 0; k < 2; ++k)
#pragma unroll
            for (int ks = 0; ks < 4; ++ks) {
                const u32x4 r = *(const u32x4*)(qrow + k * 128 + ks * 32 + fq * 8);
                raw[k][ks] = r;
                ss += bflo(r.x) * bflo(r.x) + bfhi(r.x) * bfhi(r.x) + bflo(r.y) * bflo(r.y) + bfhi(r.y) * bfhi(r.y)
                    + bflo(r.z) * bflo(r.z) + bfhi(r.z) * bfhi(r.z) + bflo(r.w) * bflo(r.w) + bfhi(r.w) * bfhi(r.w);
            }
        ss += __shfl_xor(ss, 16); ss += __shfl_xor(ss, 32);
        const float rs = rsqrtf(ss * (1.0f / 256) + EPS);
#pragma unroll
        for (int k = 0; k < 2; ++k)
#pragma unroll
            for (int ks = 0; ks < 4; ++ks) {
                const float* wp = qnw + k * 128 + ks * 32 + fq * 8;
                const f32x4 w0 = *(const f32x4*)wp, w1 = *(const f32x4*)(wp + 4);
                const u32x4 r = raw[k][ks];
                u32x4 o;
                o.x = pack2(bflo(r.x) * rs * w0.x, bfhi(r.x) * rs * w0.y); o.y = pack2(bflo(r.y) * rs * w0.z, bfhi(r.y) * rs * w0.w);
                o.z = pack2(bflo(r.z) * rs * w1.x, bfhi(r.z) * rs * w1.y); o.w = pack2(bflo(r.w) * rs * w1.z, bfhi(r.w) * rs * w1.w);
                qf[k][ks] = __builtin_bit_cast(bf16x8, o);
            }
    }
    unsigned L[2][16];
#pragma unroll
    for (int k = 0; k < 2; ++k) {
        f32x4 acc[8];
#pragma unroll
        for (int kt = 0; kt < 8; ++kt) acc[kt] = (f32x4){0.f, 0.f, 0.f, 0.f};
        const bf16_t* kb = subk + (size_t)((h * 2 + k) * 128) * 128;
#pragma unroll
        for (int kt = 0; kt < 8; ++kt)
#pragma unroll
            for (int ks = 0; ks < 4; ++ks) {
                const bf16x8 af = *(const bf16x8*)(kb + (size_t)(kt * 16 + fr) * 128 + ks * 32 + fq * 8);
                acc[kt] = __builtin_amdgcn_mfma_f32_16x16x32_bf16(af, qf[k][ks], acc[kt], 0, 0, 0);
            }
#pragma unroll
        for (int i = 0; i < 16; ++i) L[k][i] = 0u;
#pragma unroll
        for (int kt = 0; kt < 8; ++kt)
#pragma unroll
            for (int jj = 0; jj < 4; ++jj) {
                const int idx = kt * 16 + 4 * fq + jj;
                ins16(L[k], (mono_u(acc[kt][jj]) & ~0x7Fu) | (unsigned)(127 - idx));
            }
#pragma unroll
        for (int r = 16; r <= 32; r <<= 1) {
            unsigned P[16];
#pragma unroll
            for (int i = 0; i < 16; ++i) P[i] = (unsigned)__shfl_xor((int)L[k][i], r);
            merge16(L[k], P);
        }
    }
    unsigned T[16];
#pragma unroll
    for (int i = 0; i < 16; ++i) T[i] = 0u;
#pragma unroll
    for (int a = 0; a < 16; ++a) {
        const float va = unmono_f(L[0][a] & ~0x7Fu);
#pragma unroll
        for (int bb = 0; bb < 16; ++bb) {
            if (bb <= 16 / (a + 1) - 1) {
                const float sum = va + unmono_f(L[1][bb] & ~0x7Fu);
                ins16(T, (mono_u(sum) & ~0xFFu) | (unsigned)(255 - (a * 16 + bb)));
            }
        }
    }
    unsigned char* li = (unsigned char*)lds + w * 512 + fr * 32;
    if (fq == 0) {
#pragma unroll
        for (int a = 0; a < 16; ++a) { li[a] = (unsigned char)(127 - (L[0][a] & 0x7Fu)); li[16 + a] = (unsigned char)(127 - (L[1][a] & 0x7Fu)); }
    }
    __syncthreads();
    const float s0 = unmono_f(T[0] & ~0xFFu);
    float pe[16]; float sum = 0.f;
#pragma unroll
    for (int i = 0; i < 16; ++i) { pe[i] = __expf(unmono_f(T[i] & ~0xFFu) - s0); sum += pe[i]; }
    const float inv = 1.0f / sum;
    unsigned cod[4] = {0u, 0u, 0u, 0u}; float gv[4] = {0.f, 0.f, 0.f, 0.f};
#pragma unroll
    for (int i = 0; i < 16; ++i) if ((i >> 2) == fq) { cod[i & 3] = 255u - (T[i] & 0xFFu); gv[i & 3] = pe[i] * inv; }
    int ev[4];
#pragma unroll
    for (int i = 0; i < 4; ++i) ev[i] = (int)li[cod[i] >> 4] * 128 + (int)li[16 + (cod[i] & 15u)];
    *(u32x4*)(eidx + (tok * 8 + h) * 16 + fq * 4) = (u32x4){(unsigned)ev[0], (unsigned)ev[1], (unsigned)ev[2], (unsigned)ev[3]};
    *(f32x4*)(gate + (tok * 8 + h) * 16 + fq * 4) = (f32x4){gv[0], gv[1], gv[2], gv[3]};
    __syncthreads();
}

__device__ __forceinline__ void cvt16(const u32x2 q, f32x2 (&f)[8]) {
#pragma unroll
    for (int i = 0; i < 2; ++i) {
        f[4 * i] = __builtin_amdgcn_cvt_scalef32_pk_f32_fp4(q[i], 1.0f, 0); f[4 * i + 1] = __builtin_amdgcn_cvt_scalef32_pk_f32_fp4(q[i], 1.0f, 1);
        f[4 * i + 2] = __builtin_amdgcn_cvt_scalef32_pk_f32_fp4(q[i], 1.0f, 2); f[4 * i + 3] = __builtin_amdgcn_cvt_scalef32_pk_f32_fp4(q[i], 1.0f, 3);
    }
}
typedef int v8i __attribute__((ext_vector_type(8)));
__device__ __forceinline__ void d_peer_expert_mx(const bf16_t* __restrict__ h2, const unsigned char* __restrict__ down4, const unsigned char* __restrict__ up4, const float* __restrict__ dscale,
                                                 const float* __restrict__ uscale, const int* __restrict__ eidx, const float* __restrict__ gate, const float* __restrict__ mod,
                                                 const float* __restrict__ fw, float* __restrict__ out, int vb, char* lds) {
    const int tid = tid_opaque(), lane = tid & 63, wid = tid >> 6, fr = lane & 15, kq = lane >> 4;
    const size_t tok = (size_t)vb * 8 + wid; const int b = (int)(tok >> 13);
    unsigned char* hq = (unsigned char*)lds + wid * 1024;
    {
        const u32x4 v0 = *(const u32x4*)(h2 + tok * DM + lane * 16), v1 = *(const u32x4*)(h2 + tok * DM + lane * 16 + 8);
        u32x4 q;
        int wv = 0;
        wv = __builtin_amdgcn_cvt_pk_fp8_f32(bflo(v0.x), bfhi(v0.x), wv, false); wv = __builtin_amdgcn_cvt_pk_fp8_f32(bflo(v0.y), bfhi(v0.y), wv, true); q.x = (unsigned)wv;
        wv = __builtin_amdgcn_cvt_pk_fp8_f32(bflo(v0.z), bfhi(v0.z), wv, false); wv = __builtin_amdgcn_cvt_pk_fp8_f32(bflo(v0.w), bfhi(v0.w), wv, true); q.y = (unsigned)wv;
        wv = __builtin_amdgcn_cvt_pk_fp8_f32(bflo(v1.x), bfhi(v1.x), wv, false); wv = __builtin_amdgcn_cvt_pk_fp8_f32(bflo(v1.y), bfhi(v1.y), wv, true); q.z = (unsigned)wv;
        wv = __builtin_amdgcn_cvt_pk_fp8_f32(bflo(v1.z), bfhi(v1.z), wv, false); wv = __builtin_amdgcn_cvt_pk_fp8_f32(bflo(v1.w), bfhi(v1.w), wv, true); q.w = (unsigned)wv;
        *(u32x4*)(hq + lane * 16) = q;
    }
    const int e_lo = eidx[tok * 128 + lane], e_hi = eidx[tok * 128 + 64 + lane];
    const float c_lo = gate[tok * 128 + lane] * uscale[e_lo], c_hi = gate[tok * 128 + 64 + lane] * uscale[e_hi];
    const float d_lo = dscale[e_lo], d_hi = dscale[e_hi];
    f32x2 acc[8];
#pragma unroll
    for (int e = 0; e < 8; ++e) acc[e] = (f32x2){0.f, 0.f};
    u32x4 da[8], dn[8]; u32x2 uq[16], un[16];
    {
        const int em = __shfl(e_lo, fr);
        const unsigned char* ab = down4 + (size_t)em * 512 + kq * 16;
#pragma unroll
        for (int k = 0; k < 8; ++k) da[k] = *(const u32x4*)(ab + k * 64);
#pragma unroll
        for (int i = 0; i < 16; ++i) { const int e = __builtin_amdgcn_readlane(e_lo, i); uq[i] = *(const u32x2*)(up4 + (size_t)e * 512 + lane * 8); }
    }
#pragma unroll 1
    for (int g = 0; g < 8; ++g) {
        if (g + 1 < 8) {
            const int gn = g + 1;
            const int em = gn < 4 ? __shfl(e_lo, gn * 16 + fr) : __shfl(e_hi, (gn - 4) * 16 + fr);
            const unsigned char* ab = down4 + (size_t)em * 512 + kq * 16;
#pragma unroll
            for (int k = 0; k < 8; ++k) dn[k] = *(const u32x4*)(ab + k * 64);
#pragma unroll
            for (int i = 0; i < 16; ++i) {
                const int e = gn < 4 ? __builtin_amdgcn_readlane(e_lo, gn * 16 + i) : __builtin_amdgcn_readlane(e_hi, (gn - 4) * 16 + i);
                un[i] = *(const u32x2*)(up4 + (size_t)e * 512 + lane * 8);
            }
        }
        f32x4 d4 = (f32x4){0.f, 0.f, 0.f, 0.f};
#pragma unroll
        for (int k = 0; k < 8; ++k) {
            const u32x4 b0 = *(const u32x4*)(hq + k * 128 + kq * 16), b1 = *(const u32x4*)(hq + k * 128 + 64 + kq * 16);
            const v8i A = {(int)da[k].x, (int)da[k].y, (int)da[k].z, (int)da[k].w, 0, 0, 0, 0};
            const v8i B = {(int)b0.x, (int)b0.y, (int)b0.z, (int)b0.w, (int)b1.x, (int)b1.y, (int)b1.z, (int)b1.w};
            d4 = __builtin_amdgcn_mfma_scale_f32_16x16x128_f8f6f4(A, B, d4, 4  , 0  , 0, 0x7F7F7F7F, 0, 0x7F7F7F7F);
        }
        float av;
        {
            const int jm = fr & 3;
            const float dv = jm == 0 ? d4[0] : jm == 1 ? d4[1] : jm == 2 ? d4[2] : d4[3];
            const int sl = (g & 3) * 16 + 4 * kq + jm;
            const float mc = g < 4 ? __shfl(c_lo, sl) : __shfl(c_hi, sl);
            const float md = g < 4 ? __shfl(d_lo, sl) : __shfl(d_hi, sl);
            av = gelu_tanh(dv * md) * mc;
        }
#pragma unroll
        for (int i = 0; i < 16; ++i) {
            const float c = __uint_as_float((unsigned)__builtin_amdgcn_readlane((int)__float_as_uint(av), 16 * (i >> 2) + (i & 3)));
            const f32x2 c2 = {c, c};
            f32x2 f[8]; cvt16(uq[i], f);
#pragma unroll
            for (int e = 0; e < 8; ++e) acc[e] = __builtin_elementwise_fma(f[e], c2, acc[e]);
        }
#pragma unroll
        for (int k = 0; k < 8; ++k) da[k] = dn[k];
#pragma unroll
        for (int i = 0; i < 16; ++i) uq[i] = un[i];
    }
    float x2[16]; float ss = 0.f;
#pragma unroll
    for (int q4i = 0; q4i < 4; ++q4i) {
        const int col = lane * 16 + q4i * 4;
        const f32x4 xv = *(const f32x4*)(out + tok * DM + col);
        const f32x4 g2 = *(const f32x4*)(mod + b * 6144 + 5120 + col);
        const int e0 = q4i * 4;
        x2[e0 + 0] = xv.x + g2.x * acc[2 * q4i].x; x2[e0 + 1] = xv.y + g2.y * acc[2 * q4i].y; x2[e0 + 2] = xv.z + g2.z * acc[2 * q4i + 1].x; x2[e0 + 3] = xv.w + g2.w * acc[2 * q4i + 1].y;
        ss += x2[e0] * x2[e0] + x2[e0 + 1] * x2[e0 + 1] + x2[e0 + 2] * x2[e0 + 2] + x2[e0 + 3] * x2[e0 + 3];
    }
    ss = wave_sum(ss);
    const float r = rsqrtf(ss * (1.0f / DM) + EPS);
#pragma unroll
    for (int q4i = 0; q4i < 4; ++q4i) {
        const int col = lane * 16 + q4i * 4;
        const f32x4 wv = *(const f32x4*)(fw + col);
        const int e0 = q4i * 4;
        *(f32x4*)(out + tok * DM + col) = (f32x4){x2[e0] * r * wv.x, x2[e0 + 1] * r * wv.y, x2[e0 + 2] * r * wv.z, x2[e0 + 3] * r * wv.w};
    }
}

__device__ __forceinline__ void d_peer_expert8(const bf16_t* __restrict__ h2, const unsigned char* __restrict__ down8, const unsigned char* __restrict__ up8, const float* __restrict__ dscale,
                                               const float* __restrict__ uscale, const int* __restrict__ eidx, const float* __restrict__ gate, const float* __restrict__ mod,
                                               const float* __restrict__ fw, float* __restrict__ out, int vb) {
    const int tid = tid_opaque(), lane = tid & 63, wid = tid >> 6;
    const size_t tok = (size_t)vb * 8 + wid; const int b = (int)(tok >> 13);
    const int e_lo = eidx[tok * 128 + lane], e_hi = eidx[tok * 128 + 64 + lane];
    const float c_lo = gate[tok * 128 + lane] * uscale[e_lo], c_hi = gate[tok * 128 + 64 + lane] * uscale[e_hi];
    const float d_lo = dscale[e_lo], d_hi = dscale[e_hi];
    f32x2 hx[8], acc[8];
    {
        const u32x4 v0 = *(const u32x4*)(h2 + tok * DM + lane * 16), v1 = *(const u32x4*)(h2 + tok * DM + lane * 16 + 8);
        hx[0] = (f32x2){bflo(v0.x), bfhi(v0.x)}; hx[1] = (f32x2){bflo(v0.y), bfhi(v0.y)}; hx[2] = (f32x2){bflo(v0.z), bfhi(v0.z)}; hx[3] = (f32x2){bflo(v0.w), bfhi(v0.w)};
        hx[4] = (f32x2){bflo(v1.x), bfhi(v1.x)}; hx[5] = (f32x2){bflo(v1.y), bfhi(v1.y)}; hx[6] = (f32x2){bflo(v1.z), bfhi(v1.z)}; hx[7] = (f32x2){bflo(v1.w), bfhi(v1.w)};
    }
#pragma unroll
    for (int e = 0; e < 8; ++e) acc[e] = (f32x2){0.f, 0.f};
    const int es = lane >> 3;
    u32x2 dq[8], uq[8], dn[8], un[8];
#pragma unroll
    for (int i = 0; i < 8; ++i) {
        const int e = __builtin_amdgcn_readlane(e_lo, i);
        dq[i] = *(const u32x2*)(down8 + (size_t)e * 512 + lane * 8);
        uq[i] = *(const u32x2*)(up8 + (size_t)e * 512 + lane * 8);
    }
#pragma unroll 1
    for (int j0 = 0; j0 < 128; j0 += 8) {
        if (j0 + 8 < 128) {
            const int jn = j0 + 8;
#pragma unroll
            for (int i = 0; i < 8; ++i) {
                const int e = jn < 64 ? __builtin_amdgcn_readlane(e_lo, jn + i) : __builtin_amdgcn_readlane(e_hi, jn - 64 + i);
                dn[i] = *(const u32x2*)(down8 + (size_t)e * 512 + lane * 8);
                un[i] = *(const u32x2*)(up8 + (size_t)e * 512 + lane * 8);
            }
        }
        const int sl = (j0 & 63) + es;
        const float my_c = j0 < 64 ? __shfl(c_lo, sl) : __shfl(c_hi, sl);
        const float my_ds = j0 < 64 ? __shfl(d_lo, sl) : __shfl(d_hi, sl);
        float part[8];
#pragma unroll
        for (int i = 0; i < 8; ++i) {
            f32x2 f[8]; cvt16(dq[i], f);
            f32x2 s2 = hx[0] * f[0];
#pragma unroll
            for (int e = 1; e < 8; ++e) s2 = __builtin_elementwise_fma(hx[e], f[e], s2);
            part[i] = s2.x + s2.y;
        }
        float q4[4], q2[2], q1;
#pragma unroll
        for (int i = 0; i < 4; ++i) { const bool up = (lane & 32) != 0; const float send = up ? part[i] : part[i + 4]; const float keep = up ? part[i + 4] : part[i]; q4[i] = keep + __shfl_xor(send, 32); }
#pragma unroll
        for (int i = 0; i < 2; ++i) { const bool up = (lane & 16) != 0; const float send = up ? q4[i] : q4[i + 2]; const float keep = up ? q4[i + 2] : q4[i]; q2[i] = keep + __shfl_xor(send, 16); }
        { const bool up = (lane & 8) != 0; const float send = up ? q2[0] : q2[1]; const float keep = up ? q2[1] : q2[0]; q1 = keep + __shfl_xor(send, 8); }
        q1 += __shfl_xor(q1, 4); q1 += __shfl_xor(q1, 2); q1 += __shfl_xor(q1, 1);
        const float a = gelu_tanh(q1 * my_ds) * my_c;
#pragma unroll
        for (int i = 0; i < 8; ++i) {
            const float c = __uint_as_float((unsigned)__builtin_amdgcn_readlane((int)__float_as_uint(a), 8 * i));
            const f32x2 c2 = {c, c};
            f32x2 f[8]; cvt16(uq[i], f);
#pragma unroll
            for (int e = 0; e < 8; ++e) acc[e] = __builtin_elementwise_fma(f[e], c2, acc[e]);
        }
#pragma unroll
        for (int i = 0; i < 8; ++i) { dq[i] = dn[i]; uq[i] = un[i]; }
    }
    float x2[16]; float ss = 0.f;
#pragma unroll
    for (int q4i = 0; q4i < 4; ++q4i) {
        const int col = lane * 16 + q4i * 4;
        const f32x4 xv = *(const f32x4*)(out + tok * DM + col);
        const f32x4 g2 = *(const f32x4*)(mod + b * 6144 + 5120 + col);
        const int e0 = q4i * 4;
        x2[e0 + 0] = xv.x + g2.x * acc[2 * q4i].x; x2[e0 + 1] = xv.y + g2.y * acc[2 * q4i].y; x2[e0 + 2] = xv.z + g2.z * acc[2 * q4i + 1].x; x2[e0 + 3] = xv.w + g2.w * acc[2 * q4i + 1].y;
        ss += x2[e0] * x2[e0] + x2[e0 + 1] * x2[e0 + 1] + x2[e0 + 2] * x2[e0 + 2] + x2[e0 + 3] * x2[e0 + 3];
    }
    ss = wave_sum(ss);
    const float r = rsqrtf(ss * (1.0f / DM) + EPS);
#pragma unroll
    for (int q4i = 0; q4i < 4; ++q4i) {
        const int col = lane * 16 + q4i * 4;
        const f32x4 wv = *(const f32x4*)(fw + col);
        const int e0 = q4i * 4;
        *(f32x4*)(out + tok * DM + col) = (f32x4){x2[e0] * r * wv.x, x2[e0 + 1] * r * wv.y, x2[e0 + 2] * r * wv.z, x2[e0 + 3] * r * wv.w};
    }
}

#define XB_TMO      128
#define XB_XCNT(j)  (256  + 64 * (j))
#define XB_XSUB(j)  (1280 + 64 * (j))
#define XB_XGEN(j)  (2304 + 64 * (j))
#define XB_TOP      3328
#define XB_TOPGEN   3392
#define XCD_BAR_WORDS 3456
#define XB_SPIN_CAP (1u << 18)

__device__ __forceinline__ unsigned xb_ld(unsigned* p)              { return __hip_atomic_load(p, __ATOMIC_RELAXED, __HIP_MEMORY_SCOPE_AGENT); }
__device__ __forceinline__ unsigned xb_add(unsigned* p, unsigned v) { return __hip_atomic_fetch_add(p, v, __ATOMIC_RELAXED, __HIP_MEMORY_SCOPE_AGENT); }
__device__ __forceinline__ unsigned xb_xcc_id() { return (unsigned)__builtin_amdgcn_s_getreg((3 << 11) | 20) & 0xFu; }
#define XB_SPIN(cond, bar) do { unsigned _sp = 0; while (cond) { __builtin_amdgcn_s_sleep(1); \
    if ((++_sp & 255u) == 0u) { if (xb_ld(&(bar)[XB_TMO])) break; if (_sp > XB_SPIN_CAP) { atomicAdd(&(bar)[XB_TMO], 1u); break; } } } } while (0)

struct XcdBarrier {
    unsigned* bar; unsigned x;
    volatile __attribute__((address_space(3))) unsigned* st;
};

__device__ __forceinline__ XcdBarrier xcd_barrier_post(unsigned* bar, volatile __attribute__((address_space(3))) unsigned* st) {
    XcdBarrier b; b.bar = bar; b.x = xb_xcc_id(); b.st = st;
    if (threadIdx.x == 0) (void)xb_add(&bar[XB_XCNT(b.x)], 1u);
    return b;
}
__device__ __forceinline__ void xcd_barrier_complete(unsigned* bar, unsigned x, unsigned& nloc, unsigned& nx) {
    const unsigned G = gridDim.x * gridDim.y * gridDim.z;
    unsigned sum, cnt, mine, sp = 0u;
    for (;;) {
        sum = 0u; cnt = 0u; mine = 0u;
#pragma unroll
        for (unsigned j = 0; j < 16; ++j) { const unsigned c = xb_ld(&bar[XB_XCNT(j)]); sum += c; cnt += (c > 0u) ? 1u : 0u; mine = (j == x) ? c : mine; }
        if (sum == G) break;
        __builtin_amdgcn_s_sleep(1);
        if ((++sp & 255u) == 0u) { if (xb_ld(&bar[XB_TMO])) break; if (sp > XB_SPIN_CAP) { atomicAdd(&bar[XB_TMO], 1u); break; } }
    }
    nloc = mine > 0u ? mine : 1u; nx = cnt > 0u ? cnt : 1u;
}

__device__ __forceinline__ void xcd_barrier(const XcdBarrier& b) {
    asm volatile("s_waitcnt vmcnt(0)" ::: "memory");
    __syncthreads();
    if (threadIdx.x == 0) {
        unsigned* bar = b.bar;
        __builtin_amdgcn_s_waitcnt(0);
        unsigned nloc = b.st[0], nx = b.st[1];
        if (nloc == 0u) { xcd_barrier_complete(bar, b.x, nloc, nx); b.st[0] = nloc; b.st[1] = nx; }
        const unsigned old = xb_add(&bar[XB_XSUB(b.x)], 1u);
        const unsigned gen = old / nloc;
        if (old + 1u == (gen + 1u) * nloc) {
            __builtin_amdgcn_fence(__ATOMIC_RELEASE, "agent");
            asm volatile("s_waitcnt vmcnt(0)" ::: "memory");
            const unsigned og = xb_add(&bar[XB_TOP], 1u);
            const unsigned tg = og / nx;
            if (og + 1u == (tg + 1u) * nx) xb_add(&bar[XB_TOPGEN], 1u);
            else XB_SPIN(xb_ld(&bar[XB_TOPGEN]) == tg, bar);
            __builtin_amdgcn_fence(__ATOMIC_ACQUIRE, "agent");
            xb_add(&bar[XB_XGEN(b.x)], 1u);
            asm volatile("s_waitcnt vmcnt(0)" ::: "memory");
        } else {
            XB_SPIN(xb_ld(&bar[XB_XGEN(b.x)]) == gen, bar);
            __builtin_amdgcn_fence(__ATOMIC_ACQUIRE, "agent");
            asm volatile("s_waitcnt vmcnt(0)" ::: "memory");
        }
    }
    __syncthreads();
}


struct Params {
    const float *x, *c, *w_ada, *b_ada, *norm1_w, *w_in, *cmp_pe_k, *cmp_pe_v, *cmp_w1_k, *cmp_w2_k, *cmp_w1_v, *cmp_w2_v, *nsa_norm_w, *conv_w, *conv_b, *dt_bias, *a_log, *d_skip,
        *ssd_norm_w, *w_out, *norm2_w, *peer_wq, *peer_qnorm_w, *peer_sub_keys, *peer_down, *peer_up, *final_norm_w;
    float* out; char* ws;
};
#define LDS_BYTES 147456
#define LDS_MISC  (LDS_BYTES - 64)

__global__ __launch_bounds__(512, 2) void mega(Params p) {
    __shared__ __attribute__((aligned(16))) unsigned char lds_raw[LDS_BYTES];
    char* lds = (char*)lds_raw;
    PG8_LAS unsigned char* lds3 = (PG8_LAS unsigned char*)lds_raw;
    int* s_vb = (int*)(lds + LDS_MISC);
    cg::grid_group grid = cg::this_grid();
    volatile __attribute__((address_space(3))) unsigned* xb_st = (volatile __attribute__((address_space(3))) unsigned*)((PG8_LAS unsigned char*)lds_raw + LDS_MISC + 16);
    if (threadIdx.x == 0) { xb_st[0] = 0u; xb_st[1] = 0u; }
    __syncthreads();
    const XcdBarrier xbar = xcd_barrier_post((unsigned*)(p.ws + OFF_BAR), xb_st);
    const int G = gridDim.x, bid = blockIdx.x;
    if (bid == 0 && threadIdx.x == 0) { ((unsigned*)(p.ws + OFF_CTR))[0] = 0u; ((unsigned*)(p.ws + OFF_CTR))[64] = 0u; ((unsigned*)(p.ws + OFF_CTR))[128] = 0u; }
    for (int vb = bid; vb < 7906; vb += G) {
        int v = vb;
        if (v < 1536) { d_transpose_w(p.w_in, ((bf16_t*)(p.ws + OFF_WIN_T)), 1024, 2848, 1, 96, v, lds); }
        else if ((v -= 1536) < 512) { d_transpose_w(p.w_out, ((bf16_t*)(p.ws + OFF_WOUT_T)), 1024, 1024, 0, 32, v, lds); }
        else if ((v -= 512) < 1024) { d_transpose_w(p.peer_wq, ((bf16_t*)(p.ws + OFF_WQ_T)), 1024, 2048, 0, 64, v, lds); }
        else if ((v -= 1024) < 256) { d_transpose_w(p.cmp_w1_k, ((bf16_t*)(p.ws + OFF_W1K_T)), 2048, 256, 0, 8, v, lds); }
        else if ((v -= 256) < 256) { d_transpose_w(p.cmp_w1_v, ((bf16_t*)(p.ws + OFF_W1V_T)), 2048, 256, 0, 8, v, lds); }
        else if ((v -= 256) < 2048) { d_quant_rows(p.peer_down, ((unsigned char*)(p.ws + OFF_DOWN)), ((float*)(p.ws + OFF_UP)), v); }
        else if ((v -= 2048) < 2048) { d_quant_rows(p.peer_up, ((unsigned char*)(p.ws + OFF_DOWN + MIB(8))), ((float*)(p.ws + OFF_UP + 65536)), v); }
        else if ((v -= 2048) < 1) { d_convert_bf16(p.peer_sub_keys, ((bf16_t*)(p.ws + OFF_SUBK)), (size_t)8 * 2 * 128 * 128 / 8, 0, 1); }
        else if ((v -= 1) < 96) { d_mod(p.c, p.w_ada, p.b_ada, ((float*)(p.ws + OFF_MOD)), v, lds); }
        else if ((v -= 96) < 128) { d_rope_table(((float2*)(p.ws + OFF_ROPE)), v); }
        else { d_bias1(p.cmp_pe_k, p.cmp_w1_k, p.cmp_pe_v, p.cmp_w1_v, ((float*)(p.ws + OFF_BIAS1))); }
    }
    grid.sync();
    for (int vb = bid; vb < NTOK / 32; vb += G) d_norm_mod(p.x, p.norm1_w, ((float*)(p.ws + OFF_MOD)), 0, 1024, ((bf16_t*)(p.ws + OFF_H)), vb);
    xcd_barrier(xbar);
    {
        const pg8::Gemm g{((bf16_t*)(p.ws + OFF_H)), ((bf16_t*)(p.ws + OFF_WIN_T)), NTOK, NIN_PAD, 1024, 1024};
        pg8::StaticOrder S; S.init(NTOK, NIN_PAD, G, bid);
        const pg8::Epi<EpInProj> E{{((bf16_t*)(p.ws + OFF_PROJ)), ((bf16_t*)(p.ws + OFF_QROPE)), ((bf16_t*)(p.ws + OFF_KVP)), ((float*)(p.ws + OFF_SMALL)), ((float2*)(p.ws + OFF_ROPE)), p.dt_bias}};
        pg8::gemm_phase(lds3, g, S, E);
    }
    xcd_barrier(xbar);
    {
        {
            const pg8::Gemm g{((bf16_t*)(p.ws + OFF_KVP)) + 0 * KVP_SEG, ((bf16_t*)(p.ws + OFF_W1K_T)), 8192, 256, 2048, 1024};
            pg8::StaticOrder S; S.init(8192, 256, G, bid);
            const pg8::Epi<EpCmpHid> E{{((bf16_t*)(p.ws + OFF_HIDK)), ((float*)(p.ws + OFF_BIAS1))}};
            pg8::gemm_phase(lds3, g, S, E);
        }
        {
            const pg8::Gemm g{((bf16_t*)(p.ws + OFF_KVP)) + 1 * KVP_SEG, ((bf16_t*)(p.ws + OFF_W1V_T)), 8192, 256, 2048, 1024};
            pg8::StaticOrder S; S.init(8192, 256, G, (bid + G / 2) % G);
            const pg8::Epi<EpCmpHid> E{{((bf16_t*)(p.ws + OFF_HIDV)), ((float*)(p.ws + OFF_BIAS1)) + 256}};
            pg8::gemm_phase(lds3, g, S, E);
        }
        __syncthreads();
        for (int vb = bid; vb < 1024; vb += G) d_ssd_states(((bf16_t*)(p.ws + OFF_PROJ)), ((float*)(p.ws + OFF_SMALL)), p.conv_w, p.conv_b, p.a_log, ((float*)(p.ws + OFF_ONSA)), ((float*)(p.ws + OFF_CTR + 4096)), vb, lds);
    }
    xcd_barrier(xbar);
    for (int vb = bid; vb < 2048 + 128; vb += G) {
        if (vb < 1024) d_cmp_out(((bf16_t*)(p.ws + OFF_HIDK)), p.cmp_w2_k, ((bf16_t*)(p.ws + OFF_KC)), vb); else if (vb < 2048) d_cmp_out(((bf16_t*)(p.ws + OFF_HIDV)), p.cmp_w2_v, ((bf16_t*)(p.ws + OFF_VC)), vb - 1024);
        else d_ssd_scan(((float*)(p.ws + OFF_ONSA)), ((float*)(p.ws + OFF_CTR + 4096)), ((bf16_t*)(p.ws + OFF_EIDX)), vb - 2048);
    }
    xcd_barrier(xbar);
    for (;;) {
        if (threadIdx.x == 0) *s_vb = (int)atomicAdd(&((unsigned*)(p.ws + OFF_CTR))[0], 1u);
        __syncthreads();
        const int i = *s_vb;
        __syncthreads();
        if (i >= 2048) break;
        const int qt = 127 - (i >> 4), bg = i & 15;
        d_nsa_cmp(((bf16_t*)(p.ws + OFF_PROJ)), ((bf16_t*)(p.ws + OFF_KC)), ((bf16_t*)(p.ws + OFF_VC)), ((float*)(p.ws + OFF_SMALL)), ((float*)(p.ws + OFF_ONSA)), ((unsigned*)(p.ws + OFF_HIDK)) + (size_t)(bg * 128 + qt) * 512, bg >> 1, bg & 1, qt, lds);
    }
    for (;;) {
        if (threadIdx.x == 0) *s_vb = (int)atomicAdd(&((unsigned*)(p.ws + OFF_CTR))[64], 1u);
        __syncthreads();
        const int i = *s_vb;
        __syncthreads();
        if (i >= 1024) break;
        d_ssd_out(((bf16_t*)(p.ws + OFF_PROJ)), ((float*)(p.ws + OFF_SMALL)), p.conv_w, p.conv_b, p.a_log, p.d_skip, ((bf16_t*)(p.ws + OFF_EIDX)), ((bf16_t*)(p.ws + OFF_YSSD)), i, lds);
    }
    xcd_barrier(xbar);
    for (;;) {
        if (threadIdx.x == 0) *s_vb = (int)atomicAdd(&((unsigned*)(p.ws + OFF_CTR))[128], 1u);
        __syncthreads();
        const int i = *s_vb;
        __syncthreads();
        if (i >= 2048) break;
        const int qt = 127 - (i >> 4), bg = i & 15;
        d_nsa_attn(((bf16_t*)(p.ws + OFF_QROPE)), ((bf16_t*)(p.ws + OFF_KVP)), ((float*)(p.ws + OFF_SMALL)), ((float*)(p.ws + OFF_ONSA)), ((unsigned*)(p.ws + OFF_HIDK)) + (size_t)(bg * 128 + qt) * 512, bg >> 1, bg & 1, qt, lds);
    }
    xcd_barrier(xbar);
    for (int vb = bid; vb < NTOK / 32; vb += G) d_mix_prep(((float*)(p.ws + OFF_ONSA)), ((bf16_t*)(p.ws + OFF_YSSD)), p.nsa_norm_w, p.ssd_norm_w, ((bf16_t*)(p.ws + OFF_H)), vb);
    xcd_barrier(xbar);
    {
        const pg8::Gemm g{((bf16_t*)(p.ws + OFF_H)), ((bf16_t*)(p.ws + OFF_WOUT_T)), NTOK, 1024, 1024, 1024};
        pg8::StaticOrder S; S.init(NTOK, 1024, G, bid);
        const pg8::Epi<EpOutProj> E{{p.x, ((float*)(p.ws + OFF_MOD)), p.out}};
        pg8::gemm_phase(lds3, g, S, E);
    }
    xcd_barrier(xbar);
    for (int vb = bid; vb < NTOK / 32; vb += G) d_norm_mod(p.out, p.norm2_w, ((float*)(p.ws + OFF_MOD)), 3072, 4096, ((bf16_t*)(p.ws + OFF_H)), vb);
    xcd_barrier(xbar);
    {
        const pg8::Gemm g{((bf16_t*)(p.ws + OFF_H)), ((bf16_t*)(p.ws + OFF_WQ_T)), NTOK, 2048, 1024, 1024};
        pg8::StaticOrder S; S.init(NTOK, 2048, G, bid);
        const pg8::Epi<EpStoreBf16> E{{((bf16_t*)(p.ws + OFF_PROJ)), 2048, 0}};
        pg8::gemm_phase(lds3, g, S, E);
    }
    xcd_barrier(xbar);
    for (int vb = bid; vb < 4096; vb += G) d_peer_route(((bf16_t*)(p.ws + OFF_PROJ)), p.peer_qnorm_w, ((bf16_t*)(p.ws + OFF_SUBK)), ((int*)(p.ws + OFF_EIDX)), ((float*)(p.ws + OFF_GATE)), vb >> 3, vb & 7, lds);
    xcd_barrier(xbar);
    for (int vb = bid; vb < NTOK / 8; vb += G) d_peer_expert_mx(((bf16_t*)(p.ws + OFF_H)), ((unsigned char*)(p.ws + OFF_DOWN)), ((unsigned char*)(p.ws + OFF_DOWN + MIB(8))), ((float*)(p.ws + OFF_UP)), ((float*)(p.ws + OFF_UP + 65536)), ((int*)(p.ws + OFF_EIDX)), ((float*)(p.ws + OFF_GATE)), ((float*)(p.ws + OFF_MOD)), p.final_norm_w, p.out, vb, lds);
}

extern "C" void kernel_launch(void* const* d_in, const int* in_sizes, int n_in, void* d_out, int out_size, void* d_ws, size_t ws_size, hipStream_t stream) {
    if (ws_size < WS_NEED) { fprintf(stderr, "workspace too small\n"); return; }
    static int grid_blocks = 0;
    if (!grid_blocks) {
        int dev = 0, cus = 0, per_cu = 0;
        (void)hipGetDevice(&dev);
        (void)hipDeviceGetAttribute(&cus, hipDeviceAttributeMultiprocessorCount, dev);
        (void)hipOccupancyMaxActiveBlocksPerMultiprocessor(&per_cu, mega, 512, 0);
        if (per_cu < 1) fprintf(stderr, "occupancy query reports %d blocks per CU\n", per_cu);
        grid_blocks = cus;
    }
    Params p{};
    const float** pp = (const float**)&p;
    for (int i = 0; i < 27; ++i) pp[i] = (const float*)d_in[i];
    p.out = (float*)d_out; p.ws = (char*)d_ws;
    (void)hipMemsetAsync((char*)d_ws + OFF_BAR, 0, XCD_BAR_WORDS * 4, stream);
    void* args[] = {&p};
    hipError_t e = hipLaunchCooperativeKernel((void*)mega, dim3(grid_blocks), dim3(512), args, 0, stream);
    if (e != hipSuccess) fprintf(stderr, "cooperative launch failed: %s (grid %d)\n", hipGetErrorString(e), grid_blocks);
}
```

```cpp
#include <hip/hip_runtime.h>
#include <hip/hip_cooperative_groups.h>
#include <stdint.h>
#include <cstdio>
namespace cg = cooperative_groups;

typedef unsigned short bf16_t;
typedef short bf16x8 __attribute__((ext_vector_type(8)));
typedef float f32x4 __attribute__((ext_vector_type(4)));
typedef float f32x2 __attribute__((ext_vector_type(2)));
typedef unsigned u32x4 __attribute__((ext_vector_type(4)));
typedef unsigned u32x2 __attribute__((ext_vector_type(2)));

#define NB 8
#define SEQ 8192
#define NTOK 65536
#define DM 1024
#define PROJ_LD 2816
#define NIN_PAD 3072
#define C_Q 0
#define C_KCMP 512
#define C_KSEL 768
#define C_VSEL 896
#define C_KWIN 1024
#define C_VWIN 1152
#define C_Z 1280
#define C_XBC 1792
#define NCMP 511
#define EPS 1e-6f
#define KVP_SEG ((size_t)NB * 2 * SEQ * 64)

#define MIB(x) ((size_t)(x) << 20)
#define OFF_MOD    MIB(0)
#define OFF_ROPE   MIB(1)
#define OFF_BIAS1  MIB(2)
#define OFF_WIN_T  MIB(3)
#define OFF_WOUT_T MIB(9)
#define OFF_WQ_T   MIB(11)
#define OFF_SUBK   MIB(15)
#define OFF_W1K_T  MIB(16)
#define OFF_W1V_T  MIB(17)
#define OFF_KC     MIB(18)
#define OFF_VC     MIB(19)
#define OFF_HIDK   MIB(20)
#define OFF_HIDV   MIB(24)
#define OFF_DOWN   MIB(28)
#define OFF_UP     MIB(60)
#define OFF_SMALL  MIB(92)
#define OFF_H      MIB(100)
#define OFF_PROJ   MIB(228)
#define OFF_QROPE  MIB(580)
#define OFF_ONSA   MIB(644)
#define OFF_YSSD   MIB(772)
#define OFF_KVP    MIB(836)
#define OFF_EIDX   MIB(932)
#define OFF_GATE   MIB(964)
#define OFF_CTR    MIB(996)
#define OFF_BAR    (MIB(996) + 65536)
#define WS_NEED    MIB(997)

typedef __bf16 hwbf2 __attribute__((ext_vector_type(2)));
__device__ __forceinline__ bf16_t f2bf(float f) { const __bf16 h = (__bf16)f; return __builtin_bit_cast(bf16_t, h); }
__device__ __forceinline__ float bf2f(bf16_t h) { return __uint_as_float(((unsigned)h) << 16); }
__device__ __forceinline__ float bflo(unsigned u) { return __uint_as_float(u << 16); }
__device__ __forceinline__ float bfhi(unsigned u) { return __uint_as_float(u & 0xffff0000u); }
__device__ __forceinline__ unsigned pack2(float a, float b) { const f32x2 v = {a, b}; const hwbf2 r = __builtin_convertvector(v, hwbf2); return __builtin_bit_cast(unsigned, r); }
__device__ __forceinline__ float wave_sum(float v) {
#pragma unroll
    for (int o = 32; o; o >>= 1) v += __shfl_xor(v, o);
    return v;
}
__device__ __forceinline__ float wave_max(float v) {
#pragma unroll
    for (int o = 32; o; o >>= 1) v = fmaxf(v, __shfl_xor(v, o));
    return v;
}
__device__ __forceinline__ int tid_opaque() { int t = threadIdx.x; asm volatile("" : "+v"(t)); return t; }
__device__ __forceinline__ float gelu_tanh(float x) { const float u2 = 1.5957691216057308f * (x + 0.044715f * x * x * x); return x * __builtin_amdgcn_rcpf(1.0f + __expf(-u2)); }
__device__ __forceinline__ float silu(float x) { return x / (1.0f + __expf(-x)); }
__device__ __forceinline__ float sigmoidf(float x) { return 1.0f / (1.0f + __expf(-x)); }
__device__ __forceinline__ float softplusf(float x) { return x > 20.f ? x : log1pf(__expf(x)); }

__device__ __forceinline__ int inproj_src(int n) {
    if (n < 1280) return n;
    if (n < 1792) return 1304 + (n - 1280);
    if (n < 2816) return 1816 + (n - 1792);
    if (n < 2840) return 1280 + (n - 2816);
    if (n < 2848) return 2840 + (n - 2840);
    return -1;
}
__device__ __forceinline__ void d_transpose_w(const float* __restrict__ W, bf16_t* __restrict__ Wt, int K, int N, int mode, int nbx, int vb, char* lds) {
    const int tid_ = tid_opaque(); const int half = tid_ >> 8, t256 = tid_ & 255, tile = vb * 2 + half;
    float (*t)[33] = (float (*)[33])(lds + half * 4352);
    const int n0 = (tile % nbx) * 32, k0 = (tile / nbx) * 32, tx = t256 & 31, ty = t256 >> 5;
#pragma unroll
    for (int i = 0; i < 4; ++i) {
        const int k = k0 + ty + 8 * i, n = n0 + tx;
        const int src = mode == 1 ? inproj_src(n) : n;
        t[ty + 8 * i][tx] = (src >= 0 && src < N) ? W[(size_t)k * N + src] : 0.f;
    }
    __syncthreads();
#pragma unroll
    for (int i = 0; i < 4; ++i) Wt[(size_t)(n0 + ty + 8 * i) * K + k0 + tx] = f2bf(t[tx][ty + 8 * i]);
    __syncthreads();
}
__device__ __forceinline__ void d_convert_bf16(const float* __restrict__ in, bf16_t* __restrict__ out, size_t n8, int vb, int nvb) {
    size_t i = (size_t)vb * 512 + tid_opaque();
    const size_t stride = (size_t)nvb * 512;
    for (; i < n8; i += stride) {
        const f32x4 a = ((const f32x4*)in)[2 * i], b = ((const f32x4*)in)[2 * i + 1];
        u32x4 o; o.x = pack2(a.x, a.y); o.y = pack2(a.z, a.w); o.z = pack2(b.x, b.y); o.w = pack2(b.z, b.w);
        ((u32x4*)out)[i] = o;
    }
}
__device__ __forceinline__ void d_mod(const float* __restrict__ c, const float* __restrict__ w_ada, const float* __restrict__ b_ada, float* __restrict__ mod, int vb, char* lds) {
    float (*part)[8][64] = (float (*)[8][64])lds;
    const int tid = tid_opaque(), jl = tid & 63, kq = tid >> 6, j = vb * 64 + jl;
    float acc[8];
#pragma unroll
    for (int b = 0; b < 8; ++b) acc[b] = 0.f;
    for (int k0 = kq * 128; k0 < kq * 128 + 128; k0 += 16) {
        float wv[16];
#pragma unroll
        for (int i = 0; i < 16; ++i) wv[i] = w_ada[(size_t)(k0 + i) * 6144 + j];
#pragma unroll
        for (int i = 0; i < 16; ++i)
#pragma unroll
            for (int b = 0; b < 8; ++b) acc[b] += c[b * 1024 + k0 + i] * wv[i];
    }
#pragma unroll
    for (int b = 0; b < 8; ++b) part[kq][b][jl] = acc[b];
    __syncthreads();
    {
        const int b = tid >> 6, jj = tid & 63;
        float s = b_ada[vb * 64 + jj];
#pragma unroll
        for (int q = 0; q < 8; ++q) s += part[q][b][jj];
        mod[b * 6144 + vb * 64 + jj] = s;
    }
    __syncthreads();
}
__device__ __forceinline__ void d_rope_table(float2* __restrict__ rope, int vb) {
    const int i = vb * 512 + tid_opaque();
    if (i >= SEQ * 8) return;
    const int pos = i >> 3, f = i & 7;
    const double inv = pow(500000.0, -(double)f / 8.0);
    const double ang = (double)pos * inv;
    rope[i] = make_float2((float)cos(ang), (float)sin(ang));
}
__device__ __forceinline__ void d_bias1(const float* __restrict__ pe_k, const float* __restrict__ w1_k, const float* __restrict__ pe_v, const float* __restrict__ w1_v, float* __restrict__ bias1) {
    const int tid_ = tid_opaque(); const int which = tid_ >> 8, j = tid_ & 255;
    const float* pe = which ? pe_v : pe_k; const float* w1 = which ? w1_v : w1_k;
    float a = 0.f;
    for (int k0 = 0; k0 < 2048; k0 += 16) {
        float wv[16];
#pragma unroll
        for (int i = 0; i < 16; ++i) wv[i] = w1[(size_t)(k0 + i) * 256 + j];
#pragma unroll
        for (int i = 0; i < 16; ++i) a += pe[k0 + i] * wv[i];
    }
    bias1[which * 256 + j] = a;
}

__device__ __forceinline__ void d_norm_mod(const float* __restrict__ x, const float* __restrict__ w, const float* __restrict__ mod, int sh_off, int sc_off, bf16_t* __restrict__ out, int vb) {
    const int tid_ = tid_opaque(); const int lane = tid_ & 63, wid = tid_ >> 6;
    const size_t row0 = (size_t)vb * 32 + wid * 4; const int b = (int)(row0 >> 13);
    f32x4 v[4][4];
#pragma unroll
    for (int r = 0; r < 4; ++r)
#pragma unroll
        for (int k = 0; k < 4; ++k) v[r][k] = *(const f32x4*)(x + (row0 + r) * DM + k * 256 + lane * 4);
    float rs[4];
#pragma unroll
    for (int r = 0; r < 4; ++r) {
        float ss = 0.f;
#pragma unroll
        for (int k = 0; k < 4; ++k) ss += v[r][k].x * v[r][k].x + v[r][k].y * v[r][k].y + v[r][k].z * v[r][k].z + v[r][k].w * v[r][k].w;
        rs[r] = rsqrtf(wave_sum(ss) * (1.0f / DM) + EPS);
    }
#pragma unroll
    for (int k = 0; k < 4; ++k) {
        const int col = k * 256 + lane * 4;
        const f32x4 wv = *(const f32x4*)(w + col), sc = *(const f32x4*)(mod + b * 6144 + sc_off + col), sh = *(const f32x4*)(mod + b * 6144 + sh_off + col);
        const f32x4 ws = wv * (sc + 1.0f);
#pragma unroll
        for (int r = 0; r < 4; ++r) {
            const f32x4 y = v[r][k] * rs[r] * ws + sh;
            u32x2 o; o.x = pack2(y.x, y.y); o.y = pack2(y.z, y.w);
            *(u32x2*)(out + (row0 + r) * DM + col) = o;
        }
    }
}

namespace pg8 {
#define PG8_LAS __attribute__((address_space(3)))
constexpr int BM = 256, BK = 64, HALF = 128, HTB = HALF * BK * 2  , STAGE_BYTES = 8 * HTB, NXCD = 8, WGM = 8;
__host__ __device__ __forceinline__ int lds_byte(int r, int c) { const int st = (r >> 4) * 2 + (c >> 5), rr = r & 15, cc = c & 31, ob = rr * 64 + cc * 2; return st * 1024 + (ob ^ (((ob >> 9) & 1) << 5)); }
__host__ __device__ __forceinline__ void stage_rc(int b, int& R, int& C) { const int st = b / 1024, sb = b % 1024, swz = sb ^ (((sb >> 9) & 1) << 5); R = (st >> 1) * 16 + swz / 64; C = (st & 1) * 32 + (swz % 64) / 2; }
__host__ __device__ __forceinline__ int perm32(int rho) { const int n = rho >> 4, i = rho & 15; return 8 * (i >> 2) + 4 * n + (i & 3); }
struct Unit { int pm, pn; };
struct Gemm { const bf16_t* A; const bf16_t* Bt; int M, N, K, lda; };
struct StaticOrder {
    int nM, nN, nwg, G, c;
    __host__ __device__ void init(int M, int N, int G_, int c_) { nM = M / BM; nN = N / BM; nwg = nM * nN; G = G_; c = c_; }
    __host__ __device__ bool next(int i, Unit& u) const {
        const long L = (long)i * G + c; if (L >= nwg) return false;
        int wgid = (int)L; { const int q = nwg / NXCD, r = nwg % NXCD, xcd = wgid % NXCD, off = wgid / NXCD; wgid = (xcd < r ? xcd * (q + 1) : r * (q + 1) + (xcd - r) * q) + off; }
        const int nig = WGM * nN, gid = wgid / nig, fm = gid * WGM, gsz = (nM - fm) < WGM ? (nM - fm) : WGM;
        u.pm = fm + ((wgid % nig) % gsz); u.pn = (wgid % nig) / gsz; return true;
    }
};
template <class F> struct Epi {
    F f;
    __device__ __forceinline__ void operator()(const f32x4 (&acc)[2][2][4][2], const Unit& u, int wr, int wc, int fr, int fq) const {
#pragma unroll
        for (int ai = 0; ai < 2; ++ai)
#pragma unroll
            for (int m = 0; m < 4; ++m)
#pragma unroll
                for (int bj = 0; bj < 2; ++bj)
                    f(u.pm * BM + ai * HALF + wr * 64 + m * 16 + fr, u.pn * BM + bj * HALF + wc * 32 + 8 * fq, acc[ai][bj][m][0], acc[ai][bj][m][1]);
    }
};
template <class E, class Sched>
__device__ __forceinline__ void gemm_phase(PG8_LAS unsigned char* lds, const Gemm g, const Sched& S, const E& Ep) {
    const int tid = tid_opaque(), wid = __builtin_amdgcn_readfirstlane(tid >> 6), lane = tid & 63, wr = wid >> 2, wc = wid & 3, fr = lane & 15, fq = lane >> 4;
    const int K = g.K, nt = K / BK;
    unsigned voffA[2], voffB[2];
#pragma unroll
    for (int i = 0; i < 2; ++i) { int R, C; stage_rc(tid * 16 + i * 8192, R, C); const int Rb = (R & ~31) + perm32(R & 31); voffA[i] = (unsigned)(R * g.lda + C) * 2u; voffB[i] = (unsigned)(Rb * K + C) * 2u; }
    const size_t kstep = (size_t)(BK * 2);
    const size_t hstep = (size_t)HALF * K * 2, hstepA = (size_t)HALF * g.lda * 2;
    const size_t tstep = 2 * hstep, tstepA = 2 * hstepA;
    const unsigned ldsw = (unsigned)wid * 1024u;
    const int aoff = lds_byte(wr * 64 + fr, fq * 8), boff = lds_byte(wc * 32 + fr, fq * 8);
#define PG8_SA(b, h) (((b) * 2 + (h)) * HTB)
#define PG8_SB(b, h) ((4 + (b) * 2 + (h)) * HTB)
#define PG8_STAGE(bufoff, gbase, voff) do { _Pragma("unroll") for (int _i = 0; _i < 2; ++_i) \
        __builtin_amdgcn_global_load_lds((const unsigned*)((const char*)(gbase) + (voff)[_i]), (PG8_LAS unsigned*)(lds + (bufoff) + ldsw + _i * 8192), 16, 0, 0); } while (0)
#define PG8_LDA(dst, b, h) do { _Pragma("unroll") for (int m = 0; m < 4; ++m) _Pragma("unroll") for (int k = 0; k < 2; ++k) dst[m][k] = *(const PG8_LAS bf16x8*)(lds + PG8_SA(b, h) + aoff + m * 2048 + k * 1024); } while (0)
#define PG8_LDB(dst, b, h) do { _Pragma("unroll") for (int n = 0; n < 2; ++n) _Pragma("unroll") for (int k = 0; k < 2; ++k) dst[n][k] = *(const PG8_LAS bf16x8*)(lds + PG8_SB(b, h) + boff + n * 2048 + k * 1024); } while (0)
#define PG8_MMA(ai, bj, At, Bt) do { __builtin_amdgcn_s_setprio(1); _Pragma("unroll") for (int m = 0; m < 4; ++m) _Pragma("unroll") for (int n = 0; n < 2; ++n) _Pragma("unroll") for (int k = 0; k < 2; ++k) \
        acc[ai][bj][m][n] = __builtin_amdgcn_mfma_f32_16x16x32_bf16(Bt[n][k], At[m][k], acc[ai][bj][m][n], 0, 0, 0); __builtin_amdgcn_s_setprio(0); } while (0)
#define PG8_WAIT_V(n) asm volatile("s_waitcnt vmcnt(" #n ")" ::: "memory")
#define PG8_WAIT_L(n) asm volatile("s_waitcnt lgkmcnt(" #n ")" ::: "memory")
#define PG8_BAR __builtin_amdgcn_s_barrier()
#define PG8_SCHED __builtin_amdgcn_sched_barrier(0)
    Unit cur, nxt; int ui = 0;
    if (!S.next(0, cur)) return;
    f32x4 acc[2][2][4][2];
#pragma unroll
    for (int a = 0; a < 2; ++a)
#pragma unroll
        for (int b = 0; b < 2; ++b)
#pragma unroll
            for (int m = 0; m < 4; ++m)
#pragma unroll
                for (int n = 0; n < 2; ++n) acc[a][b][m][n] = (f32x4){0.f, 0.f, 0.f, 0.f};
    bf16x8 At[4][2], B0[2][2], B1[2][2];
    const char* cA = (const char*)g.A + (size_t)cur.pm * tstepA; const char* cB = (const char*)g.Bt + (size_t)cur.pn * tstep;
    PG8_STAGE(PG8_SB(0, 0), cB, voffB); PG8_STAGE(PG8_SB(0, 1), cB + hstep, voffB); PG8_STAGE(PG8_SA(0, 0), cA, voffA); PG8_STAGE(PG8_SA(0, 1), cA + hstepA, voffA);
    if (wr == 1) PG8_BAR;
    PG8_WAIT_V(2); PG8_BAR;
    PG8_STAGE(PG8_SB(1, 0), cB + kstep, voffB); PG8_STAGE(PG8_SA(1, 0), cA + kstep, voffA); PG8_STAGE(PG8_SB(1, 1), cB + hstep + kstep, voffB);
    PG8_WAIT_V(6); PG8_BAR;
    for (;;) {
        const bool has_next = S.next(ui + 1, nxt);
        const char* nA = has_next ? (const char*)g.A + (size_t)nxt.pm * tstepA : cA; const char* nB = has_next ? (const char*)g.Bt + (size_t)nxt.pn * tstep : cB;
        for (int t = 0; t < nt; t += 2) {
            const bool last = (t == nt - 2);
            const char* a1 = cA + (size_t)(t + 1) * kstep;
            const char* a2 = last ? nA : cA + (size_t)(t + 2) * kstep; const char* b2 = last ? nB : cB + (size_t)(t + 2) * kstep;
            const char* a3 = a2 + kstep; const char* b3 = b2 + kstep;
            PG8_LDB(B0, 0, 0); PG8_LDB(B1, 0, 1); PG8_SCHED; PG8_LDA(At, 0, 0); PG8_STAGE(PG8_SA(1, 1), a1 + hstepA, voffA);
            PG8_WAIT_V(8); PG8_WAIT_L(0); PG8_BAR; PG8_MMA(0, 0, At, B0); PG8_MMA(0, 1, At, B1); PG8_BAR; PG8_SCHED;
            PG8_LDA(At, 0, 1); PG8_STAGE(PG8_SB(0, 0), b2, voffB); PG8_STAGE(PG8_SB(0, 1), b2 + hstep, voffB); PG8_STAGE(PG8_SA(0, 0), a2, voffA);
            PG8_WAIT_V(8); PG8_WAIT_L(0); PG8_BAR; PG8_MMA(1, 0, At, B0); PG8_MMA(1, 1, At, B1); PG8_BAR; PG8_SCHED;
            PG8_LDB(B0, 1, 0); PG8_LDB(B1, 1, 1); PG8_SCHED; PG8_LDA(At, 1, 0); PG8_STAGE(PG8_SA(0, 1), a2 + hstepA, voffA);
            PG8_WAIT_V(8); PG8_WAIT_L(0); PG8_BAR; PG8_MMA(0, 0, At, B0); PG8_MMA(0, 1, At, B1); PG8_BAR; PG8_SCHED;
            PG8_LDA(At, 1, 1); PG8_STAGE(PG8_SB(1, 0), b3, voffB); PG8_STAGE(PG8_SB(1, 1), b3 + hstep, voffB); PG8_STAGE(PG8_SA(1, 0), a3, voffA);
            PG8_WAIT_V(8); PG8_WAIT_L(0); PG8_BAR; PG8_MMA(1, 0, At, B0); PG8_MMA(1, 1, At, B1); PG8_BAR; PG8_SCHED;
        }
        if (wr == 0) PG8_BAR;
        Ep(acc, cur, wr, wc, fr, fq);
        if (!has_next) break;
#pragma unroll
        for (int a = 0; a < 2; ++a)
#pragma unroll
            for (int b = 0; b < 2; ++b)
#pragma unroll
                for (int m = 0; m < 4; ++m)
#pragma unroll
                    for (int n = 0; n < 2; ++n) acc[a][b][m][n] = (f32x4){0.f, 0.f, 0.f, 0.f};
        cur = nxt; cA = nA; cB = nB; ++ui;
        if (wr == 1) PG8_BAR;
    }
    PG8_WAIT_V(0);
    PG8_BAR;
#undef PG8_SA
#undef PG8_SB
#undef PG8_STAGE
#undef PG8_LDA
#undef PG8_LDB
#undef PG8_MMA
#undef PG8_WAIT_V
#undef PG8_WAIT_L
#undef PG8_BAR
#undef PG8_SCHED
}
}

__device__ __forceinline__ u32x4 pack8(f32x4 a, f32x4 b) { u32x4 o; o.x = pack2(a.x, a.y); o.y = pack2(a.z, a.w); o.z = pack2(b.x, b.y); o.w = pack2(b.z, b.w); return o; }
struct EpInProj { bf16_t* proj; bf16_t* qrope; bf16_t* kvp; float* small; const float2* rope; const float* dt_bias;
    __device__ __forceinline__ void operator()(int m, int n0, f32x4 a, f32x4 b) const {
        if (n0 < 2816) {
            const bool is_q = n0 < 512;
            const bool roped_seg = is_q || (n0 >= C_KSEL && n0 < C_VSEL) || (n0 >= C_KWIN && n0 < C_VWIN);
            if (is_q) *(u32x4*)(proj + (size_t)m * PROJ_LD + n0) = pack8(a, b);
            if (roped_seg && (n0 & 32) == 0) {
                f32x4 pa, pb;
                pa.x = __shfl_xor(a.x, 16); pa.y = __shfl_xor(a.y, 16); pa.z = __shfl_xor(a.z, 16); pa.w = __shfl_xor(a.w, 16);
                pb.x = __shfl_xor(b.x, 16); pb.y = __shfl_xor(b.y, 16); pb.z = __shfl_xor(b.z, 16); pb.w = __shfl_xor(b.w, 16);
                if ((n0 & 63) < 16) {
                    const float sgn = (n0 & 8) ? 1.f : -1.f;
                    const f32x4* rp = (const f32x4*)(rope + (m & (SEQ - 1)) * 8);
                    const f32x4 c01 = rp[0], c23 = rp[1], c45 = rp[2], c67 = rp[3];
                    a.x = a.x * c01.x + sgn * pa.x * c01.y; a.y = a.y * c01.z + sgn * pa.y * c01.w;
                    a.z = a.z * c23.x + sgn * pa.z * c23.y; a.w = a.w * c23.z + sgn * pa.w * c23.w;
                    b.x = b.x * c45.x + sgn * pb.x * c45.y; b.y = b.y * c45.z + sgn * pb.y * c45.w;
                    b.z = b.z * c67.x + sgn * pb.z * c67.y; b.w = b.w * c67.z + sgn * pb.w * c67.w;
                }
            }
            const u32x4 o = pack8(a, b);
            if (is_q) *(u32x4*)(qrope + (size_t)m * 512 + n0) = o;
            else if (n0 < C_Z) {
                const int r = n0 - C_KCMP, seg = r >> 7, g = (r >> 6) & 1, d = r & 63, bb = m >> 13, t = m & (SEQ - 1);
                *(u32x4*)(kvp + (size_t)seg * KVP_SEG + ((size_t)(bb * 2 + g) * SEQ + t) * 64 + d) = o;
            }
            else *(u32x4*)(proj + (size_t)m * PROJ_LD + n0) = o;
        } else if (n0 < 2848) {
            const int c = n0 - 2816; f32x4 o0, o1;
            if (c < 24) { o0.x = sigmoidf(a.x); o0.y = sigmoidf(a.y); o0.z = sigmoidf(a.z); o0.w = sigmoidf(a.w); o1.x = sigmoidf(b.x); o1.y = sigmoidf(b.y); o1.z = sigmoidf(b.z); o1.w = sigmoidf(b.w); }
            else { const float* db = dt_bias; o0.x = softplusf(a.x + db[0]); o0.y = softplusf(a.y + db[1]); o0.z = softplusf(a.z + db[2]); o0.w = softplusf(a.w + db[3]);
                   o1.x = softplusf(b.x + db[4]); o1.y = softplusf(b.y + db[5]); o1.z = softplusf(b.z + db[6]); o1.w = softplusf(b.w + db[7]); }
            *(f32x4*)(small + (size_t)m * 32 + c) = o0; *(f32x4*)(small + (size_t)m * 32 + c + 4) = o1;
        }
    } };
struct EpCmpHid { bf16_t* hid; const float* bias;
    __device__ __forceinline__ void operator()(int m, int n0, f32x4 a, f32x4 b) const {
        const f32x4 b0 = *(const f32x4*)(bias + n0), b1 = *(const f32x4*)(bias + n0 + 4);
        a.x = gelu_tanh(a.x + b0.x); a.y = gelu_tanh(a.y + b0.y); a.z = gelu_tanh(a.z + b0.z); a.w = gelu_tanh(a.w + b0.w);
        b.x = gelu_tanh(b.x + b1.x); b.y = gelu_tanh(b.y + b1.y); b.z = gelu_tanh(b.z + b1.z); b.w = gelu_tanh(b.w + b1.w);
        *(u32x4*)(hid + (size_t)m * 256 + n0) = pack8(a, b);
    } };
struct EpOutProj { const float* x; const float* mod; float* x1;
    __device__ __forceinline__ void operator()(int m, int n0, f32x4 a, f32x4 b) const {
        const int bb = m >> 13;
        const f32x4 x0 = *(const f32x4*)(x + (size_t)m * DM + n0), x4 = *(const f32x4*)(x + (size_t)m * DM + n0 + 4);
        const f32x4 g0 = *(const f32x4*)(mod + bb * 6144 + 2048 + n0), g4 = *(const f32x4*)(mod + bb * 6144 + 2048 + n0 + 4);
        *(f32x4*)(x1 + (size_t)m * DM + n0) = x0 + g0 * a;
        *(f32x4*)(x1 + (size_t)m * DM + n0 + 4) = x4 + g4 * b;
    } };
struct EpStoreBf16 { bf16_t* out; int ld; int pad;
    __device__ __forceinline__ void operator()(int m, int n0, f32x4 a, f32x4 b) const { *(u32x4*)(out + (size_t)m * ld + n0) = pack8(a, b); } };

__device__ __forceinline__ void d_cmp_out(const bf16_t* __restrict__ hid, const float* __restrict__ w2, bf16_t* __restrict__ out, int vb) {
    const int tid_ = tid_opaque(); const int m = vb * 8 + (tid_ >> 6), d = tid_ & 63;
    float a = 0.f;
#pragma unroll 8
    for (int j = 0; j < 256; ++j) a += bf2f(hid[(size_t)m * 256 + j]) * w2[j * 64 + d];
    out[(size_t)m * 64 + d] = f2bf(a);
}

#define KLD 80
#define NSA_OFF_KS0  0
#define NSA_OFF_VT0  10240
#define NSA_OFF_KS1  20480
#define NSA_OFF_VT1  30720
#define NSA_OFF_IMP  40960
#define NSA_OFF_SELW 74752
#define NSA_OFF_ANYW 75776
#define NSA_OFF_BL   75808
#define NSA_OFF_QS   76352
#define NSA_LDS      (76352 + 8 * 32 * KLD * 2)
#define SM_C 0.18033688011112042f

struct KVStage { u32x4 k, v; };
__device__ __forceinline__ void nsa_stage_load(KVStage& st, const bf16_t* kb, const bf16_t* vb, int tid) {
    st.k = *(const u32x4*)(kb + tid * 8); st.v = *(const u32x4*)(vb + tid * 8);
}
__device__ __forceinline__ void nsa_stage_store(bf16_t* Ks, bf16_t* Vt, int tid, const KVStage& st) {
    const int r = tid >> 3, c = tid & 7;
    *(u32x4*)(Ks + r * KLD + c * 8) = st.k;
    *(u32x4*)(Vt + r * KLD + c * 8) = st.v;
}
__device__ __forceinline__ void nsa_load_q(const bf16_t* qsrc, size_t ld, int lane, bf16_t* Qs) {
    u32x4 r[4];
#pragma unroll
    for (int i = 0; i < 4; ++i) { const int p = lane + 64 * i; r[i] = *(const u32x4*)(qsrc + (size_t)(p >> 3) * ld + (p & 7) * 8); }
#pragma unroll
    for (int i = 0; i < 4; ++i) { const int p = lane + 64 * i; *(u32x4*)(Qs + (p >> 3) * KLD + (p & 7) * 8) = r[i]; }
}
__device__ __forceinline__ void nsa_qk(const bf16_t* Ks, const bf16_t* Qs, f32x4 (&s)[4][2], int fr, int fq) {
#pragma unroll
    for (int kt = 0; kt < 4; ++kt)
#pragma unroll
        for (int tt = 0; tt < 2; ++tt) s[kt][tt] = (f32x4){0.f, 0.f, 0.f, 0.f};
#pragma unroll
    for (int ks = 0; ks < 2; ++ks) {
        bf16x8 qf[2];
#pragma unroll
        for (int tt = 0; tt < 2; ++tt) qf[tt] = *(const bf16x8*)(Qs + (tt * 16 + fr) * KLD + ks * 32 + fq * 8);
#pragma unroll
        for (int kt = 0; kt < 4; ++kt) {
            const bf16x8 kf = *(const bf16x8*)(Ks + (kt * 16 + fr) * KLD + ks * 32 + fq * 8);
#pragma unroll
            for (int tt = 0; tt < 2; ++tt) s[kt][tt] = __builtin_amdgcn_mfma_f32_16x16x32_bf16(kf, qf[tt], s[kt][tt], 0, 0, 0);
        }
    }
}
__device__ __forceinline__ void nsa_pv(const bf16_t* Vt, const f32x4 (&p)[4][2], f32x4 (&o)[4][2], int fr, int fq) {
#pragma unroll
    for (int ks2 = 0; ks2 < 2; ++ks2) {
        bf16x8 pf[2];
#pragma unroll
        for (int tt = 0; tt < 2; ++tt) {
            const f32x4 a = p[2 * ks2][tt], b = p[2 * ks2 + 1][tt];
            u32x4 w; w.x = pack2(a.x, a.y); w.y = pack2(a.z, a.w); w.z = pack2(b.x, b.y); w.w = pack2(b.z, b.w);
            pf[tt] = __builtin_bit_cast(bf16x8, w);
        }
#pragma unroll
        for (int dt = 0; dt < 4; ++dt) {
            typedef short s16x4 __attribute__((ext_vector_type(4)));
            const bf16_t* vp = Vt + (ks2 * 32 + 4 * fq + (fr >> 2)) * KLD + dt * 16 + 4 * (fr & 3);
            const s16x4 a0 = __builtin_amdgcn_ds_read_tr16_b64_v4i16((__attribute__((address_space(3))) s16x4*)vp);
            const s16x4 a1 = __builtin_amdgcn_ds_read_tr16_b64_v4i16((__attribute__((address_space(3))) s16x4*)(vp + 16 * KLD));
            const bf16x8 vf = (bf16x8){a0.x, a0.y, a0.z, a0.w, a1.x, a1.y, a1.z, a1.w};
#pragma unroll
            for (int tt = 0; tt < 2; ++tt) o[dt][tt] = __builtin_amdgcn_mfma_f32_16x16x32_bf16(vf, pf[tt], o[dt][tt], 0, 0, 0);
        }
    }
}
template <int MK>
__device__ __forceinline__ bool nsa_valid(int kk, int ti, int n0, int t0) {
    if (MK == 1) return kk <= ti;
    if (MK == 2) return kk > ti;
    return 16 * (n0 + kk) + 31 <= t0 + ti;
}
template <int MK, bool WITH_O>
__device__ __forceinline__ void nsa_softmax(f32x4 (&s)[4][2], float (&m)[2], float (&l)[2], f32x4 (&o)[4][2], const bool (&selb)[2], int tib, int fq, int n0, int t0) {
#pragma unroll
    for (int tt = 0; tt < 2; ++tt) {
        const int ti = tib + tt * 16;
        float mx = -1e30f;
#pragma unroll
        for (int kt = 0; kt < 4; ++kt)
#pragma unroll
            for (int jj = 0; jj < 4; ++jj) {
                const int kk = kt * 16 + 4 * fq + jj;
                const bool v = selb[tt] && nsa_valid<MK>(kk, ti, n0, t0);
                const float sv = v ? s[kt][tt][jj] * SM_C : -1e30f;
                s[kt][tt][jj] = sv; mx = fmaxf(mx, sv);
            }
        mx = fmaxf(mx, __shfl_xor(mx, 16)); mx = fmaxf(mx, __shfl_xor(mx, 32));
        const float mn = fmaxf(m[tt], mx);
        const float alpha = __builtin_amdgcn_exp2f(m[tt] - mn);
        m[tt] = mn;
        float ls = 0.f;
#pragma unroll
        for (int kt = 0; kt < 4; ++kt)
#pragma unroll
            for (int jj = 0; jj < 4; ++jj) {
                const float sv = s[kt][tt][jj];
                const float pv = sv > -1e29f ? __builtin_amdgcn_exp2f(sv - mn) : 0.f;
                s[kt][tt][jj] = pv; ls += pv;
            }
        l[tt] = l[tt] * alpha + ls;
        if (WITH_O) {
#pragma unroll
            for (int dt = 0; dt < 4; ++dt) o[dt][tt] *= alpha;
        }
    }
}
template <bool WITH_O = true>
__device__ __forceinline__ void nsa_softmax_fast(f32x4 (&s)[4][2], float (&m)[2], float (&l)[2], f32x4 (&o)[4][2], const float (&bias)[2]) {
#pragma unroll
    for (int tt = 0; tt < 2; ++tt) {
        float mr = fmaxf(fmaxf(s[0][tt][0], s[0][tt][1]), fmaxf(s[0][tt][2], s[0][tt][3]));
#pragma unroll
        for (int kt = 1; kt < 4; ++kt) mr = fmaxf(mr, fmaxf(fmaxf(s[kt][tt][0], s[kt][tt][1]), fmaxf(s[kt][tt][2], s[kt][tt][3])));
        mr = fmaxf(mr, __shfl_xor(mr, 16)); mr = fmaxf(mr, __shfl_xor(mr, 32));
        const float mx = mr * SM_C + bias[tt];
        const float mold = m[tt], mn = fmaxf(mold, mx);
        m[tt] = mn;
        const float off = bias[tt] - mn;
        float ls = 0.f;
#pragma unroll
        for (int kt = 0; kt < 4; ++kt)
#pragma unroll
            for (int jj = 0; jj < 4; ++jj) { const float pv = __builtin_amdgcn_exp2f(__builtin_fmaf(s[kt][tt][jj], SM_C, off)); s[kt][tt][jj] = pv; ls += pv; }
        if (__builtin_amdgcn_ballot_w64(mn > mold) != 0ull) {
            const float alpha = __builtin_amdgcn_exp2f(mold - mn);
            l[tt] = l[tt] * alpha + ls;
            if (WITH_O) {
#pragma unroll
                for (int dt = 0; dt < 4; ++dt) o[dt][tt] *= alpha;
            }
        } else l[tt] += ls;
    }
}
__device__ __forceinline__ void ins16(unsigned (&L)[16], unsigned x) {
#pragma unroll
    for (int i = 0; i < 16; ++i) { const unsigned hi = L[i] > x ? L[i] : x; x = L[i] > x ? x : L[i]; L[i] = hi; }
}
__device__ __forceinline__ void merge16(unsigned (&L)[16], const unsigned (&P)[16]) {
#pragma unroll
    for (int i = 0; i < 16; ++i) L[i] = L[i] > P[15 - i] ? L[i] : P[15 - i];
#pragma unroll
    for (int st = 8; st >= 1; st >>= 1)
#pragma unroll
        for (int i = 0; i < 16; ++i)
            if ((i & st) == 0) { const unsigned a = L[i], b = L[i + st]; L[i] = a > b ? a : b; L[i + st] = a > b ? b : a; }
}
__device__ __forceinline__ void sort16(unsigned (&v)[16]) {
#pragma unroll
    for (int k = 2; k <= 16; k <<= 1)
#pragma unroll
        for (int j = k >> 1; j > 0; j >>= 1)
#pragma unroll
            for (int i = 0; i < 16; ++i) {
                const int l = i ^ j;
                if (l > i) {
                    const unsigned a = v[i], b = v[l];
                    const unsigned hi = a > b ? a : b, lo = a > b ? b : a;
                    if ((i & k) == 0) { v[i] = hi; v[l] = lo; } else { v[i] = lo; v[l] = hi; }
                }
            }
}
template <bool ACCUM>
__device__ __forceinline__ void nsa_emit(const f32x4 (&o)[4][2], const float (&l)[2], bool l_is_partial, const float* gsrc, float* obase, int tib, int fq) {
#pragma unroll
    for (int tt = 0; tt < 2; ++tt) {
        float lt = l[tt];
        if (l_is_partial) { lt += __shfl_xor(lt, 16); lt += __shfl_xor(lt, 32); }
        const int ti = tib + tt * 16;
        const float gv = gsrc[(size_t)ti * 32];
        const float sc = l_is_partial ? (lt > 0.f ? gv / lt : 0.f) : gv;
#pragma unroll
        for (int dt = 0; dt < 4; ++dt) {
            float* op = obase + (size_t)ti * 512 + dt * 16 + 4 * fq;
            f32x4 v = o[dt][tt] * sc;
            if (ACCUM) v += *(const f32x4*)op;
            *(f32x4*)op = v;
        }
    }
}
struct NsaBufs { bf16_t *Ks0, *Vt0, *Ks1, *Vt1; };
template <class SRC, class BODY>
__device__ __forceinline__ void nsa_pipeline(int n, const bf16_t* kb, const bf16_t* vb, const NsaBufs& B, int tid, SRC src, BODY body) {
    KVStage s0, s1;
    nsa_stage_load(s0, kb + (size_t)src(0) * 4096, vb + (size_t)src(0) * 4096, tid);
    s1 = s0;
    if (n > 1) nsa_stage_load(s1, kb + (size_t)src(1) * 4096, vb + (size_t)src(1) * 4096, tid);
    __syncthreads();
    nsa_stage_store(B.Ks0, B.Vt0, tid, s0);
    if (n > 2) nsa_stage_load(s0, kb + (size_t)src(2) * 4096, vb + (size_t)src(2) * 4096, tid);
#pragma unroll 1
    for (int i = 0; i < n; i += 2) {
        __syncthreads();
        if (i + 1 < n) nsa_stage_store(B.Ks1, B.Vt1, tid, s1);
        if (i + 3 < n) nsa_stage_load(s1, kb + (size_t)src(i + 3) * 4096, vb + (size_t)src(i + 3) * 4096, tid);
        body(src(i), B.Ks0, B.Vt0);
        if (i + 1 < n) {
            __syncthreads();
            if (i + 2 < n) nsa_stage_store(B.Ks0, B.Vt0, tid, s0);
            if (i + 4 < n) nsa_stage_load(s0, kb + (size_t)src(i + 4) * 4096, vb + (size_t)src(i + 4) * 4096, tid);
            body(src(i + 1), B.Ks1, B.Vt1);
        }
    }
}

__device__ __forceinline__ void d_nsa_cmp(const bf16_t* __restrict__ proj, const bf16_t* __restrict__ kc, const bf16_t* __restrict__ vc,
                                          const float* __restrict__ small, float* __restrict__ onsa, unsigned* __restrict__ selrec, int b, int g, int qt, char* lds) {
    const NsaBufs B{(bf16_t*)(lds + NSA_OFF_KS0), (bf16_t*)(lds + NSA_OFF_VT0), (bf16_t*)(lds + NSA_OFF_KS1), (bf16_t*)(lds + NSA_OFF_VT1)};
    float* imp = (float*)(lds + NSA_OFF_IMP);
    unsigned* selw = (unsigned*)(lds + NSA_OFF_SELW);
    unsigned* anyw = (unsigned*)(lds + NSA_OFF_ANYW);
    int* blist = (int*)(lds + NSA_OFF_BL);
    const int tid = tid_opaque(), lane = tid & 63, w = tid >> 6, hd = w & 3, th = w >> 2, fr = lane & 15, fq = lane >> 4;
    const int tib = th * 32 + fr;
    const size_t tok0 = (size_t)b * SEQ + (size_t)qt * 64;
    const int t0 = qt * 64;
    const float* gbase = small + tok0 * 32 + g * 12 + hd * 3;
    float* obase = onsa + tok0 * 512 + g * 256 + hd * 64;
    const bool sel_all[2] = {true, true};
    const float bias0[2] = {0.f, 0.f};

    for (int i = tid; i < 64 * 132; i += 512) imp[i] = 0.f;
    if (tid < 4) anyw[tid] = 0u;

    bf16_t* Qs = (bf16_t*)(lds + NSA_OFF_QS) + w * 32 * KLD;
    f32x4 s[4][2], o[4][2];
    float m[2], l[2];

    nsa_load_q(proj + (tok0 + th * 32) * PROJ_LD + C_Q + g * 256 + hd * 64, PROJ_LD, lane, Qs);
    const int ncb = (4 * qt + 3 + 63) >> 6;
    {
        const bf16_t* kb = kc + (size_t)(b * 2 + g) * 512 * 64;
        const bf16_t* vb = vc + (size_t)(b * 2 + g) * 512 * 64;
#pragma unroll
        for (int tt = 0; tt < 2; ++tt) { m[tt] = -1e30f; l[tt] = 0.f; }
        nsa_pipeline(ncb, kb, vb, B, tid, [&](int i) { return i; }, [&](int blk_, bf16_t* Ks, bf16_t* Vt) {
            nsa_qk(Ks, Qs, s, fr, fq);
            if (16 * (blk_ * 64 + 63) + 31 <= t0) nsa_softmax_fast<false>(s, m, l, o, bias0);
            else nsa_softmax<3, false>(s, m, l, o, sel_all, tib, fq, blk_ * 64, t0);
        });
        float linv[2];
#pragma unroll
        for (int tt = 0; tt < 2; ++tt) { float lt = l[tt]; lt += __shfl_xor(lt, 16); lt += __shfl_xor(lt, 32); linv[tt] = lt > 0.f ? 1.0f / lt : 0.f; }
#pragma unroll
        for (int dt = 0; dt < 4; ++dt)
#pragma unroll
            for (int tt = 0; tt < 2; ++tt) o[dt][tt] = (f32x4){0.f, 0.f, 0.f, 0.f};
        nsa_pipeline(ncb, kb, vb, B, tid, [&](int i) { return i; }, [&](int blk_, bf16_t* Ks, bf16_t* Vt) {
            nsa_qk(Ks, Qs, s, fr, fq);
            const bool full = 16 * (blk_ * 64 + 63) + 31 <= t0;
#pragma unroll
            for (int tt = 0; tt < 2; ++tt) {
                const int ti = tib + tt * 16;
                const float nm = -m[tt], li = linv[tt];
                float hs[4], as[4];
#pragma unroll
                for (int kt = 0; kt < 4; ++kt) {
                    f32x4 pv;
                    if (full) {
#pragma unroll
                        for (int jj = 0; jj < 4; ++jj) pv[jj] = __builtin_amdgcn_exp2f(__builtin_fmaf(s[kt][tt][jj], SM_C, nm)) * li;
                    } else {
#pragma unroll
                        for (int jj = 0; jj < 4; ++jj) {
                            const int kk = kt * 16 + 4 * fq + jj;
                            pv[jj] = nsa_valid<3>(kk, ti, blk_ * 64, t0) ? __builtin_amdgcn_exp2f(__builtin_fmaf(s[kt][tt][jj], SM_C, nm)) * li : 0.f;
                        }
                    }
                    s[kt][tt] = pv;
                    hs[kt] = 0.5f * pv[3]; as[kt] = pv[0] + pv[1] + pv[2] + hs[kt];
                }
                float r1[4];
#pragma unroll
                for (int kt = 0; kt < 4; ++kt) r1[kt] = __shfl(hs[kt], (lane + 48) & 63);
#pragma unroll
                for (int kt = 0; kt < 4; ++kt) {
                    const float recv = fq > 0 ? r1[kt] : (kt > 0 ? r1[kt - 1] : 0.f);
                    const int j = blk_ * 16 + kt * 4 + fq;
                    atomicAdd(imp + ti * 132 + (j >> 5) * 33 + (j & 31), as[kt] + recv);
                }
                if (fq == 3) { const int j1 = blk_ * 16 + 16; if (j1 < 128) atomicAdd(imp + ti * 132 + (j1 >> 5) * 33 + (j1 & 31), hs[3]); }
            }
            nsa_pv(Vt, s, o, fr, fq);
        });
        nsa_emit<false>(o, l, false, gbase + 0, obase, tib, fq);
    }
    __syncthreads();
    {
        const int ti = tid >> 3, q8 = tid & 7;
        unsigned L[16];
#pragma unroll
        for (int i = 0; i < 16; ++i) {
            const int j = q8 * 16 + i;
            const bool forced = (j == 0) || (j == qt) || (j == qt - 1);
            const float v = imp[ti * 132 + (j >> 5) * 33 + (j & 31)] + (forced ? 1e4f : 0.f) + 1e-30f;
            L[i] = (j <= qt) ? ((__float_as_uint(v) & ~0x7Fu) | (unsigned)(127 - j)) : 0u;
        }
        sort16(L);
#pragma unroll
        for (int r = 1; r <= 4; r <<= 1) {
            unsigned P[16];
#pragma unroll
            for (int i = 0; i < 16; ++i) P[i] = (unsigned)__shfl_xor((int)L[i], r);
            merge16(L, P);
        }
        if (q8 < 4) {
            unsigned word = 0u;
#pragma unroll
            for (int i = 0; i < 16; ++i) {
                const unsigned e = L[i];
                const int j = 127 - (int)(e & 0x7Fu);
                if (e != 0u && (j >> 5) == q8) word |= 1u << (j & 31);
            }
            selw[ti * 4 + q8] = word;
            atomicOr(&anyw[q8], word);
        }
    }
    __syncthreads();
    int nsel;
    {
        const unsigned a0 = anyw[0], a1 = anyw[1], a2 = anyw[2], a3 = anyw[3];
        if (tid < 128) {
            const unsigned wd = tid < 32 ? a0 : tid < 64 ? a1 : tid < 96 ? a2 : a3;
            if ((wd >> (tid & 31)) & 1u) {
                int pos = __popc(wd & ((1u << (tid & 31)) - 1u));
                if (tid >= 32) pos += __popc(a0);
                if (tid >= 64) pos += __popc(a1);
                if (tid >= 96) pos += __popc(a2);
                blist[pos] = tid;
            }
        }
        nsel = __builtin_amdgcn_readfirstlane(__popc(a0) + __popc(a1) + __popc(a2) + __popc(a3));
    }
    __syncthreads();
    if (tid < 256) selrec[tid] = selw[tid];
    if (tid < 128) selrec[256 + tid] = (unsigned)blist[tid];
    if (tid == 0) selrec[384] = (unsigned)nsel;
    __syncthreads();
}

__device__ __forceinline__ void d_nsa_attn(const bf16_t* __restrict__ qrope, const bf16_t* __restrict__ kvp, const float* __restrict__ small, float* __restrict__ onsa,
                                           const unsigned* __restrict__ selrec, int b, int g, int qt, char* lds) {
    const NsaBufs B{(bf16_t*)(lds + NSA_OFF_KS0), (bf16_t*)(lds + NSA_OFF_VT0), (bf16_t*)(lds + NSA_OFF_KS1), (bf16_t*)(lds + NSA_OFF_VT1)};
    unsigned* selw = (unsigned*)(lds + NSA_OFF_SELW);
    int* blist = (int*)(lds + NSA_OFF_BL);
    const int tid = tid_opaque(), lane = tid & 63, w = tid >> 6, hd = w & 3, th = w >> 2, fr = lane & 15, fq = lane >> 4;
    const int tib = th * 32 + fr;
    const size_t tok0 = (size_t)b * SEQ + (size_t)qt * 64;
    const float* gbase = small + tok0 * 32 + g * 12 + hd * 3;
    float* obase = onsa + tok0 * 512 + g * 256 + hd * 64;
    const bool sel_all[2] = {true, true};
    const float bias0[2] = {0.f, 0.f};
    bf16_t* Qs = (bf16_t*)(lds + NSA_OFF_QS) + w * 32 * KLD;
    f32x4 s[4][2], o[4][2];
    float m[2], l[2];
    if (tid < 256) selw[tid] = selrec[tid];
    if (tid < 128) blist[tid] = (int)selrec[256 + tid];
    const int nsel = __builtin_amdgcn_readfirstlane((int)selrec[384]);
    __syncthreads();
    nsa_load_q(qrope + (tok0 + th * 32) * 512 + g * 256 + hd * 64, 512, lane, Qs);
    {
        const bf16_t* kb = kvp + 2 * KVP_SEG + (size_t)(b * 2 + g) * SEQ * 64;
        const bf16_t* vb = kvp + 3 * KVP_SEG + (size_t)(b * 2 + g) * SEQ * 64;
#pragma unroll
        for (int tt = 0; tt < 2; ++tt) { m[tt] = -1e30f; l[tt] = 0.f; }
#pragma unroll
        for (int dt = 0; dt < 4; ++dt)
#pragma unroll
            for (int tt = 0; tt < 2; ++tt) o[dt][tt] = (f32x4){0.f, 0.f, 0.f, 0.f};
        nsa_pipeline(nsel, kb, vb, B, tid, [&](int i) { return __builtin_amdgcn_readfirstlane(blist[i]); }, [&](int blk_, bf16_t* Ks, bf16_t* Vt) {
            nsa_qk(Ks, Qs, s, fr, fq);
            bool selb[2];
#pragma unroll
            for (int tt = 0; tt < 2; ++tt) selb[tt] = (selw[(tib + tt * 16) * 4 + (blk_ >> 5)] >> (blk_ & 31)) & 1u;
            if (blk_ == qt) nsa_softmax<1, true>(s, m, l, o, selb, tib, fq, 0, 0);
            else {
                float bias[2];
#pragma unroll
                for (int tt = 0; tt < 2; ++tt) bias[tt] = selb[tt] ? 0.f : -1e30f;
                nsa_softmax_fast(s, m, l, o, bias);
            }
            nsa_pv(Vt, s, o, fr, fq);
        });
        nsa_emit<true>(o, l, true, gbase + 1, obase, tib, fq);
    }
    {
        const bf16_t* kb = kvp + 4 * KVP_SEG + (size_t)(b * 2 + g) * SEQ * 64;
        const bf16_t* vb = kvp + 5 * KVP_SEG + (size_t)(b * 2 + g) * SEQ * 64;
#pragma unroll
        for (int tt = 0; tt < 2; ++tt) { m[tt] = -1e30f; l[tt] = 0.f; }
#pragma unroll
        for (int dt = 0; dt < 4; ++dt)
#pragma unroll
            for (int tt = 0; tt < 2; ++tt) o[dt][tt] = (f32x4){0.f, 0.f, 0.f, 0.f};
        const int j0 = qt >= 8 ? qt - 8 : 0;
        nsa_pipeline(qt - j0 + 1, kb, vb, B, tid, [&](int i) { return j0 + i; }, [&](int blk_, bf16_t* Ks, bf16_t* Vt) {
            nsa_qk(Ks, Qs, s, fr, fq);
            if (blk_ == qt) nsa_softmax<1, true>(s, m, l, o, sel_all, tib, fq, 0, 0);
            else if (blk_ == qt - 8) nsa_softmax<2, true>(s, m, l, o, sel_all, tib, fq, 0, 0);
            else nsa_softmax_fast(s, m, l, o, bias0);
            nsa_pv(Vt, s, o, fr, fq);
        });
        nsa_emit<true>(o, l, true, gbase + 2, obase, tib, fq);
    }
    __syncthreads();
}

#define SSD_P 136
#define S3_XST 0
#define S3_BC  69632
#define S3_CC  104448
#define S3_ACS 139264
#define S3_DT  141312
#define S3_END 143360

__device__ __forceinline__ void ssd_acs(const float* __restrict__ small, const float* __restrict__ a_log, size_t tok0, int g, float* acs, float* dtl, int tid) {
    const int w = tid >> 6, lane = tid & 63, hh = 4 * g + (w & 3);
    if (w < 4) {
        const float a = -__expf(a_log[hh]);
        const float d0 = small[(tok0 + 2 * lane) * 32 + 24 + hh], d1 = small[(tok0 + 2 * lane + 1) * 32 + 24 + hh];
        const float s0 = d0 * a, s1 = s0 + d1 * a;
        float tot = s1;
#pragma unroll
        for (int off = 1; off < 64; off <<= 1) { const float t = __shfl_up(tot, off); if (lane >= off) tot += t; }
        const float excl = tot - s1;
        acs[w * 128 + 2 * lane] = excl + s0; acs[w * 128 + 2 * lane + 1] = excl + s1;
        dtl[w * 128 + 2 * lane] = d0; dtl[w * 128 + 2 * lane + 1] = d1;
    }
}
struct ConvCh { float w0, w1, w2, w3, bias, h0, h1, h2; };
__device__ __forceinline__ void conv_init(ConvCh& cc, const float* __restrict__ conv_w, const float* __restrict__ conv_b, int ch, const bf16_t* pb, int c) {
    cc.w0 = conv_w[ch]; cc.w1 = conv_w[1024 + ch]; cc.w2 = conv_w[2048 + ch]; cc.w3 = conv_w[3072 + ch]; cc.bias = conv_b[ch];
    if (c > 0) { cc.h0 = bf2f(pb[-3 * PROJ_LD]); cc.h1 = bf2f(pb[-2 * PROJ_LD]); cc.h2 = bf2f(pb[-1 * PROJ_LD]); } else { cc.h0 = 0.f; cc.h1 = 0.f; cc.h2 = 0.f; }
}
__device__ __forceinline__ float conv_step(ConvCh& cc, float x) {
    const float v = cc.bias + cc.w0 * cc.h0 + cc.w1 * cc.h1 + cc.w2 * cc.h2 + cc.w3 * x;
    cc.h0 = cc.h1; cc.h1 = cc.h2; cc.h2 = x;
    return silu(v);
}

__device__ __forceinline__ void d_ssd_states(const bf16_t* __restrict__ proj, const float* __restrict__ small, const float* __restrict__ conv_w, const float* __restrict__ conv_b,
                                             const float* __restrict__ a_log, float* __restrict__ states, float* __restrict__ cdec, int item, char* lds) {
    const int tid = tid_opaque(), lane = tid & 63, w = tid >> 6, fr = lane & 15, fq = lane >> 4;
    const int b = item >> 7, c = (item >> 1) & 63, g = item & 1;
    bf16_t* XwT = (bf16_t*)(lds + S3_XST); bf16_t* BcT = (bf16_t*)(lds + S3_BC);
    float* acs = (float*)(lds + S3_ACS); float* dtl = (float*)(lds + S3_DT);
    const size_t tok0 = (size_t)b * SEQ + (size_t)c * 128;
    ssd_acs(small, a_log, tok0, g, acs, dtl, tid);
    __syncthreads();
    if (tid < 384) {
        const bool isx = tid < 256;
        const int ch = isx ? g * 256 + tid : 512 + g * 128 + (tid - 256);
        const bf16_t* px = proj + tok0 * PROJ_LD + C_XBC + ch;
        ConvCh cx; conv_init(cx, conv_w, conv_b, ch, px, c);
        const int hw = w & 3;
        const float alast = acs[hw * 128 + 127];
        bf16_t* dst = isx ? XwT + tid * SSD_P : BcT + (tid - 256) * SSD_P;
        for (int l0 = 0; l0 < 128; l0 += 32) {
            float rx[32];
#pragma unroll
            for (int i = 0; i < 32; ++i) rx[i] = bf2f(px[(size_t)(l0 + i) * PROJ_LD]);
#pragma unroll
            for (int i8 = 0; i8 < 4; ++i8) {
                float ox[8];
#pragma unroll
                for (int i = 0; i < 8; ++i) {
                    const int l = l0 + i8 * 8 + i;
                    const float v = conv_step(cx, rx[i8 * 8 + i]);
                    ox[i] = isx ? v * dtl[hw * 128 + l] * __expf(alast - acs[hw * 128 + l]) : v;
                }
                u32x4 o; o.x = pack2(ox[0], ox[1]); o.y = pack2(ox[2], ox[3]); o.z = pack2(ox[4], ox[5]); o.w = pack2(ox[6], ox[7]);
                *(u32x4*)(dst + l0 + i8 * 8) = o;
            }
        }
    }
    __syncthreads();
    {
        const int hw = w & 3, nh = w >> 2;
        f32x4 acc[4][4];
#pragma unroll
        for (int pt = 0; pt < 4; ++pt)
#pragma unroll
            for (int nt = 0; nt < 4; ++nt) acc[pt][nt] = (f32x4){0.f, 0.f, 0.f, 0.f};
#pragma unroll 1
        for (int ks = 0; ks < 4; ++ks) {
            bf16x8 af[4], bfr[4];
#pragma unroll
            for (int pt = 0; pt < 4; ++pt) af[pt] = *(const bf16x8*)(XwT + (hw * 64 + pt * 16 + fr) * SSD_P + ks * 32 + fq * 8);
#pragma unroll
            for (int nt = 0; nt < 4; ++nt) bfr[nt] = *(const bf16x8*)(BcT + ((nh * 4 + nt) * 16 + fr) * SSD_P + ks * 32 + fq * 8);
#pragma unroll
            for (int pt = 0; pt < 4; ++pt)
#pragma unroll
                for (int nt = 0; nt < 4; ++nt) acc[pt][nt] = __builtin_amdgcn_mfma_f32_16x16x32_bf16(af[pt], bfr[nt], acc[pt][nt], 0, 0, 0);
        }
        const int hh = 4 * g + hw;
        float* sp = states + ((size_t)((b * 64 + c) * 8 + hh)) * 8192;
#pragma unroll
        for (int pt = 0; pt < 4; ++pt)
#pragma unroll
            for (int nt = 0; nt < 4; ++nt)
#pragma unroll
                for (int jj = 0; jj < 4; ++jj) sp[(pt * 16 + 4 * fq + jj) * 128 + (nh * 4 + nt) * 16 + fr] = acc[pt][nt][jj];
        if (lane == 0 && nh == 0) cdec[(b * 64 + c) * 8 + hh] = __expf(acs[hw * 128 + 127]);
    }
    __syncthreads();
}

__device__ __forceinline__ void d_ssd_scan(const float* __restrict__ states, const float* __restrict__ cdec, bf16_t* __restrict__ prev, int vb) {
    const int bh = vb >> 1, b = bh >> 3, hh = bh & 7;
    const size_t e0 = (size_t)((vb & 1) * 512 + tid_opaque()) * 8;
    f32x4 h0 = (f32x4){0.f, 0.f, 0.f, 0.f}, h1 = h0;
#pragma unroll 8
    for (int c = 0; c < 64; ++c) {
        const size_t base = ((size_t)((b * 64 + c) * 8 + hh)) * 8192 + e0;
        const f32x4 s0 = *(const f32x4*)(states + base), s1 = *(const f32x4*)(states + base + 4);
        const float d = cdec[(b * 64 + c) * 8 + hh];
        u32x4 o; o.x = pack2(h0.x, h0.y); o.y = pack2(h0.z, h0.w); o.z = pack2(h1.x, h1.y); o.w = pack2(h1.z, h1.w);
        *(u32x4*)(prev + base) = o;
        h0 = h0 * d + s0; h1 = h1 * d + s1;
    }
}

__device__ __forceinline__ void d_ssd_out(const bf16_t* __restrict__ proj, const float* __restrict__ small, const float* __restrict__ conv_w, const float* __restrict__ conv_b,
                                          const float* __restrict__ a_log, const float* __restrict__ d_skip, const bf16_t* __restrict__ prev, bf16_t* __restrict__ yssd, int item, char* lds) {
    const int tid = tid_opaque(), lane = tid & 63, w = tid >> 6, fr = lane & 15, fq = lane >> 4;
    const int b = item >> 7, c = (item >> 1) & 63, g = item & 1;
    bf16_t* XsT = (bf16_t*)(lds + S3_XST); bf16_t* Bc = (bf16_t*)(lds + S3_BC); bf16_t* Cc = (bf16_t*)(lds + S3_CC);
    float* acs = (float*)(lds + S3_ACS); float* dtl = (float*)(lds + S3_DT);
    const size_t tok0 = (size_t)b * SEQ + (size_t)c * 128;
    ssd_acs(small, a_log, tok0, g, acs, dtl, tid);
    {
        const int mode = tid < 256 ? 0 : (tid < 384 ? 1 : 2);
        const int ch = mode == 0 ? g * 256 + tid : (mode == 1 ? 512 + g * 128 + (tid - 256) : 768 + g * 128 + (tid - 384));
        const bf16_t* px = proj + tok0 * PROJ_LD + C_XBC + ch;
        ConvCh cx; conv_init(cx, conv_w, conv_b, ch, px, c);
        bf16_t* dstx = XsT + (tid & 255) * SSD_P;
        bf16_t* dstbc = (mode == 1 ? Bc : Cc) + (tid & 127);
        for (int l0 = 0; l0 < 128; l0 += 32) {
            float rx[32];
#pragma unroll
            for (int i = 0; i < 32; ++i) rx[i] = bf2f(px[(size_t)(l0 + i) * PROJ_LD]);
#pragma unroll
            for (int i8 = 0; i8 < 4; ++i8) {
                float ox[8];
#pragma unroll
                for (int i = 0; i < 8; ++i) ox[i] = conv_step(cx, rx[i8 * 8 + i]);
                if (mode == 0) {
                    u32x4 o; o.x = pack2(ox[0], ox[1]); o.y = pack2(ox[2], ox[3]); o.z = pack2(ox[4], ox[5]); o.w = pack2(ox[6], ox[7]);
                    *(u32x4*)(dstx + l0 + i8 * 8) = o;
                } else {
#pragma unroll
                    for (int i = 0; i < 8; ++i) dstbc[(l0 + i8 * 8 + i) * SSD_P] = f2bf(ox[i]);
                }
            }
        }
    }
    __syncthreads();
    const int hw = w & 3, lh = w >> 2, hh = 4 * g + hw;
    const float dsk = d_skip[hh];
    const bf16_t* pp = prev + ((size_t)((b * 64 + c) * 8 + hh)) * 8192;
#pragma unroll 1
    for (int lk = 0; lk < 4; ++lk) {
        const int lt = lh + 2 * lk;
        const int l = lt * 16 + fr;
        const float acs_l = acs[hw * 128 + l];
        bf16x8 cf[4];
#pragma unroll
        for (int ks = 0; ks < 4; ++ks) cf[ks] = *(const bf16x8*)(Cc + (lt * 16 + fr) * SSD_P + ks * 32 + fq * 8);
        f32x4 y[4], yo[4];
#pragma unroll
        for (int pt = 0; pt < 4; ++pt) { y[pt] = (f32x4){0.f, 0.f, 0.f, 0.f}; yo[pt] = (f32x4){0.f, 0.f, 0.f, 0.f}; }
#pragma unroll
        for (int ks2 = 0; ks2 < 4; ++ks2) {
            if (2 * ks2 <= lt) {
                f32x4 cb[2];
#pragma unroll
                for (int h2 = 0; h2 < 2; ++h2) {
                    const int st = 2 * ks2 + h2;
                    cb[h2] = (f32x4){0.f, 0.f, 0.f, 0.f};
                    if (st <= lt) {
#pragma unroll
                        for (int ks = 0; ks < 4; ++ks)
                            cb[h2] = __builtin_amdgcn_mfma_f32_16x16x32_bf16(*(const bf16x8*)(Bc + (st * 16 + fr) * SSD_P + ks * 32 + fq * 8), cf[ks], cb[h2], 0, 0, 0);
#pragma unroll
                        for (int jj = 0; jj < 4; ++jj) {
                            const int sidx = st * 16 + 4 * fq + jj;
                            cb[h2][jj] = (sidx <= l) ? cb[h2][jj] * __expf(acs_l - acs[hw * 128 + sidx]) * dtl[hw * 128 + sidx] : 0.f;
                        }
                    }
                }
                u32x4 wv; wv.x = pack2(cb[0].x, cb[0].y); wv.y = pack2(cb[0].z, cb[0].w); wv.z = pack2(cb[1].x, cb[1].y); wv.w = pack2(cb[1].z, cb[1].w);
                const bf16x8 mf = __builtin_bit_cast(bf16x8, wv);
#pragma unroll
                for (int pt = 0; pt < 4; ++pt) {
                    const bf16_t* xp = XsT + (hw * 64 + pt * 16 + fr) * SSD_P + ks2 * 32 + 4 * fq;
                    const u32x2 a0 = *(const u32x2*)xp, a1 = *(const u32x2*)(xp + 16);
                    u32x4 xv; xv.x = a0.x; xv.y = a0.y; xv.z = a1.x; xv.w = a1.y;
                    y[pt] = __builtin_amdgcn_mfma_f32_16x16x32_bf16(__builtin_bit_cast(bf16x8, xv), mf, y[pt], 0, 0, 0);
                }
            }
            __builtin_amdgcn_sched_barrier(0);
        }
        __builtin_amdgcn_sched_barrier(0);
#pragma unroll
        for (int pt = 0; pt < 4; ++pt)
#pragma unroll
            for (int ks = 0; ks < 4; ++ks) yo[pt] = __builtin_amdgcn_mfma_f32_16x16x32_bf16(*(const bf16x8*)(pp + (pt * 16 + fr) * 128 + ks * 32 + fq * 8), cf[ks], yo[pt], 0, 0, 0);
        __builtin_amdgcn_sched_barrier(0);
        const float el = __expf(acs_l);
#pragma unroll
        for (int pt = 0; pt < 4; ++pt) {
            const int p0 = pt * 16 + 4 * fq;
            const u32x2 zz = *(const u32x2*)(proj + (tok0 + l) * PROJ_LD + C_Z + hh * 64 + p0);
            const float z0 = bflo(zz.x), z1 = bfhi(zz.x), z2 = bflo(zz.y), z3 = bfhi(zz.y);
            const bf16_t* xq = XsT + (hw * 64 + p0) * SSD_P + l;
            const float x0 = bf2f(xq[0]), x1 = bf2f(xq[SSD_P]), x2 = bf2f(xq[2 * SSD_P]), x3 = bf2f(xq[3 * SSD_P]);
            u32x2 ob;
            ob.x = pack2((y[pt].x + el * yo[pt].x + dsk * x0) * silu(z0), (y[pt].y + el * yo[pt].y + dsk * x1) * silu(z1));
            ob.y = pack2((y[pt].z + el * yo[pt].z + dsk * x2) * silu(z2), (y[pt].w + el * yo[pt].w + dsk * x3) * silu(z3));
            *(u32x2*)(yssd + (tok0 + l) * 512 + hh * 64 + p0) = ob;
        }
    }
    __syncthreads();
}

__device__ __forceinline__ void d_mix_prep(const float* __restrict__ onsa, const bf16_t* __restrict__ yssd, const float* __restrict__ nsa_w, const float* __restrict__ ssd_w, bf16_t* __restrict__ A2, int vb) {
    const int tid_ = tid_opaque(); const int lane = tid_ & 63, wid = tid_ >> 6;
    const size_t row0 = (size_t)vb * 32 + wid * 4;
    f32x4 a[4][2], y[4][2];
#pragma unroll
    for (int r = 0; r < 4; ++r)
#pragma unroll
        for (int k = 0; k < 2; ++k) {
            a[r][k] = *(const f32x4*)(onsa + (row0 + r) * 512 + k * 256 + lane * 4);
            const u32x2 yy = *(const u32x2*)(yssd + (row0 + r) * 512 + k * 256 + lane * 4);
            y[r][k] = (f32x4){bflo(yy.x), bfhi(yy.x), bflo(yy.y), bfhi(yy.y)};
        }
    float ra[4], ry[4];
#pragma unroll
    for (int r = 0; r < 4; ++r) {
        float s0 = 0.f, s1 = 0.f;
#pragma unroll
        for (int k = 0; k < 2; ++k) {
            s0 += a[r][k].x * a[r][k].x + a[r][k].y * a[r][k].y + a[r][k].z * a[r][k].z + a[r][k].w * a[r][k].w;
            s1 += y[r][k].x * y[r][k].x + y[r][k].y * y[r][k].y + y[r][k].z * y[r][k].z + y[r][k].w * y[r][k].w;
        }
        ra[r] = rsqrtf(wave_sum(s0) * (1.0f / 512) + EPS); ry[r] = rsqrtf(wave_sum(s1) * (1.0f / 512) + EPS);
    }
#pragma unroll
    for (int k = 0; k < 2; ++k) {
        const int col = k * 256 + lane * 4;
        const f32x4 wn = *(const f32x4*)(nsa_w + col), wsd = *(const f32x4*)(ssd_w + col);
#pragma unroll
        for (int r = 0; r < 4; ++r) {
            const f32x4 p = a[r][k] * ra[r] * wn, q = y[r][k] * ry[r] * wsd;
            u32x2 o; o.x = pack2(p.x, p.y); o.y = pack2(p.z, p.w);
            *(u32x2*)(A2 + (row0 + r) * DM + col) = o;
            u32x2 o2; o2.x = pack2(q.x, q.y); o2.y = pack2(q.z, q.w);
            *(u32x2*)(A2 + (row0 + r) * DM + 512 + col) = o2;
        }
    }
}

__device__ __forceinline__ void d_quant_rows(const float* __restrict__ src, unsigned char* __restrict__ dst, float* __restrict__ scale, int vb) {
    const int tid_ = tid_opaque(); const int lane = tid_ & 63, row = vb * 8 + (tid_ >> 6);
    const float* rp = src + (size_t)row * DM + lane * 16;
    f32x4 v[4];
#pragma unroll
    for (int i = 0; i < 4; ++i) v[i] = *(const f32x4*)(rp + i * 4);
    float mx = 0.f;
#pragma unroll
    for (int i = 0; i < 4; ++i) mx = fmaxf(mx, fmaxf(fmaxf(fabsf(v[i].x), fabsf(v[i].y)), fmaxf(fabsf(v[i].z), fabsf(v[i].w))));
    mx = wave_max(mx);
    const float sc = mx > 0.f ? mx * (1.0f / 6.0f) : 1.0f;
    const float inv = 1.0f / sc;
    u32x2 o;
#pragma unroll
    for (int h = 0; h < 2; ++h) {
        unsigned wv = 0u;
        wv = __builtin_amdgcn_cvt_scalef32_pk_fp4_f32(wv, v[2 * h].x * inv, v[2 * h].y * inv, 1.0f, 0);
        wv = __builtin_amdgcn_cvt_scalef32_pk_fp4_f32(wv, v[2 * h].z * inv, v[2 * h].w * inv, 1.0f, 1);
        wv = __builtin_amdgcn_cvt_scalef32_pk_fp4_f32(wv, v[2 * h + 1].x * inv, v[2 * h + 1].y * inv, 1.0f, 2);
        wv = __builtin_amdgcn_cvt_scalef32_pk_fp4_f32(wv, v[2 * h + 1].z * inv, v[2 * h + 1].w * inv, 1.0f, 3);
        o[h] = wv;
    }
    *(u32x2*)(dst + (size_t)row * 512 + lane * 8) = o;
    if (lane == 0) scale[row] = sc;
}

__device__ __forceinline__ unsigned mono_u(float f) { const unsigned u = __float_as_uint(f); return (u & 0x80000000u) ? ~u : (u | 0x80000000u); }
__device__ __forceinline__ float unmono_f(unsigned m) { const unsigned u = (m & 0x80000000u) ? (m & 0x7fffffffu) : ~m; return __uint_as_float(u); }
#define RT_LI 65536
__device__ __forceinline__ void d_peer_stage_keys(const bf16_t* __restrict__ subk, int h, char* lds) {
    const int tid = tid_opaque();
    u32x4 r[8];
#pragma unroll
    for (int i = 0; i < 8; ++i) { const int p = tid + 512 * i; r[i] = *(const u32x4*)(subk + (size_t)h * 32768 + (size_t)p * 8); }
#pragma unroll
    for (int i = 0; i < 8; ++i) { const int p = tid + 512 * i, row = p >> 4, ch = p & 15; *(u32x4*)(lds + row * 256 + ((ch ^ (row & 15)) << 4)) = r[i]; }
}
__device__ __forceinline__ void d_peer_route(const bf16_t* __restrict__ qp, const float* __restrict__ qnw, int* __restrict__ eidx, float* __restrict__ gate,
                                             int tile, int h, char* lds) {
    const int tid = tid_opaque(), lane = tid & 63, w = tid >> 6, fr = lane & 15, fq = lane >> 4;
    const size_t tok = (size_t)tile * 128 + w * 16 + fr;
    bf16x8 qf[2][4];
    {
        const bf16_t* qrow = qp + tok * 2048 + h * 256;
        u32x4 raw[2][4];
        float ss = 0.f;
#pragma unroll
        for (int k = 0; k < 2; ++k)
#pragma unroll
            for (int ks = 0; ks < 4; ++ks) {
                const u32x4 r = *(const u32x4*)(qrow + k * 128 + ks * 32 + fq * 8);
                raw[k][ks] = r;
                ss += bflo(r.x) * bflo(r.x) + bfhi(r.x) * bfhi(r.x) + bflo(r.y) * bflo(r.y) + bfhi(r.y) * bfhi(r.y)
                    + bflo(r.z) * bflo(r.z) + bfhi(r.z) * bfhi(r.z) + bflo(r.w) * bflo(r.w) + bfhi(r.w) * bfhi(r.w);
            }
        ss += __shfl_xor(ss, 16); ss += __shfl_xor(ss, 32);
        const float rs = rsqrtf(ss * (1.0f / 256) + EPS);
#pragma unroll
        for (int k = 0; k < 2; ++k)
#pragma unroll
            for (int ks = 0; ks < 4; ++ks) {
                const float* wp = qnw + k * 128 + ks * 32 + fq * 8;
                const f32x4 w0 = *(const f32x4*)wp, w1 = *(const f32x4*)(wp + 4);
                const u32x4 r = raw[k][ks];
                u32x4 o;
                o.x = pack2(bflo(r.x) * rs * w0.x, bfhi(r.x) * rs * w0.y); o.y = pack2(bflo(r.y) * rs * w0.z, bfhi(r.y) * rs * w0.w);
                o.z = pack2(bflo(r.z) * rs * w1.x, bfhi(r.z) * rs * w1.y); o.w = pack2(bflo(r.w) * rs * w1.z, bfhi(r.w) * rs * w1.w);
                qf[k][ks] = __builtin_bit_cast(bf16x8, o);
            }
    }
    unsigned L[2][16];
#pragma unroll
    for (int k = 0; k < 2; ++k) {
        f32x4 acc[8];
#pragma unroll
        for (int kt = 0; kt < 8; ++kt) acc[kt] = (f32x4){0.f, 0.f, 0.f, 0.f};
#pragma unroll
        for (int kt = 0; kt < 8; ++kt)
#pragma unroll
            for (int ks = 0; ks < 4; ++ks) {
                const int row = k * 128 + kt * 16 + fr;
                const bf16x8 af = *(const bf16x8*)(lds + row * 256 + (((ks * 4 + fq) ^ fr) << 4));
                acc[kt] = __builtin_amdgcn_mfma_f32_16x16x32_bf16(af, qf[k][ks], acc[kt], 0, 0, 0);
            }
        {
            unsigned H[16];
#pragma unroll
            for (int kt = 0; kt < 4; ++kt)
#pragma unroll
                for (int jj = 0; jj < 4; ++jj) {
                    L[k][kt * 4 + jj] = (mono_u(acc[kt][jj]) & ~0x7Fu) | (unsigned)(127 - (kt * 16 + 4 * fq + jj));
                    H[kt * 4 + jj] = (mono_u(acc[kt + 4][jj]) & ~0x7Fu) | (unsigned)(127 - ((kt + 4) * 16 + 4 * fq + jj));
                }
            sort16(L[k]); sort16(H);
            merge16(L[k], H);
        }
#pragma unroll
        for (int r = 16; r <= 32; r <<= 1) {
            unsigned P[16];
#pragma unroll
            for (int i = 0; i < 16; ++i) P[i] = (unsigned)__shfl_xor((int)L[k][i], r);
            merge16(L[k], P);
        }
    }
    unsigned T[16];
#define CAND(a, b) ((mono_u(unmono_f(L[0][a] & ~0x7Fu) + unmono_f(L[1][b] & ~0x7Fu)) & ~0xFFu) | (unsigned)(255 - ((a) * 16 + (b))))
#pragma unroll
    for (int bb = 0; bb < 16; ++bb) T[bb] = CAND(0, bb);
    {
        unsigned Bq[16];
#pragma unroll
        for (int bb = 0; bb < 8; ++bb) Bq[bb] = CAND(1, bb);
        Bq[8] = CAND(4, 0); Bq[9] = CAND(4, 1); Bq[10] = CAND(4, 2); Bq[11] = CAND(5, 0); Bq[12] = CAND(5, 1); Bq[13] = CAND(6, 0); Bq[14] = CAND(6, 1); Bq[15] = CAND(8, 0);
        sort16(Bq); merge16(T, Bq);
    }
    {
        unsigned Cq[16];
#pragma unroll
        for (int bb = 0; bb < 5; ++bb) Cq[bb] = CAND(2, bb);
#pragma unroll
        for (int bb = 0; bb < 4; ++bb) Cq[5 + bb] = CAND(3, bb);
        Cq[9] = CAND(7, 0); Cq[10] = CAND(7, 1); Cq[11] = CAND(9, 0); Cq[12] = CAND(10, 0); Cq[13] = CAND(11, 0); Cq[14] = CAND(12, 0); Cq[15] = CAND(13, 0);
        sort16(Cq); merge16(T, Cq);
    }
    ins16(T, CAND(14, 0)); ins16(T, CAND(15, 0));
#undef CAND
    unsigned char* li = (unsigned char*)lds + RT_LI + w * 512 + fr * 32;
    if (fq == 0) {
#pragma unroll
        for (int a = 0; a < 16; ++a) { li[a] = (unsigned char)(127 - (L[0][a] & 0x7Fu)); li[16 + a] = (unsigned char)(127 - (L[1][a] & 0x7Fu)); }
    }
    __syncthreads();
    const float s0 = unmono_f(T[0] & ~0xFFu);
    float pe[16]; float sum = 0.f;
#pragma unroll
    for (int i = 0; i < 16; ++i) { pe[i] = __expf(unmono_f(T[i] & ~0xFFu) - s0); sum += pe[i]; }
    const float inv = 1.0f / sum;
    unsigned cod[4] = {0u, 0u, 0u, 0u}; float gv[4] = {0.f, 0.f, 0.f, 0.f};
#pragma unroll
    for (int i = 0; i < 16; ++i) if ((i >> 2) == fq) { cod[i & 3] = 255u - (T[i] & 0xFFu); gv[i & 3] = pe[i] * inv; }
    int ev[4];
#pragma unroll
    for (int i = 0; i < 4; ++i) ev[i] = (int)li[cod[i] >> 4] * 128 + (int)li[16 + (cod[i] & 15u)];
    *(u32x4*)(eidx + (tok * 8 + h) * 16 + fq * 4) = (u32x4){(unsigned)ev[0], (unsigned)ev[1], (unsigned)ev[2], (unsigned)ev[3]};
    *(f32x4*)(gate + (tok * 8 + h) * 16 + fq * 4) = (f32x4){gv[0], gv[1], gv[2], gv[3]};
    __syncthreads();
}

__device__ __forceinline__ void cvt16(const u32x2 q, f32x2 (&f)[8]) {
#pragma unroll
    for (int i = 0; i < 2; ++i) {
        f[4 * i] = __builtin_amdgcn_cvt_scalef32_pk_f32_fp4(q[i], 1.0f, 0); f[4 * i + 1] = __builtin_amdgcn_cvt_scalef32_pk_f32_fp4(q[i], 1.0f, 1);
        f[4 * i + 2] = __builtin_amdgcn_cvt_scalef32_pk_f32_fp4(q[i], 1.0f, 2); f[4 * i + 3] = __builtin_amdgcn_cvt_scalef32_pk_f32_fp4(q[i], 1.0f, 3);
    }
}
typedef int v8i __attribute__((ext_vector_type(8)));
__device__ __forceinline__ void d_peer_expert_mx(const bf16_t* __restrict__ h2, const unsigned char* __restrict__ down4, const unsigned char* __restrict__ up4, const float* __restrict__ dscale,
                                                 const float* __restrict__ uscale, const int* __restrict__ eidx, const float* __restrict__ gate, const float* __restrict__ mod,
                                                 const float* __restrict__ fw, float* __restrict__ out, int vb, char* lds) {
    const int tid = tid_opaque(), lane = tid & 63, wid = tid >> 6, fr = lane & 15, kq = lane >> 4;
    const size_t tok = (size_t)vb * 8 + wid; const int b = (int)(tok >> 13);
    unsigned char* hq = (unsigned char*)lds + wid * 1024;
    {
        const u32x4 v0 = *(const u32x4*)(h2 + tok * DM + lane * 16), v1 = *(const u32x4*)(h2 + tok * DM + lane * 16 + 8);
        u32x4 q;
        int wv = 0;
        wv = __builtin_amdgcn_cvt_pk_fp8_f32(bflo(v0.x), bfhi(v0.x), wv, false); wv = __builtin_amdgcn_cvt_pk_fp8_f32(bflo(v0.y), bfhi(v0.y), wv, true); q.x = (unsigned)wv;
        wv = __builtin_amdgcn_cvt_pk_fp8_f32(bflo(v0.z), bfhi(v0.z), wv, false); wv = __builtin_amdgcn_cvt_pk_fp8_f32(bflo(v0.w), bfhi(v0.w), wv, true); q.y = (unsigned)wv;
        wv = __builtin_amdgcn_cvt_pk_fp8_f32(bflo(v1.x), bfhi(v1.x), wv, false); wv = __builtin_amdgcn_cvt_pk_fp8_f32(bflo(v1.y), bfhi(v1.y), wv, true); q.z = (unsigned)wv;
        wv = __builtin_amdgcn_cvt_pk_fp8_f32(bflo(v1.z), bfhi(v1.z), wv, false); wv = __builtin_amdgcn_cvt_pk_fp8_f32(bflo(v1.w), bfhi(v1.w), wv, true); q.w = (unsigned)wv;
        *(u32x4*)(hq + lane * 16) = q;
    }
    const int e_lo = eidx[tok * 128 + lane], e_hi = eidx[tok * 128 + 64 + lane];
    const float c_lo = gate[tok * 128 + lane] * uscale[e_lo], c_hi = gate[tok * 128 + 64 + lane] * uscale[e_hi];
    const float d_lo = dscale[e_lo], d_hi = dscale[e_hi];
    f32x2 acc[8];
#pragma unroll
    for (int e = 0; e < 8; ++e) acc[e] = (f32x2){0.f, 0.f};
    u32x4 da[8], dn[8]; u32x2 uq[16], un[16];
    {
        const int em = __shfl(e_lo, fr);
        const unsigned char* ab = down4 + (size_t)em * 512 + kq * 16;
#pragma unroll
        for (int k = 0; k < 8; ++k) da[k] = *(const u32x4*)(ab + k * 64);
#pragma unroll
        for (int i = 0; i < 16; ++i) { const int e = __builtin_amdgcn_readlane(e_lo, i); uq[i] = *(const u32x2*)(up4 + (size_t)e * 512 + lane * 8); }
    }
#pragma unroll 1
    for (int g = 0; g < 8; ++g) {
        if (g + 1 < 8) {
            const int gn = g + 1;
            const int em = gn < 4 ? __shfl(e_lo, gn * 16 + fr) : __shfl(e_hi, (gn - 4) * 16 + fr);
            const unsigned char* ab = down4 + (size_t)em * 512 + kq * 16;
#pragma unroll
            for (int k = 0; k < 8; ++k) dn[k] = *(const u32x4*)(ab + k * 64);
#pragma unroll
            for (int i = 0; i < 16; ++i) {
                const int e = gn < 4 ? __builtin_amdgcn_readlane(e_lo, gn * 16 + i) : __builtin_amdgcn_readlane(e_hi, (gn - 4) * 16 + i);
                un[i] = *(const u32x2*)(up4 + (size_t)e * 512 + lane * 8);
            }
        }
        f32x4 d4 = (f32x4){0.f, 0.f, 0.f, 0.f};
#pragma unroll
        for (int k = 0; k < 8; ++k) {
            const u32x4 b0 = *(const u32x4*)(hq + k * 128 + kq * 16), b1 = *(const u32x4*)(hq + k * 128 + 64 + kq * 16);
            const v8i A = {(int)da[k].x, (int)da[k].y, (int)da[k].z, (int)da[k].w, 0, 0, 0, 0};
            const v8i B = {(int)b0.x, (int)b0.y, (int)b0.z, (int)b0.w, (int)b1.x, (int)b1.y, (int)b1.z, (int)b1.w};
            d4 = __builtin_amdgcn_mfma_scale_f32_16x16x128_f8f6f4(A, B, d4, 4  , 0  , 0, 0x7F7F7F7F, 0, 0x7F7F7F7F);
        }
        float av;
        {
            const int jm = fr & 3;
            const float dv = jm == 0 ? d4[0] : jm == 1 ? d4[1] : jm == 2 ? d4[2] : d4[3];
            const int sl = (g & 3) * 16 + 4 * kq + jm;
            const float mc = g < 4 ? __shfl(c_lo, sl) : __shfl(c_hi, sl);
            const float md = g < 4 ? __shfl(d_lo, sl) : __shfl(d_hi, sl);
            av = gelu_tanh(dv * md) * mc;
        }
#pragma unroll
        for (int i = 0; i < 16; ++i) {
            const float c = __uint_as_float((unsigned)__builtin_amdgcn_readlane((int)__float_as_uint(av), 16 * (i >> 2) + (i & 3)));
            const f32x2 c2 = {c, c};
            f32x2 f[8]; cvt16(uq[i], f);
#pragma unroll
            for (int e = 0; e < 8; ++e) acc[e] = __builtin_elementwise_fma(f[e], c2, acc[e]);
        }
#pragma unroll
        for (int k = 0; k < 8; ++k) da[k] = dn[k];
#pragma unroll
        for (int i = 0; i < 16; ++i) uq[i] = un[i];
    }
    float x2[16]; float ss = 0.f;
#pragma unroll
    for (int q4i = 0; q4i < 4; ++q4i) {
        const int col = lane * 16 + q4i * 4;
        const f32x4 xv = *(const f32x4*)(out + tok * DM + col);
        const f32x4 g2 = *(const f32x4*)(mod + b * 6144 + 5120 + col);
        const int e0 = q4i * 4;
        x2[e0 + 0] = xv.x + g2.x * acc[2 * q4i].x; x2[e0 + 1] = xv.y + g2.y * acc[2 * q4i].y; x2[e0 + 2] = xv.z + g2.z * acc[2 * q4i + 1].x; x2[e0 + 3] = xv.w + g2.w * acc[2 * q4i + 1].y;
        ss += x2[e0] * x2[e0] + x2[e0 + 1] * x2[e0 + 1] + x2[e0 + 2] * x2[e0 + 2] + x2[e0 + 3] * x2[e0 + 3];
    }
    ss = wave_sum(ss);
    const float r = rsqrtf(ss * (1.0f / DM) + EPS);
#pragma unroll
    for (int q4i = 0; q4i < 4; ++q4i) {
        const int col = lane * 16 + q4i * 4;
        const f32x4 wv = *(const f32x4*)(fw + col);
        const int e0 = q4i * 4;
        *(f32x4*)(out + tok * DM + col) = (f32x4){x2[e0] * r * wv.x, x2[e0 + 1] * r * wv.y, x2[e0 + 2] * r * wv.z, x2[e0 + 3] * r * wv.w};
    }
}

__device__ __forceinline__ void d_peer_expert8(const bf16_t* __restrict__ h2, const unsigned char* __restrict__ down8, const unsigned char* __restrict__ up8, const float* __restrict__ dscale,
                                               const float* __restrict__ uscale, const int* __restrict__ eidx, const float* __restrict__ gate, const float* __restrict__ mod,
                                               const float* __restrict__ fw, float* __restrict__ out, int vb) {
    const int tid = tid_opaque(), lane = tid & 63, wid = tid >> 6;
    const size_t tok = (size_t)vb * 8 + wid; const int b = (int)(tok >> 13);
    const int e_lo = eidx[tok * 128 + lane], e_hi = eidx[tok * 128 + 64 + lane];
    const float c_lo = gate[tok * 128 + lane] * uscale[e_lo], c_hi = gate[tok * 128 + 64 + lane] * uscale[e_hi];
    const float d_lo = dscale[e_lo], d_hi = dscale[e_hi];
    f32x2 hx[8], acc[8];
    {
        const u32x4 v0 = *(const u32x4*)(h2 + tok * DM + lane * 16), v1 = *(const u32x4*)(h2 + tok * DM + lane * 16 + 8);
        hx[0] = (f32x2){bflo(v0.x), bfhi(v0.x)}; hx[1] = (f32x2){bflo(v0.y), bfhi(v0.y)}; hx[2] = (f32x2){bflo(v0.z), bfhi(v0.z)}; hx[3] = (f32x2){bflo(v0.w), bfhi(v0.w)};
        hx[4] = (f32x2){bflo(v1.x), bfhi(v1.x)}; hx[5] = (f32x2){bflo(v1.y), bfhi(v1.y)}; hx[6] = (f32x2){bflo(v1.z), bfhi(v1.z)}; hx[7] = (f32x2){bflo(v1.w), bfhi(v1.w)};
    }
#pragma unroll
    for (int e = 0; e < 8; ++e) acc[e] = (f32x2){0.f, 0.f};
    const int es = lane >> 3;
    u32x2 dq[8], uq[8], dn[8], un[8];
#pragma unroll
    for (int i = 0; i < 8; ++i) {
        const int e = __builtin_amdgcn_readlane(e_lo, i);
        dq[i] = *(const u32x2*)(down8 + (size_t)e * 512 + lane * 8);
        uq[i] = *(const u32x2*)(up8 + (size_t)e * 512 + lane * 8);
    }
#pragma unroll 1
    for (int j0 = 0; j0 < 128; j0 += 8) {
        if (j0 + 8 < 128) {
            const int jn = j0 + 8;
#pragma unroll
            for (int i = 0; i < 8; ++i) {
                const int e = jn < 64 ? __builtin_amdgcn_readlane(e_lo, jn + i) : __builtin_amdgcn_readlane(e_hi, jn - 64 + i);
                dn[i] = *(const u32x2*)(down8 + (size_t)e * 512 + lane * 8);
                un[i] = *(const u32x2*)(up8 + (size_t)e * 512 + lane * 8);
            }
        }
        const int sl = (j0 & 63) + es;
        const float my_c = j0 < 64 ? __shfl(c_lo, sl) : __shfl(c_hi, sl);
        const float my_ds = j0 < 64 ? __shfl(d_lo, sl) : __shfl(d_hi, sl);
        float part[8];
#pragma unroll
        for (int i = 0; i < 8; ++i) {
            f32x2 f[8]; cvt16(dq[i], f);
            f32x2 s2 = hx[0] * f[0];
#pragma unroll
            for (int e = 1; e < 8; ++e) s2 = __builtin_elementwise_fma(hx[e], f[e], s2);
            part[i] = s2.x + s2.y;
        }
        float q4[4], q2[2], q1;
#pragma unroll
        for (int i = 0; i < 4; ++i) { const bool up = (lane & 32) != 0; const float send = up ? part[i] : part[i + 4]; const float keep = up ? part[i + 4] : part[i]; q4[i] = keep + __shfl_xor(send, 32); }
#pragma unroll
        for (int i = 0; i < 2; ++i) { const bool up = (lane & 16) != 0; const float send = up ? q4[i] : q4[i + 2]; const float keep = up ? q4[i + 2] : q4[i]; q2[i] = keep + __shfl_xor(send, 16); }
        { const bool up = (lane & 8) != 0; const float send = up ? q2[0] : q2[1]; const float keep = up ? q2[1] : q2[0]; q1 = keep + __shfl_xor(send, 8); }
        q1 += __shfl_xor(q1, 4); q1 += __shfl_xor(q1, 2); q1 += __shfl_xor(q1, 1);
        const float a = gelu_tanh(q1 * my_ds) * my_c;
#pragma unroll
        for (int i = 0; i < 8; ++i) {
            const float c = __uint_as_float((unsigned)__builtin_amdgcn_readlane((int)__float_as_uint(a), 8 * i));
            const f32x2 c2 = {c, c};
            f32x2 f[8]; cvt16(uq[i], f);
#pragma unroll
            for (int e = 0; e < 8; ++e) acc[e] = __builtin_elementwise_fma(f[e], c2, acc[e]);
        }
#pragma unroll
        for (int i = 0; i < 8; ++i) { dq[i] = dn[i]; uq[i] = un[i]; }
    }
    float x2[16]; float ss = 0.f;
#pragma unroll
    for (int q4i = 0; q4i < 4; ++q4i) {
        const int col = lane * 16 + q4i * 4;
        const f32x4 xv = *(const f32x4*)(out + tok * DM + col);
        const f32x4 g2 = *(const f32x4*)(mod + b * 6144 + 5120 + col);
        const int e0 = q4i * 4;
        x2[e0 + 0] = xv.x + g2.x * acc[2 * q4i].x; x2[e0 + 1] = xv.y + g2.y * acc[2 * q4i].y; x2[e0 + 2] = xv.z + g2.z * acc[2 * q4i + 1].x; x2[e0 + 3] = xv.w + g2.w * acc[2 * q4i + 1].y;
        ss += x2[e0] * x2[e0] + x2[e0 + 1] * x2[e0 + 1] + x2[e0 + 2] * x2[e0 + 2] + x2[e0 + 3] * x2[e0 + 3];
    }
    ss = wave_sum(ss);
    const float r = rsqrtf(ss * (1.0f / DM) + EPS);
#pragma unroll
    for (int q4i = 0; q4i < 4; ++q4i) {
        const int col = lane * 16 + q4i * 4;
        const f32x4 wv = *(const f32x4*)(fw + col);
        const int e0 = q4i * 4;
        *(f32x4*)(out + tok * DM + col) = (f32x4){x2[e0] * r * wv.x, x2[e0 + 1] * r * wv.y, x2[e0 + 2] * r * wv.z, x2[e0 + 3] * r * wv.w};
    }
}

#define XB_TMO      128
#define XB_XCNT(j)  (256  + 64 * (j))
#define XB_XSUB(j)  (1280 + 64 * (j))
#define XB_XGEN(j)  (2304 + 64 * (j))
#define XB_TOP      3328
#define XB_TOPGEN   3392
#define XCD_BAR_WORDS 3456
#define XB_SPIN_CAP (1u << 18)

__device__ __forceinline__ unsigned xb_ld(unsigned* p)              { return __hip_atomic_load(p, __ATOMIC_RELAXED, __HIP_MEMORY_SCOPE_AGENT); }
__device__ __forceinline__ unsigned xb_add(unsigned* p, unsigned v) { return __hip_atomic_fetch_add(p, v, __ATOMIC_RELAXED, __HIP_MEMORY_SCOPE_AGENT); }
__device__ __forceinline__ unsigned xb_xcc_id() { return (unsigned)__builtin_amdgcn_s_getreg((3 << 11) | 20) & 0xFu; }
#define XB_SPIN(cond, bar) do { unsigned _sp = 0; while (cond) { __builtin_amdgcn_s_sleep(1); \
    if ((++_sp & 255u) == 0u) { if (xb_ld(&(bar)[XB_TMO])) break; if (_sp > XB_SPIN_CAP) { atomicAdd(&(bar)[XB_TMO], 1u); break; } } } } while (0)

struct XcdBarrier {
    unsigned* bar; unsigned x;
    volatile __attribute__((address_space(3))) unsigned* st;
};

__device__ __forceinline__ XcdBarrier xcd_barrier_post(unsigned* bar, volatile __attribute__((address_space(3))) unsigned* st) {
    XcdBarrier b; b.bar = bar; b.x = xb_xcc_id(); b.st = st;
    if (threadIdx.x == 0) (void)xb_add(&bar[XB_XCNT(b.x)], 1u);
    return b;
}
__device__ __forceinline__ void xcd_barrier_complete(unsigned* bar, unsigned x, unsigned& nloc, unsigned& nx) {
    const unsigned G = gridDim.x * gridDim.y * gridDim.z;
    unsigned sum, cnt, mine, sp = 0u;
    for (;;) {
        sum = 0u; cnt = 0u; mine = 0u;
#pragma unroll
        for (unsigned j = 0; j < 16; ++j) { const unsigned c = xb_ld(&bar[XB_XCNT(j)]); sum += c; cnt += (c > 0u) ? 1u : 0u; mine = (j == x) ? c : mine; }
        if (sum == G) break;
        __builtin_amdgcn_s_sleep(1);
        if ((++sp & 255u) == 0u) { if (xb_ld(&bar[XB_TMO])) break; if (sp > XB_SPIN_CAP) { atomicAdd(&bar[XB_TMO], 1u); break; } }
    }
    nloc = mine > 0u ? mine : 1u; nx = cnt > 0u ? cnt : 1u;
}

__device__ __forceinline__ void xcd_barrier(const XcdBarrier& b) {
    asm volatile("s_waitcnt vmcnt(0)" ::: "memory");
    __syncthreads();
    if (threadIdx.x == 0) {
        unsigned* bar = b.bar;
        __builtin_amdgcn_s_waitcnt(0);
        unsigned nloc = b.st[0], nx = b.st[1];
        if (nloc == 0u) { xcd_barrier_complete(bar, b.x, nloc, nx); b.st[0] = nloc; b.st[1] = nx; }
        const unsigned old = xb_add(&bar[XB_XSUB(b.x)], 1u);
        const unsigned gen = old / nloc;
        if (old + 1u == (gen + 1u) * nloc) {
            __builtin_amdgcn_fence(__ATOMIC_RELEASE, "agent");
            asm volatile("s_waitcnt vmcnt(0)" ::: "memory");
            const unsigned og = xb_add(&bar[XB_TOP], 1u);
            const unsigned tg = og / nx;
            if (og + 1u == (tg + 1u) * nx) xb_add(&bar[XB_TOPGEN], 1u);
            else XB_SPIN(xb_ld(&bar[XB_TOPGEN]) == tg, bar);
            __builtin_amdgcn_fence(__ATOMIC_ACQUIRE, "agent");
            xb_add(&bar[XB_XGEN(b.x)], 1u);
            asm volatile("s_waitcnt vmcnt(0)" ::: "memory");
        } else {
            XB_SPIN(xb_ld(&bar[XB_XGEN(b.x)]) == gen, bar);
            __builtin_amdgcn_fence(__ATOMIC_ACQUIRE, "agent");
            asm volatile("s_waitcnt vmcnt(0)" ::: "memory");
        }
    }
    __syncthreads();
}


struct Params {
    const float *x, *c, *w_ada, *b_ada, *norm1_w, *w_in, *cmp_pe_k, *cmp_pe_v, *cmp_w1_k, *cmp_w2_k, *cmp_w1_v, *cmp_w2_v, *nsa_norm_w, *conv_w, *conv_b, *dt_bias, *a_log, *d_skip,
        *ssd_norm_w, *w_out, *norm2_w, *peer_wq, *peer_qnorm_w, *peer_sub_keys, *peer_down, *peer_up, *final_norm_w;
    float* out; char* ws;
};
#define LDS_BYTES 147456
#define LDS_MISC  (LDS_BYTES - 64)

__global__ __launch_bounds__(512, 2) void mega(Params p) {
    __shared__ __attribute__((aligned(16))) unsigned char lds_raw[LDS_BYTES];
    char* lds = (char*)lds_raw;
    PG8_LAS unsigned char* lds3 = (PG8_LAS unsigned char*)lds_raw;
    int* s_vb = (int*)(lds + LDS_MISC);
    cg::grid_group grid = cg::this_grid();
    volatile __attribute__((address_space(3))) unsigned* xb_st = (volatile __attribute__((address_space(3))) unsigned*)((PG8_LAS unsigned char*)lds_raw + LDS_MISC + 16);
    if (threadIdx.x == 0) { xb_st[0] = 0u; xb_st[1] = 0u; }
    __syncthreads();
    const XcdBarrier xbar = xcd_barrier_post((unsigned*)(p.ws + OFF_BAR), xb_st);
    const int G = gridDim.x, bid = blockIdx.x;
    if (bid == 0 && threadIdx.x == 0) { ((unsigned*)(p.ws + OFF_CTR))[0] = 0u; ((unsigned*)(p.ws + OFF_CTR))[64] = 0u; ((unsigned*)(p.ws + OFF_CTR))[128] = 0u; }
    for (int vb = bid; vb < 7906; vb += G) {
        int v = vb;
        if (v < 1536) { d_transpose_w(p.w_in, ((bf16_t*)(p.ws + OFF_WIN_T)), 1024, 2848, 1, 96, v, lds); }
        else if ((v -= 1536) < 512) { d_transpose_w(p.w_out, ((bf16_t*)(p.ws + OFF_WOUT_T)), 1024, 1024, 0, 32, v, lds); }
        else if ((v -= 512) < 1024) { d_transpose_w(p.peer_wq, ((bf16_t*)(p.ws + OFF_WQ_T)), 1024, 2048, 0, 64, v, lds); }
        else if ((v -= 1024) < 256) { d_transpose_w(p.cmp_w1_k, ((bf16_t*)(p.ws + OFF_W1K_T)), 2048, 256, 0, 8, v, lds); }
        else if ((v -= 256) < 256) { d_transpose_w(p.cmp_w1_v, ((bf16_t*)(p.ws + OFF_W1V_T)), 2048, 256, 0, 8, v, lds); }
        else if ((v -= 256) < 2048) { d_quant_rows(p.peer_down, ((unsigned char*)(p.ws + OFF_DOWN)), ((float*)(p.ws + OFF_UP)), v); }
        else if ((v -= 2048) < 2048) { d_quant_rows(p.peer_up, ((unsigned char*)(p.ws + OFF_DOWN + MIB(8))), ((float*)(p.ws + OFF_UP + 65536)), v); }
        else if ((v -= 2048) < 1) { d_convert_bf16(p.peer_sub_keys, ((bf16_t*)(p.ws + OFF_SUBK)), (size_t)8 * 2 * 128 * 128 / 8, 0, 1); }
        else if ((v -= 1) < 96) { d_mod(p.c, p.w_ada, p.b_ada, ((float*)(p.ws + OFF_MOD)), v, lds); }
        else if ((v -= 96) < 128) { d_rope_table(((float2*)(p.ws + OFF_ROPE)), v); }
        else { d_bias1(p.cmp_pe_k, p.cmp_w1_k, p.cmp_pe_v, p.cmp_w1_v, ((float*)(p.ws + OFF_BIAS1))); }
    }
    grid.sync();
    for (int vb = bid; vb < NTOK / 32; vb += G) d_norm_mod(p.x, p.norm1_w, ((float*)(p.ws + OFF_MOD)), 0, 1024, ((bf16_t*)(p.ws + OFF_H)), vb);
    xcd_barrier(xbar);
    {
        const pg8::Gemm g{((bf16_t*)(p.ws + OFF_H)), ((bf16_t*)(p.ws + OFF_WIN_T)), NTOK, NIN_PAD, 1024, 1024};
        pg8::StaticOrder S; S.init(NTOK, NIN_PAD, G, bid);
        const pg8::Epi<EpInProj> E{{((bf16_t*)(p.ws + OFF_PROJ)), ((bf16_t*)(p.ws + OFF_QROPE)), ((bf16_t*)(p.ws + OFF_KVP)), ((float*)(p.ws + OFF_SMALL)), ((float2*)(p.ws + OFF_ROPE)), p.dt_bias}};
        pg8::gemm_phase(lds3, g, S, E);
    }
    xcd_barrier(xbar);
    {
        {
            const pg8::Gemm g{((bf16_t*)(p.ws + OFF_KVP)) + 0 * KVP_SEG, ((bf16_t*)(p.ws + OFF_W1K_T)), 8192, 256, 2048, 1024};
            pg8::StaticOrder S; S.init(8192, 256, G, bid);
            const pg8::Epi<EpCmpHid> E{{((bf16_t*)(p.ws + OFF_HIDK)), ((float*)(p.ws + OFF_BIAS1))}};
            pg8::gemm_phase(lds3, g, S, E);
        }
        {
            const pg8::Gemm g{((bf16_t*)(p.ws + OFF_KVP)) + 1 * KVP_SEG, ((bf16_t*)(p.ws + OFF_W1V_T)), 8192, 256, 2048, 1024};
            pg8::StaticOrder S; S.init(8192, 256, G, (bid + G / 2) % G);
            const pg8::Epi<EpCmpHid> E{{((bf16_t*)(p.ws + OFF_HIDV)), ((float*)(p.ws + OFF_BIAS1)) + 256}};
            pg8::gemm_phase(lds3, g, S, E);
        }
        __syncthreads();
        for (int vb = bid; vb < 1024; vb += G) d_ssd_states(((bf16_t*)(p.ws + OFF_PROJ)), ((float*)(p.ws + OFF_SMALL)), p.conv_w, p.conv_b, p.a_log, ((float*)(p.ws + OFF_ONSA)), ((float*)(p.ws + OFF_CTR + 4096)), vb, lds);
    }
    xcd_barrier(xbar);
    for (int vb = bid; vb < 2048 + 128; vb += G) {
        if (vb < 1024) d_cmp_out(((bf16_t*)(p.ws + OFF_HIDK)), p.cmp_w2_k, ((bf16_t*)(p.ws + OFF_KC)), vb); else if (vb < 2048) d_cmp_out(((bf16_t*)(p.ws + OFF_HIDV)), p.cmp_w2_v, ((bf16_t*)(p.ws + OFF_VC)), vb - 1024);
        else d_ssd_scan(((float*)(p.ws + OFF_ONSA)), ((float*)(p.ws + OFF_CTR + 4096)), ((bf16_t*)(p.ws + OFF_EIDX)), vb - 2048);
    }
    xcd_barrier(xbar);
    for (;;) {
        if (threadIdx.x == 0) *s_vb = (int)atomicAdd(&((unsigned*)(p.ws + OFF_CTR))[0], 1u);
        __syncthreads();
        const int i = *s_vb;
        __syncthreads();
        if (i >= 2048) break;
        const int qt = 127 - (i >> 4), bg = i & 15;
        d_nsa_cmp(((bf16_t*)(p.ws + OFF_PROJ)), ((bf16_t*)(p.ws + OFF_KC)), ((bf16_t*)(p.ws + OFF_VC)), ((float*)(p.ws + OFF_SMALL)), ((float*)(p.ws + OFF_ONSA)), ((unsigned*)(p.ws + OFF_HIDK)) + (size_t)(bg * 128 + qt) * 512, bg >> 1, bg & 1, qt, lds);
    }
    for (;;) {
        if (threadIdx.x == 0) *s_vb = (int)atomicAdd(&((unsigned*)(p.ws + OFF_CTR))[64], 1u);
        __syncthreads();
        const int i = *s_vb;
        __syncthreads();
        if (i >= 1024) break;
        d_ssd_out(((bf16_t*)(p.ws + OFF_PROJ)), ((float*)(p.ws + OFF_SMALL)), p.conv_w, p.conv_b, p.a_log, p.d_skip, ((bf16_t*)(p.ws + OFF_EIDX)), ((bf16_t*)(p.ws + OFF_YSSD)), i, lds);
    }
    xcd_barrier(xbar);
    for (;;) {
        if (threadIdx.x == 0) *s_vb = (int)atomicAdd(&((unsigned*)(p.ws + OFF_CTR))[128], 1u);
        __syncthreads();
        const int i = *s_vb;
        __syncthreads();
        if (i >= 2048) break;
        const int qt = 127 - (i >> 4), bg = i & 15;
        d_nsa_attn(((bf16_t*)(p.ws + OFF_QROPE)), ((bf16_t*)(p.ws + OFF_KVP)), ((float*)(p.ws + OFF_SMALL)), ((float*)(p.ws + OFF_ONSA)), ((unsigned*)(p.ws + OFF_HIDK)) + (size_t)(bg * 128 + qt) * 512, bg >> 1, bg & 1, qt, lds);
    }
    xcd_barrier(xbar);
    for (int vb = bid; vb < NTOK / 32; vb += G) d_mix_prep(((float*)(p.ws + OFF_ONSA)), ((bf16_t*)(p.ws + OFF_YSSD)), p.nsa_norm_w, p.ssd_norm_w, ((bf16_t*)(p.ws + OFF_H)), vb);
    xcd_barrier(xbar);
    {
        const pg8::Gemm g{((bf16_t*)(p.ws + OFF_H)), ((bf16_t*)(p.ws + OFF_WOUT_T)), NTOK, 1024, 1024, 1024};
        pg8::StaticOrder S; S.init(NTOK, 1024, G, bid);
        const pg8::Epi<EpOutProj> E{{p.x, ((float*)(p.ws + OFF_MOD)), p.out}};
        pg8::gemm_phase(lds3, g, S, E);
    }
    xcd_barrier(xbar);
    for (int vb = bid; vb < NTOK / 32; vb += G) d_norm_mod(p.out, p.norm2_w, ((float*)(p.ws + OFF_MOD)), 3072, 4096, ((bf16_t*)(p.ws + OFF_H)), vb);
    xcd_barrier(xbar);
    {
        const pg8::Gemm g{((bf16_t*)(p.ws + OFF_H)), ((bf16_t*)(p.ws + OFF_WQ_T)), NTOK, 2048, 1024, 1024};
        pg8::StaticOrder S; S.init(NTOK, 2048, G, bid);
        const pg8::Epi<EpStoreBf16> E{{((bf16_t*)(p.ws + OFF_PROJ)), 2048, 0}};
        pg8::gemm_phase(lds3, g, S, E);
    }
    xcd_barrier(xbar);
    for (int h = 0; h < 8; ++h) {
        __syncthreads();
        d_peer_stage_keys(((bf16_t*)(p.ws + OFF_SUBK)), h, lds);
        __syncthreads();
        for (int tile = bid; tile < 512; tile += G) d_peer_route(((bf16_t*)(p.ws + OFF_PROJ)), p.peer_qnorm_w, ((int*)(p.ws + OFF_EIDX)), ((float*)(p.ws + OFF_GATE)), tile, h, lds);
    }
    xcd_barrier(xbar);
    for (int vb = bid; vb < NTOK / 8; vb += G) d_peer_expert_mx(((bf16_t*)(p.ws + OFF_H)), ((unsigned char*)(p.ws + OFF_DOWN)), ((unsigned char*)(p.ws + OFF_DOWN + MIB(8))), ((float*)(p.ws + OFF_UP)), ((float*)(p.ws + OFF_UP + 65536)), ((int*)(p.ws + OFF_EIDX)), ((float*)(p.ws + OFF_GATE)), ((float*)(p.ws + OFF_MOD)), p.final_norm_w, p.out, vb, lds);
}

extern "C" void kernel_launch(void* const* d_in, const int* in_sizes, int n_in, void* d_out, int out_size, void* d_ws, size_t ws_size, hipStream_t stream) {
    if (ws_size < WS_NEED) { fprintf(stderr, "workspace too small\n"); return; }
    static int grid_blocks = 0;
    if (!grid_blocks) {
        int dev = 0, cus = 0, per_cu = 0;
        (void)hipGetDevice(&dev);
        (void)hipDeviceGetAttribute(&cus, hipDeviceAttributeMultiprocessorCount, dev);
        (void)hipOccupancyMaxActiveBlocksPerMultiprocessor(&per_cu, mega, 512, 0);
        if (per_cu < 1) fprintf(stderr, "occupancy query reports %d blocks per CU\n", per_cu);
        grid_blocks = cus;
    }
    Params p{};
    const float** pp = (const float**)&p;
    for (int i = 0; i < 27; ++i) pp[i] = (const float*)d_in[i];
    p.out = (float*)d_out; p.ws = (char*)d_ws;
    (void)hipMemsetAsync((char*)d_ws + OFF_BAR, 0, XCD_BAR_WORDS * 4, stream);
    void* args[] = {&p};
    hipError_t e = hipLaunchCooperativeKernel((void*)mega, dim3(grid_blocks), dim3(512), args, 0, stream);
    if (e != hipSuccess) fprintf(stderr, "cooperative launch failed: %s (grid %d)\n", hipGetErrorString(e), grid_blocks);
}
```

```cpp
#include <hip/hip_runtime.h>
#include <hip/hip_cooperative_groups.h>
#include <stdint.h>
#include <cstdio>
namespace cg = cooperative_groups;

typedef unsigned short bf16_t;
typedef short bf16x8 __attribute__((ext_vector_type(8)));
typedef float f32x4 __attribute__((ext_vector_type(4)));
typedef float f32x2 __attribute__((ext_vector_type(2)));
typedef unsigned u32x4 __attribute__((ext_vector_type(4)));
typedef unsigned u32x2 __attribute__((ext_vector_type(2)));

#define NB 8
#define SEQ 8192
#define NTOK 65536
#define DM 1024
#define PROJ_LD 2816
#define NIN_PAD 3072
#define C_Q 0
#define C_KCMP 512
#define C_KSEL 768
#define C_VSEL 896
#define C_KWIN 1024
#define C_VWIN 1152
#define C_Z 1280
#define C_XBC 1792
#define NCMP 511
#define EPS 1e-6f
#define KVP_SEG ((size_t)NB * 2 * SEQ * 64)

#define MIB(x) ((size_t)(x) << 20)
#define OFF_MOD    MIB(0)
#define OFF_ROPE   MIB(1)
#define OFF_BIAS1  MIB(2)
#define OFF_WIN_T  MIB(3)
#define OFF_WOUT_T MIB(9)
#define OFF_WQ_T   MIB(11)
#define OFF_SUBK   MIB(15)
#define OFF_W1K_T  MIB(16)
#define OFF_W1V_T  MIB(17)
#define OFF_KC     MIB(18)
#define OFF_VC     MIB(19)
#define OFF_HIDK   MIB(20)
#define OFF_HIDV   MIB(24)
#define OFF_DOWN   MIB(28)
#define OFF_UP     MIB(60)
#define OFF_SMALL  MIB(92)
#define OFF_H      MIB(100)
#define OFF_PROJ   MIB(228)
#define OFF_QROPE  MIB(580)
#define OFF_ONSA   MIB(644)
#define OFF_YSSD   MIB(772)
#define OFF_KVP    MIB(836)
#define OFF_EIDX   MIB(932)
#define OFF_GATE   MIB(964)
#define OFF_CTR    MIB(996)
#define OFF_BAR    (MIB(996) + 65536)
#define WS_NEED    MIB(997)

typedef __bf16 hwbf2 __attribute__((ext_vector_type(2)));
__device__ __forceinline__ bf16_t f2bf(float f) { const __bf16 h = (__bf16)f; return __builtin_bit_cast(bf16_t, h); }
__device__ __forceinline__ float bf2f(bf16_t h) { return __uint_as_float(((unsigned)h) << 16); }
__device__ __forceinline__ float bflo(unsigned u) { return __uint_as_float(u << 16); }
__device__ __forceinline__ float bfhi(unsigned u) { return __uint_as_float(u & 0xffff0000u); }
__device__ __forceinline__ unsigned pack2(float a, float b) { const f32x2 v = {a, b}; const hwbf2 r = __builtin_convertvector(v, hwbf2); return __builtin_bit_cast(unsigned, r); }
__device__ __forceinline__ float wave_sum(float v) {
#pragma unroll
    for (int o = 32; o; o >>= 1) v += __shfl_xor(v, o);
    return v;
}
__device__ __forceinline__ float wave_max(float v) {
#pragma unroll
    for (int o = 32; o; o >>= 1) v = fmaxf(v, __shfl_xor(v, o));
    return v;
}
__device__ __forceinline__ int tid_opaque() { int t = threadIdx.x; asm volatile("" : "+v"(t)); return t; }
__device__ __forceinline__ float gelu_tanh(float x) { const float u2 = 1.5957691216057308f * (x + 0.044715f * x * x * x); return x * __builtin_amdgcn_rcpf(1.0f + __expf(-u2)); }
__device__ __forceinline__ float silu(float x) { return x / (1.0f + __expf(-x)); }
__device__ __forceinline__ float sigmoidf(float x) { return 1.0f / (1.0f + __expf(-x)); }
__device__ __forceinline__ float softplusf(float x) { return x > 20.f ? x : log1pf(__expf(x)); }

__device__ __forceinline__ int inproj_src(int n) {
    if (n < 1280) return n;
    if (n < 1792) return 1304 + (n - 1280);
    if (n < 2816) return 1816 + (n - 1792);
    if (n < 2840) return 1280 + (n - 2816);
    if (n < 2848) return 2840 + (n - 2840);
    return -1;
}
__device__ __forceinline__ void d_transpose_w(const float* __restrict__ W, bf16_t* __restrict__ Wt, int K, int N, int mode, int nbx, int vb, char* lds) {
    const int tid_ = tid_opaque(); const int half = tid_ >> 8, t256 = tid_ & 255, tile = vb * 2 + half;
    float (*t)[33] = (float (*)[33])(lds + half * 4352);
    const int n0 = (tile % nbx) * 32, k0 = (tile / nbx) * 32, tx = t256 & 31, ty = t256 >> 5;
#pragma unroll
    for (int i = 0; i < 4; ++i) {
        const int k = k0 + ty + 8 * i, n = n0 + tx;
        const int src = mode == 1 ? inproj_src(n) : n;
        t[ty + 8 * i][tx] = (src >= 0 && src < N) ? W[(size_t)k * N + src] : 0.f;
    }
    __syncthreads();
#pragma unroll
    for (int i = 0; i < 4; ++i) Wt[(size_t)(n0 + ty + 8 * i) * K + k0 + tx] = f2bf(t[tx][ty + 8 * i]);
    __syncthreads();
}
__device__ __forceinline__ void d_convert_bf16(const float* __restrict__ in, bf16_t* __restrict__ out, size_t n8, int vb, int nvb) {
    size_t i = (size_t)vb * 512 + tid_opaque();
    const size_t stride = (size_t)nvb * 512;
    for (; i < n8; i += stride) {
        const f32x4 a = ((const f32x4*)in)[2 * i], b = ((const f32x4*)in)[2 * i + 1];
        u32x4 o; o.x = pack2(a.x, a.y); o.y = pack2(a.z, a.w); o.z = pack2(b.x, b.y); o.w = pack2(b.z, b.w);
        ((u32x4*)out)[i] = o;
    }
}
__device__ __forceinline__ void d_mod(const float* __restrict__ c, const float* __restrict__ w_ada, const float* __restrict__ b_ada, float* __restrict__ mod, int vb, char* lds) {
    float (*part)[8][64] = (float (*)[8][64])lds;
    const int tid = tid_opaque(), jl = tid & 63, kq = tid >> 6, j = vb * 64 + jl;
    float acc[8];
#pragma unroll
    for (int b = 0; b < 8; ++b) acc[b] = 0.f;
    for (int k0 = kq * 128; k0 < kq * 128 + 128; k0 += 16) {
        float wv[16];
#pragma unroll
        for (int i = 0; i < 16; ++i) wv[i] = w_ada[(size_t)(k0 + i) * 6144 + j];
#pragma unroll
        for (int i = 0; i < 16; ++i)
#pragma unroll
            for (int b = 0; b < 8; ++b) acc[b] += c[b * 1024 + k0 + i] * wv[i];
    }
#pragma unroll
    for (int b = 0; b < 8; ++b) part[kq][b][jl] = acc[b];
    __syncthreads();
    {
        const int b = tid >> 6, jj = tid & 63;
        float s = b_ada[vb * 64 + jj];
#pragma unroll
        for (int q = 0; q < 8; ++q) s += part[q][b][jj];
        mod[b * 6144 + vb * 64 + jj] = s;
    }
    __syncthreads();
}
__device__ __forceinline__ void d_rope_table(float2* __restrict__ rope, int vb) {
    const int i = vb * 512 + tid_opaque();
    if (i >= SEQ * 8) return;
    const int pos = i >> 3, f = i & 7;
    const double inv = pow(500000.0, -(double)f / 8.0);
    const double ang = (double)pos * inv;
    rope[i] = make_float2((float)cos(ang), (float)sin(ang));
}
__device__ __forceinline__ void d_bias1(const float* __restrict__ pe_k, const float* __restrict__ w1_k, const float* __restrict__ pe_v, const float* __restrict__ w1_v, float* __restrict__ bias1) {
    const int tid_ = tid_opaque(); const int which = tid_ >> 8, j = tid_ & 255;
    const float* pe = which ? pe_v : pe_k; const float* w1 = which ? w1_v : w1_k;
    float a = 0.f;
    for (int k0 = 0; k0 < 2048; k0 += 16) {
        float wv[16];
#pragma unroll
        for (int i = 0; i < 16; ++i) wv[i] = w1[(size_t)(k0 + i) * 256 + j];
#pragma unroll
        for (int i = 0; i < 16; ++i) a += pe[k0 + i] * wv[i];
    }
    bias1[which * 256 + j] = a;
}

template <bool XBF>
__device__ __forceinline__ void d_norm_mod(const void* __restrict__ xin, const float* __restrict__ w, const float* __restrict__ mod, int sh_off, int sc_off, bf16_t* __restrict__ out, int vb) {
    const int tid_ = tid_opaque(); const int lane = tid_ & 63, wid = tid_ >> 6;
    const size_t row0 = (size_t)vb * 32 + wid * 4; const int b = (int)(row0 >> 13);
    f32x4 v[4][4];
#pragma unroll
    for (int r = 0; r < 4; ++r)
#pragma unroll
        for (int k = 0; k < 4; ++k) {
            if (XBF) { const u32x2 t = *(const u32x2*)((const bf16_t*)xin + (row0 + r) * DM + k * 256 + lane * 4); v[r][k] = (f32x4){bflo(t.x), bfhi(t.x), bflo(t.y), bfhi(t.y)}; }
            else v[r][k] = *(const f32x4*)((const float*)xin + (row0 + r) * DM + k * 256 + lane * 4);
        }
    float rs[4];
#pragma unroll
    for (int r = 0; r < 4; ++r) {
        float ss = 0.f;
#pragma unroll
        for (int k = 0; k < 4; ++k) ss += v[r][k].x * v[r][k].x + v[r][k].y * v[r][k].y + v[r][k].z * v[r][k].z + v[r][k].w * v[r][k].w;
        rs[r] = rsqrtf(wave_sum(ss) * (1.0f / DM) + EPS);
    }
#pragma unroll
    for (int k = 0; k < 4; ++k) {
        const int col = k * 256 + lane * 4;
        const f32x4 wv = *(const f32x4*)(w + col), sc = *(const f32x4*)(mod + b * 6144 + sc_off + col), sh = *(const f32x4*)(mod + b * 6144 + sh_off + col);
        const f32x4 ws = wv * (sc + 1.0f);
#pragma unroll
        for (int r = 0; r < 4; ++r) {
            const f32x4 y = v[r][k] * rs[r] * ws + sh;
            u32x2 o; o.x = pack2(y.x, y.y); o.y = pack2(y.z, y.w);
            *(u32x2*)(out + (row0 + r) * DM + col) = o;
        }
    }
}

namespace pg8 {
#define PG8_LAS __attribute__((address_space(3)))
constexpr int BM = 256, BK = 64, HALF = 128, HTB = HALF * BK * 2  , STAGE_BYTES = 8 * HTB, NXCD = 8, WGM = 8;
__host__ __device__ __forceinline__ int lds_byte(int r, int c) { const int st = (r >> 4) * 2 + (c >> 5), rr = r & 15, cc = c & 31, ob = rr * 64 + cc * 2; return st * 1024 + (ob ^ (((ob >> 9) & 1) << 5)); }
__host__ __device__ __forceinline__ void stage_rc(int b, int& R, int& C) { const int st = b / 1024, sb = b % 1024, swz = sb ^ (((sb >> 9) & 1) << 5); R = (st >> 1) * 16 + swz / 64; C = (st & 1) * 32 + (swz % 64) / 2; }
__host__ __device__ __forceinline__ int perm32(int rho) { const int n = rho >> 4, i = rho & 15; return 8 * (i >> 2) + 4 * n + (i & 3); }
struct Unit { int pm, pn; };
struct Gemm { const bf16_t* A; const bf16_t* Bt; int M, N, K, lda; };
struct StaticOrder {
    int nM, nN, nwg, G, c;
    __host__ __device__ void init(int M, int N, int G_, int c_) { nM = M / BM; nN = N / BM; nwg = nM * nN; G = G_; c = c_; }
    __host__ __device__ bool next(int i, Unit& u) const {
        const long L = (long)i * G + c; if (L >= nwg) return false;
        int wgid = (int)L; { const int q = nwg / NXCD, r = nwg % NXCD, xcd = wgid % NXCD, off = wgid / NXCD; wgid = (xcd < r ? xcd * (q + 1) : r * (q + 1) + (xcd - r) * q) + off; }
        const int nig = WGM * nN, gid = wgid / nig, fm = gid * WGM, gsz = (nM - fm) < WGM ? (nM - fm) : WGM;
        u.pm = fm + ((wgid % nig) % gsz); u.pn = (wgid % nig) / gsz; return true;
    }
};
template <class F> struct Epi {
    F f;
    __device__ __forceinline__ void operator()(const f32x4 (&acc)[2][2][4][2], const Unit& u, int wr, int wc, int fr, int fq) const {
#pragma unroll
        for (int ai = 0; ai < 2; ++ai)
#pragma unroll
            for (int m = 0; m < 4; ++m)
#pragma unroll
                for (int bj = 0; bj < 2; ++bj)
                    f(u.pm * BM + ai * HALF + wr * 64 + m * 16 + fr, u.pn * BM + bj * HALF + wc * 32 + 8 * fq, acc[ai][bj][m][0], acc[ai][bj][m][1]);
    }
};
template <class E, class Sched>
__device__ __forceinline__ void gemm_phase(PG8_LAS unsigned char* lds, const Gemm g, const Sched& S, const E& Ep) {
    const int tid = tid_opaque(), wid = __builtin_amdgcn_readfirstlane(tid >> 6), lane = tid & 63, wr = wid >> 2, wc = wid & 3, fr = lane & 15, fq = lane >> 4;
    const int K = g.K, nt = K / BK;
    unsigned voffA[2], voffB[2];
#pragma unroll
    for (int i = 0; i < 2; ++i) { int R, C; stage_rc(tid * 16 + i * 8192, R, C); const int Rb = (R & ~31) + perm32(R & 31); voffA[i] = (unsigned)(R * g.lda + C) * 2u; voffB[i] = (unsigned)(Rb * K + C) * 2u; }
    const size_t kstep = (size_t)(BK * 2);
    const size_t hstep = (size_t)HALF * K * 2, hstepA = (size_t)HALF * g.lda * 2;
    const size_t tstep = 2 * hstep, tstepA = 2 * hstepA;
    const unsigned ldsw = (unsigned)wid * 1024u;
    const int aoff = lds_byte(wr * 64 + fr, fq * 8), boff = lds_byte(wc * 32 + fr, fq * 8);
#define PG8_SA(b, h) (((b) * 2 + (h)) * HTB)
#define PG8_SB(b, h) ((4 + (b) * 2 + (h)) * HTB)
#define PG8_STAGE(bufoff, gbase, voff) do { _Pragma("unroll") for (int _i = 0; _i < 2; ++_i) \
        __builtin_amdgcn_global_load_lds((const unsigned*)((const char*)(gbase) + (voff)[_i]), (PG8_LAS unsigned*)(lds + (bufoff) + ldsw + _i * 8192), 16, 0, 0); } while (0)
#define PG8_LDA(dst, b, h) do { _Pragma("unroll") for (int m = 0; m < 4; ++m) _Pragma("unroll") for (int k = 0; k < 2; ++k) dst[m][k] = *(const PG8_LAS bf16x8*)(lds + PG8_SA(b, h) + aoff + m * 2048 + k * 1024); } while (0)
#define PG8_LDB(dst, b, h) do { _Pragma("unroll") for (int n = 0; n < 2; ++n) _Pragma("unroll") for (int k = 0; k < 2; ++k) dst[n][k] = *(const PG8_LAS bf16x8*)(lds + PG8_SB(b, h) + boff + n * 2048 + k * 1024); } while (0)
#define PG8_MMA(ai, bj, At, Bt) do { __builtin_amdgcn_s_setprio(1); _Pragma("unroll") for (int m = 0; m < 4; ++m) _Pragma("unroll") for (int n = 0; n < 2; ++n) _Pragma("unroll") for (int k = 0; k < 2; ++k) \
        acc[ai][bj][m][n] = __builtin_amdgcn_mfma_f32_16x16x32_bf16(Bt[n][k], At[m][k], acc[ai][bj][m][n], 0, 0, 0); __builtin_amdgcn_s_setprio(0); } while (0)
#define PG8_WAIT_V(n) asm volatile("s_waitcnt vmcnt(" #n ")" ::: "memory")
#define PG8_WAIT_L(n) asm volatile("s_waitcnt lgkmcnt(" #n ")" ::: "memory")
#define PG8_BAR __builtin_amdgcn_s_barrier()
#define PG8_SCHED __builtin_amdgcn_sched_barrier(0)
    Unit cur, nxt; int ui = 0;
    if (!S.next(0, cur)) return;
    f32x4 acc[2][2][4][2];
#pragma unroll
    for (int a = 0; a < 2; ++a)
#pragma unroll
        for (int b = 0; b < 2; ++b)
#pragma unroll
            for (int m = 0; m < 4; ++m)
#pragma unroll
                for (int n = 0; n < 2; ++n) acc[a][b][m][n] = (f32x4){0.f, 0.f, 0.f, 0.f};
    bf16x8 At[4][2], B0[2][2], B1[2][2];
    const char* cA = (const char*)g.A + (size_t)cur.pm * tstepA; const char* cB = (const char*)g.Bt + (size_t)cur.pn * tstep;
    PG8_STAGE(PG8_SB(0, 0), cB, voffB); PG8_STAGE(PG8_SB(0, 1), cB + hstep, voffB); PG8_STAGE(PG8_SA(0, 0), cA, voffA); PG8_STAGE(PG8_SA(0, 1), cA + hstepA, voffA);
    if (wr == 1) PG8_BAR;
    PG8_WAIT_V(2); PG8_BAR;
    PG8_STAGE(PG8_SB(1, 0), cB + kstep, voffB); PG8_STAGE(PG8_SA(1, 0), cA + kstep, voffA); PG8_STAGE(PG8_SB(1, 1), cB + hstep + kstep, voffB);
    PG8_WAIT_V(6); PG8_BAR;
    for (;;) {
        const bool has_next = S.next(ui + 1, nxt);
        const char* nA = has_next ? (const char*)g.A + (size_t)nxt.pm * tstepA : cA; const char* nB = has_next ? (const char*)g.Bt + (size_t)nxt.pn * tstep : cB;
        for (int t = 0; t < nt; t += 2) {
            const bool last = (t == nt - 2);
            const char* a1 = cA + (size_t)(t + 1) * kstep;
            const char* a2 = last ? nA : cA + (size_t)(t + 2) * kstep; const char* b2 = last ? nB : cB + (size_t)(t + 2) * kstep;
            const char* a3 = a2 + kstep; const char* b3 = b2 + kstep;
            PG8_LDB(B0, 0, 0); PG8_LDB(B1, 0, 1); PG8_SCHED; PG8_LDA(At, 0, 0); PG8_STAGE(PG8_SA(1, 1), a1 + hstepA, voffA);
            PG8_WAIT_V(8); PG8_WAIT_L(0); PG8_BAR; PG8_MMA(0, 0, At, B0); PG8_MMA(0, 1, At, B1); PG8_BAR; PG8_SCHED;
            PG8_LDA(At, 0, 1); PG8_STAGE(PG8_SB(0, 0), b2, voffB); PG8_STAGE(PG8_SB(0, 1), b2 + hstep, voffB); PG8_STAGE(PG8_SA(0, 0), a2, voffA);
            PG8_WAIT_V(8); PG8_WAIT_L(0); PG8_BAR; PG8_MMA(1, 0, At, B0); PG8_MMA(1, 1, At, B1); PG8_BAR; PG8_SCHED;
            PG8_LDB(B0, 1, 0); PG8_LDB(B1, 1, 1); PG8_SCHED; PG8_LDA(At, 1, 0); PG8_STAGE(PG8_SA(0, 1), a2 + hstepA, voffA);
            PG8_WAIT_V(8); PG8_WAIT_L(0); PG8_BAR; PG8_MMA(0, 0, At, B0); PG8_MMA(0, 1, At, B1); PG8_BAR; PG8_SCHED;
            PG8_LDA(At, 1, 1); PG8_STAGE(PG8_SB(1, 0), b3, voffB); PG8_STAGE(PG8_SB(1, 1), b3 + hstep, voffB); PG8_STAGE(PG8_SA(1, 0), a3, voffA);
            PG8_WAIT_V(8); PG8_WAIT_L(0); PG8_BAR; PG8_MMA(1, 0, At, B0); PG8_MMA(1, 1, At, B1); PG8_BAR; PG8_SCHED;
        }
        if (wr == 0) PG8_BAR;
        Ep(acc, cur, wr, wc, fr, fq);
        if (!has_next) break;
#pragma unroll
        for (int a = 0; a < 2; ++a)
#pragma unroll
            for (int b = 0; b < 2; ++b)
#pragma unroll
                for (int m = 0; m < 4; ++m)
#pragma unroll
                    for (int n = 0; n < 2; ++n) acc[a][b][m][n] = (f32x4){0.f, 0.f, 0.f, 0.f};
        cur = nxt; cA = nA; cB = nB; ++ui;
        if (wr == 1) PG8_BAR;
    }
    PG8_WAIT_V(0);
    PG8_BAR;
#undef PG8_SA
#undef PG8_SB
#undef PG8_STAGE
#undef PG8_LDA
#undef PG8_LDB
#undef PG8_MMA
#undef PG8_WAIT_V
#undef PG8_WAIT_L
#undef PG8_BAR
#undef PG8_SCHED
}
}

__device__ __forceinline__ u32x4 pack8(f32x4 a, f32x4 b) { u32x4 o; o.x = pack2(a.x, a.y); o.y = pack2(a.z, a.w); o.z = pack2(b.x, b.y); o.w = pack2(b.z, b.w); return o; }
struct EpInProj { bf16_t* proj; bf16_t* qrope; bf16_t* kvp; float* small; const float2* rope; const float* dt_bias;
    __device__ __forceinline__ void operator()(int m, int n0, f32x4 a, f32x4 b) const {
        if (n0 < 2816) {
            const bool is_q = n0 < 512;
            const bool roped_seg = is_q || (n0 >= C_KSEL && n0 < C_VSEL) || (n0 >= C_KWIN && n0 < C_VWIN);
            if (is_q) *(u32x4*)(proj + (size_t)m * PROJ_LD + n0) = pack8(a, b);
            if (roped_seg && (n0 & 32) == 0) {
                f32x4 pa, pb;
                pa.x = __shfl_xor(a.x, 16); pa.y = __shfl_xor(a.y, 16); pa.z = __shfl_xor(a.z, 16); pa.w = __shfl_xor(a.w, 16);
                pb.x = __shfl_xor(b.x, 16); pb.y = __shfl_xor(b.y, 16); pb.z = __shfl_xor(b.z, 16); pb.w = __shfl_xor(b.w, 16);
                if ((n0 & 63) < 16) {
                    const float sgn = (n0 & 8) ? 1.f : -1.f;
                    const f32x4* rp = (const f32x4*)(rope + (m & (SEQ - 1)) * 8);
                    const f32x4 c01 = rp[0], c23 = rp[1], c45 = rp[2], c67 = rp[3];
                    a.x = a.x * c01.x + sgn * pa.x * c01.y; a.y = a.y * c01.z + sgn * pa.y * c01.w;
                    a.z = a.z * c23.x + sgn * pa.z * c23.y; a.w = a.w * c23.z + sgn * pa.w * c23.w;
                    b.x = b.x * c45.x + sgn * pb.x * c45.y; b.y = b.y * c45.z + sgn * pb.y * c45.w;
                    b.z = b.z * c67.x + sgn * pb.z * c67.y; b.w = b.w * c67.z + sgn * pb.w * c67.w;
                }
            }
            const u32x4 o = pack8(a, b);
            if (is_q) *(u32x4*)(qrope + (size_t)m * 512 + n0) = o;
            else if (n0 < C_Z) {
                const int r = n0 - C_KCMP, seg = r >> 7, g = (r >> 6) & 1, d = r & 63, bb = m >> 13, t = m & (SEQ - 1);
                *(u32x4*)(kvp + (size_t)seg * KVP_SEG + ((size_t)(bb * 2 + g) * SEQ + t) * 64 + d) = o;
            }
            else *(u32x4*)(proj + (size_t)m * PROJ_LD + n0) = o;
        } else if (n0 < 2848) {
            const int c = n0 - 2816; f32x4 o0, o1;
            if (c < 24) { o0.x = sigmoidf(a.x); o0.y = sigmoidf(a.y); o0.z = sigmoidf(a.z); o0.w = sigmoidf(a.w); o1.x = sigmoidf(b.x); o1.y = sigmoidf(b.y); o1.z = sigmoidf(b.z); o1.w = sigmoidf(b.w); }
            else { const float* db = dt_bias; o0.x = softplusf(a.x + db[0]); o0.y = softplusf(a.y + db[1]); o0.z = softplusf(a.z + db[2]); o0.w = softplusf(a.w + db[3]);
                   o1.x = softplusf(b.x + db[4]); o1.y = softplusf(b.y + db[5]); o1.z = softplusf(b.z + db[6]); o1.w = softplusf(b.w + db[7]); }
            *(f32x4*)(small + (size_t)m * 32 + c) = o0; *(f32x4*)(small + (size_t)m * 32 + c + 4) = o1;
        }
    } };
struct EpCmpHid { bf16_t* hid; const float* bias;
    __device__ __forceinline__ void operator()(int m, int n0, f32x4 a, f32x4 b) const {
        const f32x4 b0 = *(const f32x4*)(bias + n0), b1 = *(const f32x4*)(bias + n0 + 4);
        a.x = gelu_tanh(a.x + b0.x); a.y = gelu_tanh(a.y + b0.y); a.z = gelu_tanh(a.z + b0.z); a.w = gelu_tanh(a.w + b0.w);
        b.x = gelu_tanh(b.x + b1.x); b.y = gelu_tanh(b.y + b1.y); b.z = gelu_tanh(b.z + b1.z); b.w = gelu_tanh(b.w + b1.w);
        *(u32x4*)(hid + (size_t)m * 256 + n0) = pack8(a, b);
    } };
struct EpOutProj { const float* x; const float* mod; bf16_t* x1;
    __device__ __forceinline__ void operator()(int m, int n0, f32x4 a, f32x4 b) const {
        const int bb = m >> 13;
        const f32x4 x0 = *(const f32x4*)(x + (size_t)m * DM + n0), x4 = *(const f32x4*)(x + (size_t)m * DM + n0 + 4);
        const f32x4 g0 = *(const f32x4*)(mod + bb * 6144 + 2048 + n0), g4 = *(const f32x4*)(mod + bb * 6144 + 2048 + n0 + 4);
        *(u32x4*)(x1 + (size_t)m * DM + n0) = pack8(x0 + g0 * a, x4 + g4 * b);
    } };
struct EpStoreBf16 { bf16_t* out; int ld; int pad;
    __device__ __forceinline__ void operator()(int m, int n0, f32x4 a, f32x4 b) const { *(u32x4*)(out + (size_t)m * ld + n0) = pack8(a, b); } };

__device__ __forceinline__ void d_cmp_out(const bf16_t* __restrict__ hid, const float* __restrict__ w2, bf16_t* __restrict__ out, int vb) {
    const int tid_ = tid_opaque(); const int m = vb * 8 + (tid_ >> 6), d = tid_ & 63;
    float a = 0.f;
#pragma unroll 8
    for (int j = 0; j < 256; ++j) a += bf2f(hid[(size_t)m * 256 + j]) * w2[j * 64 + d];
    out[(size_t)m * 64 + d] = f2bf(a);
}

#define KLD 80
#define NSA_OFF_KS0  0
#define NSA_OFF_VT0  10240
#define NSA_OFF_KS1  20480
#define NSA_OFF_VT1  30720
#define NSA_OFF_IMP  40960
#define NSA_OFF_SELW 74752
#define NSA_OFF_ANYW 75776
#define NSA_OFF_BL   75808
#define NSA_OFF_QS   76352
#define NSA_LDS      (76352 + 8 * 32 * KLD * 2)
#define SM_C 0.18033688011112042f

struct KVStage { u32x4 k, v; };
__device__ __forceinline__ void nsa_stage_load(KVStage& st, const bf16_t* kb, const bf16_t* vb, int tid) {
    st.k = *(const u32x4*)(kb + tid * 8); st.v = *(const u32x4*)(vb + tid * 8);
}
__device__ __forceinline__ void nsa_stage_store(bf16_t* Ks, bf16_t* Vt, int tid, const KVStage& st) {
    const int r = tid >> 3, c = tid & 7;
    *(u32x4*)(Ks + r * KLD + c * 8) = st.k;
    *(u32x4*)(Vt + r * KLD + c * 8) = st.v;
}
__device__ __forceinline__ void nsa_load_q(const bf16_t* qsrc, size_t ld, int lane, bf16_t* Qs) {
    u32x4 r[4];
#pragma unroll
    for (int i = 0; i < 4; ++i) { const int p = lane + 64 * i; r[i] = *(const u32x4*)(qsrc + (size_t)(p >> 3) * ld + (p & 7) * 8); }
#pragma unroll
    for (int i = 0; i < 4; ++i) { const int p = lane + 64 * i; *(u32x4*)(Qs + (p >> 3) * KLD + (p & 7) * 8) = r[i]; }
}
__device__ __forceinline__ void nsa_qk(const bf16_t* Ks, const bf16_t* Qs, f32x4 (&s)[4][2], int fr, int fq) {
#pragma unroll
    for (int kt = 0; kt < 4; ++kt)
#pragma unroll
        for (int tt = 0; tt < 2; ++tt) s[kt][tt] = (f32x4){0.f, 0.f, 0.f, 0.f};
#pragma unroll
    for (int ks = 0; ks < 2; ++ks) {
        bf16x8 qf[2];
#pragma unroll
        for (int tt = 0; tt < 2; ++tt) qf[tt] = *(const bf16x8*)(Qs + (tt * 16 + fr) * KLD + ks * 32 + fq * 8);
#pragma unroll
        for (int kt = 0; kt < 4; ++kt) {
            const bf16x8 kf = *(const bf16x8*)(Ks + (kt * 16 + fr) * KLD + ks * 32 + fq * 8);
#pragma unroll
            for (int tt = 0; tt < 2; ++tt) s[kt][tt] = __builtin_amdgcn_mfma_f32_16x16x32_bf16(kf, qf[tt], s[kt][tt], 0, 0, 0);
        }
    }
}
__device__ __forceinline__ void nsa_pv(const bf16_t* Vt, const f32x4 (&p)[4][2], f32x4 (&o)[4][2], int fr, int fq) {
#pragma unroll
    for (int ks2 = 0; ks2 < 2; ++ks2) {
        bf16x8 pf[2];
#pragma unroll
        for (int tt = 0; tt < 2; ++tt) {
            const f32x4 a = p[2 * ks2][tt], b = p[2 * ks2 + 1][tt];
            u32x4 w; w.x = pack2(a.x, a.y); w.y = pack2(a.z, a.w); w.z = pack2(b.x, b.y); w.w = pack2(b.z, b.w);
            pf[tt] = __builtin_bit_cast(bf16x8, w);
        }
#pragma unroll
        for (int dt = 0; dt < 4; ++dt) {
            typedef short s16x4 __attribute__((ext_vector_type(4)));
            const bf16_t* vp = Vt + (ks2 * 32 + 4 * fq + (fr >> 2)) * KLD + dt * 16 + 4 * (fr & 3);
            const s16x4 a0 = __builtin_amdgcn_ds_read_tr16_b64_v4i16((__attribute__((address_space(3))) s16x4*)vp);
            const s16x4 a1 = __builtin_amdgcn_ds_read_tr16_b64_v4i16((__attribute__((address_space(3))) s16x4*)(vp + 16 * KLD));
            const bf16x8 vf = (bf16x8){a0.x, a0.y, a0.z, a0.w, a1.x, a1.y, a1.z, a1.w};
#pragma unroll
            for (int tt = 0; tt < 2; ++tt) o[dt][tt] = __builtin_amdgcn_mfma_f32_16x16x32_bf16(vf, pf[tt], o[dt][tt], 0, 0, 0);
        }
    }
}
template <int MK>
__device__ __forceinline__ bool nsa_valid(int kk, int ti, int n0, int t0) {
    if (MK == 1) return kk <= ti;
    if (MK == 2) return kk > ti;
    return 16 * (n0 + kk) + 31 <= t0 + ti;
}
template <int MK, bool WITH_O>
__device__ __forceinline__ void nsa_softmax(f32x4 (&s)[4][2], float (&m)[2], float (&l)[2], f32x4 (&o)[4][2], const bool (&selb)[2], int tib, int fq, int n0, int t0) {
#pragma unroll
    for (int tt = 0; tt < 2; ++tt) {
        const int ti = tib + tt * 16;
        float mx = -1e30f;
#pragma unroll
        for (int kt = 0; kt < 4; ++kt)
#pragma unroll
            for (int jj = 0; jj < 4; ++jj) {
                const int kk = kt * 16 + 4 * fq + jj;
                const bool v = selb[tt] && nsa_valid<MK>(kk, ti, n0, t0);
                const float sv = v ? s[kt][tt][jj] * SM_C : -1e30f;
                s[kt][tt][jj] = sv; mx = fmaxf(mx, sv);
            }
        mx = fmaxf(mx, __shfl_xor(mx, 16)); mx = fmaxf(mx, __shfl_xor(mx, 32));
        const float mn = fmaxf(m[tt], mx);
        const float alpha = __builtin_amdgcn_exp2f(m[tt] - mn);
        m[tt] = mn;
        float ls = 0.f;
#pragma unroll
        for (int kt = 0; kt < 4; ++kt)
#pragma unroll
            for (int jj = 0; jj < 4; ++jj) {
                const float sv = s[kt][tt][jj];
                const float pv = sv > -1e29f ? __builtin_amdgcn_exp2f(sv - mn) : 0.f;
                s[kt][tt][jj] = pv; ls += pv;
            }
        l[tt] = l[tt] * alpha + ls;
        if (WITH_O) {
#pragma unroll
            for (int dt = 0; dt < 4; ++dt) o[dt][tt] *= alpha;
        }
    }
}
template <bool WITH_O = true>
__device__ __forceinline__ void nsa_softmax_fast(f32x4 (&s)[4][2], float (&m)[2], float (&l)[2], f32x4 (&o)[4][2], const float (&bias)[2]) {
#pragma unroll
    for (int tt = 0; tt < 2; ++tt) {
        float mr = fmaxf(fmaxf(s[0][tt][0], s[0][tt][1]), fmaxf(s[0][tt][2], s[0][tt][3]));
#pragma unroll
        for (int kt = 1; kt < 4; ++kt) mr = fmaxf(mr, fmaxf(fmaxf(s[kt][tt][0], s[kt][tt][1]), fmaxf(s[kt][tt][2], s[kt][tt][3])));
        mr = fmaxf(mr, __shfl_xor(mr, 16)); mr = fmaxf(mr, __shfl_xor(mr, 32));
        const float mx = mr * SM_C + bias[tt];
        const float mold = m[tt], mn = fmaxf(mold, mx);
        m[tt] = mn;
        const float off = bias[tt] - mn;
        float ls = 0.f;
#pragma unroll
        for (int kt = 0; kt < 4; ++kt)
#pragma unroll
            for (int jj = 0; jj < 4; ++jj) { const float pv = __builtin_amdgcn_exp2f(__builtin_fmaf(s[kt][tt][jj], SM_C, off)); s[kt][tt][jj] = pv; ls += pv; }
        if (__builtin_amdgcn_ballot_w64(mn > mold) != 0ull) {
            const float alpha = __builtin_amdgcn_exp2f(mold - mn);
            l[tt] = l[tt] * alpha + ls;
            if (WITH_O) {
#pragma unroll
                for (int dt = 0; dt < 4; ++dt) o[dt][tt] *= alpha;
            }
        } else l[tt] += ls;
    }
}
__device__ __forceinline__ void ins16(unsigned (&L)[16], unsigned x) {
#pragma unroll
    for (int i = 0; i < 16; ++i) { const unsigned hi = L[i] > x ? L[i] : x; x = L[i] > x ? x : L[i]; L[i] = hi; }
}
__device__ __forceinline__ void merge16(unsigned (&L)[16], const unsigned (&P)[16]) {
#pragma unroll
    for (int i = 0; i < 16; ++i) L[i] = L[i] > P[15 - i] ? L[i] : P[15 - i];
#pragma unroll
    for (int st = 8; st >= 1; st >>= 1)
#pragma unroll
        for (int i = 0; i < 16; ++i)
            if ((i & st) == 0) { const unsigned a = L[i], b = L[i + st]; L[i] = a > b ? a : b; L[i + st] = a > b ? b : a; }
}
__device__ __forceinline__ void sort16(unsigned (&v)[16]) {
#pragma unroll
    for (int k = 2; k <= 16; k <<= 1)
#pragma unroll
        for (int j = k >> 1; j > 0; j >>= 1)
#pragma unroll
            for (int i = 0; i < 16; ++i) {
                const int l = i ^ j;
                if (l > i) {
                    const unsigned a = v[i], b = v[l];
                    const unsigned hi = a > b ? a : b, lo = a > b ? b : a;
                    if ((i & k) == 0) { v[i] = hi; v[l] = lo; } else { v[i] = lo; v[l] = hi; }
                }
            }
}
__device__ __forceinline__ void nsa_scale(const f32x4 (&o)[4][2], const float (&l)[2], bool l_is_partial, const float* gsrc, int tib, f32x4 (&r)[4][2], bool accum) {
#pragma unroll
    for (int tt = 0; tt < 2; ++tt) {
        float lt = l[tt];
        if (l_is_partial) { lt += __shfl_xor(lt, 16); lt += __shfl_xor(lt, 32); }
        const float gv = gsrc[(size_t)(tib + tt * 16) * 32];
        const float sc = l_is_partial ? (lt > 0.f ? gv / lt : 0.f) : gv;
#pragma unroll
        for (int dt = 0; dt < 4; ++dt) r[dt][tt] = accum ? r[dt][tt] + o[dt][tt] * sc : o[dt][tt] * sc;
    }
}
template <bool ACCUM>
__device__ __forceinline__ void nsa_store(const f32x4 (&r)[4][2], bf16_t* obase, int tib, int fq) {
#pragma unroll
    for (int tt = 0; tt < 2; ++tt)
#pragma unroll
        for (int dt = 0; dt < 4; ++dt) {
            bf16_t* op = obase + (size_t)(tib + tt * 16) * 512 + dt * 16 + 4 * fq;
            f32x4 v = r[dt][tt];
            if (ACCUM) { const u32x2 t = *(const u32x2*)op; v += (f32x4){bflo(t.x), bfhi(t.x), bflo(t.y), bfhi(t.y)}; }
            u32x2 w; w.x = pack2(v.x, v.y); w.y = pack2(v.z, v.w);
            *(u32x2*)op = w;
        }
}
struct NsaBufs { bf16_t *Ks0, *Vt0, *Ks1, *Vt1; };
template <class SRC, class BODY>
__device__ __forceinline__ void nsa_pipeline(int n, const bf16_t* kb, const bf16_t* vb, const NsaBufs& B, int tid, SRC src, BODY body) {
    KVStage s0, s1;
    nsa_stage_load(s0, kb + (size_t)src(0) * 4096, vb + (size_t)src(0) * 4096, tid);
    s1 = s0;
    if (n > 1) nsa_stage_load(s1, kb + (size_t)src(1) * 4096, vb + (size_t)src(1) * 4096, tid);
    __syncthreads();
    nsa_stage_store(B.Ks0, B.Vt0, tid, s0);
    if (n > 2) nsa_stage_load(s0, kb + (size_t)src(2) * 4096, vb + (size_t)src(2) * 4096, tid);
#pragma unroll 1
    for (int i = 0; i < n; i += 2) {
        __syncthreads();
        if (i + 1 < n) nsa_stage_store(B.Ks1, B.Vt1, tid, s1);
        if (i + 3 < n) nsa_stage_load(s1, kb + (size_t)src(i + 3) * 4096, vb + (size_t)src(i + 3) * 4096, tid);
        body(src(i), B.Ks0, B.Vt0);
        if (i + 1 < n) {
            __syncthreads();
            if (i + 2 < n) nsa_stage_store(B.Ks0, B.Vt0, tid, s0);
            if (i + 4 < n) nsa_stage_load(s0, kb + (size_t)src(i + 4) * 4096, vb + (size_t)src(i + 4) * 4096, tid);
            body(src(i + 1), B.Ks1, B.Vt1);
        }
    }
}

__device__ __forceinline__ void d_nsa_cmp(const bf16_t* __restrict__ proj, const bf16_t* __restrict__ kc, const bf16_t* __restrict__ vc,
                                          const float* __restrict__ small, bf16_t* __restrict__ onsa, unsigned* __restrict__ selrec, int b, int g, int qt, char* lds) {
    const NsaBufs B{(bf16_t*)(lds + NSA_OFF_KS0), (bf16_t*)(lds + NSA_OFF_VT0), (bf16_t*)(lds + NSA_OFF_KS1), (bf16_t*)(lds + NSA_OFF_VT1)};
    float* imp = (float*)(lds + NSA_OFF_IMP);
    unsigned* selw = (unsigned*)(lds + NSA_OFF_SELW);
    unsigned* anyw = (unsigned*)(lds + NSA_OFF_ANYW);
    int* blist = (int*)(lds + NSA_OFF_BL);
    const int tid = tid_opaque(), lane = tid & 63, w = tid >> 6, hd = w & 3, th = w >> 2, fr = lane & 15, fq = lane >> 4;
    const int tib = th * 32 + fr;
    const size_t tok0 = (size_t)b * SEQ + (size_t)qt * 64;
    const int t0 = qt * 64;
    const float* gbase = small + tok0 * 32 + g * 12 + hd * 3;
    bf16_t* obase = onsa + tok0 * 512 + g * 256 + hd * 64;
    const bool sel_all[2] = {true, true};
    const float bias0[2] = {0.f, 0.f};

    for (int i = tid; i < 64 * 132; i += 512) imp[i] = 0.f;
    if (tid < 4) anyw[tid] = 0u;

    bf16_t* Qs = (bf16_t*)(lds + NSA_OFF_QS) + w * 32 * KLD;
    f32x4 s[4][2], o[4][2];
    float m[2], l[2];

    nsa_load_q(proj + (tok0 + th * 32) * PROJ_LD + C_Q + g * 256 + hd * 64, PROJ_LD, lane, Qs);
    const int ncb = (4 * qt + 3 + 63) >> 6;
    {
        const bf16_t* kb = kc + (size_t)(b * 2 + g) * 512 * 64;
        const bf16_t* vb = vc + (size_t)(b * 2 + g) * 512 * 64;
#pragma unroll
        for (int tt = 0; tt < 2; ++tt) { m[tt] = -1e30f; l[tt] = 0.f; }
        nsa_pipeline(ncb, kb, vb, B, tid, [&](int i) { return i; }, [&](int blk_, bf16_t* Ks, bf16_t* Vt) {
            nsa_qk(Ks, Qs, s, fr, fq);
            if (16 * (blk_ * 64 + 63) + 31 <= t0) nsa_softmax_fast<false>(s, m, l, o, bias0);
            else nsa_softmax<3, false>(s, m, l, o, sel_all, tib, fq, blk_ * 64, t0);
        });
        float linv[2];
#pragma unroll
        for (int tt = 0; tt < 2; ++tt) { float lt = l[tt]; lt += __shfl_xor(lt, 16); lt += __shfl_xor(lt, 32); linv[tt] = lt > 0.f ? 1.0f / lt : 0.f; }
#pragma unroll
        for (int dt = 0; dt < 4; ++dt)
#pragma unroll
            for (int tt = 0; tt < 2; ++tt) o[dt][tt] = (f32x4){0.f, 0.f, 0.f, 0.f};
        nsa_pipeline(ncb, kb, vb, B, tid, [&](int i) { return i; }, [&](int blk_, bf16_t* Ks, bf16_t* Vt) {
            nsa_qk(Ks, Qs, s, fr, fq);
            const bool full = 16 * (blk_ * 64 + 63) + 31 <= t0;
#pragma unroll
            for (int tt = 0; tt < 2; ++tt) {
                const int ti = tib + tt * 16;
                const float nm = -m[tt], li = linv[tt];
                float hs[4], as[4];
#pragma unroll
                for (int kt = 0; kt < 4; ++kt) {
                    f32x4 pv;
                    if (full) {
#pragma unroll
                        for (int jj = 0; jj < 4; ++jj) pv[jj] = __builtin_amdgcn_exp2f(__builtin_fmaf(s[kt][tt][jj], SM_C, nm)) * li;
                    } else {
#pragma unroll
                        for (int jj = 0; jj < 4; ++jj) {
                            const int kk = kt * 16 + 4 * fq + jj;
                            pv[jj] = nsa_valid<3>(kk, ti, blk_ * 64, t0) ? __builtin_amdgcn_exp2f(__builtin_fmaf(s[kt][tt][jj], SM_C, nm)) * li : 0.f;
                        }
                    }
                    s[kt][tt] = pv;
                    hs[kt] = 0.5f * pv[3]; as[kt] = pv[0] + pv[1] + pv[2] + hs[kt];
                }
                float r1[4];
#pragma unroll
                for (int kt = 0; kt < 4; ++kt) r1[kt] = __shfl(hs[kt], (lane + 48) & 63);
#pragma unroll
                for (int kt = 0; kt < 4; ++kt) {
                    const float recv = fq > 0 ? r1[kt] : (kt > 0 ? r1[kt - 1] : 0.f);
                    const int j = blk_ * 16 + kt * 4 + fq;
                    atomicAdd(imp + ti * 132 + (j >> 5) * 33 + (j & 31), as[kt] + recv);
                }
                if (fq == 3) { const int j1 = blk_ * 16 + 16; if (j1 < 128) atomicAdd(imp + ti * 132 + (j1 >> 5) * 33 + (j1 & 31), hs[3]); }
            }
            nsa_pv(Vt, s, o, fr, fq);
        });
        nsa_scale(o, l, false, gbase + 0, tib, o, false);
        nsa_store<false>(o, obase, tib, fq);
    }
    __syncthreads();
    {
        const int ti = tid >> 3, q8 = tid & 7;
        unsigned L[16];
#pragma unroll
        for (int i = 0; i < 16; ++i) {
            const int j = q8 * 16 + i;
            const bool forced = (j == 0) || (j == qt) || (j == qt - 1);
            const float v = imp[ti * 132 + (j >> 5) * 33 + (j & 31)] + (forced ? 1e4f : 0.f) + 1e-30f;
            L[i] = (j <= qt) ? ((__float_as_uint(v) & ~0x7Fu) | (unsigned)(127 - j)) : 0u;
        }
        sort16(L);
#pragma unroll
        for (int r = 1; r <= 4; r <<= 1) {
            unsigned P[16];
#pragma unroll
            for (int i = 0; i < 16; ++i) P[i] = (unsigned)__shfl_xor((int)L[i], r);
            merge16(L, P);
        }
        if (q8 < 4) {
            unsigned word = 0u;
#pragma unroll
            for (int i = 0; i < 16; ++i) {
                const unsigned e = L[i];
                const int j = 127 - (int)(e & 0x7Fu);
                if (e != 0u && (j >> 5) == q8) word |= 1u << (j & 31);
            }
            selw[ti * 4 + q8] = word;
            atomicOr(&anyw[q8], word);
        }
    }
    __syncthreads();
    int nsel;
    {
        const unsigned a0 = anyw[0], a1 = anyw[1], a2 = anyw[2], a3 = anyw[3];
        if (tid < 128) {
            const unsigned wd = tid < 32 ? a0 : tid < 64 ? a1 : tid < 96 ? a2 : a3;
            if ((wd >> (tid & 31)) & 1u) {
                int pos = __popc(wd & ((1u << (tid & 31)) - 1u));
                if (tid >= 32) pos += __popc(a0);
                if (tid >= 64) pos += __popc(a1);
                if (tid >= 96) pos += __popc(a2);
                blist[pos] = tid;
            }
        }
        nsel = __builtin_amdgcn_readfirstlane(__popc(a0) + __popc(a1) + __popc(a2) + __popc(a3));
    }
    __syncthreads();
    if (tid < 256) selrec[tid] = selw[tid];
    if (tid < 128) selrec[256 + tid] = (unsigned)blist[tid];
    if (tid == 0) selrec[384] = (unsigned)nsel;
    __syncthreads();
}

__device__ __forceinline__ void d_nsa_attn(const bf16_t* __restrict__ qrope, const bf16_t* __restrict__ kvp, const float* __restrict__ small, bf16_t* __restrict__ onsa,
                                           const unsigned* __restrict__ selrec, int b, int g, int qt, char* lds) {
    const NsaBufs B{(bf16_t*)(lds + NSA_OFF_KS0), (bf16_t*)(lds + NSA_OFF_VT0), (bf16_t*)(lds + NSA_OFF_KS1), (bf16_t*)(lds + NSA_OFF_VT1)};
    unsigned* selw = (unsigned*)(lds + NSA_OFF_SELW);
    int* blist = (int*)(lds + NSA_OFF_BL);
    const int tid = tid_opaque(), lane = tid & 63, w = tid >> 6, hd = w & 3, th = w >> 2, fr = lane & 15, fq = lane >> 4;
    const int tib = th * 32 + fr;
    const size_t tok0 = (size_t)b * SEQ + (size_t)qt * 64;
    const float* gbase = small + tok0 * 32 + g * 12 + hd * 3;
    bf16_t* obase = onsa + tok0 * 512 + g * 256 + hd * 64;
    const bool sel_all[2] = {true, true};
    const float bias0[2] = {0.f, 0.f};
    bf16_t* Qs = (bf16_t*)(lds + NSA_OFF_QS) + w * 32 * KLD;
    f32x4 s[4][2], o[4][2], tot[4][2];
    float m[2], l[2];
    if (tid < 256) selw[tid] = selrec[tid];
    if (tid < 128) blist[tid] = (int)selrec[256 + tid];
    const int nsel = __builtin_amdgcn_readfirstlane((int)selrec[384]);
    __syncthreads();
    nsa_load_q(qrope + (tok0 + th * 32) * 512 + g * 256 + hd * 64, 512, lane, Qs);
    {
        const bf16_t* kb = kvp + 2 * KVP_SEG + (size_t)(b * 2 + g) * SEQ * 64;
        const bf16_t* vb = kvp + 3 * KVP_SEG + (size_t)(b * 2 + g) * SEQ * 64;
#pragma unroll
        for (int tt = 0; tt < 2; ++tt) { m[tt] = -1e30f; l[tt] = 0.f; }
#pragma unroll
        for (int dt = 0; dt < 4; ++dt)
#pragma unroll
            for (int tt = 0; tt < 2; ++tt) o[dt][tt] = (f32x4){0.f, 0.f, 0.f, 0.f};
        nsa_pipeline(nsel, kb, vb, B, tid, [&](int i) { return __builtin_amdgcn_readfirstlane(blist[i]); }, [&](int blk_, bf16_t* Ks, bf16_t* Vt) {
            nsa_qk(Ks, Qs, s, fr, fq);
            bool selb[2];
#pragma unroll
            for (int tt = 0; tt < 2; ++tt) selb[tt] = (selw[(tib + tt * 16) * 4 + (blk_ >> 5)] >> (blk_ & 31)) & 1u;
            if (blk_ == qt) nsa_softmax<1, true>(s, m, l, o, selb, tib, fq, 0, 0);
            else {
                float bias[2];
#pragma unroll
                for (int tt = 0; tt < 2; ++tt) bias[tt] = selb[tt] ? 0.f : -1e30f;
                nsa_softmax_fast(s, m, l, o, bias);
            }
            nsa_pv(Vt, s, o, fr, fq);
        });
        nsa_scale(o, l, true, gbase + 1, tib, tot, false);
    }
    {
        const bf16_t* kb = kvp + 4 * KVP_SEG + (size_t)(b * 2 + g) * SEQ * 64;
        const bf16_t* vb = kvp + 5 * KVP_SEG + (size_t)(b * 2 + g) * SEQ * 64;
#pragma unroll
        for (int tt = 0; tt < 2; ++tt) { m[tt] = -1e30f; l[tt] = 0.f; }
#pragma unroll
        for (int dt = 0; dt < 4; ++dt)
#pragma unroll
            for (int tt = 0; tt < 2; ++tt) o[dt][tt] = (f32x4){0.f, 0.f, 0.f, 0.f};
        const int j0 = qt >= 8 ? qt - 8 : 0;
        nsa_pipeline(qt - j0 + 1, kb, vb, B, tid, [&](int i) { return j0 + i; }, [&](int blk_, bf16_t* Ks, bf16_t* Vt) {
            nsa_qk(Ks, Qs, s, fr, fq);
            if (blk_ == qt) nsa_softmax<1, true>(s, m, l, o, sel_all, tib, fq, 0, 0);
            else if (blk_ == qt - 8) nsa_softmax<2, true>(s, m, l, o, sel_all, tib, fq, 0, 0);
            else nsa_softmax_fast(s, m, l, o, bias0);
            nsa_pv(Vt, s, o, fr, fq);
        });
        nsa_scale(o, l, true, gbase + 2, tib, tot, true);
        nsa_store<true>(tot, obase, tib, fq);
    }
    __syncthreads();
}

#define SSD_P 136
#define S3_XST 0
#define S3_BC  69632
#define S3_CC  104448
#define S3_ACS 139264
#define S3_DT  141312
#define S3_END 143360

__device__ __forceinline__ void ssd_acs(const float* __restrict__ small, const float* __restrict__ a_log, size_t tok0, int g, float* acs, float* dtl, int tid) {
    const int w = tid >> 6, lane = tid & 63, hh = 4 * g + (w & 3);
    if (w < 4) {
        const float a = -__expf(a_log[hh]);
        const float d0 = small[(tok0 + 2 * lane) * 32 + 24 + hh], d1 = small[(tok0 + 2 * lane + 1) * 32 + 24 + hh];
        const float s0 = d0 * a, s1 = s0 + d1 * a;
        float tot = s1;
#pragma unroll
        for (int off = 1; off < 64; off <<= 1) { const float t = __shfl_up(tot, off); if (lane >= off) tot += t; }
        const float excl = tot - s1;
        acs[w * 128 + 2 * lane] = excl + s0; acs[w * 128 + 2 * lane + 1] = excl + s1;
        dtl[w * 128 + 2 * lane] = d0; dtl[w * 128 + 2 * lane + 1] = d1;
    }
}
struct ConvCh { float w0, w1, w2, w3, bias, h0, h1, h2; };
__device__ __forceinline__ void conv_init(ConvCh& cc, const float* __restrict__ conv_w, const float* __restrict__ conv_b, int ch, const bf16_t* pb, int c) {
    cc.w0 = conv_w[ch]; cc.w1 = conv_w[1024 + ch]; cc.w2 = conv_w[2048 + ch]; cc.w3 = conv_w[3072 + ch]; cc.bias = conv_b[ch];
    if (c > 0) { cc.h0 = bf2f(pb[-3 * PROJ_LD]); cc.h1 = bf2f(pb[-2 * PROJ_LD]); cc.h2 = bf2f(pb[-1 * PROJ_LD]); } else { cc.h0 = 0.f; cc.h1 = 0.f; cc.h2 = 0.f; }
}
__device__ __forceinline__ float conv_step(ConvCh& cc, float x) {
    const float v = cc.bias + cc.w0 * cc.h0 + cc.w1 * cc.h1 + cc.w2 * cc.h2 + cc.w3 * x;
    cc.h0 = cc.h1; cc.h1 = cc.h2; cc.h2 = x;
    return silu(v);
}

__device__ __forceinline__ void d_ssd_states(const bf16_t* __restrict__ proj, const float* __restrict__ small, const float* __restrict__ conv_w, const float* __restrict__ conv_b,
                                             const float* __restrict__ a_log, float* __restrict__ states, float* __restrict__ cdec, int item, char* lds) {
    const int tid = tid_opaque(), lane = tid & 63, w = tid >> 6, fr = lane & 15, fq = lane >> 4;
    const int b = item >> 7, c = (item >> 1) & 63, g = item & 1;
    bf16_t* XwT = (bf16_t*)(lds + S3_XST); bf16_t* BcT = (bf16_t*)(lds + S3_BC);
    float* acs = (float*)(lds + S3_ACS); float* dtl = (float*)(lds + S3_DT);
    const size_t tok0 = (size_t)b * SEQ + (size_t)c * 128;
    ssd_acs(small, a_log, tok0, g, acs, dtl, tid);
    __syncthreads();
    if (tid < 384) {
        const bool isx = tid < 256;
        const int ch = isx ? g * 256 + tid : 512 + g * 128 + (tid - 256);
        const bf16_t* px = proj + tok0 * PROJ_LD + C_XBC + ch;
        ConvCh cx; conv_init(cx, conv_w, conv_b, ch, px, c);
        const int hw = w & 3;
        const float alast = acs[hw * 128 + 127];
        bf16_t* dst = isx ? XwT + tid * SSD_P : BcT + (tid - 256) * SSD_P;
        for (int l0 = 0; l0 < 128; l0 += 32) {
            float rx[32];
#pragma unroll
            for (int i = 0; i < 32; ++i) rx[i] = bf2f(px[(size_t)(l0 + i) * PROJ_LD]);
#pragma unroll
            for (int i8 = 0; i8 < 4; ++i8) {
                float ox[8];
#pragma unroll
                for (int i = 0; i < 8; ++i) {
                    const int l = l0 + i8 * 8 + i;
                    const float v = conv_step(cx, rx[i8 * 8 + i]);
                    ox[i] = isx ? v * dtl[hw * 128 + l] * __expf(alast - acs[hw * 128 + l]) : v;
                }
                u32x4 o; o.x = pack2(ox[0], ox[1]); o.y = pack2(ox[2], ox[3]); o.z = pack2(ox[4], ox[5]); o.w = pack2(ox[6], ox[7]);
                *(u32x4*)(dst + l0 + i8 * 8) = o;
            }
        }
    }
    __syncthreads();
    {
        const int hw = w & 3, nh = w >> 2;
        f32x4 acc[4][4];
#pragma unroll
        for (int pt = 0; pt < 4; ++pt)
#pragma unroll
            for (int nt = 0; nt < 4; ++nt) acc[pt][nt] = (f32x4){0.f, 0.f, 0.f, 0.f};
#pragma unroll 1
        for (int ks = 0; ks < 4; ++ks) {
            bf16x8 af[4], bfr[4];
#pragma unroll
            for (int pt = 0; pt < 4; ++pt) af[pt] = *(const bf16x8*)(XwT + (hw * 64 + pt * 16 + fr) * SSD_P + ks * 32 + fq * 8);
#pragma unroll
            for (int nt = 0; nt < 4; ++nt) bfr[nt] = *(const bf16x8*)(BcT + ((nh * 4 + nt) * 16 + fr) * SSD_P + ks * 32 + fq * 8);
#pragma unroll
            for (int pt = 0; pt < 4; ++pt)
#pragma unroll
                for (int nt = 0; nt < 4; ++nt) acc[pt][nt] = __builtin_amdgcn_mfma_f32_16x16x32_bf16(af[pt], bfr[nt], acc[pt][nt], 0, 0, 0);
        }
        const int hh = 4 * g + hw;
        float* sp = states + ((size_t)((b * 64 + c) * 8 + hh)) * 8192;
#pragma unroll
        for (int pt = 0; pt < 4; ++pt)
#pragma unroll
            for (int nt = 0; nt < 4; ++nt)
#pragma unroll
                for (int jj = 0; jj < 4; ++jj) sp[(pt * 16 + 4 * fq + jj) * 128 + (nh * 4 + nt) * 16 + fr] = acc[pt][nt][jj];
        if (lane == 0 && nh == 0) cdec[(b * 64 + c) * 8 + hh] = __expf(acs[hw * 128 + 127]);
    }
    __syncthreads();
}

__device__ __forceinline__ void d_ssd_scan(const float* __restrict__ states, const float* __restrict__ cdec, bf16_t* __restrict__ prev, int vb) {
    const int bh = vb >> 1, b = bh >> 3, hh = bh & 7;
    const size_t e0 = (size_t)((vb & 1) * 512 + tid_opaque()) * 8;
    f32x4 h0 = (f32x4){0.f, 0.f, 0.f, 0.f}, h1 = h0;
#pragma unroll 8
    for (int c = 0; c < 64; ++c) {
        const size_t base = ((size_t)((b * 64 + c) * 8 + hh)) * 8192 + e0;
        const f32x4 s0 = *(const f32x4*)(states + base), s1 = *(const f32x4*)(states + base + 4);
        const float d = cdec[(b * 64 + c) * 8 + hh];
        u32x4 o; o.x = pack2(h0.x, h0.y); o.y = pack2(h0.z, h0.w); o.z = pack2(h1.x, h1.y); o.w = pack2(h1.z, h1.w);
        *(u32x4*)(prev + base) = o;
        h0 = h0 * d + s0; h1 = h1 * d + s1;
    }
}

__device__ __forceinline__ void d_ssd_out(const bf16_t* __restrict__ proj, const float* __restrict__ small, const float* __restrict__ conv_w, const float* __restrict__ conv_b,
                                          const float* __restrict__ a_log, const float* __restrict__ d_skip, const bf16_t* __restrict__ prev, bf16_t* __restrict__ yssd, int item, char* lds) {
    const int tid = tid_opaque(), lane = tid & 63, w = tid >> 6, fr = lane & 15, fq = lane >> 4;
    const int b = item >> 7, c = (item >> 1) & 63, g = item & 1;
    bf16_t* XsT = (bf16_t*)(lds + S3_XST); bf16_t* Bc = (bf16_t*)(lds + S3_BC); bf16_t* Cc = (bf16_t*)(lds + S3_CC);
    float* acs = (float*)(lds + S3_ACS); float* dtl = (float*)(lds + S3_DT);
    const size_t tok0 = (size_t)b * SEQ + (size_t)c * 128;
    ssd_acs(small, a_log, tok0, g, acs, dtl, tid);
    {
        const int mode = tid < 256 ? 0 : (tid < 384 ? 1 : 2);
        const int ch = mode == 0 ? g * 256 + tid : (mode == 1 ? 512 + g * 128 + (tid - 256) : 768 + g * 128 + (tid - 384));
        const bf16_t* px = proj + tok0 * PROJ_LD + C_XBC + ch;
        ConvCh cx; conv_init(cx, conv_w, conv_b, ch, px, c);
        bf16_t* dstx = XsT + (tid & 255) * SSD_P;
        bf16_t* dstbc = (mode == 1 ? Bc : Cc) + (tid & 127);
        for (int l0 = 0; l0 < 128; l0 += 32) {
            float rx[32];
#pragma unroll
            for (int i = 0; i < 32; ++i) rx[i] = bf2f(px[(size_t)(l0 + i) * PROJ_LD]);
#pragma unroll
            for (int i8 = 0; i8 < 4; ++i8) {
                float ox[8];
#pragma unroll
                for (int i = 0; i < 8; ++i) ox[i] = conv_step(cx, rx[i8 * 8 + i]);
                if (mode == 0) {
                    u32x4 o; o.x = pack2(ox[0], ox[1]); o.y = pack2(ox[2], ox[3]); o.z = pack2(ox[4], ox[5]); o.w = pack2(ox[6], ox[7]);
                    *(u32x4*)(dstx + l0 + i8 * 8) = o;
                } else {
#pragma unroll
                    for (int i = 0; i < 8; ++i) dstbc[(l0 + i8 * 8 + i) * SSD_P] = f2bf(ox[i]);
                }
            }
        }
    }
    __syncthreads();
    const int hw = w & 3, lh = w >> 2, hh = 4 * g + hw;
    const float dsk = d_skip[hh];
    const bf16_t* pp = prev + ((size_t)((b * 64 + c) * 8 + hh)) * 8192;
#pragma unroll 1
    for (int lk = 0; lk < 4; ++lk) {
        const int lt = lh + 2 * lk;
        const int l = lt * 16 + fr;
        const float acs_l = acs[hw * 128 + l];
        bf16x8 cf[4];
#pragma unroll
        for (int ks = 0; ks < 4; ++ks) cf[ks] = *(const bf16x8*)(Cc + (lt * 16 + fr) * SSD_P + ks * 32 + fq * 8);
        f32x4 y[4], yo[4];
#pragma unroll
        for (int pt = 0; pt < 4; ++pt) { y[pt] = (f32x4){0.f, 0.f, 0.f, 0.f}; yo[pt] = (f32x4){0.f, 0.f, 0.f, 0.f}; }
#pragma unroll
        for (int ks2 = 0; ks2 < 4; ++ks2) {
            if (2 * ks2 <= lt) {
                f32x4 cb[2];
#pragma unroll
                for (int h2 = 0; h2 < 2; ++h2) {
                    const int st = 2 * ks2 + h2;
                    cb[h2] = (f32x4){0.f, 0.f, 0.f, 0.f};
                    if (st <= lt) {
#pragma unroll
                        for (int ks = 0; ks < 4; ++ks)
                            cb[h2] = __builtin_amdgcn_mfma_f32_16x16x32_bf16(*(const bf16x8*)(Bc + (st * 16 + fr) * SSD_P + ks * 32 + fq * 8), cf[ks], cb[h2], 0, 0, 0);
#pragma unroll
                        for (int jj = 0; jj < 4; ++jj) {
                            const int sidx = st * 16 + 4 * fq + jj;
                            cb[h2][jj] = (sidx <= l) ? cb[h2][jj] * __expf(acs_l - acs[hw * 128 + sidx]) * dtl[hw * 128 + sidx] : 0.f;
                        }
                    }
                }
                u32x4 wv; wv.x = pack2(cb[0].x, cb[0].y); wv.y = pack2(cb[0].z, cb[0].w); wv.z = pack2(cb[1].x, cb[1].y); wv.w = pack2(cb[1].z, cb[1].w);
                const bf16x8 mf = __builtin_bit_cast(bf16x8, wv);
#pragma unroll
                for (int pt = 0; pt < 4; ++pt) {
                    const bf16_t* xp = XsT + (hw * 64 + pt * 16 + fr) * SSD_P + ks2 * 32 + 4 * fq;
                    const u32x2 a0 = *(const u32x2*)xp, a1 = *(const u32x2*)(xp + 16);
                    u32x4 xv; xv.x = a0.x; xv.y = a0.y; xv.z = a1.x; xv.w = a1.y;
                    y[pt] = __builtin_amdgcn_mfma_f32_16x16x32_bf16(__builtin_bit_cast(bf16x8, xv), mf, y[pt], 0, 0, 0);
                }
            }
            __builtin_amdgcn_sched_barrier(0);
        }
        __builtin_amdgcn_sched_barrier(0);
#pragma unroll
        for (int pt = 0; pt < 4; ++pt)
#pragma unroll
            for (int ks = 0; ks < 4; ++ks) yo[pt] = __builtin_amdgcn_mfma_f32_16x16x32_bf16(*(const bf16x8*)(pp + (pt * 16 + fr) * 128 + ks * 32 + fq * 8), cf[ks], yo[pt], 0, 0, 0);
        __builtin_amdgcn_sched_barrier(0);
        const float el = __expf(acs_l);
#pragma unroll
        for (int pt = 0; pt < 4; ++pt) {
            const int p0 = pt * 16 + 4 * fq;
            const u32x2 zz = *(const u32x2*)(proj + (tok0 + l) * PROJ_LD + C_Z + hh * 64 + p0);
            const float z0 = bflo(zz.x), z1 = bfhi(zz.x), z2 = bflo(zz.y), z3 = bfhi(zz.y);
            const bf16_t* xq = XsT + (hw * 64 + p0) * SSD_P + l;
            const float x0 = bf2f(xq[0]), x1 = bf2f(xq[SSD_P]), x2 = bf2f(xq[2 * SSD_P]), x3 = bf2f(xq[3 * SSD_P]);
            u32x2 ob;
            ob.x = pack2((y[pt].x + el * yo[pt].x + dsk * x0) * silu(z0), (y[pt].y + el * yo[pt].y + dsk * x1) * silu(z1));
            ob.y = pack2((y[pt].z + el * yo[pt].z + dsk * x2) * silu(z2), (y[pt].w + el * yo[pt].w + dsk * x3) * silu(z3));
            *(u32x2*)(yssd + (tok0 + l) * 512 + hh * 64 + p0) = ob;
        }
    }
    __syncthreads();
}

__device__ __forceinline__ void d_mix_prep(const bf16_t* __restrict__ onsa, const bf16_t* __restrict__ yssd, const float* __restrict__ nsa_w, const float* __restrict__ ssd_w, bf16_t* __restrict__ A2, int vb) {
    const int tid_ = tid_opaque(); const int lane = tid_ & 63, wid = tid_ >> 6;
    const size_t row0 = (size_t)vb * 32 + wid * 4;
    f32x4 a[4][2], y[4][2];
#pragma unroll
    for (int r = 0; r < 4; ++r)
#pragma unroll
        for (int k = 0; k < 2; ++k) {
            const u32x2 aa = *(const u32x2*)(onsa + (row0 + r) * 512 + k * 256 + lane * 4);
            a[r][k] = (f32x4){bflo(aa.x), bfhi(aa.x), bflo(aa.y), bfhi(aa.y)};
            const u32x2 yy = *(const u32x2*)(yssd + (row0 + r) * 512 + k * 256 + lane * 4);
            y[r][k] = (f32x4){bflo(yy.x), bfhi(yy.x), bflo(yy.y), bfhi(yy.y)};
        }
    float ra[4], ry[4];
#pragma unroll
    for (int r = 0; r < 4; ++r) {
        float s0 = 0.f, s1 = 0.f;
#pragma unroll
        for (int k = 0; k < 2; ++k) {
            s0 += a[r][k].x * a[r][k].x + a[r][k].y * a[r][k].y + a[r][k].z * a[r][k].z + a[r][k].w * a[r][k].w;
            s1 += y[r][k].x * y[r][k].x + y[r][k].y * y[r][k].y + y[r][k].z * y[r][k].z + y[r][k].w * y[r][k].w;
        }
        ra[r] = rsqrtf(wave_sum(s0) * (1.0f / 512) + EPS); ry[r] = rsqrtf(wave_sum(s1) * (1.0f / 512) + EPS);
    }
#pragma unroll
    for (int k = 0; k < 2; ++k) {
        const int col = k * 256 + lane * 4;
        const f32x4 wn = *(const f32x4*)(nsa_w + col), wsd = *(const f32x4*)(ssd_w + col);
#pragma unroll
        for (int r = 0; r < 4; ++r) {
            const f32x4 p = a[r][k] * ra[r] * wn, q = y[r][k] * ry[r] * wsd;
            u32x2 o; o.x = pack2(p.x, p.y); o.y = pack2(p.z, p.w);
            *(u32x2*)(A2 + (row0 + r) * DM + col) = o;
            u32x2 o2; o2.x = pack2(q.x, q.y); o2.y = pack2(q.z, q.w);
            *(u32x2*)(A2 + (row0 + r) * DM + 512 + col) = o2;
        }
    }
}

__device__ __forceinline__ void d_quant_rows(const float* __restrict__ src, unsigned char* __restrict__ dst, float* __restrict__ scale, int vb) {
    const int tid_ = tid_opaque(); const int lane = tid_ & 63, row = vb * 8 + (tid_ >> 6);
    const float* rp = src + (size_t)row * DM + lane * 16;
    f32x4 v[4];
#pragma unroll
    for (int i = 0; i < 4; ++i) v[i] = *(const f32x4*)(rp + i * 4);
    float mx = 0.f;
#pragma unroll
    for (int i = 0; i < 4; ++i) mx = fmaxf(mx, fmaxf(fmaxf(fabsf(v[i].x), fabsf(v[i].y)), fmaxf(fabsf(v[i].z), fabsf(v[i].w))));
    mx = wave_max(mx);
    const float sc = mx > 0.f ? mx * (1.0f / 6.0f) : 1.0f;
    const float inv = 1.0f / sc;
    u32x2 o;
#pragma unroll
    for (int h = 0; h < 2; ++h) {
        unsigned wv = 0u;
        wv = __builtin_amdgcn_cvt_scalef32_pk_fp4_f32(wv, v[2 * h].x * inv, v[2 * h].y * inv, 1.0f, 0);
        wv = __builtin_amdgcn_cvt_scalef32_pk_fp4_f32(wv, v[2 * h].z * inv, v[2 * h].w * inv, 1.0f, 1);
        wv = __builtin_amdgcn_cvt_scalef32_pk_fp4_f32(wv, v[2 * h + 1].x * inv, v[2 * h + 1].y * inv, 1.0f, 2);
        wv = __builtin_amdgcn_cvt_scalef32_pk_fp4_f32(wv, v[2 * h + 1].z * inv, v[2 * h + 1].w * inv, 1.0f, 3);
        o[h] = wv;
    }
    *(u32x2*)(dst + (size_t)row * 512 + lane * 8) = o;
    if (lane == 0) scale[row] = sc;
}

__device__ __forceinline__ unsigned mono_u(float f) { const unsigned u = __float_as_uint(f); return (u & 0x80000000u) ? ~u : (u | 0x80000000u); }
__device__ __forceinline__ float unmono_f(unsigned m) { const unsigned u = (m & 0x80000000u) ? (m & 0x7fffffffu) : ~m; return __uint_as_float(u); }
#define RT_LI 65536
__device__ __forceinline__ void d_peer_stage_keys(const bf16_t* __restrict__ subk, int h, char* lds) {
    const int tid = tid_opaque();
    u32x4 r[8];
#pragma unroll
    for (int i = 0; i < 8; ++i) { const int p = tid + 512 * i; r[i] = *(const u32x4*)(subk + (size_t)h * 32768 + (size_t)p * 8); }
#pragma unroll
    for (int i = 0; i < 8; ++i) { const int p = tid + 512 * i, row = p >> 4, ch = p & 15; *(u32x4*)(lds + row * 256 + ((ch ^ (row & 15)) << 4)) = r[i]; }
}
__device__ __forceinline__ void d_peer_route(const bf16_t* __restrict__ qp, const float* __restrict__ qnw, int* __restrict__ eidx, float* __restrict__ gate,
                                             int tile, int h, char* lds) {
    const int tid = tid_opaque(), lane = tid & 63, w = tid >> 6, fr = lane & 15, fq = lane >> 4;
    const size_t tok = (size_t)tile * 128 + w * 16 + fr;
    bf16x8 qf[2][4];
    {
        const bf16_t* qrow = qp + tok * 2048 + h * 256;
        u32x4 raw[2][4];
        float ss = 0.f;
#pragma unroll
        for (int k = 0; k < 2; ++k)
#pragma unroll
            for (int ks = 0; ks < 4; ++ks) {
                const u32x4 r = *(const u32x4*)(qrow + k * 128 + ks * 32 + fq * 8);
                raw[k][ks] = r;
                ss += bflo(r.x) * bflo(r.x) + bfhi(r.x) * bfhi(r.x) + bflo(r.y) * bflo(r.y) + bfhi(r.y) * bfhi(r.y)
                    + bflo(r.z) * bflo(r.z) + bfhi(r.z) * bfhi(r.z) + bflo(r.w) * bflo(r.w) + bfhi(r.w) * bfhi(r.w);
            }
        ss += __shfl_xor(ss, 16); ss += __shfl_xor(ss, 32);
        const float rs = rsqrtf(ss * (1.0f / 256) + EPS);
#pragma unroll
        for (int k = 0; k < 2; ++k)
#pragma unroll
            for (int ks = 0; ks < 4; ++ks) {
                const float* wp = qnw + k * 128 + ks * 32 + fq * 8;
                const f32x4 w0 = *(const f32x4*)wp, w1 = *(const f32x4*)(wp + 4);
                const u32x4 r = raw[k][ks];
                u32x4 o;
                o.x = pack2(bflo(r.x) * rs * w0.x, bfhi(r.x) * rs * w0.y); o.y = pack2(bflo(r.y) * rs * w0.z, bfhi(r.y) * rs * w0.w);
                o.z = pack2(bflo(r.z) * rs * w1.x, bfhi(r.z) * rs * w1.y); o.w = pack2(bflo(r.w) * rs * w1.z, bfhi(r.w) * rs * w1.w);
                qf[k][ks] = __builtin_bit_cast(bf16x8, o);
            }
    }
    unsigned L[2][16];
#pragma unroll
    for (int k = 0; k < 2; ++k) {
        f32x4 acc[8];
#pragma unroll
        for (int kt = 0; kt < 8; ++kt) acc[kt] = (f32x4){0.f, 0.f, 0.f, 0.f};
#pragma unroll
        for (int kt = 0; kt < 8; ++kt)
#pragma unroll
            for (int ks = 0; ks < 4; ++ks) {
                const int row = k * 128 + kt * 16 + fr;
                const bf16x8 af = *(const bf16x8*)(lds + row * 256 + (((ks * 4 + fq) ^ fr) << 4));
                acc[kt] = __builtin_amdgcn_mfma_f32_16x16x32_bf16(af, qf[k][ks], acc[kt], 0, 0, 0);
            }
        {
            unsigned H[16];
#pragma unroll
            for (int kt = 0; kt < 4; ++kt)
#pragma unroll
                for (int jj = 0; jj < 4; ++jj) {
                    L[k][kt * 4 + jj] = (mono_u(acc[kt][jj]) & ~0x7Fu) | (unsigned)(127 - (kt * 16 + 4 * fq + jj));
                    H[kt * 4 + jj] = (mono_u(acc[kt + 4][jj]) & ~0x7Fu) | (unsigned)(127 - ((kt + 4) * 16 + 4 * fq + jj));
                }
            sort16(L[k]); sort16(H);
            merge16(L[k], H);
        }
#pragma unroll
        for (int r = 16; r <= 32; r <<= 1) {
            unsigned P[16];
#pragma unroll
            for (int i = 0; i < 16; ++i) P[i] = (unsigned)__shfl_xor((int)L[k][i], r);
            merge16(L[k], P);
        }
    }
    unsigned T[16];
#define CAND(a, b) ((mono_u(unmono_f(L[0][a] & ~0x7Fu) + unmono_f(L[1][b] & ~0x7Fu)) & ~0xFFu) | (unsigned)(255 - ((a) * 16 + (b))))
#pragma unroll
    for (int bb = 0; bb < 16; ++bb) T[bb] = CAND(0, bb);
    {
        unsigned Bq[16];
#pragma unroll
        for (int bb = 0; bb < 8; ++bb) Bq[bb] = CAND(1, bb);
        Bq[8] = CAND(4, 0); Bq[9] = CAND(4, 1); Bq[10] = CAND(4, 2); Bq[11] = CAND(5, 0); Bq[12] = CAND(5, 1); Bq[13] = CAND(6, 0); Bq[14] = CAND(6, 1); Bq[15] = CAND(8, 0);
        sort16(Bq); merge16(T, Bq);
    }
    {
        unsigned Cq[16];
#pragma unroll
        for (int bb = 0; bb < 5; ++bb) Cq[bb] = CAND(2, bb);
#pragma unroll
        for (int bb = 0; bb < 4; ++bb) Cq[5 + bb] = CAND(3, bb);
        Cq[9] = CAND(7, 0); Cq[10] = CAND(7, 1); Cq[11] = CAND(9, 0); Cq[12] = CAND(10, 0); Cq[13] = CAND(11, 0); Cq[14] = CAND(12, 0); Cq[15] = CAND(13, 0);
        sort16(Cq); merge16(T, Cq);
    }
    ins16(T, CAND(14, 0)); ins16(T, CAND(15, 0));
#undef CAND
    unsigned char* li = (unsigned char*)lds + RT_LI + w * 512 + fr * 32;
    if (fq == 0) {
#pragma unroll
        for (int a = 0; a < 16; ++a) { li[a] = (unsigned char)(127 - (L[0][a] & 0x7Fu)); li[16 + a] = (unsigned char)(127 - (L[1][a] & 0x7Fu)); }
    }
    __syncthreads();
    const float s0 = unmono_f(T[0] & ~0xFFu);
    float pe[16]; float sum = 0.f;
#pragma unroll
    for (int i = 0; i < 16; ++i) { pe[i] = __expf(unmono_f(T[i] & ~0xFFu) - s0); sum += pe[i]; }
    const float inv = 1.0f / sum;
    unsigned cod[4] = {0u, 0u, 0u, 0u}; float gv[4] = {0.f, 0.f, 0.f, 0.f};
#pragma unroll
    for (int i = 0; i < 16; ++i) if ((i >> 2) == fq) { cod[i & 3] = 255u - (T[i] & 0xFFu); gv[i & 3] = pe[i] * inv; }
    int ev[4];
#pragma unroll
    for (int i = 0; i < 4; ++i) ev[i] = (int)li[cod[i] >> 4] * 128 + (int)li[16 + (cod[i] & 15u)];
    *(u32x4*)(eidx + (tok * 8 + h) * 16 + fq * 4) = (u32x4){(unsigned)ev[0], (unsigned)ev[1], (unsigned)ev[2], (unsigned)ev[3]};
    *(f32x4*)(gate + (tok * 8 + h) * 16 + fq * 4) = (f32x4){gv[0], gv[1], gv[2], gv[3]};
    __syncthreads();
}

__device__ __forceinline__ void cvt16(const u32x2 q, f32x2 (&f)[8]) {
#pragma unroll
    for (int i = 0; i < 2; ++i) {
        f[4 * i] = __builtin_amdgcn_cvt_scalef32_pk_f32_fp4(q[i], 1.0f, 0); f[4 * i + 1] = __builtin_amdgcn_cvt_scalef32_pk_f32_fp4(q[i], 1.0f, 1);
        f[4 * i + 2] = __builtin_amdgcn_cvt_scalef32_pk_f32_fp4(q[i], 1.0f, 2); f[4 * i + 3] = __builtin_amdgcn_cvt_scalef32_pk_f32_fp4(q[i], 1.0f, 3);
    }
}
typedef int v8i __attribute__((ext_vector_type(8)));
__device__ __forceinline__ void d_peer_expert_mx(const bf16_t* __restrict__ h2, const unsigned char* __restrict__ down4, const unsigned char* __restrict__ up4, const float* __restrict__ dscale,
                                                 const float* __restrict__ uscale, const int* __restrict__ eidx, const float* __restrict__ gate, const float* __restrict__ mod,
                                                 const float* __restrict__ fw, const bf16_t* __restrict__ x1, float* __restrict__ out, int vb, char* lds) {
    const int tid = tid_opaque(), lane = tid & 63, wid = tid >> 6, fr = lane & 15, kq = lane >> 4;
    const size_t tok = (size_t)vb * 8 + wid; const int b = (int)(tok >> 13);
    unsigned char* hq = (unsigned char*)lds + wid * 1024;
    {
        const u32x4 v0 = *(const u32x4*)(h2 + tok * DM + lane * 16), v1 = *(const u32x4*)(h2 + tok * DM + lane * 16 + 8);
        u32x4 q;
        int wv = 0;
        wv = __builtin_amdgcn_cvt_pk_fp8_f32(bflo(v0.x), bfhi(v0.x), wv, false); wv = __builtin_amdgcn_cvt_pk_fp8_f32(bflo(v0.y), bfhi(v0.y), wv, true); q.x = (unsigned)wv;
        wv = __builtin_amdgcn_cvt_pk_fp8_f32(bflo(v0.z), bfhi(v0.z), wv, false); wv = __builtin_amdgcn_cvt_pk_fp8_f32(bflo(v0.w), bfhi(v0.w), wv, true); q.y = (unsigned)wv;
        wv = __builtin_amdgcn_cvt_pk_fp8_f32(bflo(v1.x), bfhi(v1.x), wv, false); wv = __builtin_amdgcn_cvt_pk_fp8_f32(bflo(v1.y), bfhi(v1.y), wv, true); q.z = (unsigned)wv;
        wv = __builtin_amdgcn_cvt_pk_fp8_f32(bflo(v1.z), bfhi(v1.z), wv, false); wv = __builtin_amdgcn_cvt_pk_fp8_f32(bflo(v1.w), bfhi(v1.w), wv, true); q.w = (unsigned)wv;
        *(u32x4*)(hq + lane * 16) = q;
    }
    const int e_lo = eidx[tok * 128 + lane], e_hi = eidx[tok * 128 + 64 + lane];
    const float c_lo = gate[tok * 128 + lane] * uscale[e_lo], c_hi = gate[tok * 128 + 64 + lane] * uscale[e_hi];
    const float d_lo = dscale[e_lo], d_hi = dscale[e_hi];
    f32x2 acc[8];
#pragma unroll
    for (int e = 0; e < 8; ++e) acc[e] = (f32x2){0.f, 0.f};
    u32x4 da[8], dn[8]; u32x2 uq[16], un[16];
    {
        const int em = __shfl(e_lo, fr);
        const unsigned char* ab = down4 + (size_t)em * 512 + kq * 16;
#pragma unroll
        for (int k = 0; k < 8; ++k) da[k] = *(const u32x4*)(ab + k * 64);
#pragma unroll
        for (int i = 0; i < 16; ++i) { const int e = __builtin_amdgcn_readlane(e_lo, i); uq[i] = *(const u32x2*)(up4 + (size_t)e * 512 + lane * 8); }
    }
#pragma unroll 1
    for (int g = 0; g < 8; ++g) {
        if (g + 1 < 8) {
            const int gn = g + 1;
            const int em = gn < 4 ? __shfl(e_lo, gn * 16 + fr) : __shfl(e_hi, (gn - 4) * 16 + fr);
            const unsigned char* ab = down4 + (size_t)em * 512 + kq * 16;
#pragma unroll
            for (int k = 0; k < 8; ++k) dn[k] = *(const u32x4*)(ab + k * 64);
#pragma unroll
            for (int i = 0; i < 16; ++i) {
                const int e = gn < 4 ? __builtin_amdgcn_readlane(e_lo, gn * 16 + i) : __builtin_amdgcn_readlane(e_hi, (gn - 4) * 16 + i);
                un[i] = *(const u32x2*)(up4 + (size_t)e * 512 + lane * 8);
            }
        }
        f32x4 d4 = (f32x4){0.f, 0.f, 0.f, 0.f};
#pragma unroll
        for (int k = 0; k < 8; ++k) {
            const u32x4 b0 = *(const u32x4*)(hq + k * 128 + kq * 16), b1 = *(const u32x4*)(hq + k * 128 + 64 + kq * 16);
            const v8i A = {(int)da[k].x, (int)da[k].y, (int)da[k].z, (int)da[k].w, 0, 0, 0, 0};
            const v8i B = {(int)b0.x, (int)b0.y, (int)b0.z, (int)b0.w, (int)b1.x, (int)b1.y, (int)b1.z, (int)b1.w};
            d4 = __builtin_amdgcn_mfma_scale_f32_16x16x128_f8f6f4(A, B, d4, 4  , 0  , 0, 0x7F7F7F7F, 0, 0x7F7F7F7F);
        }
        float av;
        {
            const int jm = fr & 3;
            const float dv = jm == 0 ? d4[0] : jm == 1 ? d4[1] : jm == 2 ? d4[2] : d4[3];
            const int sl = (g & 3) * 16 + 4 * kq + jm;
            const float mc = g < 4 ? __shfl(c_lo, sl) : __shfl(c_hi, sl);
            const float md = g < 4 ? __shfl(d_lo, sl) : __shfl(d_hi, sl);
            av = gelu_tanh(dv * md) * mc;
        }
#pragma unroll
        for (int i = 0; i < 16; ++i) {
            const float c = __uint_as_float((unsigned)__builtin_amdgcn_readlane((int)__float_as_uint(av), 16 * (i >> 2) + (i & 3)));
            const f32x2 c2 = {c, c};
            f32x2 f[8]; cvt16(uq[i], f);
#pragma unroll
            for (int e = 0; e < 8; ++e) acc[e] = __builtin_elementwise_fma(f[e], c2, acc[e]);
        }
#pragma unroll
        for (int k = 0; k < 8; ++k) da[k] = dn[k];
#pragma unroll
        for (int i = 0; i < 16; ++i) uq[i] = un[i];
    }
    float x2[16]; float ss = 0.f;
#pragma unroll
    for (int q4i = 0; q4i < 4; ++q4i) {
        const int col = lane * 16 + q4i * 4;
        const u32x2 xb = *(const u32x2*)(x1 + tok * DM + col);
        const f32x4 xv = (f32x4){bflo(xb.x), bfhi(xb.x), bflo(xb.y), bfhi(xb.y)};
        const f32x4 g2 = *(const f32x4*)(mod + b * 6144 + 5120 + col);
        const int e0 = q4i * 4;
        x2[e0 + 0] = xv.x + g2.x * acc[2 * q4i].x; x2[e0 + 1] = xv.y + g2.y * acc[2 * q4i].y; x2[e0 + 2] = xv.z + g2.z * acc[2 * q4i + 1].x; x2[e0 + 3] = xv.w + g2.w * acc[2 * q4i + 1].y;
        ss += x2[e0] * x2[e0] + x2[e0 + 1] * x2[e0 + 1] + x2[e0 + 2] * x2[e0 + 2] + x2[e0 + 3] * x2[e0 + 3];
    }
    ss = wave_sum(ss);
    const float r = rsqrtf(ss * (1.0f / DM) + EPS);
#pragma unroll
    for (int q4i = 0; q4i < 4; ++q4i) {
        const int col = lane * 16 + q4i * 4;
        const f32x4 wv = *(const f32x4*)(fw + col);
        const int e0 = q4i * 4;
        *(f32x4*)(out + tok * DM + col) = (f32x4){x2[e0] * r * wv.x, x2[e0 + 1] * r * wv.y, x2[e0 + 2] * r * wv.z, x2[e0 + 3] * r * wv.w};
    }
}

__device__ __forceinline__ void d_peer_expert8(const bf16_t* __restrict__ h2, const unsigned char* __restrict__ down8, const unsigned char* __restrict__ up8, const float* __restrict__ dscale,
                                               const float* __restrict__ uscale, const int* __restrict__ eidx, const float* __restrict__ gate, const float* __restrict__ mod,
                                               const float* __restrict__ fw, float* __restrict__ out, int vb) {
    const int tid = tid_opaque(), lane = tid & 63, wid = tid >> 6;
    const size_t tok = (size_t)vb * 8 + wid; const int b = (int)(tok >> 13);
    const int e_lo = eidx[tok * 128 + lane], e_hi = eidx[tok * 128 + 64 + lane];
    const float c_lo = gate[tok * 128 + lane] * uscale[e_lo], c_hi = gate[tok * 128 + 64 + lane] * uscale[e_hi];
    const float d_lo = dscale[e_lo], d_hi = dscale[e_hi];
    f32x2 hx[8], acc[8];
    {
        const u32x4 v0 = *(const u32x4*)(h2 + tok * DM + lane * 16), v1 = *(const u32x4*)(h2 + tok * DM + lane * 16 + 8);
        hx[0] = (f32x2){bflo(v0.x), bfhi(v0.x)}; hx[1] = (f32x2){bflo(v0.y), bfhi(v0.y)}; hx[2] = (f32x2){bflo(v0.z), bfhi(v0.z)}; hx[3] = (f32x2){bflo(v0.w), bfhi(v0.w)};
        hx[4] = (f32x2){bflo(v1.x), bfhi(v1.x)}; hx[5] = (f32x2){bflo(v1.y), bfhi(v1.y)}; hx[6] = (f32x2){bflo(v1.z), bfhi(v1.z)}; hx[7] = (f32x2){bflo(v1.w), bfhi(v1.w)};
    }
#pragma unroll
    for (int e = 0; e < 8; ++e) acc[e] = (f32x2){0.f, 0.f};
    const int es = lane >> 3;
    u32x2 dq[8], uq[8], dn[8], un[8];
#pragma unroll
    for (int i = 0; i < 8; ++i) {
        const int e = __builtin_amdgcn_readlane(e_lo, i);
        dq[i] = *(const u32x2*)(down8 + (size_t)e * 512 + lane * 8);
        uq[i] = *(const u32x2*)(up8 + (size_t)e * 512 + lane * 8);
    }
#pragma unroll 1
    for (int j0 = 0; j0 < 128; j0 += 8) {
        if (j0 + 8 < 128) {
            const int jn = j0 + 8;
#pragma unroll
            for (int i = 0; i < 8; ++i) {
                const int e = jn < 64 ? __builtin_amdgcn_readlane(e_lo, jn + i) : __builtin_amdgcn_readlane(e_hi, jn - 64 + i);
                dn[i] = *(const u32x2*)(down8 + (size_t)e * 512 + lane * 8);
                un[i] = *(const u32x2*)(up8 + (size_t)e * 512 + lane * 8);
            }
        }
        const int sl = (j0 & 63) + es;
        const float my_c = j0 < 64 ? __shfl(c_lo, sl) : __shfl(c_hi, sl);
        const float my_ds = j0 < 64 ? __shfl(d_lo, sl) : __shfl(d_hi, sl);
        float part[8];
#pragma unroll
        for (int i = 0; i < 8; ++i) {
            f32x2 f[8]; cvt16(dq[i], f);
            f32x2 s2 = hx[0] * f[0];
#pragma unroll
            for (int e = 1; e < 8; ++e) s2 = __builtin_elementwise_fma(hx[e], f[e], s2);
            part[i] = s2.x + s2.y;
        }
        float q4[4], q2[2], q1;
#pragma unroll
        for (int i = 0; i < 4; ++i) { const bool up = (lane & 32) != 0; const float send = up ? part[i] : part[i + 4]; const float keep = up ? part[i + 4] : part[i]; q4[i] = keep + __shfl_xor(send, 32); }
#pragma unroll
        for (int i = 0; i < 2; ++i) { const bool up = (lane & 16) != 0; const float send = up ? q4[i] : q4[i + 2]; const float keep = up ? q4[i + 2] : q4[i]; q2[i] = keep + __shfl_xor(send, 16); }
        { const bool up = (lane & 8) != 0; const float send = up ? q2[0] : q2[1]; const float keep = up ? q2[1] : q2[0]; q1 = keep + __shfl_xor(send, 8); }
        q1 += __shfl_xor(q1, 4); q1 += __shfl_xor(q1, 2); q1 += __shfl_xor(q1, 1);
        const float a = gelu_tanh(q1 * my_ds) * my_c;
#pragma unroll
        for (int i = 0; i < 8; ++i) {
            const float c = __uint_as_float((unsigned)__builtin_amdgcn_readlane((int)__float_as_uint(a), 8 * i));
            const f32x2 c2 = {c, c};
            f32x2 f[8]; cvt16(uq[i], f);
#pragma unroll
            for (int e = 0; e < 8; ++e) acc[e] = __builtin_elementwise_fma(f[e], c2, acc[e]);
        }
#pragma unroll
        for (int i = 0; i < 8; ++i) { dq[i] = dn[i]; uq[i] = un[i]; }
    }
    float x2[16]; float ss = 0.f;
#pragma unroll
    for (int q4i = 0; q4i < 4; ++q4i) {
        const int col = lane * 16 + q4i * 4;
        const f32x4 xv = *(const f32x4*)(out + tok * DM + col);
        const f32x4 g2 = *(const f32x4*)(mod + b * 6144 + 5120 + col);
        const int e0 = q4i * 4;
        x2[e0 + 0] = xv.x + g2.x * acc[2 * q4i].x; x2[e0 + 1] = xv.y + g2.y * acc[2 * q4i].y; x2[e0 + 2] = xv.z + g2.z * acc[2 * q4i + 1].x; x2[e0 + 3] = xv.w + g2.w * acc[2 * q4i + 1].y;
        ss += x2[e0] * x2[e0] + x2[e0 + 1] * x2[e0 + 1] + x2[e0 + 2] * x2[e0 + 2] + x2[e0 + 3] * x2[e0 + 3];
    }
    ss = wave_sum(ss);
    const float r = rsqrtf(ss * (1.0f / DM) + EPS);
#pragma unroll
    for (int q4i = 0; q4i < 4; ++q4i) {
        const int col = lane * 16 + q4i * 4;
        const f32x4 wv = *(const f32x4*)(fw + col);
        const int e0 = q4i * 4;
        *(f32x4*)(out + tok * DM + col) = (f32x4){x2[e0] * r * wv.x, x2[e0 + 1] * r * wv.y, x2[e0 + 2] * r * wv.z, x2[e0 + 3] * r * wv.w};
    }
}

#define XB_TMO      128
#define XB_XCNT(j)  (256  + 64 * (j))
#define XB_XSUB(j)  (1280 + 64 * (j))
#define XB_XGEN(j)  (2304 + 64 * (j))
#define XB_TOP      3328
#define XB_TOPGEN   3392
#define XCD_BAR_WORDS 3456
#define XB_SPIN_CAP (1u << 18)

__device__ __forceinline__ unsigned xb_ld(unsigned* p)              { return __hip_atomic_load(p, __ATOMIC_RELAXED, __HIP_MEMORY_SCOPE_AGENT); }
__device__ __forceinline__ unsigned xb_add(unsigned* p, unsigned v) { return __hip_atomic_fetch_add(p, v, __ATOMIC_RELAXED, __HIP_MEMORY_SCOPE_AGENT); }
__device__ __forceinline__ unsigned xb_xcc_id() { return (unsigned)__builtin_amdgcn_s_getreg((3 << 11) | 20) & 0xFu; }
#define XB_SPIN(cond, bar) do { unsigned _sp = 0; while (cond) { __builtin_amdgcn_s_sleep(1); \
    if ((++_sp & 255u) == 0u) { if (xb_ld(&(bar)[XB_TMO])) break; if (_sp > XB_SPIN_CAP) { atomicAdd(&(bar)[XB_TMO], 1u); break; } } } } while (0)

struct XcdBarrier {
    unsigned* bar; unsigned x;
    volatile __attribute__((address_space(3))) unsigned* st;
};

__device__ __forceinline__ XcdBarrier xcd_barrier_post(unsigned* bar, volatile __attribute__((address_space(3))) unsigned* st) {
    XcdBarrier b; b.bar = bar; b.x = xb_xcc_id(); b.st = st;
    if (threadIdx.x == 0) (void)xb_add(&bar[XB_XCNT(b.x)], 1u);
    return b;
}
__device__ __forceinline__ void xcd_barrier_complete(unsigned* bar, unsigned x, unsigned& nloc, unsigned& nx) {
    const unsigned G = gridDim.x * gridDim.y * gridDim.z;
    unsigned sum, cnt, mine, sp = 0u;
    for (;;) {
        sum = 0u; cnt = 0u; mine = 0u;
#pragma unroll
        for (unsigned j = 0; j < 16; ++j) { const unsigned c = xb_ld(&bar[XB_XCNT(j)]); sum += c; cnt += (c > 0u) ? 1u : 0u; mine = (j == x) ? c : mine; }
        if (sum == G) break;
        __builtin_amdgcn_s_sleep(1);
        if ((++sp & 255u) == 0u) { if (xb_ld(&bar[XB_TMO])) break; if (sp > XB_SPIN_CAP) { atomicAdd(&bar[XB_TMO], 1u); break; } }
    }
    nloc = mine > 0u ? mine : 1u; nx = cnt > 0u ? cnt : 1u;
}

__device__ __forceinline__ void xcd_barrier(const XcdBarrier& b) {
    asm volatile("s_waitcnt vmcnt(0)" ::: "memory");
    __syncthreads();
    if (threadIdx.x == 0) {
        unsigned* bar = b.bar;
        __builtin_amdgcn_s_waitcnt(0);
        unsigned nloc = b.st[0], nx = b.st[1];
        if (nloc == 0u) { xcd_barrier_complete(bar, b.x, nloc, nx); b.st[0] = nloc; b.st[1] = nx; }
        const unsigned old = xb_add(&bar[XB_XSUB(b.x)], 1u);
        const unsigned gen = old / nloc;
        if (old + 1u == (gen + 1u) * nloc) {
            __builtin_amdgcn_fence(__ATOMIC_RELEASE, "agent");
            asm volatile("s_waitcnt vmcnt(0)" ::: "memory");
            const unsigned og = xb_add(&bar[XB_TOP], 1u);
            const unsigned tg = og / nx;
            if (og + 1u == (tg + 1u) * nx) xb_add(&bar[XB_TOPGEN], 1u);
            else XB_SPIN(xb_ld(&bar[XB_TOPGEN]) == tg, bar);
            __builtin_amdgcn_fence(__ATOMIC_ACQUIRE, "agent");
            xb_add(&bar[XB_XGEN(b.x)], 1u);
            asm volatile("s_waitcnt vmcnt(0)" ::: "memory");
        } else {
            XB_SPIN(xb_ld(&bar[XB_XGEN(b.x)]) == gen, bar);
            __builtin_amdgcn_fence(__ATOMIC_ACQUIRE, "agent");
            asm volatile("s_waitcnt vmcnt(0)" ::: "memory");
        }
    }
    __syncthreads();
}


struct Params {
    const float *x, *c, *w_ada, *b_ada, *norm1_w, *w_in, *cmp_pe_k, *cmp_pe_v, *cmp_w1_k, *cmp_w2_k, *cmp_w1_v, *cmp_w2_v, *nsa_norm_w, *conv_w, *conv_b, *dt_bias, *a_log, *d_skip,
        *ssd_norm_w, *w_out, *norm2_w, *peer_wq, *peer_qnorm_w, *peer_sub_keys, *peer_down, *peer_up, *final_norm_w;
    float* out; char* ws;
};
#define LDS_BYTES 147456
#define LDS_MISC  (LDS_BYTES - 64)

__global__ __launch_bounds__(512, 2) void mega(Params p) {
    __shared__ __attribute__((aligned(16))) unsigned char lds_raw[LDS_BYTES];
    char* lds = (char*)lds_raw;
    PG8_LAS unsigned char* lds3 = (PG8_LAS unsigned char*)lds_raw;
    int* s_vb = (int*)(lds + LDS_MISC);
    cg::grid_group grid = cg::this_grid();
    volatile __attribute__((address_space(3))) unsigned* xb_st = (volatile __attribute__((address_space(3))) unsigned*)((PG8_LAS unsigned char*)lds_raw + LDS_MISC + 16);
    if (threadIdx.x == 0) { xb_st[0] = 0u; xb_st[1] = 0u; }
    __syncthreads();
    const XcdBarrier xbar = xcd_barrier_post((unsigned*)(p.ws + OFF_BAR), xb_st);
    const int G = gridDim.x, bid = blockIdx.x;
    if (bid == 0 && threadIdx.x == 0) { ((unsigned*)(p.ws + OFF_CTR))[0] = 0u; ((unsigned*)(p.ws + OFF_CTR))[64] = 0u; ((unsigned*)(p.ws + OFF_CTR))[128] = 0u; }
    for (int vb = bid; vb < 7906; vb += G) {
        int v = vb;
        if (v < 1536) { d_transpose_w(p.w_in, ((bf16_t*)(p.ws + OFF_WIN_T)), 1024, 2848, 1, 96, v, lds); }
        else if ((v -= 1536) < 512) { d_transpose_w(p.w_out, ((bf16_t*)(p.ws + OFF_WOUT_T)), 1024, 1024, 0, 32, v, lds); }
        else if ((v -= 512) < 1024) { d_transpose_w(p.peer_wq, ((bf16_t*)(p.ws + OFF_WQ_T)), 1024, 2048, 0, 64, v, lds); }
        else if ((v -= 1024) < 256) { d_transpose_w(p.cmp_w1_k, ((bf16_t*)(p.ws + OFF_W1K_T)), 2048, 256, 0, 8, v, lds); }
        else if ((v -= 256) < 256) { d_transpose_w(p.cmp_w1_v, ((bf16_t*)(p.ws + OFF_W1V_T)), 2048, 256, 0, 8, v, lds); }
        else if ((v -= 256) < 2048) { d_quant_rows(p.peer_down, ((unsigned char*)(p.ws + OFF_DOWN)), ((float*)(p.ws + OFF_UP)), v); }
        else if ((v -= 2048) < 2048) { d_quant_rows(p.peer_up, ((unsigned char*)(p.ws + OFF_DOWN + MIB(8))), ((float*)(p.ws + OFF_UP + 65536)), v); }
        else if ((v -= 2048) < 1) { d_convert_bf16(p.peer_sub_keys, ((bf16_t*)(p.ws + OFF_SUBK)), (size_t)8 * 2 * 128 * 128 / 8, 0, 1); }
        else if ((v -= 1) < 96) { d_mod(p.c, p.w_ada, p.b_ada, ((float*)(p.ws + OFF_MOD)), v, lds); }
        else if ((v -= 96) < 128) { d_rope_table(((float2*)(p.ws + OFF_ROPE)), v); }
        else { d_bias1(p.cmp_pe_k, p.cmp_w1_k, p.cmp_pe_v, p.cmp_w1_v, ((float*)(p.ws + OFF_BIAS1))); }
    }
    grid.sync();
    for (int vb = bid; vb < NTOK / 32; vb += G) d_norm_mod<false>(p.x, p.norm1_w, ((float*)(p.ws + OFF_MOD)), 0, 1024, ((bf16_t*)(p.ws + OFF_H)), vb);
    xcd_barrier(xbar);
    {
        const pg8::Gemm g{((bf16_t*)(p.ws + OFF_H)), ((bf16_t*)(p.ws + OFF_WIN_T)), NTOK, NIN_PAD, 1024, 1024};
        pg8::StaticOrder S; S.init(NTOK, NIN_PAD, G, bid);
        const pg8::Epi<EpInProj> E{{((bf16_t*)(p.ws + OFF_PROJ)), ((bf16_t*)(p.ws + OFF_QROPE)), ((bf16_t*)(p.ws + OFF_KVP)), ((float*)(p.ws + OFF_SMALL)), ((float2*)(p.ws + OFF_ROPE)), p.dt_bias}};
        pg8::gemm_phase(lds3, g, S, E);
    }
    xcd_barrier(xbar);
    {
        {
            const pg8::Gemm g{((bf16_t*)(p.ws + OFF_KVP)) + 0 * KVP_SEG, ((bf16_t*)(p.ws + OFF_W1K_T)), 8192, 256, 2048, 1024};
            pg8::StaticOrder S; S.init(8192, 256, G, bid);
            const pg8::Epi<EpCmpHid> E{{((bf16_t*)(p.ws + OFF_HIDK)), ((float*)(p.ws + OFF_BIAS1))}};
            pg8::gemm_phase(lds3, g, S, E);
        }
        {
            const pg8::Gemm g{((bf16_t*)(p.ws + OFF_KVP)) + 1 * KVP_SEG, ((bf16_t*)(p.ws + OFF_W1V_T)), 8192, 256, 2048, 1024};
            pg8::StaticOrder S; S.init(8192, 256, G, (bid + G / 2) % G);
            const pg8::Epi<EpCmpHid> E{{((bf16_t*)(p.ws + OFF_HIDV)), ((float*)(p.ws + OFF_BIAS1)) + 256}};
            pg8::gemm_phase(lds3, g, S, E);
        }
        __syncthreads();
        for (int vb = bid; vb < 1024; vb += G) d_ssd_states(((bf16_t*)(p.ws + OFF_PROJ)), ((float*)(p.ws + OFF_SMALL)), p.conv_w, p.conv_b, p.a_log, ((float*)(p.ws + OFF_ONSA)), ((float*)(p.ws + OFF_CTR + 4096)), vb, lds);
    }
    xcd_barrier(xbar);
    for (int vb = bid; vb < 2048 + 128; vb += G) {
        if (vb < 1024) d_cmp_out(((bf16_t*)(p.ws + OFF_HIDK)), p.cmp_w2_k, ((bf16_t*)(p.ws + OFF_KC)), vb); else if (vb < 2048) d_cmp_out(((bf16_t*)(p.ws + OFF_HIDV)), p.cmp_w2_v, ((bf16_t*)(p.ws + OFF_VC)), vb - 1024);
        else d_ssd_scan(((float*)(p.ws + OFF_ONSA)), ((float*)(p.ws + OFF_CTR + 4096)), ((bf16_t*)(p.ws + OFF_EIDX)), vb - 2048);
    }
    xcd_barrier(xbar);
    for (;;) {
        if (threadIdx.x == 0) *s_vb = (int)atomicAdd(&((unsigned*)(p.ws + OFF_CTR))[0], 1u);
        __syncthreads();
        const int i = *s_vb;
        __syncthreads();
        if (i >= 2048) break;
        const int qt = 127 - (i >> 4), bg = i & 15;
        d_nsa_cmp(((bf16_t*)(p.ws + OFF_PROJ)), ((bf16_t*)(p.ws + OFF_KC)), ((bf16_t*)(p.ws + OFF_VC)), ((float*)(p.ws + OFF_SMALL)), ((bf16_t*)(p.ws + OFF_ONSA)), ((unsigned*)(p.ws + OFF_HIDK)) + (size_t)(bg * 128 + qt) * 512, bg >> 1, bg & 1, qt, lds);
    }
    for (;;) {
        if (threadIdx.x == 0) *s_vb = (int)atomicAdd(&((unsigned*)(p.ws + OFF_CTR))[64], 1u);
        __syncthreads();
        const int i = *s_vb;
        __syncthreads();
        if (i >= 1024) break;
        d_ssd_out(((bf16_t*)(p.ws + OFF_PROJ)), ((float*)(p.ws + OFF_SMALL)), p.conv_w, p.conv_b, p.a_log, p.d_skip, ((bf16_t*)(p.ws + OFF_EIDX)), ((bf16_t*)(p.ws + OFF_YSSD)), i, lds);
    }
    xcd_barrier(xbar);
    for (;;) {
        if (threadIdx.x == 0) *s_vb = (int)atomicAdd(&((unsigned*)(p.ws + OFF_CTR))[128], 1u);
        __syncthreads();
        const int i = *s_vb;
        __syncthreads();
        if (i >= 2048) break;
        const int qt = 127 - (i >> 4), bg = i & 15;
        d_nsa_attn(((bf16_t*)(p.ws + OFF_QROPE)), ((bf16_t*)(p.ws + OFF_KVP)), ((float*)(p.ws + OFF_SMALL)), ((bf16_t*)(p.ws + OFF_ONSA)), ((unsigned*)(p.ws + OFF_HIDK)) + (size_t)(bg * 128 + qt) * 512, bg >> 1, bg & 1, qt, lds);
    }
    xcd_barrier(xbar);
    for (int vb = bid; vb < NTOK / 32; vb += G) d_mix_prep(((bf16_t*)(p.ws + OFF_ONSA)), ((bf16_t*)(p.ws + OFF_YSSD)), p.nsa_norm_w, p.ssd_norm_w, ((bf16_t*)(p.ws + OFF_H)), vb);
    xcd_barrier(xbar);
    {
        const pg8::Gemm g{((bf16_t*)(p.ws + OFF_H)), ((bf16_t*)(p.ws + OFF_WOUT_T)), NTOK, 1024, 1024, 1024};
        pg8::StaticOrder S; S.init(NTOK, 1024, G, bid);
        const pg8::Epi<EpOutProj> E{{p.x, ((float*)(p.ws + OFF_MOD)), ((bf16_t*)(p.ws + OFF_ONSA))}};
        pg8::gemm_phase(lds3, g, S, E);
    }
    xcd_barrier(xbar);
    for (int vb = bid; vb < NTOK / 32; vb += G) d_norm_mod<true>(((bf16_t*)(p.ws + OFF_ONSA)), p.norm2_w, ((float*)(p.ws + OFF_MOD)), 3072, 4096, ((bf16_t*)(p.ws + OFF_H)), vb);
    xcd_barrier(xbar);
    {
        const pg8::Gemm g{((bf16_t*)(p.ws + OFF_H)), ((bf16_t*)(p.ws + OFF_WQ_T)), NTOK, 2048, 1024, 1024};
        pg8::StaticOrder S; S.init(NTOK, 2048, G, bid);
        const pg8::Epi<EpStoreBf16> E{{((bf16_t*)(p.ws + OFF_PROJ)), 2048, 0}};
        pg8::gemm_phase(lds3, g, S, E);
    }
    xcd_barrier(xbar);
    for (int h = 0; h < 8; ++h) {
        __syncthreads();
        d_peer_stage_keys(((bf16_t*)(p.ws + OFF_SUBK)), h, lds);
        __syncthreads();
        for (int tile = bid; tile < 512; tile += G) d_peer_route(((bf16_t*)(p.ws + OFF_PROJ)), p.peer_qnorm_w, ((int*)(p.ws + OFF_EIDX)), ((float*)(p.ws + OFF_GATE)), tile, h, lds);
    }
    xcd_barrier(xbar);
    for (int vb = bid; vb < NTOK / 8; vb += G) d_peer_expert_mx(((bf16_t*)(p.ws + OFF_H)), ((unsigned char*)(p.ws + OFF_DOWN)), ((unsigned char*)(p.ws + OFF_DOWN + MIB(8))), ((float*)(p.ws + OFF_UP)), ((float*)(p.ws + OFF_UP + 65536)), ((int*)(p.ws + OFF_EIDX)), ((float*)(p.ws + OFF_GATE)), ((float*)(p.ws + OFF_MOD)), p.final_norm_w, ((bf16_t*)(p.ws + OFF_ONSA)), p.out, vb, lds);
}

extern "C" void kernel_launch(void* const* d_in, const int* in_sizes, int n_in, void* d_out, int out_size, void* d_ws, size_t ws_size, hipStream_t stream) {
    if (ws_size < WS_NEED) { fprintf(stderr, "workspace too small\n"); return; }
    static int grid_blocks = 0;
    if (!grid_blocks) {
        int dev = 0, cus = 0, per_cu = 0;
        (void)hipGetDevice(&dev);
        (void)hipDeviceGetAttribute(&cus, hipDeviceAttributeMultiprocessorCount, dev);
        (void)hipOccupancyMaxActiveBlocksPerMultiprocessor(&per_cu, mega, 512, 0);
        if (per_cu < 1) fprintf(stderr, "occupancy query reports %d blocks per CU\n", per_cu);
        grid_blocks = cus;
    }
    Params p{};
    const float** pp = (const float**)&p;
    for (int i = 0; i < 27; ++i) pp[i] = (const float*)d_in[i];
    p.out = (float*)d_out; p.ws = (char*)d_ws;
    (void)hipMemsetAsync((char*)d_ws + OFF_BAR, 0, XCD_BAR_WORDS * 4, stream);
    void* args[] = {&p};
    hipError_t e = hipLaunchCooperativeKernel((void*)mega, dim3(grid_blocks), dim3(512), args, 0, stream);
    if (e != hipSuccess) fprintf(stderr, "cooperative launch failed: %s (grid %d)\n", hipGetErrorString(e), grid_blocks);
}
```

```cpp
#include <hip/hip_runtime.h>
#include <hip/hip_cooperative_groups.h>
#include <stdint.h>
#include <cstdio>
namespace cg = cooperative_groups;

typedef unsigned short bf16_t;
typedef short bf16x8 __attribute__((ext_vector_type(8)));
typedef float f32x4 __attribute__((ext_vector_type(4)));
typedef float f32x2 __attribute__((ext_vector_type(2)));
typedef unsigned u32x4 __attribute__((ext_vector_type(4)));
typedef unsigned u32x2 __attribute__((ext_vector_type(2)));

#define NB 8
#define SEQ 8192
#define NTOK 65536
#define DM 1024
#define PROJ_LD 2816
#define NIN_PAD 3072
#define C_Q 0
#define C_KCMP 512
#define C_KSEL 768
#define C_VSEL 896
#define C_KWIN 1024
#define C_VWIN 1152
#define C_Z 1280
#define C_XBC 1792
#define NCMP 511
#define EPS 1e-6f
#define KVP_SEG ((size_t)NB * 2 * SEQ * 64)

#define MIB(x) ((size_t)(x) << 20)
#define OFF_MOD    MIB(0)
#define OFF_ROPE   MIB(1)
#define OFF_BIAS1  MIB(2)
#define OFF_WIN_T  MIB(3)
#define OFF_WOUT_T MIB(9)
#define OFF_WQ_T   MIB(11)
#define OFF_SUBK   MIB(15)
#define OFF_W1K_T  MIB(16)
#define OFF_W1V_T  MIB(17)
#define OFF_KC     MIB(18)
#define OFF_VC     MIB(19)
#define OFF_HIDK   MIB(20)
#define OFF_HIDV   MIB(24)
#define OFF_DOWN   MIB(28)
#define OFF_UP     MIB(60)
#define OFF_SMALL  MIB(92)
#define OFF_H      MIB(100)
#define OFF_PROJ   MIB(228)
#define OFF_QROPE  MIB(580)
#define OFF_ONSA   MIB(644)
#define OFF_YSSD   MIB(772)
#define OFF_KVP    MIB(836)
#define OFF_EIDX   MIB(932)
#define OFF_GATE   MIB(964)
#define OFF_CTR    MIB(996)
#define OFF_BAR    (MIB(996) + 65536)
#define WS_NEED    MIB(997)

typedef __bf16 hwbf2 __attribute__((ext_vector_type(2)));
__device__ __forceinline__ bf16_t f2bf(float f) { const __bf16 h = (__bf16)f; return __builtin_bit_cast(bf16_t, h); }
__device__ __forceinline__ float bf2f(bf16_t h) { return __uint_as_float(((unsigned)h) << 16); }
__device__ __forceinline__ float bflo(unsigned u) { return __uint_as_float(u << 16); }
__device__ __forceinline__ float bfhi(unsigned u) { return __uint_as_float(u & 0xffff0000u); }
__device__ __forceinline__ unsigned pack2(float a, float b) { const f32x2 v = {a, b}; const hwbf2 r = __builtin_convertvector(v, hwbf2); return __builtin_bit_cast(unsigned, r); }
__device__ __forceinline__ float wave_sum(float v) {
#pragma unroll
    for (int o = 32; o; o >>= 1) v += __shfl_xor(v, o);
    return v;
}
__device__ __forceinline__ float wave_max(float v) {
#pragma unroll
    for (int o = 32; o; o >>= 1) v = fmaxf(v, __shfl_xor(v, o));
    return v;
}
__device__ __forceinline__ int tid_opaque() { int t = threadIdx.x; asm volatile("" : "+v"(t)); return t; }
__device__ __forceinline__ float gelu_tanh(float x) { const float u2 = 1.5957691216057308f * (x + 0.044715f * x * x * x); return x * __builtin_amdgcn_rcpf(1.0f + __expf(-u2)); }
__device__ __forceinline__ float silu(float x) { return x / (1.0f + __expf(-x)); }
__device__ __forceinline__ float sigmoidf(float x) { return 1.0f / (1.0f + __expf(-x)); }
__device__ __forceinline__ float softplusf(float x) { return x > 20.f ? x : log1pf(__expf(x)); }

__device__ __forceinline__ int inproj_src(int n) {
    if (n < 1280) return n;
    if (n < 1792) return 1304 + (n - 1280);
    if (n < 2816) return 1816 + (n - 1792);
    if (n < 2840) return 1280 + (n - 2816);
    if (n < 2848) return 2840 + (n - 2840);
    return -1;
}
__device__ __forceinline__ void d_transpose_w(const float* __restrict__ W, bf16_t* __restrict__ Wt, int K, int N, int mode, int nbx, int vb, char* lds) {
    const int tid_ = tid_opaque(); const int half = tid_ >> 8, t256 = tid_ & 255, tile = vb * 2 + half;
    float (*t)[33] = (float (*)[33])(lds + half * 4352);
    const int n0 = (tile % nbx) * 32, k0 = (tile / nbx) * 32, tx = t256 & 31, ty = t256 >> 5;
#pragma unroll
    for (int i = 0; i < 4; ++i) {
        const int k = k0 + ty + 8 * i, n = n0 + tx;
        const int src = mode == 1 ? inproj_src(n) : n;
        t[ty + 8 * i][tx] = (src >= 0 && src < N) ? W[(size_t)k * N + src] : 0.f;
    }
    __syncthreads();
#pragma unroll
    for (int i = 0; i < 4; ++i) Wt[(size_t)(n0 + ty + 8 * i) * K + k0 + tx] = f2bf(t[tx][ty + 8 * i]);
    __syncthreads();
}
__device__ __forceinline__ void d_convert_bf16(const float* __restrict__ in, bf16_t* __restrict__ out, size_t n8, int vb, int nvb) {
    size_t i = (size_t)vb * 512 + tid_opaque();
    const size_t stride = (size_t)nvb * 512;
    for (; i < n8; i += stride) {
        const f32x4 a = ((const f32x4*)in)[2 * i], b = ((const f32x4*)in)[2 * i + 1];
        u32x4 o; o.x = pack2(a.x, a.y); o.y = pack2(a.z, a.w); o.z = pack2(b.x, b.y); o.w = pack2(b.z, b.w);
        ((u32x4*)out)[i] = o;
    }
}
__device__ __forceinline__ void d_mod(const float* __restrict__ c, const float* __restrict__ w_ada, const float* __restrict__ b_ada, float* __restrict__ mod, int vb, char* lds) {
    float (*part)[8][64] = (float (*)[8][64])lds;
    const int tid = tid_opaque(), jl = tid & 63, kq = tid >> 6, j = vb * 64 + jl;
    float acc[8];
#pragma unroll
    for (int b = 0; b < 8; ++b) acc[b] = 0.f;
    for (int k0 = kq * 128; k0 < kq * 128 + 128; k0 += 16) {
        float wv[16];
#pragma unroll
        for (int i = 0; i < 16; ++i) wv[i] = w_ada[(size_t)(k0 + i) * 6144 + j];
#pragma unroll
        for (int i = 0; i < 16; ++i)
#pragma unroll
            for (int b = 0; b < 8; ++b) acc[b] += c[b * 1024 + k0 + i] * wv[i];
    }
#pragma unroll
    for (int b = 0; b < 8; ++b) part[kq][b][jl] = acc[b];
    __syncthreads();
    {
        const int b = tid >> 6, jj = tid & 63;
        float s = b_ada[vb * 64 + jj];
#pragma unroll
        for (int q = 0; q < 8; ++q) s += part[q][b][jj];
        mod[b * 6144 + vb * 64 + jj] = s;
    }
    __syncthreads();
}
__device__ __forceinline__ void d_rope_table(float2* __restrict__ rope, int vb) {
    const int i = vb * 512 + tid_opaque();
    if (i >= SEQ * 8) return;
    const int pos = i >> 3, f = i & 7;
    const double inv = pow(500000.0, -(double)f / 8.0);
    const double ang = (double)pos * inv;
    rope[i] = make_float2((float)cos(ang), (float)sin(ang));
}
__device__ __forceinline__ void d_bias1(const float* __restrict__ pe_k, const float* __restrict__ w1_k, const float* __restrict__ pe_v, const float* __restrict__ w1_v, float* __restrict__ bias1) {
    const int tid_ = tid_opaque(); const int which = tid_ >> 8, j = tid_ & 255;
    const float* pe = which ? pe_v : pe_k; const float* w1 = which ? w1_v : w1_k;
    float a = 0.f;
    for (int k0 = 0; k0 < 2048; k0 += 16) {
        float wv[16];
#pragma unroll
        for (int i = 0; i < 16; ++i) wv[i] = w1[(size_t)(k0 + i) * 256 + j];
#pragma unroll
        for (int i = 0; i < 16; ++i) a += pe[k0 + i] * wv[i];
    }
    bias1[which * 256 + j] = a;
}

template <bool XBF>
__device__ __forceinline__ void d_norm_mod(const void* __restrict__ xin, const float* __restrict__ w, const float* __restrict__ mod, int sh_off, int sc_off, bf16_t* __restrict__ out, int vb) {
    const int tid_ = tid_opaque(); const int lane = tid_ & 63, wid = tid_ >> 6;
    const size_t row0 = (size_t)vb * 32 + wid * 4; const int b = (int)(row0 >> 13);
    f32x4 v[4][4];
#pragma unroll
    for (int r = 0; r < 4; ++r)
#pragma unroll
        for (int k = 0; k < 4; ++k) {
            if (XBF) { const u32x2 t = *(const u32x2*)((const bf16_t*)xin + (row0 + r) * DM + k * 256 + lane * 4); v[r][k] = (f32x4){bflo(t.x), bfhi(t.x), bflo(t.y), bfhi(t.y)}; }
            else v[r][k] = *(const f32x4*)((const float*)xin + (row0 + r) * DM + k * 256 + lane * 4);
        }
    float rs[4];
#pragma unroll
    for (int r = 0; r < 4; ++r) {
        float ss = 0.f;
#pragma unroll
        for (int k = 0; k < 4; ++k) ss += v[r][k].x * v[r][k].x + v[r][k].y * v[r][k].y + v[r][k].z * v[r][k].z + v[r][k].w * v[r][k].w;
        rs[r] = rsqrtf(wave_sum(ss) * (1.0f / DM) + EPS);
    }
#pragma unroll
    for (int k = 0; k < 4; ++k) {
        const int col = k * 256 + lane * 4;
        const f32x4 wv = *(const f32x4*)(w + col), sc = *(const f32x4*)(mod + b * 6144 + sc_off + col), sh = *(const f32x4*)(mod + b * 6144 + sh_off + col);
        const f32x4 ws = wv * (sc + 1.0f);
#pragma unroll
        for (int r = 0; r < 4; ++r) {
            const f32x4 y = v[r][k] * rs[r] * ws + sh;
            u32x2 o; o.x = pack2(y.x, y.y); o.y = pack2(y.z, y.w);
            *(u32x2*)(out + (row0 + r) * DM + col) = o;
        }
    }
}

namespace pg8 {
#define PG8_LAS __attribute__((address_space(3)))
constexpr int BM = 256, BK = 64, HALF = 128, HTB = HALF * BK * 2  , STAGE_BYTES = 8 * HTB, NXCD = 8, WGM = 8;
__host__ __device__ __forceinline__ int lds_byte(int r, int c) { const int st = (r >> 4) * 2 + (c >> 5), rr = r & 15, cc = c & 31, ob = rr * 64 + cc * 2; return st * 1024 + (ob ^ (((ob >> 9) & 1) << 5)); }
__host__ __device__ __forceinline__ void stage_rc(int b, int& R, int& C) { const int st = b / 1024, sb = b % 1024, swz = sb ^ (((sb >> 9) & 1) << 5); R = (st >> 1) * 16 + swz / 64; C = (st & 1) * 32 + (swz % 64) / 2; }
__host__ __device__ __forceinline__ int perm32(int rho) { const int n = rho >> 4, i = rho & 15; return 8 * (i >> 2) + 4 * n + (i & 3); }
struct Unit { int pm, pn; };
struct Gemm { const bf16_t* A; const bf16_t* Bt; int M, N, K, lda; };
struct StaticOrder {
    int nM, nN, nwg, G, c;
    __host__ __device__ void init(int M, int N, int G_, int c_) { nM = M / BM; nN = N / BM; nwg = nM * nN; G = G_; c = c_; }
    __host__ __device__ bool next(int i, Unit& u) const {
        const long L = (long)i * G + c; if (L >= nwg) return false;
        int wgid = (int)L; { const int q = nwg / NXCD, r = nwg % NXCD, xcd = wgid % NXCD, off = wgid / NXCD; wgid = (xcd < r ? xcd * (q + 1) : r * (q + 1) + (xcd - r) * q) + off; }
        const int nig = WGM * nN, gid = wgid / nig, fm = gid * WGM, gsz = (nM - fm) < WGM ? (nM - fm) : WGM;
        u.pm = fm + ((wgid % nig) % gsz); u.pn = (wgid % nig) / gsz; return true;
    }
};
template <class F> struct Epi {
    F f;
    __device__ __forceinline__ void operator()(const f32x4 (&acc)[2][2][4][2], const Unit& u, int wr, int wc, int fr, int fq) const {
#pragma unroll
        for (int ai = 0; ai < 2; ++ai)
#pragma unroll
            for (int m = 0; m < 4; ++m)
#pragma unroll
                for (int bj = 0; bj < 2; ++bj)
                    f(u.pm * BM + ai * HALF + wr * 64 + m * 16 + fr, u.pn * BM + bj * HALF + wc * 32 + 8 * fq, acc[ai][bj][m][0], acc[ai][bj][m][1]);
    }
};
template <class E, class Sched>
__device__ __forceinline__ void gemm_phase(PG8_LAS unsigned char* lds, const Gemm g, const Sched& S, const E& Ep) {
    const int tid = tid_opaque(), wid = __builtin_amdgcn_readfirstlane(tid >> 6), lane = tid & 63, wr = wid >> 2, wc = wid & 3, fr = lane & 15, fq = lane >> 4;
    const int K = g.K, nt = K / BK;
    unsigned voffA[2], voffB[2];
#pragma unroll
    for (int i = 0; i < 2; ++i) { int R, C; stage_rc(tid * 16 + i * 8192, R, C); const int Rb = (R & ~31) + perm32(R & 31); voffA[i] = (unsigned)(R * g.lda + C) * 2u; voffB[i] = (unsigned)(Rb * K + C) * 2u; }
    const size_t kstep = (size_t)(BK * 2);
    const size_t hstep = (size_t)HALF * K * 2, hstepA = (size_t)HALF * g.lda * 2;
    const size_t tstep = 2 * hstep, tstepA = 2 * hstepA;
    const unsigned ldsw = (unsigned)wid * 1024u;
    const int aoff = lds_byte(wr * 64 + fr, fq * 8), boff = lds_byte(wc * 32 + fr, fq * 8);
#define PG8_SA(b, h) (((b) * 2 + (h)) * HTB)
#define PG8_SB(b, h) ((4 + (b) * 2 + (h)) * HTB)
#define PG8_STAGE(bufoff, gbase, voff) do { _Pragma("unroll") for (int _i = 0; _i < 2; ++_i) \
        __builtin_amdgcn_global_load_lds((const unsigned*)((const char*)(gbase) + (voff)[_i]), (PG8_LAS unsigned*)(lds + (bufoff) + ldsw + _i * 8192), 16, 0, 0); } while (0)
#define PG8_LDA(dst, b, h) do { _Pragma("unroll") for (int m = 0; m < 4; ++m) _Pragma("unroll") for (int k = 0; k < 2; ++k) dst[m][k] = *(const PG8_LAS bf16x8*)(lds + PG8_SA(b, h) + aoff + m * 2048 + k * 1024); } while (0)
#define PG8_LDB(dst, b, h) do { _Pragma("unroll") for (int n = 0; n < 2; ++n) _Pragma("unroll") for (int k = 0; k < 2; ++k) dst[n][k] = *(const PG8_LAS bf16x8*)(lds + PG8_SB(b, h) + boff + n * 2048 + k * 1024); } while (0)
#define PG8_MMA(ai, bj, At, Bt) do { __builtin_amdgcn_s_setprio(1); _Pragma("unroll") for (int m = 0; m < 4; ++m) _Pragma("unroll") for (int n = 0; n < 2; ++n) _Pragma("unroll") for (int k = 0; k < 2; ++k) \
        acc[ai][bj][m][n] = __builtin_amdgcn_mfma_f32_16x16x32_bf16(Bt[n][k], At[m][k], acc[ai][bj][m][n], 0, 0, 0); __builtin_amdgcn_s_setprio(0); } while (0)
#define PG8_WAIT_V(n) asm volatile("s_waitcnt vmcnt(" #n ")" ::: "memory")
#define PG8_WAIT_L(n) asm volatile("s_waitcnt lgkmcnt(" #n ")" ::: "memory")
#define PG8_BAR __builtin_amdgcn_s_barrier()
#define PG8_SCHED __builtin_amdgcn_sched_barrier(0)
    Unit cur, nxt; int ui = 0;
    if (!S.next(0, cur)) return;
    f32x4 acc[2][2][4][2];
#pragma unroll
    for (int a = 0; a < 2; ++a)
#pragma unroll
        for (int b = 0; b < 2; ++b)
#pragma unroll
            for (int m = 0; m < 4; ++m)
#pragma unroll
                for (int n = 0; n < 2; ++n) acc[a][b][m][n] = (f32x4){0.f, 0.f, 0.f, 0.f};
    bf16x8 At[4][2], B0[2][2], B1[2][2];
    const char* cA = (const char*)g.A + (size_t)cur.pm * tstepA; const char* cB = (const char*)g.Bt + (size_t)cur.pn * tstep;
    PG8_STAGE(PG8_SB(0, 0), cB, voffB); PG8_STAGE(PG8_SB(0, 1), cB + hstep, voffB); PG8_STAGE(PG8_SA(0, 0), cA, voffA); PG8_STAGE(PG8_SA(0, 1), cA + hstepA, voffA);
    if (wr == 1) PG8_BAR;
    PG8_WAIT_V(2); PG8_BAR;
    PG8_STAGE(PG8_SB(1, 0), cB + kstep, voffB); PG8_STAGE(PG8_SA(1, 0), cA + kstep, voffA); PG8_STAGE(PG8_SB(1, 1), cB + hstep + kstep, voffB);
    PG8_WAIT_V(6); PG8_BAR;
    for (;;) {
        const bool has_next = S.next(ui + 1, nxt);
        const char* nA = has_next ? (const char*)g.A + (size_t)nxt.pm * tstepA : cA; const char* nB = has_next ? (const char*)g.Bt + (size_t)nxt.pn * tstep : cB;
        for (int t = 0; t < nt; t += 2) {
            const bool last = (t == nt - 2);
            const char* a1 = cA + (size_t)(t + 1) * kstep;
            const char* a2 = last ? nA : cA + (size_t)(t + 2) * kstep; const char* b2 = last ? nB : cB + (size_t)(t + 2) * kstep;
            const char* a3 = a2 + kstep; const char* b3 = b2 + kstep;
            PG8_LDB(B0, 0, 0); PG8_LDB(B1, 0, 1); PG8_SCHED; PG8_LDA(At, 0, 0); PG8_STAGE(PG8_SA(1, 1), a1 + hstepA, voffA);
            PG8_WAIT_V(8); PG8_WAIT_L(0); PG8_BAR; PG8_MMA(0, 0, At, B0); PG8_MMA(0, 1, At, B1); PG8_BAR; PG8_SCHED;
            PG8_LDA(At, 0, 1); PG8_STAGE(PG8_SB(0, 0), b2, voffB); PG8_STAGE(PG8_SB(0, 1), b2 + hstep, voffB); PG8_STAGE(PG8_SA(0, 0), a2, voffA);
            PG8_WAIT_V(8); PG8_WAIT_L(0); PG8_BAR; PG8_MMA(1, 0, At, B0); PG8_MMA(1, 1, At, B1); PG8_BAR; PG8_SCHED;
            PG8_LDB(B0, 1, 0); PG8_LDB(B1, 1, 1); PG8_SCHED; PG8_LDA(At, 1, 0); PG8_STAGE(PG8_SA(0, 1), a2 + hstepA, voffA);
            PG8_WAIT_V(8); PG8_WAIT_L(0); PG8_BAR; PG8_MMA(0, 0, At, B0); PG8_MMA(0, 1, At, B1); PG8_BAR; PG8_SCHED;
            PG8_LDA(At, 1, 1); PG8_STAGE(PG8_SB(1, 0), b3, voffB); PG8_STAGE(PG8_SB(1, 1), b3 + hstep, voffB); PG8_STAGE(PG8_SA(1, 0), a3, voffA);
            PG8_WAIT_V(8); PG8_WAIT_L(0); PG8_BAR; PG8_MMA(1, 0, At, B0); PG8_MMA(1, 1, At, B1); PG8_BAR; PG8_SCHED;
        }
        if (wr == 0) PG8_BAR;
        Ep(acc, cur, wr, wc, fr, fq);
        if (!has_next) break;
#pragma unroll
        for (int a = 0; a < 2; ++a)
#pragma unroll
            for (int b = 0; b < 2; ++b)
#pragma unroll
                for (int m = 0; m < 4; ++m)
#pragma unroll
                    for (int n = 0; n < 2; ++n) acc[a][b][m][n] = (f32x4){0.f, 0.f, 0.f, 0.f};
        cur = nxt; cA = nA; cB = nB; ++ui;
        if (wr == 1) PG8_BAR;
    }
    PG8_WAIT_V(0);
    PG8_BAR;
#undef PG8_SA
#undef PG8_SB
#undef PG8_STAGE
#undef PG8_LDA
#undef PG8_LDB
#undef PG8_MMA
#undef PG8_WAIT_V
#undef PG8_WAIT_L
#undef PG8_BAR
#undef PG8_SCHED
}
}

__device__ __forceinline__ u32x4 pack8(f32x4 a, f32x4 b) { u32x4 o; o.x = pack2(a.x, a.y); o.y = pack2(a.z, a.w); o.z = pack2(b.x, b.y); o.w = pack2(b.z, b.w); return o; }
struct EpInProj { bf16_t* proj; bf16_t* qrope; bf16_t* kvp; float* small; const float2* rope; const float* dt_bias;
    __device__ __forceinline__ void operator()(int m, int n0, f32x4 a, f32x4 b) const {
        if (n0 < 2816) {
            const bool is_q = n0 < 512;
            const bool roped_seg = is_q || (n0 >= C_KSEL && n0 < C_VSEL) || (n0 >= C_KWIN && n0 < C_VWIN);
            if (is_q) *(u32x4*)(proj + (size_t)m * PROJ_LD + n0) = pack8(a, b);
            if (roped_seg && (n0 & 32) == 0) {
                f32x4 pa, pb;
                pa.x = __shfl_xor(a.x, 16); pa.y = __shfl_xor(a.y, 16); pa.z = __shfl_xor(a.z, 16); pa.w = __shfl_xor(a.w, 16);
                pb.x = __shfl_xor(b.x, 16); pb.y = __shfl_xor(b.y, 16); pb.z = __shfl_xor(b.z, 16); pb.w = __shfl_xor(b.w, 16);
                if ((n0 & 63) < 16) {
                    const float sgn = (n0 & 8) ? 1.f : -1.f;
                    const f32x4* rp = (const f32x4*)(rope + (m & (SEQ - 1)) * 8);
                    const f32x4 c01 = rp[0], c23 = rp[1], c45 = rp[2], c67 = rp[3];
                    a.x = a.x * c01.x + sgn * pa.x * c01.y; a.y = a.y * c01.z + sgn * pa.y * c01.w;
                    a.z = a.z * c23.x + sgn * pa.z * c23.y; a.w = a.w * c23.z + sgn * pa.w * c23.w;
                    b.x = b.x * c45.x + sgn * pb.x * c45.y; b.y = b.y * c45.z + sgn * pb.y * c45.w;
                    b.z = b.z * c67.x + sgn * pb.z * c67.y; b.w = b.w * c67.z + sgn * pb.w * c67.w;
                }
            }
            const u32x4 o = pack8(a, b);
            if (is_q) *(u32x4*)(qrope + (size_t)m * 512 + n0) = o;
            else if (n0 < C_Z) {
                const int r = n0 - C_KCMP, seg = r >> 7, g = (r >> 6) & 1, d = r & 63, bb = m >> 13, t = m & (SEQ - 1);
                *(u32x4*)(kvp + (size_t)seg * KVP_SEG + ((size_t)(bb * 2 + g) * SEQ + t) * 64 + d) = o;
            }
            else *(u32x4*)(proj + (size_t)m * PROJ_LD + n0) = o;
        } else if (n0 < 2848) {
            const int c = n0 - 2816; f32x4 o0, o1;
            if (c < 24) { o0.x = sigmoidf(a.x); o0.y = sigmoidf(a.y); o0.z = sigmoidf(a.z); o0.w = sigmoidf(a.w); o1.x = sigmoidf(b.x); o1.y = sigmoidf(b.y); o1.z = sigmoidf(b.z); o1.w = sigmoidf(b.w); }
            else { const float* db = dt_bias; o0.x = softplusf(a.x + db[0]); o0.y = softplusf(a.y + db[1]); o0.z = softplusf(a.z + db[2]); o0.w = softplusf(a.w + db[3]);
                   o1.x = softplusf(b.x + db[4]); o1.y = softplusf(b.y + db[5]); o1.z = softplusf(b.z + db[6]); o1.w = softplusf(b.w + db[7]); }
            *(f32x4*)(small + (size_t)m * 32 + c) = o0; *(f32x4*)(small + (size_t)m * 32 + c + 4) = o1;
        }
    } };
struct EpCmpHid { bf16_t* hid; const float* bias;
    __device__ __forceinline__ void operator()(int m, int n0, f32x4 a, f32x4 b) const {
        const f32x4 b0 = *(const f32x4*)(bias + n0), b1 = *(const f32x4*)(bias + n0 + 4);
        a.x = gelu_tanh(a.x + b0.x); a.y = gelu_tanh(a.y + b0.y); a.z = gelu_tanh(a.z + b0.z); a.w = gelu_tanh(a.w + b0.w);
        b.x = gelu_tanh(b.x + b1.x); b.y = gelu_tanh(b.y + b1.y); b.z = gelu_tanh(b.z + b1.z); b.w = gelu_tanh(b.w + b1.w);
        *(u32x4*)(hid + (size_t)m * 256 + n0) = pack8(a, b);
    } };
struct EpOutProj { const float* x; const float* mod; bf16_t* x1;
    __device__ __forceinline__ void operator()(int m, int n0, f32x4 a, f32x4 b) const {
        const int bb = m >> 13;
        const f32x4 x0 = *(const f32x4*)(x + (size_t)m * DM + n0), x4 = *(const f32x4*)(x + (size_t)m * DM + n0 + 4);
        const f32x4 g0 = *(const f32x4*)(mod + bb * 6144 + 2048 + n0), g4 = *(const f32x4*)(mod + bb * 6144 + 2048 + n0 + 4);
        *(u32x4*)(x1 + (size_t)m * DM + n0) = pack8(x0 + g0 * a, x4 + g4 * b);
    } };
struct EpStoreBf16 { bf16_t* out; int ld; int pad;
    __device__ __forceinline__ void operator()(int m, int n0, f32x4 a, f32x4 b) const { *(u32x4*)(out + (size_t)m * ld + n0) = pack8(a, b); } };

__device__ __forceinline__ void d_cmp_out(const bf16_t* __restrict__ hid, const float* __restrict__ w2, bf16_t* __restrict__ out, int vb) {
    const int tid_ = tid_opaque(); const int m = vb * 8 + (tid_ >> 6), d = tid_ & 63;
    float a = 0.f;
#pragma unroll 8
    for (int j = 0; j < 256; ++j) a += bf2f(hid[(size_t)m * 256 + j]) * w2[j * 64 + d];
    out[(size_t)m * 64 + d] = f2bf(a);
}

#define KLD 80
#define NSA_OFF_KS0  0
#define NSA_OFF_VT0  10240
#define NSA_OFF_KS1  20480
#define NSA_OFF_VT1  30720
#define NSA_OFF_IMP  40960
#define NSA_OFF_SELW 74752
#define NSA_OFF_ANYW 75776
#define NSA_OFF_BL   75808
#define NSA_OFF_QS   76352
#define NSA_LDS      (76352 + 8 * 32 * KLD * 2)
#define SM_C 0.18033688011112042f

struct KVStage { u32x4 k, v; };
__device__ __forceinline__ void nsa_stage_load(KVStage& st, const bf16_t* kb, const bf16_t* vb, int tid) {
    st.k = *(const u32x4*)(kb + tid * 8); st.v = *(const u32x4*)(vb + tid * 8);
}
__device__ __forceinline__ void nsa_stage_store(bf16_t* Ks, bf16_t* Vt, int tid, const KVStage& st) {
    const int r = tid >> 3, c = tid & 7;
    *(u32x4*)(Ks + r * KLD + c * 8) = st.k;
    *(u32x4*)(Vt + r * KLD + c * 8) = st.v;
}
template <int NROW>
__device__ __forceinline__ void nsa_load_q(const bf16_t* qsrc, size_t ld, int lane, bf16_t* Qs) {
    u32x4 r[NROW / 8];
#pragma unroll
    for (int i = 0; i < NROW / 8; ++i) { const int p = lane + 64 * i; r[i] = *(const u32x4*)(qsrc + (size_t)(p >> 3) * ld + (p & 7) * 8); }
#pragma unroll
    for (int i = 0; i < NROW / 8; ++i) { const int p = lane + 64 * i; *(u32x4*)(Qs + (p >> 3) * KLD + (p & 7) * 8) = r[i]; }
}
template <int TT>
__device__ __forceinline__ void nsa_qk(const bf16_t* Ks, const bf16_t* Qs, f32x4 (&s)[4][TT], int fr, int fq) {
#pragma unroll
    for (int kt = 0; kt < 4; ++kt)
#pragma unroll
        for (int tt = 0; tt < TT; ++tt) s[kt][tt] = (f32x4){0.f, 0.f, 0.f, 0.f};
#pragma unroll
    for (int ks = 0; ks < 2; ++ks) {
        if (TT > 2) __builtin_amdgcn_sched_barrier(0);
        bf16x8 qf[TT];
#pragma unroll
        for (int tt = 0; tt < TT; ++tt) qf[tt] = *(const bf16x8*)(Qs + (tt * 16 + fr) * KLD + ks * 32 + fq * 8);
#pragma unroll
        for (int kt = 0; kt < 4; ++kt) {
            const bf16x8 kf = *(const bf16x8*)(Ks + (kt * 16 + fr) * KLD + ks * 32 + fq * 8);
#pragma unroll
            for (int tt = 0; tt < TT; ++tt) s[kt][tt] = __builtin_amdgcn_mfma_f32_16x16x32_bf16(kf, qf[tt], s[kt][tt], 0, 0, 0);
        }
    }
}
template <int TT>
__device__ __forceinline__ void nsa_pv(const bf16_t* Vt, const f32x4 (&p)[4][TT], f32x4 (&o)[4][TT], int fr, int fq) {
#pragma unroll
    for (int ks2 = 0; ks2 < 2; ++ks2) {
        bf16x8 pf[TT];
#pragma unroll
        for (int tt = 0; tt < TT; ++tt) {
            const f32x4 a = p[2 * ks2][tt], b = p[2 * ks2 + 1][tt];
            u32x4 w; w.x = pack2(a.x, a.y); w.y = pack2(a.z, a.w); w.z = pack2(b.x, b.y); w.w = pack2(b.z, b.w);
            pf[tt] = __builtin_bit_cast(bf16x8, w);
        }
#pragma unroll
        for (int dt = 0; dt < 4; ++dt) {
            if (TT > 2) __builtin_amdgcn_sched_barrier(0);
            typedef short s16x4 __attribute__((ext_vector_type(4)));
            const bf16_t* vp = Vt + (ks2 * 32 + 4 * fq + (fr >> 2)) * KLD + dt * 16 + 4 * (fr & 3);
            const s16x4 a0 = __builtin_amdgcn_ds_read_tr16_b64_v4i16((__attribute__((address_space(3))) s16x4*)vp);
            const s16x4 a1 = __builtin_amdgcn_ds_read_tr16_b64_v4i16((__attribute__((address_space(3))) s16x4*)(vp + 16 * KLD));
            const bf16x8 vf = (bf16x8){a0.x, a0.y, a0.z, a0.w, a1.x, a1.y, a1.z, a1.w};
#pragma unroll
            for (int tt = 0; tt < TT; ++tt) o[dt][tt] = __builtin_amdgcn_mfma_f32_16x16x32_bf16(vf, pf[tt], o[dt][tt], 0, 0, 0);
        }
    }
}
template <int MK>
__device__ __forceinline__ bool nsa_valid(int kk, int ti, int n0, int t0) {
    if (MK == 1) return kk <= ti;
    if (MK == 2) return kk > ti;
    return 16 * (n0 + kk) + 31 <= t0 + ti;
}
template <int MK, bool WITH_O, int TT>
__device__ __forceinline__ void nsa_softmax(f32x4 (&s)[4][TT], float (&m)[TT], float (&l)[TT], f32x4 (&o)[4][TT], const bool (&selb)[TT], int tib, int fq, int n0, int t0) {
#pragma unroll
    for (int tt = 0; tt < TT; ++tt) {
        const int ti = tib + tt * 16;
        float mx = -1e30f;
#pragma unroll
        for (int kt = 0; kt < 4; ++kt)
#pragma unroll
            for (int jj = 0; jj < 4; ++jj) {
                const int kk = kt * 16 + 4 * fq + jj;
                const bool v = selb[tt] && nsa_valid<MK>(kk, ti, n0, t0);
                const float sv = v ? s[kt][tt][jj] * SM_C : -1e30f;
                s[kt][tt][jj] = sv; mx = fmaxf(mx, sv);
            }
        mx = fmaxf(mx, __shfl_xor(mx, 16)); mx = fmaxf(mx, __shfl_xor(mx, 32));
        const float mn = fmaxf(m[tt], mx);
        const float alpha = __builtin_amdgcn_exp2f(m[tt] - mn);
        m[tt] = mn;
        float ls = 0.f;
#pragma unroll
        for (int kt = 0; kt < 4; ++kt)
#pragma unroll
            for (int jj = 0; jj < 4; ++jj) {
                const float sv = s[kt][tt][jj];
                const float pv = sv > -1e29f ? __builtin_amdgcn_exp2f(sv - mn) : 0.f;
                s[kt][tt][jj] = pv; ls += pv;
            }
        l[tt] = l[tt] * alpha + ls;
        if (WITH_O) {
#pragma unroll
            for (int dt = 0; dt < 4; ++dt) o[dt][tt] *= alpha;
        }
    }
}
template <bool WITH_O = true, int TT = 2>
__device__ __forceinline__ void nsa_softmax_fast(f32x4 (&s)[4][TT], float (&m)[TT], float (&l)[TT], f32x4 (&o)[4][TT], const float (&bias)[TT]) {
#pragma unroll
    for (int tt = 0; tt < TT; ++tt) {
        float mr = fmaxf(fmaxf(s[0][tt][0], s[0][tt][1]), fmaxf(s[0][tt][2], s[0][tt][3]));
#pragma unroll
        for (int kt = 1; kt < 4; ++kt) mr = fmaxf(mr, fmaxf(fmaxf(s[kt][tt][0], s[kt][tt][1]), fmaxf(s[kt][tt][2], s[kt][tt][3])));
        mr = fmaxf(mr, __shfl_xor(mr, 16)); mr = fmaxf(mr, __shfl_xor(mr, 32));
        const float mx = mr * SM_C + bias[tt];
        const float mold = m[tt], mn = fmaxf(mold, mx);
        m[tt] = mn;
        const float off = bias[tt] - mn;
        float ls = 0.f;
#pragma unroll
        for (int kt = 0; kt < 4; ++kt)
#pragma unroll
            for (int jj = 0; jj < 4; ++jj) { const float pv = __builtin_amdgcn_exp2f(__builtin_fmaf(s[kt][tt][jj], SM_C, off)); s[kt][tt][jj] = pv; ls += pv; }
        if (__builtin_amdgcn_ballot_w64(mn > mold) != 0ull) {
            const float alpha = __builtin_amdgcn_exp2f(mold - mn);
            l[tt] = l[tt] * alpha + ls;
            if (WITH_O) {
#pragma unroll
                for (int dt = 0; dt < 4; ++dt) o[dt][tt] *= alpha;
            }
        } else l[tt] += ls;
    }
}
__device__ __forceinline__ void ins16(unsigned (&L)[16], unsigned x) {
#pragma unroll
    for (int i = 0; i < 16; ++i) { const unsigned hi = L[i] > x ? L[i] : x; x = L[i] > x ? x : L[i]; L[i] = hi; }
}
__device__ __forceinline__ void merge16(unsigned (&L)[16], const unsigned (&P)[16]) {
#pragma unroll
    for (int i = 0; i < 16; ++i) L[i] = L[i] > P[15 - i] ? L[i] : P[15 - i];
#pragma unroll
    for (int st = 8; st >= 1; st >>= 1)
#pragma unroll
        for (int i = 0; i < 16; ++i)
            if ((i & st) == 0) { const unsigned a = L[i], b = L[i + st]; L[i] = a > b ? a : b; L[i + st] = a > b ? b : a; }
}
__device__ __forceinline__ void sort16(unsigned (&v)[16]) {
#pragma unroll
    for (int k = 2; k <= 16; k <<= 1)
#pragma unroll
        for (int j = k >> 1; j > 0; j >>= 1)
#pragma unroll
            for (int i = 0; i < 16; ++i) {
                const int l = i ^ j;
                if (l > i) {
                    const unsigned a = v[i], b = v[l];
                    const unsigned hi = a > b ? a : b, lo = a > b ? b : a;
                    if ((i & k) == 0) { v[i] = hi; v[l] = lo; } else { v[i] = lo; v[l] = hi; }
                }
            }
}
template <int TT>
__device__ __forceinline__ void nsa_scale(const f32x4 (&o)[4][TT], const float (&l)[TT], bool l_is_partial, const float* gsrc, int tib, f32x4 (&r)[4][TT], bool accum) {
#pragma unroll
    for (int tt = 0; tt < TT; ++tt) {
        float lt = l[tt];
        if (l_is_partial) { lt += __shfl_xor(lt, 16); lt += __shfl_xor(lt, 32); }
        const float gv = gsrc[(size_t)(tib + tt * 16) * 32];
        const float sc = l_is_partial ? (lt > 0.f ? gv / lt : 0.f) : gv;
#pragma unroll
        for (int dt = 0; dt < 4; ++dt) r[dt][tt] = accum ? r[dt][tt] + o[dt][tt] * sc : o[dt][tt] * sc;
    }
}
template <bool ACCUM, int TT>
__device__ __forceinline__ void nsa_store(const f32x4 (&r)[4][TT], bf16_t* obase, int tib, int fq) {
#pragma unroll
    for (int tt = 0; tt < TT; ++tt)
#pragma unroll
        for (int dt = 0; dt < 4; ++dt) {
            bf16_t* op = obase + (size_t)(tib + tt * 16) * 512 + dt * 16 + 4 * fq;
            f32x4 v = r[dt][tt];
            if (ACCUM) { const u32x2 t = *(const u32x2*)op; v += (f32x4){bflo(t.x), bfhi(t.x), bflo(t.y), bfhi(t.y)}; }
            u32x2 w; w.x = pack2(v.x, v.y); w.y = pack2(v.z, v.w);
            *(u32x2*)op = w;
        }
}
struct NsaBufs { bf16_t *Ks0, *Vt0, *Ks1, *Vt1; };
template <class SRC, class BODY>
__device__ __forceinline__ void nsa_pipeline(int n, const bf16_t* kb, const bf16_t* vb, const NsaBufs& B, int tid, SRC src, BODY body) {
    KVStage s0, s1;
    nsa_stage_load(s0, kb + (size_t)src(0) * 4096, vb + (size_t)src(0) * 4096, tid);
    s1 = s0;
    if (n > 1) nsa_stage_load(s1, kb + (size_t)src(1) * 4096, vb + (size_t)src(1) * 4096, tid);
    __syncthreads();
    nsa_stage_store(B.Ks0, B.Vt0, tid, s0);
    if (n > 2) nsa_stage_load(s0, kb + (size_t)src(2) * 4096, vb + (size_t)src(2) * 4096, tid);
#pragma unroll 1
    for (int i = 0; i < n; i += 2) {
        __syncthreads();
        if (i + 1 < n) nsa_stage_store(B.Ks1, B.Vt1, tid, s1);
        if (i + 3 < n) nsa_stage_load(s1, kb + (size_t)src(i + 3) * 4096, vb + (size_t)src(i + 3) * 4096, tid);
        body(src(i), B.Ks0, B.Vt0);
        if (i + 1 < n) {
            __syncthreads();
            if (i + 2 < n) nsa_stage_store(B.Ks0, B.Vt0, tid, s0);
            if (i + 4 < n) nsa_stage_load(s0, kb + (size_t)src(i + 4) * 4096, vb + (size_t)src(i + 4) * 4096, tid);
            body(src(i + 1), B.Ks1, B.Vt1);
        }
    }
}

__device__ __forceinline__ void d_nsa_cmp(const bf16_t* __restrict__ proj, const bf16_t* __restrict__ kc, const bf16_t* __restrict__ vc,
                                          const float* __restrict__ small, bf16_t* __restrict__ onsa, unsigned* __restrict__ selrec, int b, int g, int qt, char* lds) {
    const NsaBufs B{(bf16_t*)(lds + NSA_OFF_KS0), (bf16_t*)(lds + NSA_OFF_VT0), (bf16_t*)(lds + NSA_OFF_KS1), (bf16_t*)(lds + NSA_OFF_VT1)};
    float* imp = (float*)(lds + NSA_OFF_IMP);
    unsigned* selw = (unsigned*)(lds + NSA_OFF_SELW);
    unsigned* anyw = (unsigned*)(lds + NSA_OFF_ANYW);
    int* blist = (int*)(lds + NSA_OFF_BL);
    const int tid = tid_opaque(), lane = tid & 63, w = tid >> 6, hd = w & 3, th = w >> 2, fr = lane & 15, fq = lane >> 4;
    const int tib = th * 32 + fr;
    const size_t tok0 = (size_t)b * SEQ + (size_t)qt * 64;
    const int t0 = qt * 64;
    const float* gbase = small + tok0 * 32 + g * 12 + hd * 3;
    bf16_t* obase = onsa + tok0 * 512 + g * 256 + hd * 64;
    const bool sel_all[2] = {true, true};
    const float bias0[2] = {0.f, 0.f};

    for (int i = tid; i < 64 * 132; i += 512) imp[i] = 0.f;
    if (tid < 4) anyw[tid] = 0u;

    bf16_t* Qs = (bf16_t*)(lds + NSA_OFF_QS) + w * 32 * KLD;
    f32x4 s[4][2], o[4][2];
    float m[2], l[2];

    nsa_load_q<32>(proj + (tok0 + th * 32) * PROJ_LD + C_Q + g * 256 + hd * 64, PROJ_LD, lane, Qs);
    const int ncb = (4 * qt + 3 + 63) >> 6;
    {
        const bf16_t* kb = kc + (size_t)(b * 2 + g) * 512 * 64;
        const bf16_t* vb = vc + (size_t)(b * 2 + g) * 512 * 64;
#pragma unroll
        for (int tt = 0; tt < 2; ++tt) { m[tt] = -1e30f; l[tt] = 0.f; }
        nsa_pipeline(ncb, kb, vb, B, tid, [&](int i) { return i; }, [&](int blk_, bf16_t* Ks, bf16_t* Vt) {
            nsa_qk(Ks, Qs, s, fr, fq);
            if (16 * (blk_ * 64 + 63) + 31 <= t0) nsa_softmax_fast<false, 2>(s, m, l, o, bias0);
            else nsa_softmax<3, false, 2>(s, m, l, o, sel_all, tib, fq, blk_ * 64, t0);
        });
        float linv[2];
#pragma unroll
        for (int tt = 0; tt < 2; ++tt) { float lt = l[tt]; lt += __shfl_xor(lt, 16); lt += __shfl_xor(lt, 32); linv[tt] = lt > 0.f ? 1.0f / lt : 0.f; }
#pragma unroll
        for (int dt = 0; dt < 4; ++dt)
#pragma unroll
            for (int tt = 0; tt < 2; ++tt) o[dt][tt] = (f32x4){0.f, 0.f, 0.f, 0.f};
        nsa_pipeline(ncb, kb, vb, B, tid, [&](int i) { return i; }, [&](int blk_, bf16_t* Ks, bf16_t* Vt) {
            nsa_qk(Ks, Qs, s, fr, fq);
            const bool full = 16 * (blk_ * 64 + 63) + 31 <= t0;
#pragma unroll
            for (int tt = 0; tt < 2; ++tt) {
                const int ti = tib + tt * 16;
                const float nm = -m[tt], li = linv[tt];
                float hs[4], as[4];
#pragma unroll
                for (int kt = 0; kt < 4; ++kt) {
                    f32x4 pv;
                    if (full) {
#pragma unroll
                        for (int jj = 0; jj < 4; ++jj) pv[jj] = __builtin_amdgcn_exp2f(__builtin_fmaf(s[kt][tt][jj], SM_C, nm)) * li;
                    } else {
#pragma unroll
                        for (int jj = 0; jj < 4; ++jj) {
                            const int kk = kt * 16 + 4 * fq + jj;
                            pv[jj] = nsa_valid<3>(kk, ti, blk_ * 64, t0) ? __builtin_amdgcn_exp2f(__builtin_fmaf(s[kt][tt][jj], SM_C, nm)) * li : 0.f;
                        }
                    }
                    s[kt][tt] = pv;
                    hs[kt] = 0.5f * pv[3]; as[kt] = pv[0] + pv[1] + pv[2] + hs[kt];
                }
                float r1[4];
#pragma unroll
                for (int kt = 0; kt < 4; ++kt) r1[kt] = __shfl(hs[kt], (lane + 48) & 63);
#pragma unroll
                for (int kt = 0; kt < 4; ++kt) {
                    const float recv = fq > 0 ? r1[kt] : (kt > 0 ? r1[kt - 1] : 0.f);
                    const int j = blk_ * 16 + kt * 4 + fq;
                    atomicAdd(imp + ti * 132 + (j >> 5) * 33 + (j & 31), as[kt] + recv);
                }
                if (fq == 3) { const int j1 = blk_ * 16 + 16; if (j1 < 128) atomicAdd(imp + ti * 132 + (j1 >> 5) * 33 + (j1 & 31), hs[3]); }
            }
            nsa_pv(Vt, s, o, fr, fq);
        });
        nsa_scale(o, l, false, gbase + 0, tib, o, false);
        nsa_store<false, 2>(o, obase, tib, fq);
    }
    __syncthreads();
    {
        const int ti = tid >> 3, q8 = tid & 7;
        unsigned L[16];
#pragma unroll
        for (int i = 0; i < 16; ++i) {
            const int j = q8 * 16 + i;
            const bool forced = (j == 0) || (j == qt) || (j == qt - 1);
            const float v = imp[ti * 132 + (j >> 5) * 33 + (j & 31)] + (forced ? 1e4f : 0.f) + 1e-30f;
            L[i] = (j <= qt) ? ((__float_as_uint(v) & ~0x7Fu) | (unsigned)(127 - j)) : 0u;
        }
        sort16(L);
#pragma unroll
        for (int r = 1; r <= 4; r <<= 1) {
            unsigned P[16];
#pragma unroll
            for (int i = 0; i < 16; ++i) P[i] = (unsigned)__shfl_xor((int)L[i], r);
            merge16(L, P);
        }
        if (q8 < 4) {
            unsigned word = 0u;
#pragma unroll
            for (int i = 0; i < 16; ++i) {
                const unsigned e = L[i];
                const int j = 127 - (int)(e & 0x7Fu);
                if (e != 0u && (j >> 5) == q8) word |= 1u << (j & 31);
            }
            selw[ti * 4 + q8] = word;
            atomicOr(&anyw[q8], word);
        }
    }
    __syncthreads();
    int nsel;
    {
        const unsigned a0 = anyw[0], a1 = anyw[1], a2 = anyw[2], a3 = anyw[3];
        if (tid < 128) {
            const unsigned wd = tid < 32 ? a0 : tid < 64 ? a1 : tid < 96 ? a2 : a3;
            if ((wd >> (tid & 31)) & 1u) {
                int pos = __popc(wd & ((1u << (tid & 31)) - 1u));
                if (tid >= 32) pos += __popc(a0);
                if (tid >= 64) pos += __popc(a1);
                if (tid >= 96) pos += __popc(a2);
                blist[pos] = tid;
            }
        }
        nsel = __builtin_amdgcn_readfirstlane(__popc(a0) + __popc(a1) + __popc(a2) + __popc(a3));
    }
    __syncthreads();
    if (tid < 256) selrec[tid] = selw[tid];
    if (tid < 128) selrec[256 + tid] = (unsigned)blist[tid];
    if (tid == 0) selrec[384] = (unsigned)nsel;
    __syncthreads();
}

__device__ __forceinline__ void d_nsa_attn(const bf16_t* __restrict__ qrope, const bf16_t* __restrict__ kvp, const float* __restrict__ small, bf16_t* __restrict__ onsa,
                                           const unsigned* __restrict__ selrec, int b, int g, int qt, char* lds) {
    const NsaBufs B{(bf16_t*)(lds + NSA_OFF_KS0), (bf16_t*)(lds + NSA_OFF_VT0), (bf16_t*)(lds + NSA_OFF_KS1), (bf16_t*)(lds + NSA_OFF_VT1)};
    unsigned* selw = (unsigned*)(lds + NSA_OFF_SELW);
    int* blist = (int*)(lds + NSA_OFF_BL);
    const int tid = tid_opaque(), lane = tid & 63, w = tid >> 6, hd = w & 3, th = w >> 2, fr = lane & 15, fq = lane >> 4;
    const int tib = th * 32 + fr;
    const size_t tok0 = (size_t)b * SEQ + (size_t)qt * 64;
    const float* gbase = small + tok0 * 32 + g * 12 + hd * 3;
    bf16_t* obase = onsa + tok0 * 512 + g * 256 + hd * 64;
    const bool sel_all[2] = {true, true};
    const float bias0[2] = {0.f, 0.f};
    bf16_t* Qs = (bf16_t*)(lds + NSA_OFF_QS) + w * 32 * KLD;
    f32x4 s[4][2], o[4][2], tot[4][2];
    float m[2], l[2];
    if (tid < 256) selw[tid] = selrec[tid];
    if (tid < 128) blist[tid] = (int)selrec[256 + tid];
    const int nsel = __builtin_amdgcn_readfirstlane((int)selrec[384]);
    __syncthreads();
    nsa_load_q<32>(qrope + (tok0 + th * 32) * 512 + g * 256 + hd * 64, 512, lane, Qs);
    {
        const bf16_t* kb = kvp + 2 * KVP_SEG + (size_t)(b * 2 + g) * SEQ * 64;
        const bf16_t* vb = kvp + 3 * KVP_SEG + (size_t)(b * 2 + g) * SEQ * 64;
#pragma unroll
        for (int tt = 0; tt < 2; ++tt) { m[tt] = -1e30f; l[tt] = 0.f; }
#pragma unroll
        for (int dt = 0; dt < 4; ++dt)
#pragma unroll
            for (int tt = 0; tt < 2; ++tt) o[dt][tt] = (f32x4){0.f, 0.f, 0.f, 0.f};
        nsa_pipeline(nsel, kb, vb, B, tid, [&](int i) { return __builtin_amdgcn_readfirstlane(blist[i]); }, [&](int blk_, bf16_t* Ks, bf16_t* Vt) {
            nsa_qk(Ks, Qs, s, fr, fq);
            bool selb[2];
#pragma unroll
            for (int tt = 0; tt < 2; ++tt) selb[tt] = (selw[(tib + tt * 16) * 4 + (blk_ >> 5)] >> (blk_ & 31)) & 1u;
            if (blk_ == qt) nsa_softmax<1, true, 2>(s, m, l, o, selb, tib, fq, 0, 0);
            else {
                float bias[2];
#pragma unroll
                for (int tt = 0; tt < 2; ++tt) bias[tt] = selb[tt] ? 0.f : -1e30f;
                nsa_softmax_fast(s, m, l, o, bias);
            }
            nsa_pv(Vt, s, o, fr, fq);
        });
        nsa_scale(o, l, true, gbase + 1, tib, tot, false);
    }
    {
        const bf16_t* kb = kvp + 4 * KVP_SEG + (size_t)(b * 2 + g) * SEQ * 64;
        const bf16_t* vb = kvp + 5 * KVP_SEG + (size_t)(b * 2 + g) * SEQ * 64;
#pragma unroll
        for (int tt = 0; tt < 2; ++tt) { m[tt] = -1e30f; l[tt] = 0.f; }
#pragma unroll
        for (int dt = 0; dt < 4; ++dt)
#pragma unroll
            for (int tt = 0; tt < 2; ++tt) o[dt][tt] = (f32x4){0.f, 0.f, 0.f, 0.f};
        const int j0 = qt >= 8 ? qt - 8 : 0;
        nsa_pipeline(qt - j0 + 1, kb, vb, B, tid, [&](int i) { return j0 + i; }, [&](int blk_, bf16_t* Ks, bf16_t* Vt) {
            nsa_qk(Ks, Qs, s, fr, fq);
            if (blk_ == qt) nsa_softmax<1, true, 2>(s, m, l, o, sel_all, tib, fq, 0, 0);
            else if (blk_ == qt - 8) nsa_softmax<2, true, 2>(s, m, l, o, sel_all, tib, fq, 0, 0);
            else nsa_softmax_fast(s, m, l, o, bias0);
            nsa_pv(Vt, s, o, fr, fq);
        });
        nsa_scale(o, l, true, gbase + 2, tib, tot, true);
        nsa_store<true, 2>(tot, obase, tib, fq);
    }
    __syncthreads();
}

template <bool TAIL, int TT>
__device__ __forceinline__ void nsa_mask_block(f32x4 (&s)[4][TT], int fr, int fq) {
    bool keep[4];
#pragma unroll
    for (int jj = 0; jj < 4; ++jj) keep[jj] = TAIL ? (4 * fq + jj > fr) : (4 * fq + jj <= fr);
#pragma unroll
    for (int tt = 0; tt < TT; ++tt)
#pragma unroll
        for (int kt = 0; kt < 4; ++kt) {
            const bool all_keep = TAIL ? (kt > tt) : (kt < tt), none_keep = TAIL ? (kt < tt) : (kt > tt);
            if (all_keep) continue;
#pragma unroll
            for (int jj = 0; jj < 4; ++jj) if (none_keep || !keep[jj]) s[kt][tt][jj] = -3e38f;
        }
}
#define NB2_OFF_SELW 40960
#define NB2_OFF_ANYW 43008
#define NB2_OFF_BL   43040
#define NB2_OFF_QS   43776
__device__ __forceinline__ void d_nsa_attn128(const bf16_t* __restrict__ qrope, const bf16_t* __restrict__ kvp, const float* __restrict__ small, bf16_t* __restrict__ onsa,
                                              const unsigned* __restrict__ selrec_bg, int b, int g, int qt2, char* lds) {
    const NsaBufs B{(bf16_t*)(lds + 0), (bf16_t*)(lds + 20480), (bf16_t*)(lds + 10240), (bf16_t*)(lds + 30720)};
    unsigned* selw = (unsigned*)(lds + NB2_OFF_SELW);
    unsigned* anyw = (unsigned*)(lds + NB2_OFF_ANYW);
    int* blist = (int*)(lds + NB2_OFF_BL);
    const int tid = tid_opaque(), lane = tid & 63, w = tid >> 6, hd = w & 3, th = w >> 2, fr = lane & 15, fq = lane >> 4;
    const int bt = 2 * qt2 + th;
    const size_t tokw = (size_t)b * SEQ + (size_t)bt * 64;
    const float* gbase = small + tokw * 32 + g * 12 + hd * 3;
    bf16_t* obase = onsa + tokw * 512 + g * 256 + hd * 64;
    const float bias0[4] = {0.f, 0.f, 0.f, 0.f};
    bf16_t* Qs = (bf16_t*)(lds + NB2_OFF_QS) + w * 64 * KLD;
    f32x4 s[4][4], o[4][4];
    float m[4], l[4];
    selw[tid] = selrec_bg[(size_t)(2 * qt2 + (tid >> 8)) * 512 + (tid & 255)];
    if (tid < 4) anyw[tid] = 0u;
    __syncthreads();
    atomicOr(&anyw[tid & 3], selw[tid]);
    __syncthreads();
    int nsel;
    {
        const unsigned a0 = anyw[0], a1 = anyw[1], a2 = anyw[2], a3 = anyw[3];
        if (tid < 128) {
            const unsigned wd = tid < 32 ? a0 : tid < 64 ? a1 : tid < 96 ? a2 : a3;
            if ((wd >> (tid & 31)) & 1u) {
                int pos = __popc(wd & ((1u << (tid & 31)) - 1u));
                if (tid >= 32) pos += __popc(a0);
                if (tid >= 64) pos += __popc(a1);
                if (tid >= 96) pos += __popc(a2);
                blist[pos] = tid;
            }
        }
        nsel = __builtin_amdgcn_readfirstlane(__popc(a0) + __popc(a1) + __popc(a2) + __popc(a3));
    }
    __syncthreads();
    nsa_load_q<64>(qrope + tokw * 512 + g * 256 + hd * 64, 512, lane, Qs);
    {
        const bf16_t* kb = kvp + 2 * KVP_SEG + (size_t)(b * 2 + g) * SEQ * 64;
        const bf16_t* vb = kvp + 3 * KVP_SEG + (size_t)(b * 2 + g) * SEQ * 64;
#pragma unroll
        for (int tt = 0; tt < 4; ++tt) { m[tt] = -1e30f; l[tt] = 0.f; }
#pragma unroll
        for (int dt = 0; dt < 4; ++dt)
#pragma unroll
            for (int tt = 0; tt < 4; ++tt) o[dt][tt] = (f32x4){0.f, 0.f, 0.f, 0.f};
        nsa_pipeline(nsel, kb, vb, B, tid, [&](int i) { return __builtin_amdgcn_readfirstlane(blist[i]); }, [&](int blk_, bf16_t* Ks, bf16_t* Vt) {
            if (blk_ > bt) return;
            nsa_qk(Ks, Qs, s, fr, fq);
            bool selb[4];
#pragma unroll
            for (int tt = 0; tt < 4; ++tt) selb[tt] = (selw[(th * 64 + tt * 16 + fr) * 4 + (blk_ >> 5)] >> (blk_ & 31)) & 1u;
            float bias[4];
#pragma unroll
            for (int tt = 0; tt < 4; ++tt) bias[tt] = selb[tt] ? 0.f : -1e30f;
            if (blk_ == bt) nsa_mask_block<false, 4>(s, fr, fq);
            nsa_softmax_fast<true, 4>(s, m, l, o, bias);
            nsa_pv(Vt, s, o, fr, fq);
        });
        nsa_scale(o, l, true, gbase + 1, fr, o, false);
        nsa_store<true, 4>(o, obase, fr, fq);
    }
    {
        const bf16_t* kb = kvp + 4 * KVP_SEG + (size_t)(b * 2 + g) * SEQ * 64;
        const bf16_t* vb = kvp + 5 * KVP_SEG + (size_t)(b * 2 + g) * SEQ * 64;
#pragma unroll
        for (int tt = 0; tt < 4; ++tt) { m[tt] = -1e30f; l[tt] = 0.f; }
#pragma unroll
        for (int dt = 0; dt < 4; ++dt)
#pragma unroll
            for (int tt = 0; tt < 4; ++tt) o[dt][tt] = (f32x4){0.f, 0.f, 0.f, 0.f};
        const int j0 = 2 * qt2 >= 8 ? 2 * qt2 - 8 : 0;
        nsa_pipeline(2 * qt2 + 2 - j0, kb, vb, B, tid, [&](int i) { return j0 + i; }, [&](int blk_, bf16_t* Ks, bf16_t* Vt) {
            if (blk_ > bt || blk_ < bt - 8) return;
            nsa_qk(Ks, Qs, s, fr, fq);
            if (blk_ == bt) nsa_mask_block<false, 4>(s, fr, fq);
            else if (blk_ == bt - 8) nsa_mask_block<true, 4>(s, fr, fq);
            nsa_softmax_fast<true, 4>(s, m, l, o, bias0);
            nsa_pv(Vt, s, o, fr, fq);
        });
        nsa_scale(o, l, true, gbase + 2, fr, o, false);
        nsa_store<true, 4>(o, obase, fr, fq);
    }
    __syncthreads();
}

#define SSD_P 136
#define S3_XST 0
#define S3_BC  69632
#define S3_CC  104448
#define S3_ACS 139264
#define S3_DT  141312
#define S3_END 143360

__device__ __forceinline__ void ssd_acs(const float* __restrict__ small, const float* __restrict__ a_log, size_t tok0, int g, float* acs, float* dtl, int tid) {
    const int w = tid >> 6, lane = tid & 63, hh = 4 * g + (w & 3);
    if (w < 4) {
        const float a = -__expf(a_log[hh]);
        const float d0 = small[(tok0 + 2 * lane) * 32 + 24 + hh], d1 = small[(tok0 + 2 * lane + 1) * 32 + 24 + hh];
        const float s0 = d0 * a, s1 = s0 + d1 * a;
        float tot = s1;
#pragma unroll
        for (int off = 1; off < 64; off <<= 1) { const float t = __shfl_up(tot, off); if (lane >= off) tot += t; }
        const float excl = tot - s1;
        acs[w * 128 + 2 * lane] = excl + s0; acs[w * 128 + 2 * lane + 1] = excl + s1;
        dtl[w * 128 + 2 * lane] = d0; dtl[w * 128 + 2 * lane + 1] = d1;
    }
}
struct ConvCh { float w0, w1, w2, w3, bias, h0, h1, h2; };
__device__ __forceinline__ void conv_init(ConvCh& cc, const float* __restrict__ conv_w, const float* __restrict__ conv_b, int ch, const bf16_t* pb, int c) {
    cc.w0 = conv_w[ch]; cc.w1 = conv_w[1024 + ch]; cc.w2 = conv_w[2048 + ch]; cc.w3 = conv_w[3072 + ch]; cc.bias = conv_b[ch];
    if (c > 0) { cc.h0 = bf2f(pb[-3 * PROJ_LD]); cc.h1 = bf2f(pb[-2 * PROJ_LD]); cc.h2 = bf2f(pb[-1 * PROJ_LD]); } else { cc.h0 = 0.f; cc.h1 = 0.f; cc.h2 = 0.f; }
}
__device__ __forceinline__ float conv_step(ConvCh& cc, float x) {
    const float v = cc.bias + cc.w0 * cc.h0 + cc.w1 * cc.h1 + cc.w2 * cc.h2 + cc.w3 * x;
    cc.h0 = cc.h1; cc.h1 = cc.h2; cc.h2 = x;
    return silu(v);
}

__device__ __forceinline__ void d_ssd_states(const bf16_t* __restrict__ proj, const float* __restrict__ small, const float* __restrict__ conv_w, const float* __restrict__ conv_b,
                                             const float* __restrict__ a_log, float* __restrict__ states, float* __restrict__ cdec, int item, char* lds) {
    const int tid = tid_opaque(), lane = tid & 63, w = tid >> 6, fr = lane & 15, fq = lane >> 4;
    const int b = item >> 7, c = (item >> 1) & 63, g = item & 1;
    bf16_t* XwT = (bf16_t*)(lds + S3_XST); bf16_t* BcT = (bf16_t*)(lds + S3_BC);
    float* acs = (float*)(lds + S3_ACS); float* dtl = (float*)(lds + S3_DT);
    const size_t tok0 = (size_t)b * SEQ + (size_t)c * 128;
    ssd_acs(small, a_log, tok0, g, acs, dtl, tid);
    __syncthreads();
    if (tid < 384) {
        const bool isx = tid < 256;
        const int ch = isx ? g * 256 + tid : 512 + g * 128 + (tid - 256);
        const bf16_t* px = proj + tok0 * PROJ_LD + C_XBC + ch;
        ConvCh cx; conv_init(cx, conv_w, conv_b, ch, px, c);
        const int hw = w & 3;
        const float alast = acs[hw * 128 + 127];
        bf16_t* dst = isx ? XwT + tid * SSD_P : BcT + (tid - 256) * SSD_P;
        for (int l0 = 0; l0 < 128; l0 += 32) {
            float rx[32];
#pragma unroll
            for (int i = 0; i < 32; ++i) rx[i] = bf2f(px[(size_t)(l0 + i) * PROJ_LD]);
#pragma unroll
            for (int i8 = 0; i8 < 4; ++i8) {
                float ox[8];
#pragma unroll
                for (int i = 0; i < 8; ++i) {
                    const int l = l0 + i8 * 8 + i;
                    const float v = conv_step(cx, rx[i8 * 8 + i]);
                    ox[i] = isx ? v * dtl[hw * 128 + l] * __expf(alast - acs[hw * 128 + l]) : v;
                }
                u32x4 o; o.x = pack2(ox[0], ox[1]); o.y = pack2(ox[2], ox[3]); o.z = pack2(ox[4], ox[5]); o.w = pack2(ox[6], ox[7]);
                *(u32x4*)(dst + l0 + i8 * 8) = o;
            }
        }
    }
    __syncthreads();
    {
        const int hw = w & 3, nh = w >> 2;
        f32x4 acc[4][4];
#pragma unroll
        for (int pt = 0; pt < 4; ++pt)
#pragma unroll
            for (int nt = 0; nt < 4; ++nt) acc[pt][nt] = (f32x4){0.f, 0.f, 0.f, 0.f};
#pragma unroll 1
        for (int ks = 0; ks < 4; ++ks) {
            bf16x8 af[4], bfr[4];
#pragma unroll
            for (int pt = 0; pt < 4; ++pt) af[pt] = *(const bf16x8*)(XwT + (hw * 64 + pt * 16 + fr) * SSD_P + ks * 32 + fq * 8);
#pragma unroll
            for (int nt = 0; nt < 4; ++nt) bfr[nt] = *(const bf16x8*)(BcT + ((nh * 4 + nt) * 16 + fr) * SSD_P + ks * 32 + fq * 8);
#pragma unroll
            for (int pt = 0; pt < 4; ++pt)
#pragma unroll
                for (int nt = 0; nt < 4; ++nt) acc[pt][nt] = __builtin_amdgcn_mfma_f32_16x16x32_bf16(af[pt], bfr[nt], acc[pt][nt], 0, 0, 0);
        }
        const int hh = 4 * g + hw;
        float* sp = states + ((size_t)((b * 64 + c) * 8 + hh)) * 8192;
#pragma unroll
        for (int pt = 0; pt < 4; ++pt)
#pragma unroll
            for (int nt = 0; nt < 4; ++nt)
#pragma unroll
                for (int jj = 0; jj < 4; ++jj) sp[(pt * 16 + 4 * fq + jj) * 128 + (nh * 4 + nt) * 16 + fr] = acc[pt][nt][jj];
        if (lane == 0 && nh == 0) cdec[(b * 64 + c) * 8 + hh] = __expf(acs[hw * 128 + 127]);
    }
    __syncthreads();
}

__device__ __forceinline__ void d_ssd_scan(const float* __restrict__ states, const float* __restrict__ cdec, bf16_t* __restrict__ prev, int vb) {
    const int bh = vb >> 1, b = bh >> 3, hh = bh & 7;
    const size_t e0 = (size_t)((vb & 1) * 512 + tid_opaque()) * 8;
    f32x4 h0 = (f32x4){0.f, 0.f, 0.f, 0.f}, h1 = h0;
#pragma unroll 8
    for (int c = 0; c < 64; ++c) {
        const size_t base = ((size_t)((b * 64 + c) * 8 + hh)) * 8192 + e0;
        const f32x4 s0 = *(const f32x4*)(states + base), s1 = *(const f32x4*)(states + base + 4);
        const float d = cdec[(b * 64 + c) * 8 + hh];
        u32x4 o; o.x = pack2(h0.x, h0.y); o.y = pack2(h0.z, h0.w); o.z = pack2(h1.x, h1.y); o.w = pack2(h1.z, h1.w);
        *(u32x4*)(prev + base) = o;
        h0 = h0 * d + s0; h1 = h1 * d + s1;
    }
}

__device__ __forceinline__ void d_ssd_out(const bf16_t* __restrict__ proj, const float* __restrict__ small, const float* __restrict__ conv_w, const float* __restrict__ conv_b,
                                          const float* __restrict__ a_log, const float* __restrict__ d_skip, const bf16_t* __restrict__ prev, bf16_t* __restrict__ yssd, int item, char* lds) {
    const int tid = tid_opaque(), lane = tid & 63, w = tid >> 6, fr = lane & 15, fq = lane >> 4;
    const int b = item >> 7, c = (item >> 1) & 63, g = item & 1;
    bf16_t* XsT = (bf16_t*)(lds + S3_XST); bf16_t* Bc = (bf16_t*)(lds + S3_BC); bf16_t* Cc = (bf16_t*)(lds + S3_CC);
    float* acs = (float*)(lds + S3_ACS); float* dtl = (float*)(lds + S3_DT);
    const size_t tok0 = (size_t)b * SEQ + (size_t)c * 128;
    ssd_acs(small, a_log, tok0, g, acs, dtl, tid);
    {
        const int mode = tid < 256 ? 0 : (tid < 384 ? 1 : 2);
        const int ch = mode == 0 ? g * 256 + tid : (mode == 1 ? 512 + g * 128 + (tid - 256) : 768 + g * 128 + (tid - 384));
        const bf16_t* px = proj + tok0 * PROJ_LD + C_XBC + ch;
        ConvCh cx; conv_init(cx, conv_w, conv_b, ch, px, c);
        bf16_t* dstx = XsT + (tid & 255) * SSD_P;
        bf16_t* dstbc = (mode == 1 ? Bc : Cc) + (tid & 127);
        for (int l0 = 0; l0 < 128; l0 += 32) {
            float rx[32];
#pragma unroll
            for (int i = 0; i < 32; ++i) rx[i] = bf2f(px[(size_t)(l0 + i) * PROJ_LD]);
#pragma unroll
            for (int i8 = 0; i8 < 4; ++i8) {
                float ox[8];
#pragma unroll
                for (int i = 0; i < 8; ++i) ox[i] = conv_step(cx, rx[i8 * 8 + i]);
                if (mode == 0) {
                    u32x4 o; o.x = pack2(ox[0], ox[1]); o.y = pack2(ox[2], ox[3]); o.z = pack2(ox[4], ox[5]); o.w = pack2(ox[6], ox[7]);
                    *(u32x4*)(dstx + l0 + i8 * 8) = o;
                } else {
#pragma unroll
                    for (int i = 0; i < 8; ++i) dstbc[(l0 + i8 * 8 + i) * SSD_P] = f2bf(ox[i]);
                }
            }
        }
    }
    __syncthreads();
    const int hw = w & 3, lh = w >> 2, hh = 4 * g + hw;
    const float dsk = d_skip[hh];
    const bf16_t* pp = prev + ((size_t)((b * 64 + c) * 8 + hh)) * 8192;
#pragma unroll 1
    for (int lk = 0; lk < 4; ++lk) {
        const int lt = lh + 2 * lk;
        const int l = lt * 16 + fr;
        const float acs_l = acs[hw * 128 + l];
        bf16x8 cf[4];
#pragma unroll
        for (int ks = 0; ks < 4; ++ks) cf[ks] = *(const bf16x8*)(Cc + (lt * 16 + fr) * SSD_P + ks * 32 + fq * 8);
        f32x4 y[4], yo[4];
#pragma unroll
        for (int pt = 0; pt < 4; ++pt) { y[pt] = (f32x4){0.f, 0.f, 0.f, 0.f}; yo[pt] = (f32x4){0.f, 0.f, 0.f, 0.f}; }
#pragma unroll
        for (int ks2 = 0; ks2 < 4; ++ks2) {
            if (2 * ks2 <= lt) {
                f32x4 cb[2];
#pragma unroll
                for (int h2 = 0; h2 < 2; ++h2) {
                    const int st = 2 * ks2 + h2;
                    cb[h2] = (f32x4){0.f, 0.f, 0.f, 0.f};
                    if (st <= lt) {
#pragma unroll
                        for (int ks = 0; ks < 4; ++ks)
                            cb[h2] = __builtin_amdgcn_mfma_f32_16x16x32_bf16(*(const bf16x8*)(Bc + (st * 16 + fr) * SSD_P + ks * 32 + fq * 8), cf[ks], cb[h2], 0, 0, 0);
#pragma unroll
                        for (int jj = 0; jj < 4; ++jj) {
                            const int sidx = st * 16 + 4 * fq + jj;
                            cb[h2][jj] = (sidx <= l) ? cb[h2][jj] * __expf(acs_l - acs[hw * 128 + sidx]) * dtl[hw * 128 + sidx] : 0.f;
                        }
                    }
                }
                u32x4 wv; wv.x = pack2(cb[0].x, cb[0].y); wv.y = pack2(cb[0].z, cb[0].w); wv.z = pack2(cb[1].x, cb[1].y); wv.w = pack2(cb[1].z, cb[1].w);
                const bf16x8 mf = __builtin_bit_cast(bf16x8, wv);
#pragma unroll
                for (int pt = 0; pt < 4; ++pt) {
                    const bf16_t* xp = XsT + (hw * 64 + pt * 16 + fr) * SSD_P + ks2 * 32 + 4 * fq;
                    const u32x2 a0 = *(const u32x2*)xp, a1 = *(const u32x2*)(xp + 16);
                    u32x4 xv; xv.x = a0.x; xv.y = a0.y; xv.z = a1.x; xv.w = a1.y;
                    y[pt] = __builtin_amdgcn_mfma_f32_16x16x32_bf16(__builtin_bit_cast(bf16x8, xv), mf, y[pt], 0, 0, 0);
                }
            }
            __builtin_amdgcn_sched_barrier(0);
        }
        __builtin_amdgcn_sched_barrier(0);
#pragma unroll
        for (int pt = 0; pt < 4; ++pt)
#pragma unroll
            for (int ks = 0; ks < 4; ++ks) yo[pt] = __builtin_amdgcn_mfma_f32_16x16x32_bf16(*(const bf16x8*)(pp + (pt * 16 + fr) * 128 + ks * 32 + fq * 8), cf[ks], yo[pt], 0, 0, 0);
        __builtin_amdgcn_sched_barrier(0);
        const float el = __expf(acs_l);
#pragma unroll
        for (int pt = 0; pt < 4; ++pt) {
            const int p0 = pt * 16 + 4 * fq;
            const u32x2 zz = *(const u32x2*)(proj + (tok0 + l) * PROJ_LD + C_Z + hh * 64 + p0);
            const float z0 = bflo(zz.x), z1 = bfhi(zz.x), z2 = bflo(zz.y), z3 = bfhi(zz.y);
            const bf16_t* xq = XsT + (hw * 64 + p0) * SSD_P + l;
            const float x0 = bf2f(xq[0]), x1 = bf2f(xq[SSD_P]), x2 = bf2f(xq[2 * SSD_P]), x3 = bf2f(xq[3 * SSD_P]);
            u32x2 ob;
            ob.x = pack2((y[pt].x + el * yo[pt].x + dsk * x0) * silu(z0), (y[pt].y + el * yo[pt].y + dsk * x1) * silu(z1));
            ob.y = pack2((y[pt].z + el * yo[pt].z + dsk * x2) * silu(z2), (y[pt].w + el * yo[pt].w + dsk * x3) * silu(z3));
            *(u32x2*)(yssd + (tok0 + l) * 512 + hh * 64 + p0) = ob;
        }
    }
    __syncthreads();
}

__device__ __forceinline__ void d_mix_prep(const bf16_t* __restrict__ onsa, const bf16_t* __restrict__ yssd, const float* __restrict__ nsa_w, const float* __restrict__ ssd_w, bf16_t* __restrict__ A2, int vb) {
    const int tid_ = tid_opaque(); const int lane = tid_ & 63, wid = tid_ >> 6;
    const size_t row0 = (size_t)vb * 32 + wid * 4;
    f32x4 a[4][2], y[4][2];
#pragma unroll
    for (int r = 0; r < 4; ++r)
#pragma unroll
        for (int k = 0; k < 2; ++k) {
            const u32x2 aa = *(const u32x2*)(onsa + (row0 + r) * 512 + k * 256 + lane * 4);
            a[r][k] = (f32x4){bflo(aa.x), bfhi(aa.x), bflo(aa.y), bfhi(aa.y)};
            const u32x2 yy = *(const u32x2*)(yssd + (row0 + r) * 512 + k * 256 + lane * 4);
            y[r][k] = (f32x4){bflo(yy.x), bfhi(yy.x), bflo(yy.y), bfhi(yy.y)};
        }
    float ra[4], ry[4];
#pragma unroll
    for (int r = 0; r < 4; ++r) {
        float s0 = 0.f, s1 = 0.f;
#pragma unroll
        for (int k = 0; k < 2; ++k) {
            s0 += a[r][k].x * a[r][k].x + a[r][k].y * a[r][k].y + a[r][k].z * a[r][k].z + a[r][k].w * a[r][k].w;
            s1 += y[r][k].x * y[r][k].x + y[r][k].y * y[r][k].y + y[r][k].z * y[r][k].z + y[r][k].w * y[r][k].w;
        }
        ra[r] = rsqrtf(wave_sum(s0) * (1.0f / 512) + EPS); ry[r] = rsqrtf(wave_sum(s1) * (1.0f / 512) + EPS);
    }
#pragma unroll
    for (int k = 0; k < 2; ++k) {
        const int col = k * 256 + lane * 4;
        const f32x4 wn = *(const f32x4*)(nsa_w + col), wsd = *(const f32x4*)(ssd_w + col);
#pragma unroll
        for (int r = 0; r < 4; ++r) {
            const f32x4 p = a[r][k] * ra[r] * wn, q = y[r][k] * ry[r] * wsd;
            u32x2 o; o.x = pack2(p.x, p.y); o.y = pack2(p.z, p.w);
            *(u32x2*)(A2 + (row0 + r) * DM + col) = o;
            u32x2 o2; o2.x = pack2(q.x, q.y); o2.y = pack2(q.z, q.w);
            *(u32x2*)(A2 + (row0 + r) * DM + 512 + col) = o2;
        }
    }
}

__device__ __forceinline__ void d_quant_rows(const float* __restrict__ src, unsigned char* __restrict__ dst, float* __restrict__ scale, int vb) {
    const int tid_ = tid_opaque(); const int lane = tid_ & 63, row = vb * 8 + (tid_ >> 6);
    const float* rp = src + (size_t)row * DM + lane * 16;
    f32x4 v[4];
#pragma unroll
    for (int i = 0; i < 4; ++i) v[i] = *(const f32x4*)(rp + i * 4);
    float mx = 0.f;
#pragma unroll
    for (int i = 0; i < 4; ++i) mx = fmaxf(mx, fmaxf(fmaxf(fabsf(v[i].x), fabsf(v[i].y)), fmaxf(fabsf(v[i].z), fabsf(v[i].w))));
    mx = wave_max(mx);
    const float sc = mx > 0.f ? mx * (1.0f / 6.0f) : 1.0f;
    const float inv = 1.0f / sc;
    u32x2 o;
#pragma unroll
    for (int h = 0; h < 2; ++h) {
        unsigned wv = 0u;
        wv = __builtin_amdgcn_cvt_scalef32_pk_fp4_f32(wv, v[2 * h].x * inv, v[2 * h].y * inv, 1.0f, 0);
        wv = __builtin_amdgcn_cvt_scalef32_pk_fp4_f32(wv, v[2 * h].z * inv, v[2 * h].w * inv, 1.0f, 1);
        wv = __builtin_amdgcn_cvt_scalef32_pk_fp4_f32(wv, v[2 * h + 1].x * inv, v[2 * h + 1].y * inv, 1.0f, 2);
        wv = __builtin_amdgcn_cvt_scalef32_pk_fp4_f32(wv, v[2 * h + 1].z * inv, v[2 * h + 1].w * inv, 1.0f, 3);
        o[h] = wv;
    }
    *(u32x2*)(dst + (size_t)row * 512 + lane * 8) = o;
    if (lane == 0) scale[row] = sc;
}

__device__ __forceinline__ unsigned mono_u(float f) { const unsigned u = __float_as_uint(f); return (u & 0x80000000u) ? ~u : (u | 0x80000000u); }
__device__ __forceinline__ float unmono_f(unsigned m) { const unsigned u = (m & 0x80000000u) ? (m & 0x7fffffffu) : ~m; return __uint_as_float(u); }
#define RT_LI 65536
__device__ __forceinline__ void d_peer_stage_keys(const bf16_t* __restrict__ subk, int h, char* lds) {
    const int tid = tid_opaque();
    u32x4 r[8];
#pragma unroll
    for (int i = 0; i < 8; ++i) { const int p = tid + 512 * i; r[i] = *(const u32x4*)(subk + (size_t)h * 32768 + (size_t)p * 8); }
#pragma unroll
    for (int i = 0; i < 8; ++i) { const int p = tid + 512 * i, row = p >> 4, ch = p & 15; *(u32x4*)(lds + row * 256 + ((ch ^ (row & 15)) << 4)) = r[i]; }
}
__device__ __forceinline__ void d_peer_route(const bf16_t* __restrict__ qp, const float* __restrict__ qnw, int* __restrict__ eidx, float* __restrict__ gate,
                                             int tile, int h, char* lds) {
    const int tid = tid_opaque(), lane = tid & 63, w = tid >> 6, fr = lane & 15, fq = lane >> 4;
    const size_t tok = (size_t)tile * 128 + w * 16 + fr;
    bf16x8 qf[2][4];
    {
        const bf16_t* qrow = qp + tok * 2048 + h * 256;
        u32x4 raw[2][4];
        float ss = 0.f;
#pragma unroll
        for (int k = 0; k < 2; ++k)
#pragma unroll
            for (int ks = 0; ks < 4; ++ks) {
                const u32x4 r = *(const u32x4*)(qrow + k * 128 + ks * 32 + fq * 8);
                raw[k][ks] = r;
                ss += bflo(r.x) * bflo(r.x) + bfhi(r.x) * bfhi(r.x) + bflo(r.y) * bflo(r.y) + bfhi(r.y) * bfhi(r.y)
                    + bflo(r.z) * bflo(r.z) + bfhi(r.z) * bfhi(r.z) + bflo(r.w) * bflo(r.w) + bfhi(r.w) * bfhi(r.w);
            }
        ss += __shfl_xor(ss, 16); ss += __shfl_xor(ss, 32);
        const float rs = rsqrtf(ss * (1.0f / 256) + EPS);
#pragma unroll
        for (int k = 0; k < 2; ++k)
#pragma unroll
            for (int ks = 0; ks < 4; ++ks) {
                const float* wp = qnw + k * 128 + ks * 32 + fq * 8;
                const f32x4 w0 = *(const f32x4*)wp, w1 = *(const f32x4*)(wp + 4);
                const u32x4 r = raw[k][ks];
                u32x4 o;
                o.x = pack2(bflo(r.x) * rs * w0.x, bfhi(r.x) * rs * w0.y); o.y = pack2(bflo(r.y) * rs * w0.z, bfhi(r.y) * rs * w0.w);
                o.z = pack2(bflo(r.z) * rs * w1.x, bfhi(r.z) * rs * w1.y); o.w = pack2(bflo(r.w) * rs * w1.z, bfhi(r.w) * rs * w1.w);
                qf[k][ks] = __builtin_bit_cast(bf16x8, o);
            }
    }
    unsigned L[2][16];
#pragma unroll
    for (int k = 0; k < 2; ++k) {
        f32x4 acc[8];
#pragma unroll
        for (int kt = 0; kt < 8; ++kt) acc[kt] = (f32x4){0.f, 0.f, 0.f, 0.f};
#pragma unroll
        for (int kt = 0; kt < 8; ++kt)
#pragma unroll
            for (int ks = 0; ks < 4; ++ks) {
                const int row = k * 128 + kt * 16 + fr;
                const bf16x8 af = *(const bf16x8*)(lds + row * 256 + (((ks * 4 + fq) ^ fr) << 4));
                acc[kt] = __builtin_amdgcn_mfma_f32_16x16x32_bf16(af, qf[k][ks], acc[kt], 0, 0, 0);
            }
        {
            unsigned H[16];
#pragma unroll
            for (int kt = 0; kt < 4; ++kt)
#pragma unroll
                for (int jj = 0; jj < 4; ++jj) {
                    L[k][kt * 4 + jj] = (mono_u(acc[kt][jj]) & ~0x7Fu) | (unsigned)(127 - (kt * 16 + 4 * fq + jj));
                    H[kt * 4 + jj] = (mono_u(acc[kt + 4][jj]) & ~0x7Fu) | (unsigned)(127 - ((kt + 4) * 16 + 4 * fq + jj));
                }
            sort16(L[k]); sort16(H);
            merge16(L[k], H);
        }
#pragma unroll
        for (int r = 16; r <= 32; r <<= 1) {
            unsigned P[16];
#pragma unroll
            for (int i = 0; i < 16; ++i) P[i] = (unsigned)__shfl_xor((int)L[k][i], r);
            merge16(L[k], P);
        }
    }
    unsigned T[16];
#define CAND(a, b) ((mono_u(unmono_f(L[0][a] & ~0x7Fu) + unmono_f(L[1][b] & ~0x7Fu)) & ~0xFFu) | (unsigned)(255 - ((a) * 16 + (b))))
#pragma unroll
    for (int bb = 0; bb < 16; ++bb) T[bb] = CAND(0, bb);
    {
        unsigned Bq[16];
#pragma unroll
        for (int bb = 0; bb < 8; ++bb) Bq[bb] = CAND(1, bb);
        Bq[8] = CAND(4, 0); Bq[9] = CAND(4, 1); Bq[10] = CAND(4, 2); Bq[11] = CAND(5, 0); Bq[12] = CAND(5, 1); Bq[13] = CAND(6, 0); Bq[14] = CAND(6, 1); Bq[15] = CAND(8, 0);
        sort16(Bq); merge16(T, Bq);
    }
    {
        unsigned Cq[16];
#pragma unroll
        for (int bb = 0; bb < 5; ++bb) Cq[bb] = CAND(2, bb);
#pragma unroll
        for (int bb = 0; bb < 4; ++bb) Cq[5 + bb] = CAND(3, bb);
        Cq[9] = CAND(7, 0); Cq[10] = CAND(7, 1); Cq[11] = CAND(9, 0); Cq[12] = CAND(10, 0); Cq[13] = CAND(11, 0); Cq[14] = CAND(12, 0); Cq[15] = CAND(13, 0);
        sort16(Cq); merge16(T, Cq);
    }
    ins16(T, CAND(14, 0)); ins16(T, CAND(15, 0));
#undef CAND
    unsigned char* li = (unsigned char*)lds + RT_LI + w * 512 + fr * 32;
    if (fq == 0) {
#pragma unroll
        for (int a = 0; a < 16; ++a) { li[a] = (unsigned char)(127 - (L[0][a] & 0x7Fu)); li[16 + a] = (unsigned char)(127 - (L[1][a] & 0x7Fu)); }
    }
    __syncthreads();
    const float s0 = unmono_f(T[0] & ~0xFFu);
    float pe[16]; float sum = 0.f;
#pragma unroll
    for (int i = 0; i < 16; ++i) { pe[i] = __expf(unmono_f(T[i] & ~0xFFu) - s0); sum += pe[i]; }
    const float inv = 1.0f / sum;
    unsigned cod[4] = {0u, 0u, 0u, 0u}; float gv[4] = {0.f, 0.f, 0.f, 0.f};
#pragma unroll
    for (int i = 0; i < 16; ++i) if ((i >> 2) == fq) { cod[i & 3] = 255u - (T[i] & 0xFFu); gv[i & 3] = pe[i] * inv; }
    int ev[4];
#pragma unroll
    for (int i = 0; i < 4; ++i) ev[i] = (int)li[cod[i] >> 4] * 128 + (int)li[16 + (cod[i] & 15u)];
    *(u32x4*)(eidx + (tok * 8 + h) * 16 + fq * 4) = (u32x4){(unsigned)ev[0], (unsigned)ev[1], (unsigned)ev[2], (unsigned)ev[3]};
    *(f32x4*)(gate + (tok * 8 + h) * 16 + fq * 4) = (f32x4){gv[0], gv[1], gv[2], gv[3]};
    __syncthreads();
}

__device__ __forceinline__ void cvt16(const u32x2 q, f32x2 (&f)[8]) {
#pragma unroll
    for (int i = 0; i < 2; ++i) {
        f[4 * i] = __builtin_amdgcn_cvt_scalef32_pk_f32_fp4(q[i], 1.0f, 0); f[4 * i + 1] = __builtin_amdgcn_cvt_scalef32_pk_f32_fp4(q[i], 1.0f, 1);
        f[4 * i + 2] = __builtin_amdgcn_cvt_scalef32_pk_f32_fp4(q[i], 1.0f, 2); f[4 * i + 3] = __builtin_amdgcn_cvt_scalef32_pk_f32_fp4(q[i], 1.0f, 3);
    }
}
typedef int v8i __attribute__((ext_vector_type(8)));
__device__ __forceinline__ void d_peer_expert_mx(const bf16_t* __restrict__ h2, const unsigned char* __restrict__ down4, const unsigned char* __restrict__ up4, const float* __restrict__ dscale,
                                                 const float* __restrict__ uscale, const int* __restrict__ eidx, const float* __restrict__ gate, const float* __restrict__ mod,
                                                 const float* __restrict__ fw, const bf16_t* __restrict__ x1, float* __restrict__ out, int vb, char* lds) {
    const int tid = tid_opaque(), lane = tid & 63, wid = tid >> 6, fr = lane & 15, kq = lane >> 4;
    const size_t tok = (size_t)vb * 8 + wid; const int b = (int)(tok >> 13);
    unsigned char* hq = (unsigned char*)lds + wid * 1024;
    {
        const u32x4 v0 = *(const u32x4*)(h2 + tok * DM + lane * 16), v1 = *(const u32x4*)(h2 + tok * DM + lane * 16 + 8);
        u32x4 q;
        int wv = 0;
        wv = __builtin_amdgcn_cvt_pk_fp8_f32(bflo(v0.x), bfhi(v0.x), wv, false); wv = __builtin_amdgcn_cvt_pk_fp8_f32(bflo(v0.y), bfhi(v0.y), wv, true); q.x = (unsigned)wv;
        wv = __builtin_amdgcn_cvt_pk_fp8_f32(bflo(v0.z), bfhi(v0.z), wv, false); wv = __builtin_amdgcn_cvt_pk_fp8_f32(bflo(v0.w), bfhi(v0.w), wv, true); q.y = (unsigned)wv;
        wv = __builtin_amdgcn_cvt_pk_fp8_f32(bflo(v1.x), bfhi(v1.x), wv, false); wv = __builtin_amdgcn_cvt_pk_fp8_f32(bflo(v1.y), bfhi(v1.y), wv, true); q.z = (unsigned)wv;
        wv = __builtin_amdgcn_cvt_pk_fp8_f32(bflo(v1.z), bfhi(v1.z), wv, false); wv = __builtin_amdgcn_cvt_pk_fp8_f32(bflo(v1.w), bfhi(v1.w), wv, true); q.w = (unsigned)wv;
        *(u32x4*)(hq + lane * 16) = q;
    }
    const int e_lo = eidx[tok * 128 + lane], e_hi = eidx[tok * 128 + 64 + lane];
    const float c_lo = gate[tok * 128 + lane] * uscale[e_lo], c_hi = gate[tok * 128 + 64 + lane] * uscale[e_hi];
    const float d_lo = dscale[e_lo], d_hi = dscale[e_hi];
    f32x2 acc[8];
#pragma unroll
    for (int e = 0; e < 8; ++e) acc[e] = (f32x2){0.f, 0.f};
    u32x4 da[8], dn[8]; u32x2 uq[16], un[16];
    {
        const int em = __shfl(e_lo, fr);
        const unsigned char* ab = down4 + (size_t)em * 512 + kq * 16;
#pragma unroll
        for (int k = 0; k < 8; ++k) da[k] = *(const u32x4*)(ab + k * 64);
#pragma unroll
        for (int i = 0; i < 16; ++i) { const int e = __builtin_amdgcn_readlane(e_lo, i); uq[i] = *(const u32x2*)(up4 + (size_t)e * 512 + lane * 8); }
    }
#pragma unroll 1
    for (int g = 0; g < 8; ++g) {
        if (g + 1 < 8) {
            const int gn = g + 1;
            const int em = gn < 4 ? __shfl(e_lo, gn * 16 + fr) : __shfl(e_hi, (gn - 4) * 16 + fr);
            const unsigned char* ab = down4 + (size_t)em * 512 + kq * 16;
#pragma unroll
            for (int k = 0; k < 8; ++k) dn[k] = *(const u32x4*)(ab + k * 64);
#pragma unroll
            for (int i = 0; i < 16; ++i) {
                const int e = gn < 4 ? __builtin_amdgcn_readlane(e_lo, gn * 16 + i) : __builtin_amdgcn_readlane(e_hi, (gn - 4) * 16 + i);
                un[i] = *(const u32x2*)(up4 + (size_t)e * 512 + lane * 8);
            }
        }
        f32x4 d4 = (f32x4){0.f, 0.f, 0.f, 0.f};
#pragma unroll
        for (int k = 0; k < 8; ++k) {
            const u32x4 b0 = *(const u32x4*)(hq + k * 128 + kq * 16), b1 = *(const u32x4*)(hq + k * 128 + 64 + kq * 16);
            const v8i A = {(int)da[k].x, (int)da[k].y, (int)da[k].z, (int)da[k].w, 0, 0, 0, 0};
            const v8i B = {(int)b0.x, (int)b0.y, (int)b0.z, (int)b0.w, (int)b1.x, (int)b1.y, (int)b1.z, (int)b1.w};
            d4 = __builtin_amdgcn_mfma_scale_f32_16x16x128_f8f6f4(A, B, d4, 4  , 0  , 0, 0x7F7F7F7F, 0, 0x7F7F7F7F);
        }
        float av;
        {
            const int jm = fr & 3;
            const float dv = jm == 0 ? d4[0] : jm == 1 ? d4[1] : jm == 2 ? d4[2] : d4[3];
            const int sl = (g & 3) * 16 + 4 * kq + jm;
            const float mc = g < 4 ? __shfl(c_lo, sl) : __shfl(c_hi, sl);
            const float md = g < 4 ? __shfl(d_lo, sl) : __shfl(d_hi, sl);
            av = gelu_tanh(dv * md) * mc;
        }
#pragma unroll
        for (int i = 0; i < 16; ++i) {
            const float c = __uint_as_float((unsigned)__builtin_amdgcn_readlane((int)__float_as_uint(av), 16 * (i >> 2) + (i & 3)));
            const f32x2 c2 = {c, c};
            f32x2 f[8]; cvt16(uq[i], f);
#pragma unroll
            for (int e = 0; e < 8; ++e) acc[e] = __builtin_elementwise_fma(f[e], c2, acc[e]);
        }
#pragma unroll
        for (int k = 0; k < 8; ++k) da[k] = dn[k];
#pragma unroll
        for (int i = 0; i < 16; ++i) uq[i] = un[i];
    }
    float x2[16]; float ss = 0.f;
#pragma unroll
    for (int q4i = 0; q4i < 4; ++q4i) {
        const int col = lane * 16 + q4i * 4;
        const u32x2 xb = *(const u32x2*)(x1 + tok * DM + col);
        const f32x4 xv = (f32x4){bflo(xb.x), bfhi(xb.x), bflo(xb.y), bfhi(xb.y)};
        const f32x4 g2 = *(const f32x4*)(mod + b * 6144 + 5120 + col);
        const int e0 = q4i * 4;
        x2[e0 + 0] = xv.x + g2.x * acc[2 * q4i].x; x2[e0 + 1] = xv.y + g2.y * acc[2 * q4i].y; x2[e0 + 2] = xv.z + g2.z * acc[2 * q4i + 1].x; x2[e0 + 3] = xv.w + g2.w * acc[2 * q4i + 1].y;
        ss += x2[e0] * x2[e0] + x2[e0 + 1] * x2[e0 + 1] + x2[e0 + 2] * x2[e0 + 2] + x2[e0 + 3] * x2[e0 + 3];
    }
    ss = wave_sum(ss);
    const float r = rsqrtf(ss * (1.0f / DM) + EPS);
#pragma unroll
    for (int q4i = 0; q4i < 4; ++q4i) {
        const int col = lane * 16 + q4i * 4;
        const f32x4 wv = *(const f32x4*)(fw + col);
        const int e0 = q4i * 4;
        *(f32x4*)(out + tok * DM + col) = (f32x4){x2[e0] * r * wv.x, x2[e0 + 1] * r * wv.y, x2[e0 + 2] * r * wv.z, x2[e0 + 3] * r * wv.w};
    }
}

__device__ __forceinline__ void d_peer_expert8(const bf16_t* __restrict__ h2, const unsigned char* __restrict__ down8, const unsigned char* __restrict__ up8, const float* __restrict__ dscale,
                                               const float* __restrict__ uscale, const int* __restrict__ eidx, const float* __restrict__ gate, const float* __restrict__ mod,
                                               const float* __restrict__ fw, float* __restrict__ out, int vb) {
    const int tid = tid_opaque(), lane = tid & 63, wid = tid >> 6;
    const size_t tok = (size_t)vb * 8 + wid; const int b = (int)(tok >> 13);
    const int e_lo = eidx[tok * 128 + lane], e_hi = eidx[tok * 128 + 64 + lane];
    const float c_lo = gate[tok * 128 + lane] * uscale[e_lo], c_hi = gate[tok * 128 + 64 + lane] * uscale[e_hi];
    const float d_lo = dscale[e_lo], d_hi = dscale[e_hi];
    f32x2 hx[8], acc[8];
    {
        const u32x4 v0 = *(const u32x4*)(h2 + tok * DM + lane * 16), v1 = *(const u32x4*)(h2 + tok * DM + lane * 16 + 8);
        hx[0] = (f32x2){bflo(v0.x), bfhi(v0.x)}; hx[1] = (f32x2){bflo(v0.y), bfhi(v0.y)}; hx[2] = (f32x2){bflo(v0.z), bfhi(v0.z)}; hx[3] = (f32x2){bflo(v0.w), bfhi(v0.w)};
        hx[4] = (f32x2){bflo(v1.x), bfhi(v1.x)}; hx[5] = (f32x2){bflo(v1.y), bfhi(v1.y)}; hx[6] = (f32x2){bflo(v1.z), bfhi(v1.z)}; hx[7] = (f32x2){bflo(v1.w), bfhi(v1.w)};
    }
#pragma unroll
    for (int e = 0; e < 8; ++e) acc[e] = (f32x2){0.f, 0.f};
    const int es = lane >> 3;
    u32x2 dq[8], uq[8], dn[8], un[8];
#pragma unroll
    for (int i = 0; i < 8; ++i) {
        const int e = __builtin_amdgcn_readlane(e_lo, i);
        dq[i] = *(const u32x2*)(down8 + (size_t)e * 512 + lane * 8);
        uq[i] = *(const u32x2*)(up8 + (size_t)e * 512 + lane * 8);
    }
#pragma unroll 1
    for (int j0 = 0; j0 < 128; j0 += 8) {
        if (j0 + 8 < 128) {
            const int jn = j0 + 8;
#pragma unroll
            for (int i = 0; i < 8; ++i) {
                const int e = jn < 64 ? __builtin_amdgcn_readlane(e_lo, jn + i) : __builtin_amdgcn_readlane(e_hi, jn - 64 + i);
                dn[i] = *(const u32x2*)(down8 + (size_t)e * 512 + lane * 8);
                un[i] = *(const u32x2*)(up8 + (size_t)e * 512 + lane * 8);
            }
        }
        const int sl = (j0 & 63) + es;
        const float my_c = j0 < 64 ? __shfl(c_lo, sl) : __shfl(c_hi, sl);
        const float my_ds = j0 < 64 ? __shfl(d_lo, sl) : __shfl(d_hi, sl);
        float part[8];
#pragma unroll
        for (int i = 0; i < 8; ++i) {
            f32x2 f[8]; cvt16(dq[i], f);
            f32x2 s2 = hx[0] * f[0];
#pragma unroll
            for (int e = 1; e < 8; ++e) s2 = __builtin_elementwise_fma(hx[e], f[e], s2);
            part[i] = s2.x + s2.y;
        }
        float q4[4], q2[2], q1;
#pragma unroll
        for (int i = 0; i < 4; ++i) { const bool up = (lane & 32) != 0; const float send = up ? part[i] : part[i + 4]; const float keep = up ? part[i + 4] : part[i]; q4[i] = keep + __shfl_xor(send, 32); }
#pragma unroll
        for (int i = 0; i < 2; ++i) { const bool up = (lane & 16) != 0; const float send = up ? q4[i] : q4[i + 2]; const float keep = up ? q4[i + 2] : q4[i]; q2[i] = keep + __shfl_xor(send, 16); }
        { const bool up = (lane & 8) != 0; const float send = up ? q2[0] : q2[1]; const float keep = up ? q2[1] : q2[0]; q1 = keep + __shfl_xor(send, 8); }
        q1 += __shfl_xor(q1, 4); q1 += __shfl_xor(q1, 2); q1 += __shfl_xor(q1, 1);
        const float a = gelu_tanh(q1 * my_ds) * my_c;
#pragma unroll
        for (int i = 0; i < 8; ++i) {
            const float c = __uint_as_float((unsigned)__builtin_amdgcn_readlane((int)__float_as_uint(a), 8 * i));
            const f32x2 c2 = {c, c};
            f32x2 f[8]; cvt16(uq[i], f);
#pragma unroll
            for (int e = 0; e < 8; ++e) acc[e] = __builtin_elementwise_fma(f[e], c2, acc[e]);
        }
#pragma unroll
        for (int i = 0; i < 8; ++i) { dq[i] = dn[i]; uq[i] = un[i]; }
    }
    float x2[16]; float ss = 0.f;
#pragma unroll
    for (int q4i = 0; q4i < 4; ++q4i) {
        const int col = lane * 16 + q4i * 4;
        const f32x4 xv = *(const f32x4*)(out + tok * DM + col);
        const f32x4 g2 = *(const f32x4*)(mod + b * 6144 + 5120 + col);
        const int e0 = q4i * 4;
        x2[e0 + 0] = xv.x + g2.x * acc[2 * q4i].x; x2[e0 + 1] = xv.y + g2.y * acc[2 * q4i].y; x2[e0 + 2] = xv.z + g2.z * acc[2 * q4i + 1].x; x2[e0 + 3] = xv.w + g2.w * acc[2 * q4i + 1].y;
        ss += x2[e0] * x2[e0] + x2[e0 + 1] * x2[e0 + 1] + x2[e0 + 2] * x2[e0 + 2] + x2[e0 + 3] * x2[e0 + 3];
    }
    ss = wave_sum(ss);
    const float r = rsqrtf(ss * (1.0f / DM) + EPS);
#pragma unroll
    for (int q4i = 0; q4i < 4; ++q4i) {
        const int col = lane * 16 + q4i * 4;
        const f32x4 wv = *(const f32x4*)(fw + col);
        const int e0 = q4i * 4;
        *(f32x4*)(out + tok * DM + col) = (f32x4){x2[e0] * r * wv.x, x2[e0 + 1] * r * wv.y, x2[e0 + 2] * r * wv.z, x2[e0 + 3] * r * wv.w};
    }
}

#define XB_TMO      128
#define XB_XCNT(j)  (256  + 64 * (j))
#define XB_XSUB(j)  (1280 + 64 * (j))
#define XB_XGEN(j)  (2304 + 64 * (j))
#define XB_TOP      3328
#define XB_TOPGEN   3392
#define XCD_BAR_WORDS 3456
#define XB_SPIN_CAP (1u << 18)

__device__ __forceinline__ unsigned xb_ld(unsigned* p)              { return __hip_atomic_load(p, __ATOMIC_RELAXED, __HIP_MEMORY_SCOPE_AGENT); }
__device__ __forceinline__ unsigned xb_add(unsigned* p, unsigned v) { return __hip_atomic_fetch_add(p, v, __ATOMIC_RELAXED, __HIP_MEMORY_SCOPE_AGENT); }
__device__ __forceinline__ unsigned xb_xcc_id() { return (unsigned)__builtin_amdgcn_s_getreg((3 << 11) | 20) & 0xFu; }
#define XB_SPIN(cond, bar) do { unsigned _sp = 0; while (cond) { __builtin_amdgcn_s_sleep(1); \
    if ((++_sp & 255u) == 0u) { if (xb_ld(&(bar)[XB_TMO])) break; if (_sp > XB_SPIN_CAP) { atomicAdd(&(bar)[XB_TMO], 1u); break; } } } } while (0)

struct XcdBarrier {
    unsigned* bar; unsigned x;
    volatile __attribute__((address_space(3))) unsigned* st;
};

__device__ __forceinline__ XcdBarrier xcd_barrier_post(unsigned* bar, volatile __attribute__((address_space(3))) unsigned* st) {
    XcdBarrier b; b.bar = bar; b.x = xb_xcc_id(); b.st = st;
    if (threadIdx.x == 0) (void)xb_add(&bar[XB_XCNT(b.x)], 1u);
    return b;
}
__device__ __forceinline__ void xcd_barrier_complete(unsigned* bar, unsigned x, unsigned& nloc, unsigned& nx) {
    const unsigned G = gridDim.x * gridDim.y * gridDim.z;
    unsigned sum, cnt, mine, sp = 0u;
    for (;;) {
        sum = 0u; cnt = 0u; mine = 0u;
#pragma unroll
        for (unsigned j = 0; j < 16; ++j) { const unsigned c = xb_ld(&bar[XB_XCNT(j)]); sum += c; cnt += (c > 0u) ? 1u : 0u; mine = (j == x) ? c : mine; }
        if (sum == G) break;
        __builtin_amdgcn_s_sleep(1);
        if ((++sp & 255u) == 0u) { if (xb_ld(&bar[XB_TMO])) break; if (sp > XB_SPIN_CAP) { atomicAdd(&bar[XB_TMO], 1u); break; } }
    }
    nloc = mine > 0u ? mine : 1u; nx = cnt > 0u ? cnt : 1u;
}

__device__ __forceinline__ void xcd_barrier(const XcdBarrier& b) {
    asm volatile("s_waitcnt vmcnt(0)" ::: "memory");
    __syncthreads();
    if (threadIdx.x == 0) {
        unsigned* bar = b.bar;
        __builtin_amdgcn_s_waitcnt(0);
        unsigned nloc = b.st[0], nx = b.st[1];
        if (nloc == 0u) { xcd_barrier_complete(bar, b.x, nloc, nx); b.st[0] = nloc; b.st[1] = nx; }
        const unsigned old = xb_add(&bar[XB_XSUB(b.x)], 1u);
        const unsigned gen = old / nloc;
        if (old + 1u == (gen + 1u) * nloc) {
            __builtin_amdgcn_fence(__ATOMIC_RELEASE, "agent");
            asm volatile("s_waitcnt vmcnt(0)" ::: "memory");
            const unsigned og = xb_add(&bar[XB_TOP], 1u);
            const unsigned tg = og / nx;
            if (og + 1u == (tg + 1u) * nx) xb_add(&bar[XB_TOPGEN], 1u);
            else XB_SPIN(xb_ld(&bar[XB_TOPGEN]) == tg, bar);
            __builtin_amdgcn_fence(__ATOMIC_ACQUIRE, "agent");
            xb_add(&bar[XB_XGEN(b.x)], 1u);
            asm volatile("s_waitcnt vmcnt(0)" ::: "memory");
        } else {
            XB_SPIN(xb_ld(&bar[XB_XGEN(b.x)]) == gen, bar);
            __builtin_amdgcn_fence(__ATOMIC_ACQUIRE, "agent");
            asm volatile("s_waitcnt vmcnt(0)" ::: "memory");
        }
    }
    __syncthreads();
}


struct Params {
    const float *x, *c, *w_ada, *b_ada, *norm1_w, *w_in, *cmp_pe_k, *cmp_pe_v, *cmp_w1_k, *cmp_w2_k, *cmp_w1_v, *cmp_w2_v, *nsa_norm_w, *conv_w, *conv_b, *dt_bias, *a_log, *d_skip,
        *ssd_norm_w, *w_out, *norm2_w, *peer_wq, *peer_qnorm_w, *peer_sub_keys, *peer_down, *peer_up, *final_norm_w;
    float* out; char* ws;
};
#define LDS_BYTES 147456
#define LDS_MISC  (LDS_BYTES - 64)

__global__ __launch_bounds__(512, 2) void mega(Params p) {
    __shared__ __attribute__((aligned(16))) unsigned char lds_raw[LDS_BYTES];
    char* lds = (char*)lds_raw;
    PG8_LAS unsigned char* lds3 = (PG8_LAS unsigned char*)lds_raw;
    int* s_vb = (int*)(lds + LDS_MISC);
    cg::grid_group grid = cg::this_grid();
    volatile __attribute__((address_space(3))) unsigned* xb_st = (volatile __attribute__((address_space(3))) unsigned*)((PG8_LAS unsigned char*)lds_raw + LDS_MISC + 16);
    if (threadIdx.x == 0) { xb_st[0] = 0u; xb_st[1] = 0u; }
    __syncthreads();
    const XcdBarrier xbar = xcd_barrier_post((unsigned*)(p.ws + OFF_BAR), xb_st);
    const int G = gridDim.x, bid = blockIdx.x;
    if (bid == 0 && threadIdx.x == 0) { ((unsigned*)(p.ws + OFF_CTR))[0] = 0u; ((unsigned*)(p.ws + OFF_CTR))[64] = 0u; ((unsigned*)(p.ws + OFF_CTR))[128] = 0u; ((unsigned*)(p.ws + OFF_CTR))[192] = 0u; }
    for (int vb = bid; vb < 7906; vb += G) {
        int v = vb;
        if (v < 1536) { d_transpose_w(p.w_in, ((bf16_t*)(p.ws + OFF_WIN_T)), 1024, 2848, 1, 96, v, lds); }
        else if ((v -= 1536) < 512) { d_transpose_w(p.w_out, ((bf16_t*)(p.ws + OFF_WOUT_T)), 1024, 1024, 0, 32, v, lds); }
        else if ((v -= 512) < 1024) { d_transpose_w(p.peer_wq, ((bf16_t*)(p.ws + OFF_WQ_T)), 1024, 2048, 0, 64, v, lds); }
        else if ((v -= 1024) < 256) { d_transpose_w(p.cmp_w1_k, ((bf16_t*)(p.ws + OFF_W1K_T)), 2048, 256, 0, 8, v, lds); }
        else if ((v -= 256) < 256) { d_transpose_w(p.cmp_w1_v, ((bf16_t*)(p.ws + OFF_W1V_T)), 2048, 256, 0, 8, v, lds); }
        else if ((v -= 256) < 2048) { d_quant_rows(p.peer_down, ((unsigned char*)(p.ws + OFF_DOWN)), ((float*)(p.ws + OFF_UP)), v); }
        else if ((v -= 2048) < 2048) { d_quant_rows(p.peer_up, ((unsigned char*)(p.ws + OFF_DOWN + MIB(8))), ((float*)(p.ws + OFF_UP + 65536)), v); }
        else if ((v -= 2048) < 1) { d_convert_bf16(p.peer_sub_keys, ((bf16_t*)(p.ws + OFF_SUBK)), (size_t)8 * 2 * 128 * 128 / 8, 0, 1); }
        else if ((v -= 1) < 96) { d_mod(p.c, p.w_ada, p.b_ada, ((float*)(p.ws + OFF_MOD)), v, lds); }
        else if ((v -= 96) < 128) { d_rope_table(((float2*)(p.ws + OFF_ROPE)), v); }
        else { d_bias1(p.cmp_pe_k, p.cmp_w1_k, p.cmp_pe_v, p.cmp_w1_v, ((float*)(p.ws + OFF_BIAS1))); }
    }
    grid.sync();
    for (int vb = bid; vb < NTOK / 32; vb += G) d_norm_mod<false>(p.x, p.norm1_w, ((float*)(p.ws + OFF_MOD)), 0, 1024, ((bf16_t*)(p.ws + OFF_H)), vb);
    xcd_barrier(xbar);
    {
        const pg8::Gemm g{((bf16_t*)(p.ws + OFF_H)), ((bf16_t*)(p.ws + OFF_WIN_T)), NTOK, NIN_PAD, 1024, 1024};
        pg8::StaticOrder S; S.init(NTOK, NIN_PAD, G, bid);
        const pg8::Epi<EpInProj> E{{((bf16_t*)(p.ws + OFF_PROJ)), ((bf16_t*)(p.ws + OFF_QROPE)), ((bf16_t*)(p.ws + OFF_KVP)), ((float*)(p.ws + OFF_SMALL)), ((float2*)(p.ws + OFF_ROPE)), p.dt_bias}};
        pg8::gemm_phase(lds3, g, S, E);
    }
    xcd_barrier(xbar);
    {
        {
            const pg8::Gemm g{((bf16_t*)(p.ws + OFF_KVP)) + 0 * KVP_SEG, ((bf16_t*)(p.ws + OFF_W1K_T)), 8192, 256, 2048, 1024};
            pg8::StaticOrder S; S.init(8192, 256, G, bid);
            const pg8::Epi<EpCmpHid> E{{((bf16_t*)(p.ws + OFF_HIDK)), ((float*)(p.ws + OFF_BIAS1))}};
            pg8::gemm_phase(lds3, g, S, E);
        }
        {
            const pg8::Gemm g{((bf16_t*)(p.ws + OFF_KVP)) + 1 * KVP_SEG, ((bf16_t*)(p.ws + OFF_W1V_T)), 8192, 256, 2048, 1024};
            pg8::StaticOrder S; S.init(8192, 256, G, (bid + G / 2) % G);
            const pg8::Epi<EpCmpHid> E{{((bf16_t*)(p.ws + OFF_HIDV)), ((float*)(p.ws + OFF_BIAS1)) + 256}};
            pg8::gemm_phase(lds3, g, S, E);
        }
        __syncthreads();
        for (;;) {
            if (threadIdx.x == 0) *s_vb = (int)atomicAdd(&((unsigned*)(p.ws + OFF_CTR))[192], 1u);
            __syncthreads();
            const int i = *s_vb;
            __syncthreads();
            if (i >= 1024) break;
            d_ssd_states(((bf16_t*)(p.ws + OFF_PROJ)), ((float*)(p.ws + OFF_SMALL)), p.conv_w, p.conv_b, p.a_log, ((float*)(p.ws + OFF_ONSA)), ((float*)(p.ws + OFF_CTR + 4096)), i, lds);
        }
    }
    xcd_barrier(xbar);
    for (int vb = bid; vb < 2048 + 128; vb += G) {
        if (vb < 1024) d_cmp_out(((bf16_t*)(p.ws + OFF_HIDK)), p.cmp_w2_k, ((bf16_t*)(p.ws + OFF_KC)), vb); else if (vb < 2048) d_cmp_out(((bf16_t*)(p.ws + OFF_HIDV)), p.cmp_w2_v, ((bf16_t*)(p.ws + OFF_VC)), vb - 1024);
        else d_ssd_scan(((float*)(p.ws + OFF_ONSA)), ((float*)(p.ws + OFF_CTR + 4096)), ((bf16_t*)(p.ws + OFF_EIDX)), vb - 2048);
    }
    xcd_barrier(xbar);
    for (;;) {
        if (threadIdx.x == 0) *s_vb = (int)atomicAdd(&((unsigned*)(p.ws + OFF_CTR))[0], 1u);
        __syncthreads();
        const int i = *s_vb;
        __syncthreads();
        if (i >= 2048) break;
        const int qt = 127 - (i >> 4), bg = i & 15;
        d_nsa_cmp(((bf16_t*)(p.ws + OFF_PROJ)), ((bf16_t*)(p.ws + OFF_KC)), ((bf16_t*)(p.ws + OFF_VC)), ((float*)(p.ws + OFF_SMALL)), ((bf16_t*)(p.ws + OFF_ONSA)), ((unsigned*)(p.ws + OFF_HIDK)) + (size_t)(bg * 128 + qt) * 512, bg >> 1, bg & 1, qt, lds);
    }
    for (;;) {
        if (threadIdx.x == 0) *s_vb = (int)atomicAdd(&((unsigned*)(p.ws + OFF_CTR))[64], 1u);
        __syncthreads();
        const int i = *s_vb;
        __syncthreads();
        if (i >= 1024) break;
        d_ssd_out(((bf16_t*)(p.ws + OFF_PROJ)), ((float*)(p.ws + OFF_SMALL)), p.conv_w, p.conv_b, p.a_log, p.d_skip, ((bf16_t*)(p.ws + OFF_EIDX)), ((bf16_t*)(p.ws + OFF_YSSD)), i, lds);
    }
    xcd_barrier(xbar);
    for (;;) {
        if (threadIdx.x == 0) *s_vb = (int)atomicAdd(&((unsigned*)(p.ws + OFF_CTR))[128], 1u);
        __syncthreads();
        const int i = *s_vb;
        __syncthreads();
        if (i >= 1024) break;
        const int qt2 = 63 - (i >> 4), bg = i & 15;
        d_nsa_attn128(((bf16_t*)(p.ws + OFF_QROPE)), ((bf16_t*)(p.ws + OFF_KVP)), ((float*)(p.ws + OFF_SMALL)), ((bf16_t*)(p.ws + OFF_ONSA)), ((unsigned*)(p.ws + OFF_HIDK)) + (size_t)(bg * 128) * 512, bg >> 1, bg & 1, qt2, lds);
    }
    xcd_barrier(xbar);
    for (int vb = bid; vb < NTOK / 32; vb += G) d_mix_prep(((bf16_t*)(p.ws + OFF_ONSA)), ((bf16_t*)(p.ws + OFF_YSSD)), p.nsa_norm_w, p.ssd_norm_w, ((bf16_t*)(p.ws + OFF_H)), vb);
    xcd_barrier(xbar);
    {
        const pg8::Gemm g{((bf16_t*)(p.ws + OFF_H)), ((bf16_t*)(p.ws + OFF_WOUT_T)), NTOK, 1024, 1024, 1024};
        pg8::StaticOrder S; S.init(NTOK, 1024, G, bid);
        const pg8::Epi<EpOutProj> E{{p.x, ((float*)(p.ws + OFF_MOD)), ((bf16_t*)(p.ws + OFF_ONSA))}};
        pg8::gemm_phase(lds3, g, S, E);
    }
    xcd_barrier(xbar);
    for (int vb = bid; vb < NTOK / 32; vb += G) d_norm_mod<true>(((bf16_t*)(p.ws + OFF_ONSA)), p.norm2_w, ((float*)(p.ws + OFF_MOD)), 3072, 4096, ((bf16_t*)(p.ws + OFF_H)), vb);
    xcd_barrier(xbar);
    {
        const pg8::Gemm g{((bf16_t*)(p.ws + OFF_H)), ((bf16_t*)(p.ws + OFF_WQ_T)), NTOK, 2048, 1024, 1024};
        pg8::StaticOrder S; S.init(NTOK, 2048, G, bid);
        const pg8::Epi<EpStoreBf16> E{{((bf16_t*)(p.ws + OFF_PROJ)), 2048, 0}};
        pg8::gemm_phase(lds3, g, S, E);
    }
    xcd_barrier(xbar);
    for (int h = 0; h < 8; ++h) {
        __syncthreads();
        d_peer_stage_keys(((bf16_t*)(p.ws + OFF_SUBK)), h, lds);
        __syncthreads();
        for (int tile = bid; tile < 512; tile += G) d_peer_route(((bf16_t*)(p.ws + OFF_PROJ)), p.peer_qnorm_w, ((int*)(p.ws + OFF_EIDX)), ((float*)(p.ws + OFF_GATE)), tile, h, lds);
    }
    xcd_barrier(xbar);
    for (int vb = bid; vb < NTOK / 8; vb += G) d_peer_expert_mx(((bf16_t*)(p.ws + OFF_H)), ((unsigned char*)(p.ws + OFF_DOWN)), ((unsigned char*)(p.ws + OFF_DOWN + MIB(8))), ((float*)(p.ws + OFF_UP)), ((float*)(p.ws + OFF_UP + 65536)), ((int*)(p.ws + OFF_EIDX)), ((float*)(p.ws + OFF_GATE)), ((float*)(p.ws + OFF_MOD)), p.final_norm_w, ((bf16_t*)(p.ws + OFF_ONSA)), p.out, vb, lds);
}

extern "C" void kernel_launch(void* const* d_in, const int* in_sizes, int n_in, void* d_out, int out_size, void* d_ws, size_t ws_size, hipStream_t stream) {
    if (ws_size < WS_NEED) { fprintf(stderr, "workspace too small\n"); return; }
    static int grid_blocks = 0;
    if (!grid_blocks) {
        int dev = 0, cus = 0, per_cu = 0;
        (void)hipGetDevice(&dev);
        (void)hipDeviceGetAttribute(&cus, hipDeviceAttributeMultiprocessorCount, dev);
        (void)hipOccupancyMaxActiveBlocksPerMultiprocessor(&per_cu, mega, 512, 0);
        if (per_cu < 1) fprintf(stderr, "occupancy query reports %d blocks per CU\n", per_cu);
        grid_blocks = cus;
    }
    Params p{};
    const float** pp = (const float**)&p;
    for (int i = 0; i < 27; ++i) pp[i] = (const float*)d_in[i];
    p.out = (float*)d_out; p.ws = (char*)d_ws;
    (void)hipMemsetAsync((char*)d_ws + OFF_BAR, 0, XCD_BAR_WORDS * 4, stream);
    void* args[] = {&p};
    hipError_t e = hipLaunchCooperativeKernel((void*)mega, dim3(grid_blocks), dim3(512), args, 0, stream);
    if (e != hipSuccess) fprintf(stderr, "cooperative launch failed: %s (grid %d)\n", hipGetErrorString(e), grid_blocks);
}
```

```cpp
#include <hip/hip_runtime.h>
#include <hip/hip_cooperative_groups.h>
#include <stdint.h>
#include <cstdio>
namespace cg = cooperative_groups;

typedef unsigned short bf16_t;
typedef short bf16x8 __attribute__((ext_vector_type(8)));
typedef float f32x4 __attribute__((ext_vector_type(4)));
typedef float f32x2 __attribute__((ext_vector_type(2)));
typedef unsigned u32x4 __attribute__((ext_vector_type(4)));
typedef unsigned u32x2 __attribute__((ext_vector_type(2)));

#define NB 8
#define SEQ 8192
#define NTOK 65536
#define DM 1024
#define PROJ_LD 2816
#define NIN_PAD 3072
#define C_Q 0
#define C_KCMP 512
#define C_KSEL 768
#define C_VSEL 896
#define C_KWIN 1024
#define C_VWIN 1152
#define C_Z 1280
#define C_XBC 1792
#define NCMP 511
#define EPS 1e-6f
#define KVP_SEG ((size_t)NB * 2 * SEQ * 64)

#define MIB(x) ((size_t)(x) << 20)
#define OFF_MOD    MIB(0)
#define OFF_ROPE   MIB(1)
#define OFF_BIAS1  MIB(2)
#define OFF_WIN_T  MIB(3)
#define OFF_WOUT_T MIB(9)
#define OFF_WQ_T   MIB(11)
#define OFF_SUBK   MIB(15)
#define OFF_W1K_T  MIB(16)
#define OFF_W1V_T  MIB(17)
#define OFF_KC     MIB(18)
#define OFF_VC     MIB(19)
#define OFF_HIDK   MIB(20)
#define OFF_HIDV   MIB(24)
#define OFF_DOWN   MIB(28)
#define OFF_UP     MIB(60)
#define OFF_SMALL  MIB(92)
#define OFF_H      MIB(100)
#define OFF_PROJ   MIB(228)
#define OFF_QROPE  MIB(580)
#define OFF_ONSA   MIB(644)
#define OFF_YSSD   MIB(772)
#define OFF_KVP    MIB(836)
#define OFF_EIDX   MIB(932)
#define OFF_GATE   MIB(964)
#define OFF_CTR    MIB(996)
#define OFF_BAR    (MIB(996) + 65536)
#define WS_NEED    MIB(997)

typedef __bf16 hwbf2 __attribute__((ext_vector_type(2)));
__device__ __forceinline__ bf16_t f2bf(float f) { const __bf16 h = (__bf16)f; return __builtin_bit_cast(bf16_t, h); }
__device__ __forceinline__ float bf2f(bf16_t h) { return __uint_as_float(((unsigned)h) << 16); }
__device__ __forceinline__ float bflo(unsigned u) { return __uint_as_float(u << 16); }
__device__ __forceinline__ float bfhi(unsigned u) { return __uint_as_float(u & 0xffff0000u); }
__device__ __forceinline__ unsigned pack2(float a, float b) { const f32x2 v = {a, b}; const hwbf2 r = __builtin_convertvector(v, hwbf2); return __builtin_bit_cast(unsigned, r); }
__device__ __forceinline__ float wave_sum(float v) {
#pragma unroll
    for (int o = 32; o; o >>= 1) v += __shfl_xor(v, o);
    return v;
}
__device__ __forceinline__ float wave_max(float v) {
#pragma unroll
    for (int o = 32; o; o >>= 1) v = fmaxf(v, __shfl_xor(v, o));
    return v;
}
__device__ __forceinline__ int tid_opaque() { int t = threadIdx.x; asm volatile("" : "+v"(t)); return t; }
__device__ __forceinline__ float gelu_tanh(float x) { const float u2 = 1.5957691216057308f * (x + 0.044715f * x * x * x); return x * __builtin_amdgcn_rcpf(1.0f + __expf(-u2)); }
__device__ __forceinline__ float silu(float x) { return x / (1.0f + __expf(-x)); }
__device__ __forceinline__ float sigmoidf(float x) { return 1.0f / (1.0f + __expf(-x)); }
__device__ __forceinline__ float softplusf(float x) { return x > 20.f ? x : log1pf(__expf(x)); }

__device__ __forceinline__ int inproj_src(int n) {
    if (n < 1280) return n;
    if (n < 1792) return 1304 + (n - 1280);
    if (n < 2816) return 1816 + (n - 1792);
    if (n < 2840) return 1280 + (n - 2816);
    if (n < 2848) return 2840 + (n - 2840);
    return -1;
}
__device__ __forceinline__ void d_transpose_w(const float* __restrict__ W, bf16_t* __restrict__ Wt, int K, int N, int mode, int nbx, int vb, char* lds) {
    const int tid_ = tid_opaque(); const int half = tid_ >> 8, t256 = tid_ & 255, tile = vb * 2 + half;
    float (*t)[33] = (float (*)[33])(lds + half * 4352);
    const int n0 = (tile % nbx) * 32, k0 = (tile / nbx) * 32, tx = t256 & 31, ty = t256 >> 5;
#pragma unroll
    for (int i = 0; i < 4; ++i) {
        const int k = k0 + ty + 8 * i, n = n0 + tx;
        const int src = mode == 1 ? inproj_src(n) : n;
        t[ty + 8 * i][tx] = (src >= 0 && src < N) ? W[(size_t)k * N + src] : 0.f;
    }
    __syncthreads();
#pragma unroll
    for (int i = 0; i < 4; ++i) Wt[(size_t)(n0 + ty + 8 * i) * K + k0 + tx] = f2bf(t[tx][ty + 8 * i]);
    __syncthreads();
}
__device__ __forceinline__ void d_convert_bf16(const float* __restrict__ in, bf16_t* __restrict__ out, size_t n8, int vb, int nvb) {
    size_t i = (size_t)vb * 512 + tid_opaque();
    const size_t stride = (size_t)nvb * 512;
    for (; i < n8; i += stride) {
        const f32x4 a = ((const f32x4*)in)[2 * i], b = ((const f32x4*)in)[2 * i + 1];
        u32x4 o; o.x = pack2(a.x, a.y); o.y = pack2(a.z, a.w); o.z = pack2(b.x, b.y); o.w = pack2(b.z, b.w);
        ((u32x4*)out)[i] = o;
    }
}
__device__ __forceinline__ void d_mod(const float* __restrict__ c, const float* __restrict__ w_ada, const float* __restrict__ b_ada, float* __restrict__ mod, int vb, char* lds) {
    float (*part)[8][64] = (float (*)[8][64])lds;
    const int tid = tid_opaque(), jl = tid & 63, kq = tid >> 6, j = vb * 64 + jl;
    float acc[8];
#pragma unroll
    for (int b = 0; b < 8; ++b) acc[b] = 0.f;
    for (int k0 = kq * 128; k0 < kq * 128 + 128; k0 += 16) {
        float wv[16];
#pragma unroll
        for (int i = 0; i < 16; ++i) wv[i] = w_ada[(size_t)(k0 + i) * 6144 + j];
#pragma unroll
        for (int i = 0; i < 16; ++i)
#pragma unroll
            for (int b = 0; b < 8; ++b) acc[b] += c[b * 1024 + k0 + i] * wv[i];
    }
#pragma unroll
    for (int b = 0; b < 8; ++b) part[kq][b][jl] = acc[b];
    __syncthreads();
    {
        const int b = tid >> 6, jj = tid & 63;
        float s = b_ada[vb * 64 + jj];
#pragma unroll
        for (int q = 0; q < 8; ++q) s += part[q][b][jj];
        mod[b * 6144 + vb * 64 + jj] = s;
    }
    __syncthreads();
}
__device__ __forceinline__ void d_rope_table(float2* __restrict__ rope, int vb) {
    const int i = vb * 512 + tid_opaque();
    if (i >= SEQ * 8) return;
    const int pos = i >> 3, f = i & 7;
    const double inv = pow(500000.0, -(double)f / 8.0);
    const double ang = (double)pos * inv;
    rope[i] = make_float2((float)cos(ang), (float)sin(ang));
}
__device__ __forceinline__ void d_bias1_part(const float* __restrict__ pe_k, const float* __restrict__ w1_k, const float* __restrict__ pe_v, const float* __restrict__ w1_v, float* __restrict__ part, int sl) {
    const int tid_ = tid_opaque(); const int which = tid_ >> 8, j = tid_ & 255;
    const float* pe = which ? pe_v : pe_k; const float* w1 = which ? w1_v : w1_k;
    float wv[32];
#pragma unroll
    for (int i = 0; i < 32; ++i) wv[i] = w1[(size_t)(sl * 32 + i) * 256 + j];
    float a = 0.f;
#pragma unroll
    for (int i = 0; i < 32; ++i) a += pe[sl * 32 + i] * wv[i];
    part[sl * 512 + which * 256 + j] = a;
}
__device__ __forceinline__ void d_bias1_sum(const float* __restrict__ part, float* __restrict__ bias1) {
    const int t = tid_opaque();
    float v[64];
#pragma unroll
    for (int sl = 0; sl < 64; ++sl) v[sl] = part[sl * 512 + t];
    float a = 0.f;
#pragma unroll
    for (int sl = 0; sl < 64; ++sl) a += v[sl];
    bias1[t] = a;
}

template <bool XBF>
__device__ __forceinline__ void d_norm_mod(const void* __restrict__ xin, const float* __restrict__ w, const float* __restrict__ mod, int sh_off, int sc_off, bf16_t* __restrict__ out, int vb) {
    const int tid_ = tid_opaque(); const int lane = tid_ & 63, wid = tid_ >> 6;
    const size_t row0 = (size_t)vb * 32 + wid * 4; const int b = (int)(row0 >> 13);
    f32x4 v[4][2][2];
#pragma unroll
    for (int r = 0; r < 4; ++r)
#pragma unroll
        for (int k = 0; k < 2; ++k) {
            if (XBF) {
                const u32x4 t = *(const u32x4*)((const bf16_t*)xin + (row0 + r) * DM + k * 512 + lane * 8);
                v[r][k][0] = (f32x4){bflo(t.x), bfhi(t.x), bflo(t.y), bfhi(t.y)}; v[r][k][1] = (f32x4){bflo(t.z), bfhi(t.z), bflo(t.w), bfhi(t.w)};
            } else {
                const float* xp = (const float*)xin + (row0 + r) * DM + k * 512 + lane * 8;
                v[r][k][0] = *(const f32x4*)xp; v[r][k][1] = *(const f32x4*)(xp + 4);
            }
        }
    float rs[4];
#pragma unroll
    for (int r = 0; r < 4; ++r) {
        float ss = 0.f;
#pragma unroll
        for (int k = 0; k < 2; ++k)
#pragma unroll
            for (int h = 0; h < 2; ++h) ss += v[r][k][h].x * v[r][k][h].x + v[r][k][h].y * v[r][k][h].y + v[r][k][h].z * v[r][k][h].z + v[r][k][h].w * v[r][k][h].w;
        rs[r] = rsqrtf(wave_sum(ss) * (1.0f / DM) + EPS);
    }
#pragma unroll
    for (int k = 0; k < 2; ++k) {
        const int col = k * 512 + lane * 8;
        f32x4 ws[2], sh[2];
#pragma unroll
        for (int h = 0; h < 2; ++h) {
            const f32x4 wv = *(const f32x4*)(w + col + 4 * h), sc = *(const f32x4*)(mod + b * 6144 + sc_off + col + 4 * h);
            sh[h] = *(const f32x4*)(mod + b * 6144 + sh_off + col + 4 * h);
            ws[h] = wv * (sc + 1.0f);
        }
#pragma unroll
        for (int r = 0; r < 4; ++r) {
            const f32x4 y0 = v[r][k][0] * rs[r] * ws[0] + sh[0], y1 = v[r][k][1] * rs[r] * ws[1] + sh[1];
            u32x4 o; o.x = pack2(y0.x, y0.y); o.y = pack2(y0.z, y0.w); o.z = pack2(y1.x, y1.y); o.w = pack2(y1.z, y1.w);
            *(u32x4*)(out + (row0 + r) * DM + col) = o;
        }
    }
}

namespace pg8 {
#define PG8_LAS __attribute__((address_space(3)))
constexpr int BM = 256, BK = 64, HALF = 128, HTB = HALF * BK * 2  , STAGE_BYTES = 8 * HTB, NXCD = 8, WGM = 4;
__host__ __device__ __forceinline__ int lds_byte(int r, int c) { const int st = (r >> 4) * 2 + (c >> 5), rr = r & 15, cc = c & 31, ob = rr * 64 + cc * 2; return st * 1024 + (ob ^ (((ob >> 9) & 1) << 5)); }
__host__ __device__ __forceinline__ void stage_rc(int b, int& R, int& C) { const int st = b / 1024, sb = b % 1024, swz = sb ^ (((sb >> 9) & 1) << 5); R = (st >> 1) * 16 + swz / 64; C = (st & 1) * 32 + (swz % 64) / 2; }
__host__ __device__ __forceinline__ int perm32(int rho) { const int n = rho >> 4, i = rho & 15; return 8 * (i >> 2) + 4 * n + (i & 3); }
struct Unit { int pm, pn; };
struct Gemm { const bf16_t* A; const bf16_t* Bt; int M, N, K, lda; };
struct StaticOrder {
    int nM, nN, nwg, G, c;
    __host__ __device__ void init(int M, int N, int G_, int c_) { nM = M / BM; nN = N / BM; nwg = nM * nN; G = G_; c = c_; }
    __host__ __device__ bool next(int i, Unit& u) const {
        const long L = (long)i * G + c; if (L >= nwg) return false;
        int wgid = (int)L; { const int q = nwg / NXCD, r = nwg % NXCD, xcd = wgid % NXCD, off = wgid / NXCD; wgid = (xcd < r ? xcd * (q + 1) : r * (q + 1) + (xcd - r) * q) + off; }
        const int nig = WGM * nN, gid = wgid / nig, fm = gid * WGM, gsz = (nM - fm) < WGM ? (nM - fm) : WGM;
        u.pm = fm + ((wgid % nig) % gsz); u.pn = (wgid % nig) / gsz; return true;
    }
};
template <class F> struct Epi {
    F f;
    __device__ __forceinline__ void operator()(const f32x4 (&acc)[2][2][4][2], const Unit& u, int wr, int wc, int fr, int fq) const {
#pragma unroll
        for (int ai = 0; ai < 2; ++ai)
#pragma unroll
            for (int m = 0; m < 4; ++m)
#pragma unroll
                for (int bj = 0; bj < 2; ++bj)
                    f(u.pm * BM + ai * HALF + wr * 64 + m * 16 + fr, u.pn * BM + bj * HALF + wc * 32 + 8 * fq, acc[ai][bj][m][0], acc[ai][bj][m][1]);
    }
};
template <class E, class Sched>
__device__ __forceinline__ void gemm_phase(PG8_LAS unsigned char* lds, const Gemm g, const Sched& S, const E& Ep) {
    const int tid = tid_opaque(), wid = __builtin_amdgcn_readfirstlane(tid >> 6), lane = tid & 63, wr = wid >> 2, wc = wid & 3, fr = lane & 15, fq = lane >> 4;
    const int K = g.K, nt = K / BK;
    unsigned voffA[2], voffB[2];
#pragma unroll
    for (int i = 0; i < 2; ++i) { int R, C; stage_rc(tid * 16 + i * 8192, R, C); const int Rb = (R & ~31) + perm32(R & 31); voffA[i] = (unsigned)(R * g.lda + C) * 2u; voffB[i] = (unsigned)(Rb * K + C) * 2u; }
    const size_t kstep = (size_t)(BK * 2);
    const size_t hstep = (size_t)HALF * K * 2, hstepA = (size_t)HALF * g.lda * 2;
    const size_t tstep = 2 * hstep, tstepA = 2 * hstepA;
    const unsigned ldsw = (unsigned)wid * 1024u;
    const int aoff = lds_byte(wr * 64 + fr, fq * 8), boff = lds_byte(wc * 32 + fr, fq * 8);
#define PG8_SA(b, h) (((b) * 2 + (h)) * HTB)
#define PG8_SB(b, h) ((4 + (b) * 2 + (h)) * HTB)
#define PG8_STAGE(bufoff, gbase, voff) do { _Pragma("unroll") for (int _i = 0; _i < 2; ++_i) \
        __builtin_amdgcn_global_load_lds((const unsigned*)((const char*)(gbase) + (voff)[_i]), (PG8_LAS unsigned*)(lds + (bufoff) + ldsw + _i * 8192), 16, 0, 0); } while (0)
#define PG8_LDA(dst, b, h) do { _Pragma("unroll") for (int m = 0; m < 4; ++m) _Pragma("unroll") for (int k = 0; k < 2; ++k) dst[m][k] = *(const PG8_LAS bf16x8*)(lds + PG8_SA(b, h) + aoff + m * 2048 + k * 1024); } while (0)
#define PG8_LDB(dst, b, h) do { _Pragma("unroll") for (int n = 0; n < 2; ++n) _Pragma("unroll") for (int k = 0; k < 2; ++k) dst[n][k] = *(const PG8_LAS bf16x8*)(lds + PG8_SB(b, h) + boff + n * 2048 + k * 1024); } while (0)
#define PG8_MMA(ai, bj, At, Bt) do { __builtin_amdgcn_s_setprio(1); _Pragma("unroll") for (int m = 0; m < 4; ++m) _Pragma("unroll") for (int n = 0; n < 2; ++n) _Pragma("unroll") for (int k = 0; k < 2; ++k) \
        acc[ai][bj][m][n] = __builtin_amdgcn_mfma_f32_16x16x32_bf16(Bt[n][k], At[m][k], acc[ai][bj][m][n], 0, 0, 0); __builtin_amdgcn_s_setprio(0); } while (0)
#define PG8_WAIT_V(n) asm volatile("s_waitcnt vmcnt(" #n ")" ::: "memory")
#define PG8_WAIT_L(n) asm volatile("s_waitcnt lgkmcnt(" #n ")" ::: "memory")
#define PG8_BAR __builtin_amdgcn_s_barrier()
#define PG8_SCHED __builtin_amdgcn_sched_barrier(0)
    Unit cur, nxt; int ui = 0;
    if (!S.next(0, cur)) return;
    f32x4 acc[2][2][4][2];
#pragma unroll
    for (int a = 0; a < 2; ++a)
#pragma unroll
        for (int b = 0; b < 2; ++b)
#pragma unroll
            for (int m = 0; m < 4; ++m)
#pragma unroll
                for (int n = 0; n < 2; ++n) acc[a][b][m][n] = (f32x4){0.f, 0.f, 0.f, 0.f};
    bf16x8 At[4][2], B0[2][2], B1[2][2];
    const char* cA = (const char*)g.A + (size_t)cur.pm * tstepA; const char* cB = (const char*)g.Bt + (size_t)cur.pn * tstep;
    PG8_STAGE(PG8_SB(0, 0), cB, voffB); PG8_STAGE(PG8_SB(0, 1), cB + hstep, voffB); PG8_STAGE(PG8_SA(0, 0), cA, voffA); PG8_STAGE(PG8_SA(0, 1), cA + hstepA, voffA);
    if (wr == 1) PG8_BAR;
    PG8_WAIT_V(2); PG8_BAR;
    PG8_STAGE(PG8_SB(1, 0), cB + kstep, voffB); PG8_STAGE(PG8_SA(1, 0), cA + kstep, voffA); PG8_STAGE(PG8_SB(1, 1), cB + hstep + kstep, voffB);
    PG8_WAIT_V(6); PG8_BAR;
    for (;;) {
        const bool has_next = S.next(ui + 1, nxt);
        const char* nA = has_next ? (const char*)g.A + (size_t)nxt.pm * tstepA : cA; const char* nB = has_next ? (const char*)g.Bt + (size_t)nxt.pn * tstep : cB;
        for (int t = 0; t < nt; t += 2) {
            const bool last = (t == nt - 2);
            const char* a1 = cA + (size_t)(t + 1) * kstep;
            const char* a2 = last ? nA : cA + (size_t)(t + 2) * kstep; const char* b2 = last ? nB : cB + (size_t)(t + 2) * kstep;
            const char* a3 = a2 + kstep; const char* b3 = b2 + kstep;
            PG8_LDB(B0, 0, 0); PG8_LDB(B1, 0, 1); PG8_SCHED; PG8_LDA(At, 0, 0); PG8_STAGE(PG8_SA(1, 1), a1 + hstepA, voffA);
            PG8_WAIT_V(8); PG8_WAIT_L(0); PG8_BAR; PG8_MMA(0, 0, At, B0); PG8_MMA(0, 1, At, B1); PG8_BAR; PG8_SCHED;
            PG8_LDA(At, 0, 1); PG8_STAGE(PG8_SB(0, 0), b2, voffB); PG8_STAGE(PG8_SB(0, 1), b2 + hstep, voffB); PG8_STAGE(PG8_SA(0, 0), a2, voffA);
            PG8_WAIT_V(8); PG8_WAIT_L(0); PG8_BAR; PG8_MMA(1, 0, At, B0); PG8_MMA(1, 1, At, B1); PG8_BAR; PG8_SCHED;
            PG8_LDB(B0, 1, 0); PG8_LDB(B1, 1, 1); PG8_SCHED; PG8_LDA(At, 1, 0); PG8_STAGE(PG8_SA(0, 1), a2 + hstepA, voffA);
            PG8_WAIT_V(8); PG8_WAIT_L(0); PG8_BAR; PG8_MMA(0, 0, At, B0); PG8_MMA(0, 1, At, B1); PG8_BAR; PG8_SCHED;
            PG8_LDA(At, 1, 1); PG8_STAGE(PG8_SB(1, 0), b3, voffB); PG8_STAGE(PG8_SB(1, 1), b3 + hstep, voffB); PG8_STAGE(PG8_SA(1, 0), a3, voffA);
            PG8_WAIT_V(8); PG8_WAIT_L(0); PG8_BAR; PG8_MMA(1, 0, At, B0); PG8_MMA(1, 1, At, B1); PG8_BAR; PG8_SCHED;
        }
        if (wr == 0) PG8_BAR;
        Ep(acc, cur, wr, wc, fr, fq);
        if (!has_next) break;
#pragma unroll
        for (int a = 0; a < 2; ++a)
#pragma unroll
            for (int b = 0; b < 2; ++b)
#pragma unroll
                for (int m = 0; m < 4; ++m)
#pragma unroll
                    for (int n = 0; n < 2; ++n) acc[a][b][m][n] = (f32x4){0.f, 0.f, 0.f, 0.f};
        cur = nxt; cA = nA; cB = nB; ++ui;
        if (wr == 1) PG8_BAR;
    }
    PG8_WAIT_V(0);
    PG8_BAR;
#undef PG8_SA
#undef PG8_SB
#undef PG8_STAGE
#undef PG8_LDA
#undef PG8_LDB
#undef PG8_MMA
#undef PG8_WAIT_V
#undef PG8_WAIT_L
#undef PG8_BAR
#undef PG8_SCHED
}
}

__device__ __forceinline__ u32x4 pack8(f32x4 a, f32x4 b) { u32x4 o; o.x = pack2(a.x, a.y); o.y = pack2(a.z, a.w); o.z = pack2(b.x, b.y); o.w = pack2(b.z, b.w); return o; }
struct EpInProj { bf16_t* proj; bf16_t* qrope; bf16_t* kvp; float* small; const float2* rope; const float* dt_bias;
    __device__ __forceinline__ void operator()(int m, int n0, f32x4 a, f32x4 b) const {
        if (n0 < 2816) {
            const bool is_q = n0 < 512;
            const bool roped_seg = (n0 >= C_KSEL && n0 < C_VSEL) || (n0 >= C_KWIN && n0 < C_VWIN);
            if (roped_seg && (n0 & 32) == 0) {
                f32x4 pa, pb;
                pa.x = __shfl_xor(a.x, 16); pa.y = __shfl_xor(a.y, 16); pa.z = __shfl_xor(a.z, 16); pa.w = __shfl_xor(a.w, 16);
                pb.x = __shfl_xor(b.x, 16); pb.y = __shfl_xor(b.y, 16); pb.z = __shfl_xor(b.z, 16); pb.w = __shfl_xor(b.w, 16);
                if ((n0 & 63) < 16) {
                    const float sgn = (n0 & 8) ? 1.f : -1.f;
                    const f32x4* rp = (const f32x4*)(rope + (m & (SEQ - 1)) * 8);
                    const f32x4 c01 = rp[0], c23 = rp[1], c45 = rp[2], c67 = rp[3];
                    a.x = a.x * c01.x + sgn * pa.x * c01.y; a.y = a.y * c01.z + sgn * pa.y * c01.w;
                    a.z = a.z * c23.x + sgn * pa.z * c23.y; a.w = a.w * c23.z + sgn * pa.w * c23.w;
                    b.x = b.x * c45.x + sgn * pb.x * c45.y; b.y = b.y * c45.z + sgn * pb.y * c45.w;
                    b.z = b.z * c67.x + sgn * pb.z * c67.y; b.w = b.w * c67.z + sgn * pb.w * c67.w;
                }
            }
            const u32x4 o = pack8(a, b);
            if (!is_q && n0 < C_Z) {
                const int r = n0 - C_KCMP, seg = r >> 7, g = (r >> 6) & 1, d = r & 63, bb = m >> 13, t = m & (SEQ - 1);
                *(u32x4*)(kvp + (size_t)seg * KVP_SEG + ((size_t)(bb * 2 + g) * SEQ + t) * 64 + d) = o;
            }
            else *(u32x4*)(proj + (size_t)m * PROJ_LD + n0) = o;
        } else if (n0 < 2848) {
            const int c = n0 - 2816; f32x4 o0, o1;
            if (c < 24) { o0.x = sigmoidf(a.x); o0.y = sigmoidf(a.y); o0.z = sigmoidf(a.z); o0.w = sigmoidf(a.w); o1.x = sigmoidf(b.x); o1.y = sigmoidf(b.y); o1.z = sigmoidf(b.z); o1.w = sigmoidf(b.w); }
            else { const float* db = dt_bias; o0.x = softplusf(a.x + db[0]); o0.y = softplusf(a.y + db[1]); o0.z = softplusf(a.z + db[2]); o0.w = softplusf(a.w + db[3]);
                   o1.x = softplusf(b.x + db[4]); o1.y = softplusf(b.y + db[5]); o1.z = softplusf(b.z + db[6]); o1.w = softplusf(b.w + db[7]); }
            *(f32x4*)(small + (size_t)m * 32 + c) = o0; *(f32x4*)(small + (size_t)m * 32 + c + 4) = o1;
        }
    } };
struct EpCmpHid { bf16_t* hid; const float* bias;
    __device__ __forceinline__ void operator()(int m, int n0, f32x4 a, f32x4 b) const {
        const f32x4 b0 = *(const f32x4*)(bias + n0), b1 = *(const f32x4*)(bias + n0 + 4);
        a.x = gelu_tanh(a.x + b0.x); a.y = gelu_tanh(a.y + b0.y); a.z = gelu_tanh(a.z + b0.z); a.w = gelu_tanh(a.w + b0.w);
        b.x = gelu_tanh(b.x + b1.x); b.y = gelu_tanh(b.y + b1.y); b.z = gelu_tanh(b.z + b1.z); b.w = gelu_tanh(b.w + b1.w);
        *(u32x4*)(hid + (size_t)m * 256 + n0) = pack8(a, b);
    } };
struct EpOutProj { const float* x; const float* mod; bf16_t* x1;
    __device__ __forceinline__ void operator()(int m, int n0, f32x4 a, f32x4 b) const {
        const int bb = m >> 13;
        const f32x4 x0 = *(const f32x4*)(x + (size_t)m * DM + n0), x4 = *(const f32x4*)(x + (size_t)m * DM + n0 + 4);
        const f32x4 g0 = *(const f32x4*)(mod + bb * 6144 + 2048 + n0), g4 = *(const f32x4*)(mod + bb * 6144 + 2048 + n0 + 4);
        *(u32x4*)(x1 + (size_t)m * DM + n0) = pack8(x0 + g0 * a, x4 + g4 * b);
    } };
struct EpStoreBf16 { bf16_t* out; int ld; int pad;
    __device__ __forceinline__ void operator()(int m, int n0, f32x4 a, f32x4 b) const { *(u32x4*)(out + (size_t)m * ld + n0) = pack8(a, b); } };

__device__ __forceinline__ void d_cmp_out(const bf16_t* __restrict__ hid, const float* __restrict__ w2, bf16_t* __restrict__ out, int vb) {
    const int tid_ = tid_opaque(); const int m = vb * 8 + (tid_ >> 6), d = tid_ & 63;
    float a = 0.f;
#pragma unroll 8
    for (int j = 0; j < 256; ++j) a += bf2f(hid[(size_t)m * 256 + j]) * w2[j * 64 + d];
    out[(size_t)m * 64 + d] = f2bf(a);
}

#define KLD 80
#define NSA_OFF_KS0  0
#define NSA_OFF_VT0  10240
#define NSA_OFF_KS1  20480
#define NSA_OFF_VT1  30720
#define NSA_OFF_IMP  40960
#define NSA_OFF_SELW 74752
#define NSA_OFF_ANYW 75776
#define NSA_OFF_BL   75808
#define NSA_OFF_QS   76352
#define NSA_LDS      (76352 + 8 * 32 * KLD * 2)
#define SM_C 0.18033688011112042f

struct KVStage { u32x4 k, v; };
__device__ __forceinline__ void nsa_stage_load(KVStage& st, const bf16_t* kb, const bf16_t* vb, int tid) {
    st.k = *(const u32x4*)(kb + tid * 8); st.v = *(const u32x4*)(vb + tid * 8);
}
__device__ __forceinline__ void nsa_stage_store(bf16_t* Ks, bf16_t* Vt, int tid, const KVStage& st) {
    const int r = tid >> 3, c = tid & 7;
    *(u32x4*)(Ks + r * KLD + c * 8) = st.k;
    *(u32x4*)(Vt + r * KLD + c * 8) = st.v;
}
template <int NROW>
__device__ __forceinline__ void nsa_load_q(const bf16_t* qsrc, size_t ld, int lane, bf16_t* Qs, float qscale) {
    u32x4 r[NROW / 8];
#pragma unroll
    for (int i = 0; i < NROW / 8; ++i) { const int p = lane + 64 * i; r[i] = *(const u32x4*)(qsrc + (size_t)(p >> 3) * ld + (p & 7) * 8); }
#pragma unroll
    for (int i = 0; i < NROW / 8; ++i) {
        const int p = lane + 64 * i;
        u32x4 o;
        o.x = pack2(bflo(r[i].x) * qscale, bfhi(r[i].x) * qscale); o.y = pack2(bflo(r[i].y) * qscale, bfhi(r[i].y) * qscale);
        o.z = pack2(bflo(r[i].z) * qscale, bfhi(r[i].z) * qscale); o.w = pack2(bflo(r[i].w) * qscale, bfhi(r[i].w) * qscale);
        *(u32x4*)(Qs + (p >> 3) * KLD + (p & 7) * 8) = o;
    }
}
template <int NROW>
__device__ __forceinline__ void nsa_load_q_rope(const bf16_t* qsrc, size_t ld, const float2* __restrict__ rope, int t0, int lane, bf16_t* Qs, float qscale = 1.0f) {
    u32x4 r[NROW / 8];
#pragma unroll
    for (int i = 0; i < NROW / 8; ++i) { const int p = lane + 64 * i; r[i] = *(const u32x4*)(qsrc + (size_t)(p >> 3) * ld + (p & 7) * 8); }
#pragma unroll
    for (int i = 0; i < NROW / 8; ++i) {
        const int p = lane + 64 * i, piece = p & 7;
        u32x4 pr;
        pr.x = (unsigned)__shfl_xor((int)r[i].x, 1); pr.y = (unsigned)__shfl_xor((int)r[i].y, 1); pr.z = (unsigned)__shfl_xor((int)r[i].z, 1); pr.w = (unsigned)__shfl_xor((int)r[i].w, 1);
        if (piece < 2) {
            const float sgn = piece ? 1.f : -1.f;
            const f32x4* rp = (const f32x4*)(rope + (size_t)(t0 + (p >> 3)) * 8);
            const f32x4 c01 = rp[0], c23 = rp[1], c45 = rp[2], c67 = rp[3];
            u32x4 o;
            o.x = pack2(bflo(r[i].x) * c01.x + sgn * bflo(pr.x) * c01.y, bfhi(r[i].x) * c01.z + sgn * bfhi(pr.x) * c01.w);
            o.y = pack2(bflo(r[i].y) * c23.x + sgn * bflo(pr.y) * c23.y, bfhi(r[i].y) * c23.z + sgn * bfhi(pr.y) * c23.w);
            o.z = pack2(bflo(r[i].z) * c45.x + sgn * bflo(pr.z) * c45.y, bfhi(r[i].z) * c45.z + sgn * bfhi(pr.z) * c45.w);
            o.w = pack2(bflo(r[i].w) * c67.x + sgn * bflo(pr.w) * c67.y, bfhi(r[i].w) * c67.z + sgn * bfhi(pr.w) * c67.w);
            r[i] = o;
        }
        if (qscale != 1.0f) {
            u32x4 o;
            o.x = pack2(bflo(r[i].x) * qscale, bfhi(r[i].x) * qscale); o.y = pack2(bflo(r[i].y) * qscale, bfhi(r[i].y) * qscale);
            o.z = pack2(bflo(r[i].z) * qscale, bfhi(r[i].z) * qscale); o.w = pack2(bflo(r[i].w) * qscale, bfhi(r[i].w) * qscale);
            r[i] = o;
        }
    }
#pragma unroll
    for (int i = 0; i < NROW / 8; ++i) { const int p = lane + 64 * i; *(u32x4*)(Qs + (p >> 3) * KLD + (p & 7) * 8) = r[i]; }
}
template <int TT>
__device__ __forceinline__ void nsa_qk(const bf16_t* Ks, const bf16_t* Qs, f32x4 (&s)[4][TT], int fr, int fq, const float (&ci)[TT]) {
#pragma unroll
    for (int kt = 0; kt < 4; ++kt)
#pragma unroll
        for (int tt = 0; tt < TT; ++tt) s[kt][tt] = (f32x4){ci[tt], ci[tt], ci[tt], ci[tt]};
#pragma unroll
    for (int ks = 0; ks < 2; ++ks) {
        if (TT > 2) __builtin_amdgcn_sched_barrier(0);
        bf16x8 qf[TT];
#pragma unroll
        for (int tt = 0; tt < TT; ++tt) qf[tt] = *(const bf16x8*)(Qs + (tt * 16 + fr) * KLD + ks * 32 + fq * 8);
#pragma unroll
        for (int kt = 0; kt < 4; ++kt) {
            const bf16x8 kf = *(const bf16x8*)(Ks + (kt * 16 + fr) * KLD + ks * 32 + fq * 8);
#pragma unroll
            for (int tt = 0; tt < TT; ++tt) s[kt][tt] = __builtin_amdgcn_mfma_f32_16x16x32_bf16(kf, qf[tt], s[kt][tt], 0, 0, 0);
        }
    }
}
template <int TT>
__device__ __forceinline__ void nsa_pv(const bf16_t* Vt, const f32x4 (&p)[4][TT], f32x4 (&o)[4][TT], int fr, int fq) {
#pragma unroll
    for (int ks2 = 0; ks2 < 2; ++ks2) {
        bf16x8 pf[TT];
#pragma unroll
        for (int tt = 0; tt < TT; ++tt) {
            const f32x4 a = p[2 * ks2][tt], b = p[2 * ks2 + 1][tt];
            u32x4 w; w.x = pack2(a.x, a.y); w.y = pack2(a.z, a.w); w.z = pack2(b.x, b.y); w.w = pack2(b.z, b.w);
            pf[tt] = __builtin_bit_cast(bf16x8, w);
        }
#pragma unroll
        for (int dt = 0; dt < 4; ++dt) {
            if (TT > 2) __builtin_amdgcn_sched_barrier(0);
            typedef short s16x4 __attribute__((ext_vector_type(4)));
            const bf16_t* vp = Vt + (ks2 * 32 + 4 * fq + (fr >> 2)) * KLD + dt * 16 + 4 * (fr & 3);
            const s16x4 a0 = __builtin_amdgcn_ds_read_tr16_b64_v4i16((__attribute__((address_space(3))) s16x4*)vp);
            const s16x4 a1 = __builtin_amdgcn_ds_read_tr16_b64_v4i16((__attribute__((address_space(3))) s16x4*)(vp + 16 * KLD));
            const bf16x8 vf = (bf16x8){a0.x, a0.y, a0.z, a0.w, a1.x, a1.y, a1.z, a1.w};
#pragma unroll
            for (int tt = 0; tt < TT; ++tt) o[dt][tt] = __builtin_amdgcn_mfma_f32_16x16x32_bf16(vf, pf[tt], o[dt][tt], 0, 0, 0);
        }
    }
}
template <int MK>
__device__ __forceinline__ bool nsa_valid(int kk, int ti, int n0, int t0) {
    if (MK == 1) return kk <= ti;
    if (MK == 2) return kk > ti;
    return 16 * (n0 + kk) + 31 <= t0 + ti;
}
template <int MK, bool WITH_O, int TT>
__device__ __forceinline__ void nsa_softmax(f32x4 (&s)[4][TT], float (&m)[TT], float (&l)[TT], f32x4 (&o)[4][TT], const bool (&selb)[TT], int tib, int fq, int n0, int t0) {
#pragma unroll
    for (int tt = 0; tt < TT; ++tt) {
        const int ti = tib + tt * 16;
        float mx = -1e30f;
#pragma unroll
        for (int kt = 0; kt < 4; ++kt)
#pragma unroll
            for (int jj = 0; jj < 4; ++jj) {
                const int kk = kt * 16 + 4 * fq + jj;
                const bool v = selb[tt] && nsa_valid<MK>(kk, ti, n0, t0);
                const float sv = v ? s[kt][tt][jj] * SM_C : -1e30f;
                s[kt][tt][jj] = sv; mx = fmaxf(mx, sv);
            }
        mx = fmaxf(mx, __shfl_xor(mx, 16)); mx = fmaxf(mx, __shfl_xor(mx, 32));
        const float mn = fmaxf(m[tt], mx);
        const float alpha = __builtin_amdgcn_exp2f(m[tt] - mn);
        m[tt] = mn;
        float ls = 0.f;
#pragma unroll
        for (int kt = 0; kt < 4; ++kt)
#pragma unroll
            for (int jj = 0; jj < 4; ++jj) {
                const float sv = s[kt][tt][jj];
                const float pv = sv > -1e29f ? __builtin_amdgcn_exp2f(sv - mn) : 0.f;
                s[kt][tt][jj] = pv; ls += pv;
            }
        l[tt] = l[tt] * alpha + ls;
        if (WITH_O) {
#pragma unroll
            for (int dt = 0; dt < 4; ++dt) o[dt][tt] *= alpha;
        }
    }
}
__device__ __forceinline__ float vmax2(float a, float b) { float r; asm("v_max_f32 %0, %1, %2" : "=v"(r) : "v"(a), "v"(b)); return r; }
__device__ __forceinline__ float vmax3(float a, float b, float c) { float r; asm("v_max3_f32 %0, %1, %2, %3" : "=v"(r) : "v"(a), "v"(b), "v"(c)); return r; }
__device__ __forceinline__ float vmax2_pad(float a, float b) { float r; asm("v_max_f32 %0, %1, %2\n\ts_nop 1" : "=v"(r) : "v"(a), "v"(b)); return r; }
__device__ __forceinline__ float quad_max(float x) {
    const unsigned u = __float_as_uint(x);
    const auto r = __builtin_amdgcn_permlane16_swap(u, u, false, false);
    const float y = vmax2_pad(__uint_as_float(r[0]), __uint_as_float(r[1]));
    const unsigned v = __float_as_uint(y);
    const auto r2 = __builtin_amdgcn_permlane32_swap(v, v, false, false);
    return vmax2(__uint_as_float(r2[0]), __uint_as_float(r2[1]));
}
template <bool WITH_O = true, int TT = 2>
__device__ __forceinline__ void nsa_softmax_fast(f32x4 (&s)[4][TT], float (&m)[TT], float (&l)[TT], f32x4 (&o)[4][TT], const float (&bias)[TT]) {
    __builtin_amdgcn_sched_barrier(0);
    asm volatile("s_nop 7\n\ts_nop 7" ::: );
    __builtin_amdgcn_sched_barrier(0);
#pragma unroll
    for (int tt = 0; tt < TT; ++tt) {
        const float a0 = vmax3(s[0][tt][0], s[0][tt][1], s[0][tt][2]), a1 = vmax3(s[0][tt][3], s[1][tt][0], s[1][tt][1]), a2 = vmax3(s[1][tt][2], s[1][tt][3], s[2][tt][0]);
        const float a3 = vmax3(s[2][tt][1], s[2][tt][2], s[2][tt][3]), a4 = vmax3(s[3][tt][0], s[3][tt][1], s[3][tt][2]);
        const float mr = quad_max(vmax2_pad(vmax3(a0, a1, a2), vmax3(a3, a4, s[3][tt][3])));
        const float mx = mr * SM_C + bias[tt];
        const float mold = m[tt], mn = vmax2(mold, mx);
        m[tt] = mn;
        const float off = bias[tt] - mn;
        const f32x2 c2 = {SM_C, SM_C}, off2 = {off, off};
        f32x2 ls2 = {0.f, 0.f};
#pragma unroll
        for (int kt = 0; kt < 4; ++kt) {
            const f32x2 x0 = __builtin_elementwise_fma((f32x2){s[kt][tt][0], s[kt][tt][1]}, c2, off2), x1 = __builtin_elementwise_fma((f32x2){s[kt][tt][2], s[kt][tt][3]}, c2, off2);
            const f32x2 p0 = {__builtin_amdgcn_exp2f(x0.x), __builtin_amdgcn_exp2f(x0.y)}, p1 = {__builtin_amdgcn_exp2f(x1.x), __builtin_amdgcn_exp2f(x1.y)};
            s[kt][tt] = (f32x4){p0.x, p0.y, p1.x, p1.y};
            ls2 += p0; ls2 += p1;
        }
        const float ls = ls2.x + ls2.y;
        if (__builtin_amdgcn_ballot_w64(mn > mold) != 0ull) {
            const float alpha = __builtin_amdgcn_exp2f(mold - mn);
            l[tt] = l[tt] * alpha + ls;
            if (WITH_O) {
#pragma unroll
                for (int dt = 0; dt < 4; ++dt) o[dt][tt] *= alpha;
            }
        } else l[tt] += ls;
    }
}
template <bool WITH_O = true, int TT = 4, bool READY = false>
__device__ __forceinline__ void nsa_softmax_stale(f32x4 (&s)[4][TT], float (&m)[TT], float (&l)[TT], f32x4 (&o)[4][TT], const float (&bias)[TT]) {
    float lsv[TT];
    int odd = 0;
#pragma unroll
    for (int tt = 0; tt < TT; ++tt) {
        const float off = bias[tt] - m[tt];
        const f32x2 c2 = {SM_C, SM_C}, off2 = {off, off};
        f32x2 ls2 = {0.f, 0.f};
#pragma unroll
        for (int kt = 0; kt < 4; ++kt) {
            const f32x2 x0 = READY ? (f32x2){s[kt][tt][0], s[kt][tt][1]} : __builtin_elementwise_fma((f32x2){s[kt][tt][0], s[kt][tt][1]}, c2, off2);
            const f32x2 x1 = READY ? (f32x2){s[kt][tt][2], s[kt][tt][3]} : __builtin_elementwise_fma((f32x2){s[kt][tt][2], s[kt][tt][3]}, c2, off2);
            const f32x2 p0 = {__builtin_amdgcn_exp2f(x0.x), __builtin_amdgcn_exp2f(x0.y)}, p1 = {__builtin_amdgcn_exp2f(x1.x), __builtin_amdgcn_exp2f(x1.y)};
            s[kt][tt] = (f32x4){p0.x, p0.y, p1.x, p1.y};
            ls2 += p0; ls2 += p1;
        }
        lsv[tt] = ls2.x + ls2.y;
        l[tt] += lsv[tt];
        odd |= (int)(lsv[tt] > 1048576.0f) | ((int)(l[tt] > 0.f) & (int)(l[tt] < 9.0e-13f));
    }
    if (__builtin_amdgcn_ballot_w64(odd != 0) != 0ull) {
#pragma unroll
        for (int tt = 0; tt < TT; ++tt) {
            const float t = quad_max(l[tt]);
            int k = t > 0.f ? (int)((__float_as_uint(t) >> 23) & 0xFFu) - 127 : 0;
            k = k > 100 ? 100 : (k < -100 ? -100 : k);
            const float alpha = __uint_as_float((unsigned)(127 - k) << 23);
            m[tt] += (float)k; l[tt] *= alpha;
#pragma unroll
            for (int kt = 0; kt < 4; ++kt) s[kt][tt] *= alpha;
            if (WITH_O) {
#pragma unroll
                for (int dt = 0; dt < 4; ++dt) o[dt][tt] *= alpha;
            }
        }
    }
}
__device__ __forceinline__ void ins16(unsigned (&L)[16], unsigned x) {
#pragma unroll
    for (int i = 0; i < 16; ++i) { const unsigned hi = L[i] > x ? L[i] : x; x = L[i] > x ? x : L[i]; L[i] = hi; }
}
__device__ __forceinline__ void merge16(unsigned (&L)[16], const unsigned (&P)[16]) {
#pragma unroll
    for (int i = 0; i < 16; ++i) L[i] = L[i] > P[15 - i] ? L[i] : P[15 - i];
#pragma unroll
    for (int st = 8; st >= 1; st >>= 1)
#pragma unroll
        for (int i = 0; i < 16; ++i)
            if ((i & st) == 0) { const unsigned a = L[i], b = L[i + st]; L[i] = a > b ? a : b; L[i + st] = a > b ? b : a; }
}
__device__ __forceinline__ void sort16(unsigned (&v)[16]) {
#define CE(i, j) do { const unsigned a_ = v[i], b_ = v[j]; v[i] = a_ > b_ ? a_ : b_; v[j] = a_ > b_ ? b_ : a_; } while (0)
    CE(0, 13); CE(1, 12); CE(2, 15); CE(3, 14); CE(4, 8); CE(5, 6); CE(7, 11); CE(9, 10); CE(0, 5); CE(1, 7); CE(2, 9); CE(3, 4); CE(6, 13); CE(8, 14); CE(10, 15); CE(11, 12); CE(0, 1); CE(2, 3); CE(4, 5); CE(6, 8); CE(7, 9); CE(10, 11); CE(12, 13); CE(14, 15); CE(0, 2); CE(1, 3); CE(4, 10); CE(5, 11); CE(6, 7); CE(8, 9); CE(12, 14); CE(13, 15); CE(1, 2); CE(3, 12); CE(4, 6); CE(5, 7); CE(8, 10); CE(9, 11); CE(13, 14); CE(1, 4); CE(2, 6); CE(5, 8); CE(7, 10); CE(9, 13); CE(11, 14); CE(2, 4); CE(3, 6); CE(9, 12); CE(11, 13); CE(3, 5); CE(6, 8); CE(7, 9); CE(10, 12); CE(3, 4); CE(5, 6); CE(7, 8); CE(9, 10); CE(11, 12); CE(6, 7); CE(8, 9);
#undef CE
}
template <int TT>
__device__ __forceinline__ void nsa_scale(const f32x4 (&o)[4][TT], const float (&l)[TT], bool l_is_partial, const float* gsrc, int tib, f32x4 (&r)[4][TT], bool accum) {
#pragma unroll
    for (int tt = 0; tt < TT; ++tt) {
        float lt = l[tt];
        if (l_is_partial) { lt += __shfl_xor(lt, 16); lt += __shfl_xor(lt, 32); }
        const float gv = gsrc[(size_t)(tib + tt * 16) * 32];
        const float sc = l_is_partial ? (lt > 0.f ? gv / lt : 0.f) : gv;
#pragma unroll
        for (int dt = 0; dt < 4; ++dt) r[dt][tt] = accum ? r[dt][tt] + o[dt][tt] * sc : o[dt][tt] * sc;
    }
}
template <bool ACCUM, int TT>
__device__ __forceinline__ void nsa_store(const f32x4 (&r)[4][TT], bf16_t* obase, int tib, int fq) {
#pragma unroll
    for (int tt = 0; tt < TT; ++tt)
#pragma unroll
        for (int dp = 0; dp < 2; ++dp) {
            const f32x4 a = r[2 * dp][tt], b = r[2 * dp + 1][tt];
            float lo[4], hi[4];
#pragma unroll
            for (int c = 0; c < 4; ++c) {
                const auto q = __builtin_amdgcn_permlane16_swap(__float_as_uint(a[c]), __float_as_uint(b[c]), false, false);
                lo[c] = __uint_as_float(q[0]); hi[c] = __uint_as_float(q[1]);
            }
            bf16_t* op = obase + (size_t)(tib + tt * 16) * 512 + (2 * dp + (fq & 1)) * 16 + 8 * (fq >> 1);
            if (ACCUM) {
                const u32x4 t = *(const u32x4*)op;
                lo[0] += bflo(t.x); lo[1] += bfhi(t.x); lo[2] += bflo(t.y); lo[3] += bfhi(t.y); hi[0] += bflo(t.z); hi[1] += bfhi(t.z); hi[2] += bflo(t.w); hi[3] += bfhi(t.w);
            }
            u32x4 w; w.x = pack2(lo[0], lo[1]); w.y = pack2(lo[2], lo[3]); w.z = pack2(hi[0], hi[1]); w.w = pack2(hi[2], hi[3]);
            *(u32x4*)op = w;
        }
}
struct NsaBufs { bf16_t *Ks0, *Vt0, *Ks1, *Vt1; };
template <class SRC, class BODY>
__device__ __forceinline__ void nsa_pipeline(int n, const bf16_t* kb, const bf16_t* vb, const NsaBufs& B, int tid, SRC src, BODY body) {
    KVStage s0, s1;
    const int nl = n - 1;
    int q0 = src(0), q1 = src(1 < nl ? 1 : nl), q2 = src(2 < nl ? 2 : nl);
    nsa_stage_load(s0, kb + (size_t)q0 * 4096, vb + (size_t)q0 * 4096, tid);
    nsa_stage_load(s1, kb + (size_t)q1 * 4096, vb + (size_t)q1 * 4096, tid);
    __syncthreads();
    nsa_stage_store(B.Ks0, B.Vt0, tid, s0);
    nsa_stage_load(s0, kb + (size_t)q2 * 4096, vb + (size_t)q2 * 4096, tid);
#pragma unroll 1
    for (int i = 0; i < n; i += 2) {
        const int l3 = src(i + 3 < nl ? i + 3 : nl);
        __syncthreads();
        nsa_stage_store(B.Ks1, B.Vt1, tid, s1);
        nsa_stage_load(s1, kb + (size_t)l3 * 4096, vb + (size_t)l3 * 4096, tid);
        body(q0, B.Ks0, B.Vt0);
        const int l4 = src(i + 4 < nl ? i + 4 : nl);
        __syncthreads();
        nsa_stage_store(B.Ks0, B.Vt0, tid, s0);
        nsa_stage_load(s0, kb + (size_t)l4 * 4096, vb + (size_t)l4 * 4096, tid);
        if (i + 1 < n) body(q1, B.Ks1, B.Vt1);
        q0 = q2; q1 = l3; q2 = l4;
    }
}

__device__ __forceinline__ void d_nsa_cmp(const bf16_t* __restrict__ proj, const bf16_t* __restrict__ kc, const bf16_t* __restrict__ vc,
                                          const float* __restrict__ small, bf16_t* __restrict__ onsa, unsigned* __restrict__ selrec, int b, int g, int qt, char* lds) {
    const NsaBufs B{(bf16_t*)(lds + NSA_OFF_KS0), (bf16_t*)(lds + NSA_OFF_VT0), (bf16_t*)(lds + NSA_OFF_KS1), (bf16_t*)(lds + NSA_OFF_VT1)};
    float* imp = (float*)(lds + NSA_OFF_IMP);
    unsigned* selw = (unsigned*)(lds + NSA_OFF_SELW);
    unsigned* anyw = (unsigned*)(lds + NSA_OFF_ANYW);
    int* blist = (int*)(lds + NSA_OFF_BL);
    const int tid = tid_opaque(), lane = tid & 63, w = tid >> 6, hd = w & 3, th = w >> 2, fr = lane & 15, fq = lane >> 4;
    const int tib = th * 32 + fr;
    const size_t tok0 = (size_t)b * SEQ + (size_t)qt * 64;
    const int t0 = qt * 64;
    const float* gbase = small + tok0 * 32 + g * 12 + hd * 3;
    bf16_t* obase = onsa + tok0 * 512 + g * 256 + hd * 64;
    const bool sel_all[2] = {true, true};
    const float bias0[2] = {0.f, 0.f};

    for (int i = tid; i < 64 * 132; i += 512) imp[i] = 0.f;
    if (tid < 4) anyw[tid] = 0u;

    bf16_t* Qs = (bf16_t*)(lds + NSA_OFF_QS) + w * 32 * KLD;
    f32x4 s[4][2], o[4][2];
    float m[2], l[2];

    nsa_load_q<32>(proj + (tok0 + th * 32) * PROJ_LD + C_Q + g * 256 + hd * 64, PROJ_LD, lane, Qs, SM_C);
    const int ncb = (4 * qt + 3 + 63) >> 6;
    {
        const bf16_t* kb = kc + (size_t)(b * 2 + g) * 512 * 64;
        const bf16_t* vb = vc + (size_t)(b * 2 + g) * 512 * 64;
#pragma unroll
        for (int tt = 0; tt < 2; ++tt) { m[tt] = 0.f; l[tt] = 0.f; }
        nsa_pipeline(ncb, kb, vb, B, tid, [&](int i) { return i; }, [&](int blk_, bf16_t* Ks, bf16_t* Vt) {
            const float ci1[2] = {-m[0], -m[1]};
            nsa_qk(Ks, Qs, s, fr, fq, ci1);
            if (16 * (blk_ * 64 + 63) + 31 > t0) {
#pragma unroll
                for (int tt = 0; tt < 2; ++tt)
#pragma unroll
                    for (int kt = 0; kt < 4; ++kt)
#pragma unroll
                        for (int jj = 0; jj < 4; ++jj) if (!nsa_valid<3>(kt * 16 + 4 * fq + jj, tib + tt * 16, blk_ * 64, t0)) s[kt][tt][jj] = -3e38f;
            }
            nsa_softmax_stale<false, 2, true>(s, m, l, o, bias0);
        });
        float linv[2];
#pragma unroll
        for (int tt = 0; tt < 2; ++tt) { float lt = l[tt]; lt += __shfl_xor(lt, 16); lt += __shfl_xor(lt, 32); linv[tt] = lt > 0.f ? -m[tt] - __log2f(lt) : -1e30f; }
#pragma unroll
        for (int dt = 0; dt < 4; ++dt)
#pragma unroll
            for (int tt = 0; tt < 2; ++tt) o[dt][tt] = (f32x4){0.f, 0.f, 0.f, 0.f};
        nsa_pipeline(ncb, kb, vb, B, tid, [&](int i) { return i; }, [&](int blk_, bf16_t* Ks, bf16_t* Vt) {
            nsa_qk(Ks, Qs, s, fr, fq, linv);
            const bool full = 16 * (blk_ * 64 + 63) + 31 <= t0;
#pragma unroll
            for (int tt = 0; tt < 2; ++tt) {
                const int ti = tib + tt * 16;
                float hs[4], as[4];
#pragma unroll
                for (int kt = 0; kt < 4; ++kt) {
                    f32x4 pv;
                    if (full) {
#pragma unroll
                        for (int jj = 0; jj < 4; ++jj) pv[jj] = __builtin_amdgcn_exp2f(s[kt][tt][jj]);
                    } else {
#pragma unroll
                        for (int jj = 0; jj < 4; ++jj) {
                            const int kk = kt * 16 + 4 * fq + jj;
                            pv[jj] = nsa_valid<3>(kk, ti, blk_ * 64, t0) ? __builtin_amdgcn_exp2f(s[kt][tt][jj]) : 0.f;
                        }
                    }
                    s[kt][tt] = pv;
                    hs[kt] = 0.5f * pv[3]; as[kt] = pv[0] + pv[1] + pv[2] + hs[kt];
                }
                float r1[4];
#pragma unroll
                for (int kt = 0; kt < 4; ++kt) r1[kt] = __shfl(hs[kt], (lane + 48) & 63);
#pragma unroll
                for (int kt = 0; kt < 4; ++kt) {
                    const float recv = fq > 0 ? r1[kt] : (kt > 0 ? r1[kt - 1] : 0.f);
                    const int j = blk_ * 16 + kt * 4 + fq;
                    atomicAdd(imp + ti * 132 + (j >> 5) * 33 + (j & 31), as[kt] + recv);
                }
                if (fq == 3) { const int j1 = blk_ * 16 + 16; if (j1 < 128) atomicAdd(imp + ti * 132 + (j1 >> 5) * 33 + (j1 & 31), hs[3]); }
            }
            nsa_pv(Vt, s, o, fr, fq);
        });
        nsa_scale(o, l, false, gbase + 0, tib, o, false);
        nsa_store<false, 2>(o, obase, tib, fq);
    }
    __syncthreads();
    {
        const int ti = tid >> 3, q8 = tid & 7;
        unsigned L[16];
#pragma unroll
        for (int i = 0; i < 16; ++i) {
            const int j = q8 * 16 + i;
            const bool forced = (j == 0) || (j == qt) || (j == qt - 1);
            const float v = imp[ti * 132 + (j >> 5) * 33 + (j & 31)] + (forced ? 1e4f : 0.f) + 1e-30f;
            L[i] = (j <= qt) ? ((__float_as_uint(v) & ~0x7Fu) | (unsigned)(127 - j)) : 0u;
        }
        sort16(L);
#pragma unroll
        for (int r = 1; r <= 4; r <<= 1) {
            unsigned P[16];
#pragma unroll
            for (int i = 0; i < 16; ++i) P[i] = (unsigned)__shfl_xor((int)L[i], r);
            merge16(L, P);
        }
        if (q8 < 4) {
            unsigned word = 0u;
#pragma unroll
            for (int i = 0; i < 16; ++i) {
                const unsigned e = L[i];
                const int j = 127 - (int)(e & 0x7Fu);
                if (e != 0u && (j >> 5) == q8) word |= 1u << (j & 31);
            }
            selw[ti * 4 + q8] = word;
            atomicOr(&anyw[q8], word);
        }
    }
    __syncthreads();
    int nsel;
    {
        const unsigned a0 = anyw[0], a1 = anyw[1], a2 = anyw[2], a3 = anyw[3];
        if (tid < 128) {
            const unsigned wd = tid < 32 ? a0 : tid < 64 ? a1 : tid < 96 ? a2 : a3;
            if ((wd >> (tid & 31)) & 1u) {
                int pos = __popc(wd & ((1u << (tid & 31)) - 1u));
                if (tid >= 32) pos += __popc(a0);
                if (tid >= 64) pos += __popc(a1);
                if (tid >= 96) pos += __popc(a2);
                blist[pos] = tid;
            }
        }
        nsel = __builtin_amdgcn_readfirstlane(__popc(a0) + __popc(a1) + __popc(a2) + __popc(a3));
    }
    __syncthreads();
    if (tid < 256) selrec[tid] = selw[tid];
    if (tid < 128) selrec[256 + tid] = (unsigned)blist[tid];
    if (tid == 0) selrec[384] = (unsigned)nsel;
    __syncthreads();
}

template <bool TAIL, int TT>
__device__ __forceinline__ void nsa_mask_block(f32x4 (&s)[4][TT], int fr, int fq) {
    bool keep[4];
#pragma unroll
    for (int jj = 0; jj < 4; ++jj) keep[jj] = TAIL ? (4 * fq + jj > fr) : (4 * fq + jj <= fr);
#pragma unroll
    for (int tt = 0; tt < TT; ++tt)
#pragma unroll
        for (int kt = 0; kt < 4; ++kt) {
            const bool all_keep = TAIL ? (kt > tt) : (kt < tt), none_keep = TAIL ? (kt < tt) : (kt > tt);
            if (all_keep) continue;
#pragma unroll
            for (int jj = 0; jj < 4; ++jj) if (none_keep || !keep[jj]) s[kt][tt][jj] = -3e38f;
        }
}
template <bool TAIL, int KT0>
__device__ __forceinline__ void nsa_mask_kt2(f32x4 (&s)[4][4], int fr, int fq) {
    bool keep[4];
#pragma unroll
    for (int jj = 0; jj < 4; ++jj) keep[jj] = TAIL ? (4 * fq + jj > fr) : (4 * fq + jj <= fr);
#pragma unroll
    for (int tt = 0; tt < 4; ++tt)
#pragma unroll
        for (int kt = KT0; kt < KT0 + 2; ++kt) {
            const bool all_keep = TAIL ? (kt > tt) : (kt < tt), none_keep = TAIL ? (kt < tt) : (kt > tt);
            if (all_keep) continue;
            f32x4 v = s[kt][tt];
            v.x = (none_keep || !keep[0]) ? -3e38f : v.x; v.y = (none_keep || !keep[1]) ? -3e38f : v.y;
            v.z = (none_keep || !keep[2]) ? -3e38f : v.z; v.w = (none_keep || !keep[3]) ? -3e38f : v.w;
            s[kt][tt] = v;
        }
}
__device__ __forceinline__ void nsa_sm_item(f32x4& sv) {
    sv = (f32x4){__builtin_amdgcn_exp2f(sv[0]), __builtin_amdgcn_exp2f(sv[1]), __builtin_amdgcn_exp2f(sv[2]), __builtin_amdgcn_exp2f(sv[3])};
}
__device__ __forceinline__ void nsa_pin(f32x4& v) { float a = v[0], b = v[1], c = v[2], d = v[3]; asm volatile("" : "+v"(a), "+v"(b), "+v"(c), "+v"(d)); v = (f32x4){a, b, c, d}; }
__device__ __forceinline__ void nsa_block_split(const bf16_t* Ks, const bf16_t* Vt, const bf16_t* Qs, f32x4 (&s)[4][4], float (&m)[4], f32x4 (&lt)[4], f32x4 (&o)[4][4],
                                                const float (&bias)[4], int mk, int fr, int fq) {
    typedef short s16x4 __attribute__((ext_vector_type(4)));
    const bf16_t* kb = Ks + fr * KLD + fq * 8; const bf16_t* qb = Qs + fr * KLD + fq * 8;
    const bf16_t* vbase = Vt + (4 * fq + (fr >> 2)) * KLD + 4 * (fr & 3);
    float off[4];
#pragma unroll
    for (int tt = 0; tt < 4; ++tt) off[tt] = bias[tt] - m[tt];
    const bf16x8 ones = {0x3F80, 0x3F80, 0x3F80, 0x3F80, 0x3F80, 0x3F80, 0x3F80, 0x3F80};
#pragma unroll
    for (int kt = 0; kt < 4; ++kt)
#pragma unroll
        for (int tt = 0; tt < 4; ++tt) s[kt][tt] = (f32x4){off[tt], off[tt], off[tt], off[tt]};
#pragma unroll
    for (int ks = 0; ks < 2; ++ks) {
        bf16x8 qf[4];
#pragma unroll
        for (int tt = 0; tt < 4; ++tt) qf[tt] = *(const bf16x8*)(qb + tt * 16 * KLD + ks * 32);
#pragma unroll
        for (int kt = 0; kt < 2; ++kt) {
            const bf16x8 kf = *(const bf16x8*)(kb + kt * 16 * KLD + ks * 32);
#pragma unroll
            for (int tt = 0; tt < 4; ++tt) s[kt][tt] = __builtin_amdgcn_mfma_f32_16x16x32_bf16(kf, qf[tt], s[kt][tt], 0, 0, 0);
        }
        __builtin_amdgcn_sched_barrier(0);
    }
    if (mk == 1) nsa_mask_kt2<false, 0>(s, fr, fq); else if (mk == 2) nsa_mask_kt2<true, 0>(s, fr, fq);
    __builtin_amdgcn_sched_barrier(0);
#define NSA_QKB_GROUP(KS, KT, SKT, STT) do { \
        const bf16x8 kf_ = *(const bf16x8*)(kb + (KT) * 16 * KLD + (KS) * 32); \
        s[KT][0] = __builtin_amdgcn_mfma_f32_16x16x32_bf16(kf_, qf[0], s[KT][0], 0, 0, 0); s[KT][1] = __builtin_amdgcn_mfma_f32_16x16x32_bf16(kf_, qf[1], s[KT][1], 0, 0, 0); \
        s[KT][2] = __builtin_amdgcn_mfma_f32_16x16x32_bf16(kf_, qf[2], s[KT][2], 0, 0, 0); s[KT][3] = __builtin_amdgcn_mfma_f32_16x16x32_bf16(kf_, qf[3], s[KT][3], 0, 0, 0); \
        nsa_sm_item(s[SKT][STT]); nsa_sm_item(s[SKT][(STT) + 1]); \
        nsa_pin(s[SKT][STT]); nsa_pin(s[SKT][(STT) + 1]);        \
        __builtin_amdgcn_sched_barrier(0); } while (0)
    {
        bf16x8 qf[4];
        qf[0] = *(const bf16x8*)(qb); qf[1] = *(const bf16x8*)(qb + 16 * KLD); qf[2] = *(const bf16x8*)(qb + 32 * KLD); qf[3] = *(const bf16x8*)(qb + 48 * KLD);
        NSA_QKB_GROUP(0, 2, 0, 0);
        NSA_QKB_GROUP(0, 3, 0, 2);
        qf[0] = *(const bf16x8*)(qb + 32); qf[1] = *(const bf16x8*)(qb + 16 * KLD + 32); qf[2] = *(const bf16x8*)(qb + 32 * KLD + 32); qf[3] = *(const bf16x8*)(qb + 48 * KLD + 32);
        NSA_QKB_GROUP(1, 2, 1, 0);
        NSA_QKB_GROUP(1, 3, 1, 2);
    }
#undef NSA_QKB_GROUP
    if (mk == 1) nsa_mask_kt2<false, 2>(s, fr, fq); else if (mk == 2) nsa_mask_kt2<true, 2>(s, fr, fq);
    __builtin_amdgcn_sched_barrier(0);
    {
        bf16x8 pf[4];
#pragma unroll
        for (int tt = 0; tt < 4; ++tt) {
            const f32x4 a = s[0][tt], b = s[1][tt];
            u32x4 w; w.x = pack2(a.x, a.y); w.y = pack2(a.z, a.w); w.z = pack2(b.x, b.y); w.w = pack2(b.z, b.w);
            pf[tt] = __builtin_bit_cast(bf16x8, w);
        }
#define NSA_PVA_GROUP(DT, SKT, STT) do { \
            const bf16_t* vp_ = vbase + (DT) * 16; \
            const s16x4 a0_ = __builtin_amdgcn_ds_read_tr16_b64_v4i16((__attribute__((address_space(3))) s16x4*)vp_); \
            const s16x4 a1_ = __builtin_amdgcn_ds_read_tr16_b64_v4i16((__attribute__((address_space(3))) s16x4*)(vp_ + 16 * KLD)); \
            const bf16x8 vf_ = (bf16x8){a0_.x, a0_.y, a0_.z, a0_.w, a1_.x, a1_.y, a1_.z, a1_.w}; \
            o[DT][0] = __builtin_amdgcn_mfma_f32_16x16x32_bf16(vf_, pf[0], o[DT][0], 0, 0, 0); o[DT][1] = __builtin_amdgcn_mfma_f32_16x16x32_bf16(vf_, pf[1], o[DT][1], 0, 0, 0); \
            o[DT][2] = __builtin_amdgcn_mfma_f32_16x16x32_bf16(vf_, pf[2], o[DT][2], 0, 0, 0); o[DT][3] = __builtin_amdgcn_mfma_f32_16x16x32_bf16(vf_, pf[3], o[DT][3], 0, 0, 0); \
            nsa_sm_item(s[SKT][STT]); nsa_sm_item(s[SKT][(STT) + 1]); \
            __builtin_amdgcn_sched_barrier(0); } while (0)
#pragma unroll
        for (int tt = 0; tt < 4; ++tt) lt[tt] = __builtin_amdgcn_mfma_f32_16x16x32_bf16(ones, pf[tt], lt[tt], 0, 0, 0);
        NSA_PVA_GROUP(0, 2, 0);
        NSA_PVA_GROUP(1, 2, 2);
        NSA_PVA_GROUP(2, 3, 0);
        NSA_PVA_GROUP(3, 3, 2);
#undef NSA_PVA_GROUP
    }
    {
        bf16x8 pf[4];
#pragma unroll
        for (int tt = 0; tt < 4; ++tt) {
            const f32x4 a = s[2][tt], b = s[3][tt];
            u32x4 w; w.x = pack2(a.x, a.y); w.y = pack2(a.z, a.w); w.z = pack2(b.x, b.y); w.w = pack2(b.z, b.w);
            pf[tt] = __builtin_bit_cast(bf16x8, w);
        }
#pragma unroll
        for (int dt = 0; dt < 4; ++dt) {
            const bf16_t* vp = vbase + 32 * KLD + dt * 16;
            const s16x4 a0 = __builtin_amdgcn_ds_read_tr16_b64_v4i16((__attribute__((address_space(3))) s16x4*)vp);
            const s16x4 a1 = __builtin_amdgcn_ds_read_tr16_b64_v4i16((__attribute__((address_space(3))) s16x4*)(vp + 16 * KLD));
            const bf16x8 vf = (bf16x8){a0.x, a0.y, a0.z, a0.w, a1.x, a1.y, a1.z, a1.w};
#pragma unroll
            for (int tt = 0; tt < 4; ++tt) o[dt][tt] = __builtin_amdgcn_mfma_f32_16x16x32_bf16(vf, pf[tt], o[dt][tt], 0, 0, 0);
        }
#pragma unroll
        for (int tt = 0; tt < 4; ++tt) lt[tt] = __builtin_amdgcn_mfma_f32_16x16x32_bf16(ones, pf[tt], lt[tt], 0, 0, 0);
    }
    int odd = 0;
#pragma unroll
    for (int tt = 0; tt < 4; ++tt) odd |= (int)(lt[tt][0] > 1073741824.0f) | ((int)(lt[tt][0] > 0.f) & (int)(lt[tt][0] < 9.0e-13f));
    if (__builtin_amdgcn_ballot_w64(odd != 0) != 0ull) {
#pragma unroll
        for (int tt = 0; tt < 4; ++tt) {
            const float t = lt[tt][0];
            int k = t > 0.f ? (int)((__float_as_uint(t) >> 23) & 0xFFu) - 127 : 0;
            k = k > 100 ? 100 : (k < -100 ? -100 : k);
            const float alpha = __uint_as_float((unsigned)(127 - k) << 23);
            m[tt] += (float)k; lt[tt] *= alpha;
#pragma unroll
            for (int dt = 0; dt < 4; ++dt) o[dt][tt] *= alpha;
        }
    }
}
#define NB2_OFF_SELW 40960
#define NB2_OFF_ANYW 43008
#define NB2_OFF_BL   43040
#define NB2_OFF_QS   43776
__device__ __forceinline__ void d_nsa_attn128(const bf16_t* __restrict__ proj, const float2* __restrict__ rope, const bf16_t* __restrict__ kvp, const float* __restrict__ small, bf16_t* __restrict__ onsa,
                                              const unsigned* __restrict__ selrec_bg, int b, int g, int qt2, char* lds) {
    const NsaBufs B{(bf16_t*)(lds + 0), (bf16_t*)(lds + 20480), (bf16_t*)(lds + 10240), (bf16_t*)(lds + 30720)};
    unsigned* selw = (unsigned*)(lds + NB2_OFF_SELW);
    unsigned* anyw = (unsigned*)(lds + NB2_OFF_ANYW);
    int* blist = (int*)(lds + NB2_OFF_BL);
    const int tid = tid_opaque(), lane = tid & 63, w = tid >> 6, hd = w & 3, th = w >> 2, fr = lane & 15, fq = lane >> 4;
    const int bt = 2 * qt2 + th;
    const size_t tokw = (size_t)b * SEQ + (size_t)bt * 64;
    const float* gbase = small + tokw * 32 + g * 12 + hd * 3;
    bf16_t* obase = onsa + tokw * 512 + g * 256 + hd * 64;
    const float bias0[4] = {0.f, 0.f, 0.f, 0.f};
    bf16_t* Qs = (bf16_t*)(lds + NB2_OFF_QS) + w * 64 * KLD;
    f32x4 s[4][4], o[4][4];
    float m[4], l[4];
    f32x4 lt[4];
    selw[tid] = selrec_bg[(size_t)(2 * qt2 + (tid >> 8)) * 512 + (tid & 255)];
    if (tid < 4) anyw[tid] = 0u;
    __syncthreads();
    atomicOr(&anyw[tid & 3], selw[tid]);
    __syncthreads();
    int nsel;
    {
        const unsigned a0 = anyw[0], a1 = anyw[1], a2 = anyw[2], a3 = anyw[3];
        if (tid < 128) {
            const unsigned wd = tid < 32 ? a0 : tid < 64 ? a1 : tid < 96 ? a2 : a3;
            if ((wd >> (tid & 31)) & 1u) {
                int pos = __popc(wd & ((1u << (tid & 31)) - 1u));
                if (tid >= 32) pos += __popc(a0);
                if (tid >= 64) pos += __popc(a1);
                if (tid >= 96) pos += __popc(a2);
                blist[pos] = tid;
            }
        }
        nsel = __builtin_amdgcn_readfirstlane(__popc(a0) + __popc(a1) + __popc(a2) + __popc(a3));
    }
    __syncthreads();
    nsa_load_q_rope<64>(proj + tokw * PROJ_LD + C_Q + g * 256 + hd * 64, PROJ_LD, rope, bt * 64, lane, Qs, SM_C);
    {
        const bf16_t* kb = kvp + 2 * KVP_SEG + (size_t)(b * 2 + g) * SEQ * 64;
        const bf16_t* vb = kvp + 3 * KVP_SEG + (size_t)(b * 2 + g) * SEQ * 64;
#pragma unroll
        for (int tt = 0; tt < 4; ++tt) { m[tt] = 0.f; lt[tt] = (f32x4){0.f, 0.f, 0.f, 0.f}; }
#pragma unroll
        for (int dt = 0; dt < 4; ++dt)
#pragma unroll
            for (int tt = 0; tt < 4; ++tt) o[dt][tt] = (f32x4){0.f, 0.f, 0.f, 0.f};
        nsa_pipeline(nsel, kb, vb, B, tid, [&](int i) { return __builtin_amdgcn_readfirstlane(blist[i]); }, [&](int blk_, bf16_t* Ks, bf16_t* Vt) {
            if (blk_ > bt) return;
            bool selb[4];
#pragma unroll
            for (int tt = 0; tt < 4; ++tt) selb[tt] = (selw[(th * 64 + tt * 16 + fr) * 4 + (blk_ >> 5)] >> (blk_ & 31)) & 1u;
            float bias[4];
#pragma unroll
            for (int tt = 0; tt < 4; ++tt) bias[tt] = selb[tt] ? 0.f : -1e30f;
            nsa_block_split(Ks, Vt, Qs, s, m, lt, o, bias, blk_ == bt ? 1 : 0, fr, fq);
        });
#pragma unroll
        for (int tt = 0; tt < 4; ++tt) l[tt] = lt[tt][0] * 0.25f;
        nsa_scale(o, l, true, gbase + 1, fr, o, false);
        nsa_store<true, 4>(o, obase, fr, fq);
    }
    {
        const bf16_t* kb = kvp + 4 * KVP_SEG + (size_t)(b * 2 + g) * SEQ * 64;
        const bf16_t* vb = kvp + 5 * KVP_SEG + (size_t)(b * 2 + g) * SEQ * 64;
#pragma unroll
        for (int tt = 0; tt < 4; ++tt) { m[tt] = 0.f; lt[tt] = (f32x4){0.f, 0.f, 0.f, 0.f}; }
#pragma unroll
        for (int dt = 0; dt < 4; ++dt)
#pragma unroll
            for (int tt = 0; tt < 4; ++tt) o[dt][tt] = (f32x4){0.f, 0.f, 0.f, 0.f};
        const int j0 = 2 * qt2 >= 8 ? 2 * qt2 - 8 : 0;
        nsa_pipeline(2 * qt2 + 2 - j0, kb, vb, B, tid, [&](int i) { return j0 + i; }, [&](int blk_, bf16_t* Ks, bf16_t* Vt) {
            if (blk_ > bt || blk_ < bt - 8) return;
            nsa_block_split(Ks, Vt, Qs, s, m, lt, o, bias0, blk_ == bt ? 1 : (blk_ == bt - 8 ? 2 : 0), fr, fq);
        });
#pragma unroll
        for (int tt = 0; tt < 4; ++tt) l[tt] = lt[tt][0] * 0.25f;
        nsa_scale(o, l, true, gbase + 2, fr, o, false);
        nsa_store<true, 4>(o, obase, fr, fq);
    }
    __syncthreads();
}

#define SSD_P 136
#define S3_XST 0
#define S3_BC  69632
#define S3_CC  104448
#define S3_ACS 139264
#define S3_DT  141312
#define S3_END 143360

__device__ __forceinline__ void ssd_acs(const float* __restrict__ small, const float* __restrict__ a_log, size_t tok0, int g, float* acs, float* dtl, int tid) {
    const int w = tid >> 6, lane = tid & 63, hh = 4 * g + (w & 3);
    if (w < 4) {
        const float a = -__expf(a_log[hh]);
        const float d0 = small[(tok0 + 2 * lane) * 32 + 24 + hh], d1 = small[(tok0 + 2 * lane + 1) * 32 + 24 + hh];
        const float s0 = d0 * a, s1 = s0 + d1 * a;
        float tot = s1;
#pragma unroll
        for (int off = 1; off < 64; off <<= 1) { const float t = __shfl_up(tot, off); if (lane >= off) tot += t; }
        const float excl = tot - s1;
        acs[w * 128 + 2 * lane] = excl + s0; acs[w * 128 + 2 * lane + 1] = excl + s1;
        dtl[w * 128 + 2 * lane] = d0; dtl[w * 128 + 2 * lane + 1] = d1;
    }
}
struct ConvCh { float w0, w1, w2, w3, bias, h0, h1, h2; };
__device__ __forceinline__ void conv_init(ConvCh& cc, const float* __restrict__ conv_w, const float* __restrict__ conv_b, int ch, const bf16_t* pb, int c) {
    cc.w0 = conv_w[ch]; cc.w1 = conv_w[1024 + ch]; cc.w2 = conv_w[2048 + ch]; cc.w3 = conv_w[3072 + ch]; cc.bias = conv_b[ch];
    if (c > 0) { cc.h0 = bf2f(pb[-3 * PROJ_LD]); cc.h1 = bf2f(pb[-2 * PROJ_LD]); cc.h2 = bf2f(pb[-1 * PROJ_LD]); } else { cc.h0 = 0.f; cc.h1 = 0.f; cc.h2 = 0.f; }
}
__device__ __forceinline__ float conv_step(ConvCh& cc, float x) {
    const float v = cc.bias + cc.w0 * cc.h0 + cc.w1 * cc.h1 + cc.w2 * cc.h2 + cc.w3 * x;
    cc.h0 = cc.h1; cc.h1 = cc.h2; cc.h2 = x;
    return silu(v);
}

__device__ __forceinline__ void d_ssd_states(const bf16_t* __restrict__ proj, const float* __restrict__ small, const float* __restrict__ conv_w, const float* __restrict__ conv_b,
                                             const float* __restrict__ a_log, float* __restrict__ states, float* __restrict__ cdec, int item, char* lds) {
    const int tid = tid_opaque(), lane = tid & 63, w = tid >> 6, fr = lane & 15, fq = lane >> 4;
    const int b = item >> 7, c = (item >> 1) & 63, g = item & 1;
    bf16_t* XwT = (bf16_t*)(lds + S3_XST); bf16_t* BcT = (bf16_t*)(lds + S3_BC);
    float* acs = (float*)(lds + S3_ACS); float* dtl = (float*)(lds + S3_DT);
    const size_t tok0 = (size_t)b * SEQ + (size_t)c * 128;
    ssd_acs(small, a_log, tok0, g, acs, dtl, tid);
    __syncthreads();
    if (tid < 384) {
        const bool isx = tid < 256;
        const int ch = isx ? g * 256 + tid : 512 + g * 128 + (tid - 256);
        const bf16_t* px = proj + tok0 * PROJ_LD + C_XBC + ch;
        ConvCh cx; conv_init(cx, conv_w, conv_b, ch, px, c);
        const int hw = w & 3;
        const float alast = acs[hw * 128 + 127];
        bf16_t* dst = isx ? XwT + tid * SSD_P : BcT + (tid - 256) * SSD_P;
        for (int l0 = 0; l0 < 128; l0 += 32) {
            float rx[32];
#pragma unroll
            for (int i = 0; i < 32; ++i) rx[i] = bf2f(px[(size_t)(l0 + i) * PROJ_LD]);
#pragma unroll
            for (int i8 = 0; i8 < 4; ++i8) {
                float ox[8];
#pragma unroll
                for (int i = 0; i < 8; ++i) {
                    const int l = l0 + i8 * 8 + i;
                    const float v = conv_step(cx, rx[i8 * 8 + i]);
                    ox[i] = isx ? v * dtl[hw * 128 + l] * __expf(alast - acs[hw * 128 + l]) : v;
                }
                u32x4 o; o.x = pack2(ox[0], ox[1]); o.y = pack2(ox[2], ox[3]); o.z = pack2(ox[4], ox[5]); o.w = pack2(ox[6], ox[7]);
                *(u32x4*)(dst + l0 + i8 * 8) = o;
            }
        }
    }
    __syncthreads();
    {
        const int hw = w & 3, nh = w >> 2;
        f32x4 acc[4][4];
#pragma unroll
        for (int pt = 0; pt < 4; ++pt)
#pragma unroll
            for (int nt = 0; nt < 4; ++nt) acc[pt][nt] = (f32x4){0.f, 0.f, 0.f, 0.f};
#pragma unroll 1
        for (int ks = 0; ks < 4; ++ks) {
            bf16x8 af[4], bfr[4];
#pragma unroll
            for (int pt = 0; pt < 4; ++pt) af[pt] = *(const bf16x8*)(XwT + (hw * 64 + pt * 16 + fr) * SSD_P + ks * 32 + fq * 8);
#pragma unroll
            for (int nt = 0; nt < 4; ++nt) bfr[nt] = *(const bf16x8*)(BcT + ((nh * 4 + nt) * 16 + fr) * SSD_P + ks * 32 + fq * 8);
#pragma unroll
            for (int pt = 0; pt < 4; ++pt)
#pragma unroll
                for (int nt = 0; nt < 4; ++nt) acc[pt][nt] = __builtin_amdgcn_mfma_f32_16x16x32_bf16(bfr[nt], af[pt], acc[pt][nt], 0, 0, 0);
        }
        const int hh = 4 * g + hw;
        float* sp = states + ((size_t)((b * 64 + c) * 8 + hh)) * 8192;
#pragma unroll
        for (int pt = 0; pt < 4; ++pt)
#pragma unroll
            for (int nt = 0; nt < 4; ++nt)
                *(f32x4*)(sp + (pt * 16 + fr) * 128 + (nh * 4 + nt) * 16 + 4 * fq) = acc[pt][nt];
        if (lane == 0 && nh == 0) cdec[(b * 64 + c) * 8 + hh] = __expf(acs[hw * 128 + 127]);
    }
    __syncthreads();
}

__device__ __forceinline__ void d_ssd_scan(const float* __restrict__ states, const float* __restrict__ cdec, bf16_t* __restrict__ prev, int vb) {
    const int bh = vb >> 1, b = bh >> 3, hh = bh & 7;
    const size_t e0 = (size_t)((vb & 1) * 512 + tid_opaque()) * 8;
    f32x4 h0 = (f32x4){0.f, 0.f, 0.f, 0.f}, h1 = h0;
#pragma unroll 8
    for (int c = 0; c < 64; ++c) {
        const size_t base = ((size_t)((b * 64 + c) * 8 + hh)) * 8192 + e0;
        const f32x4 s0 = *(const f32x4*)(states + base), s1 = *(const f32x4*)(states + base + 4);
        const float d = cdec[(b * 64 + c) * 8 + hh];
        u32x4 o; o.x = pack2(h0.x, h0.y); o.y = pack2(h0.z, h0.w); o.z = pack2(h1.x, h1.y); o.w = pack2(h1.z, h1.w);
        *(u32x4*)(prev + base) = o;
        h0 = h0 * d + s0; h1 = h1 * d + s1;
    }
}

__device__ __forceinline__ void d_ssd_out(const bf16_t* __restrict__ proj, const float* __restrict__ small, const float* __restrict__ conv_w, const float* __restrict__ conv_b,
                                          const float* __restrict__ a_log, const float* __restrict__ d_skip, const bf16_t* __restrict__ prev, bf16_t* __restrict__ yssd, int item, char* lds) {
    const int tid = tid_opaque(), lane = tid & 63, w = tid >> 6, fr = lane & 15, fq = lane >> 4;
    const int b = item >> 7, c = (item >> 1) & 63, g = item & 1;
    bf16_t* XsT = (bf16_t*)(lds + S3_XST); bf16_t* Bc = (bf16_t*)(lds + S3_BC); bf16_t* Cc = (bf16_t*)(lds + S3_CC);
    float* acs = (float*)(lds + S3_ACS); float* dtl = (float*)(lds + S3_DT);
    const size_t tok0 = (size_t)b * SEQ + (size_t)c * 128;
    ssd_acs(small, a_log, tok0, g, acs, dtl, tid);
    {
        const int mode = tid < 256 ? 0 : (tid < 384 ? 1 : 2);
        const int ch = mode == 0 ? g * 256 + tid : (mode == 1 ? 512 + g * 128 + (tid - 256) : 768 + g * 128 + (tid - 384));
        const bf16_t* px = proj + tok0 * PROJ_LD + C_XBC + ch;
        ConvCh cx; conv_init(cx, conv_w, conv_b, ch, px, c);
        bf16_t* dstx = XsT + (tid & 255) * SSD_P;
        bf16_t* dstbc = (mode == 1 ? Bc : Cc) + (tid & 127);
        for (int l0 = 0; l0 < 128; l0 += 64) {
            float rx[64];
#pragma unroll
            for (int i = 0; i < 64; ++i) rx[i] = bf2f(px[(size_t)(l0 + i) * PROJ_LD]);
#pragma unroll
            for (int i8 = 0; i8 < 8; ++i8) {
                float ox[8];
#pragma unroll
                for (int i = 0; i < 8; ++i) ox[i] = conv_step(cx, rx[i8 * 8 + i]);
                if (mode == 0) {
                    u32x4 o; o.x = pack2(ox[0], ox[1]); o.y = pack2(ox[2], ox[3]); o.z = pack2(ox[4], ox[5]); o.w = pack2(ox[6], ox[7]);
                    *(u32x4*)(dstx + l0 + i8 * 8) = o;
                } else {
#pragma unroll
                    for (int i = 0; i < 8; ++i) dstbc[(l0 + i8 * 8 + i) * SSD_P] = f2bf(ox[i]);
                }
            }
        }
    }
    __syncthreads();
    const int hw = w & 3, lh = w >> 2, hh = 4 * g + hw;
    const float dsk = d_skip[hh];
    const bf16_t* pp = prev + ((size_t)((b * 64 + c) * 8 + hh)) * 8192;
    bf16x8 pf[4][4];
#pragma unroll
    for (int pt = 0; pt < 4; ++pt)
#pragma unroll
        for (int ks = 0; ks < 4; ++ks) pf[pt][ks] = *(const bf16x8*)(pp + (pt * 16 + fr) * 128 + ks * 32 + fq * 8);
#pragma unroll 1
    for (int lk = 0; lk < 4; ++lk) {
        const int lt = lh + 2 * lk;
        const int l = lt * 16 + fr;
        const float acs_l = acs[hw * 128 + l];
        u32x4 zq[2];
#pragma unroll
        for (int pp = 0; pp < 2; ++pp) zq[pp] = *(const u32x4*)(proj + (tok0 + l) * PROJ_LD + C_Z + hh * 64 + (2 * pp + (fq & 1)) * 16 + 8 * (fq >> 1));
        bf16x8 cf[4];
#pragma unroll
        for (int ks = 0; ks < 4; ++ks) cf[ks] = *(const bf16x8*)(Cc + (lt * 16 + fr) * SSD_P + ks * 32 + fq * 8);
        f32x4 y[4], yo[4];
#pragma unroll
        for (int pt = 0; pt < 4; ++pt) { y[pt] = (f32x4){0.f, 0.f, 0.f, 0.f}; yo[pt] = (f32x4){0.f, 0.f, 0.f, 0.f}; }
#pragma unroll
        for (int ks2 = 0; ks2 < 4; ++ks2) {
            if (2 * ks2 <= lt) {
                f32x4 cb[2];
#pragma unroll
                for (int h2 = 0; h2 < 2; ++h2) {
                    const int st = 2 * ks2 + h2;
                    cb[h2] = (f32x4){0.f, 0.f, 0.f, 0.f};
                    if (st <= lt) {
#pragma unroll
                        for (int ks = 0; ks < 4; ++ks)
                            cb[h2] = __builtin_amdgcn_mfma_f32_16x16x32_bf16(*(const bf16x8*)(Bc + (st * 16 + fr) * SSD_P + ks * 32 + fq * 8), cf[ks], cb[h2], 0, 0, 0);
#pragma unroll
                        for (int jj = 0; jj < 4; ++jj) {
                            const int sidx = st * 16 + 4 * fq + jj;
                            cb[h2][jj] = (sidx <= l) ? cb[h2][jj] * __expf(acs_l - acs[hw * 128 + sidx]) * dtl[hw * 128 + sidx] : 0.f;
                        }
                    }
                }
                u32x4 wv; wv.x = pack2(cb[0].x, cb[0].y); wv.y = pack2(cb[0].z, cb[0].w); wv.z = pack2(cb[1].x, cb[1].y); wv.w = pack2(cb[1].z, cb[1].w);
                const bf16x8 mf = __builtin_bit_cast(bf16x8, wv);
#pragma unroll
                for (int pt = 0; pt < 4; ++pt) {
                    const bf16_t* xp = XsT + (hw * 64 + pt * 16 + fr) * SSD_P + ks2 * 32 + 4 * fq;
                    const u32x2 a0 = *(const u32x2*)xp, a1 = *(const u32x2*)(xp + 16);
                    u32x4 xv; xv.x = a0.x; xv.y = a0.y; xv.z = a1.x; xv.w = a1.y;
                    y[pt] = __builtin_amdgcn_mfma_f32_16x16x32_bf16(__builtin_bit_cast(bf16x8, xv), mf, y[pt], 0, 0, 0);
                }
            }
            __builtin_amdgcn_sched_barrier(0);
        }
        __builtin_amdgcn_sched_barrier(0);
#pragma unroll
        for (int pt = 0; pt < 4; ++pt)
#pragma unroll
            for (int ks = 0; ks < 4; ++ks) yo[pt] = __builtin_amdgcn_mfma_f32_16x16x32_bf16(pf[pt][ks], cf[ks], yo[pt], 0, 0, 0);
        __builtin_amdgcn_sched_barrier(0);
        const float el = __expf(acs_l);
        f32x4 pre[4];
#pragma unroll
        for (int pt = 0; pt < 4; ++pt) {
            const int p0 = pt * 16 + 4 * fq;
            const bf16_t* xq = XsT + (hw * 64 + p0) * SSD_P + l;
            const float x0 = bf2f(xq[0]), x1 = bf2f(xq[SSD_P]), x2 = bf2f(xq[2 * SSD_P]), x3 = bf2f(xq[3 * SSD_P]);
            pre[pt] = (f32x4){y[pt].x + el * yo[pt].x + dsk * x0, y[pt].y + el * yo[pt].y + dsk * x1, y[pt].z + el * yo[pt].z + dsk * x2, y[pt].w + el * yo[pt].w + dsk * x3};
        }
#pragma unroll
        for (int pp = 0; pp < 2; ++pp) {
            float v8[8];
#pragma unroll
            for (int cc = 0; cc < 4; ++cc) {
                const auto q = __builtin_amdgcn_permlane16_swap(__float_as_uint(pre[2 * pp][cc]), __float_as_uint(pre[2 * pp + 1][cc]), false, false);
                v8[cc] = __uint_as_float(q[0]); v8[4 + cc] = __uint_as_float(q[1]);
            }
            const u32x4 zz = zq[pp];
            u32x4 ob;
            ob.x = pack2(v8[0] * silu(bflo(zz.x)), v8[1] * silu(bfhi(zz.x))); ob.y = pack2(v8[2] * silu(bflo(zz.y)), v8[3] * silu(bfhi(zz.y)));
            ob.z = pack2(v8[4] * silu(bflo(zz.z)), v8[5] * silu(bfhi(zz.z))); ob.w = pack2(v8[6] * silu(bflo(zz.w)), v8[7] * silu(bfhi(zz.w)));
            *(u32x4*)(yssd + (tok0 + l) * 512 + hh * 64 + (2 * pp + (fq & 1)) * 16 + 8 * (fq >> 1)) = ob;
        }
    }
    __syncthreads();
}

__device__ __forceinline__ void d_mix_prep(const bf16_t* __restrict__ onsa, const bf16_t* __restrict__ yssd, const float* __restrict__ nsa_w, const float* __restrict__ ssd_w, bf16_t* __restrict__ A2, int vb) {
    const int tid_ = tid_opaque(); const int lane = tid_ & 63, wid = tid_ >> 6;
    const size_t row0 = (size_t)vb * 32 + wid * 4;
    f32x4 a[4][2], y[4][2];
#pragma unroll
    for (int r = 0; r < 4; ++r) {
        const u32x4 aa = *(const u32x4*)(onsa + (row0 + r) * 512 + lane * 8);
        a[r][0] = (f32x4){bflo(aa.x), bfhi(aa.x), bflo(aa.y), bfhi(aa.y)}; a[r][1] = (f32x4){bflo(aa.z), bfhi(aa.z), bflo(aa.w), bfhi(aa.w)};
        const u32x4 yy = *(const u32x4*)(yssd + (row0 + r) * 512 + lane * 8);
        y[r][0] = (f32x4){bflo(yy.x), bfhi(yy.x), bflo(yy.y), bfhi(yy.y)}; y[r][1] = (f32x4){bflo(yy.z), bfhi(yy.z), bflo(yy.w), bfhi(yy.w)};
    }
    float ra[4], ry[4];
#pragma unroll
    for (int r = 0; r < 4; ++r) {
        float s0 = 0.f, s1 = 0.f;
#pragma unroll
        for (int k = 0; k < 2; ++k) {
            s0 += a[r][k].x * a[r][k].x + a[r][k].y * a[r][k].y + a[r][k].z * a[r][k].z + a[r][k].w * a[r][k].w;
            s1 += y[r][k].x * y[r][k].x + y[r][k].y * y[r][k].y + y[r][k].z * y[r][k].z + y[r][k].w * y[r][k].w;
        }
        ra[r] = rsqrtf(wave_sum(s0) * (1.0f / 512) + EPS); ry[r] = rsqrtf(wave_sum(s1) * (1.0f / 512) + EPS);
    }
    const int col = lane * 8;
    const f32x4 wn0 = *(const f32x4*)(nsa_w + col), wn1 = *(const f32x4*)(nsa_w + col + 4), ws0 = *(const f32x4*)(ssd_w + col), ws1 = *(const f32x4*)(ssd_w + col + 4);
#pragma unroll
    for (int r = 0; r < 4; ++r) {
        const f32x4 p0 = a[r][0] * ra[r] * wn0, p1 = a[r][1] * ra[r] * wn1, q0 = y[r][0] * ry[r] * ws0, q1 = y[r][1] * ry[r] * ws1;
        u32x4 o; o.x = pack2(p0.x, p0.y); o.y = pack2(p0.z, p0.w); o.z = pack2(p1.x, p1.y); o.w = pack2(p1.z, p1.w);
        *(u32x4*)(A2 + (row0 + r) * DM + col) = o;
        u32x4 o2; o2.x = pack2(q0.x, q0.y); o2.y = pack2(q0.z, q0.w); o2.z = pack2(q1.x, q1.y); o2.w = pack2(q1.z, q1.w);
        *(u32x4*)(A2 + (row0 + r) * DM + 512 + col) = o2;
    }
}

__device__ __forceinline__ void d_quant_rows(const float* __restrict__ src, unsigned char* __restrict__ dst, float* __restrict__ scale, int vb) {
    const int tid_ = tid_opaque(); const int lane = tid_ & 63, row = vb * 8 + (tid_ >> 6);
    const float* rp = src + (size_t)row * DM + lane * 16;
    f32x4 v[4];
#pragma unroll
    for (int i = 0; i < 4; ++i) v[i] = *(const f32x4*)(rp + i * 4);
    float mx = 0.f;
#pragma unroll
    for (int i = 0; i < 4; ++i) mx = fmaxf(mx, fmaxf(fmaxf(fabsf(v[i].x), fabsf(v[i].y)), fmaxf(fabsf(v[i].z), fabsf(v[i].w))));
    mx = wave_max(mx);
    const float sc = mx > 0.f ? mx * (1.0f / 6.0f) : 1.0f;
    const float inv = 1.0f / sc;
    u32x2 o;
#pragma unroll
    for (int h = 0; h < 2; ++h) {
        unsigned wv = 0u;
        wv = __builtin_amdgcn_cvt_scalef32_pk_fp4_f32(wv, v[2 * h].x * inv, v[2 * h].y * inv, 1.0f, 0);
        wv = __builtin_amdgcn_cvt_scalef32_pk_fp4_f32(wv, v[2 * h].z * inv, v[2 * h].w * inv, 1.0f, 1);
        wv = __builtin_amdgcn_cvt_scalef32_pk_fp4_f32(wv, v[2 * h + 1].x * inv, v[2 * h + 1].y * inv, 1.0f, 2);
        wv = __builtin_amdgcn_cvt_scalef32_pk_fp4_f32(wv, v[2 * h + 1].z * inv, v[2 * h + 1].w * inv, 1.0f, 3);
        o[h] = wv;
    }
    *(u32x2*)(dst + (size_t)row * 512 + lane * 8) = o;
    if (lane == 0) scale[row] = sc;
}

__device__ __forceinline__ unsigned mono_u(float f) { const unsigned u = __float_as_uint(f); return u ^ ((unsigned)((int)u >> 31) | 0x80000000u); }
__device__ __forceinline__ float unmono_f(unsigned m) { return __uint_as_float(m ^ (~(unsigned)((int)m >> 31) | 0x80000000u)); }
#define RT_LI 65536
__device__ __forceinline__ void d_peer_stage_keys(const bf16_t* __restrict__ subk, int h, char* lds) {
    const int tid = tid_opaque();
    u32x4 r[8];
#pragma unroll
    for (int i = 0; i < 8; ++i) { const int p = tid + 512 * i; r[i] = *(const u32x4*)(subk + (size_t)h * 32768 + (size_t)p * 8); }
#pragma unroll
    for (int i = 0; i < 8; ++i) { const int p = tid + 512 * i, row = p >> 4, ch = p & 15; *(u32x4*)(lds + row * 256 + ((ch ^ (row & 15)) << 4)) = r[i]; }
}
__device__ __forceinline__ void d_peer_route(const bf16_t* __restrict__ qp, const float* __restrict__ qnw, int* __restrict__ eidx, float* __restrict__ gate,
                                             int tile, int h, char* lds) {
    const int tid = tid_opaque(), lane = tid & 63, w = tid >> 6, fr = lane & 15, fq = lane >> 4;
    const size_t tok = (size_t)tile * 128 + w * 16 + fr;
    bf16x8 qf[2][4];
    {
        const bf16_t* qrow = qp + tok * 2048 + h * 256;
        u32x4 raw[2][4];
        float ss = 0.f;
#pragma unroll
        for (int k = 0; k < 2; ++k)
#pragma unroll
            for (int ks = 0; ks < 4; ++ks) {
                const u32x4 r = *(const u32x4*)(qrow + k * 128 + ks * 32 + fq * 8);
                raw[k][ks] = r;
                ss += bflo(r.x) * bflo(r.x) + bfhi(r.x) * bfhi(r.x) + bflo(r.y) * bflo(r.y) + bfhi(r.y) * bfhi(r.y)
                    + bflo(r.z) * bflo(r.z) + bfhi(r.z) * bfhi(r.z) + bflo(r.w) * bflo(r.w) + bfhi(r.w) * bfhi(r.w);
            }
        ss += __shfl_xor(ss, 16); ss += __shfl_xor(ss, 32);
        const float rs = rsqrtf(ss * (1.0f / 256) + EPS);
#pragma unroll
        for (int k = 0; k < 2; ++k)
#pragma unroll
            for (int ks = 0; ks < 4; ++ks) {
                const float* wp = qnw + k * 128 + ks * 32 + fq * 8;
                const f32x4 w0 = *(const f32x4*)wp, w1 = *(const f32x4*)(wp + 4);
                const u32x4 r = raw[k][ks];
                u32x4 o;
                o.x = pack2(bflo(r.x) * rs * w0.x, bfhi(r.x) * rs * w0.y); o.y = pack2(bflo(r.y) * rs * w0.z, bfhi(r.y) * rs * w0.w);
                o.z = pack2(bflo(r.z) * rs * w1.x, bfhi(r.z) * rs * w1.y); o.w = pack2(bflo(r.w) * rs * w1.z, bfhi(r.w) * rs * w1.w);
                qf[k][ks] = __builtin_bit_cast(bf16x8, o);
            }
    }
    unsigned L[2][16];
#pragma unroll
    for (int k = 0; k < 2; ++k) {
        f32x4 acc[8];
#pragma unroll
        for (int kt = 0; kt < 8; ++kt) acc[kt] = (f32x4){0.f, 0.f, 0.f, 0.f};
#pragma unroll
        for (int kt = 0; kt < 8; ++kt)
#pragma unroll
            for (int ks = 0; ks < 4; ++ks) {
                const int row = k * 128 + kt * 16 + fr;
                const bf16x8 af = *(const bf16x8*)(lds + row * 256 + (((ks * 4 + fq) ^ fr) << 4));
                acc[kt] = __builtin_amdgcn_mfma_f32_16x16x32_bf16(af, qf[k][ks], acc[kt], 0, 0, 0);
            }
        {
            unsigned H[16];
#pragma unroll
            for (int kt = 0; kt < 4; ++kt)
#pragma unroll
                for (int jj = 0; jj < 4; ++jj) {
                    L[k][kt * 4 + jj] = (mono_u(acc[kt][jj]) & ~0x7Fu) | (unsigned)(127 - (kt * 16 + 4 * fq + jj));
                    H[kt * 4 + jj] = (mono_u(acc[kt + 4][jj]) & ~0x7Fu) | (unsigned)(127 - ((kt + 4) * 16 + 4 * fq + jj));
                }
            sort16(L[k]); sort16(H);
            merge16(L[k], H);
        }
#pragma unroll
        for (int r = 16; r <= 32; r <<= 1) {
            unsigned P[16];
#pragma unroll
            for (int i = 0; i < 16; ++i) P[i] = (unsigned)__shfl_xor((int)L[k][i], r);
            merge16(L[k], P);
        }
    }
    unsigned char* li = (unsigned char*)lds + RT_LI + w * 512 + fr * 32;
    if (fq == 0) {
#pragma unroll
        for (int a = 0; a < 16; ++a) { li[a] = (unsigned char)(127 - (L[0][a] & 0x7Fu)); li[16 + a] = (unsigned char)(127 - (L[1][a] & 0x7Fu)); }
    }
    float fa[16], fb[16];
#pragma unroll
    for (int a = 0; a < 16; ++a) { fa[a] = unmono_f(L[0][a] & ~0x7Fu); fb[a] = unmono_f(L[1][a] & ~0x7Fu); }
    unsigned T[16];
#define CAND(a, b) ((mono_u(fa[a] + fb[b]) & ~0xFFu) | (unsigned)(255 - ((a) * 16 + (b))))
#pragma unroll
    for (int bb = 0; bb < 16; ++bb) T[bb] = CAND(0, bb);
    {
        unsigned Bq[16];
#pragma unroll
        for (int bb = 0; bb < 8; ++bb) Bq[bb] = CAND(1, bb);
        Bq[8] = CAND(4, 0); Bq[9] = CAND(4, 1); Bq[10] = CAND(4, 2); Bq[11] = CAND(5, 0); Bq[12] = CAND(5, 1); Bq[13] = CAND(6, 0); Bq[14] = CAND(6, 1); Bq[15] = CAND(8, 0);
        sort16(Bq); merge16(T, Bq);
    }
    {
        unsigned Cq[16];
#pragma unroll
        for (int bb = 0; bb < 5; ++bb) Cq[bb] = CAND(2, bb);
#pragma unroll
        for (int bb = 0; bb < 4; ++bb) Cq[5 + bb] = CAND(3, bb);
        Cq[9] = CAND(7, 0); Cq[10] = CAND(7, 1); Cq[11] = CAND(9, 0); Cq[12] = CAND(10, 0); Cq[13] = CAND(11, 0); Cq[14] = CAND(12, 0); Cq[15] = CAND(13, 0);
        sort16(Cq); merge16(T, Cq);
    }
    ins16(T, CAND(14, 0)); ins16(T, CAND(15, 0));
#undef CAND
    __syncthreads();
    const float s0 = unmono_f(T[0] & ~0xFFu);
    float pe[16]; float sum = 0.f;
#pragma unroll
    for (int i = 0; i < 16; ++i) { pe[i] = __expf(unmono_f(T[i] & ~0xFFu) - s0); sum += pe[i]; }
    const float inv = 1.0f / sum;
    unsigned cod[4] = {0u, 0u, 0u, 0u}; float gv[4] = {0.f, 0.f, 0.f, 0.f};
#pragma unroll
    for (int i = 0; i < 16; ++i) if ((i >> 2) == fq) { cod[i & 3] = 255u - (T[i] & 0xFFu); gv[i & 3] = pe[i] * inv; }
    int ev[4];
#pragma unroll
    for (int i = 0; i < 4; ++i) ev[i] = (int)li[cod[i] >> 4] * 128 + (int)li[16 + (cod[i] & 15u)];
    *(u32x4*)(eidx + (tok * 8 + h) * 16 + fq * 4) = (u32x4){(unsigned)ev[0], (unsigned)ev[1], (unsigned)ev[2], (unsigned)ev[3]};
    *(f32x4*)(gate + (tok * 8 + h) * 16 + fq * 4) = (f32x4){gv[0], gv[1], gv[2], gv[3]};
    __syncthreads();
}

__device__ __forceinline__ void cvt16(const u32x2 q, f32x2 (&f)[8]) {
#pragma unroll
    for (int i = 0; i < 2; ++i) {
        f[4 * i] = __builtin_amdgcn_cvt_scalef32_pk_f32_fp4(q[i], 1.0f, 0); f[4 * i + 1] = __builtin_amdgcn_cvt_scalef32_pk_f32_fp4(q[i], 1.0f, 1);
        f[4 * i + 2] = __builtin_amdgcn_cvt_scalef32_pk_f32_fp4(q[i], 1.0f, 2); f[4 * i + 3] = __builtin_amdgcn_cvt_scalef32_pk_f32_fp4(q[i], 1.0f, 3);
    }
}
typedef int v8i __attribute__((ext_vector_type(8)));
__device__ __forceinline__ void px_issue_down(const unsigned char* __restrict__ down4, int esel, int sb, int fr, int kq, u32x4 (&d)[8]) {
    const int em = __shfl(esel, sb + fr);
    const unsigned char* ab = down4 + (size_t)em * 512 + kq * 16;
#pragma unroll
    for (int k = 0; k < 8; ++k) d[k] = *(const u32x4*)(ab + k * 64);
}
__device__ __forceinline__ void px_issue_up(const unsigned char* __restrict__ up4, int esel, int sb, int lane, u32x4 (&u)[8]) {
    unsigned l16 = ((unsigned)lane & 31u) * 16u;
    asm volatile("" : "+v"(l16));
    const bool lo = lane < 32;
#pragma unroll
    for (int j = 0; j < 8; ++j) {
        const unsigned ea = (unsigned)__builtin_amdgcn_readlane(esel, sb + 2 * j), eb = (unsigned)__builtin_amdgcn_readlane(esel, sb + 2 * j + 1);
        const unsigned voff = ((lo ? ea : eb) << 9) + l16;
        u[j] = *(const __attribute__((address_space(1))) u32x4*)((const __attribute__((address_space(1))) unsigned char*)up4 + voff);
    }
}
__device__ __forceinline__ float px_dots(const unsigned char* hq, int kq, int fr, const u32x4 (&d)[8], float csel, float dsel, int sb) {
    const int jm = fr & 3;
    const int sl = sb + 4 * kq + jm;
    const float mc = __shfl(csel, sl);
    const float md = __shfl(dsel, sl);
    f32x4 d4e = (f32x4){0.f, 0.f, 0.f, 0.f}, d4o = d4e;
    u32x4 b0 = *(const u32x4*)(hq + kq * 16), b1 = *(const u32x4*)(hq + 64 + kq * 16);
#pragma unroll
    for (int k = 0; k < 8; ++k) {
        u32x4 n0 = b0, n1 = b1;
        if (k < 7) { n0 = *(const u32x4*)(hq + (k + 1) * 128 + kq * 16); n1 = *(const u32x4*)(hq + (k + 1) * 128 + 64 + kq * 16); }
        __builtin_amdgcn_sched_barrier(0);
        const v8i A = {(int)d[k].x, (int)d[k].y, (int)d[k].z, (int)d[k].w, 0, 0, 0, 0};
        const v8i B = {(int)b0.x, (int)b0.y, (int)b0.z, (int)b0.w, (int)b1.x, (int)b1.y, (int)b1.z, (int)b1.w};
        if (k & 1) d4o = __builtin_amdgcn_mfma_scale_f32_16x16x128_f8f6f4(A, B, d4o, 4  , 0  , 0, 0x7F7F7F7F, 0, 0x7F7F7F7F);
        else d4e = __builtin_amdgcn_mfma_scale_f32_16x16x128_f8f6f4(A, B, d4e, 4, 0, 0, 0x7F7F7F7F, 0, 0x7F7F7F7F);
        __builtin_amdgcn_sched_barrier(0);
        b0 = n0; b1 = n1;
    }
    const f32x4 d4 = d4e + d4o;
    const float dv = jm == 0 ? d4[0] : jm == 1 ? d4[1] : jm == 2 ? d4[2] : d4[3];
    return gelu_tanh(dv * md) * mc;
}
__device__ __forceinline__ void px_up(const u32x4 (&u)[8], float av, f32x2 (&acc)[16], int lane) {
    const bool lo = lane < 32;
#pragma unroll
    for (int j = 0; j < 8; ++j) {
        const int ia = 2 * j, ib = 2 * j + 1;
        const float ca = __uint_as_float((unsigned)__builtin_amdgcn_readlane((int)__float_as_uint(av), 16 * (ia >> 2) + (ia & 3)));
        const float cb = __uint_as_float((unsigned)__builtin_amdgcn_readlane((int)__float_as_uint(av), 16 * (ib >> 2) + (ib & 3)));
        const float c = lo ? ca : cb;
        const f32x2 c2 = {c, c};
        f32x2 f[8];
        cvt16((u32x2){u[j].x, u[j].y}, f);
#pragma unroll
        for (int e = 0; e < 8; ++e) acc[e] = __builtin_elementwise_fma(f[e], c2, acc[e]);
        cvt16((u32x2){u[j].z, u[j].w}, f);
#pragma unroll
        for (int e = 0; e < 8; ++e) acc[8 + e] = __builtin_elementwise_fma(f[e], c2, acc[8 + e]);
    }
}
__device__ __forceinline__ void px_h2_to_fp8(const u32x4 v0, const u32x4 v1, unsigned char* hq, int lane) {
    u32x4 q;
    int wv = 0;
    wv = __builtin_amdgcn_cvt_pk_fp8_f32(bflo(v0.x), bfhi(v0.x), wv, false); wv = __builtin_amdgcn_cvt_pk_fp8_f32(bflo(v0.y), bfhi(v0.y), wv, true); q.x = (unsigned)wv;
    wv = __builtin_amdgcn_cvt_pk_fp8_f32(bflo(v0.z), bfhi(v0.z), wv, false); wv = __builtin_amdgcn_cvt_pk_fp8_f32(bflo(v0.w), bfhi(v0.w), wv, true); q.y = (unsigned)wv;
    wv = __builtin_amdgcn_cvt_pk_fp8_f32(bflo(v1.x), bfhi(v1.x), wv, false); wv = __builtin_amdgcn_cvt_pk_fp8_f32(bflo(v1.y), bfhi(v1.y), wv, true); q.z = (unsigned)wv;
    wv = __builtin_amdgcn_cvt_pk_fp8_f32(bflo(v1.z), bfhi(v1.z), wv, false); wv = __builtin_amdgcn_cvt_pk_fp8_f32(bflo(v1.w), bfhi(v1.w), wv, true); q.w = (unsigned)wv;
    *(u32x4*)(hq + lane * 16) = q;
}
#define PX_FW  16384
#define PX_G2  20480
__device__ __forceinline__ void d_peer_expert_stream(const bf16_t* __restrict__ h2, const unsigned char* __restrict__ down4, const unsigned char* __restrict__ up4, const float* __restrict__ dscale,
                                                     const float* __restrict__ uscale, const int* __restrict__ eidx, const float* __restrict__ gate, const float* __restrict__ mod,
                                                     const float* __restrict__ fw, const bf16_t* __restrict__ x1, float* __restrict__ out, float* __restrict__ dummy, int bid, int G, char* lds) {
    const int tid = tid_opaque(), lane = tid & 63, wid = tid >> 6, fr = lane & 15, kq = lane >> 4;
    __syncthreads();
    if (tid < 256) ((f32x4*)(lds + PX_FW))[tid] = ((const f32x4*)fw)[tid];
#pragma unroll
    for (int i = 0; i < 4; ++i) { const int idx = tid + i * 512; ((f32x4*)(lds + PX_G2))[idx] = *(const f32x4*)(mod + (idx >> 8) * 6144 + 5120 + (idx & 255) * 4); }
    __syncthreads();
    unsigned char* hq0 = (unsigned char*)lds + wid * 2048;
    const int nvb = NTOK / 8, nit = (nvb + G - 1) / G;
    int e_lo, e_hi; float c_lo, c_hi, d_lo, d_hi;
    u32x4 da[8], dn[8], uq[8], un[8];
    f32x2 acc[16];
    {
        const size_t tok = (size_t)(bid < nvb ? bid : nvb - 1) * 8 + wid;
        const u32x4 v0 = __builtin_nontemporal_load((const u32x4*)(h2 + tok * DM + lane * 16)), v1 = __builtin_nontemporal_load((const u32x4*)(h2 + tok * DM + lane * 16 + 8));
        e_lo = eidx[tok * 128 + lane]; e_hi = eidx[tok * 128 + 64 + lane];
        px_issue_down(down4, e_lo, 0, fr, kq, da); px_issue_up(up4, e_lo, 0, lane, uq);
        px_issue_down(down4, e_lo, 16, fr, kq, dn); px_issue_up(up4, e_lo, 16, lane, un);
        c_lo = gate[tok * 128 + lane] * uscale[e_lo]; c_hi = gate[tok * 128 + 64 + lane] * uscale[e_hi];
        d_lo = dscale[e_lo]; d_hi = dscale[e_hi];
        px_h2_to_fp8(v0, v1, hq0, lane);
    }
#pragma unroll
    for (int e = 0; e < 16; ++e) acc[e] = (f32x2){0.f, 0.f};
#pragma unroll 1
    for (int it = 0; it < nit; ++it) {
        const int vbc = bid + it * G, vbn0 = vbc + G;
        const bool valid = vbc < nvb;
        const size_t tok = (size_t)(valid ? vbc : nvb - 1) * 8 + wid;
        const size_t tokn = (size_t)(vbn0 < nvb ? vbn0 : nvb - 1) * 8 + wid;
        const int b = (int)(tok >> 13);
        const unsigned char* hq = hq0 + (it & 1) * 1024;
        const int ne_lo = eidx[tokn * 128 + lane], ne_hi = eidx[tokn * 128 + 64 + lane];
        const float ng_lo = gate[tokn * 128 + lane], ng_hi = gate[tokn * 128 + 64 + lane];
        const u32x4 nv0 = __builtin_nontemporal_load((const u32x4*)(h2 + tokn * DM + lane * 16)), nv1 = __builtin_nontemporal_load((const u32x4*)(h2 + tokn * DM + lane * 16 + 8));
#pragma unroll 1
        for (int gp = 0; gp < 3; ++gp) {
            const int g = 2 * gp;
            const float csel = gp < 2 ? c_lo : c_hi, dsel = gp < 2 ? d_lo : d_hi;
            const int esel = gp < 1 ? e_lo : e_hi;
            float av = px_dots(hq, kq, fr, da, csel, dsel, (g & 3) * 16);
            __builtin_amdgcn_sched_barrier(0);
            px_issue_down(down4, esel, ((g + 2) & 3) * 16, fr, kq, da);
            __builtin_amdgcn_sched_barrier(0);
            px_up(uq, av, acc, lane);
            __builtin_amdgcn_sched_barrier(0);
            px_issue_up(up4, esel, ((g + 2) & 3) * 16, lane, uq);
            __builtin_amdgcn_sched_barrier(0);
            av = px_dots(hq, kq, fr, dn, csel, dsel, ((g + 1) & 3) * 16);
            __builtin_amdgcn_sched_barrier(0);
            px_issue_down(down4, esel, ((g + 3) & 3) * 16, fr, kq, dn);
            __builtin_amdgcn_sched_barrier(0);
            px_up(un, av, acc, lane);
            __builtin_amdgcn_sched_barrier(0);
            px_issue_up(up4, esel, ((g + 3) & 3) * 16, lane, un);
            __builtin_amdgcn_sched_barrier(0);
        }
        px_h2_to_fp8(nv0, nv1, hq0 + ((it + 1) & 1) * 1024, lane);
        const float nus_lo = uscale[ne_lo], nus_hi = uscale[ne_hi], nds_lo = dscale[ne_lo], nds_hi = dscale[ne_hi];
        u32x2 xb[4];
        {
            const u32x4 xa = __builtin_nontemporal_load((const u32x4*)(x1 + tok * DM + (lane & 31) * 32 + (lane >> 5) * 16)), xc = __builtin_nontemporal_load((const u32x4*)(x1 + tok * DM + (lane & 31) * 32 + (lane >> 5) * 16 + 8));
            xb[0] = (u32x2){xa.x, xa.y}; xb[1] = (u32x2){xa.z, xa.w}; xb[2] = (u32x2){xc.x, xc.y}; xb[3] = (u32x2){xc.z, xc.w};
        }
        {
            __builtin_amdgcn_sched_barrier(0);
            float av = px_dots(hq, kq, fr, da, c_hi, d_hi, 32);
            __builtin_amdgcn_sched_barrier(0);
            px_issue_down(down4, ne_lo, 0, fr, kq, da);
            __builtin_amdgcn_sched_barrier(0);
            px_up(uq, av, acc, lane);
            __builtin_amdgcn_sched_barrier(0);
            px_issue_up(up4, ne_lo, 0, lane, uq);
            __builtin_amdgcn_sched_barrier(0);
            av = px_dots(hq, kq, fr, dn, c_hi, d_hi, 48);
            __builtin_amdgcn_sched_barrier(0);
            px_issue_down(down4, ne_lo, 16, fr, kq, dn);
            __builtin_amdgcn_sched_barrier(0);
            px_up(un, av, acc, lane);
            __builtin_amdgcn_sched_barrier(0);
            px_issue_up(up4, ne_lo, 16, lane, un);
            __builtin_amdgcn_sched_barrier(0);
        }
        {
#pragma unroll
            for (int e = 0; e < 8; ++e) {
                const auto rx = __builtin_amdgcn_permlane32_swap(__float_as_uint(acc[e].x), __float_as_uint(acc[8 + e].x), false, false);
                const auto ry = __builtin_amdgcn_permlane32_swap(__float_as_uint(acc[e].y), __float_as_uint(acc[8 + e].y), false, false);
                acc[e] = (f32x2){__uint_as_float(rx[0]) + __uint_as_float(rx[1]), __uint_as_float(ry[0]) + __uint_as_float(ry[1])};
            }
        }
        const int cb0 = (lane & 31) * 32 + (lane >> 5) * 16;
        float x2[16]; float ss = 0.f;
#pragma unroll
        for (int q4i = 0; q4i < 4; ++q4i) {
            const int col = cb0 + q4i * 4;
            const f32x4 xv = (f32x4){bflo(xb[q4i].x), bfhi(xb[q4i].x), bflo(xb[q4i].y), bfhi(xb[q4i].y)};
            const f32x4 g2 = *(const f32x4*)(lds + PX_G2 + (b * 1024 + col) * 4);
            const int e0 = q4i * 4;
            x2[e0 + 0] = xv.x + g2.x * acc[2 * q4i].x; x2[e0 + 1] = xv.y + g2.y * acc[2 * q4i].y; x2[e0 + 2] = xv.z + g2.z * acc[2 * q4i + 1].x; x2[e0 + 3] = xv.w + g2.w * acc[2 * q4i + 1].y;
            ss += x2[e0] * x2[e0] + x2[e0 + 1] * x2[e0 + 1] + x2[e0 + 2] * x2[e0 + 2] + x2[e0 + 3] * x2[e0 + 3];
        }
        ss = wave_sum(ss);
        const float r = rsqrtf(ss * (1.0f / DM) + EPS);
        float* op = valid ? out + tok * DM : dummy + (size_t)((bid * 8 + wid) & 2047) * DM;
#pragma unroll
        for (int q4i = 0; q4i < 4; ++q4i) {
            const int col = cb0 + q4i * 4;
            const f32x4 wv = *(const f32x4*)(lds + PX_FW + col * 4);
            const int e0 = q4i * 4;
            __builtin_nontemporal_store((f32x4){x2[e0] * r * wv.x, x2[e0 + 1] * r * wv.y, x2[e0 + 2] * r * wv.z, x2[e0 + 3] * r * wv.w}, (f32x4*)(op + col));
        }
        e_lo = ne_lo; e_hi = ne_hi; c_lo = ng_lo * nus_lo; c_hi = ng_hi * nus_hi; d_lo = nds_lo; d_hi = nds_hi;
#pragma unroll
        for (int e = 0; e < 16; ++e) acc[e] = (f32x2){0.f, 0.f};
    }
}

#define XB_TMO      128
#define XB_XCNT(j)  (256  + 64 * (j))
#define XB_XSUB(j)  (1280 + 64 * (j))
#define XB_XGEN(j)  (2304 + 64 * (j))
#define XB_TOP      3328
#define XB_TOPGEN   3392
#define XCD_BAR_WORDS 3456
#define XB_SPIN_CAP (1u << 18)

__device__ __forceinline__ unsigned xb_ld(unsigned* p)              { return __hip_atomic_load(p, __ATOMIC_RELAXED, __HIP_MEMORY_SCOPE_AGENT); }
__device__ __forceinline__ unsigned xb_add(unsigned* p, unsigned v) { return __hip_atomic_fetch_add(p, v, __ATOMIC_RELAXED, __HIP_MEMORY_SCOPE_AGENT); }
__device__ __forceinline__ unsigned xb_xcc_id() { return (unsigned)__builtin_amdgcn_s_getreg((3 << 11) | 20) & 0xFu; }
#define XB_SPIN(cond, bar) do { unsigned _sp = 0; while (cond) { __builtin_amdgcn_s_sleep(1); \
    if ((++_sp & 255u) == 0u) { if (xb_ld(&(bar)[XB_TMO])) break; if (_sp > XB_SPIN_CAP) { atomicAdd(&(bar)[XB_TMO], 1u); break; } } } } while (0)

struct XcdBarrier {
    unsigned* bar; unsigned x;
    volatile __attribute__((address_space(3))) unsigned* st;
};

__device__ __forceinline__ XcdBarrier xcd_barrier_post(unsigned* bar, volatile __attribute__((address_space(3))) unsigned* st) {
    XcdBarrier b; b.bar = bar; b.x = xb_xcc_id(); b.st = st;
    if (threadIdx.x == 0) (void)xb_add(&bar[XB_XCNT(b.x)], 1u);
    return b;
}
__device__ __forceinline__ void xcd_barrier_complete(unsigned* bar, unsigned x, unsigned& nloc, unsigned& nx) {
    const unsigned G = gridDim.x * gridDim.y * gridDim.z;
    unsigned sum, cnt, mine, sp = 0u;
    for (;;) {
        sum = 0u; cnt = 0u; mine = 0u;
#pragma unroll
        for (unsigned j = 0; j < 16; ++j) { const unsigned c = xb_ld(&bar[XB_XCNT(j)]); sum += c; cnt += (c > 0u) ? 1u : 0u; mine = (j == x) ? c : mine; }
        if (sum == G) break;
        __builtin_amdgcn_s_sleep(1);
        if ((++sp & 255u) == 0u) { if (xb_ld(&bar[XB_TMO])) break; if (sp > XB_SPIN_CAP) { atomicAdd(&bar[XB_TMO], 1u); break; } }
    }
    nloc = mine > 0u ? mine : 1u; nx = cnt > 0u ? cnt : 1u;
}

__device__ __forceinline__ void xcd_barrier(const XcdBarrier& b) {
    asm volatile("s_waitcnt vmcnt(0)" ::: "memory");
    __syncthreads();
    if (threadIdx.x == 0) {
        unsigned* bar = b.bar;
        __builtin_amdgcn_s_waitcnt(0);
        unsigned nloc = b.st[0], nx = b.st[1];
        if (nloc == 0u) { xcd_barrier_complete(bar, b.x, nloc, nx); b.st[0] = nloc; b.st[1] = nx; }
        const unsigned old = xb_add(&bar[XB_XSUB(b.x)], 1u);
        const unsigned gen = old / nloc;
        if (old + 1u == (gen + 1u) * nloc) {
            __builtin_amdgcn_fence(__ATOMIC_RELEASE, "agent");
            asm volatile("s_waitcnt vmcnt(0)" ::: "memory");
            const unsigned og = xb_add(&bar[XB_TOP], 1u);
            const unsigned tg = og / nx;
            if (og + 1u == (tg + 1u) * nx) xb_add(&bar[XB_TOPGEN], 1u);
            else XB_SPIN(xb_ld(&bar[XB_TOPGEN]) == tg, bar);
            __builtin_amdgcn_fence(__ATOMIC_ACQUIRE, "agent");
            xb_add(&bar[XB_XGEN(b.x)], 1u);
            asm volatile("s_waitcnt vmcnt(0)" ::: "memory");
        } else {
            XB_SPIN(xb_ld(&bar[XB_XGEN(b.x)]) == gen, bar);
            __builtin_amdgcn_fence(__ATOMIC_ACQUIRE, "agent");
            asm volatile("s_waitcnt vmcnt(0)" ::: "memory");
        }
    }
    __syncthreads();
}


struct Params {
    const float *x, *c, *w_ada, *b_ada, *norm1_w, *w_in, *cmp_pe_k, *cmp_pe_v, *cmp_w1_k, *cmp_w2_k, *cmp_w1_v, *cmp_w2_v, *nsa_norm_w, *conv_w, *conv_b, *dt_bias, *a_log, *d_skip,
        *ssd_norm_w, *w_out, *norm2_w, *peer_wq, *peer_qnorm_w, *peer_sub_keys, *peer_down, *peer_up, *final_norm_w;
    float* out; char* ws;
};
#define LDS_BYTES 147456
#define LDS_MISC  (LDS_BYTES - 64)

__global__ __launch_bounds__(512, 2) void mega(Params p) {
    __shared__ __attribute__((aligned(16))) unsigned char lds_raw[LDS_BYTES];
    char* lds = (char*)lds_raw;
    PG8_LAS unsigned char* lds3 = (PG8_LAS unsigned char*)lds_raw;
    int* s_vb = (int*)(lds + LDS_MISC);
    cg::grid_group grid = cg::this_grid();
    volatile __attribute__((address_space(3))) unsigned* xb_st = (volatile __attribute__((address_space(3))) unsigned*)((PG8_LAS unsigned char*)lds_raw + LDS_MISC + 16);
    if (threadIdx.x == 0) { xb_st[0] = 0u; xb_st[1] = 0u; }
    __syncthreads();
    const XcdBarrier xbar = xcd_barrier_post((unsigned*)(p.ws + OFF_BAR), xb_st);
    const int G = gridDim.x, bid = blockIdx.x;
    if (bid == 0 && threadIdx.x == 0) { ((unsigned*)(p.ws + OFF_CTR))[0] = 0u; ((unsigned*)(p.ws + OFF_CTR))[64] = 0u; ((unsigned*)(p.ws + OFF_CTR))[128] = 0u; ((unsigned*)(p.ws + OFF_CTR))[192] = 0u; }
    for (int vb = bid; vb < 7969; vb += G) {
        int v = vb;
        if (v < 1536) { d_transpose_w(p.w_in, ((bf16_t*)(p.ws + OFF_WIN_T)), 1024, 2848, 1, 96, v, lds); }
        else if ((v -= 1536) < 512) { d_transpose_w(p.w_out, ((bf16_t*)(p.ws + OFF_WOUT_T)), 1024, 1024, 0, 32, v, lds); }
        else if ((v -= 512) < 1024) { d_transpose_w(p.peer_wq, ((bf16_t*)(p.ws + OFF_WQ_T)), 1024, 2048, 0, 64, v, lds); }
        else if ((v -= 1024) < 256) { d_transpose_w(p.cmp_w1_k, ((bf16_t*)(p.ws + OFF_W1K_T)), 2048, 256, 0, 8, v, lds); }
        else if ((v -= 256) < 256) { d_transpose_w(p.cmp_w1_v, ((bf16_t*)(p.ws + OFF_W1V_T)), 2048, 256, 0, 8, v, lds); }
        else if ((v -= 256) < 2048) { d_quant_rows(p.peer_down, ((unsigned char*)(p.ws + OFF_DOWN)), ((float*)(p.ws + OFF_UP)), v); }
        else if ((v -= 2048) < 2048) { d_quant_rows(p.peer_up, ((unsigned char*)(p.ws + OFF_DOWN + MIB(8))), ((float*)(p.ws + OFF_UP + 65536)), v); }
        else if ((v -= 2048) < 1) { d_convert_bf16(p.peer_sub_keys, ((bf16_t*)(p.ws + OFF_SUBK)), (size_t)8 * 2 * 128 * 128 / 8, 0, 1); }
        else if ((v -= 1) < 96) { d_mod(p.c, p.w_ada, p.b_ada, ((float*)(p.ws + OFF_MOD)), v, lds); }
        else if ((v -= 96) < 128) { d_rope_table(((float2*)(p.ws + OFF_ROPE)), v); }
        else { d_bias1_part(p.cmp_pe_k, p.cmp_w1_k, p.cmp_pe_v, p.cmp_w1_v, ((float*)(p.ws + OFF_BIAS1 + 4096)), v - 128); }
    }
    grid.sync();
    if (bid == G - 1) d_bias1_sum(((float*)(p.ws + OFF_BIAS1 + 4096)), ((float*)(p.ws + OFF_BIAS1)));
    for (int vb = bid; vb < NTOK / 32; vb += G) d_norm_mod<false>(p.x, p.norm1_w, ((float*)(p.ws + OFF_MOD)), 0, 1024, ((bf16_t*)(p.ws + OFF_H)), vb);
    xcd_barrier(xbar);
    {
        const pg8::Gemm g{((bf16_t*)(p.ws + OFF_H)), ((bf16_t*)(p.ws + OFF_WIN_T)), NTOK, NIN_PAD, 1024, 1024};
        pg8::StaticOrder S; S.init(NTOK, NIN_PAD, G, bid);
        const pg8::Epi<EpInProj> E{{((bf16_t*)(p.ws + OFF_PROJ)), ((bf16_t*)(p.ws + OFF_QROPE)), ((bf16_t*)(p.ws + OFF_KVP)), ((float*)(p.ws + OFF_SMALL)), ((float2*)(p.ws + OFF_ROPE)), p.dt_bias}};
        pg8::gemm_phase(lds3, g, S, E);
    }
    xcd_barrier(xbar);
    {
        {
            const pg8::Gemm g{((bf16_t*)(p.ws + OFF_KVP)) + 0 * KVP_SEG, ((bf16_t*)(p.ws + OFF_W1K_T)), 8192, 256, 2048, 1024};
            pg8::StaticOrder S; S.init(8192, 256, G, bid);
            const pg8::Epi<EpCmpHid> E{{((bf16_t*)(p.ws + OFF_HIDK)), ((float*)(p.ws + OFF_BIAS1))}};
            pg8::gemm_phase(lds3, g, S, E);
        }
        {
            const pg8::Gemm g{((bf16_t*)(p.ws + OFF_KVP)) + 1 * KVP_SEG, ((bf16_t*)(p.ws + OFF_W1V_T)), 8192, 256, 2048, 1024};
            pg8::StaticOrder S; S.init(8192, 256, G, (bid + G / 2) % G);
            const pg8::Epi<EpCmpHid> E{{((bf16_t*)(p.ws + OFF_HIDV)), ((float*)(p.ws + OFF_BIAS1)) + 256}};
            pg8::gemm_phase(lds3, g, S, E);
        }
        __syncthreads();
        for (;;) {
            if (threadIdx.x == 0) *s_vb = (int)atomicAdd(&((unsigned*)(p.ws + OFF_CTR))[192], 1u);
            __syncthreads();
            const int i = *s_vb;
            __syncthreads();
            if (i >= 1024) break;
            d_ssd_states(((bf16_t*)(p.ws + OFF_PROJ)), ((float*)(p.ws + OFF_SMALL)), p.conv_w, p.conv_b, p.a_log, ((float*)(p.ws + OFF_ONSA)), ((float*)(p.ws + OFF_CTR + 4096)), i, lds);
        }
    }
    xcd_barrier(xbar);
    for (int vb = bid; vb < 2048 + 128; vb += G) {
        if (vb < 1024) d_cmp_out(((bf16_t*)(p.ws + OFF_HIDK)), p.cmp_w2_k, ((bf16_t*)(p.ws + OFF_KC)), vb); else if (vb < 2048) d_cmp_out(((bf16_t*)(p.ws + OFF_HIDV)), p.cmp_w2_v, ((bf16_t*)(p.ws + OFF_VC)), vb - 1024);
        else d_ssd_scan(((float*)(p.ws + OFF_ONSA)), ((float*)(p.ws + OFF_CTR + 4096)), ((bf16_t*)(p.ws + OFF_EIDX)), vb - 2048);
    }
    xcd_barrier(xbar);
    for (;;) {
        if (threadIdx.x == 0) *s_vb = (int)atomicAdd(&((unsigned*)(p.ws + OFF_CTR))[64], 1u);
        __syncthreads();
        const int i = *s_vb;
        __syncthreads();
        if (i >= 1024) break;
        d_ssd_out(((bf16_t*)(p.ws + OFF_PROJ)), ((float*)(p.ws + OFF_SMALL)), p.conv_w, p.conv_b, p.a_log, p.d_skip, ((bf16_t*)(p.ws + OFF_EIDX)), ((bf16_t*)(p.ws + OFF_YSSD)), i, lds);
    }
    for (;;) {
        if (threadIdx.x == 0) *s_vb = (int)atomicAdd(&((unsigned*)(p.ws + OFF_CTR))[0], 1u);
        __syncthreads();
        const int i = *s_vb;
        __syncthreads();
        if (i >= 2048) break;
        const int qt = 127 - (i >> 4), bg = i & 15;
        d_nsa_cmp(((bf16_t*)(p.ws + OFF_PROJ)), ((bf16_t*)(p.ws + OFF_KC)), ((bf16_t*)(p.ws + OFF_VC)), ((float*)(p.ws + OFF_SMALL)), ((bf16_t*)(p.ws + OFF_ONSA)), ((unsigned*)(p.ws + OFF_HIDK)) + (size_t)(bg * 128 + qt) * 512, bg >> 1, bg & 1, qt, lds);
    }
    xcd_barrier(xbar);
    for (;;) {
        if (threadIdx.x == 0) *s_vb = (int)atomicAdd(&((unsigned*)(p.ws + OFF_CTR))[128], 1u);
        __syncthreads();
        const int i = *s_vb;
        __syncthreads();
        if (i >= 1024) break;
        const int qt2 = 63 - (i >> 4), bg = i & 15;
        d_nsa_attn128(((bf16_t*)(p.ws + OFF_PROJ)), ((float2*)(p.ws + OFF_ROPE)), ((bf16_t*)(p.ws + OFF_KVP)), ((float*)(p.ws + OFF_SMALL)), ((bf16_t*)(p.ws + OFF_ONSA)), ((unsigned*)(p.ws + OFF_HIDK)) + (size_t)(bg * 128) * 512, bg >> 1, bg & 1, qt2, lds);
    }
    xcd_barrier(xbar);
    for (int vb = bid; vb < NTOK / 32; vb += G) d_mix_prep(((bf16_t*)(p.ws + OFF_ONSA)), ((bf16_t*)(p.ws + OFF_YSSD)), p.nsa_norm_w, p.ssd_norm_w, ((bf16_t*)(p.ws + OFF_H)), vb);
    xcd_barrier(xbar);
    {
        const pg8::Gemm g{((bf16_t*)(p.ws + OFF_H)), ((bf16_t*)(p.ws + OFF_WOUT_T)), NTOK, 1024, 1024, 1024};
        pg8::StaticOrder S; S.init(NTOK, 1024, G, bid);
        const pg8::Epi<EpOutProj> E{{p.x, ((float*)(p.ws + OFF_MOD)), ((bf16_t*)(p.ws + OFF_ONSA))}};
        pg8::gemm_phase(lds3, g, S, E);
    }
    xcd_barrier(xbar);
    for (int vb = bid; vb < NTOK / 32; vb += G) d_norm_mod<true>(((bf16_t*)(p.ws + OFF_ONSA)), p.norm2_w, ((float*)(p.ws + OFF_MOD)), 3072, 4096, ((bf16_t*)(p.ws + OFF_H)), vb);
    xcd_barrier(xbar);
    {
        const pg8::Gemm g{((bf16_t*)(p.ws + OFF_H)), ((bf16_t*)(p.ws + OFF_WQ_T)), NTOK, 2048, 1024, 1024};
        pg8::StaticOrder S; S.init(NTOK, 2048, G, bid);
        const pg8::Epi<EpStoreBf16> E{{((bf16_t*)(p.ws + OFF_PROJ)), 2048, 0}};
        pg8::gemm_phase(lds3, g, S, E);
    }
    xcd_barrier(xbar);
    for (int h = 0; h < 8; ++h) {
        __syncthreads();
        d_peer_stage_keys(((bf16_t*)(p.ws + OFF_SUBK)), h, lds);
        __syncthreads();
        for (int tile = bid; tile < 512; tile += G) d_peer_route(((bf16_t*)(p.ws + OFF_PROJ)), p.peer_qnorm_w, ((int*)(p.ws + OFF_EIDX)), ((float*)(p.ws + OFF_GATE)), tile, h, lds);
    }
    xcd_barrier(xbar);
    d_peer_expert_stream(((bf16_t*)(p.ws + OFF_H)), ((unsigned char*)(p.ws + OFF_DOWN)), ((unsigned char*)(p.ws + OFF_DOWN + MIB(8))), ((float*)(p.ws + OFF_UP)), ((float*)(p.ws + OFF_UP + 65536)), ((int*)(p.ws + OFF_EIDX)), ((float*)(p.ws + OFF_GATE)), ((float*)(p.ws + OFF_MOD)), p.final_norm_w, ((bf16_t*)(p.ws + OFF_ONSA)), p.out, ((float*)(p.ws + OFF_SMALL)), bid, G, lds);
}

extern "C" void kernel_launch(void* const* d_in, const int* in_sizes, int n_in, void* d_out, int out_size, void* d_ws, size_t ws_size, hipStream_t stream) {
    if (ws_size < WS_NEED) { fprintf(stderr, "workspace too small\n"); return; }
    static int grid_blocks = 0;
    if (!grid_blocks) {
        int dev = 0, cus = 0, per_cu = 0;
        (void)hipGetDevice(&dev);
        (void)hipDeviceGetAttribute(&cus, hipDeviceAttributeMultiprocessorCount, dev);
        (void)hipOccupancyMaxActiveBlocksPerMultiprocessor(&per_cu, mega, 512, 0);
        if (per_cu < 1) fprintf(stderr, "occupancy query reports %d blocks per CU\n", per_cu);
        grid_blocks = cus;
    }
    Params p{};
    const float** pp = (const float**)&p;
    for (int i = 0; i < 27; ++i) pp[i] = (const float*)d_in[i];
    p.out = (float*)d_out; p.ws = (char*)d_ws;
    (void)hipMemsetAsync((char*)d_ws + OFF_BAR, 0, XCD_BAR_WORDS * 4, stream);
    void* args[] = {&p};
    hipError_t e = hipLaunchCooperativeKernel((void*)mega, dim3(grid_blocks), dim3(512), args, 0, stream);
    if (e != hipSuccess) fprintf(stderr, "cooperative launch failed: %s (grid %d)\n", hipGetErrorString(e), grid_blocks);
}
```

```cpp
#include <hip/hip_runtime.h>
#include <hip/hip_cooperative_groups.h>
#include <stdint.h>
#include <cstdio>
namespace cg = cooperative_groups;

typedef unsigned short bf16_t;
typedef short bf16x8 __attribute__((ext_vector_type(8)));
typedef float f32x4 __attribute__((ext_vector_type(4)));
typedef float f32x2 __attribute__((ext_vector_type(2)));
typedef unsigned u32x4 __attribute__((ext_vector_type(4)));
typedef unsigned u32x2 __attribute__((ext_vector_type(2)));

#define NB 8
#define SEQ 8192
#define NTOK 65536
#define DM 1024
#define PROJ_LD 2816
#define NIN_PAD 3072
#define C_Q 0
#define C_KCMP 512
#define C_KSEL 768
#define C_VSEL 896
#define C_KWIN 1024
#define C_VWIN 1152
#define C_Z 1280
#define C_XBC 1792
#define NCMP 511
#define EPS 1e-6f
#define KVP_SEG ((size_t)NB * 2 * SEQ * 64)

#define MIB(x) ((size_t)(x) << 20)
#define OFF_MOD    MIB(0)
#define OFF_ROPE   MIB(1)
#define OFF_BIAS1  MIB(2)
#define OFF_WIN_T  MIB(3)
#define OFF_WOUT_T MIB(9)
#define OFF_WQ_T   MIB(11)
#define OFF_SUBK   MIB(15)
#define OFF_W1K_T  MIB(16)
#define OFF_W1V_T  MIB(17)
#define OFF_KC     MIB(18)
#define OFF_VC     MIB(19)
#define OFF_HIDK   MIB(20)
#define OFF_HIDV   MIB(24)
#define OFF_DOWN   MIB(28)
#define OFF_UP     MIB(60)
#define OFF_SMALL  MIB(92)
#define OFF_H      MIB(100)
#define OFF_PROJ   MIB(228)
#define OFF_QROPE  MIB(580)
#define OFF_ONSA   MIB(644)
#define OFF_YSSD   MIB(772)
#define OFF_KVP    MIB(836)
#define OFF_EIDX   MIB(932)
#define OFF_GATE   MIB(964)
#define OFF_CTR    MIB(996)
#define OFF_BAR    (MIB(996) + 65536)
#define WS_NEED    MIB(997)

typedef __bf16 hwbf2 __attribute__((ext_vector_type(2)));
__device__ __forceinline__ bf16_t f2bf(float f) { const __bf16 h = (__bf16)f; return __builtin_bit_cast(bf16_t, h); }
__device__ __forceinline__ float bf2f(bf16_t h) { return __uint_as_float(((unsigned)h) << 16); }
__device__ __forceinline__ float bflo(unsigned u) { return __uint_as_float(u << 16); }
__device__ __forceinline__ float bfhi(unsigned u) { return __uint_as_float(u & 0xffff0000u); }
__device__ __forceinline__ unsigned pack2(float a, float b) { const f32x2 v = {a, b}; const hwbf2 r = __builtin_convertvector(v, hwbf2); return __builtin_bit_cast(unsigned, r); }
__device__ __forceinline__ float wave_sum(float v) {
#pragma unroll
    for (int o = 32; o; o >>= 1) v += __shfl_xor(v, o);
    return v;
}
__device__ __forceinline__ float wave_max(float v) {
#pragma unroll
    for (int o = 32; o; o >>= 1) v = fmaxf(v, __shfl_xor(v, o));
    return v;
}
__device__ __forceinline__ int tid_opaque() { int t = threadIdx.x; asm volatile("" : "+v"(t)); return t; }
__device__ __forceinline__ float gelu_tanh(float x) { const float u2 = 1.5957691216057308f * (x + 0.044715f * x * x * x); return x * __builtin_amdgcn_rcpf(1.0f + __expf(-u2)); }
__device__ __forceinline__ float silu(float x) { return x / (1.0f + __expf(-x)); }
__device__ __forceinline__ float sigmoidf(float x) { return 1.0f / (1.0f + __expf(-x)); }
__device__ __forceinline__ float softplusf(float x) { return x > 20.f ? x : log1pf(__expf(x)); }

__device__ __forceinline__ int inproj_src(int n) {
    if (n < 1280) return n;
    if (n < 1792) return 1304 + (n - 1280);
    if (n < 2816) return 1816 + (n - 1792);
    if (n < 2840) return 1280 + (n - 2816);
    if (n < 2848) return 2840 + (n - 2840);
    return -1;
}
__device__ __forceinline__ void d_transpose_w(const float* __restrict__ W, bf16_t* __restrict__ Wt, int K, int N, int mode, int nbx, int vb, char* lds) {
    const int tid_ = tid_opaque(); const int half = tid_ >> 8, t256 = tid_ & 255, tx = t256 & 31, ty = t256 >> 5;
    float r[2][4];
#pragma unroll
    for (int u = 0; u < 2; ++u) {
        const int tile = vb * 4 + half * 2 + u, n0 = (tile % nbx) * 32, k0 = (tile / nbx) * 32;
#pragma unroll
        for (int i = 0; i < 4; ++i) {
            const int k = k0 + ty + 8 * i, n = n0 + tx;
            const int src = mode == 1 ? inproj_src(n) : n;
            r[u][i] = (src >= 0 && src < N) ? W[(size_t)k * N + src] : 0.f;
        }
    }
#pragma unroll
    for (int u = 0; u < 2; ++u) {
        float (*t)[33] = (float (*)[33])(lds + (half * 2 + u) * 4352);
#pragma unroll
        for (int i = 0; i < 4; ++i) t[ty + 8 * i][tx] = r[u][i];
    }
    __syncthreads();
#pragma unroll
    for (int u = 0; u < 2; ++u) {
        const int tile = vb * 4 + half * 2 + u, n0 = (tile % nbx) * 32, k0 = (tile / nbx) * 32;
        float (*t)[33] = (float (*)[33])(lds + (half * 2 + u) * 4352);
#pragma unroll
        for (int i = 0; i < 4; ++i) Wt[(size_t)(n0 + ty + 8 * i) * K + k0 + tx] = f2bf(t[tx][ty + 8 * i]);
    }
    __syncthreads();
}
__device__ __forceinline__ void d_convert_bf16(const float* __restrict__ in, bf16_t* __restrict__ out, size_t n8, int vb, int nvb) {
    size_t i = (size_t)vb * 512 + tid_opaque();
    const size_t stride = (size_t)nvb * 512;
    for (; i < n8; i += stride) {
        const f32x4 a = ((const f32x4*)in)[2 * i], b = ((const f32x4*)in)[2 * i + 1];
        u32x4 o; o.x = pack2(a.x, a.y); o.y = pack2(a.z, a.w); o.z = pack2(b.x, b.y); o.w = pack2(b.z, b.w);
        ((u32x4*)out)[i] = o;
    }
}
__device__ __forceinline__ void d_mod(const float* __restrict__ c, const float* __restrict__ w_ada, const float* __restrict__ b_ada, float* __restrict__ mod, int vb, char* lds) {
    float (*part)[8][64] = (float (*)[8][64])lds;
    const int tid = tid_opaque(), jl = tid & 63, kq = tid >> 6, j = vb * 64 + jl;
    float acc[8];
#pragma unroll
    for (int b = 0; b < 8; ++b) acc[b] = 0.f;
    for (int k0 = kq * 128; k0 < kq * 128 + 128; k0 += 32) {
        float wv[32];
#pragma unroll
        for (int i = 0; i < 32; ++i) wv[i] = w_ada[(size_t)(k0 + i) * 6144 + j];
#pragma unroll
        for (int i = 0; i < 32; ++i)
#pragma unroll
            for (int b = 0; b < 8; ++b) acc[b] += c[b * 1024 + k0 + i] * wv[i];
    }
#pragma unroll
    for (int b = 0; b < 8; ++b) part[kq][b][jl] = acc[b];
    __syncthreads();
    {
        const int b = tid >> 6, jj = tid & 63;
        float s = b_ada[vb * 64 + jj];
#pragma unroll
        for (int q = 0; q < 8; ++q) s += part[q][b][jj];
        mod[b * 6144 + vb * 64 + jj] = s;
    }
    __syncthreads();
}
__device__ __forceinline__ void d_rope_table(float2* __restrict__ rope, int vb) {
    const int i = vb * 512 + tid_opaque();
    if (i >= SEQ * 8) return;
    const int pos = i >> 3, f = i & 7;
    const double inv = pow(500000.0, -(double)f / 8.0);
    const double ang = (double)pos * inv;
    rope[i] = make_float2((float)cos(ang), (float)sin(ang));
}
__device__ __forceinline__ void d_bias1_part(const float* __restrict__ pe_k, const float* __restrict__ w1_k, const float* __restrict__ pe_v, const float* __restrict__ w1_v, float* __restrict__ part, int sl) {
    const int tid_ = tid_opaque(); const int which = tid_ >> 8, j = tid_ & 255;
    const float* pe = which ? pe_v : pe_k; const float* w1 = which ? w1_v : w1_k;
    float wv[32];
#pragma unroll
    for (int i = 0; i < 32; ++i) wv[i] = w1[(size_t)(sl * 32 + i) * 256 + j];
    float a = 0.f;
#pragma unroll
    for (int i = 0; i < 32; ++i) a += pe[sl * 32 + i] * wv[i];
    part[sl * 512 + which * 256 + j] = a;
}
__device__ __forceinline__ void d_bias1_sum(const float* __restrict__ part, float* __restrict__ bias1) {
    const int t = tid_opaque();
    float v[64];
#pragma unroll
    for (int sl = 0; sl < 64; ++sl) v[sl] = part[sl * 512 + t];
    float a = 0.f;
#pragma unroll
    for (int sl = 0; sl < 64; ++sl) a += v[sl];
    bias1[t] = a;
}

template <bool XBF>
__device__ __forceinline__ void d_norm_mod(const void* __restrict__ xin, const float* __restrict__ w, const float* __restrict__ mod, int sh_off, int sc_off, bf16_t* __restrict__ out, int vb) {
    const int tid_ = tid_opaque(); const int lane = tid_ & 63, wid = tid_ >> 6;
    const size_t row0 = (size_t)vb * 32 + wid * 4; const int b = (int)(row0 >> 13);
    f32x4 v[4][2][2];
#pragma unroll
    for (int r = 0; r < 4; ++r)
#pragma unroll
        for (int k = 0; k < 2; ++k) {
            if (XBF) {
                const u32x4 t = *(const u32x4*)((const bf16_t*)xin + (row0 + r) * DM + k * 512 + lane * 8);
                v[r][k][0] = (f32x4){bflo(t.x), bfhi(t.x), bflo(t.y), bfhi(t.y)}; v[r][k][1] = (f32x4){bflo(t.z), bfhi(t.z), bflo(t.w), bfhi(t.w)};
            } else {
                const float* xp = (const float*)xin + (row0 + r) * DM + k * 512 + lane * 8;
                v[r][k][0] = *(const f32x4*)xp; v[r][k][1] = *(const f32x4*)(xp + 4);
            }
        }
    float rs[4];
#pragma unroll
    for (int r = 0; r < 4; ++r) {
        float ss = 0.f;
#pragma unroll
        for (int k = 0; k < 2; ++k)
#pragma unroll
            for (int h = 0; h < 2; ++h) ss += v[r][k][h].x * v[r][k][h].x + v[r][k][h].y * v[r][k][h].y + v[r][k][h].z * v[r][k][h].z + v[r][k][h].w * v[r][k][h].w;
        rs[r] = rsqrtf(wave_sum(ss) * (1.0f / DM) + EPS);
    }
#pragma unroll
    for (int k = 0; k < 2; ++k) {
        const int col = k * 512 + lane * 8;
        f32x4 ws[2], sh[2];
#pragma unroll
        for (int h = 0; h < 2; ++h) {
            const f32x4 wv = *(const f32x4*)(w + col + 4 * h), sc = *(const f32x4*)(mod + b * 6144 + sc_off + col + 4 * h);
            sh[h] = *(const f32x4*)(mod + b * 6144 + sh_off + col + 4 * h);
            ws[h] = wv * (sc + 1.0f);
        }
#pragma unroll
        for (int r = 0; r < 4; ++r) {
            const f32x4 y0 = v[r][k][0] * rs[r] * ws[0] + sh[0], y1 = v[r][k][1] * rs[r] * ws[1] + sh[1];
            u32x4 o; o.x = pack2(y0.x, y0.y); o.y = pack2(y0.z, y0.w); o.z = pack2(y1.x, y1.y); o.w = pack2(y1.z, y1.w);
            *(u32x4*)(out + (row0 + r) * DM + col) = o;
        }
    }
}

namespace pg8 {
#define PG8_LAS __attribute__((address_space(3)))
constexpr int BM = 256, BK = 64, HALF = 128, HTB = HALF * BK * 2  , STAGE_BYTES = 8 * HTB, NXCD = 8, WGM = 4;
__host__ __device__ __forceinline__ int lds_byte(int r, int c) { const int st = (r >> 4) * 2 + (c >> 5), rr = r & 15, cc = c & 31, ob = rr * 64 + cc * 2; return st * 1024 + (ob ^ (((ob >> 9) & 1) << 5)); }
__host__ __device__ __forceinline__ void stage_rc(int b, int& R, int& C) { const int st = b / 1024, sb = b % 1024, swz = sb ^ (((sb >> 9) & 1) << 5); R = (st >> 1) * 16 + swz / 64; C = (st & 1) * 32 + (swz % 64) / 2; }
__host__ __device__ __forceinline__ int perm32(int rho) { const int n = rho >> 4, i = rho & 15; return 8 * (i >> 2) + 4 * n + (i & 3); }
struct Unit { int pm, pn; };
struct Gemm { const bf16_t* A; const bf16_t* Bt; int M, N, K, lda; };
struct StaticOrder {
    int nM, nN, nwg, G, c;
    __host__ __device__ void init(int M, int N, int G_, int c_) { nM = M / BM; nN = N / BM; nwg = nM * nN; G = G_; c = c_; }
    __host__ __device__ bool next(int i, Unit& u) const {
        const long L = (long)i * G + c; if (L >= nwg) return false;
        int wgid = (int)L; { const int q = nwg / NXCD, r = nwg % NXCD, xcd = wgid % NXCD, off = wgid / NXCD; wgid = (xcd < r ? xcd * (q + 1) : r * (q + 1) + (xcd - r) * q) + off; }
        const int nig = WGM * nN, gid = wgid / nig, fm = gid * WGM, gsz = (nM - fm) < WGM ? (nM - fm) : WGM;
        u.pm = fm + ((wgid % nig) % gsz); u.pn = (wgid % nig) / gsz; return true;
    }
};
template <class F> struct Epi {
    F f;
    __device__ __forceinline__ void operator()(const f32x4 (&acc)[2][2][4][2], const Unit& u, int wr, int wc, int fr, int fq) const {
#pragma unroll
        for (int ai = 0; ai < 2; ++ai)
#pragma unroll
            for (int m = 0; m < 4; ++m)
#pragma unroll
                for (int bj = 0; bj < 2; ++bj)
                    f(u.pm * BM + ai * HALF + wr * 64 + m * 16 + fr, u.pn * BM + bj * HALF + wc * 32 + 8 * fq, acc[ai][bj][m][0], acc[ai][bj][m][1]);
    }
};
template <class E, class Sched>
__device__ __forceinline__ void gemm_phase(PG8_LAS unsigned char* lds, const Gemm g, const Sched& S, const E& Ep) {
    const int tid = tid_opaque(), wid = __builtin_amdgcn_readfirstlane(tid >> 6), lane = tid & 63, wr = wid >> 2, wc = wid & 3, fr = lane & 15, fq = lane >> 4;
    const int K = g.K, nt = K / BK;
    unsigned voffA[2], voffB[2];
#pragma unroll
    for (int i = 0; i < 2; ++i) { int R, C; stage_rc(tid * 16 + i * 8192, R, C); const int Rb = (R & ~31) + perm32(R & 31); voffA[i] = (unsigned)(R * g.lda + C) * 2u; voffB[i] = (unsigned)(Rb * K + C) * 2u; }
    const size_t kstep = (size_t)(BK * 2);
    const size_t hstep = (size_t)HALF * K * 2, hstepA = (size_t)HALF * g.lda * 2;
    const size_t tstep = 2 * hstep, tstepA = 2 * hstepA;
    const unsigned ldsw = (unsigned)wid * 1024u;
    const int aoff = lds_byte(wr * 64 + fr, fq * 8), boff = lds_byte(wc * 32 + fr, fq * 8);
#define PG8_SA(b, h) (((b) * 2 + (h)) * HTB)
#define PG8_SB(b, h) ((4 + (b) * 2 + (h)) * HTB)
#define PG8_STAGE(bufoff, gbase, voff) do { _Pragma("unroll") for (int _i = 0; _i < 2; ++_i) \
        __builtin_amdgcn_global_load_lds((const unsigned*)((const char*)(gbase) + (voff)[_i]), (PG8_LAS unsigned*)(lds + (bufoff) + ldsw + _i * 8192), 16, 0, 0); } while (0)
#define PG8_LDA(dst, b, h) do { _Pragma("unroll") for (int m = 0; m < 4; ++m) _Pragma("unroll") for (int k = 0; k < 2; ++k) dst[m][k] = *(const PG8_LAS bf16x8*)(lds + PG8_SA(b, h) + aoff + m * 2048 + k * 1024); } while (0)
#define PG8_LDB(dst, b, h) do { _Pragma("unroll") for (int n = 0; n < 2; ++n) _Pragma("unroll") for (int k = 0; k < 2; ++k) dst[n][k] = *(const PG8_LAS bf16x8*)(lds + PG8_SB(b, h) + boff + n * 2048 + k * 1024); } while (0)
#define PG8_MMA(ai, bj, At, Bt) do { __builtin_amdgcn_s_setprio(1); _Pragma("unroll") for (int m = 0; m < 4; ++m) _Pragma("unroll") for (int n = 0; n < 2; ++n) _Pragma("unroll") for (int k = 0; k < 2; ++k) \
        acc[ai][bj][m][n] = __builtin_amdgcn_mfma_f32_16x16x32_bf16(Bt[n][k], At[m][k], acc[ai][bj][m][n], 0, 0, 0); __builtin_amdgcn_s_setprio(0); } while (0)
#define PG8_WAIT_V(n) asm volatile("s_waitcnt vmcnt(" #n ")" ::: "memory")
#define PG8_WAIT_L(n) asm volatile("s_waitcnt lgkmcnt(" #n ")" ::: "memory")
#define PG8_BAR __builtin_amdgcn_s_barrier()
#define PG8_SCHED __builtin_amdgcn_sched_barrier(0)
    Unit cur, nxt; int ui = 0;
    if (!S.next(0, cur)) return;
    f32x4 acc[2][2][4][2];
#pragma unroll
    for (int a = 0; a < 2; ++a)
#pragma unroll
        for (int b = 0; b < 2; ++b)
#pragma unroll
            for (int m = 0; m < 4; ++m)
#pragma unroll
                for (int n = 0; n < 2; ++n) acc[a][b][m][n] = (f32x4){0.f, 0.f, 0.f, 0.f};
    bf16x8 At[4][2], B0[2][2], B1[2][2];
    const char* cA = (const char*)g.A + (size_t)cur.pm * tstepA; const char* cB = (const char*)g.Bt + (size_t)cur.pn * tstep;
    PG8_STAGE(PG8_SB(0, 0), cB, voffB); PG8_STAGE(PG8_SB(0, 1), cB + hstep, voffB); PG8_STAGE(PG8_SA(0, 0), cA, voffA); PG8_STAGE(PG8_SA(0, 1), cA + hstepA, voffA);
    if (wr == 1) PG8_BAR;
    PG8_WAIT_V(2); PG8_BAR;
    PG8_STAGE(PG8_SB(1, 0), cB + kstep, voffB); PG8_STAGE(PG8_SA(1, 0), cA + kstep, voffA); PG8_STAGE(PG8_SB(1, 1), cB + hstep + kstep, voffB);
    PG8_WAIT_V(6); PG8_BAR;
    for (;;) {
        const bool has_next = S.next(ui + 1, nxt);
        const char* nA = has_next ? (const char*)g.A + (size_t)nxt.pm * tstepA : cA; const char* nB = has_next ? (const char*)g.Bt + (size_t)nxt.pn * tstep : cB;
        for (int t = 0; t < nt; t += 2) {
            const bool last = (t == nt - 2);
            const char* a1 = cA + (size_t)(t + 1) * kstep;
            const char* a2 = last ? nA : cA + (size_t)(t + 2) * kstep; const char* b2 = last ? nB : cB + (size_t)(t + 2) * kstep;
            const char* a3 = a2 + kstep; const char* b3 = b2 + kstep;
            PG8_LDB(B0, 0, 0); PG8_LDB(B1, 0, 1); PG8_SCHED; PG8_LDA(At, 0, 0); PG8_STAGE(PG8_SA(1, 1), a1 + hstepA, voffA);
            PG8_WAIT_V(8); PG8_WAIT_L(0); PG8_BAR; PG8_MMA(0, 0, At, B0); PG8_MMA(0, 1, At, B1); PG8_BAR; PG8_SCHED;
            PG8_LDA(At, 0, 1); PG8_STAGE(PG8_SB(0, 0), b2, voffB); PG8_STAGE(PG8_SB(0, 1), b2 + hstep, voffB); PG8_STAGE(PG8_SA(0, 0), a2, voffA);
            PG8_WAIT_V(8); PG8_WAIT_L(0); PG8_BAR; PG8_MMA(1, 0, At, B0); PG8_MMA(1, 1, At, B1); PG8_BAR; PG8_SCHED;
            PG8_LDB(B0, 1, 0); PG8_LDB(B1, 1, 1); PG8_SCHED; PG8_LDA(At, 1, 0); PG8_STAGE(PG8_SA(0, 1), a2 + hstepA, voffA);
            PG8_WAIT_V(8); PG8_WAIT_L(0); PG8_BAR; PG8_MMA(0, 0, At, B0); PG8_MMA(0, 1, At, B1); PG8_BAR; PG8_SCHED;
            PG8_LDA(At, 1, 1); PG8_STAGE(PG8_SB(1, 0), b3, voffB); PG8_STAGE(PG8_SB(1, 1), b3 + hstep, voffB); PG8_STAGE(PG8_SA(1, 0), a3, voffA);
            PG8_WAIT_V(8); PG8_WAIT_L(0); PG8_BAR; PG8_MMA(1, 0, At, B0); PG8_MMA(1, 1, At, B1); PG8_BAR; PG8_SCHED;
        }
        if (wr == 0) PG8_BAR;
        Ep(acc, cur, wr, wc, fr, fq);
        if (!has_next) break;
#pragma unroll
        for (int a = 0; a < 2; ++a)
#pragma unroll
            for (int b = 0; b < 2; ++b)
#pragma unroll
                for (int m = 0; m < 4; ++m)
#pragma unroll
                    for (int n = 0; n < 2; ++n) acc[a][b][m][n] = (f32x4){0.f, 0.f, 0.f, 0.f};
        cur = nxt; cA = nA; cB = nB; ++ui;
        if (wr == 1) PG8_BAR;
    }
    PG8_WAIT_V(0);
    PG8_BAR;
#undef PG8_SA
#undef PG8_SB
#undef PG8_STAGE
#undef PG8_LDA
#undef PG8_LDB
#undef PG8_MMA
#undef PG8_WAIT_V
#undef PG8_WAIT_L
#undef PG8_BAR
#undef PG8_SCHED
}
}

__device__ __forceinline__ u32x4 pack8(f32x4 a, f32x4 b) { u32x4 o; o.x = pack2(a.x, a.y); o.y = pack2(a.z, a.w); o.z = pack2(b.x, b.y); o.w = pack2(b.z, b.w); return o; }
struct EpInProj { bf16_t* proj; bf16_t* qrope; bf16_t* kvp; float* small; const float2* rope; const float* dt_bias;
    __device__ __forceinline__ void operator()(int m, int n0, f32x4 a, f32x4 b) const {
        if (n0 < 2816) {
            const bool is_q = n0 < 512;
            const bool roped_seg = (n0 >= C_KSEL && n0 < C_VSEL) || (n0 >= C_KWIN && n0 < C_VWIN);
            if (roped_seg && (n0 & 32) == 0) {
                f32x4 pa, pb;
                pa.x = __shfl_xor(a.x, 16); pa.y = __shfl_xor(a.y, 16); pa.z = __shfl_xor(a.z, 16); pa.w = __shfl_xor(a.w, 16);
                pb.x = __shfl_xor(b.x, 16); pb.y = __shfl_xor(b.y, 16); pb.z = __shfl_xor(b.z, 16); pb.w = __shfl_xor(b.w, 16);
                if ((n0 & 63) < 16) {
                    const float sgn = (n0 & 8) ? 1.f : -1.f;
                    const f32x4* rp = (const f32x4*)(rope + (m & (SEQ - 1)) * 8);
                    const f32x4 c01 = rp[0], c23 = rp[1], c45 = rp[2], c67 = rp[3];
                    a.x = a.x * c01.x + sgn * pa.x * c01.y; a.y = a.y * c01.z + sgn * pa.y * c01.w;
                    a.z = a.z * c23.x + sgn * pa.z * c23.y; a.w = a.w * c23.z + sgn * pa.w * c23.w;
                    b.x = b.x * c45.x + sgn * pb.x * c45.y; b.y = b.y * c45.z + sgn * pb.y * c45.w;
                    b.z = b.z * c67.x + sgn * pb.z * c67.y; b.w = b.w * c67.z + sgn * pb.w * c67.w;
                }
            }
            const u32x4 o = pack8(a, b);
            if (!is_q && n0 < C_Z) {
                const int r = n0 - C_KCMP, seg = r >> 7, g = (r >> 6) & 1, d = r & 63, bb = m >> 13, t = m & (SEQ - 1);
                *(u32x4*)(kvp + (size_t)seg * KVP_SEG + ((size_t)(bb * 2 + g) * SEQ + t) * 64 + d) = o;
            }
            else *(u32x4*)(proj + (size_t)m * PROJ_LD + n0) = o;
        } else if (n0 < 2848) {
            const int c = n0 - 2816; f32x4 o0, o1;
            if (c < 24) { o0.x = sigmoidf(a.x); o0.y = sigmoidf(a.y); o0.z = sigmoidf(a.z); o0.w = sigmoidf(a.w); o1.x = sigmoidf(b.x); o1.y = sigmoidf(b.y); o1.z = sigmoidf(b.z); o1.w = sigmoidf(b.w); }
            else { const float* db = dt_bias; o0.x = softplusf(a.x + db[0]); o0.y = softplusf(a.y + db[1]); o0.z = softplusf(a.z + db[2]); o0.w = softplusf(a.w + db[3]);
                   o1.x = softplusf(b.x + db[4]); o1.y = softplusf(b.y + db[5]); o1.z = softplusf(b.z + db[6]); o1.w = softplusf(b.w + db[7]); }
            *(f32x4*)(small + (size_t)m * 32 + c) = o0; *(f32x4*)(small + (size_t)m * 32 + c + 4) = o1;
        }
    } };
struct EpCmpHid { bf16_t* hid; const float* bias;
    __device__ __forceinline__ void operator()(int m, int n0, f32x4 a, f32x4 b) const {
        const f32x4 b0 = *(const f32x4*)(bias + n0), b1 = *(const f32x4*)(bias + n0 + 4);
        a.x = gelu_tanh(a.x + b0.x); a.y = gelu_tanh(a.y + b0.y); a.z = gelu_tanh(a.z + b0.z); a.w = gelu_tanh(a.w + b0.w);
        b.x = gelu_tanh(b.x + b1.x); b.y = gelu_tanh(b.y + b1.y); b.z = gelu_tanh(b.z + b1.z); b.w = gelu_tanh(b.w + b1.w);
        *(u32x4*)(hid + (size_t)m * 256 + n0) = pack8(a, b);
    } };
struct EpOutProj { const float* x; const float* mod; bf16_t* x1;
    __device__ __forceinline__ void operator()(int m, int n0, f32x4 a, f32x4 b) const {
        const int bb = m >> 13;
        const f32x4 x0 = __builtin_nontemporal_load((const f32x4*)(x + (size_t)m * DM + n0)), x4 = __builtin_nontemporal_load((const f32x4*)(x + (size_t)m * DM + n0 + 4));
        const f32x4 g0 = *(const f32x4*)(mod + bb * 6144 + 2048 + n0), g4 = *(const f32x4*)(mod + bb * 6144 + 2048 + n0 + 4);
        *(u32x4*)(x1 + (size_t)m * DM + n0) = pack8(x0 + g0 * a, x4 + g4 * b);
    } };
struct EpStoreBf16 { bf16_t* out; int ld; int pad;
    __device__ __forceinline__ void operator()(int m, int n0, f32x4 a, f32x4 b) const { *(u32x4*)(out + (size_t)m * ld + n0) = pack8(a, b); } };

#define CMP_R 4
template <int R>
__device__ __forceinline__ void d_cmp_out(const bf16_t* __restrict__ hid, const float* __restrict__ w2, bf16_t* __restrict__ out, int vb) {
    const int tid_ = tid_opaque(); const int lane = tid_ & 63, m0 = (vb * 8 + (tid_ >> 6)) * R, q = lane >> 4, d4 = lane & 15;
    u32x4 hv[R][8];
#pragma unroll
    for (int r = 0; r < R; ++r)
#pragma unroll
        for (int i = 0; i < 8; ++i) hv[r][i] = *(const u32x4*)(hid + (size_t)(m0 + r) * 256 + q * 64 + i * 8);
    f32x4 a[R];
#pragma unroll
    for (int r = 0; r < R; ++r) a[r] = (f32x4){0.f, 0.f, 0.f, 0.f};
    const float* wq = w2 + (size_t)(q * 64) * 64 + d4 * 4;
#pragma unroll
    for (int i = 0; i < 8; ++i)
#pragma unroll
        for (int e = 0; e < 8; ++e) {
            const f32x4 wv = *(const f32x4*)(wq + (i * 8 + e) * 64);
#pragma unroll
            for (int r = 0; r < R; ++r) {
                const unsigned wd = e < 2 ? hv[r][i].x : e < 4 ? hv[r][i].y : e < 6 ? hv[r][i].z : hv[r][i].w;
                const float h = (e & 1) ? bfhi(wd) : bflo(wd);
                a[r] += wv * h;
            }
        }
#pragma unroll
    for (int r = 0; r < R; ++r)
#pragma unroll
        for (int c = 0; c < 4; ++c) {
            const auto p1 = __builtin_amdgcn_permlane16_swap(__float_as_uint(a[r][c]), __float_as_uint(a[r][c]), false, false);
            const float t = __uint_as_float(p1[0]) + __uint_as_float(p1[1]);
            const auto p2 = __builtin_amdgcn_permlane32_swap(__float_as_uint(t), __float_as_uint(t), false, false);
            a[r][c] = __uint_as_float(p2[0]) + __uint_as_float(p2[1]);
        }
    if (R == 4) {
        const f32x4 s = q == 0 ? a[0] : q == 1 ? a[1 % R] : q == 2 ? a[2 % R] : a[3 % R];
        u32x2 o; o.x = pack2(s.x, s.y); o.y = pack2(s.z, s.w); *(u32x2*)(out + (size_t)(m0 + q) * 64 + d4 * 4) = o;
    } else {
#pragma unroll
        for (int r = 0; r < R; ++r)
            if (q == r) { u32x2 o; o.x = pack2(a[r].x, a[r].y); o.y = pack2(a[r].z, a[r].w); *(u32x2*)(out + (size_t)(m0 + r) * 64 + d4 * 4) = o; }
    }
}

#define KLD 80
#define NSA_OFF_KS0  0
#define NSA_OFF_VT0  10240
#define NSA_OFF_KS1  20480
#define NSA_OFF_VT1  30720
#define NSA_OFF_IMP  40960
#define NSA_OFF_SELW 74752
#define NSA_OFF_ANYW 75776
#define NSA_OFF_BL   75808
#define NSA_OFF_QS   76352
#define NSA_LDS      (76352 + 8 * 32 * KLD * 2)
#define SM_C 0.18033688011112042f

struct KVStage { u32x4 k, v; };
__device__ __forceinline__ void nsa_stage_load(KVStage& st, const bf16_t* kb, const bf16_t* vb, int tid) {
    st.k = *(const u32x4*)(kb + tid * 8); st.v = *(const u32x4*)(vb + tid * 8);
}
__device__ __forceinline__ void nsa_stage_store(bf16_t* Ks, bf16_t* Vt, int tid, const KVStage& st) {
    const int r = tid >> 3, c = tid & 7;
    *(u32x4*)(Ks + r * KLD + c * 8) = st.k;
    *(u32x4*)(Vt + r * KLD + c * 8) = st.v;
}
template <int NROW>
__device__ __forceinline__ void nsa_load_q(const bf16_t* qsrc, size_t ld, int lane, bf16_t* Qs, float qscale) {
    u32x4 r[NROW / 8];
#pragma unroll
    for (int i = 0; i < NROW / 8; ++i) { const int p = lane + 64 * i; r[i] = *(const u32x4*)(qsrc + (size_t)(p >> 3) * ld + (p & 7) * 8); }
#pragma unroll
    for (int i = 0; i < NROW / 8; ++i) {
        const int p = lane + 64 * i;
        u32x4 o;
        o.x = pack2(bflo(r[i].x) * qscale, bfhi(r[i].x) * qscale); o.y = pack2(bflo(r[i].y) * qscale, bfhi(r[i].y) * qscale);
        o.z = pack2(bflo(r[i].z) * qscale, bfhi(r[i].z) * qscale); o.w = pack2(bflo(r[i].w) * qscale, bfhi(r[i].w) * qscale);
        *(u32x4*)(Qs + (p >> 3) * KLD + (p & 7) * 8) = o;
    }
}
template <int NROW>
__device__ __forceinline__ void nsa_load_q_rope(const bf16_t* qsrc, size_t ld, const float2* __restrict__ rope, int t0, int lane, bf16_t* Qs, float qscale = 1.0f) {
    u32x4 r[NROW / 8];
#pragma unroll
    for (int i = 0; i < NROW / 8; ++i) { const int p = lane + 64 * i; r[i] = *(const u32x4*)(qsrc + (size_t)(p >> 3) * ld + (p & 7) * 8); }
#pragma unroll
    for (int i = 0; i < NROW / 8; ++i) {
        const int p = lane + 64 * i, piece = p & 7;
        u32x4 pr;
        pr.x = (unsigned)__shfl_xor((int)r[i].x, 1); pr.y = (unsigned)__shfl_xor((int)r[i].y, 1); pr.z = (unsigned)__shfl_xor((int)r[i].z, 1); pr.w = (unsigned)__shfl_xor((int)r[i].w, 1);
        if (piece < 2) {
            const float sgn = piece ? 1.f : -1.f;
            const f32x4* rp = (const f32x4*)(rope + (size_t)(t0 + (p >> 3)) * 8);
            const f32x4 c01 = rp[0], c23 = rp[1], c45 = rp[2], c67 = rp[3];
            u32x4 o;
            o.x = pack2(bflo(r[i].x) * c01.x + sgn * bflo(pr.x) * c01.y, bfhi(r[i].x) * c01.z + sgn * bfhi(pr.x) * c01.w);
            o.y = pack2(bflo(r[i].y) * c23.x + sgn * bflo(pr.y) * c23.y, bfhi(r[i].y) * c23.z + sgn * bfhi(pr.y) * c23.w);
            o.z = pack2(bflo(r[i].z) * c45.x + sgn * bflo(pr.z) * c45.y, bfhi(r[i].z) * c45.z + sgn * bfhi(pr.z) * c45.w);
            o.w = pack2(bflo(r[i].w) * c67.x + sgn * bflo(pr.w) * c67.y, bfhi(r[i].w) * c67.z + sgn * bfhi(pr.w) * c67.w);
            r[i] = o;
        }
        if (qscale != 1.0f) {
            u32x4 o;
            o.x = pack2(bflo(r[i].x) * qscale, bfhi(r[i].x) * qscale); o.y = pack2(bflo(r[i].y) * qscale, bfhi(r[i].y) * qscale);
            o.z = pack2(bflo(r[i].z) * qscale, bfhi(r[i].z) * qscale); o.w = pack2(bflo(r[i].w) * qscale, bfhi(r[i].w) * qscale);
            r[i] = o;
        }
    }
#pragma unroll
    for (int i = 0; i < NROW / 8; ++i) { const int p = lane + 64 * i; *(u32x4*)(Qs + (p >> 3) * KLD + (p & 7) * 8) = r[i]; }
}
template <int TT>
__device__ __forceinline__ void nsa_qk(const bf16_t* Ks, const bf16_t* Qs, f32x4 (&s)[4][TT], int fr, int fq, const float (&ci)[TT]) {
#pragma unroll
    for (int kt = 0; kt < 4; ++kt)
#pragma unroll
        for (int tt = 0; tt < TT; ++tt) s[kt][tt] = (f32x4){ci[tt], ci[tt], ci[tt], ci[tt]};
#pragma unroll
    for (int ks = 0; ks < 2; ++ks) {
        if (TT > 2) __builtin_amdgcn_sched_barrier(0);
        bf16x8 qf[TT];
#pragma unroll
        for (int tt = 0; tt < TT; ++tt) qf[tt] = *(const bf16x8*)(Qs + (tt * 16 + fr) * KLD + ks * 32 + fq * 8);
#pragma unroll
        for (int kt = 0; kt < 4; ++kt) {
            const bf16x8 kf = *(const bf16x8*)(Ks + (kt * 16 + fr) * KLD + ks * 32 + fq * 8);
#pragma unroll
            for (int tt = 0; tt < TT; ++tt) s[kt][tt] = __builtin_amdgcn_mfma_f32_16x16x32_bf16(kf, qf[tt], s[kt][tt], 0, 0, 0);
        }
    }
}
template <int TT>
__device__ __forceinline__ void nsa_pv(const bf16_t* Vt, const f32x4 (&p)[4][TT], f32x4 (&o)[4][TT], int fr, int fq) {
#pragma unroll
    for (int ks2 = 0; ks2 < 2; ++ks2) {
        bf16x8 pf[TT];
#pragma unroll
        for (int tt = 0; tt < TT; ++tt) {
            const f32x4 a = p[2 * ks2][tt], b = p[2 * ks2 + 1][tt];
            u32x4 w; w.x = pack2(a.x, a.y); w.y = pack2(a.z, a.w); w.z = pack2(b.x, b.y); w.w = pack2(b.z, b.w);
            pf[tt] = __builtin_bit_cast(bf16x8, w);
        }
#pragma unroll
        for (int dt = 0; dt < 4; ++dt) {
            if (TT > 2) __builtin_amdgcn_sched_barrier(0);
            typedef short s16x4 __attribute__((ext_vector_type(4)));
            const bf16_t* vp = Vt + (ks2 * 32 + 4 * fq + (fr >> 2)) * KLD + dt * 16 + 4 * (fr & 3);
            const s16x4 a0 = __builtin_amdgcn_ds_read_tr16_b64_v4i16((__attribute__((address_space(3))) s16x4*)vp);
            const s16x4 a1 = __builtin_amdgcn_ds_read_tr16_b64_v4i16((__attribute__((address_space(3))) s16x4*)(vp + 16 * KLD));
            const bf16x8 vf = (bf16x8){a0.x, a0.y, a0.z, a0.w, a1.x, a1.y, a1.z, a1.w};
#pragma unroll
            for (int tt = 0; tt < TT; ++tt) o[dt][tt] = __builtin_amdgcn_mfma_f32_16x16x32_bf16(vf, pf[tt], o[dt][tt], 0, 0, 0);
        }
    }
}
template <int MK>
__device__ __forceinline__ bool nsa_valid(int kk, int ti, int n0, int t0) {
    if (MK == 1) return kk <= ti;
    if (MK == 2) return kk > ti;
    return 16 * (n0 + kk) + 31 <= t0 + ti;
}
template <int MK, bool WITH_O, int TT>
__device__ __forceinline__ void nsa_softmax(f32x4 (&s)[4][TT], float (&m)[TT], float (&l)[TT], f32x4 (&o)[4][TT], const bool (&selb)[TT], int tib, int fq, int n0, int t0) {
#pragma unroll
    for (int tt = 0; tt < TT; ++tt) {
        const int ti = tib + tt * 16;
        float mx = -1e30f;
#pragma unroll
        for (int kt = 0; kt < 4; ++kt)
#pragma unroll
            for (int jj = 0; jj < 4; ++jj) {
                const int kk = kt * 16 + 4 * fq + jj;
                const bool v = selb[tt] && nsa_valid<MK>(kk, ti, n0, t0);
                const float sv = v ? s[kt][tt][jj] * SM_C : -1e30f;
                s[kt][tt][jj] = sv; mx = fmaxf(mx, sv);
            }
        mx = fmaxf(mx, __shfl_xor(mx, 16)); mx = fmaxf(mx, __shfl_xor(mx, 32));
        const float mn = fmaxf(m[tt], mx);
        const float alpha = __builtin_amdgcn_exp2f(m[tt] - mn);
        m[tt] = mn;
        float ls = 0.f;
#pragma unroll
        for (int kt = 0; kt < 4; ++kt)
#pragma unroll
            for (int jj = 0; jj < 4; ++jj) {
                const float sv = s[kt][tt][jj];
                const float pv = sv > -1e29f ? __builtin_amdgcn_exp2f(sv - mn) : 0.f;
                s[kt][tt][jj] = pv; ls += pv;
            }
        l[tt] = l[tt] * alpha + ls;
        if (WITH_O) {
#pragma unroll
            for (int dt = 0; dt < 4; ++dt) o[dt][tt] *= alpha;
        }
    }
}
__device__ __forceinline__ float vmax2(float a, float b) { float r; asm("v_max_f32 %0, %1, %2" : "=v"(r) : "v"(a), "v"(b)); return r; }
__device__ __forceinline__ float vmax3(float a, float b, float c) { float r; asm("v_max3_f32 %0, %1, %2, %3" : "=v"(r) : "v"(a), "v"(b), "v"(c)); return r; }
__device__ __forceinline__ float vmax2_pad(float a, float b) { float r; asm("v_max_f32 %0, %1, %2\n\ts_nop 1" : "=v"(r) : "v"(a), "v"(b)); return r; }
__device__ __forceinline__ float quad_max(float x) {
    const unsigned u = __float_as_uint(x);
    const auto r = __builtin_amdgcn_permlane16_swap(u, u, false, false);
    const float y = vmax2_pad(__uint_as_float(r[0]), __uint_as_float(r[1]));
    const unsigned v = __float_as_uint(y);
    const auto r2 = __builtin_amdgcn_permlane32_swap(v, v, false, false);
    return vmax2(__uint_as_float(r2[0]), __uint_as_float(r2[1]));
}
template <bool WITH_O = true, int TT = 2>
__device__ __forceinline__ void nsa_softmax_fast(f32x4 (&s)[4][TT], float (&m)[TT], float (&l)[TT], f32x4 (&o)[4][TT], const float (&bias)[TT]) {
    __builtin_amdgcn_sched_barrier(0);
    asm volatile("s_nop 7\n\ts_nop 7" ::: );
    __builtin_amdgcn_sched_barrier(0);
#pragma unroll
    for (int tt = 0; tt < TT; ++tt) {
        const float a0 = vmax3(s[0][tt][0], s[0][tt][1], s[0][tt][2]), a1 = vmax3(s[0][tt][3], s[1][tt][0], s[1][tt][1]), a2 = vmax3(s[1][tt][2], s[1][tt][3], s[2][tt][0]);
        const float a3 = vmax3(s[2][tt][1], s[2][tt][2], s[2][tt][3]), a4 = vmax3(s[3][tt][0], s[3][tt][1], s[3][tt][2]);
        const float mr = quad_max(vmax2_pad(vmax3(a0, a1, a2), vmax3(a3, a4, s[3][tt][3])));
        const float mx = mr * SM_C + bias[tt];
        const float mold = m[tt], mn = vmax2(mold, mx);
        m[tt] = mn;
        const float off = bias[tt] - mn;
        const f32x2 c2 = {SM_C, SM_C}, off2 = {off, off};
        f32x2 ls2 = {0.f, 0.f};
#pragma unroll
        for (int kt = 0; kt < 4; ++kt) {
            const f32x2 x0 = __builtin_elementwise_fma((f32x2){s[kt][tt][0], s[kt][tt][1]}, c2, off2), x1 = __builtin_elementwise_fma((f32x2){s[kt][tt][2], s[kt][tt][3]}, c2, off2);
            const f32x2 p0 = {__builtin_amdgcn_exp2f(x0.x), __builtin_amdgcn_exp2f(x0.y)}, p1 = {__builtin_amdgcn_exp2f(x1.x), __builtin_amdgcn_exp2f(x1.y)};
            s[kt][tt] = (f32x4){p0.x, p0.y, p1.x, p1.y};
            ls2 += p0; ls2 += p1;
        }
        const float ls = ls2.x + ls2.y;
        if (__builtin_amdgcn_ballot_w64(mn > mold) != 0ull) {
            const float alpha = __builtin_amdgcn_exp2f(mold - mn);
            l[tt] = l[tt] * alpha + ls;
            if (WITH_O) {
#pragma unroll
                for (int dt = 0; dt < 4; ++dt) o[dt][tt] *= alpha;
            }
        } else l[tt] += ls;
    }
}
template <bool WITH_O = true, int TT = 4, bool READY = false>
__device__ __forceinline__ void nsa_softmax_stale(f32x4 (&s)[4][TT], float (&m)[TT], float (&l)[TT], f32x4 (&o)[4][TT], const float (&bias)[TT]) {
    float lsv[TT];
    int odd = 0;
#pragma unroll
    for (int tt = 0; tt < TT; ++tt) {
        const float off = bias[tt] - m[tt];
        const f32x2 c2 = {SM_C, SM_C}, off2 = {off, off};
        f32x2 ls2 = {0.f, 0.f};
#pragma unroll
        for (int kt = 0; kt < 4; ++kt) {
            const f32x2 x0 = READY ? (f32x2){s[kt][tt][0], s[kt][tt][1]} : __builtin_elementwise_fma((f32x2){s[kt][tt][0], s[kt][tt][1]}, c2, off2);
            const f32x2 x1 = READY ? (f32x2){s[kt][tt][2], s[kt][tt][3]} : __builtin_elementwise_fma((f32x2){s[kt][tt][2], s[kt][tt][3]}, c2, off2);
            const f32x2 p0 = {__builtin_amdgcn_exp2f(x0.x), __builtin_amdgcn_exp2f(x0.y)}, p1 = {__builtin_amdgcn_exp2f(x1.x), __builtin_amdgcn_exp2f(x1.y)};
            s[kt][tt] = (f32x4){p0.x, p0.y, p1.x, p1.y};
            ls2 += p0; ls2 += p1;
        }
        lsv[tt] = ls2.x + ls2.y;
        l[tt] += lsv[tt];
        odd |= (int)(lsv[tt] > 1048576.0f) | ((int)(l[tt] > 0.f) & (int)(l[tt] < 9.0e-13f));
    }
    if (__builtin_amdgcn_ballot_w64(odd != 0) != 0ull) {
#pragma unroll
        for (int tt = 0; tt < TT; ++tt) {
            const float t = quad_max(l[tt]);
            int k = t > 0.f ? (int)((__float_as_uint(t) >> 23) & 0xFFu) - 127 : 0;
            k = k > 100 ? 100 : (k < -100 ? -100 : k);
            const float alpha = __uint_as_float((unsigned)(127 - k) << 23);
            m[tt] += (float)k; l[tt] *= alpha;
#pragma unroll
            for (int kt = 0; kt < 4; ++kt) s[kt][tt] *= alpha;
            if (WITH_O) {
#pragma unroll
                for (int dt = 0; dt < 4; ++dt) o[dt][tt] *= alpha;
            }
        }
    }
}
__device__ __forceinline__ void ins16(unsigned (&L)[16], unsigned x) {
#pragma unroll
    for (int i = 0; i < 16; ++i) { const unsigned hi = L[i] > x ? L[i] : x; x = L[i] > x ? x : L[i]; L[i] = hi; }
}
__device__ __forceinline__ void merge16(unsigned (&L)[16], const unsigned (&P)[16]) {
#pragma unroll
    for (int i = 0; i < 16; ++i) L[i] = L[i] > P[15 - i] ? L[i] : P[15 - i];
#pragma unroll
    for (int st = 8; st >= 1; st >>= 1)
#pragma unroll
        for (int i = 0; i < 16; ++i)
            if ((i & st) == 0) { const unsigned a = L[i], b = L[i + st]; L[i] = a > b ? a : b; L[i + st] = a > b ? b : a; }
}
__device__ __forceinline__ void sort16(unsigned (&v)[16]) {
#define CE(i, j) do { const unsigned a_ = v[i], b_ = v[j]; v[i] = a_ > b_ ? a_ : b_; v[j] = a_ > b_ ? b_ : a_; } while (0)
    CE(0, 13); CE(1, 12); CE(2, 15); CE(3, 14); CE(4, 8); CE(5, 6); CE(7, 11); CE(9, 10); CE(0, 5); CE(1, 7); CE(2, 9); CE(3, 4); CE(6, 13); CE(8, 14); CE(10, 15); CE(11, 12); CE(0, 1); CE(2, 3); CE(4, 5); CE(6, 8); CE(7, 9); CE(10, 11); CE(12, 13); CE(14, 15); CE(0, 2); CE(1, 3); CE(4, 10); CE(5, 11); CE(6, 7); CE(8, 9); CE(12, 14); CE(13, 15); CE(1, 2); CE(3, 12); CE(4, 6); CE(5, 7); CE(8, 10); CE(9, 11); CE(13, 14); CE(1, 4); CE(2, 6); CE(5, 8); CE(7, 10); CE(9, 13); CE(11, 14); CE(2, 4); CE(3, 6); CE(9, 12); CE(11, 13); CE(3, 5); CE(6, 8); CE(7, 9); CE(10, 12); CE(3, 4); CE(5, 6); CE(7, 8); CE(9, 10); CE(11, 12); CE(6, 7); CE(8, 9);
#undef CE
}
template <int TT>
__device__ __forceinline__ void nsa_scale(const f32x4 (&o)[4][TT], const float (&l)[TT], bool l_is_partial, const float* gsrc, int tib, f32x4 (&r)[4][TT], bool accum) {
#pragma unroll
    for (int tt = 0; tt < TT; ++tt) {
        float lt = l[tt];
        if (l_is_partial) { lt += __shfl_xor(lt, 16); lt += __shfl_xor(lt, 32); }
        const float gv = gsrc[(size_t)(tib + tt * 16) * 32];
        const float sc = l_is_partial ? (lt > 0.f ? gv / lt : 0.f) : gv;
#pragma unroll
        for (int dt = 0; dt < 4; ++dt) r[dt][tt] = accum ? r[dt][tt] + o[dt][tt] * sc : o[dt][tt] * sc;
    }
}
template <bool ACCUM, int TT>
__device__ __forceinline__ void nsa_store(const f32x4 (&r)[4][TT], bf16_t* obase, int tib, int fq) {
#pragma unroll
    for (int tt = 0; tt < TT; ++tt)
#pragma unroll
        for (int dp = 0; dp < 2; ++dp) {
            const f32x4 a = r[2 * dp][tt], b = r[2 * dp + 1][tt];
            float lo[4], hi[4];
#pragma unroll
            for (int c = 0; c < 4; ++c) {
                const auto q = __builtin_amdgcn_permlane16_swap(__float_as_uint(a[c]), __float_as_uint(b[c]), false, false);
                lo[c] = __uint_as_float(q[0]); hi[c] = __uint_as_float(q[1]);
            }
            bf16_t* op = obase + (size_t)(tib + tt * 16) * 512 + (2 * dp + (fq & 1)) * 16 + 8 * (fq >> 1);
            if (ACCUM) {
                const u32x4 t = *(const u32x4*)op;
                lo[0] += bflo(t.x); lo[1] += bfhi(t.x); lo[2] += bflo(t.y); lo[3] += bfhi(t.y); hi[0] += bflo(t.z); hi[1] += bfhi(t.z); hi[2] += bflo(t.w); hi[3] += bfhi(t.w);
            }
            u32x4 w; w.x = pack2(lo[0], lo[1]); w.y = pack2(lo[2], lo[3]); w.z = pack2(hi[0], hi[1]); w.w = pack2(hi[2], hi[3]);
            *(u32x4*)op = w;
        }
}
struct NsaBufs { bf16_t *Ks0, *Vt0, *Ks1, *Vt1; };
template <class SRC, class BODY>
__device__ __forceinline__ void nsa_pipeline(int n, const bf16_t* kb, const bf16_t* vb, const NsaBufs& B, int tid, SRC src, BODY body) {
    KVStage s0, s1;
    const int nl = n - 1;
    int q0 = src(0), q1 = src(1 < nl ? 1 : nl), q2 = src(2 < nl ? 2 : nl);
    nsa_stage_load(s0, kb + (size_t)q0 * 4096, vb + (size_t)q0 * 4096, tid);
    nsa_stage_load(s1, kb + (size_t)q1 * 4096, vb + (size_t)q1 * 4096, tid);
    __syncthreads();
    nsa_stage_store(B.Ks0, B.Vt0, tid, s0);
    nsa_stage_load(s0, kb + (size_t)q2 * 4096, vb + (size_t)q2 * 4096, tid);
#pragma unroll 1
    for (int i = 0; i < n; i += 2) {
        const int l3 = src(i + 3 < nl ? i + 3 : nl);
        __syncthreads();
        nsa_stage_store(B.Ks1, B.Vt1, tid, s1);
        nsa_stage_load(s1, kb + (size_t)l3 * 4096, vb + (size_t)l3 * 4096, tid);
        body(q0, B.Ks0, B.Vt0);
        const int l4 = src(i + 4 < nl ? i + 4 : nl);
        __syncthreads();
        nsa_stage_store(B.Ks0, B.Vt0, tid, s0);
        nsa_stage_load(s0, kb + (size_t)l4 * 4096, vb + (size_t)l4 * 4096, tid);
        if (i + 1 < n) body(q1, B.Ks1, B.Vt1);
        q0 = q2; q1 = l3; q2 = l4;
    }
}

__device__ __forceinline__ void d_nsa_cmp(const bf16_t* __restrict__ proj, const bf16_t* __restrict__ kc, const bf16_t* __restrict__ vc,
                                          const float* __restrict__ small, bf16_t* __restrict__ onsa, unsigned* __restrict__ selrec, int b, int g, int qt, char* lds) {
    const NsaBufs B{(bf16_t*)(lds + NSA_OFF_KS0), (bf16_t*)(lds + NSA_OFF_VT0), (bf16_t*)(lds + NSA_OFF_KS1), (bf16_t*)(lds + NSA_OFF_VT1)};
    float* imp = (float*)(lds + NSA_OFF_IMP);
    unsigned* selw = (unsigned*)(lds + NSA_OFF_SELW);
    unsigned* anyw = (unsigned*)(lds + NSA_OFF_ANYW);
    int* blist = (int*)(lds + NSA_OFF_BL);
    const int tid = tid_opaque(), lane = tid & 63, w = tid >> 6, hd = w & 3, th = w >> 2, fr = lane & 15, fq = lane >> 4;
    const int tib = th * 32 + fr;
    const size_t tok0 = (size_t)b * SEQ + (size_t)qt * 64;
    const int t0 = qt * 64;
    const float* gbase = small + tok0 * 32 + g * 12 + hd * 3;
    bf16_t* obase = onsa + tok0 * 512 + g * 256 + hd * 64;
    const bool sel_all[2] = {true, true};
    const float bias0[2] = {0.f, 0.f};

    for (int i = tid; i < 64 * 132; i += 512) imp[i] = 0.f;
    if (tid < 4) anyw[tid] = 0u;

    bf16_t* Qs = (bf16_t*)(lds + NSA_OFF_QS) + w * 32 * KLD;
    f32x4 s[4][2], o[4][2];
    float m[2], l[2];

    nsa_load_q<32>(proj + (tok0 + th * 32) * PROJ_LD + C_Q + g * 256 + hd * 64, PROJ_LD, lane, Qs, SM_C);
    const int ncb = (4 * qt + 3 + 63) >> 6;
    {
        const bf16_t* kb = kc + (size_t)(b * 2 + g) * 512 * 64;
        const bf16_t* vb = vc + (size_t)(b * 2 + g) * 512 * 64;
#pragma unroll
        for (int tt = 0; tt < 2; ++tt) { m[tt] = 0.f; l[tt] = 0.f; }
        nsa_pipeline(ncb, kb, vb, B, tid, [&](int i) { return i; }, [&](int blk_, bf16_t* Ks, bf16_t* Vt) {
            const float ci1[2] = {-m[0], -m[1]};
            nsa_qk(Ks, Qs, s, fr, fq, ci1);
            if (16 * (blk_ * 64 + 63) + 31 > t0) {
#pragma unroll
                for (int tt = 0; tt < 2; ++tt)
#pragma unroll
                    for (int kt = 0; kt < 4; ++kt)
#pragma unroll
                        for (int jj = 0; jj < 4; ++jj) if (!nsa_valid<3>(kt * 16 + 4 * fq + jj, tib + tt * 16, blk_ * 64, t0)) s[kt][tt][jj] = -3e38f;
            }
            nsa_softmax_stale<false, 2, true>(s, m, l, o, bias0);
        });
        float linv[2];
#pragma unroll
        for (int tt = 0; tt < 2; ++tt) { float lt = l[tt]; lt += __shfl_xor(lt, 16); lt += __shfl_xor(lt, 32); linv[tt] = lt > 0.f ? -m[tt] - __log2f(lt) : -1e30f; }
#pragma unroll
        for (int dt = 0; dt < 4; ++dt)
#pragma unroll
            for (int tt = 0; tt < 2; ++tt) o[dt][tt] = (f32x4){0.f, 0.f, 0.f, 0.f};
        nsa_pipeline(ncb, kb, vb, B, tid, [&](int i) { return i; }, [&](int blk_, bf16_t* Ks, bf16_t* Vt) {
            nsa_qk(Ks, Qs, s, fr, fq, linv);
            const bool full = 16 * (blk_ * 64 + 63) + 31 <= t0;
#pragma unroll
            for (int tt = 0; tt < 2; ++tt) {
                const int ti = tib + tt * 16;
                float hs[4], as[4];
#pragma unroll
                for (int kt = 0; kt < 4; ++kt) {
                    f32x4 pv;
                    if (full) {
#pragma unroll
                        for (int jj = 0; jj < 4; ++jj) pv[jj] = __builtin_amdgcn_exp2f(s[kt][tt][jj]);
                    } else {
#pragma unroll
                        for (int jj = 0; jj < 4; ++jj) {
                            const int kk = kt * 16 + 4 * fq + jj;
                            pv[jj] = nsa_valid<3>(kk, ti, blk_ * 64, t0) ? __builtin_amdgcn_exp2f(s[kt][tt][jj]) : 0.f;
                        }
                    }
                    s[kt][tt] = pv;
                    hs[kt] = 0.5f * pv[3]; as[kt] = pv[0] + pv[1] + pv[2] + hs[kt];
                }
                float r1[4];
#pragma unroll
                for (int kt = 0; kt < 4; ++kt) r1[kt] = __shfl(hs[kt], (lane + 48) & 63);
#pragma unroll
                for (int kt = 0; kt < 4; ++kt) {
                    const float recv = fq > 0 ? r1[kt] : (kt > 0 ? r1[kt - 1] : 0.f);
                    const int j = blk_ * 16 + kt * 4 + fq;
                    atomicAdd(imp + ti * 132 + (j >> 5) * 33 + (j & 31), as[kt] + recv);
                }
                if (fq == 3) { const int j1 = blk_ * 16 + 16; if (j1 < 128) atomicAdd(imp + ti * 132 + (j1 >> 5) * 33 + (j1 & 31), hs[3]); }
            }
            nsa_pv(Vt, s, o, fr, fq);
        });
        nsa_scale(o, l, false, gbase + 0, tib, o, false);
        nsa_store<false, 2>(o, obase, tib, fq);
    }
    __syncthreads();
    {
        const int ti = tid >> 3, q8 = tid & 7;
        unsigned L[16];
#pragma unroll
        for (int i = 0; i < 16; ++i) {
            const int j = q8 * 16 + i;
            const bool forced = (j == 0) || (j == qt) || (j == qt - 1);
            const float v = imp[ti * 132 + (j >> 5) * 33 + (j & 31)] + (forced ? 1e4f : 0.f) + 1e-30f;
            L[i] = (j <= qt) ? ((__float_as_uint(v) & ~0x7Fu) | (unsigned)(127 - j)) : 0u;
        }
        sort16(L);
#pragma unroll
        for (int r = 1; r <= 4; r <<= 1) {
            unsigned P[16];
#pragma unroll
            for (int i = 0; i < 16; ++i) P[i] = (unsigned)__shfl_xor((int)L[i], r);
            merge16(L, P);
        }
        if (q8 < 4) {
            unsigned word = 0u;
#pragma unroll
            for (int i = 0; i < 16; ++i) {
                const unsigned e = L[i];
                const int j = 127 - (int)(e & 0x7Fu);
                if (e != 0u && (j >> 5) == q8) word |= 1u << (j & 31);
            }
            selw[ti * 4 + q8] = word;
            atomicOr(&anyw[q8], word);
        }
    }
    __syncthreads();
    int nsel;
    {
        const unsigned a0 = anyw[0], a1 = anyw[1], a2 = anyw[2], a3 = anyw[3];
        if (tid < 128) {
            const unsigned wd = tid < 32 ? a0 : tid < 64 ? a1 : tid < 96 ? a2 : a3;
            if ((wd >> (tid & 31)) & 1u) {
                int pos = __popc(wd & ((1u << (tid & 31)) - 1u));
                if (tid >= 32) pos += __popc(a0);
                if (tid >= 64) pos += __popc(a1);
                if (tid >= 96) pos += __popc(a2);
                blist[pos] = tid;
            }
        }
        nsel = __builtin_amdgcn_readfirstlane(__popc(a0) + __popc(a1) + __popc(a2) + __popc(a3));
    }
    __syncthreads();
    if (tid < 256) selrec[tid] = selw[tid];
    if (tid < 128) selrec[256 + tid] = (unsigned)blist[tid];
    if (tid == 0) selrec[384] = (unsigned)nsel;
    __syncthreads();
}

template <bool TAIL, int TT>
__device__ __forceinline__ void nsa_mask_block(f32x4 (&s)[4][TT], int fr, int fq) {
    bool keep[4];
#pragma unroll
    for (int jj = 0; jj < 4; ++jj) keep[jj] = TAIL ? (4 * fq + jj > fr) : (4 * fq + jj <= fr);
#pragma unroll
    for (int tt = 0; tt < TT; ++tt)
#pragma unroll
        for (int kt = 0; kt < 4; ++kt) {
            const bool all_keep = TAIL ? (kt > tt) : (kt < tt), none_keep = TAIL ? (kt < tt) : (kt > tt);
            if (all_keep) continue;
#pragma unroll
            for (int jj = 0; jj < 4; ++jj) if (none_keep || !keep[jj]) s[kt][tt][jj] = -3e38f;
        }
}
template <bool TAIL, int KT0>
__device__ __forceinline__ void nsa_mask_kt2(f32x4 (&s)[4][4], int fr, int fq) {
    bool keep[4];
#pragma unroll
    for (int jj = 0; jj < 4; ++jj) keep[jj] = TAIL ? (4 * fq + jj > fr) : (4 * fq + jj <= fr);
#pragma unroll
    for (int tt = 0; tt < 4; ++tt)
#pragma unroll
        for (int kt = KT0; kt < KT0 + 2; ++kt) {
            const bool all_keep = TAIL ? (kt > tt) : (kt < tt), none_keep = TAIL ? (kt < tt) : (kt > tt);
            if (all_keep) continue;
            f32x4 v = s[kt][tt];
            v.x = (none_keep || !keep[0]) ? -3e38f : v.x; v.y = (none_keep || !keep[1]) ? -3e38f : v.y;
            v.z = (none_keep || !keep[2]) ? -3e38f : v.z; v.w = (none_keep || !keep[3]) ? -3e38f : v.w;
            s[kt][tt] = v;
        }
}
__device__ __forceinline__ void nsa_sm_item(f32x4& sv) {
    sv = (f32x4){__builtin_amdgcn_exp2f(sv[0]), __builtin_amdgcn_exp2f(sv[1]), __builtin_amdgcn_exp2f(sv[2]), __builtin_amdgcn_exp2f(sv[3])};
}
__device__ __forceinline__ void nsa_pin(f32x4& v) { float a = v[0], b = v[1], c = v[2], d = v[3]; asm volatile("" : "+v"(a), "+v"(b), "+v"(c), "+v"(d)); v = (f32x4){a, b, c, d}; }
__device__ __forceinline__ void nsa_block_split(const bf16_t* Ks, const bf16_t* Vt, const bf16_t* Qs, f32x4 (&s)[4][4], float (&m)[4], f32x4 (&lt)[4], f32x4 (&o)[4][4],
                                                const float (&bias)[4], int mk, int fr, int fq) {
    typedef short s16x4 __attribute__((ext_vector_type(4)));
    const bf16_t* kb = Ks + fr * KLD + fq * 8; const bf16_t* qb = Qs + fr * KLD + fq * 8;
    const bf16_t* vbase = Vt + (4 * fq + (fr >> 2)) * KLD + 4 * (fr & 3);
    float off[4];
#pragma unroll
    for (int tt = 0; tt < 4; ++tt) off[tt] = bias[tt] - m[tt];
    const bf16x8 ones = {0x3F80, 0x3F80, 0x3F80, 0x3F80, 0x3F80, 0x3F80, 0x3F80, 0x3F80};
#pragma unroll
    for (int kt = 0; kt < 4; ++kt)
#pragma unroll
        for (int tt = 0; tt < 4; ++tt) s[kt][tt] = (f32x4){off[tt], off[tt], off[tt], off[tt]};
#pragma unroll
    for (int ks = 0; ks < 2; ++ks) {
        bf16x8 qf[4];
#pragma unroll
        for (int tt = 0; tt < 4; ++tt) qf[tt] = *(const bf16x8*)(qb + tt * 16 * KLD + ks * 32);
#pragma unroll
        for (int kt = 0; kt < 2; ++kt) {
            const bf16x8 kf = *(const bf16x8*)(kb + kt * 16 * KLD + ks * 32);
#pragma unroll
            for (int tt = 0; tt < 4; ++tt) s[kt][tt] = __builtin_amdgcn_mfma_f32_16x16x32_bf16(kf, qf[tt], s[kt][tt], 0, 0, 0);
        }
        __builtin_amdgcn_sched_barrier(0);
    }
    if (mk == 1) nsa_mask_kt2<false, 0>(s, fr, fq); else if (mk == 2) nsa_mask_kt2<true, 0>(s, fr, fq);
    __builtin_amdgcn_sched_barrier(0);
#define NSA_QKB_GROUP(KS, KT, SKT, STT) do { \
        const bf16x8 kf_ = *(const bf16x8*)(kb + (KT) * 16 * KLD + (KS) * 32); \
        s[KT][0] = __builtin_amdgcn_mfma_f32_16x16x32_bf16(kf_, qf[0], s[KT][0], 0, 0, 0); s[KT][1] = __builtin_amdgcn_mfma_f32_16x16x32_bf16(kf_, qf[1], s[KT][1], 0, 0, 0); \
        s[KT][2] = __builtin_amdgcn_mfma_f32_16x16x32_bf16(kf_, qf[2], s[KT][2], 0, 0, 0); s[KT][3] = __builtin_amdgcn_mfma_f32_16x16x32_bf16(kf_, qf[3], s[KT][3], 0, 0, 0); \
        nsa_sm_item(s[SKT][STT]); nsa_sm_item(s[SKT][(STT) + 1]); \
        nsa_pin(s[SKT][STT]); nsa_pin(s[SKT][(STT) + 1]);        \
        __builtin_amdgcn_sched_barrier(0); } while (0)
    {
        bf16x8 qf[4];
        qf[0] = *(const bf16x8*)(qb); qf[1] = *(const bf16x8*)(qb + 16 * KLD); qf[2] = *(const bf16x8*)(qb + 32 * KLD); qf[3] = *(const bf16x8*)(qb + 48 * KLD);
        NSA_QKB_GROUP(0, 2, 0, 0);
        NSA_QKB_GROUP(0, 3, 0, 2);
        qf[0] = *(const bf16x8*)(qb + 32); qf[1] = *(const bf16x8*)(qb + 16 * KLD + 32); qf[2] = *(const bf16x8*)(qb + 32 * KLD + 32); qf[3] = *(const bf16x8*)(qb + 48 * KLD + 32);
        NSA_QKB_GROUP(1, 2, 1, 0);
        NSA_QKB_GROUP(1, 3, 1, 2);
    }
#undef NSA_QKB_GROUP
    if (mk == 1) nsa_mask_kt2<false, 2>(s, fr, fq); else if (mk == 2) nsa_mask_kt2<true, 2>(s, fr, fq);
    __builtin_amdgcn_sched_barrier(0);
    {
        bf16x8 pf[4];
#pragma unroll
        for (int tt = 0; tt < 4; ++tt) {
            const f32x4 a = s[0][tt], b = s[1][tt];
            u32x4 w; w.x = pack2(a.x, a.y); w.y = pack2(a.z, a.w); w.z = pack2(b.x, b.y); w.w = pack2(b.z, b.w);
            pf[tt] = __builtin_bit_cast(bf16x8, w);
        }
#define NSA_PVA_GROUP(DT, SKT, STT) do { \
            const bf16_t* vp_ = vbase + (DT) * 16; \
            const s16x4 a0_ = __builtin_amdgcn_ds_read_tr16_b64_v4i16((__attribute__((address_space(3))) s16x4*)vp_); \
            const s16x4 a1_ = __builtin_amdgcn_ds_read_tr16_b64_v4i16((__attribute__((address_space(3))) s16x4*)(vp_ + 16 * KLD)); \
            const bf16x8 vf_ = (bf16x8){a0_.x, a0_.y, a0_.z, a0_.w, a1_.x, a1_.y, a1_.z, a1_.w}; \
            o[DT][0] = __builtin_amdgcn_mfma_f32_16x16x32_bf16(vf_, pf[0], o[DT][0], 0, 0, 0); o[DT][1] = __builtin_amdgcn_mfma_f32_16x16x32_bf16(vf_, pf[1], o[DT][1], 0, 0, 0); \
            o[DT][2] = __builtin_amdgcn_mfma_f32_16x16x32_bf16(vf_, pf[2], o[DT][2], 0, 0, 0); o[DT][3] = __builtin_amdgcn_mfma_f32_16x16x32_bf16(vf_, pf[3], o[DT][3], 0, 0, 0); \
            nsa_sm_item(s[SKT][STT]); nsa_sm_item(s[SKT][(STT) + 1]); \
            __builtin_amdgcn_sched_barrier(0); } while (0)
#pragma unroll
        for (int tt = 0; tt < 4; ++tt) lt[tt] = __builtin_amdgcn_mfma_f32_16x16x32_bf16(ones, pf[tt], lt[tt], 0, 0, 0);
        NSA_PVA_GROUP(0, 2, 0);
        NSA_PVA_GROUP(1, 2, 2);
        NSA_PVA_GROUP(2, 3, 0);
        NSA_PVA_GROUP(3, 3, 2);
#undef NSA_PVA_GROUP
    }
    {
        bf16x8 pf[4];
#pragma unroll
        for (int tt = 0; tt < 4; ++tt) {
            const f32x4 a = s[2][tt], b = s[3][tt];
            u32x4 w; w.x = pack2(a.x, a.y); w.y = pack2(a.z, a.w); w.z = pack2(b.x, b.y); w.w = pack2(b.z, b.w);
            pf[tt] = __builtin_bit_cast(bf16x8, w);
        }
#pragma unroll
        for (int dt = 0; dt < 4; ++dt) {
            const bf16_t* vp = vbase + 32 * KLD + dt * 16;
            const s16x4 a0 = __builtin_amdgcn_ds_read_tr16_b64_v4i16((__attribute__((address_space(3))) s16x4*)vp);
            const s16x4 a1 = __builtin_amdgcn_ds_read_tr16_b64_v4i16((__attribute__((address_space(3))) s16x4*)(vp + 16 * KLD));
            const bf16x8 vf = (bf16x8){a0.x, a0.y, a0.z, a0.w, a1.x, a1.y, a1.z, a1.w};
#pragma unroll
            for (int tt = 0; tt < 4; ++tt) o[dt][tt] = __builtin_amdgcn_mfma_f32_16x16x32_bf16(vf, pf[tt], o[dt][tt], 0, 0, 0);
        }
#pragma unroll
        for (int tt = 0; tt < 4; ++tt) lt[tt] = __builtin_amdgcn_mfma_f32_16x16x32_bf16(ones, pf[tt], lt[tt], 0, 0, 0);
    }
    int odd = 0;
#pragma unroll
    for (int tt = 0; tt < 4; ++tt) odd |= (int)(lt[tt][0] > 1073741824.0f) | ((int)(lt[tt][0] > 0.f) & (int)(lt[tt][0] < 9.0e-13f));
    if (__builtin_amdgcn_ballot_w64(odd != 0) != 0ull) {
#pragma unroll
        for (int tt = 0; tt < 4; ++tt) {
            const float t = lt[tt][0];
            int k = t > 0.f ? (int)((__float_as_uint(t) >> 23) & 0xFFu) - 127 : 0;
            k = k > 100 ? 100 : (k < -100 ? -100 : k);
            const float alpha = __uint_as_float((unsigned)(127 - k) << 23);
            m[tt] += (float)k; lt[tt] *= alpha;
#pragma unroll
            for (int dt = 0; dt < 4; ++dt) o[dt][tt] *= alpha;
        }
    }
}
#define NB2_OFF_SELW 40960
#define NB2_OFF_ANYW 43008
#define NB2_OFF_BL   43040
#define NB2_OFF_QS   43776
__device__ __forceinline__ void d_nsa_attn128(const bf16_t* __restrict__ proj, const float2* __restrict__ rope, const bf16_t* __restrict__ kvp, const float* __restrict__ small, bf16_t* __restrict__ onsa,
                                              const unsigned* __restrict__ selrec_bg, int b, int g, int qt2, char* lds) {
    const NsaBufs B{(bf16_t*)(lds + 0), (bf16_t*)(lds + 20480), (bf16_t*)(lds + 10240), (bf16_t*)(lds + 30720)};
    unsigned* selw = (unsigned*)(lds + NB2_OFF_SELW);
    unsigned* anyw = (unsigned*)(lds + NB2_OFF_ANYW);
    int* blist = (int*)(lds + NB2_OFF_BL);
    const int tid = tid_opaque(), lane = tid & 63, w = tid >> 6, hd = w & 3, th = w >> 2, fr = lane & 15, fq = lane >> 4;
    const int bt = 2 * qt2 + th;
    const size_t tokw = (size_t)b * SEQ + (size_t)bt * 64;
    const float* gbase = small + tokw * 32 + g * 12 + hd * 3;
    bf16_t* obase = onsa + tokw * 512 + g * 256 + hd * 64;
    const float bias0[4] = {0.f, 0.f, 0.f, 0.f};
    bf16_t* Qs = (bf16_t*)(lds + NB2_OFF_QS) + w * 64 * KLD;
    f32x4 s[4][4], o[4][4];
    float m[4], l[4];
    f32x4 lt[4];
    selw[tid] = selrec_bg[(size_t)(2 * qt2 + (tid >> 8)) * 512 + (tid & 255)];
    if (tid < 4) anyw[tid] = 0u;
    __syncthreads();
    atomicOr(&anyw[tid & 3], selw[tid]);
    __syncthreads();
    int nsel;
    {
        const unsigned a0 = anyw[0], a1 = anyw[1], a2 = anyw[2], a3 = anyw[3];
        if (tid < 128) {
            const unsigned wd = tid < 32 ? a0 : tid < 64 ? a1 : tid < 96 ? a2 : a3;
            if ((wd >> (tid & 31)) & 1u) {
                int pos = __popc(wd & ((1u << (tid & 31)) - 1u));
                if (tid >= 32) pos += __popc(a0);
                if (tid >= 64) pos += __popc(a1);
                if (tid >= 96) pos += __popc(a2);
                blist[pos] = tid;
            }
        }
        nsel = __builtin_amdgcn_readfirstlane(__popc(a0) + __popc(a1) + __popc(a2) + __popc(a3));
    }
    __syncthreads();
    nsa_load_q_rope<64>(proj + tokw * PROJ_LD + C_Q + g * 256 + hd * 64, PROJ_LD, rope, bt * 64, lane, Qs, SM_C);
    {
        const bf16_t* kb = kvp + 2 * KVP_SEG + (size_t)(b * 2 + g) * SEQ * 64;
        const bf16_t* vb = kvp + 3 * KVP_SEG + (size_t)(b * 2 + g) * SEQ * 64;
#pragma unroll
        for (int tt = 0; tt < 4; ++tt) { m[tt] = 0.f; lt[tt] = (f32x4){0.f, 0.f, 0.f, 0.f}; }
#pragma unroll
        for (int dt = 0; dt < 4; ++dt)
#pragma unroll
            for (int tt = 0; tt < 4; ++tt) o[dt][tt] = (f32x4){0.f, 0.f, 0.f, 0.f};
        nsa_pipeline(nsel, kb, vb, B, tid, [&](int i) { return __builtin_amdgcn_readfirstlane(blist[i]); }, [&](int blk_, bf16_t* Ks, bf16_t* Vt) {
            if (blk_ > bt) return;
            bool selb[4];
#pragma unroll
            for (int tt = 0; tt < 4; ++tt) selb[tt] = (selw[(th * 64 + tt * 16 + fr) * 4 + (blk_ >> 5)] >> (blk_ & 31)) & 1u;
            float bias[4];
#pragma unroll
            for (int tt = 0; tt < 4; ++tt) bias[tt] = selb[tt] ? 0.f : -1e30f;
            nsa_block_split(Ks, Vt, Qs, s, m, lt, o, bias, blk_ == bt ? 1 : 0, fr, fq);
        });
#pragma unroll
        for (int tt = 0; tt < 4; ++tt) l[tt] = lt[tt][0] * 0.25f;
        nsa_scale(o, l, true, gbase + 1, fr, o, false);
        nsa_store<true, 4>(o, obase, fr, fq);
    }
    {
        const bf16_t* kb = kvp + 4 * KVP_SEG + (size_t)(b * 2 + g) * SEQ * 64;
        const bf16_t* vb = kvp + 5 * KVP_SEG + (size_t)(b * 2 + g) * SEQ * 64;
#pragma unroll
        for (int tt = 0; tt < 4; ++tt) { m[tt] = 0.f; lt[tt] = (f32x4){0.f, 0.f, 0.f, 0.f}; }
#pragma unroll
        for (int dt = 0; dt < 4; ++dt)
#pragma unroll
            for (int tt = 0; tt < 4; ++tt) o[dt][tt] = (f32x4){0.f, 0.f, 0.f, 0.f};
        const int j0 = 2 * qt2 >= 8 ? 2 * qt2 - 8 : 0;
        nsa_pipeline(2 * qt2 + 2 - j0, kb, vb, B, tid, [&](int i) { return j0 + i; }, [&](int blk_, bf16_t* Ks, bf16_t* Vt) {
            if (blk_ > bt || blk_ < bt - 8) return;
            nsa_block_split(Ks, Vt, Qs, s, m, lt, o, bias0, blk_ == bt ? 1 : (blk_ == bt - 8 ? 2 : 0), fr, fq);
        });
#pragma unroll
        for (int tt = 0; tt < 4; ++tt) l[tt] = lt[tt][0] * 0.25f;
        nsa_scale(o, l, true, gbase + 2, fr, o, false);
        nsa_store<true, 4>(o, obase, fr, fq);
    }
    __syncthreads();
}

#define SSD_P 136
#define S3_XST 0
#define S3_BC  69632
#define S3_CC  104448
#define S3_ACS 139264
#define S3_DT  141312
#define S3_END 143360

__device__ __forceinline__ void ssd_acs(const float* __restrict__ small, const float* __restrict__ a_log, size_t tok0, int g, float* acs, float* dtl, int tid) {
    const int w = tid >> 6, lane = tid & 63, hh = 4 * g + (w & 3);
    if (w < 4) {
        const float a = -__expf(a_log[hh]);
        const float d0 = small[(tok0 + 2 * lane) * 32 + 24 + hh], d1 = small[(tok0 + 2 * lane + 1) * 32 + 24 + hh];
        const float s0 = d0 * a, s1 = s0 + d1 * a;
        float tot = s1;
#pragma unroll
        for (int off = 1; off < 64; off <<= 1) { const float t = __shfl_up(tot, off); if (lane >= off) tot += t; }
        const float excl = tot - s1;
        acs[w * 128 + 2 * lane] = excl + s0; acs[w * 128 + 2 * lane + 1] = excl + s1;
        dtl[w * 128 + 2 * lane] = d0; dtl[w * 128 + 2 * lane + 1] = d1;
    }
}
struct ConvCh { float w0, w1, w2, w3, bias, h0, h1, h2; };
__device__ __forceinline__ void conv_init(ConvCh& cc, const float* __restrict__ conv_w, const float* __restrict__ conv_b, int ch, const bf16_t* pb, int c) {
    cc.w0 = conv_w[ch]; cc.w1 = conv_w[1024 + ch]; cc.w2 = conv_w[2048 + ch]; cc.w3 = conv_w[3072 + ch]; cc.bias = conv_b[ch];
    if (c > 0) { cc.h0 = bf2f(pb[-3 * PROJ_LD]); cc.h1 = bf2f(pb[-2 * PROJ_LD]); cc.h2 = bf2f(pb[-1 * PROJ_LD]); } else { cc.h0 = 0.f; cc.h1 = 0.f; cc.h2 = 0.f; }
}
__device__ __forceinline__ float conv_step(ConvCh& cc, float x) {
    const float v = cc.bias + cc.w0 * cc.h0 + cc.w1 * cc.h1 + cc.w2 * cc.h2 + cc.w3 * x;
    cc.h0 = cc.h1; cc.h1 = cc.h2; cc.h2 = x;
    return silu(v);
}

__device__ __forceinline__ void d_ssd_states(const bf16_t* __restrict__ proj, const float* __restrict__ small, const float* __restrict__ conv_w, const float* __restrict__ conv_b,
                                             const float* __restrict__ a_log, float* __restrict__ states, float* __restrict__ cdec, int item, char* lds) {
    const int tid = tid_opaque(), lane = tid & 63, w = tid >> 6, fr = lane & 15, fq = lane >> 4;
    const int b = item >> 7, c = (item >> 1) & 63, g = item & 1;
    bf16_t* XwT = (bf16_t*)(lds + S3_XST); bf16_t* BcT = (bf16_t*)(lds + S3_BC);
    float* acs = (float*)(lds + S3_ACS); float* dtl = (float*)(lds + S3_DT);
    const size_t tok0 = (size_t)b * SEQ + (size_t)c * 128;
    ssd_acs(small, a_log, tok0, g, acs, dtl, tid);
    __syncthreads();
    if (tid < 384) {
        const bool isx = tid < 256;
        const int ch = isx ? g * 256 + tid : 512 + g * 128 + (tid - 256);
        const bf16_t* px = proj + tok0 * PROJ_LD + C_XBC + ch;
        ConvCh cx; conv_init(cx, conv_w, conv_b, ch, px, c);
        const int hw = w & 3;
        const float alast = acs[hw * 128 + 127];
        bf16_t* dst = isx ? XwT + tid * SSD_P : BcT + (tid - 256) * SSD_P;
        for (int l0 = 0; l0 < 128; l0 += 32) {
            float rx[32];
#pragma unroll
            for (int i = 0; i < 32; ++i) rx[i] = bf2f(px[(size_t)(l0 + i) * PROJ_LD]);
#pragma unroll
            for (int i8 = 0; i8 < 4; ++i8) {
                float ox[8];
#pragma unroll
                for (int i = 0; i < 8; ++i) {
                    const int l = l0 + i8 * 8 + i;
                    const float v = conv_step(cx, rx[i8 * 8 + i]);
                    ox[i] = isx ? v * dtl[hw * 128 + l] * __expf(alast - acs[hw * 128 + l]) : v;
                }
                u32x4 o; o.x = pack2(ox[0], ox[1]); o.y = pack2(ox[2], ox[3]); o.z = pack2(ox[4], ox[5]); o.w = pack2(ox[6], ox[7]);
                *(u32x4*)(dst + l0 + i8 * 8) = o;
            }
        }
    }
    __syncthreads();
    {
        const int hw = w & 3, nh = w >> 2;
        f32x4 acc[4][4];
#pragma unroll
        for (int pt = 0; pt < 4; ++pt)
#pragma unroll
            for (int nt = 0; nt < 4; ++nt) acc[pt][nt] = (f32x4){0.f, 0.f, 0.f, 0.f};
#pragma unroll 1
        for (int ks = 0; ks < 4; ++ks) {
            bf16x8 af[4], bfr[4];
#pragma unroll
            for (int pt = 0; pt < 4; ++pt) af[pt] = *(const bf16x8*)(XwT + (hw * 64 + pt * 16 + fr) * SSD_P + ks * 32 + fq * 8);
#pragma unroll
            for (int nt = 0; nt < 4; ++nt) bfr[nt] = *(const bf16x8*)(BcT + ((nh * 4 + nt) * 16 + fr) * SSD_P + ks * 32 + fq * 8);
#pragma unroll
            for (int pt = 0; pt < 4; ++pt)
#pragma unroll
                for (int nt = 0; nt < 4; ++nt) acc[pt][nt] = __builtin_amdgcn_mfma_f32_16x16x32_bf16(bfr[nt], af[pt], acc[pt][nt], 0, 0, 0);
        }
        const int hh = 4 * g + hw;
        bf16_t* sp = (bf16_t*)states + ((size_t)((b * 64 + c) * 8 + hh)) * 8192;
#pragma unroll
        for (int pt = 0; pt < 4; ++pt)
#pragma unroll
            for (int np = 0; np < 2; ++np) {
                const f32x4 va = acc[pt][2 * np], vb2 = acc[pt][2 * np + 1];
                const auto q1 = __builtin_amdgcn_permlane16_swap(pack2(va.x, va.y), pack2(vb2.x, vb2.y), false, false);
                const auto q2 = __builtin_amdgcn_permlane16_swap(pack2(va.z, va.w), pack2(vb2.z, vb2.w), false, false);
                u32x4 o; o.x = q1[0]; o.y = q2[0]; o.z = q1[1]; o.w = q2[1];
                *(u32x4*)(sp + (pt * 16 + fr) * 128 + (nh * 4 + 2 * np + (fq & 1)) * 16 + 8 * (fq >> 1)) = o;
            }
        if (lane == 0 && nh == 0) cdec[(b * 64 + c) * 8 + hh] = __expf(acs[hw * 128 + 127]);
    }
    __syncthreads();
}

__device__ __forceinline__ void d_ssd_scan(const float* __restrict__ states, const float* __restrict__ cdec, bf16_t* __restrict__ prev, int vb) {
    const int bh = vb >> 1, b = bh >> 3, hh = bh & 7;
    const size_t e0 = (size_t)((vb & 1) * 512 + tid_opaque()) * 8;
    f32x4 h0 = (f32x4){0.f, 0.f, 0.f, 0.f}, h1 = h0;
#pragma unroll 16
    for (int c = 0; c < 64; ++c) {
        const size_t base = ((size_t)((b * 64 + c) * 8 + hh)) * 8192 + e0;
        const u32x4 sv = __builtin_nontemporal_load((const u32x4*)((const bf16_t*)states + base));
        const f32x4 s0 = (f32x4){bflo(sv.x), bfhi(sv.x), bflo(sv.y), bfhi(sv.y)}, s1 = (f32x4){bflo(sv.z), bfhi(sv.z), bflo(sv.w), bfhi(sv.w)};
        const float d = cdec[(b * 64 + c) * 8 + hh];
        u32x4 o; o.x = pack2(h0.x, h0.y); o.y = pack2(h0.z, h0.w); o.z = pack2(h1.x, h1.y); o.w = pack2(h1.z, h1.w);
        *(u32x4*)(prev + base) = o;
        h0 = h0 * d + s0; h1 = h1 * d + s1;
    }
}

__device__ __forceinline__ void d_ssd_out(const bf16_t* __restrict__ proj, const float* __restrict__ small, const float* __restrict__ conv_w, const float* __restrict__ conv_b,
                                          const float* __restrict__ a_log, const float* __restrict__ d_skip, const bf16_t* __restrict__ prev, bf16_t* __restrict__ yssd, int item, char* lds) {
    const int tid = tid_opaque(), lane = tid & 63, w = tid >> 6, fr = lane & 15, fq = lane >> 4;
    const int b = item >> 7, c = (item >> 1) & 63, g = item & 1;
    bf16_t* XsT = (bf16_t*)(lds + S3_XST); bf16_t* Bc = (bf16_t*)(lds + S3_BC); bf16_t* Cc = (bf16_t*)(lds + S3_CC);
    float* acs = (float*)(lds + S3_ACS); float* dtl = (float*)(lds + S3_DT);
    const size_t tok0 = (size_t)b * SEQ + (size_t)c * 128;
    ssd_acs(small, a_log, tok0, g, acs, dtl, tid);
    {
        const int mode = tid < 256 ? 0 : (tid < 384 ? 1 : 2);
        const int ch = mode == 0 ? g * 256 + tid : (mode == 1 ? 512 + g * 128 + (tid - 256) : 768 + g * 128 + (tid - 384));
        const bf16_t* px = proj + tok0 * PROJ_LD + C_XBC + ch;
        ConvCh cx; conv_init(cx, conv_w, conv_b, ch, px, c);
        bf16_t* dstx = XsT + (tid & 255) * SSD_P;
        bf16_t* dstbc = (mode == 1 ? Bc : Cc) + (tid & 127);
        for (int l0 = 0; l0 < 128; l0 += 64) {
            float rx[64];
#pragma unroll
            for (int i = 0; i < 64; ++i) rx[i] = bf2f(px[(size_t)(l0 + i) * PROJ_LD]);
#pragma unroll
            for (int i8 = 0; i8 < 8; ++i8) {
                float ox[8];
#pragma unroll
                for (int i = 0; i < 8; ++i) ox[i] = conv_step(cx, rx[i8 * 8 + i]);
                if (mode == 0) {
                    u32x4 o; o.x = pack2(ox[0], ox[1]); o.y = pack2(ox[2], ox[3]); o.z = pack2(ox[4], ox[5]); o.w = pack2(ox[6], ox[7]);
                    *(u32x4*)(dstx + l0 + i8 * 8) = o;
                } else {
#pragma unroll
                    for (int i = 0; i < 8; ++i) dstbc[(l0 + i8 * 8 + i) * SSD_P] = f2bf(ox[i]);
                }
            }
        }
    }
    __syncthreads();
    const int hw = w & 3, lh = w >> 2, hh = 4 * g + hw;
    const float dsk = d_skip[hh];
    const bf16_t* pp = prev + ((size_t)((b * 64 + c) * 8 + hh)) * 8192;
    bf16x8 pf[4][4];
#pragma unroll
    for (int pt = 0; pt < 4; ++pt)
#pragma unroll
        for (int ks = 0; ks < 4; ++ks) pf[pt][ks] = *(const bf16x8*)(pp + (pt * 16 + fr) * 128 + ks * 32 + fq * 8);
#pragma unroll 1
    for (int lk = 0; lk < 4; ++lk) {
        const int lt = lh + 2 * lk;
        const int l = lt * 16 + fr;
        const float acs_l = acs[hw * 128 + l];
        u32x4 zq[2];
#pragma unroll
        for (int pp = 0; pp < 2; ++pp) zq[pp] = *(const u32x4*)(proj + (tok0 + l) * PROJ_LD + C_Z + hh * 64 + (2 * pp + (fq & 1)) * 16 + 8 * (fq >> 1));
        bf16x8 cf[4];
#pragma unroll
        for (int ks = 0; ks < 4; ++ks) cf[ks] = *(const bf16x8*)(Cc + (lt * 16 + fr) * SSD_P + ks * 32 + fq * 8);
        f32x4 y[4], yo[4];
#pragma unroll
        for (int pt = 0; pt < 4; ++pt) { y[pt] = (f32x4){0.f, 0.f, 0.f, 0.f}; yo[pt] = (f32x4){0.f, 0.f, 0.f, 0.f}; }
#pragma unroll
        for (int ks2 = 0; ks2 < 4; ++ks2) {
            if (2 * ks2 <= lt) {
                f32x4 cb[2];
#pragma unroll
                for (int h2 = 0; h2 < 2; ++h2) {
                    const int st = 2 * ks2 + h2;
                    cb[h2] = (f32x4){0.f, 0.f, 0.f, 0.f};
                    if (st <= lt) {
#pragma unroll
                        for (int ks = 0; ks < 4; ++ks)
                            cb[h2] = __builtin_amdgcn_mfma_f32_16x16x32_bf16(*(const bf16x8*)(Bc + (st * 16 + fr) * SSD_P + ks * 32 + fq * 8), cf[ks], cb[h2], 0, 0, 0);
#pragma unroll
                        for (int jj = 0; jj < 4; ++jj) {
                            const int sidx = st * 16 + 4 * fq + jj;
                            cb[h2][jj] = (sidx <= l) ? cb[h2][jj] * __expf(acs_l - acs[hw * 128 + sidx]) * dtl[hw * 128 + sidx] : 0.f;
                        }
                    }
                }
                u32x4 wv; wv.x = pack2(cb[0].x, cb[0].y); wv.y = pack2(cb[0].z, cb[0].w); wv.z = pack2(cb[1].x, cb[1].y); wv.w = pack2(cb[1].z, cb[1].w);
                const bf16x8 mf = __builtin_bit_cast(bf16x8, wv);
#pragma unroll
                for (int pt = 0; pt < 4; ++pt) {
                    const bf16_t* xp = XsT + (hw * 64 + pt * 16 + fr) * SSD_P + ks2 * 32 + 4 * fq;
                    const u32x2 a0 = *(const u32x2*)xp, a1 = *(const u32x2*)(xp + 16);
                    u32x4 xv; xv.x = a0.x; xv.y = a0.y; xv.z = a1.x; xv.w = a1.y;
                    y[pt] = __builtin_amdgcn_mfma_f32_16x16x32_bf16(__builtin_bit_cast(bf16x8, xv), mf, y[pt], 0, 0, 0);
                }
            }
            __builtin_amdgcn_sched_barrier(0);
        }
        __builtin_amdgcn_sched_barrier(0);
#pragma unroll
        for (int pt = 0; pt < 4; ++pt)
#pragma unroll
            for (int ks = 0; ks < 4; ++ks) yo[pt] = __builtin_amdgcn_mfma_f32_16x16x32_bf16(pf[pt][ks], cf[ks], yo[pt], 0, 0, 0);
        __builtin_amdgcn_sched_barrier(0);
        const float el = __expf(acs_l);
        f32x4 pre[4];
#pragma unroll
        for (int pt = 0; pt < 4; ++pt) {
            const int p0 = pt * 16 + 4 * fq;
            const bf16_t* xq = XsT + (hw * 64 + p0) * SSD_P + l;
            const float x0 = bf2f(xq[0]), x1 = bf2f(xq[SSD_P]), x2 = bf2f(xq[2 * SSD_P]), x3 = bf2f(xq[3 * SSD_P]);
            pre[pt] = (f32x4){y[pt].x + el * yo[pt].x + dsk * x0, y[pt].y + el * yo[pt].y + dsk * x1, y[pt].z + el * yo[pt].z + dsk * x2, y[pt].w + el * yo[pt].w + dsk * x3};
        }
#pragma unroll
        for (int pp = 0; pp < 2; ++pp) {
            float v8[8];
#pragma unroll
            for (int cc = 0; cc < 4; ++cc) {
                const auto q = __builtin_amdgcn_permlane16_swap(__float_as_uint(pre[2 * pp][cc]), __float_as_uint(pre[2 * pp + 1][cc]), false, false);
                v8[cc] = __uint_as_float(q[0]); v8[4 + cc] = __uint_as_float(q[1]);
            }
            const u32x4 zz = zq[pp];
            u32x4 ob;
            ob.x = pack2(v8[0] * silu(bflo(zz.x)), v8[1] * silu(bfhi(zz.x))); ob.y = pack2(v8[2] * silu(bflo(zz.y)), v8[3] * silu(bfhi(zz.y)));
            ob.z = pack2(v8[4] * silu(bflo(zz.z)), v8[5] * silu(bfhi(zz.z))); ob.w = pack2(v8[6] * silu(bflo(zz.w)), v8[7] * silu(bfhi(zz.w)));
            *(u32x4*)(yssd + (tok0 + l) * 512 + hh * 64 + (2 * pp + (fq & 1)) * 16 + 8 * (fq >> 1)) = ob;
        }
    }
    __syncthreads();
}

__device__ __forceinline__ void d_mix_prep(const bf16_t* __restrict__ onsa, const bf16_t* __restrict__ yssd, const float* __restrict__ nsa_w, const float* __restrict__ ssd_w, bf16_t* __restrict__ A2, int vb) {
    const int tid_ = tid_opaque(); const int lane = tid_ & 63, wid = tid_ >> 6;
    const size_t row0 = (size_t)vb * 32 + wid * 4;
    f32x4 a[4][2], y[4][2];
#pragma unroll
    for (int r = 0; r < 4; ++r) {
        const u32x4 aa = *(const u32x4*)(onsa + (row0 + r) * 512 + lane * 8);
        a[r][0] = (f32x4){bflo(aa.x), bfhi(aa.x), bflo(aa.y), bfhi(aa.y)}; a[r][1] = (f32x4){bflo(aa.z), bfhi(aa.z), bflo(aa.w), bfhi(aa.w)};
        const u32x4 yy = *(const u32x4*)(yssd + (row0 + r) * 512 + lane * 8);
        y[r][0] = (f32x4){bflo(yy.x), bfhi(yy.x), bflo(yy.y), bfhi(yy.y)}; y[r][1] = (f32x4){bflo(yy.z), bfhi(yy.z), bflo(yy.w), bfhi(yy.w)};
    }
    float ra[4], ry[4];
#pragma unroll
    for (int r = 0; r < 4; ++r) {
        float s0 = 0.f, s1 = 0.f;
#pragma unroll
        for (int k = 0; k < 2; ++k) {
            s0 += a[r][k].x * a[r][k].x + a[r][k].y * a[r][k].y + a[r][k].z * a[r][k].z + a[r][k].w * a[r][k].w;
            s1 += y[r][k].x * y[r][k].x + y[r][k].y * y[r][k].y + y[r][k].z * y[r][k].z + y[r][k].w * y[r][k].w;
        }
        ra[r] = rsqrtf(wave_sum(s0) * (1.0f / 512) + EPS); ry[r] = rsqrtf(wave_sum(s1) * (1.0f / 512) + EPS);
    }
    const int col = lane * 8;
    const f32x4 wn0 = *(const f32x4*)(nsa_w + col), wn1 = *(const f32x4*)(nsa_w + col + 4), ws0 = *(const f32x4*)(ssd_w + col), ws1 = *(const f32x4*)(ssd_w + col + 4);
#pragma unroll
    for (int r = 0; r < 4; ++r) {
        const f32x4 p0 = a[r][0] * ra[r] * wn0, p1 = a[r][1] * ra[r] * wn1, q0 = y[r][0] * ry[r] * ws0, q1 = y[r][1] * ry[r] * ws1;
        u32x4 o; o.x = pack2(p0.x, p0.y); o.y = pack2(p0.z, p0.w); o.z = pack2(p1.x, p1.y); o.w = pack2(p1.z, p1.w);
        *(u32x4*)(A2 + (row0 + r) * DM + col) = o;
        u32x4 o2; o2.x = pack2(q0.x, q0.y); o2.y = pack2(q0.z, q0.w); o2.z = pack2(q1.x, q1.y); o2.w = pack2(q1.z, q1.w);
        *(u32x4*)(A2 + (row0 + r) * DM + 512 + col) = o2;
    }
}

__device__ __forceinline__ void d_quant_rows(const float* __restrict__ src, unsigned char* __restrict__ dst, float* __restrict__ scale, int vb) {
    const int tid_ = tid_opaque(); const int lane = tid_ & 63;
    f32x4 v[2][4];
#pragma unroll
    for (int rr = 0; rr < 2; ++rr) {
        const float* rp = src + (size_t)(vb * 16 + rr * 8 + (tid_ >> 6)) * DM + lane * 16;
#pragma unroll
        for (int i = 0; i < 4; ++i) v[rr][i] = *(const f32x4*)(rp + i * 4);
    }
#pragma unroll
    for (int rr = 0; rr < 2; ++rr) {
        const int row = vb * 16 + rr * 8 + (tid_ >> 6);
        float mx = 0.f;
#pragma unroll
        for (int i = 0; i < 4; ++i) mx = fmaxf(mx, fmaxf(fmaxf(fabsf(v[rr][i].x), fabsf(v[rr][i].y)), fmaxf(fabsf(v[rr][i].z), fabsf(v[rr][i].w))));
        mx = wave_max(mx);
        const float sc = mx > 0.f ? mx * (1.0f / 6.0f) : 1.0f;
        const float inv = 1.0f / sc;
        u32x2 o;
#pragma unroll
        for (int h = 0; h < 2; ++h) {
            unsigned wv = 0u;
            wv = __builtin_amdgcn_cvt_scalef32_pk_fp4_f32(wv, v[rr][2 * h].x * inv, v[rr][2 * h].y * inv, 1.0f, 0);
            wv = __builtin_amdgcn_cvt_scalef32_pk_fp4_f32(wv, v[rr][2 * h].z * inv, v[rr][2 * h].w * inv, 1.0f, 1);
            wv = __builtin_amdgcn_cvt_scalef32_pk_fp4_f32(wv, v[rr][2 * h + 1].x * inv, v[rr][2 * h + 1].y * inv, 1.0f, 2);
            wv = __builtin_amdgcn_cvt_scalef32_pk_fp4_f32(wv, v[rr][2 * h + 1].z * inv, v[rr][2 * h + 1].w * inv, 1.0f, 3);
            o[h] = wv;
        }
        *(u32x2*)(dst + (size_t)row * 512 + lane * 8) = o;
        if (lane == 0) scale[row] = sc;
    }
}

__device__ __forceinline__ unsigned mono_u(float f) { const unsigned u = __float_as_uint(f); return u ^ ((unsigned)((int)u >> 31) | 0x80000000u); }
__device__ __forceinline__ float unmono_f(unsigned m) { return __uint_as_float(m ^ (~(unsigned)((int)m >> 31) | 0x80000000u)); }
#define RT_LI 65536
__device__ __forceinline__ void d_peer_stage_keys(const bf16_t* __restrict__ subk, int h, char* lds) {
    const int tid = tid_opaque();
    u32x4 r[8];
#pragma unroll
    for (int i = 0; i < 8; ++i) { const int p = tid + 512 * i; r[i] = *(const u32x4*)(subk + (size_t)h * 32768 + (size_t)p * 8); }
#pragma unroll
    for (int i = 0; i < 8; ++i) { const int p = tid + 512 * i, row = p >> 4, ch = p & 15; *(u32x4*)(lds + row * 256 + ((ch ^ (row & 15)) << 4)) = r[i]; }
}
__device__ __forceinline__ void d_peer_route(const bf16_t* __restrict__ qp, const float* __restrict__ qnw, int* __restrict__ eidx, float* __restrict__ gate,
                                             int tile, int h, char* lds) {
    const int tid = tid_opaque(), lane = tid & 63, w = tid >> 6, fr = lane & 15, fq = lane >> 4;
    const size_t tok = (size_t)tile * 128 + w * 16 + fr;
    bf16x8 qf[2][4];
    {
        const bf16_t* qrow = qp + tok * 2048 + h * 256;
        u32x4 raw[2][4];
        float ss = 0.f;
#pragma unroll
        for (int k = 0; k < 2; ++k)
#pragma unroll
            for (int ks = 0; ks < 4; ++ks) {
                const u32x4 r = *(const u32x4*)(qrow + k * 128 + ks * 32 + fq * 8);
                raw[k][ks] = r;
                ss += bflo(r.x) * bflo(r.x) + bfhi(r.x) * bfhi(r.x) + bflo(r.y) * bflo(r.y) + bfhi(r.y) * bfhi(r.y)
                    + bflo(r.z) * bflo(r.z) + bfhi(r.z) * bfhi(r.z) + bflo(r.w) * bflo(r.w) + bfhi(r.w) * bfhi(r.w);
            }
        ss += __shfl_xor(ss, 16); ss += __shfl_xor(ss, 32);
        const float rs = rsqrtf(ss * (1.0f / 256) + EPS);
#pragma unroll
        for (int k = 0; k < 2; ++k)
#pragma unroll
            for (int ks = 0; ks < 4; ++ks) {
                const float* wp = qnw + k * 128 + ks * 32 + fq * 8;
                const f32x4 w0 = *(const f32x4*)wp, w1 = *(const f32x4*)(wp + 4);
                const u32x4 r = raw[k][ks];
                u32x4 o;
                o.x = pack2(bflo(r.x) * rs * w0.x, bfhi(r.x) * rs * w0.y); o.y = pack2(bflo(r.y) * rs * w0.z, bfhi(r.y) * rs * w0.w);
                o.z = pack2(bflo(r.z) * rs * w1.x, bfhi(r.z) * rs * w1.y); o.w = pack2(bflo(r.w) * rs * w1.z, bfhi(r.w) * rs * w1.w);
                qf[k][ks] = __builtin_bit_cast(bf16x8, o);
            }
    }
    unsigned L[2][16];
#pragma unroll
    for (int k = 0; k < 2; ++k) {
        f32x4 acc[8];
#pragma unroll
        for (int kt = 0; kt < 8; ++kt) acc[kt] = (f32x4){0.f, 0.f, 0.f, 0.f};
#pragma unroll
        for (int kt = 0; kt < 8; ++kt)
#pragma unroll
            for (int ks = 0; ks < 4; ++ks) {
                const int row = k * 128 + kt * 16 + fr;
                const bf16x8 af = *(const bf16x8*)(lds + row * 256 + (((ks * 4 + fq) ^ fr) << 4));
                acc[kt] = __builtin_amdgcn_mfma_f32_16x16x32_bf16(af, qf[k][ks], acc[kt], 0, 0, 0);
            }
        {
            unsigned H[16];
#pragma unroll
            for (int kt = 0; kt < 4; ++kt)
#pragma unroll
                for (int jj = 0; jj < 4; ++jj) {
                    L[k][kt * 4 + jj] = (mono_u(acc[kt][jj]) & ~0x7Fu) | (unsigned)(127 - (kt * 16 + 4 * fq + jj));
                    H[kt * 4 + jj] = (mono_u(acc[kt + 4][jj]) & ~0x7Fu) | (unsigned)(127 - ((kt + 4) * 16 + 4 * fq + jj));
                }
            sort16(L[k]); sort16(H);
            merge16(L[k], H);
        }
#pragma unroll
        for (int r = 16; r <= 32; r <<= 1) {
            unsigned P[16];
#pragma unroll
            for (int i = 0; i < 16; ++i) P[i] = (unsigned)__shfl_xor((int)L[k][i], r);
            merge16(L[k], P);
        }
    }
    unsigned char* li = (unsigned char*)lds + RT_LI + w * 512 + fr * 32;
    if (fq == 0) {
#pragma unroll
        for (int a = 0; a < 16; ++a) { li[a] = (unsigned char)(127 - (L[0][a] & 0x7Fu)); li[16 + a] = (unsigned char)(127 - (L[1][a] & 0x7Fu)); }
    }
    float fa[16], fb[16];
#pragma unroll
    for (int a = 0; a < 16; ++a) { fa[a] = unmono_f(L[0][a] & ~0x7Fu); fb[a] = unmono_f(L[1][a] & ~0x7Fu); }
    unsigned T[16];
#define CAND(a, b) ((mono_u(fa[a] + fb[b]) & ~0xFFu) | (unsigned)(255 - ((a) * 16 + (b))))
#pragma unroll
    for (int bb = 0; bb < 16; ++bb) T[bb] = CAND(0, bb);
    {
        unsigned Bq[16];
#pragma unroll
        for (int bb = 0; bb < 8; ++bb) Bq[bb] = CAND(1, bb);
        Bq[8] = CAND(4, 0); Bq[9] = CAND(4, 1); Bq[10] = CAND(4, 2); Bq[11] = CAND(5, 0); Bq[12] = CAND(5, 1); Bq[13] = CAND(6, 0); Bq[14] = CAND(6, 1); Bq[15] = CAND(8, 0);
        sort16(Bq); merge16(T, Bq);
    }
    {
        unsigned Cq[16];
#pragma unroll
        for (int bb = 0; bb < 5; ++bb) Cq[bb] = CAND(2, bb);
#pragma unroll
        for (int bb = 0; bb < 4; ++bb) Cq[5 + bb] = CAND(3, bb);
        Cq[9] = CAND(7, 0); Cq[10] = CAND(7, 1); Cq[11] = CAND(9, 0); Cq[12] = CAND(10, 0); Cq[13] = CAND(11, 0); Cq[14] = CAND(12, 0); Cq[15] = CAND(13, 0);
        sort16(Cq); merge16(T, Cq);
    }
    ins16(T, CAND(14, 0)); ins16(T, CAND(15, 0));
#undef CAND
    __syncthreads();
    const float s0 = unmono_f(T[0] & ~0xFFu);
    float pe[16]; float sum = 0.f;
#pragma unroll
    for (int i = 0; i < 16; ++i) { pe[i] = __expf(unmono_f(T[i] & ~0xFFu) - s0); sum += pe[i]; }
    const float inv = 1.0f / sum;
    unsigned cod[4] = {0u, 0u, 0u, 0u}; float gv[4] = {0.f, 0.f, 0.f, 0.f};
#pragma unroll
    for (int i = 0; i < 16; ++i) if ((i >> 2) == fq) { cod[i & 3] = 255u - (T[i] & 0xFFu); gv[i & 3] = pe[i] * inv; }
    int ev[4];
#pragma unroll
    for (int i = 0; i < 4; ++i) ev[i] = (int)li[cod[i] >> 4] * 128 + (int)li[16 + (cod[i] & 15u)];
    *(u32x4*)(eidx + (tok * 8 + h) * 16 + fq * 4) = (u32x4){(unsigned)ev[0], (unsigned)ev[1], (unsigned)ev[2], (unsigned)ev[3]};
    *(f32x4*)(gate + (tok * 8 + h) * 16 + fq * 4) = (f32x4){gv[0], gv[1], gv[2], gv[3]};
    __syncthreads();
}

__device__ __forceinline__ void cvt16(const u32x2 q, f32x2 (&f)[8]) {
#pragma unroll
    for (int i = 0; i < 2; ++i) {
        f[4 * i] = __builtin_amdgcn_cvt_scalef32_pk_f32_fp4(q[i], 1.0f, 0); f[4 * i + 1] = __builtin_amdgcn_cvt_scalef32_pk_f32_fp4(q[i], 1.0f, 1);
        f[4 * i + 2] = __builtin_amdgcn_cvt_scalef32_pk_f32_fp4(q[i], 1.0f, 2); f[4 * i + 3] = __builtin_amdgcn_cvt_scalef32_pk_f32_fp4(q[i], 1.0f, 3);
    }
}
typedef int v8i __attribute__((ext_vector_type(8)));
__device__ __forceinline__ void px_issue_down(const unsigned char* __restrict__ down4, int esel, int sb, int fr, int kq, u32x4 (&d)[8]) {
    const int em = __shfl(esel, sb + fr);
    const unsigned char* ab = down4 + (size_t)em * 512 + kq * 16;
#pragma unroll
    for (int k = 0; k < 8; ++k) d[k] = *(const u32x4*)(ab + k * 64);
}
__device__ __forceinline__ void px_issue_up(const unsigned char* __restrict__ up4, int esel, int sb, int lane, u32x4 (&u)[8]) {
    unsigned l16 = ((unsigned)lane & 31u) * 16u;
    asm volatile("" : "+v"(l16));
    const bool lo = lane < 32;
#pragma unroll
    for (int j = 0; j < 8; ++j) {
        const unsigned ea = (unsigned)__builtin_amdgcn_readlane(esel, sb + 2 * j), eb = (unsigned)__builtin_amdgcn_readlane(esel, sb + 2 * j + 1);
        const unsigned voff = ((lo ? ea : eb) << 9) + l16;
        u[j] = *(const __attribute__((address_space(1))) u32x4*)((const __attribute__((address_space(1))) unsigned char*)up4 + voff);
    }
}
__device__ __forceinline__ float px_dots(const unsigned char* hq, int kq, int fr, const u32x4 (&d)[8], float csel, float dsel, int sb) {
    const int jm = fr & 3;
    const int sl = sb + 4 * kq + jm;
    const float mc = __shfl(csel, sl);
    const float md = __shfl(dsel, sl);
    f32x4 d4e = (f32x4){0.f, 0.f, 0.f, 0.f}, d4o = d4e;
    u32x4 b0 = *(const u32x4*)(hq + kq * 16), b1 = *(const u32x4*)(hq + 64 + kq * 16);
#pragma unroll
    for (int k = 0; k < 8; ++k) {
        u32x4 n0 = b0, n1 = b1;
        if (k < 7) { n0 = *(const u32x4*)(hq + (k + 1) * 128 + kq * 16); n1 = *(const u32x4*)(hq + (k + 1) * 128 + 64 + kq * 16); }
        __builtin_amdgcn_sched_barrier(0);
        const v8i A = {(int)d[k].x, (int)d[k].y, (int)d[k].z, (int)d[k].w, 0, 0, 0, 0};
        const v8i B = {(int)b0.x, (int)b0.y, (int)b0.z, (int)b0.w, (int)b1.x, (int)b1.y, (int)b1.z, (int)b1.w};
        if (k & 1) d4o = __builtin_amdgcn_mfma_scale_f32_16x16x128_f8f6f4(A, B, d4o, 4  , 0  , 0, 0x7F7F7F7F, 0, 0x7F7F7F7F);
        else d4e = __builtin_amdgcn_mfma_scale_f32_16x16x128_f8f6f4(A, B, d4e, 4, 0, 0, 0x7F7F7F7F, 0, 0x7F7F7F7F);
        __builtin_amdgcn_sched_barrier(0);
        b0 = n0; b1 = n1;
    }
    const f32x4 d4 = d4e + d4o;
    const float dv = jm == 0 ? d4[0] : jm == 1 ? d4[1] : jm == 2 ? d4[2] : d4[3];
    return gelu_tanh(dv * md) * mc;
}
__device__ __forceinline__ void px_up(const u32x4 (&u)[8], float av, f32x2 (&acc)[16], int lane) {
    const bool lo = lane < 32;
#pragma unroll
    for (int j = 0; j < 8; ++j) {
        const int ia = 2 * j, ib = 2 * j + 1;
        const float ca = __uint_as_float((unsigned)__builtin_amdgcn_readlane((int)__float_as_uint(av), 16 * (ia >> 2) + (ia & 3)));
        const float cb = __uint_as_float((unsigned)__builtin_amdgcn_readlane((int)__float_as_uint(av), 16 * (ib >> 2) + (ib & 3)));
        const float c = lo ? ca : cb;
        const f32x2 c2 = {c, c};
        f32x2 f[8];
        cvt16((u32x2){u[j].x, u[j].y}, f);
#pragma unroll
        for (int e = 0; e < 8; ++e) acc[e] = __builtin_elementwise_fma(f[e], c2, acc[e]);
        cvt16((u32x2){u[j].z, u[j].w}, f);
#pragma unroll
        for (int e = 0; e < 8; ++e) acc[8 + e] = __builtin_elementwise_fma(f[e], c2, acc[8 + e]);
    }
}
__device__ __forceinline__ void px_h2_to_fp8(const u32x4 v0, const u32x4 v1, unsigned char* hq, int lane) {
    u32x4 q;
    int wv = 0;
    wv = __builtin_amdgcn_cvt_pk_fp8_f32(bflo(v0.x), bfhi(v0.x), wv, false); wv = __builtin_amdgcn_cvt_pk_fp8_f32(bflo(v0.y), bfhi(v0.y), wv, true); q.x = (unsigned)wv;
    wv = __builtin_amdgcn_cvt_pk_fp8_f32(bflo(v0.z), bfhi(v0.z), wv, false); wv = __builtin_amdgcn_cvt_pk_fp8_f32(bflo(v0.w), bfhi(v0.w), wv, true); q.y = (unsigned)wv;
    wv = __builtin_amdgcn_cvt_pk_fp8_f32(bflo(v1.x), bfhi(v1.x), wv, false); wv = __builtin_amdgcn_cvt_pk_fp8_f32(bflo(v1.y), bfhi(v1.y), wv, true); q.z = (unsigned)wv;
    wv = __builtin_amdgcn_cvt_pk_fp8_f32(bflo(v1.z), bfhi(v1.z), wv, false); wv = __builtin_amdgcn_cvt_pk_fp8_f32(bflo(v1.w), bfhi(v1.w), wv, true); q.w = (unsigned)wv;
    *(u32x4*)(hq + lane * 16) = q;
}
#define PX_FW  16384
#define PX_G2  20480
__device__ __forceinline__ void d_peer_expert_stream(const bf16_t* __restrict__ h2, const unsigned char* __restrict__ down4, const unsigned char* __restrict__ up4, const float* __restrict__ dscale,
                                                     const float* __restrict__ uscale, const int* __restrict__ eidx, const float* __restrict__ gate, const float* __restrict__ mod,
                                                     const float* __restrict__ fw, const bf16_t* __restrict__ x1, float* __restrict__ out, float* __restrict__ dummy, int bid, int G, char* lds) {
    const int tid = tid_opaque(), lane = tid & 63, wid = tid >> 6, fr = lane & 15, kq = lane >> 4;
    __syncthreads();
    if (tid < 256) ((f32x4*)(lds + PX_FW))[tid] = ((const f32x4*)fw)[tid];
#pragma unroll
    for (int i = 0; i < 4; ++i) { const int idx = tid + i * 512; ((f32x4*)(lds + PX_G2))[idx] = *(const f32x4*)(mod + (idx >> 8) * 6144 + 5120 + (idx & 255) * 4); }
    __syncthreads();
    unsigned char* hq0 = (unsigned char*)lds + wid * 2048;
    const int nvb = NTOK / 8, nit = (nvb + G - 1) / G;
    int e_lo, e_hi; float c_lo, c_hi, d_lo, d_hi;
    u32x4 da[8], dn[8], uq[8], un[8];
    f32x2 acc[16];
    {
        const size_t tok = (size_t)(bid < nvb ? bid : nvb - 1) * 8 + wid;
        const u32x4 v0 = __builtin_nontemporal_load((const u32x4*)(h2 + tok * DM + lane * 16)), v1 = __builtin_nontemporal_load((const u32x4*)(h2 + tok * DM + lane * 16 + 8));
        e_lo = eidx[tok * 128 + lane]; e_hi = eidx[tok * 128 + 64 + lane];
        px_issue_down(down4, e_lo, 0, fr, kq, da); px_issue_up(up4, e_lo, 0, lane, uq);
        px_issue_down(down4, e_lo, 16, fr, kq, dn); px_issue_up(up4, e_lo, 16, lane, un);
        c_lo = gate[tok * 128 + lane] * uscale[e_lo]; c_hi = gate[tok * 128 + 64 + lane] * uscale[e_hi];
        d_lo = dscale[e_lo]; d_hi = dscale[e_hi];
        px_h2_to_fp8(v0, v1, hq0, lane);
    }
#pragma unroll
    for (int e = 0; e < 16; ++e) acc[e] = (f32x2){0.f, 0.f};
#pragma unroll 1
    for (int it = 0; it < nit; ++it) {
        const int vbc = bid + it * G, vbn0 = vbc + G;
        const bool valid = vbc < nvb;
        const size_t tok = (size_t)(valid ? vbc : nvb - 1) * 8 + wid;
        const size_t tokn = (size_t)(vbn0 < nvb ? vbn0 : nvb - 1) * 8 + wid;
        const int b = (int)(tok >> 13);
        const unsigned char* hq = hq0 + (it & 1) * 1024;
        const int ne_lo = eidx[tokn * 128 + lane], ne_hi = eidx[tokn * 128 + 64 + lane];
        const float ng_lo = gate[tokn * 128 + lane], ng_hi = gate[tokn * 128 + 64 + lane];
        const u32x4 nv0 = __builtin_nontemporal_load((const u32x4*)(h2 + tokn * DM + lane * 16)), nv1 = __builtin_nontemporal_load((const u32x4*)(h2 + tokn * DM + lane * 16 + 8));
#pragma unroll 1
        for (int gp = 0; gp < 3; ++gp) {
            const int g = 2 * gp;
            const float csel = gp < 2 ? c_lo : c_hi, dsel = gp < 2 ? d_lo : d_hi;
            const int esel = gp < 1 ? e_lo : e_hi;
            float av = px_dots(hq, kq, fr, da, csel, dsel, (g & 3) * 16);
            __builtin_amdgcn_sched_barrier(0);
            px_issue_down(down4, esel, ((g + 2) & 3) * 16, fr, kq, da);
            __builtin_amdgcn_sched_barrier(0);
            px_up(uq, av, acc, lane);
            __builtin_amdgcn_sched_barrier(0);
            px_issue_up(up4, esel, ((g + 2) & 3) * 16, lane, uq);
            __builtin_amdgcn_sched_barrier(0);
            av = px_dots(hq, kq, fr, dn, csel, dsel, ((g + 1) & 3) * 16);
            __builtin_amdgcn_sched_barrier(0);
            px_issue_down(down4, esel, ((g + 3) & 3) * 16, fr, kq, dn);
            __builtin_amdgcn_sched_barrier(0);
            px_up(un, av, acc, lane);
            __builtin_amdgcn_sched_barrier(0);
            px_issue_up(up4, esel, ((g + 3) & 3) * 16, lane, un);
            __builtin_amdgcn_sched_barrier(0);
        }
        px_h2_to_fp8(nv0, nv1, hq0 + ((it + 1) & 1) * 1024, lane);
        const float nus_lo = uscale[ne_lo], nus_hi = uscale[ne_hi], nds_lo = dscale[ne_lo], nds_hi = dscale[ne_hi];
        u32x2 xb[4];
        {
            const u32x4 xa = __builtin_nontemporal_load((const u32x4*)(x1 + tok * DM + (lane & 31) * 32 + (lane >> 5) * 16)), xc = __builtin_nontemporal_load((const u32x4*)(x1 + tok * DM + (lane & 31) * 32 + (lane >> 5) * 16 + 8));
            xb[0] = (u32x2){xa.x, xa.y}; xb[1] = (u32x2){xa.z, xa.w}; xb[2] = (u32x2){xc.x, xc.y}; xb[3] = (u32x2){xc.z, xc.w};
        }
        {
            __builtin_amdgcn_sched_barrier(0);
            float av = px_dots(hq, kq, fr, da, c_hi, d_hi, 32);
            __builtin_amdgcn_sched_barrier(0);
            px_issue_down(down4, ne_lo, 0, fr, kq, da);
            __builtin_amdgcn_sched_barrier(0);
            px_up(uq, av, acc, lane);
            __builtin_amdgcn_sched_barrier(0);
            px_issue_up(up4, ne_lo, 0, lane, uq);
            __builtin_amdgcn_sched_barrier(0);
            av = px_dots(hq, kq, fr, dn, c_hi, d_hi, 48);
            __builtin_amdgcn_sched_barrier(0);
            px_issue_down(down4, ne_lo, 16, fr, kq, dn);
            __builtin_amdgcn_sched_barrier(0);
            px_up(un, av, acc, lane);
            __builtin_amdgcn_sched_barrier(0);
            px_issue_up(up4, ne_lo, 16, lane, un);
            __builtin_amdgcn_sched_barrier(0);
        }
        {
#pragma unroll
            for (int e = 0; e < 8; ++e) {
                const auto rx = __builtin_amdgcn_permlane32_swap(__float_as_uint(acc[e].x), __float_as_uint(acc[8 + e].x), false, false);
                const auto ry = __builtin_amdgcn_permlane32_swap(__float_as_uint(acc[e].y), __float_as_uint(acc[8 + e].y), false, false);
                acc[e] = (f32x2){__uint_as_float(rx[0]) + __uint_as_float(rx[1]), __uint_as_float(ry[0]) + __uint_as_float(ry[1])};
            }
        }
        const int cb0 = (lane & 31) * 32 + (lane >> 5) * 16;
        float x2[16]; float ss = 0.f;
#pragma unroll
        for (int q4i = 0; q4i < 4; ++q4i) {
            const int col = cb0 + q4i * 4;
            const f32x4 xv = (f32x4){bflo(xb[q4i].x), bfhi(xb[q4i].x), bflo(xb[q4i].y), bfhi(xb[q4i].y)};
            const f32x4 g2 = *(const f32x4*)(lds + PX_G2 + (b * 1024 + col) * 4);
            const int e0 = q4i * 4;
            x2[e0 + 0] = xv.x + g2.x * acc[2 * q4i].x; x2[e0 + 1] = xv.y + g2.y * acc[2 * q4i].y; x2[e0 + 2] = xv.z + g2.z * acc[2 * q4i + 1].x; x2[e0 + 3] = xv.w + g2.w * acc[2 * q4i + 1].y;
            ss += x2[e0] * x2[e0] + x2[e0 + 1] * x2[e0 + 1] + x2[e0 + 2] * x2[e0 + 2] + x2[e0 + 3] * x2[e0 + 3];
        }
        ss = wave_sum(ss);
        const float r = rsqrtf(ss * (1.0f / DM) + EPS);
        float* op = valid ? out + tok * DM : dummy + (size_t)((bid * 8 + wid) & 2047) * DM;
#pragma unroll
        for (int q4i = 0; q4i < 4; ++q4i) {
            const int col = cb0 + q4i * 4;
            const f32x4 wv = *(const f32x4*)(lds + PX_FW + col * 4);
            const int e0 = q4i * 4;
            __builtin_nontemporal_store((f32x4){x2[e0] * r * wv.x, x2[e0 + 1] * r * wv.y, x2[e0 + 2] * r * wv.z, x2[e0 + 3] * r * wv.w}, (f32x4*)(op + col));
        }
        e_lo = ne_lo; e_hi = ne_hi; c_lo = ng_lo * nus_lo; c_hi = ng_hi * nus_hi; d_lo = nds_lo; d_hi = nds_hi;
#pragma unroll
        for (int e = 0; e < 16; ++e) acc[e] = (f32x2){0.f, 0.f};
    }
}

#define XB_TMO      128
#define XB_XCNT(j)  (256  + 64 * (j))
#define XB_XSUB(j)  (1280 + 64 * (j))
#define XB_XGEN(j)  (2304 + 64 * (j))
#define XB_TOP      3328
#define XB_TOPGEN   3392
#define XCD_BAR_WORDS 3456
#define XB_SPIN_CAP (1u << 18)

__device__ __forceinline__ unsigned xb_ld(unsigned* p)              { return __hip_atomic_load(p, __ATOMIC_RELAXED, __HIP_MEMORY_SCOPE_AGENT); }
__device__ __forceinline__ unsigned xb_add(unsigned* p, unsigned v) { return __hip_atomic_fetch_add(p, v, __ATOMIC_RELAXED, __HIP_MEMORY_SCOPE_AGENT); }
__device__ __forceinline__ unsigned xb_xcc_id() { return (unsigned)__builtin_amdgcn_s_getreg((3 << 11) | 20) & 0xFu; }
#define XB_SPIN(cond, bar) do { unsigned _sp = 0; while (cond) { __builtin_amdgcn_s_sleep(1); \
    if ((++_sp & 255u) == 0u) { if (xb_ld(&(bar)[XB_TMO])) break; if (_sp > XB_SPIN_CAP) { atomicAdd(&(bar)[XB_TMO], 1u); break; } } } } while (0)

struct XcdBarrier {
    unsigned* bar; unsigned x;
    volatile __attribute__((address_space(3))) unsigned* st;
};

__device__ __forceinline__ XcdBarrier xcd_barrier_post(unsigned* bar, volatile __attribute__((address_space(3))) unsigned* st) {
    XcdBarrier b; b.bar = bar; b.x = xb_xcc_id(); b.st = st;
    if (threadIdx.x == 0) (void)xb_add(&bar[XB_XCNT(b.x)], 1u);
    return b;
}
__device__ __forceinline__ void xcd_barrier_complete(unsigned* bar, unsigned x, unsigned& nloc, unsigned& nx) {
    const unsigned G = gridDim.x * gridDim.y * gridDim.z;
    unsigned sum, cnt, mine, sp = 0u;
    for (;;) {
        sum = 0u; cnt = 0u; mine = 0u;
#pragma unroll
        for (unsigned j = 0; j < 16; ++j) { const unsigned c = xb_ld(&bar[XB_XCNT(j)]); sum += c; cnt += (c > 0u) ? 1u : 0u; mine = (j == x) ? c : mine; }
        if (sum == G) break;
        __builtin_amdgcn_s_sleep(1);
        if ((++sp & 255u) == 0u) { if (xb_ld(&bar[XB_TMO])) break; if (sp > XB_SPIN_CAP) { atomicAdd(&bar[XB_TMO], 1u); break; } }
    }
    nloc = mine > 0u ? mine : 1u; nx = cnt > 0u ? cnt : 1u;
}

__device__ __forceinline__ void xcd_barrier(const XcdBarrier& b) {
    asm volatile("s_waitcnt vmcnt(0)" ::: "memory");
    __syncthreads();
    if (threadIdx.x == 0) {
        unsigned* bar = b.bar;
        __builtin_amdgcn_s_waitcnt(0);
        unsigned nloc = b.st[0], nx = b.st[1];
        if (nloc == 0u) { xcd_barrier_complete(bar, b.x, nloc, nx); b.st[0] = nloc; b.st[1] = nx; }
        const unsigned old = xb_add(&bar[XB_XSUB(b.x)], 1u);
        const unsigned gen = old / nloc;
        if (old + 1u == (gen + 1u) * nloc) {
            __builtin_amdgcn_fence(__ATOMIC_RELEASE, "agent");
            asm volatile("s_waitcnt vmcnt(0)" ::: "memory");
            const unsigned og = xb_add(&bar[XB_TOP], 1u);
            const unsigned tg = og / nx;
            if (og + 1u == (tg + 1u) * nx) xb_add(&bar[XB_TOPGEN], 1u);
            else XB_SPIN(xb_ld(&bar[XB_TOPGEN]) == tg, bar);
            __builtin_amdgcn_fence(__ATOMIC_ACQUIRE, "agent");
            xb_add(&bar[XB_XGEN(b.x)], 1u);
            asm volatile("s_waitcnt vmcnt(0)" ::: "memory");
        } else {
            XB_SPIN(xb_ld(&bar[XB_XGEN(b.x)]) == gen, bar);
            __builtin_amdgcn_fence(__ATOMIC_ACQUIRE, "agent");
            asm volatile("s_waitcnt vmcnt(0)" ::: "memory");
        }
    }
    __syncthreads();
}


struct Params {
    const float *x, *c, *w_ada, *b_ada, *norm1_w, *w_in, *cmp_pe_k, *cmp_pe_v, *cmp_w1_k, *cmp_w2_k, *cmp_w1_v, *cmp_w2_v, *nsa_norm_w, *conv_w, *conv_b, *dt_bias, *a_log, *d_skip,
        *ssd_norm_w, *w_out, *norm2_w, *peer_wq, *peer_qnorm_w, *peer_sub_keys, *peer_down, *peer_up, *final_norm_w;
    float* out; char* ws;
};
#define LDS_BYTES 147456
#define LDS_MISC  (LDS_BYTES - 64)

__global__ __launch_bounds__(512, 2) void mega(Params p) {
    __shared__ __attribute__((aligned(16))) unsigned char lds_raw[LDS_BYTES];
    char* lds = (char*)lds_raw;
    PG8_LAS unsigned char* lds3 = (PG8_LAS unsigned char*)lds_raw;
    int* s_vb = (int*)(lds + LDS_MISC);
    cg::grid_group grid = cg::this_grid();
    volatile __attribute__((address_space(3))) unsigned* xb_st = (volatile __attribute__((address_space(3))) unsigned*)((PG8_LAS unsigned char*)lds_raw + LDS_MISC + 16);
    if (threadIdx.x == 0) { xb_st[0] = 0u; xb_st[1] = 0u; }
    __syncthreads();
    const XcdBarrier xbar = xcd_barrier_post((unsigned*)(p.ws + OFF_BAR), xb_st);
    const int G = gridDim.x, bid = blockIdx.x;
    if (bid == 0 && threadIdx.x == 0) { ((unsigned*)(p.ws + OFF_CTR))[0] = 0u; ((unsigned*)(p.ws + OFF_CTR))[64] = 0u; ((unsigned*)(p.ws + OFF_CTR))[128] = 0u; ((unsigned*)(p.ws + OFF_CTR))[192] = 0u; }
    for (int vb = bid; vb < 4129; vb += G) {
        int v = vb;
        if (v < 768) { d_transpose_w(p.w_in, ((bf16_t*)(p.ws + OFF_WIN_T)), 1024, 2848, 1, 96, v, lds); }
        else if ((v -= 768) < 256) { d_transpose_w(p.w_out, ((bf16_t*)(p.ws + OFF_WOUT_T)), 1024, 1024, 0, 32, v, lds); }
        else if ((v -= 256) < 512) { d_transpose_w(p.peer_wq, ((bf16_t*)(p.ws + OFF_WQ_T)), 1024, 2048, 0, 64, v, lds); }
        else if ((v -= 512) < 128) { d_transpose_w(p.cmp_w1_k, ((bf16_t*)(p.ws + OFF_W1K_T)), 2048, 256, 0, 8, v, lds); }
        else if ((v -= 128) < 128) { d_transpose_w(p.cmp_w1_v, ((bf16_t*)(p.ws + OFF_W1V_T)), 2048, 256, 0, 8, v, lds); }
        else if ((v -= 128) < 1024) { d_quant_rows(p.peer_down, ((unsigned char*)(p.ws + OFF_DOWN)), ((float*)(p.ws + OFF_UP)), v); }
        else if ((v -= 1024) < 1024) { d_quant_rows(p.peer_up, ((unsigned char*)(p.ws + OFF_DOWN + MIB(8))), ((float*)(p.ws + OFF_UP + 65536)), v); }
        else if ((v -= 1024) < 1) { d_convert_bf16(p.peer_sub_keys, ((bf16_t*)(p.ws + OFF_SUBK)), (size_t)8 * 2 * 128 * 128 / 8, 0, 1); }
        else if ((v -= 1) < 96) { d_mod(p.c, p.w_ada, p.b_ada, ((float*)(p.ws + OFF_MOD)), v, lds); }
        else if ((v -= 96) < 128) { d_rope_table(((float2*)(p.ws + OFF_ROPE)), v); }
        else { d_bias1_part(p.cmp_pe_k, p.cmp_w1_k, p.cmp_pe_v, p.cmp_w1_v, ((float*)(p.ws + OFF_BIAS1 + 4096)), v - 128); }
    }
    grid.sync();
    if (bid == G - 1) d_bias1_sum(((float*)(p.ws + OFF_BIAS1 + 4096)), ((float*)(p.ws + OFF_BIAS1)));
    for (int vb = bid; vb < NTOK / 32; vb += G) d_norm_mod<false>(p.x, p.norm1_w, ((float*)(p.ws + OFF_MOD)), 0, 1024, ((bf16_t*)(p.ws + OFF_H)), vb);
    xcd_barrier(xbar);
    {
        const pg8::Gemm g{((bf16_t*)(p.ws + OFF_H)), ((bf16_t*)(p.ws + OFF_WIN_T)), NTOK, NIN_PAD, 1024, 1024};
        pg8::StaticOrder S; S.init(NTOK, NIN_PAD, G, bid);
        const pg8::Epi<EpInProj> E{{((bf16_t*)(p.ws + OFF_PROJ)), ((bf16_t*)(p.ws + OFF_QROPE)), ((bf16_t*)(p.ws + OFF_KVP)), ((float*)(p.ws + OFF_SMALL)), ((float2*)(p.ws + OFF_ROPE)), p.dt_bias}};
        pg8::gemm_phase(lds3, g, S, E);
    }
    xcd_barrier(xbar);
    {
        {
            const pg8::Gemm g{((bf16_t*)(p.ws + OFF_KVP)) + 0 * KVP_SEG, ((bf16_t*)(p.ws + OFF_W1K_T)), 8192, 256, 2048, 1024};
            pg8::StaticOrder S; S.init(8192, 256, G, bid);
            const pg8::Epi<EpCmpHid> E{{((bf16_t*)(p.ws + OFF_HIDK)), ((float*)(p.ws + OFF_BIAS1))}};
            pg8::gemm_phase(lds3, g, S, E);
        }
        {
            const pg8::Gemm g{((bf16_t*)(p.ws + OFF_KVP)) + 1 * KVP_SEG, ((bf16_t*)(p.ws + OFF_W1V_T)), 8192, 256, 2048, 1024};
            pg8::StaticOrder S; S.init(8192, 256, G, (bid + G / 2) % G);
            const pg8::Epi<EpCmpHid> E{{((bf16_t*)(p.ws + OFF_HIDV)), ((float*)(p.ws + OFF_BIAS1)) + 256}};
            pg8::gemm_phase(lds3, g, S, E);
        }
        __syncthreads();
        for (;;) {
            if (threadIdx.x == 0) *s_vb = (int)atomicAdd(&((unsigned*)(p.ws + OFF_CTR))[192], 1u);
            __syncthreads();
            const int i = *s_vb;
            __syncthreads();
            if (i >= 1024) break;
            d_ssd_states(((bf16_t*)(p.ws + OFF_PROJ)), ((float*)(p.ws + OFF_SMALL)), p.conv_w, p.conv_b, p.a_log, ((float*)(p.ws + OFF_ONSA)), ((float*)(p.ws + OFF_CTR + 4096)), i, lds);
        }
    }
    xcd_barrier(xbar);
    for (int k = 0;; ++k) {
        constexpr int p4ni = 2048 / CMP_R, p4na = p4ni / 512, p4nb = (p4ni - 128 * p4na) / 128;
        int vb;
        if (G == 256) {
            if (bid < 128) { if (k > p4na) break; vb = k == 0 ? p4ni + bid : bid * p4na + k - 1; }
            else { if (k >= p4nb) break; vb = 128 * p4na + (bid - 128) * p4nb + k; }
        } else { vb = bid + k * G; if (vb >= p4ni + 128) break; }
        if (vb < p4ni / 2) d_cmp_out<CMP_R>(((bf16_t*)(p.ws + OFF_HIDK)), p.cmp_w2_k, ((bf16_t*)(p.ws + OFF_KC)), vb); else if (vb < p4ni) d_cmp_out<CMP_R>(((bf16_t*)(p.ws + OFF_HIDV)), p.cmp_w2_v, ((bf16_t*)(p.ws + OFF_VC)), vb - p4ni / 2);
        else d_ssd_scan(((float*)(p.ws + OFF_ONSA)), ((float*)(p.ws + OFF_CTR + 4096)), ((bf16_t*)(p.ws + OFF_EIDX)), vb - p4ni);
    }
    xcd_barrier(xbar);
    for (;;) {
        if (threadIdx.x == 0) *s_vb = (int)atomicAdd(&((unsigned*)(p.ws + OFF_CTR))[0], 1u);
        __syncthreads();
        const int i = *s_vb;
        __syncthreads();
        if (i >= 2048) break;
        const int qt = 127 - (i >> 4), bg = i & 15;
        d_nsa_cmp(((bf16_t*)(p.ws + OFF_PROJ)), ((bf16_t*)(p.ws + OFF_KC)), ((bf16_t*)(p.ws + OFF_VC)), ((float*)(p.ws + OFF_SMALL)), ((bf16_t*)(p.ws + OFF_ONSA)), ((unsigned*)(p.ws + OFF_HIDK)) + (size_t)(bg * 128 + qt) * 512, bg >> 1, bg & 1, qt, lds);
    }
    for (;;) {
        if (threadIdx.x == 0) *s_vb = (int)atomicAdd(&((unsigned*)(p.ws + OFF_CTR))[64], 1u);
        __syncthreads();
        const int i = *s_vb;
        __syncthreads();
        if (i >= 1024) break;
        d_ssd_out(((bf16_t*)(p.ws + OFF_PROJ)), ((float*)(p.ws + OFF_SMALL)), p.conv_w, p.conv_b, p.a_log, p.d_skip, ((bf16_t*)(p.ws + OFF_EIDX)), ((bf16_t*)(p.ws + OFF_YSSD)), i, lds);
    }
    xcd_barrier(xbar);
    for (;;) {
        if (threadIdx.x == 0) *s_vb = (int)atomicAdd(&((unsigned*)(p.ws + OFF_CTR))[128], 1u);
        __syncthreads();
        const int i = *s_vb;
        __syncthreads();
        if (i >= 1024) break;
        const int qt2 = 63 - (i >> 4), bg = i & 15;
        d_nsa_attn128(((bf16_t*)(p.ws + OFF_PROJ)), ((float2*)(p.ws + OFF_ROPE)), ((bf16_t*)(p.ws + OFF_KVP)), ((float*)(p.ws + OFF_SMALL)), ((bf16_t*)(p.ws + OFF_ONSA)), ((unsigned*)(p.ws + OFF_HIDK)) + (size_t)(bg * 128) * 512, bg >> 1, bg & 1, qt2, lds);
    }
    xcd_barrier(xbar);
    for (int vb = bid; vb < NTOK / 32; vb += G) d_mix_prep(((bf16_t*)(p.ws + OFF_ONSA)), ((bf16_t*)(p.ws + OFF_YSSD)), p.nsa_norm_w, p.ssd_norm_w, ((bf16_t*)(p.ws + OFF_H)), vb);
    xcd_barrier(xbar);
    {
        const pg8::Gemm g{((bf16_t*)(p.ws + OFF_H)), ((bf16_t*)(p.ws + OFF_WOUT_T)), NTOK, 1024, 1024, 1024};
        pg8::StaticOrder S; S.init(NTOK, 1024, G, bid);
        const pg8::Epi<EpOutProj> E{{p.x, ((float*)(p.ws + OFF_MOD)), ((bf16_t*)(p.ws + OFF_ONSA))}};
        pg8::gemm_phase(lds3, g, S, E);
    }
    xcd_barrier(xbar);
    for (int vb = bid; vb < NTOK / 32; vb += G) d_norm_mod<true>(((bf16_t*)(p.ws + OFF_ONSA)), p.norm2_w, ((float*)(p.ws + OFF_MOD)), 3072, 4096, ((bf16_t*)(p.ws + OFF_H)), vb);
    xcd_barrier(xbar);
    {
        const pg8::Gemm g{((bf16_t*)(p.ws + OFF_H)), ((bf16_t*)(p.ws + OFF_WQ_T)), NTOK, 2048, 1024, 1024};
        pg8::StaticOrder S; S.init(NTOK, 2048, G, bid);
        const pg8::Epi<EpStoreBf16> E{{((bf16_t*)(p.ws + OFF_PROJ)), 2048, 0}};
        pg8::gemm_phase(lds3, g, S, E);
    }
    xcd_barrier(xbar);
    for (int h = 0; h < 8; ++h) {
        __syncthreads();
        d_peer_stage_keys(((bf16_t*)(p.ws + OFF_SUBK)), h, lds);
        __syncthreads();
        for (int tile = bid; tile < 512; tile += G) d_peer_route(((bf16_t*)(p.ws + OFF_PROJ)), p.peer_qnorm_w, ((int*)(p.ws + OFF_EIDX)), ((float*)(p.ws + OFF_GATE)), tile, h, lds);
    }
    xcd_barrier(xbar);
    d_peer_expert_stream(((bf16_t*)(p.ws + OFF_H)), ((unsigned char*)(p.ws + OFF_DOWN)), ((unsigned char*)(p.ws + OFF_DOWN + MIB(8))), ((float*)(p.ws + OFF_UP)), ((float*)(p.ws + OFF_UP + 65536)), ((int*)(p.ws + OFF_EIDX)), ((float*)(p.ws + OFF_GATE)), ((float*)(p.ws + OFF_MOD)), p.final_norm_w, ((bf16_t*)(p.ws + OFF_ONSA)), p.out, ((float*)(p.ws + OFF_SMALL)), bid, G, lds);
}

extern "C" void kernel_launch(void* const* d_in, const int* in_sizes, int n_in, void* d_out, int out_size, void* d_ws, size_t ws_size, hipStream_t stream) {
    if (ws_size < WS_NEED) { fprintf(stderr, "workspace too small\n"); return; }
    static int grid_blocks = 0;
    if (!grid_blocks) {
        int dev = 0, cus = 0, per_cu = 0;
        (void)hipGetDevice(&dev);
        (void)hipDeviceGetAttribute(&cus, hipDeviceAttributeMultiprocessorCount, dev);
        (void)hipOccupancyMaxActiveBlocksPerMultiprocessor(&per_cu, mega, 512, 0);
        if (per_cu < 1) fprintf(stderr, "occupancy query reports %d blocks per CU\n", per_cu);
        grid_blocks = cus;
    }
    Params p{};
    const float** pp = (const float**)&p;
    for (int i = 0; i < 27; ++i) pp[i] = (const float*)d_in[i];
    p.out = (float*)d_out; p.ws = (char*)d_ws;
    (void)hipMemsetAsync((char*)d_ws + OFF_BAR, 0, XCD_BAR_WORDS * 4, stream);
    void* args[] = {&p};
    hipError_t e = hipLaunchCooperativeKernel((void*)mega, dim3(grid_blocks), dim3(512), args, 0, stream);
    if (e != hipSuccess) fprintf(stderr, "cooperative launch failed: %s (grid %d)\n", hipGetErrorString(e), grid_blocks);
}
```
